# Optimizing an MI355X kernel written in HIP

```python
import math
import jax, jax.numpy as jnp
from jax import lax
import numpy as np

D_MODEL = 2048
BATCH = 4
SEQ = 4096
DEPTH = 1

GDN_HEADS = 8
GDN_DK = 128
GDN_DV = 128
CONV_WIDTH = 4
CHUNK = 64
DSA_HEADS = 8
DSA_KV_HEADS = 2
DSA_HEAD_DIM = 128
IDX_HEADS = 16
IDX_DIM = 64
TOPK_MAX = 256
Q_BLOCK = 128
ROPE_THETA = 500000.0
ROPE_FRACTION = 4
EPS = 1e-6

GDN_W = GDN_HEADS * GDN_DV
DSA_W = DSA_HEADS * DSA_HEAD_DIM
MIX_W = GDN_W + DSA_W
CONV_CH = 2 * GDN_HEADS * GDN_DK + GDN_HEADS * GDN_DV
IN_SIZES = (
    GDN_HEADS * GDN_DK,
    GDN_HEADS * GDN_DK,
    GDN_HEADS * GDN_DV,
    GDN_W,
    GDN_HEADS,
    GDN_HEADS,
    DSA_HEADS * DSA_HEAD_DIM,
    DSA_KV_HEADS * DSA_HEAD_DIM,
    DSA_KV_HEADS * DSA_HEAD_DIM,
    DSA_W,
    IDX_HEADS * IDX_DIM,
    IDX_DIM,
    IDX_HEADS,
)
IN_COLS = sum(IN_SIZES)

kernel_name = "hymba_gdn_dsa_hybrid_layer"


def rms_norm(x, g):
    xf = x.astype(jnp.float32)
    out = xf * lax.rsqrt(jnp.mean(xf * xf, axis=-1, keepdims=True) + EPS)
    return (out * g.astype(jnp.float32)).astype(x.dtype)


def l2_normalize(x):
    return x * lax.rsqrt(jnp.sum(x * x, axis=-1, keepdims=True) + EPS)


def partial_rope(x, positions):
    d = x.shape[-1]
    rot = d // ROPE_FRACTION
    half = rot // 2
    inv_freq = ROPE_THETA ** (-(jnp.arange(half, dtype=jnp.float32) * 2.0 / rot))
    ang = positions.astype(jnp.float32)[..., None] * inv_freq
    cos = jnp.cos(ang)[:, :, None, :]
    sin = jnp.sin(ang)[:, :, None, :]
    x1, x2, rest = x[..., :half], x[..., half:rot], x[..., rot:]
    return jnp.concatenate([x1 * cos - x2 * sin, x2 * cos + x1 * sin, rest], axis=-1)


def causal_depthwise_conv(x, w):
    c = x.shape[-1]
    return lax.conv_general_dilated(
        x, w[:, None, :].astype(x.dtype), window_strides=(1,), padding=[(w.shape[0] - 1, 0)],
        dimension_numbers=('NWC', 'WIO', 'NWC'), feature_group_count=c)


def gated_delta_rule(q, k, v, g, beta):
    b, t, h, dk = q.shape
    dv = v.shape[-1]
    n = t // CHUNK
    q = l2_normalize(q) * (dk ** -0.5)
    k = l2_normalize(k)

    def to_chunks(a):
        return a.reshape(b, n, CHUNK, h, a.shape[-1]).transpose(1, 0, 3, 2, 4)

    qc, kc, vc = to_chunks(q), to_chunks(k), to_chunks(v)
    gc = jnp.cumsum(g.reshape(b, n, CHUNK, h).transpose(1, 0, 3, 2), axis=-1)
    bc = beta.reshape(b, n, CHUNK, h).transpose(1, 0, 3, 2)
    pos = jnp.arange(CHUNK)
    incl = pos[:, None] >= pos[None, :]
    strict = pos[:, None] > pos[None, :]
    diff = gc[..., :, None] - gc[..., None, :]
    decay = jnp.where(incl, jnp.exp(jnp.where(incl, diff, 0.0)), 0.0)
    kb = kc * bc[..., None]
    vb = vc * bc[..., None]
    lmat = jnp.where(strict, jnp.einsum('nbhid,nbhjd->nbhij', kb, kc) * decay, 0.0)
    eye = jnp.eye(CHUNK, dtype=q.dtype)
    tmat = lax.linalg.triangular_solve(lmat + eye, jnp.broadcast_to(eye, lmat.shape),
                                       left_side=True, lower=True, unit_diagonal=True)
    w = jnp.einsum('nbhij,nbhjd->nbhid', tmat, kb * jnp.exp(gc)[..., None])
    u = jnp.einsum('nbhij,nbhjd->nbhid', tmat, vb)
    a_intra = jnp.einsum('nbhid,nbhjd->nbhij', qc, kc) * decay

    def step(state, xs):
        qn, kn, un, wn, gn, an = xs
        v_new = un - jnp.einsum('bhcd,bhde->bhce', wn, state)
        o = (jnp.einsum('bhcd,bhde->bhce', qn * jnp.exp(gn)[..., None], state)
             + jnp.einsum('bhij,bhje->bhie', an, v_new))
        g_last = gn[..., -1]
        state = (state * jnp.exp(g_last)[..., None, None]
                 + jnp.einsum('bhcd,bhce->bhde', kn * jnp.exp(g_last[..., None] - gn)[..., None], v_new))
        return state, o

    s0 = jnp.zeros((b, h, dk, dv), q.dtype)
    _, o = lax.scan(step, s0, (qc, kc, u, w, gc, a_intra))
    return o.transpose(1, 0, 3, 2, 4).reshape(b, t, h, dv)


def dsa_sparse_attention(q, k, v, q_idx, k_idx, w_idx, k_sel):
    b, t, hq, dh = q.shape
    hkv = k.shape[2]
    rep = hq // hkv
    nb = t // Q_BLOCK
    qg = q.reshape(b, t, hkv, rep, dh)
    key_pos = jnp.arange(t)
    scale = dh ** -0.5
    gather = jax.vmap(lambda src, ids: src[ids])

    def block(j):
        t0 = j * Q_BLOCK
        qi = lax.dynamic_slice_in_dim(q_idx, t0, Q_BLOCK, axis=1)
        wi = lax.dynamic_slice_in_dim(w_idx, t0, Q_BLOCK, axis=1)
        qa = lax.dynamic_slice_in_dim(qg, t0, Q_BLOCK, axis=1)
        q_pos = t0 + jnp.arange(Q_BLOCK)
        score = jnp.einsum('bqh,bqhs->bqs', wi,
                           jax.nn.relu(jnp.einsum('bqhd,bsd->bqhs', qi, k_idx)))
        causal = key_pos[None, :] <= q_pos[:, None]
        score = jnp.where(causal[None], score, -jnp.inf)
        _, sel = lax.top_k(score, k_sel)
        valid = sel <= q_pos[None, :, None]
        k_g = gather(k, sel)
        v_g = gather(v, sel)
        logits = jnp.einsum('bqgrd,bqkgd->bqgrk', qa, k_g) * scale
        logits = jnp.where(valid[:, :, None, None, :], logits, -jnp.inf)
        p = jax.nn.softmax(logits, axis=-1)
        o = jnp.einsum('bqgrk,bqkgd->bqgrd', p, v_g)
        return o.reshape(b, Q_BLOCK, hq * dh)

    out = lax.map(block, jnp.arange(nb))
    return out.transpose(1, 0, 2, 3).reshape(b, t, hq * dh)


def setup_inputs(seed: int = 0) -> dict:
    key = jax.random.key(seed)
    ks = jax.random.split(key, 10)
    x = jax.random.normal(ks[0], (BATCH, SEQ, D_MODEL), jnp.float32)
    positions = jnp.broadcast_to(jnp.arange(SEQ, dtype=jnp.int32), (BATCH, SEQ))
    attn_norm_g = 1.0 + 0.02 * jax.random.normal(ks[1], (DEPTH, D_MODEL), jnp.float32)
    w_in = jax.random.normal(ks[2], (DEPTH, D_MODEL, IN_COLS), jnp.float32) * D_MODEL ** -0.5
    gdn_conv_w = jax.random.normal(ks[3], (DEPTH, CONV_WIDTH, CONV_CH), jnp.float32) * CONV_WIDTH ** -0.5
    gdn_a_log = jnp.log(jax.random.uniform(ks[4], (DEPTH, GDN_HEADS), jnp.float32, 1.0, 16.0))
    dt = jnp.exp(jax.random.uniform(ks[5], (DEPTH, GDN_HEADS), jnp.float32,
                                    math.log(1e-3), math.log(1e-1)))
    gdn_dt_bias = dt + jnp.log(-jnp.expm1(-dt))
    gdn_norm_g = 1.0 + 0.02 * jax.random.normal(ks[6], (DEPTH, GDN_DV), jnp.float32)
    w_out = jax.random.normal(ks[7], (DEPTH, MIX_W, D_MODEL), jnp.float32) * MIX_W ** -0.5
    final_norm_g = 1.0 + 0.02 * jax.random.normal(ks[8], (D_MODEL,), jnp.float32)
    return {"x": x, "positions": positions, "attn_norm_g": attn_norm_g, "w_in": w_in,
            "gdn_conv_w": gdn_conv_w, "gdn_a_log": gdn_a_log, "gdn_dt_bias": gdn_dt_bias,
            "gdn_norm_g": gdn_norm_g, "w_out": w_out, "final_norm_g": final_norm_g}


def reference(x, positions, attn_norm_g, w_in, gdn_conv_w, gdn_a_log, gdn_dt_bias,
              gdn_norm_g, w_out, final_norm_g):
    b, t, _ = x.shape
    k_sel = min(TOPK_MAX, t // 4)
    split_points = tuple(int(s) for s in np.cumsum(IN_SIZES)[:-1])
    f32 = jnp.float32
    for l in range(DEPTH):
        h = rms_norm(x, attn_norm_g[l])
        proj = (h @ w_in[l]).astype(f32)
        (gq, gk, gv, gz, ga, gb, aq, ak, av, az, iq, ik, iw) = jnp.split(proj, split_points, axis=-1)

        qkv = jax.nn.silu(causal_depthwise_conv(jnp.concatenate([gq, gk, gv], axis=-1), gdn_conv_w[l].astype(f32)))
        q_a, k_a, v_a = jnp.split(qkv, (GDN_HEADS * GDN_DK, 2 * GDN_HEADS * GDN_DK), axis=-1)
        q_a = q_a.reshape(b, t, GDN_HEADS, GDN_DK)
        k_a = k_a.reshape(b, t, GDN_HEADS, GDN_DK)
        v_a = v_a.reshape(b, t, GDN_HEADS, GDN_DV)
        g_a = -jnp.exp(gdn_a_log[l].astype(f32)) * jax.nn.softplus(ga + gdn_dt_bias[l].astype(f32))
        beta_a = jax.nn.sigmoid(gb)
        o_a = gated_delta_rule(q_a, k_a, v_a, g_a, beta_a)
        o_a = rms_norm(o_a, gdn_norm_g[l]).reshape(b, t, GDN_W) * jax.nn.silu(gz)

        q_b = partial_rope(aq.reshape(b, t, DSA_HEADS, DSA_HEAD_DIM), positions)
        k_b = partial_rope(ak.reshape(b, t, DSA_KV_HEADS, DSA_HEAD_DIM), positions)
        v_b = av.reshape(b, t, DSA_KV_HEADS, DSA_HEAD_DIM)
        q_i = partial_rope(iq.reshape(b, t, IDX_HEADS, IDX_DIM), positions)
        k_i = partial_rope(ik.reshape(b, t, 1, IDX_DIM), positions)[:, :, 0]
        w_i = iw * (IDX_HEADS ** -0.5) * (IDX_DIM ** -0.5)
        o_b = dsa_sparse_attention(q_b, k_b, v_b, q_i, k_i, w_i, k_sel) * jax.nn.silu(az)

        mixed = jnp.concatenate([o_a, o_b], axis=-1).astype(x.dtype) @ w_out[l]
        x = x + mixed
    return rms_norm(x, final_norm_g)
```

```cpp
#include <hip/hip_runtime.h>
#include <hip/hip_cooperative_groups.h>
#include <cstdio>
#include <cstdint>
namespace cg = cooperative_groups;

#ifndef FUSED
#define FUSED 0
#endif

#define LAS __attribute__((address_space(3)))
typedef _Float16 h16;
typedef h16 h16x8 __attribute__((ext_vector_type(8)));
typedef h16 h16x4 __attribute__((ext_vector_type(4)));
typedef h16 h16x2 __attribute__((ext_vector_type(2)));
typedef float f32x4 __attribute__((ext_vector_type(4)));
typedef float f32x2 __attribute__((ext_vector_type(2)));
typedef unsigned u32x4 __attribute__((ext_vector_type(4)));

constexpr int NB = 4, NT = 4096, DM = 2048, BT = NB * NT;
constexpr int IN_COLS = 7776, NPAD = 7936;
constexpr float EPS = 1e-6f;
constexpr int LDS_BYTES = 131072 + 8192;

constexpr size_t MB = 1024 * 1024;
constexpr size_t OFF_CTRL = 0;
constexpr size_t OFF_ROWSS = 65536;
constexpr size_t CTL_ZERO_BYTES = 65536 + (size_t)BT * 4;
constexpr size_t OFF_H = 1 * MB;
constexpr size_t OFF_OMIX = OFF_H;
constexpr size_t OFF_WT = OFF_H + 64 * MB;
constexpr size_t OFF_WOT = OFF_WT + (size_t)NPAD * 2048 * 2;
constexpr size_t OFF_QKVR = OFF_WOT + 8 * MB;
constexpr size_t OFF_GZ = OFF_QKVR + (size_t)BT * 3072 * 2;
constexpr size_t OFF_AQ = OFF_GZ + 32 * MB;
constexpr size_t OFF_AK = OFF_AQ + 32 * MB;
constexpr size_t OFF_AV = OFF_AK + 8 * MB;
constexpr size_t OFF_AZ = OFF_AV + 8 * MB;
constexpr size_t OFF_IQ = OFF_AZ + 32 * MB;
constexpr size_t OFF_IK = OFF_IQ + 32 * MB;
constexpr size_t OFF_GB = OFF_IK + 2 * MB;
constexpr size_t OFF_IW = OFF_GB + 1 * MB;
constexpr size_t OFF_COS = OFF_IW + 1 * MB;
constexpr size_t OFF_SIN = OFF_COS + 2 * MB;
constexpr size_t OFF_SEL = OFF_SIN + 2 * MB;
constexpr size_t OFF_ORAW = OFF_SEL + 8 * MB;
constexpr size_t WS_END = OFF_ORAW + 64 * MB;

struct Params {
    const float* x; const int* pos; const float* attn_g; const float* w_in; const float* conv_w; const float* a_log;
    const float* dt_bias; const float* gdn_norm_g; const float* w_out; const float* final_g; float* out; unsigned char* ws;
};

__device__ __forceinline__ float wave_sum(float v) {
#pragma unroll
    for (int o = 1; o < 64; o <<= 1) v += __shfl_xor(v, o);
    return v;
}
__device__ __forceinline__ float wave_max(float v) {
#pragma unroll
    for (int o = 1; o < 64; o <<= 1) v = fmaxf(v, __shfl_xor(v, o));
    return v;
}
__device__ __forceinline__ float silu_f(float x) { return x / (1.0f + __expf(-x)); }

namespace pg8 {
constexpr int BM = 256, BK = 64, HALF = 128, HTB = HALF * BK * 2, STAGE_BYTES = 8 * HTB, NXCD = 8, WGM = 8;
__host__ __device__ __forceinline__ int lds_byte(int r, int c) { const int st = (r >> 4) * 2 + (c >> 5), rr = r & 15, cc = c & 31, ob = rr * 64 + cc * 2; return st * 1024 + (ob ^ (((ob >> 9) & 1) << 5)); }
__host__ __device__ __forceinline__ void stage_rc(int b, int& R, int& C) { const int st = b / 1024, sb = b % 1024, swz = sb ^ (((sb >> 9) & 1) << 5); R = (st >> 1) * 16 + swz / 64; C = (st & 1) * 32 + (swz % 64) / 2; }
__host__ __device__ __forceinline__ int perm32(int rho) { const int n = rho >> 4, i = rho & 15; return 8 * (i >> 2) + 4 * n + (i & 3); }
struct Unit { int pm, pn; };
struct Gemm { const h16* A; const h16* Bt; int M, N, K; };
struct StaticOrder {
    int nM, nN, nwg, G, c;
    __host__ __device__ void init(int M, int N, int G_, int c_) { nM = M / BM; nN = N / BM; nwg = nM * nN; G = G_; c = c_; }
    __host__ __device__ bool next(int i, Unit& u) const {
        const long L = (long)i * G + c; if (L >= nwg) return false;
        int wgid = (int)L; { const int q = nwg / NXCD, r = nwg % NXCD, xcd = wgid % NXCD, off = wgid / NXCD; wgid = (xcd < r ? xcd * (q + 1) : r * (q + 1) + (xcd - r) * q) + off; }
        const int nig = WGM * nN, gid = wgid / nig, fm = gid * WGM, gsz = (nM - fm) < WGM ? (nM - fm) : WGM;
        u.pm = fm + ((wgid % nig) % gsz); u.pn = (wgid % nig) / gsz; return true;
    }
    __device__ __forceinline__ void a_ready(const Unit&) const {}
    __device__ __forceinline__ void done(const Unit&) const {}
};

template <class Epi, class Sched>
__device__ __forceinline__ void gemm_phase(LAS unsigned char* lds, const Gemm g, const Sched& S, const Epi& E) {
    const int tid = threadIdx.x, wid = __builtin_amdgcn_readfirstlane(tid >> 6), lane = tid & 63, wr = wid >> 2, wc = wid & 3, fr = lane & 15, fq = lane >> 4;
    const int K = g.K, nt = K / BK;
    unsigned voffA[2], voffB[2];
#pragma unroll
    for (int i = 0; i < 2; ++i) { int R, C; stage_rc(tid * 16 + i * 8192, R, C); const int Rb = Epi::PERM ? ((R & ~31) + perm32(R & 31)) : R;
        voffA[i] = (unsigned)(R * K + C) * 2u; voffB[i] = (unsigned)(Rb * K + C) * 2u; }
    const size_t kstep = (size_t)(BK * 2);
    const size_t hstep = (size_t)HALF * K * 2;
    const size_t tstep = 2 * hstep;
    const unsigned ldsw = (unsigned)wid * 1024u;
    const int aoff = lds_byte(wr * 64 + fr, fq * 8), boff = lds_byte(wc * 32 + fr, fq * 8);
#define PG8_SA(b, h) (((b) * 2 + (h)) * HTB)
#define PG8_SB(b, h) ((4 + (b) * 2 + (h)) * HTB)
#define PG8_STAGE(bufoff, gbase, voff) do { _Pragma("unroll") for (int _i = 0; _i < 2; ++_i) \
        __builtin_amdgcn_global_load_lds((const unsigned*)((const char*)(gbase) + (voff)[_i]), (LAS unsigned*)(lds + (bufoff) + ldsw + _i * 8192), 16, 0, 0); } while (0)
#define PG8_LDA(dst, b, h) do { _Pragma("unroll") for (int m = 0; m < 4; ++m) _Pragma("unroll") for (int k = 0; k < 2; ++k) dst[m][k] = *(const LAS h16x8*)(lds + PG8_SA(b, h) + aoff + m * 2048 + k * 1024); } while (0)
#define PG8_LDB(dst, b, h) do { _Pragma("unroll") for (int n = 0; n < 2; ++n) _Pragma("unroll") for (int k = 0; k < 2; ++k) dst[n][k] = *(const LAS h16x8*)(lds + PG8_SB(b, h) + boff + n * 2048 + k * 1024); } while (0)
#define PG8_MMA(ai, bj, At, Bt) do { __builtin_amdgcn_s_setprio(1); _Pragma("unroll") for (int m = 0; m < 4; ++m) _Pragma("unroll") for (int n = 0; n < 2; ++n) _Pragma("unroll") for (int k = 0; k < 2; ++k) \
        acc[ai][bj][m][n] = __builtin_amdgcn_mfma_f32_16x16x32_f16(Bt[n][k], At[m][k], acc[ai][bj][m][n], 0, 0, 0); __builtin_amdgcn_s_setprio(0); } while (0)
#define PG8_WAIT_V(n) asm volatile("s_waitcnt vmcnt(" #n ")" ::: "memory")
#define PG8_WAIT_L(n) asm volatile("s_waitcnt lgkmcnt(" #n ")" ::: "memory")
#define PG8_BAR __builtin_amdgcn_s_barrier()
#define PG8_SCHED __builtin_amdgcn_sched_barrier(0)
    Unit cur, nxt; int ui = 0;
    if (!S.next(0, cur)) return;
    f32x4 acc[2][2][4][2];
#pragma unroll
    for (int a = 0; a < 2; ++a)
#pragma unroll
        for (int b = 0; b < 2; ++b)
#pragma unroll
            for (int m = 0; m < 4; ++m)
#pragma unroll
                for (int n = 0; n < 2; ++n) acc[a][b][m][n] = (f32x4){0.f, 0.f, 0.f, 0.f};
    h16x8 At[4][2], B0[2][2], B1[2][2];
    const char* cA = (const char*)g.A + (size_t)cur.pm * tstep; const char* cB = (const char*)g.Bt + (size_t)cur.pn * tstep;
    S.a_ready(cur);
    PG8_STAGE(PG8_SB(0, 0), cB, voffB); PG8_STAGE(PG8_SA(0, 0), cA, voffA); PG8_STAGE(PG8_SB(0, 1), cB + hstep, voffB); PG8_STAGE(PG8_SA(0, 1), cA + hstep, voffA);
    if (wr == 1) PG8_BAR;
    PG8_WAIT_V(4); PG8_BAR;
    PG8_STAGE(PG8_SB(1, 0), cB + kstep, voffB); PG8_STAGE(PG8_SA(1, 0), cA + kstep, voffA); PG8_STAGE(PG8_SB(1, 1), cB + hstep + kstep, voffB);
    PG8_WAIT_V(6); PG8_BAR;
    for (;;) {
        const bool has_next = S.next(ui + 1, nxt);
        const char* nA = has_next ? (const char*)g.A + (size_t)nxt.pm * tstep : cA; const char* nB = has_next ? (const char*)g.Bt + (size_t)nxt.pn * tstep : cB;
        for (int t = 0; t < nt; t += 2) {
            const bool last = (t == nt - 2);
            const char* a1 = cA + (size_t)(t + 1) * kstep;
            const char* a2 = last ? nA : cA + (size_t)(t + 2) * kstep; const char* b2 = last ? nB : cB + (size_t)(t + 2) * kstep;
            const char* a3 = a2 + kstep; const char* b3 = b2 + kstep;
            if (last && has_next) S.a_ready(nxt);
            PG8_LDB(B0, 0, 0); PG8_SCHED; PG8_LDA(At, 0, 0); PG8_STAGE(PG8_SA(1, 1), a1 + hstep, voffA);
            PG8_WAIT_L(8); PG8_BAR; PG8_WAIT_L(0); PG8_MMA(0, 0, At, B0); PG8_BAR; PG8_SCHED;
            PG8_LDB(B1, 0, 1); PG8_STAGE(PG8_SB(0, 0), b2, voffB);
            PG8_BAR; PG8_WAIT_L(0); PG8_MMA(0, 1, At, B1); PG8_BAR;
            PG8_LDA(At, 0, 1); PG8_STAGE(PG8_SA(0, 0), a2, voffA);
            PG8_BAR; PG8_WAIT_L(0); PG8_MMA(1, 0, At, B0); PG8_BAR; PG8_SCHED;
            PG8_STAGE(PG8_SB(0, 1), b2 + hstep, voffB);
            PG8_WAIT_V(6); PG8_BAR; PG8_MMA(1, 1, At, B1); PG8_BAR;
            PG8_LDB(B0, 1, 0); PG8_SCHED; PG8_LDA(At, 1, 0); PG8_STAGE(PG8_SA(0, 1), a2 + hstep, voffA);
            PG8_WAIT_L(8); PG8_BAR; PG8_WAIT_L(0); PG8_MMA(0, 0, At, B0); PG8_BAR; PG8_SCHED;
            PG8_LDB(B1, 1, 1); PG8_STAGE(PG8_SB(1, 0), b3, voffB);
            PG8_BAR; PG8_WAIT_L(0); PG8_MMA(0, 1, At, B1); PG8_BAR;
            PG8_LDA(At, 1, 1); PG8_STAGE(PG8_SA(1, 0), a3, voffA);
            PG8_BAR; PG8_WAIT_L(0); PG8_MMA(1, 0, At, B0); PG8_BAR; PG8_SCHED;
            PG8_STAGE(PG8_SB(1, 1), b3 + hstep, voffB);
            PG8_WAIT_V(6); PG8_BAR; PG8_MMA(1, 1, At, B1); PG8_BAR;
        }
        E(acc, cur, wr, wc, fr, fq); S.done(cur);
        if (!has_next) break;
#pragma unroll
        for (int a = 0; a < 2; ++a)
#pragma unroll
            for (int b = 0; b < 2; ++b)
#pragma unroll
                for (int m = 0; m < 4; ++m)
#pragma unroll
                    for (int n = 0; n < 2; ++n) acc[a][b][m][n] = (f32x4){0.f, 0.f, 0.f, 0.f};
        cur = nxt; cA = nA; cB = nB; ++ui;
    }
    PG8_WAIT_V(0);
    if (wr == 0) PG8_BAR;
    PG8_BAR;
#undef PG8_SA
#undef PG8_SB
#undef PG8_STAGE
#undef PG8_LDA
#undef PG8_LDB
#undef PG8_MMA
#undef PG8_WAIT_V
#undef PG8_WAIT_L
#undef PG8_BAR
#undef PG8_SCHED
}
}

struct EpiIn {
    static constexpr bool PERM = true;
    unsigned char* ws; const float* a_log; const float* dt_bias;
    __device__ __forceinline__ void operator()(const f32x4 (&acc)[2][2][4][2], const pg8::Unit& u, int wr, int wc, int fr, int fq) const {
        const int pn = u.pn;
        const int rowb = u.pm * 256 + wr * 64 + fr;
        const int cw = wc * 32 + 8 * fq;
        const float* cosT = (const float*)(ws + OFF_COS); const float* sinT = (const float*)(ws + OFF_SIN);
        if (pn < 30) {
            h16* base; int ldc, colt, mode; float scale = 1.f;
            if (pn < 12) { base = (h16*)(ws + OFF_QKVR); ldc = 3072; colt = pn * 256; mode = 0; }
            else if (pn < 16) { base = (h16*)(ws + OFF_GZ); ldc = 1024; colt = (pn - 12) * 256; mode = 1; }
            else if (pn < 20) { base = (h16*)(ws + OFF_AQ); ldc = 1024; colt = (pn - 16) * 256; mode = 2; scale = 0.08838834764831845f; }
            else if (pn == 20) { base = (h16*)(ws + OFF_AK); ldc = 256; colt = 0; mode = 2; }
            else if (pn == 21) { base = (h16*)(ws + OFF_AV); ldc = 256; colt = 0; mode = 0; }
            else if (pn < 26) { base = (h16*)(ws + OFF_AZ); ldc = 1024; colt = (pn - 22) * 256; mode = 1; }
            else { base = (h16*)(ws + OFF_IQ); ldc = 1024; colt = (pn - 26) * 256; mode = 3; }
            const bool rot_wave = (mode == 2 && wc == 0) || (mode == 3 && (wc & 1) == 0);
            const int xm = (mode == 2) ? 32 : 16;
            const bool rot_lane = (mode == 2) ? true : (fq < 2);
            const float sgn = (mode == 2) ? (fq < 2 ? -1.f : 1.f) : (fq == 0 ? -1.f : 1.f);
            const int tix = (mode == 2) ? 8 * (fq & 1) : 16;
#pragma unroll
            for (int ai = 0; ai < 2; ++ai)
#pragma unroll
                for (int m = 0; m < 4; ++m) {
                    const int row = rowb + ai * 128 + m * 16;
                    float cs[8], sn[8];
                    if (rot_wave) {
                        const f32x4 c0 = *(const f32x4*)(cosT + (size_t)row * 24 + tix), c1 = *(const f32x4*)(cosT + (size_t)row * 24 + tix + 4);
                        const f32x4 s0 = *(const f32x4*)(sinT + (size_t)row * 24 + tix), s1 = *(const f32x4*)(sinT + (size_t)row * 24 + tix + 4);
#pragma unroll
                        for (int j = 0; j < 4; ++j) { cs[j] = c0[j]; cs[4 + j] = c1[j]; sn[j] = s0[j]; sn[4 + j] = s1[j]; }
                    }
#pragma unroll
                    for (int bj = 0; bj < 2; ++bj) {
                        float v[8];
#pragma unroll
                        for (int j = 0; j < 4; ++j) { v[j] = acc[ai][bj][m][0][j]; v[4 + j] = acc[ai][bj][m][1][j]; }
                        if (rot_wave) {
#pragma unroll
                            for (int j = 0; j < 8; ++j) { const float pv = __shfl_xor(v[j], xm); if (rot_lane) v[j] = v[j] * cs[j] + sgn * pv * sn[j]; }
                        }
                        if (mode == 1) {
#pragma unroll
                            for (int j = 0; j < 8; ++j) v[j] = silu_f(v[j]);
                        }
                        h16x8 o;
#pragma unroll
                        for (int j = 0; j < 8; ++j) o[j] = (h16)(v[j] * scale);
                        *(h16x8*)(base + (size_t)row * ldc + colt + bj * 128 + cw) = o;
                    }
                }
        } else {
            h16* ik = (h16*)(ws + OFF_IK); float* gb = (float*)(ws + OFF_GB); float* iw = (float*)(ws + OFF_IW);
#pragma unroll
            for (int ai = 0; ai < 2; ++ai)
#pragma unroll
                for (int m = 0; m < 4; ++m) {
                    const int row = rowb + ai * 128 + m * 16;
                    float v[8];
#pragma unroll
                    for (int j = 0; j < 4; ++j) { v[j] = acc[ai][0][m][0][j]; v[4 + j] = acc[ai][0][m][1][j]; }
                    if (wc == 0) {
                        const f32x4 c0 = *(const f32x4*)(cosT + (size_t)row * 24 + 16), c1 = *(const f32x4*)(cosT + (size_t)row * 24 + 20);
                        const f32x4 s0 = *(const f32x4*)(sinT + (size_t)row * 24 + 16), s1 = *(const f32x4*)(sinT + (size_t)row * 24 + 20);
                        const float sgn = (fq == 0 ? -1.f : 1.f);
#pragma unroll
                        for (int j = 0; j < 8; ++j) { const float pv = __shfl_xor(v[j], 16); const float c = j < 4 ? c0[j & 3] : c1[j & 3], s = j < 4 ? s0[j & 3] : s1[j & 3];
                            if (fq < 2) v[j] = v[j] * c + sgn * pv * s; }
                    }
                    if (wc < 2) {
                        h16x8 o;
#pragma unroll
                        for (int j = 0; j < 8; ++j) o[j] = (h16)v[j];
                        *(h16x8*)(ik + (size_t)row * 64 + cw) = o;
                    } else if (wc == 2) {
                        if (fq == 0) {
#pragma unroll
                            for (int j = 0; j < 8; ++j) { const float z = v[j] + dt_bias[j]; const float sp = z > 20.f ? z : log1pf(expf(z)); gb[(size_t)row * 16 + j] = -expf(a_log[j]) * sp; }
                        } else if (fq == 1) {
#pragma unroll
                            for (int j = 0; j < 8; ++j) gb[(size_t)row * 16 + 8 + j] = 1.0f / (1.0f + expf(-v[j]));
                        } else {
#pragma unroll
                            for (int j = 0; j < 8; ++j) iw[(size_t)row * 16 + 8 * (fq - 2) + j] = v[j] * 0.03125f;
                        }
                    }
                }
        }
    }
};

struct EpiOut {
    static constexpr bool PERM = false;
    const float* x; float* out; float* rowss;
    __device__ __forceinline__ void operator()(const f32x4 (&acc)[2][2][4][2], const pg8::Unit& u, int wr, int wc, int fr, int fq) const {
        const int rowb = u.pm * 256 + wr * 64 + fr, col0 = u.pn * 256 + wc * 32 + 4 * fq;
#pragma unroll
        for (int ai = 0; ai < 2; ++ai)
#pragma unroll
            for (int m = 0; m < 4; ++m) {
                const int row = rowb + ai * 128 + m * 16; float ss = 0.f;
#pragma unroll
                for (int bj = 0; bj < 2; ++bj)
#pragma unroll
                    for (int n = 0; n < 2; ++n) {
                        const size_t off = (size_t)row * DM + col0 + bj * 128 + n * 16;
                        const f32x4 y = *(const f32x4*)(x + off) + acc[ai][bj][m][n];
                        *(f32x4*)(out + off) = y; ss += (y[0] * y[0] + y[1] * y[1]) + (y[2] * y[2] + y[3] * y[3]);
                    }
                ss += __shfl_xor(ss, 16); ss += __shfl_xor(ss, 32);
                if (fq == 0) atomicAdd(rowss + row, ss);
            }
    }
};

__device__ __forceinline__ int src_col(int np) {
    if (np < 4096) return np;
    if (np < 7680) return np + 16;
    if (np < 7744) return 7696 + (np - 7680);
    if (np < 7752) return 4096 + (np - 7744);
    if (np < 7760) return 4104 + (np - 7752);
    if (np < 7776) return np;
    return -1;
}
__device__ __forceinline__ void phase0(const Params& p, unsigned char* smem) {
    const int tid = threadIdx.x, wid = tid >> 6, lane = tid & 63;
    const int gw = blockIdx.x * 8 + wid, nw = gridDim.x * 8;
    h16* H = (h16*)(p.ws + OFF_H);
    for (int row = gw; row < BT; row += nw) {
        const f32x4* xr = (const f32x4*)(p.x + (size_t)row * DM);
        f32x4 v[8]; float ss = 0.f;
#pragma unroll
        for (int i = 0; i < 8; ++i) { v[i] = xr[lane + 64 * i]; ss += (v[i][0] * v[i][0] + v[i][1] * v[i][1]) + (v[i][2] * v[i][2] + v[i][3] * v[i][3]); }
        ss = wave_sum(ss);
        const float r = 1.0f / sqrtf(ss * (1.0f / DM) + EPS);
#pragma unroll
        for (int i = 0; i < 8; ++i) { const f32x4 g = ((const f32x4*)p.attn_g)[lane + 64 * i]; h16x4 o;
#pragma unroll
            for (int j = 0; j < 4; ++j) o[j] = (h16)(v[i][j] * r * g[j]);
            *(h16x4*)(H + (size_t)row * DM + 4 * (lane + 64 * i)) = o; }
    }
    float* tile = (float*)smem;
    h16* Wt = (h16*)(p.ws + OFF_WT);
    for (int tI = blockIdx.x; tI < 124 * 32; tI += gridDim.x) {
        const int n0 = (tI / 32) * 64, k0 = (tI % 32) * 64;
        __syncthreads();
        { const int nl = tid & 63; const int src = src_col(n0 + nl);
#pragma unroll
          for (int i = 0; i < 8; ++i) { const int kl = (tid >> 6) + 8 * i; tile[kl * 65 + nl] = src >= 0 ? p.w_in[(size_t)(k0 + kl) * IN_COLS + src] : 0.f; } }
        __syncthreads();
        { const int nl = tid >> 3, kc = tid & 7; h16x8 o;
#pragma unroll
          for (int j = 0; j < 8; ++j) o[j] = (h16)tile[(8 * kc + j) * 65 + nl];
          *(h16x8*)(Wt + (size_t)(n0 + nl) * 2048 + k0 + 8 * kc) = o; }
    }
    h16* WoT = (h16*)(p.ws + OFF_WOT);
    for (int tI = blockIdx.x; tI < 32 * 32; tI += gridDim.x) {
        const int n0 = (tI / 32) * 64, k0 = (tI % 32) * 64;
        __syncthreads();
        { const int nl = tid & 63;
#pragma unroll
          for (int i = 0; i < 8; ++i) { const int kl = (tid >> 6) + 8 * i; tile[kl * 65 + nl] = p.w_out[(size_t)(k0 + kl) * DM + n0 + nl]; } }
        __syncthreads();
        { const int nl = tid >> 3, kc = tid & 7; h16x8 o;
#pragma unroll
          for (int j = 0; j < 8; ++j) o[j] = (h16)tile[(8 * kc + j) * 65 + nl];
          *(h16x8*)(WoT + (size_t)(n0 + nl) * 2048 + k0 + 8 * kc) = o; }
    }
    __syncthreads();
    float* cosT = (float*)(p.ws + OFF_COS); float* sinT = (float*)(p.ws + OFF_SIN);
    for (int i = blockIdx.x * 512 + tid; i < BT * 24; i += gridDim.x * 512) {
        const int row = i / 24, j = i % 24;
        const float ex = (j < 16) ? (float)j * (2.0f / 32.0f) : (float)(j - 16) * (2.0f / 16.0f);
        const float inv = powf(500000.0f, -ex);
        const float ang = (float)p.pos[row] * inv;
        cosT[i] = cosf(ang); sinT[i] = sinf(ang);
    }
}

__device__ __forceinline__ void gdn_naive_task(const Params& p, unsigned char* smem, int task) {
    const int tid = threadIdx.x, wid = tid >> 6, lane = tid & 63;
    const int b = task >> 6, h = (task >> 3) & 7, eb = task & 7;
    float* stage = (float*)smem;
    const h16* qkvr = (const h16*)(p.ws + OFF_QKVR);
    const float* gb = (const float*)(p.ws + OFF_GB);
    float* oraw = (float*)(p.ws + OFF_ORAW);
    int ch = -1;
    if (tid < 128) ch = h * 128 + tid; else if (tid < 256) ch = 1024 + h * 128 + (tid - 128); else if (tid < 272) ch = 2048 + h * 128 + eb * 16 + (tid - 256);
    float w0 = 0.f, w1 = 0.f, w2 = 0.f, w3 = 0.f;
    if (ch >= 0) { w0 = p.conv_w[ch]; w1 = p.conv_w[3072 + ch]; w2 = p.conv_w[2 * 3072 + ch]; w3 = p.conv_w[3 * 3072 + ch]; }
    float x0 = 0.f, x1 = 0.f, x2 = 0.f;
    float S00 = 0.f, S01 = 0.f, S10 = 0.f, S11 = 0.f;
    const size_t rowbase = (size_t)b * NT;
    float xn = ch >= 0 ? (float)qkvr[rowbase * 3072 + ch] : 0.f;
    const int e0 = eb * 16 + 2 * wid;
    __syncthreads();
    for (int t = 0; t < NT; ++t) {
        const float x3 = xn;
        if (t + 1 < NT && ch >= 0) xn = (float)qkvr[(rowbase + t + 1) * 3072 + ch];
        float* st = stage + (t & 1) * 288;
        if (ch >= 0) { float y = w0 * x0 + w1 * x1 + w2 * x2 + w3 * x3; y = y / (1.0f + expf(-y)); st[tid] = y; x0 = x1; x1 = x2; x2 = x3; }
        const float g = gb[(rowbase + t) * 16 + h], beta = gb[(rowbase + t) * 16 + 8 + h];
        __syncthreads();
        float q0 = st[lane], q1 = st[lane + 64], k0 = st[128 + lane], k1 = st[192 + lane];
        const float ssq = wave_sum(q0 * q0 + q1 * q1), ssk = wave_sum(k0 * k0 + k1 * k1);
        const float rq = 0.08838834764831845f / sqrtf(ssq + EPS), rk = 1.0f / sqrtf(ssk + EPS);
        q0 *= rq; q1 *= rq; k0 *= rk; k1 *= rk;
        const float eg = expf(g);
        const float v0 = st[256 + 2 * wid], v1 = st[256 + 2 * wid + 1];
        S00 *= eg; S01 *= eg; S10 *= eg; S11 *= eg;
        const float r0 = wave_sum(k0 * S00 + k1 * S01), r1 = wave_sum(k0 * S10 + k1 * S11);
        const float vn0 = beta * (v0 - r0), vn1 = beta * (v1 - r1);
        S00 += k0 * vn0; S01 += k1 * vn0; S10 += k0 * vn1; S11 += k1 * vn1;
        const float o0 = wave_sum(q0 * S00 + q1 * S01), o1 = wave_sum(q0 * S10 + q1 * S11);
        if (lane == 0) { float* op = oraw + (rowbase + t) * 1024 + h * 128 + e0; op[0] = o0; op[1] = o1; }
    }
}

__device__ __forceinline__ unsigned f2key(float x) { const unsigned u = __float_as_uint(x); return (u & 0x80000000u) ? ~u : (u | 0x80000000u); }
__device__ __forceinline__ void idx_task(const Params& p, unsigned char* smem, int bt) {
    const int tid = threadIdx.x, wid = tid >> 6, lane = tid & 63;
    const int b = bt / NT, t = bt % NT, n = t + 1;
    unsigned short* sel = (unsigned short*)(p.ws + OFF_SEL) + (size_t)bt * 256;
    if (n <= 256) { if (tid < 256) sel[tid] = (unsigned short)(tid < n ? tid : 0); return; }
    float* qs = (float*)smem; float* wsm = qs + 1024; unsigned* keys = (unsigned*)(smem + 8192); unsigned* hist = keys + 4096; unsigned* misc = hist + 256;
    __syncthreads();
    { const h16* iq = (const h16*)(p.ws + OFF_IQ) + (size_t)bt * 1024; const h16x2 v = *(const h16x2*)(iq + 2 * tid); qs[2 * tid] = (float)v[0]; qs[2 * tid + 1] = (float)v[1];
      if (tid < 16) wsm[tid] = ((const float*)(p.ws + OFF_IW))[(size_t)bt * 16 + tid]; }
    __syncthreads();
    const h16* ik = (const h16*)(p.ws + OFF_IK) + (size_t)b * NT * 64;
    for (int s = tid; s < n; s += 512) {
        float kf[64];
#pragma unroll
        for (int i = 0; i < 8; ++i) { const h16x8 v = *(const h16x8*)(ik + (size_t)s * 64 + 8 * i);
#pragma unroll
            for (int j = 0; j < 8; ++j) kf[8 * i + j] = (float)v[j]; }
        float sc = 0.f;
#pragma unroll 1
        for (int hh = 0; hh < 16; ++hh) { float d = 0.f;
#pragma unroll
            for (int dd = 0; dd < 64; ++dd) d += qs[hh * 64 + dd] * kf[dd];
            sc += wsm[hh] * fmaxf(d, 0.f); }
        keys[s] = f2key(sc);
    }
    __syncthreads();
    unsigned prefix = 0, need = 256;
    for (int pass = 0; pass < 4; ++pass) {
        const int shift = 24 - 8 * pass;
        if (tid < 256) hist[tid] = 0;
        __syncthreads();
        for (int i = tid; i < n; i += 512) { const unsigned u = keys[i]; const bool part = (pass == 0) || ((u >> (shift + 8)) == (prefix >> (shift + 8))); if (part) atomicAdd(&hist[(u >> shift) & 255u], 1u); }
        __syncthreads();
        if (wid == 0) {
            const unsigned c0 = hist[4 * lane], c1 = hist[4 * lane + 1], c2 = hist[4 * lane + 2], c3 = hist[4 * lane + 3]; const unsigned s = c0 + c1 + c2 + c3;
            unsigned suf = s;
#pragma unroll
            for (int off = 1; off < 64; off <<= 1) { const unsigned tt = __shfl_down(suf, off); if (lane + off < 64) suf += tt; }
            const unsigned above = suf - s;
            if (above < need && need <= suf) {
                unsigned cum = above; int bin;
                if (cum + c3 >= need) bin = 3; else { cum += c3; if (cum + c2 >= need) bin = 2; else { cum += c2; if (cum + c1 >= need) bin = 1; else { cum += c1; bin = 0; } } }
                misc[0] = prefix | ((unsigned)(4 * lane + bin) << shift); misc[1] = need - cum;
            }
        }
        __syncthreads();
        prefix = misc[0]; need = misc[1];
    }
    const unsigned Kt = prefix, r = need;
    unsigned kk[8]; unsigned cgt = 0, ceq = 0;
#pragma unroll
    for (int j = 0; j < 8; ++j) { const int i = 8 * tid + j; const unsigned u = (i < n) ? keys[i] : 0u; kk[j] = u; if (i < n) { cgt += (u > Kt) ? 1u : 0u; ceq += (u == Kt) ? 1u : 0u; } }
    const unsigned packed = cgt | (ceq << 16);
    unsigned inc = packed;
#pragma unroll
    for (int off = 1; off < 64; off <<= 1) { const unsigned tt = __shfl_up(inc, off); if (lane >= off) inc += tt; }
    if (lane == 63) misc[8 + wid] = inc;
    __syncthreads();
    unsigned basev = 0;
    for (int w = 0; w < wid; ++w) basev += misc[8 + w];
    const unsigned exc = basev + inc - packed;
    unsigned eq_before = exc >> 16; unsigned pos = (exc & 0xFFFFu) + (eq_before < r ? eq_before : r);
#pragma unroll
    for (int j = 0; j < 8; ++j) { const int i = 8 * tid + j; if (i < n) { const unsigned u = kk[j]; const bool s = (u > Kt) || (u == Kt && eq_before < r); if (u == Kt) ++eq_before; if (s) { sel[pos] = (unsigned short)i; ++pos; } } }
}

__device__ __forceinline__ void gdn_post(const Params& p) {
    const int tid = threadIdx.x, wid = tid >> 6, lane = tid & 63;
    const int gw = blockIdx.x * 8 + wid, nw = gridDim.x * 8;
    const float* oraw = (const float*)(p.ws + OFF_ORAW); const h16* gz = (const h16*)(p.ws + OFF_GZ); h16* omix = (h16*)(p.ws + OFF_OMIX);
    const float g0 = p.gdn_norm_g[lane], g1 = p.gdn_norm_g[lane + 64];
    for (int it = gw; it < BT * 8; it += nw) {
        const int bt = it >> 3, h = it & 7;
        const float a = oraw[(size_t)bt * 1024 + h * 128 + lane], c = oraw[(size_t)bt * 1024 + h * 128 + 64 + lane];
        const float ss = wave_sum(a * a + c * c);
        const float r = 1.0f / sqrtf(ss * (1.0f / 128.0f) + EPS);
        omix[(size_t)bt * 2048 + h * 128 + lane] = (h16)(a * r * g0 * (float)gz[(size_t)bt * 1024 + h * 128 + lane]);
        omix[(size_t)bt * 2048 + h * 128 + 64 + lane] = (h16)(c * r * g1 * (float)gz[(size_t)bt * 1024 + h * 128 + 64 + lane]);
    }
}

__device__ __forceinline__ void attn_naive_task(const Params& p, unsigned char* smem, int bt) {
    const int tid = threadIdx.x, wid = tid >> 6, lane = tid & 63;
    const int b = bt / NT, t = bt % NT; const int nvalid = (t + 1) < 256 ? (t + 1) : 256;
    float* qs = (float*)smem; float* lg = qs + 1024; unsigned short* sl = (unsigned short*)(lg + 2048);
    const h16* aq = (const h16*)(p.ws + OFF_AQ); const h16* ak = (const h16*)(p.ws + OFF_AK); const h16* av = (const h16*)(p.ws + OFF_AV);
    const h16* az = (const h16*)(p.ws + OFF_AZ); h16* omix = (h16*)(p.ws + OFF_OMIX);
    __syncthreads();
    { const h16x2 v = *(const h16x2*)(aq + (size_t)bt * 1024 + 2 * tid); qs[2 * tid] = (float)v[0]; qs[2 * tid + 1] = (float)v[1];
      if (tid < 256) sl[tid] = ((const unsigned short*)(p.ws + OFF_SEL))[(size_t)bt * 256 + tid]; }
    __syncthreads();
    { const int kk = tid & 255, g = tid >> 8; const int key = sl[kk];
      const h16* kr = ak + ((size_t)b * NT + key) * 256 + g * 128;
      float d0 = 0.f, d1 = 0.f, d2 = 0.f, d3 = 0.f; const float* q = qs + (4 * g) * 128;
#pragma unroll 4
      for (int i = 0; i < 16; ++i) { const h16x8 v = *(const h16x8*)(kr + 8 * i);
#pragma unroll
          for (int j = 0; j < 8; ++j) { const float kv = (float)v[j]; d0 += q[8 * i + j] * kv; d1 += q[128 + 8 * i + j] * kv; d2 += q[256 + 8 * i + j] * kv; d3 += q[384 + 8 * i + j] * kv; } }
      const bool valid = kk < nvalid;
      lg[(4 * g + 0) * 256 + kk] = valid ? d0 : -INFINITY; lg[(4 * g + 1) * 256 + kk] = valid ? d1 : -INFINITY;
      lg[(4 * g + 2) * 256 + kk] = valid ? d2 : -INFINITY; lg[(4 * g + 3) * 256 + kk] = valid ? d3 : -INFINITY; }
    __syncthreads();
    { float* L = lg + wid * 256; const float a0 = L[lane], a1 = L[lane + 64], a2 = L[lane + 128], a3 = L[lane + 192];
      const float m = wave_max(fmaxf(fmaxf(a0, a1), fmaxf(a2, a3)));
      const float e0 = expf(a0 - m), e1 = expf(a1 - m), e2 = expf(a2 - m), e3 = expf(a3 - m);
      const float inv = 1.0f / wave_sum((e0 + e1) + (e2 + e3));
      L[lane] = e0 * inv; L[lane + 64] = e1 * inv; L[lane + 128] = e2 * inv; L[lane + 192] = e3 * inv; }
    __syncthreads();
    { const int h = wid, g = h >> 2; float o0 = 0.f, o1 = 0.f; const float* P = lg + h * 256;
      for (int kk = 0; kk < nvalid; ++kk) { const int key = sl[kk]; const h16x2 v = *(const h16x2*)(av + ((size_t)b * NT + key) * 256 + g * 128 + 2 * lane); const float pk = P[kk]; o0 += pk * (float)v[0]; o1 += pk * (float)v[1]; }
      const h16x2 gt = *(const h16x2*)(az + (size_t)bt * 1024 + h * 128 + 2 * lane);
      h16x2 o; o[0] = (h16)(o0 * (float)gt[0]); o[1] = (h16)(o1 * (float)gt[1]);
      *(h16x2*)(omix + (size_t)bt * 2048 + 1024 + h * 128 + 2 * lane) = o; }
}

__device__ __forceinline__ void phase5(const Params& p) {
    const int tid = threadIdx.x, wid = tid >> 6, lane = tid & 63;
    const int gw = blockIdx.x * 8 + wid, nw = gridDim.x * 8;
    const float* rowss = (const float*)(p.ws + OFF_ROWSS);
    for (int row = gw; row < BT; row += nw) {
        const float r = 1.0f / sqrtf(rowss[row] * (1.0f / DM) + EPS);
        f32x4* o = (f32x4*)(p.out + (size_t)row * DM);
#pragma unroll
        for (int i = 0; i < 8; ++i) { const f32x4 g = ((const f32x4*)p.final_g)[lane + 64 * i]; f32x4 v = o[lane + 64 * i]; v = v * r * g; o[lane + 64 * i] = v; }
    }
}

template <int LO, int HI>
__global__ void __launch_bounds__(512, 2) k_phases(Params p) {
    extern __shared__ __attribute__((aligned(16))) unsigned char smem[];
#define IN(k) (LO <= (k) && (k) < HI)
#define SEAM(k) do { if constexpr (IN(k) && IN((k) + 1)) { cg::this_grid().sync(); } } while (0)
    if constexpr (IN(0)) { phase0(p, smem); }
    SEAM(0);
    if constexpr (IN(1)) {
        pg8::Gemm g{(const h16*)(p.ws + OFF_H), (const h16*)(p.ws + OFF_WT), BT, NPAD, DM};
        pg8::StaticOrder S; S.init(BT, NPAD, gridDim.x, blockIdx.x);
        EpiIn E{p.ws, p.a_log, p.dt_bias};
        pg8::gemm_phase<EpiIn, pg8::StaticOrder>((LAS unsigned char*)smem, g, S, E);
    }
    SEAM(1);
    if constexpr (IN(2)) {
        for (int task = blockIdx.x; task < 256; task += gridDim.x) gdn_naive_task(p, smem, task);
        __syncthreads();
        for (int bt = blockIdx.x; bt < BT; bt += gridDim.x) idx_task(p, smem, bt);
    }
    SEAM(2);
    if constexpr (IN(3)) {
        gdn_post(p);
        for (int bt = blockIdx.x; bt < BT; bt += gridDim.x) attn_naive_task(p, smem, bt);
    }
    SEAM(3);
    if constexpr (IN(4)) {
        pg8::Gemm g{(const h16*)(p.ws + OFF_OMIX), (const h16*)(p.ws + OFF_WOT), BT, DM, DM};
        pg8::StaticOrder S; S.init(BT, DM, gridDim.x, blockIdx.x);
        EpiOut E{p.x, p.out, (float*)(p.ws + OFF_ROWSS)};
        pg8::gemm_phase<EpiOut, pg8::StaticOrder>((LAS unsigned char*)smem, g, S, E);
    }
    SEAM(4);
    if constexpr (IN(5)) { phase5(p); }
#undef IN
#undef SEAM
}

template <int LO, int HI> static void launch_range(const Params& p, int grid, hipStream_t stream, bool coop) {
    static bool attr = false;
    if (!attr) { hipFuncSetAttribute((const void*)k_phases<LO, HI>, hipFuncAttributeMaxDynamicSharedMemorySize, LDS_BYTES); attr = true; }
    if (coop) {
        Params pp = p; void* args[] = {&pp};
        hipError_t e = hipLaunchCooperativeKernel((const void*)k_phases<LO, HI>, dim3(grid), dim3(512), args, LDS_BYTES, stream);
        if (e != hipSuccess) fprintf(stderr, "cooperative launch failed: %s (grid %d)\n", hipGetErrorString(e), grid);
    } else {
        hipLaunchKernelGGL((k_phases<LO, HI>), dim3(grid), dim3(512), LDS_BYTES, stream, p);
    }
}

extern "C" void kernel_launch(void* const* d_in, const int* in_sizes, int n_in, void* d_out, int out_size, void* d_ws, size_t ws_size, hipStream_t stream) {
    if (n_in != 10 || in_sizes[0] != BT * DM || out_size != BT * DM || ws_size < WS_END) {
        fprintf(stderr, "kernel_launch: unexpected shapes (n_in %d in0 %d out %d ws %zu need %zu)\n", n_in, n_in > 0 ? in_sizes[0] : -1, out_size, ws_size, (size_t)WS_END); return; }
    static int grid = 0;
    if (!grid) {
        int dev = 0, cus = 0, per_cu = 0; hipGetDevice(&dev); hipDeviceGetAttribute(&cus, hipDeviceAttributeMultiprocessorCount, dev);
#if FUSED
        hipFuncSetAttribute((const void*)k_phases<0, 6>, hipFuncAttributeMaxDynamicSharedMemorySize, LDS_BYTES);
        hipOccupancyMaxActiveBlocksPerMultiprocessor(&per_cu, (const void*)k_phases<0, 6>, 512, LDS_BYTES);
#else
        per_cu = 1;
#endif
        if (per_cu < 1) per_cu = 1; if (per_cu > 1) per_cu = 1;
        grid = cus * per_cu;
    }
    Params p{};
    p.x = (const float*)d_in[0]; p.pos = (const int*)d_in[1]; p.attn_g = (const float*)d_in[2]; p.w_in = (const float*)d_in[3]; p.conv_w = (const float*)d_in[4];
    p.a_log = (const float*)d_in[5]; p.dt_bias = (const float*)d_in[6]; p.gdn_norm_g = (const float*)d_in[7]; p.w_out = (const float*)d_in[8]; p.final_g = (const float*)d_in[9];
    p.out = (float*)d_out; p.ws = (unsigned char*)d_ws;
    hipMemsetAsync((char*)d_ws + OFF_CTRL, 0, CTL_ZERO_BYTES, stream);
#if FUSED
    launch_range<0, 6>(p, grid, stream, true);
#else
    launch_range<0, 1>(p, grid, stream, false);
    launch_range<1, 2>(p, grid, stream, false);
    launch_range<2, 3>(p, grid, stream, false);
    launch_range<3, 4>(p, grid, stream, false);
    launch_range<4, 5>(p, grid, stream, false);
    launch_range<5, 6>(p, grid, stream, false);
#endif
}
```

```cpp
#include <hip/hip_runtime.h>
#include <hip/hip_cooperative_groups.h>
#include <cstdio>
#include <cstdint>
namespace cg = cooperative_groups;

#ifndef FUSED
#define FUSED 1
#endif

#define LAS __attribute__((address_space(3)))
typedef _Float16 h16;
typedef h16 h16x8 __attribute__((ext_vector_type(8)));
typedef h16 h16x4 __attribute__((ext_vector_type(4)));
typedef h16 h16x2 __attribute__((ext_vector_type(2)));
typedef float f32x4 __attribute__((ext_vector_type(4)));
typedef float f32x2 __attribute__((ext_vector_type(2)));
typedef unsigned u32x4 __attribute__((ext_vector_type(4)));

constexpr int NB = 4, NT = 4096, DM = 2048, BT = NB * NT;
constexpr int IN_COLS = 7776, NPAD = 7936;
constexpr float EPS = 1e-6f;
constexpr int LDS_BYTES = 131072 + 8192;

constexpr size_t MB = 1024 * 1024;
constexpr size_t OFF_CTRL = 0;
constexpr size_t OFF_ROWSS = 65536;
constexpr size_t CTL_ZERO_BYTES = 65536 + (size_t)BT * 4;
constexpr size_t OFF_H = 1 * MB;
constexpr size_t OFF_OMIX = OFF_H;
constexpr size_t OFF_WT = OFF_H + 64 * MB;
constexpr size_t OFF_WOT = OFF_WT + (size_t)NPAD * 2048 * 2;
constexpr size_t OFF_QKVR = OFF_WOT + 8 * MB;
constexpr size_t OFF_GZ = OFF_QKVR + (size_t)BT * 3072 * 2;
constexpr size_t OFF_AQ = OFF_GZ + 32 * MB;
constexpr size_t OFF_AK = OFF_AQ + 32 * MB;
constexpr size_t OFF_AV = OFF_AK + 8 * MB;
constexpr size_t OFF_AZ = OFF_AV + 8 * MB;
constexpr size_t OFF_IQ = OFF_AZ + 32 * MB;
constexpr size_t OFF_IK = OFF_IQ + 32 * MB;
constexpr size_t OFF_GB = OFF_IK + 2 * MB;
constexpr size_t OFF_IW = OFF_GB + 1 * MB;
constexpr size_t OFF_COS = OFF_IW + 1 * MB;
constexpr size_t OFF_SIN = OFF_COS + 2 * MB;
constexpr size_t OFF_SEL = OFF_SIN + 2 * MB;
constexpr size_t OFF_ORAW = OFF_SEL + 8 * MB;
constexpr size_t WS_END = OFF_ORAW + 64 * MB;

struct Params {
    const float* x; const int* pos; const float* attn_g; const float* w_in; const float* conv_w; const float* a_log;
    const float* dt_bias; const float* gdn_norm_g; const float* w_out; const float* final_g; float* out; unsigned char* ws;
};

__device__ __forceinline__ float wave_sum(float v) {
#pragma unroll
    for (int o = 1; o < 64; o <<= 1) v += __shfl_xor(v, o);
    return v;
}
__device__ __forceinline__ float wave_max(float v) {
#pragma unroll
    for (int o = 1; o < 64; o <<= 1) v = fmaxf(v, __shfl_xor(v, o));
    return v;
}
__device__ __forceinline__ float silu_f(float x) { return x / (1.0f + __expf(-x)); }

namespace pg8 {
constexpr int BM = 256, BK = 64, HALF = 128, HTB = HALF * BK * 2, STAGE_BYTES = 8 * HTB, NXCD = 8, WGM = 8;
__host__ __device__ __forceinline__ int lds_byte(int r, int c) { const int st = (r >> 4) * 2 + (c >> 5), rr = r & 15, cc = c & 31, ob = rr * 64 + cc * 2; return st * 1024 + (ob ^ (((ob >> 9) & 1) << 5)); }
__host__ __device__ __forceinline__ void stage_rc(int b, int& R, int& C) { const int st = b / 1024, sb = b % 1024, swz = sb ^ (((sb >> 9) & 1) << 5); R = (st >> 1) * 16 + swz / 64; C = (st & 1) * 32 + (swz % 64) / 2; }
__host__ __device__ __forceinline__ int perm32(int rho) { const int n = rho >> 4, i = rho & 15; return 8 * (i >> 2) + 4 * n + (i & 3); }
struct Unit { int pm, pn; };
struct Gemm { const h16* A; const h16* Bt; int M, N, K; };
struct StaticOrder {
    int nM, nN, nwg, G, c;
    __host__ __device__ void init(int M, int N, int G_, int c_) { nM = M / BM; nN = N / BM; nwg = nM * nN; G = G_; c = c_; }
    __host__ __device__ bool next(int i, Unit& u) const {
        const long L = (long)i * G + c; if (L >= nwg) return false;
        int wgid = (int)L; { const int q = nwg / NXCD, r = nwg % NXCD, xcd = wgid % NXCD, off = wgid / NXCD; wgid = (xcd < r ? xcd * (q + 1) : r * (q + 1) + (xcd - r) * q) + off; }
        const int nig = WGM * nN, gid = wgid / nig, fm = gid * WGM, gsz = (nM - fm) < WGM ? (nM - fm) : WGM;
        u.pm = fm + ((wgid % nig) % gsz); u.pn = (wgid % nig) / gsz; return true;
    }
    __device__ __forceinline__ void a_ready(const Unit&) const {}
    __device__ __forceinline__ void done(const Unit&) const {}
};

template <class Epi, class Sched>
__device__ __forceinline__ void gemm_phase(LAS unsigned char* lds, const Gemm g, const Sched& S, const Epi& E) {
    const int tid = threadIdx.x, wid = __builtin_amdgcn_readfirstlane(tid >> 6), lane = tid & 63, wr = wid >> 2, wc = wid & 3, fr = lane & 15, fq = lane >> 4;
    const int K = g.K, nt = K / BK;
    unsigned voffA[2], voffB[2];
#pragma unroll
    for (int i = 0; i < 2; ++i) { int R, C; stage_rc(tid * 16 + i * 8192, R, C); const int Rb = Epi::PERM ? ((R & ~31) + perm32(R & 31)) : R;
        voffA[i] = (unsigned)(R * K + C) * 2u; voffB[i] = (unsigned)(Rb * K + C) * 2u; }
    const size_t kstep = (size_t)(BK * 2);
    const size_t hstep = (size_t)HALF * K * 2;
    const size_t tstep = 2 * hstep;
    const unsigned ldsw = (unsigned)wid * 1024u;
    const int aoff = lds_byte(wr * 64 + fr, fq * 8), boff = lds_byte(wc * 32 + fr, fq * 8);
#define PG8_SA(b, h) (((b) * 2 + (h)) * HTB)
#define PG8_SB(b, h) ((4 + (b) * 2 + (h)) * HTB)
#define PG8_STAGE(bufoff, gbase, voff) do { _Pragma("unroll") for (int _i = 0; _i < 2; ++_i) \
        __builtin_amdgcn_global_load_lds((const unsigned*)((const char*)(gbase) + (voff)[_i]), (LAS unsigned*)(lds + (bufoff) + ldsw + _i * 8192), 16, 0, 0); } while (0)
#define PG8_LDA(dst, b, h) do { _Pragma("unroll") for (int m = 0; m < 4; ++m) _Pragma("unroll") for (int k = 0; k < 2; ++k) dst[m][k] = *(const LAS h16x8*)(lds + PG8_SA(b, h) + aoff + m * 2048 + k * 1024); } while (0)
#define PG8_LDB(dst, b, h) do { _Pragma("unroll") for (int n = 0; n < 2; ++n) _Pragma("unroll") for (int k = 0; k < 2; ++k) dst[n][k] = *(const LAS h16x8*)(lds + PG8_SB(b, h) + boff + n * 2048 + k * 1024); } while (0)
#define PG8_MMA(ai, bj, At, Bt) do { __builtin_amdgcn_s_setprio(1); _Pragma("unroll") for (int m = 0; m < 4; ++m) _Pragma("unroll") for (int n = 0; n < 2; ++n) _Pragma("unroll") for (int k = 0; k < 2; ++k) \
        acc[ai][bj][m][n] = __builtin_amdgcn_mfma_f32_16x16x32_f16(Bt[n][k], At[m][k], acc[ai][bj][m][n], 0, 0, 0); __builtin_amdgcn_s_setprio(0); } while (0)
#define PG8_WAIT_V(n) asm volatile("s_waitcnt vmcnt(" #n ")" ::: "memory")
#define PG8_WAIT_L(n) asm volatile("s_waitcnt lgkmcnt(" #n ")" ::: "memory")
#define PG8_BAR __builtin_amdgcn_s_barrier()
#define PG8_SCHED __builtin_amdgcn_sched_barrier(0)
    Unit cur, nxt; int ui = 0;
    if (!S.next(0, cur)) return;
    f32x4 acc[2][2][4][2];
#pragma unroll
    for (int a = 0; a < 2; ++a)
#pragma unroll
        for (int b = 0; b < 2; ++b)
#pragma unroll
            for (int m = 0; m < 4; ++m)
#pragma unroll
                for (int n = 0; n < 2; ++n) acc[a][b][m][n] = (f32x4){0.f, 0.f, 0.f, 0.f};
    h16x8 At[4][2], B0[2][2], B1[2][2];
    const char* cA = (const char*)g.A + (size_t)cur.pm * tstep; const char* cB = (const char*)g.Bt + (size_t)cur.pn * tstep;
    S.a_ready(cur);
    PG8_STAGE(PG8_SB(0, 0), cB, voffB); PG8_STAGE(PG8_SA(0, 0), cA, voffA); PG8_STAGE(PG8_SB(0, 1), cB + hstep, voffB); PG8_STAGE(PG8_SA(0, 1), cA + hstep, voffA);
    if (wr == 1) PG8_BAR;
    PG8_WAIT_V(4); PG8_BAR;
    PG8_STAGE(PG8_SB(1, 0), cB + kstep, voffB); PG8_STAGE(PG8_SA(1, 0), cA + kstep, voffA); PG8_STAGE(PG8_SB(1, 1), cB + hstep + kstep, voffB);
    PG8_WAIT_V(6); PG8_BAR;
    for (;;) {
        const bool has_next = S.next(ui + 1, nxt);
        const char* nA = has_next ? (const char*)g.A + (size_t)nxt.pm * tstep : cA; const char* nB = has_next ? (const char*)g.Bt + (size_t)nxt.pn * tstep : cB;
        for (int t = 0; t < nt; t += 2) {
            const bool last = (t == nt - 2);
            const char* a1 = cA + (size_t)(t + 1) * kstep;
            const char* a2 = last ? nA : cA + (size_t)(t + 2) * kstep; const char* b2 = last ? nB : cB + (size_t)(t + 2) * kstep;
            const char* a3 = a2 + kstep; const char* b3 = b2 + kstep;
            if (last && has_next) S.a_ready(nxt);
            PG8_LDB(B0, 0, 0); PG8_SCHED; PG8_LDA(At, 0, 0); PG8_STAGE(PG8_SA(1, 1), a1 + hstep, voffA);
            PG8_WAIT_L(8); PG8_BAR; PG8_WAIT_L(0); PG8_MMA(0, 0, At, B0); PG8_BAR; PG8_SCHED;
            PG8_LDB(B1, 0, 1); PG8_STAGE(PG8_SB(0, 0), b2, voffB);
            PG8_BAR; PG8_WAIT_L(0); PG8_MMA(0, 1, At, B1); PG8_BAR;
            PG8_LDA(At, 0, 1); PG8_STAGE(PG8_SA(0, 0), a2, voffA);
            PG8_BAR; PG8_WAIT_L(0); PG8_MMA(1, 0, At, B0); PG8_BAR; PG8_SCHED;
            PG8_STAGE(PG8_SB(0, 1), b2 + hstep, voffB);
            PG8_WAIT_V(6); PG8_BAR; PG8_MMA(1, 1, At, B1); PG8_BAR;
            PG8_LDB(B0, 1, 0); PG8_SCHED; PG8_LDA(At, 1, 0); PG8_STAGE(PG8_SA(0, 1), a2 + hstep, voffA);
            PG8_WAIT_L(8); PG8_BAR; PG8_WAIT_L(0); PG8_MMA(0, 0, At, B0); PG8_BAR; PG8_SCHED;
            PG8_LDB(B1, 1, 1); PG8_STAGE(PG8_SB(1, 0), b3, voffB);
            PG8_BAR; PG8_WAIT_L(0); PG8_MMA(0, 1, At, B1); PG8_BAR;
            PG8_LDA(At, 1, 1); PG8_STAGE(PG8_SA(1, 0), a3, voffA);
            PG8_BAR; PG8_WAIT_L(0); PG8_MMA(1, 0, At, B0); PG8_BAR; PG8_SCHED;
            PG8_STAGE(PG8_SB(1, 1), b3 + hstep, voffB);
            PG8_WAIT_V(6); PG8_BAR; PG8_MMA(1, 1, At, B1); PG8_BAR;
        }
        E(acc, cur, wr, wc, fr, fq); S.done(cur);
        if (!has_next) break;
#pragma unroll
        for (int a = 0; a < 2; ++a)
#pragma unroll
            for (int b = 0; b < 2; ++b)
#pragma unroll
                for (int m = 0; m < 4; ++m)
#pragma unroll
                    for (int n = 0; n < 2; ++n) acc[a][b][m][n] = (f32x4){0.f, 0.f, 0.f, 0.f};
        cur = nxt; cA = nA; cB = nB; ++ui;
    }
    PG8_WAIT_V(0);
    if (wr == 0) PG8_BAR;
    PG8_BAR;
#undef PG8_SA
#undef PG8_SB
#undef PG8_STAGE
#undef PG8_LDA
#undef PG8_LDB
#undef PG8_MMA
#undef PG8_WAIT_V
#undef PG8_WAIT_L
#undef PG8_BAR
#undef PG8_SCHED
}
}

struct EpiIn {
    static constexpr bool PERM = true;
    unsigned char* ws; const float* a_log; const float* dt_bias;
    __device__ __forceinline__ void operator()(const f32x4 (&acc)[2][2][4][2], const pg8::Unit& u, int wr, int wc, int fr, int fq) const {
        const int pn = u.pn;
        const int rowb = u.pm * 256 + wr * 64 + fr;
        const int cw = wc * 32 + 8 * fq;
        const float* cosT = (const float*)(ws + OFF_COS); const float* sinT = (const float*)(ws + OFF_SIN);
        if (pn < 30) {
            h16* base; int ldc, colt, mode; float scale = 1.f;
            if (pn < 12) { base = (h16*)(ws + OFF_QKVR); ldc = 3072; colt = pn * 256; mode = 0; }
            else if (pn < 16) { base = (h16*)(ws + OFF_GZ); ldc = 1024; colt = (pn - 12) * 256; mode = 1; }
            else if (pn < 20) { base = (h16*)(ws + OFF_AQ); ldc = 1024; colt = (pn - 16) * 256; mode = 2; scale = 0.08838834764831845f; }
            else if (pn == 20) { base = (h16*)(ws + OFF_AK); ldc = 256; colt = 0; mode = 2; }
            else if (pn == 21) { base = (h16*)(ws + OFF_AV); ldc = 256; colt = 0; mode = 0; }
            else if (pn < 26) { base = (h16*)(ws + OFF_AZ); ldc = 1024; colt = (pn - 22) * 256; mode = 1; }
            else { base = (h16*)(ws + OFF_IQ); ldc = 1024; colt = (pn - 26) * 256; mode = 3; }
            const bool rot_wave = (mode == 2 && wc == 0) || (mode == 3 && (wc & 1) == 0);
            const int xm = (mode == 2) ? 32 : 16;
            const bool rot_lane = (mode == 2) ? true : (fq < 2);
            const float sgn = (mode == 2) ? (fq < 2 ? -1.f : 1.f) : (fq == 0 ? -1.f : 1.f);
            const int tix = (mode == 2) ? 8 * (fq & 1) : 16;
#pragma unroll
            for (int ai = 0; ai < 2; ++ai)
#pragma unroll
                for (int m = 0; m < 4; ++m) {
                    const int row = rowb + ai * 128 + m * 16;
                    float cs[8], sn[8];
                    if (rot_wave) {
                        const f32x4 c0 = *(const f32x4*)(cosT + (size_t)row * 24 + tix), c1 = *(const f32x4*)(cosT + (size_t)row * 24 + tix + 4);
                        const f32x4 s0 = *(const f32x4*)(sinT + (size_t)row * 24 + tix), s1 = *(const f32x4*)(sinT + (size_t)row * 24 + tix + 4);
#pragma unroll
                        for (int j = 0; j < 4; ++j) { cs[j] = c0[j]; cs[4 + j] = c1[j]; sn[j] = s0[j]; sn[4 + j] = s1[j]; }
                    }
#pragma unroll
                    for (int bj = 0; bj < 2; ++bj) {
                        float v[8];
#pragma unroll
                        for (int j = 0; j < 4; ++j) { v[j] = acc[ai][bj][m][0][j]; v[4 + j] = acc[ai][bj][m][1][j]; }
                        if (rot_wave) {
#pragma unroll
                            for (int j = 0; j < 8; ++j) { const float pv = __shfl_xor(v[j], xm); if (rot_lane) v[j] = v[j] * cs[j] + sgn * pv * sn[j]; }
                        }
                        if (mode == 1) {
#pragma unroll
                            for (int j = 0; j < 8; ++j) v[j] = silu_f(v[j]);
                        }
                        h16x8 o;
#pragma unroll
                        for (int j = 0; j < 8; ++j) o[j] = (h16)(v[j] * scale);
                        *(h16x8*)(base + (size_t)row * ldc + colt + bj * 128 + cw) = o;
                    }
                }
        } else {
            h16* ik = (h16*)(ws + OFF_IK); float* gb = (float*)(ws + OFF_GB); float* iw = (float*)(ws + OFF_IW);
#pragma unroll
            for (int ai = 0; ai < 2; ++ai)
#pragma unroll
                for (int m = 0; m < 4; ++m) {
                    const int row = rowb + ai * 128 + m * 16;
                    float v[8];
#pragma unroll
                    for (int j = 0; j < 4; ++j) { v[j] = acc[ai][0][m][0][j]; v[4 + j] = acc[ai][0][m][1][j]; }
                    if (wc == 0) {
                        const f32x4 c0 = *(const f32x4*)(cosT + (size_t)row * 24 + 16), c1 = *(const f32x4*)(cosT + (size_t)row * 24 + 20);
                        const f32x4 s0 = *(const f32x4*)(sinT + (size_t)row * 24 + 16), s1 = *(const f32x4*)(sinT + (size_t)row * 24 + 20);
                        const float sgn = (fq == 0 ? -1.f : 1.f);
#pragma unroll
                        for (int j = 0; j < 8; ++j) { const float pv = __shfl_xor(v[j], 16); const float c = j < 4 ? c0[j & 3] : c1[j & 3], s = j < 4 ? s0[j & 3] : s1[j & 3];
                            if (fq < 2) v[j] = v[j] * c + sgn * pv * s; }
                    }
                    if (wc < 2) {
                        h16x8 o;
#pragma unroll
                        for (int j = 0; j < 8; ++j) o[j] = (h16)v[j];
                        *(h16x8*)(ik + (size_t)row * 64 + cw) = o;
                    } else if (wc == 2) {
                        if (fq == 0) {
#pragma unroll
                            for (int j = 0; j < 8; ++j) { const float z = v[j] + dt_bias[j]; const float sp = z > 20.f ? z : log1pf(expf(z)); gb[(size_t)row * 16 + j] = -expf(a_log[j]) * sp; }
                        } else if (fq == 1) {
#pragma unroll
                            for (int j = 0; j < 8; ++j) gb[(size_t)row * 16 + 8 + j] = 1.0f / (1.0f + expf(-v[j]));
                        } else {
#pragma unroll
                            for (int j = 0; j < 8; ++j) iw[(size_t)row * 16 + 8 * (fq - 2) + j] = v[j] * 0.03125f;
                        }
                    }
                }
        }
    }
};

struct EpiOut {
    static constexpr bool PERM = false;
    const float* x; float* out; float* rowss;
    __device__ __forceinline__ void operator()(const f32x4 (&acc)[2][2][4][2], const pg8::Unit& u, int wr, int wc, int fr, int fq) const {
        const int rowb = u.pm * 256 + wr * 64 + fr, col0 = u.pn * 256 + wc * 32 + 4 * fq;
#pragma unroll
        for (int ai = 0; ai < 2; ++ai)
#pragma unroll
            for (int m = 0; m < 4; ++m) {
                const int row = rowb + ai * 128 + m * 16; float ss = 0.f;
#pragma unroll
                for (int bj = 0; bj < 2; ++bj)
#pragma unroll
                    for (int n = 0; n < 2; ++n) {
                        const size_t off = (size_t)row * DM + col0 + bj * 128 + n * 16;
                        const f32x4 y = *(const f32x4*)(x + off) + acc[ai][bj][m][n];
                        *(f32x4*)(out + off) = y; ss += (y[0] * y[0] + y[1] * y[1]) + (y[2] * y[2] + y[3] * y[3]);
                    }
                ss += __shfl_xor(ss, 16); ss += __shfl_xor(ss, 32);
                if (fq == 0) atomicAdd(rowss + row, ss);
            }
    }
};

__device__ __forceinline__ int src_col(int np) {
    if (np < 4096) return np;
    if (np < 7680) return np + 16;
    if (np < 7744) return 7696 + (np - 7680);
    if (np < 7752) return 4096 + (np - 7744);
    if (np < 7760) return 4104 + (np - 7752);
    if (np < 7776) return np;
    return -1;
}
__device__ __forceinline__ void phase0(const Params& p, unsigned char* smem) {
    const int tid = threadIdx.x, wid = tid >> 6, lane = tid & 63;
    const int gw = blockIdx.x * 8 + wid, nw = gridDim.x * 8;
    h16* H = (h16*)(p.ws + OFF_H);
    for (int row = gw; row < BT; row += nw) {
        const f32x4* xr = (const f32x4*)(p.x + (size_t)row * DM);
        f32x4 v[8]; float ss = 0.f;
#pragma unroll
        for (int i = 0; i < 8; ++i) { v[i] = xr[lane + 64 * i]; ss += (v[i][0] * v[i][0] + v[i][1] * v[i][1]) + (v[i][2] * v[i][2] + v[i][3] * v[i][3]); }
        ss = wave_sum(ss);
        const float r = 1.0f / sqrtf(ss * (1.0f / DM) + EPS);
#pragma unroll
        for (int i = 0; i < 8; ++i) { const f32x4 g = ((const f32x4*)p.attn_g)[lane + 64 * i]; h16x4 o;
#pragma unroll
            for (int j = 0; j < 4; ++j) o[j] = (h16)(v[i][j] * r * g[j]);
            *(h16x4*)(H + (size_t)row * DM + 4 * (lane + 64 * i)) = o; }
    }
    float* tile = (float*)smem;
    h16* Wt = (h16*)(p.ws + OFF_WT);
    for (int tI = blockIdx.x; tI < 124 * 32; tI += gridDim.x) {
        const int n0 = (tI / 32) * 64, k0 = (tI % 32) * 64;
        __syncthreads();
        { const int nl = tid & 63; const int src = src_col(n0 + nl);
#pragma unroll
          for (int i = 0; i < 8; ++i) { const int kl = (tid >> 6) + 8 * i; tile[kl * 65 + nl] = src >= 0 ? p.w_in[(size_t)(k0 + kl) * IN_COLS + src] : 0.f; } }
        __syncthreads();
        { const int nl = tid >> 3, kc = tid & 7; h16x8 o;
#pragma unroll
          for (int j = 0; j < 8; ++j) o[j] = (h16)tile[(8 * kc + j) * 65 + nl];
          *(h16x8*)(Wt + (size_t)(n0 + nl) * 2048 + k0 + 8 * kc) = o; }
    }
    h16* WoT = (h16*)(p.ws + OFF_WOT);
    for (int tI = blockIdx.x; tI < 32 * 32; tI += gridDim.x) {
        const int n0 = (tI / 32) * 64, k0 = (tI % 32) * 64;
        __syncthreads();
        { const int nl = tid & 63;
#pragma unroll
          for (int i = 0; i < 8; ++i) { const int kl = (tid >> 6) + 8 * i; tile[kl * 65 + nl] = p.w_out[(size_t)(k0 + kl) * DM + n0 + nl]; } }
        __syncthreads();
        { const int nl = tid >> 3, kc = tid & 7; h16x8 o;
#pragma unroll
          for (int j = 0; j < 8; ++j) o[j] = (h16)tile[(8 * kc + j) * 65 + nl];
          *(h16x8*)(WoT + (size_t)(n0 + nl) * 2048 + k0 + 8 * kc) = o; }
    }
    __syncthreads();
    float* cosT = (float*)(p.ws + OFF_COS); float* sinT = (float*)(p.ws + OFF_SIN);
    for (int i = blockIdx.x * 512 + tid; i < BT * 24; i += gridDim.x * 512) {
        const int row = i / 24, j = i % 24;
        const float ex = (j < 16) ? (float)j * (2.0f / 32.0f) : (float)(j - 16) * (2.0f / 16.0f);
        const float inv = powf(500000.0f, -ex);
        const float ang = (float)p.pos[row] * inv;
        cosT[i] = cosf(ang); sinT[i] = sinf(ang);
    }
}

__device__ __forceinline__ void gdn_naive_task(const Params& p, unsigned char* smem, int task) {
    const int tid = threadIdx.x, wid = tid >> 6, lane = tid & 63;
    const int b = task >> 6, h = (task >> 3) & 7, eb = task & 7;
    float* stage = (float*)smem;
    const h16* qkvr = (const h16*)(p.ws + OFF_QKVR);
    const float* gb = (const float*)(p.ws + OFF_GB);
    float* oraw = (float*)(p.ws + OFF_ORAW);
    int ch = -1;
    if (tid < 128) ch = h * 128 + tid; else if (tid < 256) ch = 1024 + h * 128 + (tid - 128); else if (tid < 272) ch = 2048 + h * 128 + eb * 16 + (tid - 256);
    float w0 = 0.f, w1 = 0.f, w2 = 0.f, w3 = 0.f;
    if (ch >= 0) { w0 = p.conv_w[ch]; w1 = p.conv_w[3072 + ch]; w2 = p.conv_w[2 * 3072 + ch]; w3 = p.conv_w[3 * 3072 + ch]; }
    float x0 = 0.f, x1 = 0.f, x2 = 0.f;
    float S00 = 0.f, S01 = 0.f, S10 = 0.f, S11 = 0.f;
    const size_t rowbase = (size_t)b * NT;
    float xn = ch >= 0 ? (float)qkvr[rowbase * 3072 + ch] : 0.f;
    const int e0 = eb * 16 + 2 * wid;
    __syncthreads();
    for (int t = 0; t < NT; ++t) {
        const float x3 = xn;
        if (t + 1 < NT && ch >= 0) xn = (float)qkvr[(rowbase + t + 1) * 3072 + ch];
        float* st = stage + (t & 1) * 288;
        if (ch >= 0) { float y = w0 * x0 + w1 * x1 + w2 * x2 + w3 * x3; y = y / (1.0f + expf(-y)); st[tid] = y; x0 = x1; x1 = x2; x2 = x3; }
        const float g = gb[(rowbase + t) * 16 + h], beta = gb[(rowbase + t) * 16 + 8 + h];
        __syncthreads();
        float q0 = st[lane], q1 = st[lane + 64], k0 = st[128 + lane], k1 = st[192 + lane];
        const float ssq = wave_sum(q0 * q0 + q1 * q1), ssk = wave_sum(k0 * k0 + k1 * k1);
        const float rq = 0.08838834764831845f / sqrtf(ssq + EPS), rk = 1.0f / sqrtf(ssk + EPS);
        q0 *= rq; q1 *= rq; k0 *= rk; k1 *= rk;
        const float eg = expf(g);
        const float v0 = st[256 + 2 * wid], v1 = st[256 + 2 * wid + 1];
        S00 *= eg; S01 *= eg; S10 *= eg; S11 *= eg;
        const float r0 = wave_sum(k0 * S00 + k1 * S01), r1 = wave_sum(k0 * S10 + k1 * S11);
        const float vn0 = beta * (v0 - r0), vn1 = beta * (v1 - r1);
        S00 += k0 * vn0; S01 += k1 * vn0; S10 += k0 * vn1; S11 += k1 * vn1;
        const float o0 = wave_sum(q0 * S00 + q1 * S01), o1 = wave_sum(q0 * S10 + q1 * S11);
        if (lane == 0) { float* op = oraw + (rowbase + t) * 1024 + h * 128 + e0; op[0] = o0; op[1] = o1; }
    }
}

__device__ __forceinline__ unsigned f2key(float x) { const unsigned u = __float_as_uint(x); return (u & 0x80000000u) ? ~u : (u | 0x80000000u); }
__device__ __forceinline__ void idx_task(const Params& p, unsigned char* smem, int bt) {
    const int tid = threadIdx.x, wid = tid >> 6, lane = tid & 63;
    const int b = bt / NT, t = bt % NT, n = t + 1;
    unsigned short* sel = (unsigned short*)(p.ws + OFF_SEL) + (size_t)bt * 256;
    if (n <= 256) { if (tid < 256) sel[tid] = (unsigned short)(tid < n ? tid : 0); return; }
    float* qs = (float*)smem; float* wsm = qs + 1024; unsigned* keys = (unsigned*)(smem + 8192); unsigned* hist = keys + 4096; unsigned* misc = hist + 256;
    __syncthreads();
    { const h16* iq = (const h16*)(p.ws + OFF_IQ) + (size_t)bt * 1024; const h16x2 v = *(const h16x2*)(iq + 2 * tid); qs[2 * tid] = (float)v[0]; qs[2 * tid + 1] = (float)v[1];
      if (tid < 16) wsm[tid] = ((const float*)(p.ws + OFF_IW))[(size_t)bt * 16 + tid]; }
    __syncthreads();
    const h16* ik = (const h16*)(p.ws + OFF_IK) + (size_t)b * NT * 64;
    for (int s = tid; s < n; s += 512) {
        float kf[64];
#pragma unroll
        for (int i = 0; i < 8; ++i) { const h16x8 v = *(const h16x8*)(ik + (size_t)s * 64 + 8 * i);
#pragma unroll
            for (int j = 0; j < 8; ++j) kf[8 * i + j] = (float)v[j]; }
        float sc = 0.f;
#pragma unroll 1
        for (int hh = 0; hh < 16; ++hh) { float d = 0.f;
#pragma unroll
            for (int dd = 0; dd < 64; ++dd) d += qs[hh * 64 + dd] * kf[dd];
            sc += wsm[hh] * fmaxf(d, 0.f); }
        keys[s] = f2key(sc);
    }
    __syncthreads();
    unsigned prefix = 0, need = 256;
    for (int pass = 0; pass < 4; ++pass) {
        const int shift = 24 - 8 * pass;
        if (tid < 256) hist[tid] = 0;
        __syncthreads();
        for (int i = tid; i < n; i += 512) { const unsigned u = keys[i]; const bool part = (pass == 0) || ((u >> (shift + 8)) == (prefix >> (shift + 8))); if (part) atomicAdd(&hist[(u >> shift) & 255u], 1u); }
        __syncthreads();
        if (wid == 0) {
            const unsigned c0 = hist[4 * lane], c1 = hist[4 * lane + 1], c2 = hist[4 * lane + 2], c3 = hist[4 * lane + 3]; const unsigned s = c0 + c1 + c2 + c3;
            unsigned suf = s;
#pragma unroll
            for (int off = 1; off < 64; off <<= 1) { const unsigned tt = __shfl_down(suf, off); if (lane + off < 64) suf += tt; }
            const unsigned above = suf - s;
            if (above < need && need <= suf) {
                unsigned cum = above; int bin;
                if (cum + c3 >= need) bin = 3; else { cum += c3; if (cum + c2 >= need) bin = 2; else { cum += c2; if (cum + c1 >= need) bin = 1; else { cum += c1; bin = 0; } } }
                misc[0] = prefix | ((unsigned)(4 * lane + bin) << shift); misc[1] = need - cum;
            }
        }
        __syncthreads();
        prefix = misc[0]; need = misc[1];
    }
    const unsigned Kt = prefix, r = need;
    unsigned kk[8]; unsigned cgt = 0, ceq = 0;
#pragma unroll
    for (int j = 0; j < 8; ++j) { const int i = 8 * tid + j; const unsigned u = (i < n) ? keys[i] : 0u; kk[j] = u; if (i < n) { cgt += (u > Kt) ? 1u : 0u; ceq += (u == Kt) ? 1u : 0u; } }
    const unsigned packed = cgt | (ceq << 16);
    unsigned inc = packed;
#pragma unroll
    for (int off = 1; off < 64; off <<= 1) { const unsigned tt = __shfl_up(inc, off); if (lane >= off) inc += tt; }
    if (lane == 63) misc[8 + wid] = inc;
    __syncthreads();
    unsigned basev = 0;
    for (int w = 0; w < wid; ++w) basev += misc[8 + w];
    const unsigned exc = basev + inc - packed;
    unsigned eq_before = exc >> 16; unsigned pos = (exc & 0xFFFFu) + (eq_before < r ? eq_before : r);
#pragma unroll
    for (int j = 0; j < 8; ++j) { const int i = 8 * tid + j; if (i < n) { const unsigned u = kk[j]; const bool s = (u > Kt) || (u == Kt && eq_before < r); if (u == Kt) ++eq_before; if (s) { sel[pos] = (unsigned short)i; ++pos; } } }
}

__device__ __forceinline__ void gdn_post(const Params& p) {
    const int tid = threadIdx.x, wid = tid >> 6, lane = tid & 63;
    const int gw = blockIdx.x * 8 + wid, nw = gridDim.x * 8;
    const float* oraw = (const float*)(p.ws + OFF_ORAW); const h16* gz = (const h16*)(p.ws + OFF_GZ); h16* omix = (h16*)(p.ws + OFF_OMIX);
    const float g0 = p.gdn_norm_g[lane], g1 = p.gdn_norm_g[lane + 64];
    for (int it = gw; it < BT * 8; it += nw) {
        const int bt = it >> 3, h = it & 7;
        const float a = oraw[(size_t)bt * 1024 + h * 128 + lane], c = oraw[(size_t)bt * 1024 + h * 128 + 64 + lane];
        const float ss = wave_sum(a * a + c * c);
        const float r = 1.0f / sqrtf(ss * (1.0f / 128.0f) + EPS);
        omix[(size_t)bt * 2048 + h * 128 + lane] = (h16)(a * r * g0 * (float)gz[(size_t)bt * 1024 + h * 128 + lane]);
        omix[(size_t)bt * 2048 + h * 128 + 64 + lane] = (h16)(c * r * g1 * (float)gz[(size_t)bt * 1024 + h * 128 + 64 + lane]);
    }
}

__device__ __forceinline__ void attn_naive_task(const Params& p, unsigned char* smem, int bt) {
    const int tid = threadIdx.x, wid = tid >> 6, lane = tid & 63;
    const int b = bt / NT, t = bt % NT; const int nvalid = (t + 1) < 256 ? (t + 1) : 256;
    float* qs = (float*)smem; float* lg = qs + 1024; unsigned short* sl = (unsigned short*)(lg + 2048);
    const h16* aq = (const h16*)(p.ws + OFF_AQ); const h16* ak = (const h16*)(p.ws + OFF_AK); const h16* av = (const h16*)(p.ws + OFF_AV);
    const h16* az = (const h16*)(p.ws + OFF_AZ); h16* omix = (h16*)(p.ws + OFF_OMIX);
    __syncthreads();
    { const h16x2 v = *(const h16x2*)(aq + (size_t)bt * 1024 + 2 * tid); qs[2 * tid] = (float)v[0]; qs[2 * tid + 1] = (float)v[1];
      if (tid < 256) sl[tid] = ((const unsigned short*)(p.ws + OFF_SEL))[(size_t)bt * 256 + tid]; }
    __syncthreads();
    { const int kk = tid & 255, g = tid >> 8; const int key = sl[kk];
      const h16* kr = ak + ((size_t)b * NT + key) * 256 + g * 128;
      float d0 = 0.f, d1 = 0.f, d2 = 0.f, d3 = 0.f; const float* q = qs + (4 * g) * 128;
#pragma unroll 4
      for (int i = 0; i < 16; ++i) { const h16x8 v = *(const h16x8*)(kr + 8 * i);
#pragma unroll
          for (int j = 0; j < 8; ++j) { const float kv = (float)v[j]; d0 += q[8 * i + j] * kv; d1 += q[128 + 8 * i + j] * kv; d2 += q[256 + 8 * i + j] * kv; d3 += q[384 + 8 * i + j] * kv; } }
      const bool valid = kk < nvalid;
      lg[(4 * g + 0) * 256 + kk] = valid ? d0 : -INFINITY; lg[(4 * g + 1) * 256 + kk] = valid ? d1 : -INFINITY;
      lg[(4 * g + 2) * 256 + kk] = valid ? d2 : -INFINITY; lg[(4 * g + 3) * 256 + kk] = valid ? d3 : -INFINITY; }
    __syncthreads();
    { float* L = lg + wid * 256; const float a0 = L[lane], a1 = L[lane + 64], a2 = L[lane + 128], a3 = L[lane + 192];
      const float m = wave_max(fmaxf(fmaxf(a0, a1), fmaxf(a2, a3)));
      const float e0 = expf(a0 - m), e1 = expf(a1 - m), e2 = expf(a2 - m), e3 = expf(a3 - m);
      const float inv = 1.0f / wave_sum((e0 + e1) + (e2 + e3));
      L[lane] = e0 * inv; L[lane + 64] = e1 * inv; L[lane + 128] = e2 * inv; L[lane + 192] = e3 * inv; }
    __syncthreads();
    { const int h = wid, g = h >> 2; float o0 = 0.f, o1 = 0.f; const float* P = lg + h * 256;
      for (int kk = 0; kk < nvalid; ++kk) { const int key = sl[kk]; const h16x2 v = *(const h16x2*)(av + ((size_t)b * NT + key) * 256 + g * 128 + 2 * lane); const float pk = P[kk]; o0 += pk * (float)v[0]; o1 += pk * (float)v[1]; }
      const h16x2 gt = *(const h16x2*)(az + (size_t)bt * 1024 + h * 128 + 2 * lane);
      h16x2 o; o[0] = (h16)(o0 * (float)gt[0]); o[1] = (h16)(o1 * (float)gt[1]);
      *(h16x2*)(omix + (size_t)bt * 2048 + 1024 + h * 128 + 2 * lane) = o; }
}

__device__ __forceinline__ void phase5(const Params& p) {
    const int tid = threadIdx.x, wid = tid >> 6, lane = tid & 63;
    const int gw = blockIdx.x * 8 + wid, nw = gridDim.x * 8;
    const float* rowss = (const float*)(p.ws + OFF_ROWSS);
    for (int row = gw; row < BT; row += nw) {
        const float r = 1.0f / sqrtf(rowss[row] * (1.0f / DM) + EPS);
        f32x4* o = (f32x4*)(p.out + (size_t)row * DM);
#pragma unroll
        for (int i = 0; i < 8; ++i) { const f32x4 g = ((const f32x4*)p.final_g)[lane + 64 * i]; f32x4 v = o[lane + 64 * i]; v = v * r * g; o[lane + 64 * i] = v; }
    }
}

template <int LO, int HI>
__global__ void __launch_bounds__(512, 2) k_phases(Params p) {
    extern __shared__ __attribute__((aligned(16))) unsigned char smem[];
#define IN(k) (LO <= (k) && (k) < HI)
#define SEAM(k) do { if constexpr (IN(k) && IN((k) + 1)) { cg::this_grid().sync(); } } while (0)
    if constexpr (IN(0)) { phase0(p, smem); }
    SEAM(0);
    if constexpr (IN(1)) {
        pg8::Gemm g{(const h16*)(p.ws + OFF_H), (const h16*)(p.ws + OFF_WT), BT, NPAD, DM};
        pg8::StaticOrder S; S.init(BT, NPAD, gridDim.x, blockIdx.x);
        EpiIn E{p.ws, p.a_log, p.dt_bias};
        pg8::gemm_phase<EpiIn, pg8::StaticOrder>((LAS unsigned char*)smem, g, S, E);
    }
    SEAM(1);
    if constexpr (IN(2)) {
        for (int task = blockIdx.x; task < 256; task += gridDim.x) gdn_naive_task(p, smem, task);
        __syncthreads();
        for (int bt = blockIdx.x; bt < BT; bt += gridDim.x) idx_task(p, smem, bt);
    }
    SEAM(2);
    if constexpr (IN(3)) {
        gdn_post(p);
        for (int bt = blockIdx.x; bt < BT; bt += gridDim.x) attn_naive_task(p, smem, bt);
    }
    SEAM(3);
    if constexpr (IN(4)) {
        pg8::Gemm g{(const h16*)(p.ws + OFF_OMIX), (const h16*)(p.ws + OFF_WOT), BT, DM, DM};
        pg8::StaticOrder S; S.init(BT, DM, gridDim.x, blockIdx.x);
        EpiOut E{p.x, p.out, (float*)(p.ws + OFF_ROWSS)};
        pg8::gemm_phase<EpiOut, pg8::StaticOrder>((LAS unsigned char*)smem, g, S, E);
    }
    SEAM(4);
    if constexpr (IN(5)) { phase5(p); }
#undef IN
#undef SEAM
}

template <int LO, int HI> static void launch_range(const Params& p, int grid, hipStream_t stream, bool coop) {
    static bool attr = false;
    if (!attr) { hipFuncSetAttribute((const void*)k_phases<LO, HI>, hipFuncAttributeMaxDynamicSharedMemorySize, LDS_BYTES); attr = true; }
    if (coop) {
        Params pp = p; void* args[] = {&pp};
        hipError_t e = hipLaunchCooperativeKernel((const void*)k_phases<LO, HI>, dim3(grid), dim3(512), args, LDS_BYTES, stream);
        if (e != hipSuccess) fprintf(stderr, "cooperative launch failed: %s (grid %d)\n", hipGetErrorString(e), grid);
    } else {
        hipLaunchKernelGGL((k_phases<LO, HI>), dim3(grid), dim3(512), LDS_BYTES, stream, p);
    }
}

extern "C" void kernel_launch(void* const* d_in, const int* in_sizes, int n_in, void* d_out, int out_size, void* d_ws, size_t ws_size, hipStream_t stream) {
    if (n_in != 10 || in_sizes[0] != BT * DM || out_size != BT * DM || ws_size < WS_END) {
        fprintf(stderr, "kernel_launch: unexpected shapes (n_in %d in0 %d out %d ws %zu need %zu)\n", n_in, n_in > 0 ? in_sizes[0] : -1, out_size, ws_size, (size_t)WS_END); return; }
    static int grid = 0;
    if (!grid) {
        int dev = 0, cus = 0, per_cu = 0; hipGetDevice(&dev); hipDeviceGetAttribute(&cus, hipDeviceAttributeMultiprocessorCount, dev);
#if FUSED
        hipFuncSetAttribute((const void*)k_phases<0, 6>, hipFuncAttributeMaxDynamicSharedMemorySize, LDS_BYTES);
        hipOccupancyMaxActiveBlocksPerMultiprocessor(&per_cu, (const void*)k_phases<0, 6>, 512, LDS_BYTES);
#else
        per_cu = 1;
#endif
        if (per_cu < 1) per_cu = 1; if (per_cu > 1) per_cu = 1;
        grid = cus * per_cu;
    }
    Params p{};
    p.x = (const float*)d_in[0]; p.pos = (const int*)d_in[1]; p.attn_g = (const float*)d_in[2]; p.w_in = (const float*)d_in[3]; p.conv_w = (const float*)d_in[4];
    p.a_log = (const float*)d_in[5]; p.dt_bias = (const float*)d_in[6]; p.gdn_norm_g = (const float*)d_in[7]; p.w_out = (const float*)d_in[8]; p.final_g = (const float*)d_in[9];
    p.out = (float*)d_out; p.ws = (unsigned char*)d_ws;
    hipMemsetAsync((char*)d_ws + OFF_CTRL, 0, CTL_ZERO_BYTES, stream);
#if FUSED
    launch_range<0, 6>(p, grid, stream, true);
#else
    launch_range<0, 1>(p, grid, stream, false);
    launch_range<1, 2>(p, grid, stream, false);
    launch_range<2, 3>(p, grid, stream, false);
    launch_range<3, 4>(p, grid, stream, false);
    launch_range<4, 5>(p, grid, stream, false);
    launch_range<5, 6>(p, grid, stream, false);
#endif
}
```

```cpp
#include <hip/hip_runtime.h>
#include <hip/hip_cooperative_groups.h>
#include <cstdio>
#include <cstdint>
namespace cg = cooperative_groups;

#ifndef FUSED
#define FUSED 1
#endif

#define LAS __attribute__((address_space(3)))
typedef _Float16 h16;
typedef h16 h16x8 __attribute__((ext_vector_type(8)));
typedef h16 h16x4 __attribute__((ext_vector_type(4)));
typedef h16 h16x2 __attribute__((ext_vector_type(2)));
typedef float f32x4 __attribute__((ext_vector_type(4)));
typedef float f32x2 __attribute__((ext_vector_type(2)));
typedef unsigned u32x4 __attribute__((ext_vector_type(4)));

constexpr int NB = 4, NT = 4096, DM = 2048, BT = NB * NT;
constexpr int IN_COLS = 7776, NPAD = 7936;
constexpr float EPS = 1e-6f;
constexpr int LDS_BYTES = 155648;

constexpr size_t MB = 1024 * 1024;
constexpr size_t OFF_CTRL = 0;
constexpr size_t OFF_ROWSS = 65536;
constexpr size_t CTL_ZERO_BYTES = 65536 + (size_t)BT * 4;
constexpr size_t OFF_H = 1 * MB;
constexpr size_t OFF_OMIX = OFF_H;
constexpr size_t OFF_WT = OFF_H + 64 * MB;
constexpr size_t OFF_WOT = OFF_WT + (size_t)NPAD * 2048 * 2;
constexpr size_t OFF_QKVR = OFF_WOT + 8 * MB;
constexpr size_t OFF_GZ = OFF_QKVR + (size_t)BT * 3072 * 2;
constexpr size_t OFF_AQ = OFF_GZ + 32 * MB;
constexpr size_t OFF_AK = OFF_AQ + 32 * MB;
constexpr size_t OFF_AV = OFF_AK + 8 * MB;
constexpr size_t OFF_AZ = OFF_AV + 8 * MB;
constexpr size_t OFF_IQ = OFF_AZ + 32 * MB;
constexpr size_t OFF_IK = OFF_IQ + 32 * MB;
constexpr size_t OFF_GB = OFF_IK + 2 * MB;
constexpr size_t OFF_IW = OFF_GB + 1 * MB;
constexpr size_t OFF_COS = OFF_IW + 1 * MB;
constexpr size_t OFF_SIN = OFF_COS + 2 * MB;
constexpr size_t OFF_SEL = OFF_SIN + 2 * MB;
constexpr size_t OFF_ORAW = OFF_SEL + 8 * MB;
constexpr size_t WS_END = OFF_ORAW + 64 * MB;

struct Params {
    const float* x; const int* pos; const float* attn_g; const float* w_in; const float* conv_w; const float* a_log;
    const float* dt_bias; const float* gdn_norm_g; const float* w_out; const float* final_g; float* out; unsigned char* ws;
};

__device__ __forceinline__ float wave_sum(float v) {
#pragma unroll
    for (int o = 1; o < 64; o <<= 1) v += __shfl_xor(v, o);
    return v;
}
__device__ __forceinline__ float wave_max(float v) {
#pragma unroll
    for (int o = 1; o < 64; o <<= 1) v = fmaxf(v, __shfl_xor(v, o));
    return v;
}
__device__ __forceinline__ float silu_f(float x) { return x / (1.0f + __expf(-x)); }

namespace pg8 {
constexpr int BM = 256, BK = 64, HALF = 128, HTB = HALF * BK * 2, STAGE_BYTES = 8 * HTB, NXCD = 8, WGM = 8;
__host__ __device__ __forceinline__ int lds_byte(int r, int c) { const int st = (r >> 4) * 2 + (c >> 5), rr = r & 15, cc = c & 31, ob = rr * 64 + cc * 2; return st * 1024 + (ob ^ (((ob >> 9) & 1) << 5)); }
__host__ __device__ __forceinline__ void stage_rc(int b, int& R, int& C) { const int st = b / 1024, sb = b % 1024, swz = sb ^ (((sb >> 9) & 1) << 5); R = (st >> 1) * 16 + swz / 64; C = (st & 1) * 32 + (swz % 64) / 2; }
__host__ __device__ __forceinline__ int perm32(int rho) { const int n = rho >> 4, i = rho & 15; return 8 * (i >> 2) + 4 * n + (i & 3); }
struct Unit { int pm, pn; };
struct Gemm { const h16* A; const h16* Bt; int M, N, K; };
struct StaticOrder {
    int nM, nN, nwg, G, c;
    __host__ __device__ void init(int M, int N, int G_, int c_) { nM = M / BM; nN = N / BM; nwg = nM * nN; G = G_; c = c_; }
    __host__ __device__ bool next(int i, Unit& u) const {
        const long L = (long)i * G + c; if (L >= nwg) return false;
        int wgid = (int)L; { const int q = nwg / NXCD, r = nwg % NXCD, xcd = wgid % NXCD, off = wgid / NXCD; wgid = (xcd < r ? xcd * (q + 1) : r * (q + 1) + (xcd - r) * q) + off; }
        const int nig = WGM * nN, gid = wgid / nig, fm = gid * WGM, gsz = (nM - fm) < WGM ? (nM - fm) : WGM;
        u.pm = fm + ((wgid % nig) % gsz); u.pn = (wgid % nig) / gsz; return true;
    }
    __device__ __forceinline__ void a_ready(const Unit&) const {}
    __device__ __forceinline__ void done(const Unit&) const {}
};

template <class Epi, class Sched>
__device__ __forceinline__ void gemm_phase(LAS unsigned char* lds, const Gemm g, const Sched& S, const Epi& E) {
    const int tid = threadIdx.x, wid = __builtin_amdgcn_readfirstlane(tid >> 6), lane = tid & 63, wr = wid >> 2, wc = wid & 3, fr = lane & 15, fq = lane >> 4;
    const int K = g.K, nt = K / BK;
    unsigned voffA[2], voffB[2];
#pragma unroll
    for (int i = 0; i < 2; ++i) { int R, C; stage_rc(tid * 16 + i * 8192, R, C); const int Rb = Epi::PERM ? ((R & ~31) + perm32(R & 31)) : R;
        voffA[i] = (unsigned)(R * K + C) * 2u; voffB[i] = (unsigned)(Rb * K + C) * 2u; }
    const size_t kstep = (size_t)(BK * 2);
    const size_t hstep = (size_t)HALF * K * 2;
    const size_t tstep = 2 * hstep;
    const unsigned ldsw = (unsigned)wid * 1024u;
    const int aoff = lds_byte(wr * 64 + fr, fq * 8), boff = lds_byte(wc * 32 + fr, fq * 8);
#define PG8_SA(b, h) (((b) * 2 + (h)) * HTB)
#define PG8_SB(b, h) ((4 + (b) * 2 + (h)) * HTB)
#define PG8_STAGE(bufoff, gbase, voff) do { _Pragma("unroll") for (int _i = 0; _i < 2; ++_i) \
        __builtin_amdgcn_global_load_lds((const unsigned*)((const char*)(gbase) + (voff)[_i]), (LAS unsigned*)(lds + (bufoff) + ldsw + _i * 8192), 16, 0, 0); } while (0)
#define PG8_LDA(dst, b, h) do { _Pragma("unroll") for (int m = 0; m < 4; ++m) _Pragma("unroll") for (int k = 0; k < 2; ++k) dst[m][k] = *(const LAS h16x8*)(lds + PG8_SA(b, h) + aoff + m * 2048 + k * 1024); } while (0)
#define PG8_LDB(dst, b, h) do { _Pragma("unroll") for (int n = 0; n < 2; ++n) _Pragma("unroll") for (int k = 0; k < 2; ++k) dst[n][k] = *(const LAS h16x8*)(lds + PG8_SB(b, h) + boff + n * 2048 + k * 1024); } while (0)
#define PG8_MMA(ai, bj, At, Bt) do { __builtin_amdgcn_s_setprio(1); _Pragma("unroll") for (int m = 0; m < 4; ++m) _Pragma("unroll") for (int n = 0; n < 2; ++n) _Pragma("unroll") for (int k = 0; k < 2; ++k) \
        acc[ai][bj][m][n] = __builtin_amdgcn_mfma_f32_16x16x32_f16(Bt[n][k], At[m][k], acc[ai][bj][m][n], 0, 0, 0); __builtin_amdgcn_s_setprio(0); } while (0)
#define PG8_WAIT_V(n) asm volatile("s_waitcnt vmcnt(" #n ")" ::: "memory")
#define PG8_WAIT_L(n) asm volatile("s_waitcnt lgkmcnt(" #n ")" ::: "memory")
#define PG8_BAR __builtin_amdgcn_s_barrier()
#define PG8_SCHED __builtin_amdgcn_sched_barrier(0)
    Unit cur, nxt; int ui = 0;
    if (!S.next(0, cur)) return;
    f32x4 acc[2][2][4][2];
#pragma unroll
    for (int a = 0; a < 2; ++a)
#pragma unroll
        for (int b = 0; b < 2; ++b)
#pragma unroll
            for (int m = 0; m < 4; ++m)
#pragma unroll
                for (int n = 0; n < 2; ++n) acc[a][b][m][n] = (f32x4){0.f, 0.f, 0.f, 0.f};
    h16x8 At[4][2], B0[2][2], B1[2][2];
    const char* cA = (const char*)g.A + (size_t)cur.pm * tstep; const char* cB = (const char*)g.Bt + (size_t)cur.pn * tstep;
    S.a_ready(cur);
    PG8_STAGE(PG8_SB(0, 0), cB, voffB); PG8_STAGE(PG8_SA(0, 0), cA, voffA); PG8_STAGE(PG8_SB(0, 1), cB + hstep, voffB); PG8_STAGE(PG8_SA(0, 1), cA + hstep, voffA);
    if (wr == 1) PG8_BAR;
    PG8_WAIT_V(4); PG8_BAR;
    PG8_STAGE(PG8_SB(1, 0), cB + kstep, voffB); PG8_STAGE(PG8_SA(1, 0), cA + kstep, voffA); PG8_STAGE(PG8_SB(1, 1), cB + hstep + kstep, voffB);
    PG8_WAIT_V(6); PG8_BAR;
    for (;;) {
        const bool has_next = S.next(ui + 1, nxt);
        const char* nA = has_next ? (const char*)g.A + (size_t)nxt.pm * tstep : cA; const char* nB = has_next ? (const char*)g.Bt + (size_t)nxt.pn * tstep : cB;
        for (int t = 0; t < nt; t += 2) {
            const bool last = (t == nt - 2);
            const char* a1 = cA + (size_t)(t + 1) * kstep;
            const char* a2 = last ? nA : cA + (size_t)(t + 2) * kstep; const char* b2 = last ? nB : cB + (size_t)(t + 2) * kstep;
            const char* a3 = a2 + kstep; const char* b3 = b2 + kstep;
            if (last && has_next) S.a_ready(nxt);
            PG8_LDB(B0, 0, 0); PG8_SCHED; PG8_LDA(At, 0, 0); PG8_STAGE(PG8_SA(1, 1), a1 + hstep, voffA);
            PG8_WAIT_L(8); PG8_BAR; PG8_WAIT_L(0); PG8_MMA(0, 0, At, B0); PG8_BAR; PG8_SCHED;
            PG8_LDB(B1, 0, 1); PG8_STAGE(PG8_SB(0, 0), b2, voffB);
            PG8_BAR; PG8_WAIT_L(0); PG8_MMA(0, 1, At, B1); PG8_BAR;
            PG8_LDA(At, 0, 1); PG8_STAGE(PG8_SA(0, 0), a2, voffA);
            PG8_BAR; PG8_WAIT_L(0); PG8_MMA(1, 0, At, B0); PG8_BAR; PG8_SCHED;
            PG8_STAGE(PG8_SB(0, 1), b2 + hstep, voffB);
            PG8_WAIT_V(6); PG8_BAR; PG8_MMA(1, 1, At, B1); PG8_BAR;
            PG8_LDB(B0, 1, 0); PG8_SCHED; PG8_LDA(At, 1, 0); PG8_STAGE(PG8_SA(0, 1), a2 + hstep, voffA);
            PG8_WAIT_L(8); PG8_BAR; PG8_WAIT_L(0); PG8_MMA(0, 0, At, B0); PG8_BAR; PG8_SCHED;
            PG8_LDB(B1, 1, 1); PG8_STAGE(PG8_SB(1, 0), b3, voffB);
            PG8_BAR; PG8_WAIT_L(0); PG8_MMA(0, 1, At, B1); PG8_BAR;
            PG8_LDA(At, 1, 1); PG8_STAGE(PG8_SA(1, 0), a3, voffA);
            PG8_BAR; PG8_WAIT_L(0); PG8_MMA(1, 0, At, B0); PG8_BAR; PG8_SCHED;
            PG8_STAGE(PG8_SB(1, 1), b3 + hstep, voffB);
            PG8_WAIT_V(6); PG8_BAR; PG8_MMA(1, 1, At, B1); PG8_BAR;
        }
        E(acc, cur, wr, wc, fr, fq); S.done(cur);
        if (!has_next) break;
#pragma unroll
        for (int a = 0; a < 2; ++a)
#pragma unroll
            for (int b = 0; b < 2; ++b)
#pragma unroll
                for (int m = 0; m < 4; ++m)
#pragma unroll
                    for (int n = 0; n < 2; ++n) acc[a][b][m][n] = (f32x4){0.f, 0.f, 0.f, 0.f};
        cur = nxt; cA = nA; cB = nB; ++ui;
    }
    PG8_WAIT_V(0);
    if (wr == 0) PG8_BAR;
    PG8_BAR;
#undef PG8_SA
#undef PG8_SB
#undef PG8_STAGE
#undef PG8_LDA
#undef PG8_LDB
#undef PG8_MMA
#undef PG8_WAIT_V
#undef PG8_WAIT_L
#undef PG8_BAR
#undef PG8_SCHED
}
}

struct EpiIn {
    static constexpr bool PERM = true;
    unsigned char* ws; const float* a_log; const float* dt_bias;
    __device__ __forceinline__ void operator()(const f32x4 (&acc)[2][2][4][2], const pg8::Unit& u, int wr, int wc, int fr, int fq) const {
        const int pn = u.pn;
        const int rowb = u.pm * 256 + wr * 64 + fr;
        const int cw = wc * 32 + 8 * fq;
        const float* cosT = (const float*)(ws + OFF_COS); const float* sinT = (const float*)(ws + OFF_SIN);
        if (pn < 30) {
            h16* base; int ldc, colt, mode; float scale = 1.f;
            if (pn < 12) { base = (h16*)(ws + OFF_QKVR); ldc = 3072; colt = pn * 256; mode = 0; }
            else if (pn < 16) { base = (h16*)(ws + OFF_GZ); ldc = 1024; colt = (pn - 12) * 256; mode = 1; }
            else if (pn < 20) { base = (h16*)(ws + OFF_AQ); ldc = 1024; colt = (pn - 16) * 256; mode = 2; scale = 0.08838834764831845f; }
            else if (pn == 20) { base = (h16*)(ws + OFF_AK); ldc = 256; colt = 0; mode = 2; }
            else if (pn == 21) { base = (h16*)(ws + OFF_AV); ldc = 256; colt = 0; mode = 0; }
            else if (pn < 26) { base = (h16*)(ws + OFF_AZ); ldc = 1024; colt = (pn - 22) * 256; mode = 1; }
            else { base = (h16*)(ws + OFF_IQ); ldc = 1024; colt = (pn - 26) * 256; mode = 3; }
            const bool rot_wave = (mode == 2 && wc == 0) || (mode == 3 && (wc & 1) == 0);
            const int xm = (mode == 2) ? 32 : 16;
            const bool rot_lane = (mode == 2) ? true : (fq < 2);
            const float sgn = (mode == 2) ? (fq < 2 ? -1.f : 1.f) : (fq == 0 ? -1.f : 1.f);
            const int tix = (mode == 2) ? 8 * (fq & 1) : 16;
#pragma unroll
            for (int ai = 0; ai < 2; ++ai)
#pragma unroll
                for (int m = 0; m < 4; ++m) {
                    const int row = rowb + ai * 128 + m * 16;
                    float cs[8], sn[8];
                    if (rot_wave) {
                        const f32x4 c0 = *(const f32x4*)(cosT + (size_t)row * 24 + tix), c1 = *(const f32x4*)(cosT + (size_t)row * 24 + tix + 4);
                        const f32x4 s0 = *(const f32x4*)(sinT + (size_t)row * 24 + tix), s1 = *(const f32x4*)(sinT + (size_t)row * 24 + tix + 4);
#pragma unroll
                        for (int j = 0; j < 4; ++j) { cs[j] = c0[j]; cs[4 + j] = c1[j]; sn[j] = s0[j]; sn[4 + j] = s1[j]; }
                    }
#pragma unroll
                    for (int bj = 0; bj < 2; ++bj) {
                        float v[8];
#pragma unroll
                        for (int j = 0; j < 4; ++j) { v[j] = acc[ai][bj][m][0][j]; v[4 + j] = acc[ai][bj][m][1][j]; }
                        if (rot_wave) {
#pragma unroll
                            for (int j = 0; j < 8; ++j) { const float pv = __shfl_xor(v[j], xm); if (rot_lane) v[j] = v[j] * cs[j] + sgn * pv * sn[j]; }
                        }
                        if (mode == 1) {
#pragma unroll
                            for (int j = 0; j < 8; ++j) v[j] = silu_f(v[j]);
                        }
                        h16x8 o;
#pragma unroll
                        for (int j = 0; j < 8; ++j) o[j] = (h16)(v[j] * scale);
                        *(h16x8*)(base + (size_t)row * ldc + colt + bj * 128 + cw) = o;
                    }
                }
        } else {
            h16* ik = (h16*)(ws + OFF_IK); float* gb = (float*)(ws + OFF_GB); float* iw = (float*)(ws + OFF_IW);
#pragma unroll
            for (int ai = 0; ai < 2; ++ai)
#pragma unroll
                for (int m = 0; m < 4; ++m) {
                    const int row = rowb + ai * 128 + m * 16;
                    float v[8];
#pragma unroll
                    for (int j = 0; j < 4; ++j) { v[j] = acc[ai][0][m][0][j]; v[4 + j] = acc[ai][0][m][1][j]; }
                    if (wc == 0) {
                        const f32x4 c0 = *(const f32x4*)(cosT + (size_t)row * 24 + 16), c1 = *(const f32x4*)(cosT + (size_t)row * 24 + 20);
                        const f32x4 s0 = *(const f32x4*)(sinT + (size_t)row * 24 + 16), s1 = *(const f32x4*)(sinT + (size_t)row * 24 + 20);
                        const float sgn = (fq == 0 ? -1.f : 1.f);
#pragma unroll
                        for (int j = 0; j < 8; ++j) { const float pv = __shfl_xor(v[j], 16); const float c = j < 4 ? c0[j & 3] : c1[j & 3], s = j < 4 ? s0[j & 3] : s1[j & 3];
                            if (fq < 2) v[j] = v[j] * c + sgn * pv * s; }
                    }
                    if (wc < 2) {
                        h16x8 o;
#pragma unroll
                        for (int j = 0; j < 8; ++j) o[j] = (h16)v[j];
                        *(h16x8*)(ik + (size_t)row * 64 + cw) = o;
                    } else if (wc == 2) {
                        if (fq == 0) {
#pragma unroll
                            for (int j = 0; j < 8; ++j) { const float z = v[j] + dt_bias[j]; const float sp = z > 20.f ? z : log1pf(expf(z)); gb[(size_t)row * 16 + j] = -expf(a_log[j]) * sp; }
                        } else if (fq == 1) {
#pragma unroll
                            for (int j = 0; j < 8; ++j) gb[(size_t)row * 16 + 8 + j] = 1.0f / (1.0f + expf(-v[j]));
                        } else {
#pragma unroll
                            for (int j = 0; j < 8; ++j) iw[(size_t)row * 16 + 8 * (fq - 2) + j] = v[j] * 0.03125f;
                        }
                    }
                }
        }
    }
};

struct EpiOut {
    static constexpr bool PERM = false;
    const float* x; float* out; float* rowss;
    __device__ __forceinline__ void operator()(const f32x4 (&acc)[2][2][4][2], const pg8::Unit& u, int wr, int wc, int fr, int fq) const {
        const int rowb = u.pm * 256 + wr * 64 + fr, col0 = u.pn * 256 + wc * 32 + 4 * fq;
#pragma unroll
        for (int ai = 0; ai < 2; ++ai)
#pragma unroll
            for (int m = 0; m < 4; ++m) {
                const int row = rowb + ai * 128 + m * 16; float ss = 0.f;
#pragma unroll
                for (int bj = 0; bj < 2; ++bj)
#pragma unroll
                    for (int n = 0; n < 2; ++n) {
                        const size_t off = (size_t)row * DM + col0 + bj * 128 + n * 16;
                        const f32x4 y = *(const f32x4*)(x + off) + acc[ai][bj][m][n];
                        *(f32x4*)(out + off) = y; ss += (y[0] * y[0] + y[1] * y[1]) + (y[2] * y[2] + y[3] * y[3]);
                    }
                ss += __shfl_xor(ss, 16); ss += __shfl_xor(ss, 32);
                if (fq == 0) atomicAdd(rowss + row, ss);
            }
    }
};

__device__ __forceinline__ int src_col(int np) {
    if (np < 4096) return np;
    if (np < 7680) return np + 16;
    if (np < 7744) return 7696 + (np - 7680);
    if (np < 7752) return 4096 + (np - 7744);
    if (np < 7760) return 4104 + (np - 7752);
    if (np < 7776) return np;
    return -1;
}
__device__ __forceinline__ void phase0(const Params& p, unsigned char* smem) {
    const int tid = threadIdx.x, wid = tid >> 6, lane = tid & 63;
    const int gw = blockIdx.x * 8 + wid, nw = gridDim.x * 8;
    h16* H = (h16*)(p.ws + OFF_H);
    for (int row = gw; row < BT; row += nw) {
        const f32x4* xr = (const f32x4*)(p.x + (size_t)row * DM);
        f32x4 v[8]; float ss = 0.f;
#pragma unroll
        for (int i = 0; i < 8; ++i) { v[i] = xr[lane + 64 * i]; ss += (v[i][0] * v[i][0] + v[i][1] * v[i][1]) + (v[i][2] * v[i][2] + v[i][3] * v[i][3]); }
        ss = wave_sum(ss);
        const float r = 1.0f / sqrtf(ss * (1.0f / DM) + EPS);
#pragma unroll
        for (int i = 0; i < 8; ++i) { const f32x4 g = ((const f32x4*)p.attn_g)[lane + 64 * i]; h16x4 o;
#pragma unroll
            for (int j = 0; j < 4; ++j) o[j] = (h16)(v[i][j] * r * g[j]);
            *(h16x4*)(H + (size_t)row * DM + 4 * (lane + 64 * i)) = o; }
    }
    float* tile = (float*)smem;
    h16* Wt = (h16*)(p.ws + OFF_WT);
    for (int tI = blockIdx.x; tI < 124 * 32; tI += gridDim.x) {
        const int n0 = (tI / 32) * 64, k0 = (tI % 32) * 64;
        __syncthreads();
        { const int nl = tid & 63; const int src = src_col(n0 + nl);
#pragma unroll
          for (int i = 0; i < 8; ++i) { const int kl = (tid >> 6) + 8 * i; tile[kl * 65 + nl] = src >= 0 ? p.w_in[(size_t)(k0 + kl) * IN_COLS + src] : 0.f; } }
        __syncthreads();
        { const int nl = tid >> 3, kc = tid & 7; h16x8 o;
#pragma unroll
          for (int j = 0; j < 8; ++j) o[j] = (h16)tile[(8 * kc + j) * 65 + nl];
          *(h16x8*)(Wt + (size_t)(n0 + nl) * 2048 + k0 + 8 * kc) = o; }
    }
    h16* WoT = (h16*)(p.ws + OFF_WOT);
    for (int tI = blockIdx.x; tI < 32 * 32; tI += gridDim.x) {
        const int n0 = (tI / 32) * 64, k0 = (tI % 32) * 64;
        __syncthreads();
        { const int nl = tid & 63;
#pragma unroll
          for (int i = 0; i < 8; ++i) { const int kl = (tid >> 6) + 8 * i; tile[kl * 65 + nl] = p.w_out[(size_t)(k0 + kl) * DM + n0 + nl]; } }
        __syncthreads();
        { const int nl = tid >> 3, kc = tid & 7; h16x8 o;
#pragma unroll
          for (int j = 0; j < 8; ++j) o[j] = (h16)tile[(8 * kc + j) * 65 + nl];
          *(h16x8*)(WoT + (size_t)(n0 + nl) * 2048 + k0 + 8 * kc) = o; }
    }
    __syncthreads();
    float* cosT = (float*)(p.ws + OFF_COS); float* sinT = (float*)(p.ws + OFF_SIN);
    for (int i = blockIdx.x * 512 + tid; i < BT * 24; i += gridDim.x * 512) {
        const int row = i / 24, j = i % 24;
        const float ex = (j < 16) ? (float)j * (2.0f / 32.0f) : (float)(j - 16) * (2.0f / 16.0f);
        const float inv = powf(500000.0f, -ex);
        const float ang = (float)p.pos[row] * inv;
        cosT[i] = cosf(ang); sinT[i] = sinf(ang);
    }
}

__device__ __forceinline__ void gdn_naive_task(const Params& p, unsigned char* smem, int task) {
    const int tid = threadIdx.x, wid = tid >> 6, lane = tid & 63;
    const int b = task >> 6, h = (task >> 3) & 7, eb = task & 7;
    float* stage = (float*)smem;
    const h16* qkvr = (const h16*)(p.ws + OFF_QKVR);
    const float* gb = (const float*)(p.ws + OFF_GB);
    float* oraw = (float*)(p.ws + OFF_ORAW);
    int ch = -1;
    if (tid < 128) ch = h * 128 + tid; else if (tid < 256) ch = 1024 + h * 128 + (tid - 128); else if (tid < 272) ch = 2048 + h * 128 + eb * 16 + (tid - 256);
    float w0 = 0.f, w1 = 0.f, w2 = 0.f, w3 = 0.f;
    if (ch >= 0) { w0 = p.conv_w[ch]; w1 = p.conv_w[3072 + ch]; w2 = p.conv_w[2 * 3072 + ch]; w3 = p.conv_w[3 * 3072 + ch]; }
    float x0 = 0.f, x1 = 0.f, x2 = 0.f;
    float S00 = 0.f, S01 = 0.f, S10 = 0.f, S11 = 0.f;
    const size_t rowbase = (size_t)b * NT;
    float xn = ch >= 0 ? (float)qkvr[rowbase * 3072 + ch] : 0.f;
    const int e0 = eb * 16 + 2 * wid;
    __syncthreads();
    for (int t = 0; t < NT; ++t) {
        const float x3 = xn;
        if (t + 1 < NT && ch >= 0) xn = (float)qkvr[(rowbase + t + 1) * 3072 + ch];
        float* st = stage + (t & 1) * 288;
        if (ch >= 0) { float y = w0 * x0 + w1 * x1 + w2 * x2 + w3 * x3; y = y / (1.0f + expf(-y)); st[tid] = y; x0 = x1; x1 = x2; x2 = x3; }
        const float g = gb[(rowbase + t) * 16 + h], beta = gb[(rowbase + t) * 16 + 8 + h];
        __syncthreads();
        float q0 = st[lane], q1 = st[lane + 64], k0 = st[128 + lane], k1 = st[192 + lane];
        const float ssq = wave_sum(q0 * q0 + q1 * q1), ssk = wave_sum(k0 * k0 + k1 * k1);
        const float rq = 0.08838834764831845f / sqrtf(ssq + EPS), rk = 1.0f / sqrtf(ssk + EPS);
        q0 *= rq; q1 *= rq; k0 *= rk; k1 *= rk;
        const float eg = expf(g);
        const float v0 = st[256 + 2 * wid], v1 = st[256 + 2 * wid + 1];
        S00 *= eg; S01 *= eg; S10 *= eg; S11 *= eg;
        const float r0 = wave_sum(k0 * S00 + k1 * S01), r1 = wave_sum(k0 * S10 + k1 * S11);
        const float vn0 = beta * (v0 - r0), vn1 = beta * (v1 - r1);
        S00 += k0 * vn0; S01 += k1 * vn0; S10 += k0 * vn1; S11 += k1 * vn1;
        const float o0 = wave_sum(q0 * S00 + q1 * S01), o1 = wave_sum(q0 * S10 + q1 * S11);
        if (lane == 0) { float* op = oraw + (rowbase + t) * 1024 + h * 128 + e0; op[0] = o0; op[1] = o1; }
    }
}

__device__ __forceinline__ unsigned f2key(float x) { const unsigned u = __float_as_uint(x); return (u & 0x80000000u) ? ~u : (u | 0x80000000u); }
__device__ __forceinline__ void idx_task(const Params& p, unsigned char* smem, int bt) {
    const int tid = threadIdx.x, wid = tid >> 6, lane = tid & 63;
    const int b = bt / NT, t = bt % NT, n = t + 1;
    unsigned short* sel = (unsigned short*)(p.ws + OFF_SEL) + (size_t)bt * 256;
    if (n <= 256) { if (tid < 256) sel[tid] = (unsigned short)(tid < n ? tid : 0); return; }
    float* qs = (float*)smem; float* wsm = qs + 1024; unsigned* keys = (unsigned*)(smem + 8192); unsigned* hist = keys + 4096; unsigned* misc = hist + 256;
    __syncthreads();
    { const h16* iq = (const h16*)(p.ws + OFF_IQ) + (size_t)bt * 1024; const h16x2 v = *(const h16x2*)(iq + 2 * tid); qs[2 * tid] = (float)v[0]; qs[2 * tid + 1] = (float)v[1];
      if (tid < 16) wsm[tid] = ((const float*)(p.ws + OFF_IW))[(size_t)bt * 16 + tid]; }
    __syncthreads();
    const h16* ik = (const h16*)(p.ws + OFF_IK) + (size_t)b * NT * 64;
    for (int s = tid; s < n; s += 512) {
        float kf[64];
#pragma unroll
        for (int i = 0; i < 8; ++i) { const h16x8 v = *(const h16x8*)(ik + (size_t)s * 64 + 8 * i);
#pragma unroll
            for (int j = 0; j < 8; ++j) kf[8 * i + j] = (float)v[j]; }
        float sc = 0.f;
#pragma unroll 1
        for (int hh = 0; hh < 16; ++hh) { float d = 0.f;
#pragma unroll
            for (int dd = 0; dd < 64; ++dd) d += qs[hh * 64 + dd] * kf[dd];
            sc += wsm[hh] * fmaxf(d, 0.f); }
        keys[s] = f2key(sc);
    }
    __syncthreads();
    unsigned prefix = 0, need = 256;
    for (int pass = 0; pass < 4; ++pass) {
        const int shift = 24 - 8 * pass;
        if (tid < 256) hist[tid] = 0;
        __syncthreads();
        for (int i = tid; i < n; i += 512) { const unsigned u = keys[i]; const bool part = (pass == 0) || ((u >> (shift + 8)) == (prefix >> (shift + 8))); if (part) atomicAdd(&hist[(u >> shift) & 255u], 1u); }
        __syncthreads();
        if (wid == 0) {
            const unsigned c0 = hist[4 * lane], c1 = hist[4 * lane + 1], c2 = hist[4 * lane + 2], c3 = hist[4 * lane + 3]; const unsigned s = c0 + c1 + c2 + c3;
            unsigned suf = s;
#pragma unroll
            for (int off = 1; off < 64; off <<= 1) { const unsigned tt = __shfl_down(suf, off); if (lane + off < 64) suf += tt; }
            const unsigned above = suf - s;
            if (above < need && need <= suf) {
                unsigned cum = above; int bin;
                if (cum + c3 >= need) bin = 3; else { cum += c3; if (cum + c2 >= need) bin = 2; else { cum += c2; if (cum + c1 >= need) bin = 1; else { cum += c1; bin = 0; } } }
                misc[0] = prefix | ((unsigned)(4 * lane + bin) << shift); misc[1] = need - cum;
            }
        }
        __syncthreads();
        prefix = misc[0]; need = misc[1];
    }
    const unsigned Kt = prefix, r = need;
    unsigned kk[8]; unsigned cgt = 0, ceq = 0;
#pragma unroll
    for (int j = 0; j < 8; ++j) { const int i = 8 * tid + j; const unsigned u = (i < n) ? keys[i] : 0u; kk[j] = u; if (i < n) { cgt += (u > Kt) ? 1u : 0u; ceq += (u == Kt) ? 1u : 0u; } }
    const unsigned packed = cgt | (ceq << 16);
    unsigned inc = packed;
#pragma unroll
    for (int off = 1; off < 64; off <<= 1) { const unsigned tt = __shfl_up(inc, off); if (lane >= off) inc += tt; }
    if (lane == 63) misc[8 + wid] = inc;
    __syncthreads();
    unsigned basev = 0;
    for (int w = 0; w < wid; ++w) basev += misc[8 + w];
    const unsigned exc = basev + inc - packed;
    unsigned eq_before = exc >> 16; unsigned pos = (exc & 0xFFFFu) + (eq_before < r ? eq_before : r);
#pragma unroll
    for (int j = 0; j < 8; ++j) { const int i = 8 * tid + j; if (i < n) { const unsigned u = kk[j]; const bool s = (u > Kt) || (u == Kt && eq_before < r); if (u == Kt) ++eq_before; if (s) { sel[pos] = (unsigned short)i; ++pos; } } }
}

typedef float f32x16 __attribute__((ext_vector_type(16)));
__device__ __forceinline__ float wave_min(float v) {
#pragma unroll
    for (int o = 1; o < 64; o <<= 1) v = fminf(v, __shfl_xor(v, o));
    return v;
}
__device__ __forceinline__ unsigned lane_below(unsigned long long m) { return __builtin_amdgcn_mbcnt_hi((unsigned)(m >> 32), __builtin_amdgcn_mbcnt_lo((unsigned)m, 0u)); }
__device__ __forceinline__ void idx8_task(const Params& p, unsigned char* smem, int b, int qb) {
    const int tid = threadIdx.x, wid = __builtin_amdgcn_readfirstlane(tid >> 6), lane = tid & 63;
    const int t0 = qb * 8;
    unsigned short* selg = (unsigned short*)(p.ws + OFF_SEL) + ((size_t)b * NT + t0) * 256;
    if (t0 + 8 <= 256) {
        for (int i = tid; i < 8 * 256; i += 512) { const int q = i >> 8, k = i & 255; selg[i] = (unsigned short)(k <= t0 + q ? k : 0); }
        return;
    }
    float* sc = (float*)smem;
    unsigned* hist = (unsigned*)(smem + 131072 + wid * 2048);
    unsigned* cand = hist + 256;
    __syncthreads();
    {
        const int n8 = t0 + 8;
        const int ntile = (n8 + 31) >> 5, ntile_pad = ((n8 + 255) >> 8) << 3;
        const h16* iq = (const h16*)(p.ws + OFF_IQ) + ((size_t)b * NT + t0) * 1024;
        const float* iw = (const float*)(p.ws + OFF_IW) + ((size_t)b * NT + t0) * 16;
        const h16* ik = (const h16*)(p.ws + OFF_IK) + (size_t)b * NT * 64;
        const int r = lane & 31, kh = lane >> 5, qq = (r >> 2) & 1, hh = (r & 3) + 4 * (r >> 3);
        h16x8 Af[4][4]; f32x4 Wr[4][4];
#pragma unroll
        for (int a = 0; a < 4; ++a) {
#pragma unroll
            for (int s = 0; s < 4; ++s) Af[a][s] = *(const h16x8*)(iq + (size_t)(2 * a + qq) * 1024 + hh * 64 + 16 * s + 8 * kh);
#pragma unroll
            for (int c = 0; c < 4; ++c) Wr[a][c] = *(const f32x4*)(iw + (size_t)(2 * a + kh) * 16 + 4 * c);
        }
        for (int i = wid; i < ntile_pad; i += 8) {
            const int key = 32 * i + r;
            if (i < ntile) {
                h16x8 Bf[4];
#pragma unroll
                for (int s = 0; s < 4; ++s) Bf[s] = *(const h16x8*)(ik + (size_t)key * 64 + 16 * s + 8 * kh);
#pragma unroll
                for (int a = 0; a < 4; ++a) {
                    f32x16 acc;
#pragma unroll
                    for (int e = 0; e < 16; ++e) acc[e] = 0.f;
#pragma unroll
                    for (int s = 0; s < 4; ++s) acc = __builtin_amdgcn_mfma_f32_32x32x16_f16(Af[a][s], Bf[s], acc, 0, 0, 0);
                    float s0 = 0.f;
#pragma unroll
                    for (int e = 0; e < 16; ++e) s0 += Wr[a][e >> 2][e & 3] * fmaxf(acc[e], 0.f);
                    const int q = 2 * a + kh;
                    sc[q * 4096 + key] = (key > t0 + q) ? -INFINITY : s0;
                }
            } else {
#pragma unroll
                for (int a = 0; a < 4; ++a) sc[(2 * a + kh) * 4096 + key] = -INFINITY;
            }
        }
    }
    __syncthreads();
    {
        const int tq = t0 + wid, n = tq + 1;
        const float* row = sc + wid * 4096;
        const int ng = (n + 255) >> 8;
        f32x4 x[16];
#pragma unroll
        for (int g = 0; g < 16; ++g) { if (g < ng) x[g] = *(const f32x4*)(row + 256 * g + 4 * lane); else x[g] = (f32x4){-INFINITY, -INFINITY, -INFINITY, -INFINITY}; }
        float hi = -INFINITY, lo = INFINITY;
#pragma unroll
        for (int g = 0; g < 16; ++g)
#pragma unroll
            for (int c = 0; c < 4; ++c) { const float v = x[g][c]; hi = fmaxf(hi, v); lo = fminf(lo, v == -INFINITY ? INFINITY : v); }
        hi = wave_max(hi); lo = wave_min(lo);
        const float scale = (hi > lo) ? 255.99f / (hi - lo) : 0.f; const float off = -lo * scale;
        *(u32x4*)(hist + 4 * lane) = (u32x4){0u, 0u, 0u, 0u};
#pragma unroll
        for (int g = 0; g < 16; ++g) { if (g < ng) {
#pragma unroll
            for (int c = 0; c < 4; ++c) { int bin = (int)fmaf(x[g][c], scale, off); bin = bin < 0 ? 0 : (bin > 255 ? 255 : bin); atomicAdd(&hist[bin], 1u); } } }
        unsigned bstar, need;
        {
            const u32x4 h4 = *(const u32x4*)(hist + 4 * lane); const unsigned s = h4[0] + h4[1] + h4[2] + h4[3];
            unsigned suf = s;
#pragma unroll
            for (int o = 1; o < 64; o <<= 1) { const unsigned tt = __shfl_down(suf, o); if (lane + o < 64) suf += tt; }
            const unsigned above = suf - s;
            const bool mine = (above < 256u && 256u <= suf);
            unsigned cum = above; unsigned bin = 0;
            if (cum + h4[3] >= 256u) bin = 3; else { cum += h4[3]; if (cum + h4[2] >= 256u) bin = 2; else { cum += h4[2]; if (cum + h4[1] >= 256u) bin = 1; else { cum += h4[1]; bin = 0; } } }
            const unsigned long long mm = __ballot(mine);
            const int src = (int)__builtin_ctzll(mm);
            bstar = (unsigned)__shfl((int)(4 * lane + bin), src); need = (unsigned)__shfl((int)(256u - cum), src);
        }
        unsigned m = 0;
#pragma unroll
        for (int g = 0; g < 16; ++g) { if (g < ng) {
#pragma unroll
            for (int c = 0; c < 4; ++c) { int bin = (int)fmaf(x[g][c], scale, off); bin = bin < 0 ? 0 : (bin > 255 ? 255 : bin);
                const bool pr = ((unsigned)bin == bstar); const unsigned long long mk = __ballot(pr);
                if (mk) { const unsigned pos = m + lane_below(mk); if (pr && pos < 256u) cand[pos] = f2key(x[g][c]); m += (unsigned)__builtin_popcountll(mk); } } } }
        unsigned Kt = 0, rr = need;
        if (m <= 256u) {
            const int nc = (int)((m + 63u) >> 6);
            unsigned c0 = (lane < (int)m) ? cand[lane] : 0u, c1 = (64 + lane < (int)m) ? cand[64 + lane] : 0u, c2 = (128 + lane < (int)m) ? cand[128 + lane] : 0u, c3 = (192 + lane < (int)m) ? cand[192 + lane] : 0u;
            for (int bit = 31; bit >= 0; --bit) {
                const unsigned test = (Kt | (1u << bit)) >> bit;
                unsigned cnt = (unsigned)__builtin_popcountll(__ballot((c0 >> bit) == test));
                if (nc > 1) cnt += (unsigned)__builtin_popcountll(__ballot((c1 >> bit) == test));
                if (nc > 2) cnt += (unsigned)__builtin_popcountll(__ballot((c2 >> bit) == test));
                if (nc > 3) cnt += (unsigned)__builtin_popcountll(__ballot((c3 >> bit) == test));
                if (cnt >= rr) Kt |= (1u << bit); else rr -= cnt;
            }
        } else {
            for (int bit = 31; bit >= 0; --bit) {
                const unsigned test = (Kt | (1u << bit)) >> bit; unsigned cnt = 0;
                for (int idx = lane; idx < ng * 256; idx += 64) { const float v = row[idx]; int bin = (int)fmaf(v, scale, off); bin = bin < 0 ? 0 : (bin > 255 ? 255 : bin);
                    const bool pr = ((unsigned)bin == bstar) && ((f2key(v) >> bit) == test); cnt += (unsigned)__builtin_popcountll(__ballot(pr)); }
                if (cnt >= rr) Kt |= (1u << bit); else rr -= cnt;
            }
        }
        unsigned short* so = selg + (size_t)wid * 256;
        unsigned outb = 0, eqb = 0;
#pragma unroll
        for (int g = 0; g < 16; ++g) { if (g < ng) {
#pragma unroll
            for (int c = 0; c < 4; ++c) { const unsigned k = f2key(x[g][c]); const bool gt = k > Kt; bool eq = (k == Kt);
                const unsigned long long me = __ballot(eq); bool take = gt;
                if (me) { const unsigned er = eqb + lane_below(me); take = gt || (eq && er < rr); eqb += (unsigned)__builtin_popcountll(me); }
                const unsigned long long mt = __ballot(take);
                if (mt) { const unsigned pos = outb + lane_below(mt); if (take) so[pos] = (unsigned short)(256 * g + 4 * lane + c); outb += (unsigned)__builtin_popcountll(mt); } } } }
    }
}

__device__ __forceinline__ void gdn_post(const Params& p) {
    const int tid = threadIdx.x, wid = tid >> 6, lane = tid & 63;
    const int gw = blockIdx.x * 8 + wid, nw = gridDim.x * 8;
    const float* oraw = (const float*)(p.ws + OFF_ORAW); const h16* gz = (const h16*)(p.ws + OFF_GZ); h16* omix = (h16*)(p.ws + OFF_OMIX);
    const float g0 = p.gdn_norm_g[lane], g1 = p.gdn_norm_g[lane + 64];
    for (int it = gw; it < BT * 8; it += nw) {
        const int bt = it >> 3, h = it & 7;
        const float a = oraw[(size_t)bt * 1024 + h * 128 + lane], c = oraw[(size_t)bt * 1024 + h * 128 + 64 + lane];
        const float ss = wave_sum(a * a + c * c);
        const float r = 1.0f / sqrtf(ss * (1.0f / 128.0f) + EPS);
        omix[(size_t)bt * 2048 + h * 128 + lane] = (h16)(a * r * g0 * (float)gz[(size_t)bt * 1024 + h * 128 + lane]);
        omix[(size_t)bt * 2048 + h * 128 + 64 + lane] = (h16)(c * r * g1 * (float)gz[(size_t)bt * 1024 + h * 128 + 64 + lane]);
    }
}

__device__ __forceinline__ void attn_naive_task(const Params& p, unsigned char* smem, int bt) {
    const int tid = threadIdx.x, wid = tid >> 6, lane = tid & 63;
    const int b = bt / NT, t = bt % NT; const int nvalid = (t + 1) < 256 ? (t + 1) : 256;
    float* qs = (float*)smem; float* lg = qs + 1024; unsigned short* sl = (unsigned short*)(lg + 2048);
    const h16* aq = (const h16*)(p.ws + OFF_AQ); const h16* ak = (const h16*)(p.ws + OFF_AK); const h16* av = (const h16*)(p.ws + OFF_AV);
    const h16* az = (const h16*)(p.ws + OFF_AZ); h16* omix = (h16*)(p.ws + OFF_OMIX);
    __syncthreads();
    { const h16x2 v = *(const h16x2*)(aq + (size_t)bt * 1024 + 2 * tid); qs[2 * tid] = (float)v[0]; qs[2 * tid + 1] = (float)v[1];
      if (tid < 256) sl[tid] = ((const unsigned short*)(p.ws + OFF_SEL))[(size_t)bt * 256 + tid]; }
    __syncthreads();
    { const int kk = tid & 255, g = tid >> 8; const int key = sl[kk];
      const h16* kr = ak + ((size_t)b * NT + key) * 256 + g * 128;
      float d0 = 0.f, d1 = 0.f, d2 = 0.f, d3 = 0.f; const float* q = qs + (4 * g) * 128;
#pragma unroll 4
      for (int i = 0; i < 16; ++i) { const h16x8 v = *(const h16x8*)(kr + 8 * i);
#pragma unroll
          for (int j = 0; j < 8; ++j) { const float kv = (float)v[j]; d0 += q[8 * i + j] * kv; d1 += q[128 + 8 * i + j] * kv; d2 += q[256 + 8 * i + j] * kv; d3 += q[384 + 8 * i + j] * kv; } }
      const bool valid = kk < nvalid;
      lg[(4 * g + 0) * 256 + kk] = valid ? d0 : -INFINITY; lg[(4 * g + 1) * 256 + kk] = valid ? d1 : -INFINITY;
      lg[(4 * g + 2) * 256 + kk] = valid ? d2 : -INFINITY; lg[(4 * g + 3) * 256 + kk] = valid ? d3 : -INFINITY; }
    __syncthreads();
    { float* L = lg + wid * 256; const float a0 = L[lane], a1 = L[lane + 64], a2 = L[lane + 128], a3 = L[lane + 192];
      const float m = wave_max(fmaxf(fmaxf(a0, a1), fmaxf(a2, a3)));
      const float e0 = expf(a0 - m), e1 = expf(a1 - m), e2 = expf(a2 - m), e3 = expf(a3 - m);
      const float inv = 1.0f / wave_sum((e0 + e1) + (e2 + e3));
      L[lane] = e0 * inv; L[lane + 64] = e1 * inv; L[lane + 128] = e2 * inv; L[lane + 192] = e3 * inv; }
    __syncthreads();
    { const int h = wid, g = h >> 2; float o0 = 0.f, o1 = 0.f; const float* P = lg + h * 256;
      for (int kk = 0; kk < nvalid; ++kk) { const int key = sl[kk]; const h16x2 v = *(const h16x2*)(av + ((size_t)b * NT + key) * 256 + g * 128 + 2 * lane); const float pk = P[kk]; o0 += pk * (float)v[0]; o1 += pk * (float)v[1]; }
      const h16x2 gt = *(const h16x2*)(az + (size_t)bt * 1024 + h * 128 + 2 * lane);
      h16x2 o; o[0] = (h16)(o0 * (float)gt[0]); o[1] = (h16)(o1 * (float)gt[1]);
      *(h16x2*)(omix + (size_t)bt * 2048 + 1024 + h * 128 + 2 * lane) = o; }
}

__device__ __forceinline__ void phase5(const Params& p) {
    const int tid = threadIdx.x, wid = tid >> 6, lane = tid & 63;
    const int gw = blockIdx.x * 8 + wid, nw = gridDim.x * 8;
    const float* rowss = (const float*)(p.ws + OFF_ROWSS);
    for (int row = gw; row < BT; row += nw) {
        const float r = 1.0f / sqrtf(rowss[row] * (1.0f / DM) + EPS);
        f32x4* o = (f32x4*)(p.out + (size_t)row * DM);
#pragma unroll
        for (int i = 0; i < 8; ++i) { const f32x4 g = ((const f32x4*)p.final_g)[lane + 64 * i]; f32x4 v = o[lane + 64 * i]; v = v * r * g; o[lane + 64 * i] = v; }
    }
}

template <int LO, int HI>
__global__ void __launch_bounds__(512, 2) k_phases(Params p) {
    extern __shared__ __attribute__((aligned(16))) unsigned char smem[];
#define IN(k) (LO <= (k) && (k) < HI)
#define SEAM(k) do { if constexpr (IN(k) && IN((k) + 1)) { cg::this_grid().sync(); } } while (0)
    if constexpr (IN(0)) { phase0(p, smem); }
    SEAM(0);
    if constexpr (IN(1)) {
        pg8::Gemm g{(const h16*)(p.ws + OFF_H), (const h16*)(p.ws + OFF_WT), BT, NPAD, DM};
        pg8::StaticOrder S; S.init(BT, NPAD, gridDim.x, blockIdx.x);
        EpiIn E{p.ws, p.a_log, p.dt_bias};
        pg8::gemm_phase<EpiIn, pg8::StaticOrder>((LAS unsigned char*)smem, g, S, E);
    }
    SEAM(1);
    if constexpr (IN(2)) {
        for (int task = blockIdx.x; task < 256; task += gridDim.x) gdn_naive_task(p, smem, task);
        __syncthreads();
        {
            unsigned* qctr = (unsigned*)(p.ws + OFF_CTRL);
            unsigned* lds_t = (unsigned*)(smem + LDS_BYTES - 16);
            for (;;) {
                __syncthreads();
                if (threadIdx.x == 0) lds_t[0] = atomicAdd(qctr + 0, 1u);
                __syncthreads();
                const unsigned o = lds_t[0];
                if (o >= 2048u) break;
                idx8_task(p, smem, (int)(o & 3u), 511 - (int)(o >> 2));
            }
        }
    }
    SEAM(2);
    if constexpr (IN(3)) {
        gdn_post(p);
        for (int bt = blockIdx.x; bt < BT; bt += gridDim.x) attn_naive_task(p, smem, bt);
    }
    SEAM(3);
    if constexpr (IN(4)) {
        pg8::Gemm g{(const h16*)(p.ws + OFF_OMIX), (const h16*)(p.ws + OFF_WOT), BT, DM, DM};
        pg8::StaticOrder S; S.init(BT, DM, gridDim.x, blockIdx.x);
        EpiOut E{p.x, p.out, (float*)(p.ws + OFF_ROWSS)};
        pg8::gemm_phase<EpiOut, pg8::StaticOrder>((LAS unsigned char*)smem, g, S, E);
    }
    SEAM(4);
    if constexpr (IN(5)) { phase5(p); }
#undef IN
#undef SEAM
}

template <int LO, int HI> static void launch_range(const Params& p, int grid, hipStream_t stream, bool coop) {
    static bool attr = false;
    if (!attr) { hipFuncSetAttribute((const void*)k_phases<LO, HI>, hipFuncAttributeMaxDynamicSharedMemorySize, LDS_BYTES); attr = true; }
    if (coop) {
        Params pp = p; void* args[] = {&pp};
        hipError_t e = hipLaunchCooperativeKernel((const void*)k_phases<LO, HI>, dim3(grid), dim3(512), args, LDS_BYTES, stream);
        if (e != hipSuccess) fprintf(stderr, "cooperative launch failed: %s (grid %d)\n", hipGetErrorString(e), grid);
    } else {
        hipLaunchKernelGGL((k_phases<LO, HI>), dim3(grid), dim3(512), LDS_BYTES, stream, p);
    }
}

extern "C" void kernel_launch(void* const* d_in, const int* in_sizes, int n_in, void* d_out, int out_size, void* d_ws, size_t ws_size, hipStream_t stream) {
    if (n_in != 10 || in_sizes[0] != BT * DM || out_size != BT * DM || ws_size < WS_END) {
        fprintf(stderr, "kernel_launch: unexpected shapes (n_in %d in0 %d out %d ws %zu need %zu)\n", n_in, n_in > 0 ? in_sizes[0] : -1, out_size, ws_size, (size_t)WS_END); return; }
    static int grid = 0;
    if (!grid) {
        int dev = 0, cus = 0, per_cu = 0; hipGetDevice(&dev); hipDeviceGetAttribute(&cus, hipDeviceAttributeMultiprocessorCount, dev);
#if FUSED
        hipFuncSetAttribute((const void*)k_phases<0, 6>, hipFuncAttributeMaxDynamicSharedMemorySize, LDS_BYTES);
        hipOccupancyMaxActiveBlocksPerMultiprocessor(&per_cu, (const void*)k_phases<0, 6>, 512, LDS_BYTES);
#else
        per_cu = 1;
#endif
        if (per_cu < 1) per_cu = 1; if (per_cu > 1) per_cu = 1;
        grid = cus * per_cu;
    }
    Params p{};
    p.x = (const float*)d_in[0]; p.pos = (const int*)d_in[1]; p.attn_g = (const float*)d_in[2]; p.w_in = (const float*)d_in[3]; p.conv_w = (const float*)d_in[4];
    p.a_log = (const float*)d_in[5]; p.dt_bias = (const float*)d_in[6]; p.gdn_norm_g = (const float*)d_in[7]; p.w_out = (const float*)d_in[8]; p.final_g = (const float*)d_in[9];
    p.out = (float*)d_out; p.ws = (unsigned char*)d_ws;
    hipMemsetAsync((char*)d_ws + OFF_CTRL, 0, CTL_ZERO_BYTES, stream);
#if FUSED
    launch_range<0, 6>(p, grid, stream, true);
#else
    launch_range<0, 1>(p, grid, stream, false);
    launch_range<1, 2>(p, grid, stream, false);
    launch_range<2, 3>(p, grid, stream, false);
    launch_range<3, 4>(p, grid, stream, false);
    launch_range<4, 5>(p, grid, stream, false);
    launch_range<5, 6>(p, grid, stream, false);
#endif
}
```

```cpp
#include <hip/hip_runtime.h>
#include <hip/hip_cooperative_groups.h>
#include <cstdio>
#include <cstdint>
namespace cg = cooperative_groups;

#ifndef FUSED
#define FUSED 1
#endif

#define LAS __attribute__((address_space(3)))
typedef _Float16 h16;
typedef h16 h16x8 __attribute__((ext_vector_type(8)));
typedef h16 h16x4 __attribute__((ext_vector_type(4)));
typedef h16 h16x2 __attribute__((ext_vector_type(2)));
typedef float f32x4 __attribute__((ext_vector_type(4)));
typedef float f32x2 __attribute__((ext_vector_type(2)));
typedef unsigned u32x4 __attribute__((ext_vector_type(4)));

constexpr int NB = 4, NT = 4096, DM = 2048, BT = NB * NT;
constexpr int IN_COLS = 7776, NPAD = 7936;
constexpr float EPS = 1e-6f;
constexpr int LDS_BYTES = 155648;

constexpr size_t MB = 1024 * 1024;
constexpr size_t OFF_CTRL = 0;
constexpr size_t OFF_ROWSS = 65536;
constexpr size_t CTL_ZERO_BYTES = 65536 + (size_t)BT * 4;
constexpr size_t OFF_H = 1 * MB;
constexpr size_t OFF_OMIX = OFF_H;
constexpr size_t OFF_WT = OFF_H + 64 * MB;
constexpr size_t OFF_WOT = OFF_WT + (size_t)NPAD * 2048 * 2;
constexpr size_t OFF_QKVR = OFF_WOT + 8 * MB;
constexpr size_t OFF_GZ = OFF_QKVR + (size_t)BT * 3072 * 2;
constexpr size_t OFF_AQ = OFF_GZ + 32 * MB;
constexpr size_t OFF_AK = OFF_AQ + 32 * MB;
constexpr size_t OFF_AV = OFF_AK + 8 * MB;
constexpr size_t OFF_AZ = OFF_AV + 8 * MB;
constexpr size_t OFF_IQ = OFF_AZ + 32 * MB;
constexpr size_t OFF_IK = OFF_IQ + 32 * MB;
constexpr size_t OFF_GB = OFF_IK + 2 * MB;
constexpr size_t OFF_IW = OFF_GB + 1 * MB;
constexpr size_t OFF_COS = OFF_IW + 1 * MB;
constexpr size_t OFF_SIN = OFF_COS + 2 * MB;
constexpr size_t OFF_SEL = OFF_SIN + 2 * MB;
constexpr size_t OFF_REC = OFF_SEL + 8 * MB;
constexpr size_t WS_END = OFF_REC + (size_t)2048 * 74752;

struct Params {
    const float* x; const int* pos; const float* attn_g; const float* w_in; const float* conv_w; const float* a_log;
    const float* dt_bias; const float* gdn_norm_g; const float* w_out; const float* final_g; float* out; unsigned char* ws;
};

__device__ __forceinline__ float wave_sum(float v) {
#pragma unroll
    for (int o = 1; o < 64; o <<= 1) v += __shfl_xor(v, o);
    return v;
}
__device__ __forceinline__ float wave_max(float v) {
#pragma unroll
    for (int o = 1; o < 64; o <<= 1) v = fmaxf(v, __shfl_xor(v, o));
    return v;
}
__device__ __forceinline__ int opaque_tid() { int t = threadIdx.x; asm volatile("" : "+v"(t)); return t; }
__device__ __forceinline__ float silu_f(float x) { return x / (1.0f + __expf(-x)); }

namespace pg8 {
constexpr int BM = 256, BK = 64, HALF = 128, HTB = HALF * BK * 2, STAGE_BYTES = 8 * HTB, NXCD = 8, WGM = 8;
__host__ __device__ __forceinline__ int lds_byte(int r, int c) { const int st = (r >> 4) * 2 + (c >> 5), rr = r & 15, cc = c & 31, ob = rr * 64 + cc * 2; return st * 1024 + (ob ^ (((ob >> 9) & 1) << 5)); }
__host__ __device__ __forceinline__ void stage_rc(int b, int& R, int& C) { const int st = b / 1024, sb = b % 1024, swz = sb ^ (((sb >> 9) & 1) << 5); R = (st >> 1) * 16 + swz / 64; C = (st & 1) * 32 + (swz % 64) / 2; }
__host__ __device__ __forceinline__ int perm32(int rho) { const int n = rho >> 4, i = rho & 15; return 8 * (i >> 2) + 4 * n + (i & 3); }
struct Unit { int pm, pn; };
struct Gemm { const h16* A; const h16* Bt; int M, N, K; };
struct StaticOrder {
    int nM, nN, nwg, G, c;
    __host__ __device__ void init(int M, int N, int G_, int c_) { nM = M / BM; nN = N / BM; nwg = nM * nN; G = G_; c = c_; }
    __host__ __device__ bool next(int i, Unit& u) const {
        const long L = (long)i * G + c; if (L >= nwg) return false;
        int wgid = (int)L; { const int q = nwg / NXCD, r = nwg % NXCD, xcd = wgid % NXCD, off = wgid / NXCD; wgid = (xcd < r ? xcd * (q + 1) : r * (q + 1) + (xcd - r) * q) + off; }
        const int nig = WGM * nN, gid = wgid / nig, fm = gid * WGM, gsz = (nM - fm) < WGM ? (nM - fm) : WGM;
        u.pm = fm + ((wgid % nig) % gsz); u.pn = (wgid % nig) / gsz; return true;
    }
    __device__ __forceinline__ void a_ready(const Unit&) const {}
    __device__ __forceinline__ void done(const Unit&) const {}
};

template <class Epi, class Sched>
__device__ __forceinline__ void gemm_phase(LAS unsigned char* lds, const Gemm g, const Sched& S, const Epi& E) {
    const int tid = threadIdx.x, wid = __builtin_amdgcn_readfirstlane(tid >> 6), lane = tid & 63, wr = wid >> 2, wc = wid & 3, fr = lane & 15, fq = lane >> 4;
    const int K = g.K, nt = K / BK;
    unsigned voffA[2], voffB[2];
#pragma unroll
    for (int i = 0; i < 2; ++i) { int R, C; stage_rc(tid * 16 + i * 8192, R, C); const int Rb = Epi::PERM ? ((R & ~31) + perm32(R & 31)) : R;
        voffA[i] = (unsigned)(R * K + C) * 2u; voffB[i] = (unsigned)(Rb * K + C) * 2u; }
    const size_t kstep = (size_t)(BK * 2);
    const size_t hstep = (size_t)HALF * K * 2;
    const size_t tstep = 2 * hstep;
    const unsigned ldsw = (unsigned)wid * 1024u;
    const int aoff = lds_byte(wr * 64 + fr, fq * 8), boff = lds_byte(wc * 32 + fr, fq * 8);
#define PG8_SA(b, h) (((b) * 2 + (h)) * HTB)
#define PG8_SB(b, h) ((4 + (b) * 2 + (h)) * HTB)
#define PG8_STAGE(bufoff, gbase, voff) do { _Pragma("unroll") for (int _i = 0; _i < 2; ++_i) \
        __builtin_amdgcn_global_load_lds((const unsigned*)((const char*)(gbase) + (voff)[_i]), (LAS unsigned*)(lds + (bufoff) + ldsw + _i * 8192), 16, 0, 0); } while (0)
#define PG8_LDA(dst, b, h) do { _Pragma("unroll") for (int m = 0; m < 4; ++m) _Pragma("unroll") for (int k = 0; k < 2; ++k) dst[m][k] = *(const LAS h16x8*)(lds + PG8_SA(b, h) + aoff + m * 2048 + k * 1024); } while (0)
#define PG8_LDB(dst, b, h) do { _Pragma("unroll") for (int n = 0; n < 2; ++n) _Pragma("unroll") for (int k = 0; k < 2; ++k) dst[n][k] = *(const LAS h16x8*)(lds + PG8_SB(b, h) + boff + n * 2048 + k * 1024); } while (0)
#define PG8_MMA(ai, bj, At, Bt) do { __builtin_amdgcn_s_setprio(1); _Pragma("unroll") for (int m = 0; m < 4; ++m) _Pragma("unroll") for (int n = 0; n < 2; ++n) _Pragma("unroll") for (int k = 0; k < 2; ++k) \
        acc[ai][bj][m][n] = __builtin_amdgcn_mfma_f32_16x16x32_f16(Bt[n][k], At[m][k], acc[ai][bj][m][n], 0, 0, 0); __builtin_amdgcn_s_setprio(0); } while (0)
#define PG8_WAIT_V(n) asm volatile("s_waitcnt vmcnt(" #n ")" ::: "memory")
#define PG8_WAIT_L(n) asm volatile("s_waitcnt lgkmcnt(" #n ")" ::: "memory")
#define PG8_BAR __builtin_amdgcn_s_barrier()
#define PG8_SCHED __builtin_amdgcn_sched_barrier(0)
    Unit cur, nxt; int ui = 0;
    if (!S.next(0, cur)) return;
    f32x4 acc[2][2][4][2];
#pragma unroll
    for (int a = 0; a < 2; ++a)
#pragma unroll
        for (int b = 0; b < 2; ++b)
#pragma unroll
            for (int m = 0; m < 4; ++m)
#pragma unroll
                for (int n = 0; n < 2; ++n) acc[a][b][m][n] = (f32x4){0.f, 0.f, 0.f, 0.f};
    h16x8 At[4][2], B0[2][2], B1[2][2];
    const char* cA = (const char*)g.A + (size_t)cur.pm * tstep; const char* cB = (const char*)g.Bt + (size_t)cur.pn * tstep;
    S.a_ready(cur);
    PG8_STAGE(PG8_SB(0, 0), cB, voffB); PG8_STAGE(PG8_SA(0, 0), cA, voffA); PG8_STAGE(PG8_SB(0, 1), cB + hstep, voffB); PG8_STAGE(PG8_SA(0, 1), cA + hstep, voffA);
    if (wr == 1) PG8_BAR;
    PG8_WAIT_V(4); PG8_BAR;
    PG8_STAGE(PG8_SB(1, 0), cB + kstep, voffB); PG8_STAGE(PG8_SA(1, 0), cA + kstep, voffA); PG8_STAGE(PG8_SB(1, 1), cB + hstep + kstep, voffB);
    PG8_WAIT_V(6); PG8_BAR;
    for (;;) {
        const bool has_next = S.next(ui + 1, nxt);
        const char* nA = has_next ? (const char*)g.A + (size_t)nxt.pm * tstep : cA; const char* nB = has_next ? (const char*)g.Bt + (size_t)nxt.pn * tstep : cB;
        for (int t = 0; t < nt; t += 2) {
            const bool last = (t == nt - 2);
            const char* a1 = cA + (size_t)(t + 1) * kstep;
            const char* a2 = last ? nA : cA + (size_t)(t + 2) * kstep; const char* b2 = last ? nB : cB + (size_t)(t + 2) * kstep;
            const char* a3 = a2 + kstep; const char* b3 = b2 + kstep;
            if (last && has_next) S.a_ready(nxt);
            PG8_LDB(B0, 0, 0); PG8_SCHED; PG8_LDA(At, 0, 0); PG8_STAGE(PG8_SA(1, 1), a1 + hstep, voffA);
            PG8_WAIT_L(8); PG8_BAR; PG8_WAIT_L(0); PG8_MMA(0, 0, At, B0); PG8_BAR; PG8_SCHED;
            PG8_LDB(B1, 0, 1); PG8_STAGE(PG8_SB(0, 0), b2, voffB);
            PG8_BAR; PG8_WAIT_L(0); PG8_MMA(0, 1, At, B1); PG8_BAR;
            PG8_LDA(At, 0, 1); PG8_STAGE(PG8_SA(0, 0), a2, voffA);
            PG8_BAR; PG8_WAIT_L(0); PG8_MMA(1, 0, At, B0); PG8_BAR; PG8_SCHED;
            PG8_STAGE(PG8_SB(0, 1), b2 + hstep, voffB);
            PG8_WAIT_V(6); PG8_BAR; PG8_MMA(1, 1, At, B1); PG8_BAR;
            PG8_LDB(B0, 1, 0); PG8_SCHED; PG8_LDA(At, 1, 0); PG8_STAGE(PG8_SA(0, 1), a2 + hstep, voffA);
            PG8_WAIT_L(8); PG8_BAR; PG8_WAIT_L(0); PG8_MMA(0, 0, At, B0); PG8_BAR; PG8_SCHED;
            PG8_LDB(B1, 1, 1); PG8_STAGE(PG8_SB(1, 0), b3, voffB);
            PG8_BAR; PG8_WAIT_L(0); PG8_MMA(0, 1, At, B1); PG8_BAR;
            PG8_LDA(At, 1, 1); PG8_STAGE(PG8_SA(1, 0), a3, voffA);
            PG8_BAR; PG8_WAIT_L(0); PG8_MMA(1, 0, At, B0); PG8_BAR; PG8_SCHED;
            PG8_STAGE(PG8_SB(1, 1), b3 + hstep, voffB);
            PG8_WAIT_V(6); PG8_BAR; PG8_MMA(1, 1, At, B1); PG8_BAR;
        }
        E(acc, cur, wr, wc, fr, fq); S.done(cur);
        if (!has_next) break;
#pragma unroll
        for (int a = 0; a < 2; ++a)
#pragma unroll
            for (int b = 0; b < 2; ++b)
#pragma unroll
                for (int m = 0; m < 4; ++m)
#pragma unroll
                    for (int n = 0; n < 2; ++n) acc[a][b][m][n] = (f32x4){0.f, 0.f, 0.f, 0.f};
        cur = nxt; cA = nA; cB = nB; ++ui;
    }
    PG8_WAIT_V(0);
    if (wr == 0) PG8_BAR;
    PG8_BAR;
#undef PG8_SA
#undef PG8_SB
#undef PG8_STAGE
#undef PG8_LDA
#undef PG8_LDB
#undef PG8_MMA
#undef PG8_WAIT_V
#undef PG8_WAIT_L
#undef PG8_BAR
#undef PG8_SCHED
}
}

struct EpiIn {
    static constexpr bool PERM = true;
    unsigned char* ws; const float* a_log; const float* dt_bias;
    __device__ __forceinline__ void operator()(const f32x4 (&acc)[2][2][4][2], const pg8::Unit& u, int wr, int wc, int fr, int fq) const {
        const int pn = u.pn;
        const int rowb = u.pm * 256 + wr * 64 + fr;
        const int cw = wc * 32 + 8 * fq;
        const float* cosT = (const float*)(ws + OFF_COS); const float* sinT = (const float*)(ws + OFF_SIN);
        if (pn < 30) {
            h16* base; int ldc, colt, mode; float scale = 1.f;
            if (pn < 12) { base = (h16*)(ws + OFF_QKVR); ldc = 3072; colt = pn * 256; mode = 0; }
            else if (pn < 16) { base = (h16*)(ws + OFF_GZ); ldc = 1024; colt = (pn - 12) * 256; mode = 1; }
            else if (pn < 20) { base = (h16*)(ws + OFF_AQ); ldc = 1024; colt = (pn - 16) * 256; mode = 2; scale = 0.08838834764831845f; }
            else if (pn == 20) { base = (h16*)(ws + OFF_AK); ldc = 256; colt = 0; mode = 2; }
            else if (pn == 21) { base = (h16*)(ws + OFF_AV); ldc = 256; colt = 0; mode = 0; }
            else if (pn < 26) { base = (h16*)(ws + OFF_AZ); ldc = 1024; colt = (pn - 22) * 256; mode = 1; }
            else { base = (h16*)(ws + OFF_IQ); ldc = 1024; colt = (pn - 26) * 256; mode = 3; }
            const bool rot_wave = (mode == 2 && wc == 0) || (mode == 3 && (wc & 1) == 0);
            const int xm = (mode == 2) ? 32 : 16;
            const bool rot_lane = (mode == 2) ? true : (fq < 2);
            const float sgn = (mode == 2) ? (fq < 2 ? -1.f : 1.f) : (fq == 0 ? -1.f : 1.f);
            const int tix = (mode == 2) ? 8 * (fq & 1) : 16;
#pragma unroll
            for (int ai = 0; ai < 2; ++ai)
#pragma unroll
                for (int m = 0; m < 4; ++m) {
                    const int row = rowb + ai * 128 + m * 16;
                    float cs[8], sn[8];
                    if (rot_wave) {
                        const f32x4 c0 = *(const f32x4*)(cosT + (size_t)row * 24 + tix), c1 = *(const f32x4*)(cosT + (size_t)row * 24 + tix + 4);
                        const f32x4 s0 = *(const f32x4*)(sinT + (size_t)row * 24 + tix), s1 = *(const f32x4*)(sinT + (size_t)row * 24 + tix + 4);
#pragma unroll
                        for (int j = 0; j < 4; ++j) { cs[j] = c0[j]; cs[4 + j] = c1[j]; sn[j] = s0[j]; sn[4 + j] = s1[j]; }
                    }
#pragma unroll
                    for (int bj = 0; bj < 2; ++bj) {
                        float v[8];
#pragma unroll
                        for (int j = 0; j < 4; ++j) { v[j] = acc[ai][bj][m][0][j]; v[4 + j] = acc[ai][bj][m][1][j]; }
                        if (rot_wave) {
#pragma unroll
                            for (int j = 0; j < 8; ++j) { const float pv = __shfl_xor(v[j], xm); if (rot_lane) v[j] = v[j] * cs[j] + sgn * pv * sn[j]; }
                        }
                        if (mode == 1) {
#pragma unroll
                            for (int j = 0; j < 8; ++j) v[j] = silu_f(v[j]);
                        }
                        h16x8 o;
#pragma unroll
                        for (int j = 0; j < 8; ++j) o[j] = (h16)(v[j] * scale);
                        *(h16x8*)(base + (size_t)row * ldc + colt + bj * 128 + cw) = o;
                    }
                }
        } else {
            h16* ik = (h16*)(ws + OFF_IK); float* gb = (float*)(ws + OFF_GB); float* iw = (float*)(ws + OFF_IW);
#pragma unroll
            for (int ai = 0; ai < 2; ++ai)
#pragma unroll
                for (int m = 0; m < 4; ++m) {
                    const int row = rowb + ai * 128 + m * 16;
                    float v[8];
#pragma unroll
                    for (int j = 0; j < 4; ++j) { v[j] = acc[ai][0][m][0][j]; v[4 + j] = acc[ai][0][m][1][j]; }
                    if (wc == 0) {
                        const f32x4 c0 = *(const f32x4*)(cosT + (size_t)row * 24 + 16), c1 = *(const f32x4*)(cosT + (size_t)row * 24 + 20);
                        const f32x4 s0 = *(const f32x4*)(sinT + (size_t)row * 24 + 16), s1 = *(const f32x4*)(sinT + (size_t)row * 24 + 20);
                        const float sgn = (fq == 0 ? -1.f : 1.f);
#pragma unroll
                        for (int j = 0; j < 8; ++j) { const float pv = __shfl_xor(v[j], 16); const float c = j < 4 ? c0[j & 3] : c1[j & 3], s = j < 4 ? s0[j & 3] : s1[j & 3];
                            if (fq < 2) v[j] = v[j] * c + sgn * pv * s; }
                    }
                    if (wc < 2) {
                        h16x8 o;
#pragma unroll
                        for (int j = 0; j < 8; ++j) o[j] = (h16)v[j];
                        *(h16x8*)(ik + (size_t)row * 64 + cw) = o;
                    } else if (wc == 2) {
                        if (fq == 0) {
#pragma unroll
                            for (int j = 0; j < 8; ++j) { const float z = v[j] + dt_bias[j]; const float sp = z > 20.f ? z : log1pf(expf(z)); gb[(size_t)row * 16 + j] = -expf(a_log[j]) * sp; }
                        } else if (fq == 1) {
#pragma unroll
                            for (int j = 0; j < 8; ++j) gb[(size_t)row * 16 + 8 + j] = 1.0f / (1.0f + expf(-v[j]));
                        } else {
#pragma unroll
                            for (int j = 0; j < 8; ++j) iw[(size_t)row * 16 + 8 * (fq - 2) + j] = v[j] * 0.03125f;
                        }
                    }
                }
        }
    }
};

struct EpiOut {
    static constexpr bool PERM = false;
    const float* x; float* out; float* rowss;
    __device__ __forceinline__ void operator()(const f32x4 (&acc)[2][2][4][2], const pg8::Unit& u, int wr, int wc, int fr, int fq) const {
        const int rowb = u.pm * 256 + wr * 64 + fr, col0 = u.pn * 256 + wc * 32 + 4 * fq;
#pragma unroll
        for (int ai = 0; ai < 2; ++ai)
#pragma unroll
            for (int m = 0; m < 4; ++m) {
                const int row = rowb + ai * 128 + m * 16; float ss = 0.f;
#pragma unroll
                for (int bj = 0; bj < 2; ++bj)
#pragma unroll
                    for (int n = 0; n < 2; ++n) {
                        const size_t off = (size_t)row * DM + col0 + bj * 128 + n * 16;
                        const f32x4 y = *(const f32x4*)(x + off) + acc[ai][bj][m][n];
                        *(f32x4*)(out + off) = y; ss += (y[0] * y[0] + y[1] * y[1]) + (y[2] * y[2] + y[3] * y[3]);
                    }
                ss += __shfl_xor(ss, 16); ss += __shfl_xor(ss, 32);
                if (fq == 0) atomicAdd(rowss + row, ss);
            }
    }
};

__device__ __forceinline__ int src_col(int np) {
    if (np < 4096) return np;
    if (np < 7680) return np + 16;
    if (np < 7744) return 7696 + (np - 7680);
    if (np < 7752) return 4096 + (np - 7744);
    if (np < 7760) return 4104 + (np - 7752);
    if (np < 7776) return np;
    return -1;
}
__device__ __forceinline__ void phase0(const Params& p, unsigned char* smem) {
    const int tid = threadIdx.x, wid = tid >> 6, lane = tid & 63;
    const int gw = blockIdx.x * 8 + wid, nw = gridDim.x * 8;
    h16* H = (h16*)(p.ws + OFF_H);
    for (int row = gw; row < BT; row += nw) {
        const f32x4* xr = (const f32x4*)(p.x + (size_t)row * DM);
        f32x4 v[8]; float ss = 0.f;
#pragma unroll
        for (int i = 0; i < 8; ++i) { v[i] = xr[lane + 64 * i]; ss += (v[i][0] * v[i][0] + v[i][1] * v[i][1]) + (v[i][2] * v[i][2] + v[i][3] * v[i][3]); }
        ss = wave_sum(ss);
        const float r = 1.0f / sqrtf(ss * (1.0f / DM) + EPS);
#pragma unroll
        for (int i = 0; i < 8; ++i) { const f32x4 g = ((const f32x4*)p.attn_g)[lane + 64 * i]; h16x4 o;
#pragma unroll
            for (int j = 0; j < 4; ++j) o[j] = (h16)(v[i][j] * r * g[j]);
            *(h16x4*)(H + (size_t)row * DM + 4 * (lane + 64 * i)) = o; }
    }
    float* tile = (float*)smem;
    h16* Wt = (h16*)(p.ws + OFF_WT);
    for (int tI = blockIdx.x; tI < 124 * 32; tI += gridDim.x) {
        const int n0 = (tI / 32) * 64, k0 = (tI % 32) * 64;
        __syncthreads();
        { const int nl = tid & 63; const int src = src_col(n0 + nl);
#pragma unroll
          for (int i = 0; i < 8; ++i) { const int kl = (tid >> 6) + 8 * i; tile[kl * 65 + nl] = src >= 0 ? p.w_in[(size_t)(k0 + kl) * IN_COLS + src] : 0.f; } }
        __syncthreads();
        { const int nl = tid >> 3, kc = tid & 7; h16x8 o;
#pragma unroll
          for (int j = 0; j < 8; ++j) o[j] = (h16)tile[(8 * kc + j) * 65 + nl];
          *(h16x8*)(Wt + (size_t)(n0 + nl) * 2048 + k0 + 8 * kc) = o; }
    }
    h16* WoT = (h16*)(p.ws + OFF_WOT);
    for (int tI = blockIdx.x; tI < 32 * 32; tI += gridDim.x) {
        const int n0 = (tI / 32) * 64, k0 = (tI % 32) * 64;
        __syncthreads();
        { const int nl = tid & 63;
#pragma unroll
          for (int i = 0; i < 8; ++i) { const int kl = (tid >> 6) + 8 * i; tile[kl * 65 + nl] = p.w_out[(size_t)(k0 + kl) * DM + n0 + nl]; } }
        __syncthreads();
        { const int nl = tid >> 3, kc = tid & 7; h16x8 o;
#pragma unroll
          for (int j = 0; j < 8; ++j) o[j] = (h16)tile[(8 * kc + j) * 65 + nl];
          *(h16x8*)(WoT + (size_t)(n0 + nl) * 2048 + k0 + 8 * kc) = o; }
    }
    __syncthreads();
    float* cosT = (float*)(p.ws + OFF_COS); float* sinT = (float*)(p.ws + OFF_SIN);
    for (int i = blockIdx.x * 512 + tid; i < BT * 24; i += gridDim.x * 512) {
        const int row = i / 24, j = i % 24;
        const float ex = (j < 16) ? (float)j * (2.0f / 32.0f) : (float)(j - 16) * (2.0f / 16.0f);
        const float inv = powf(500000.0f, -ex);
        const float ang = (float)p.pos[row] * inv;
        cosT[i] = cosf(ang); sinT[i] = sinf(ang);
    }
}

constexpr int REC_BYTES = 74752, REC_WF = 0, REC_QF = 16384, REC_AF = 32768, REC_KTF = 40960, REC_UF = 57344, REC_VEC = 73728;
constexpr int HB_BYTES = 69632;

__device__ __forceinline__ void gdn_prep_pair(const Params& p, unsigned char* smem, int pair) {
    const int tid = opaque_tid(), wid = __builtin_amdgcn_readfirstlane(tid >> 6), lane = tid & 63, hb = wid >> 2, w4 = wid & 3, tl = tid & 255;
    const int tk = 2 * pair + hb; const int b = tk >> 9, h = (tk >> 6) & 7, n = tk & 63; const int t0 = n * 64;
    unsigned char* base = smem + hb * HB_BYTES;
    h16* Kn = (h16*)base; h16* Qn = Kn + 64 * 136; h16* Vh = Qn + 64 * 136; float* L = (float*)(Vh + 64 * 136); float* vec = L + 4096;
    unsigned char* rec = p.ws + OFF_REC + (size_t)tk * REC_BYTES;
    const h16* qkvr = (const h16*)(p.ws + OFF_QKVR);
    __syncthreads();
    {
        const int cg = tl & 15, rg = tl >> 4;
#pragma unroll 1
        for (int ti = 0; ti < 3; ++ti) {
            const int chan = ti * 1024 + h * 128 + 8 * cg;
            float xr[7][8];
#pragma unroll
            for (int r = 0; r < 7; ++r) {
                const int trow = t0 + 4 * rg - 3 + r;
                h16x8 v;
                if (trow >= 0) v = *(const h16x8*)(qkvr + ((size_t)b * NT + trow) * 3072 + chan);
                else { for (int j = 0; j < 8; ++j) v[j] = (h16)0.f; }
#pragma unroll
                for (int j = 0; j < 8; ++j) xr[r][j] = (float)v[j];
            }
            float wv[4][8];
#pragma unroll
            for (int tp = 0; tp < 4; ++tp) { const f32x4 a = *(const f32x4*)(p.conv_w + (size_t)tp * 3072 + chan), c = *(const f32x4*)(p.conv_w + (size_t)tp * 3072 + chan + 4);
#pragma unroll
                for (int j = 0; j < 4; ++j) { wv[tp][j] = a[j]; wv[tp][4 + j] = c[j]; } }
            h16* dst = (ti == 0) ? Qn : (ti == 1 ? Kn : Vh);
#pragma unroll
            for (int r = 0; r < 4; ++r) {
                float y[8]; float ss = 0.f;
#pragma unroll
                for (int j = 0; j < 8; ++j) { float a = wv[0][j] * xr[r][j] + wv[1][j] * xr[r + 1][j] + wv[2][j] * xr[r + 2][j] + wv[3][j] * xr[r + 3][j]; a = a / (1.0f + __expf(-a)); y[j] = a; ss += a * a; }
                float sc = 1.f;
                if (ti < 2) { ss += __shfl_xor(ss, 1); ss += __shfl_xor(ss, 2); ss += __shfl_xor(ss, 4); ss += __shfl_xor(ss, 8); sc = (ti == 0 ? 0.08838834764831845f : 1.0f) / sqrtf(ss + EPS); }
                h16x8 o;
#pragma unroll
                for (int j = 0; j < 8; ++j) o[j] = (h16)(y[j] * sc);
                *(h16x8*)(dst + (4 * rg + r) * 136 + 8 * cg) = o;
            }
        }
    }
    if (tl < 64) {
        const float* gb = (const float*)(p.ws + OFF_GB) + ((size_t)b * NT + t0 + tl) * 16;
        const float g = gb[h], be = gb[8 + h];
        float gc = g;
#pragma unroll
        for (int o = 1; o < 64; o <<= 1) { const float tt = __shfl_up(gc, o); if (lane >= o) gc += tt; }
        const float gl = __shfl(gc, 63);
        vec[tl] = g; vec[64 + tl] = be; vec[128 + tl] = gc; vec[192 + tl] = __expf(gc);
        float* rv = (float*)(rec + REC_VEC);
        rv[tl] = __expf(gc); rv[64 + tl] = __expf(gl - gc); if (tl == 0) rv[128] = __expf(gl);
    }
    __syncthreads();
    {
        const int rt = w4, fr = lane & 15, kg = lane >> 4;
        h16x8 Ak[4], Aq[4];
#pragma unroll
        for (int s = 0; s < 4; ++s) { Ak[s] = *(const h16x8*)(Kn + (16 * rt + fr) * 136 + 32 * s + 8 * kg); Aq[s] = *(const h16x8*)(Qn + (16 * rt + fr) * 136 + 32 * s + 8 * kg); }
        h16* AF = (h16*)(rec + REC_AF);
#pragma unroll
        for (int ct = 0; ct < 4; ++ct) {
            f32x4 kk = (f32x4){0.f, 0.f, 0.f, 0.f}, qk = (f32x4){0.f, 0.f, 0.f, 0.f};
#pragma unroll
            for (int s = 0; s < 4; ++s) { const h16x8 Bk = *(const h16x8*)(Kn + (16 * ct + fr) * 136 + 32 * s + 8 * kg);
                kk = __builtin_amdgcn_mfma_f32_16x16x32_f16(Ak[s], Bk, kk, 0, 0, 0); qk = __builtin_amdgcn_mfma_f32_16x16x32_f16(Aq[s], Bk, qk, 0, 0, 0); }
            const int j = 16 * ct + fr; const float gcj = vec[128 + j];
#pragma unroll
            for (int rgi = 0; rgi < 4; ++rgi) {
                const int i = 16 * rt + 4 * kg + rgi;
                const float dec = (i >= j) ? __expf(vec[128 + i] - gcj) : 0.f;
                L[i * 64 + j] = (i > j) ? vec[64 + i] * kk[rgi] * dec : 0.f;
                const int sp = ct >> 1, kgp = fr >> 2, j8 = (ct & 1) * 4 + (fr & 3), lanep = 16 * kgp + 4 * kg + rgi;
                AF[((rt * 2 + sp) * 64 + lanep) * 8 + j8] = (h16)(qk[rgi] * dec);
            }
        }
    }
    __syncthreads();
    float X[64];
#pragma unroll
    for (int i = 0; i < 64; ++i) X[i] = 0.f;
    {
        const bool isw = tl < 128;
        const h16* colp = isw ? (Kn + tl) : (Vh + (tl - 128));
#pragma unroll
        for (int i = 0; i < 64; ++i) {
            const float be = vec[64 + i], sc = be * (isw ? vec[192 + i] : 1.0f);
            float acc = sc * (float)colp[i * 136];
#pragma unroll
            for (int jj = 0; jj < (i + 3) / 4; ++jj) { const f32x4 l4 = *(const f32x4*)(L + i * 64 + 4 * jj);
                acc -= l4[0] * X[4 * jj]; acc -= l4[1] * X[4 * jj + 1]; acc -= l4[2] * X[4 * jj + 2]; acc -= l4[3] * X[4 * jj + 3]; }
            asm volatile("" : "+v"(acc) :: "memory");
            X[i] = acc;
        }
    }
    if (tl < 128) {
        h16* WF = (h16*)(rec + REC_WF); const int d = tl, s = d >> 5, dd = d & 31;
        const int kgp = (dd < 16) ? (dd >> 2) : ((dd - 16) >> 2), j8 = (dd < 16) ? (dd & 3) : 4 + (dd & 3);
#pragma unroll
        for (int i = 0; i < 64; ++i) { const int rt = i >> 4, row = i & 15; WF[((rt * 4 + s) * 64 + 16 * kgp + row) * 8 + j8] = (h16)(-X[i]); }
    } else {
        h16* UF = (h16*)(rec + REC_UF); const int e = tl - 128, dvb = e >> 4;
#pragma unroll
        for (int i = 0; i < 64; ++i) { const int rt = i >> 4, kg = (i & 15) >> 2, rgi = i & 3; UF[((dvb * 4 + rt) * 64 + 16 * kg + (e & 15)) * 4 + rgi] = (h16)X[i]; }
    }
    {
        h16* QF = (h16*)(rec + REC_QF);
#pragma unroll
        for (int it = 0; it < 4; ++it) { const int f = tl + 256 * it; const int lanep = f & 63, s = (f >> 6) & 3, rt = f >> 8; const int row = 16 * rt + (lanep & 15), kgp = lanep >> 4;
            const h16x4 a = *(const h16x4*)(Qn + row * 136 + 32 * s + 4 * kgp), c = *(const h16x4*)(Qn + row * 136 + 32 * s + 16 + 4 * kgp);
            h16x8 o; o[0] = a[0]; o[1] = a[1]; o[2] = a[2]; o[3] = a[3]; o[4] = c[0]; o[5] = c[1]; o[6] = c[2]; o[7] = c[3];
            *(h16x8*)(QF + (size_t)f * 8) = o; }
        h16* KTF = (h16*)(rec + REC_KTF);
#pragma unroll
        for (int it = 0; it < 4; ++it) { const int f = tl + 256 * it; const int lanep = f & 63, sp = (f >> 6) & 1, rt = f >> 7; const int d = 16 * rt + (lanep & 15), kgp = lanep >> 4;
            h16x8 o;
#pragma unroll
            for (int j8 = 0; j8 < 8; ++j8) { const int c = 32 * sp + (j8 < 4 ? 4 * kgp + j8 : 16 + 4 * kgp + (j8 - 4)); o[j8] = Kn[c * 136 + d]; }
            *(h16x8*)(KTF + (size_t)f * 8) = o; }
    }
}

__device__ __forceinline__ h16x8 pack8(const f32x4 a, const f32x4 c) { h16x8 o; o[0] = (h16)a[0]; o[1] = (h16)a[1]; o[2] = (h16)a[2]; o[3] = (h16)a[3]; o[4] = (h16)c[0]; o[5] = (h16)c[1]; o[6] = (h16)c[2]; o[7] = (h16)c[3]; return o; }

__device__ __forceinline__ void gdn_scan_task(const Params& p, unsigned char* smem, int bh) {
    const int tid = opaque_tid(), wid = __builtin_amdgcn_readfirstlane(tid >> 6), lane = tid & 63, kg = lane >> 4, fr = lane & 15;
    const int b = bh >> 3, h = bh & 7;
    LAS unsigned char* lds = (LAS unsigned char*)smem;
    const unsigned char* rec0 = p.ws + OFF_REC + (size_t)(bh * 64) * REC_BYTES;
    h16* OB = (h16*)(smem + 114688);
    const h16* gz = (const h16*)(p.ws + OFF_GZ); h16* omix = (h16*)(p.ws + OFF_OMIX);
    const float ng0 = p.gdn_norm_g[2 * lane], ng1 = p.gdn_norm_g[2 * lane + 1];
    f32x4 Sacc[8];
#pragma unroll
    for (int t = 0; t < 8; ++t) Sacc[t] = (f32x4){0.f, 0.f, 0.f, 0.f};
    h16x4 Uc[4], Un[4]; f32x4 egc[4], ekc[4], egn[4], ekn[4]; float eglc, egln;
    __syncthreads();
#define GDN_GLDS(recp, bufi) do { _Pragma("unroll") for (int _i = 0; _i < 7; ++_i) \
        __builtin_amdgcn_global_load_lds((const unsigned*)((recp) + (size_t)(_i * 512 + tid) * 16), (LAS unsigned*)(lds + (bufi) * 57344 + (_i * 512 + wid * 64) * 16), 16, 0, 0); } while (0)
#define GDN_LDREG(recp, U_, eg_, ek_, egl_) do { _Pragma("unroll") for (int rt = 0; rt < 4; ++rt) { \
        U_[rt] = *(const h16x4*)((recp) + REC_UF + (size_t)((wid * 4 + rt) * 64 + lane) * 8); \
        eg_[rt] = *(const f32x4*)((recp) + REC_VEC + (16 * rt + 4 * kg) * 4); ek_[rt] = *(const f32x4*)((recp) + REC_VEC + 256 + (16 * rt + 4 * kg) * 4); } \
        egl_ = *(const float*)((recp) + REC_VEC + 512); } while (0)
    GDN_GLDS(rec0, 0);
    GDN_LDREG(rec0, Uc, egc, ekc, eglc);
    asm volatile("s_waitcnt vmcnt(0)" ::: "memory");
    __syncthreads();
    for (int n = 0; n < 64; ++n) {
        const unsigned char* recn = rec0 + (size_t)(n + 1) * REC_BYTES;
        if (n + 1 < 64) { GDN_GLDS(recn, (n + 1) & 1); GDN_LDREG(recn, Un, egn, ekn, egln); }
        if (n > 0) {
            const h16* Ob = OB + ((n - 1) & 1) * 8192;
#pragma unroll
            for (int rr = 0; rr < 8; ++rr) { const int c = 8 * wid + rr; const h16x2 ov = *(const h16x2*)(Ob + c * 128 + 2 * lane);
                const float o0 = (float)ov[0], o1 = (float)ov[1]; const float ss = wave_sum(o0 * o0 + o1 * o1); const float r = 1.0f / sqrtf(ss * (1.0f / 128.0f) + EPS);
                const size_t bt = (size_t)b * NT + 64 * (n - 1) + c; const h16x2 gt = *(const h16x2*)(gz + bt * 1024 + h * 128 + 2 * lane);
                h16x2 o; o[0] = (h16)(o0 * r * ng0 * (float)gt[0]); o[1] = (h16)(o1 * r * ng1 * (float)gt[1]);
                *(h16x2*)(omix + bt * 2048 + h * 128 + 2 * lane) = o; }
        }
        const LAS unsigned char* bufp = lds + (n & 1) * 57344;
        h16x8 SB[4];
#pragma unroll
        for (int s = 0; s < 4; ++s) SB[s] = pack8(Sacc[2 * s], Sacc[2 * s + 1]);
        f32x4 vacc[4], oacc[4];
#pragma unroll
        for (int rt = 0; rt < 4; ++rt) { vacc[rt] = (f32x4){(float)Uc[rt][0], (float)Uc[rt][1], (float)Uc[rt][2], (float)Uc[rt][3]}; oacc[rt] = (f32x4){0.f, 0.f, 0.f, 0.f}; }
#pragma unroll
        for (int rt = 0; rt < 4; ++rt)
#pragma unroll
            for (int s = 0; s < 4; ++s) { const h16x8 a = *(const LAS h16x8*)(bufp + REC_WF + ((rt * 4 + s) * 64 + lane) * 16); vacc[rt] = __builtin_amdgcn_mfma_f32_16x16x32_f16(a, SB[s], vacc[rt], 0, 0, 0); }
#pragma unroll
        for (int rt = 0; rt < 4; ++rt)
#pragma unroll
            for (int s = 0; s < 4; ++s) { const h16x8 a = *(const LAS h16x8*)(bufp + REC_QF + ((rt * 4 + s) * 64 + lane) * 16); oacc[rt] = __builtin_amdgcn_mfma_f32_16x16x32_f16(a, SB[s], oacc[rt], 0, 0, 0); }
#pragma unroll
        for (int rt = 0; rt < 4; ++rt) oacc[rt] = oacc[rt] * egc[rt];
        h16x8 VB[2], VKB[2];
#pragma unroll
        for (int sp = 0; sp < 2; ++sp) { VB[sp] = pack8(vacc[2 * sp], vacc[2 * sp + 1]); VKB[sp] = pack8(vacc[2 * sp] * ekc[2 * sp], vacc[2 * sp + 1] * ekc[2 * sp + 1]); }
#pragma unroll
        for (int rt = 0; rt < 4; ++rt)
#pragma unroll
            for (int sp = 0; sp < 2; ++sp) { const h16x8 a = *(const LAS h16x8*)(bufp + REC_AF + ((rt * 2 + sp) * 64 + lane) * 16); oacc[rt] = __builtin_amdgcn_mfma_f32_16x16x32_f16(a, VB[sp], oacc[rt], 0, 0, 0); }
#pragma unroll
        for (int t = 0; t < 8; ++t) { Sacc[t] = Sacc[t] * eglc;
#pragma unroll
            for (int sp = 0; sp < 2; ++sp) { const h16x8 a = *(const LAS h16x8*)(bufp + REC_KTF + ((t * 2 + sp) * 64 + lane) * 16); Sacc[t] = __builtin_amdgcn_mfma_f32_16x16x32_f16(a, VKB[sp], Sacc[t], 0, 0, 0); } }
        { h16* Ob = OB + (n & 1) * 8192;
#pragma unroll
          for (int rt = 0; rt < 4; ++rt)
#pragma unroll
              for (int rgi = 0; rgi < 4; ++rgi) Ob[(16 * rt + 4 * kg + rgi) * 128 + 16 * wid + fr] = (h16)oacc[rt][rgi]; }
        asm volatile("s_waitcnt vmcnt(0)" ::: "memory");
        __syncthreads();
#pragma unroll
        for (int rt = 0; rt < 4; ++rt) { Uc[rt] = Un[rt]; egc[rt] = egn[rt]; ekc[rt] = ekn[rt]; }
        eglc = egln;
    }
    {
        const h16* Ob = OB + 8192;
#pragma unroll
        for (int rr = 0; rr < 8; ++rr) { const int c = 8 * wid + rr; const h16x2 ov = *(const h16x2*)(Ob + c * 128 + 2 * lane);
            const float o0 = (float)ov[0], o1 = (float)ov[1]; const float ss = wave_sum(o0 * o0 + o1 * o1); const float r = 1.0f / sqrtf(ss * (1.0f / 128.0f) + EPS);
            const size_t bt = (size_t)b * NT + 64 * 63 + c; const h16x2 gt = *(const h16x2*)(gz + bt * 1024 + h * 128 + 2 * lane);
            h16x2 o; o[0] = (h16)(o0 * r * ng0 * (float)gt[0]); o[1] = (h16)(o1 * r * ng1 * (float)gt[1]);
            *(h16x2*)(omix + bt * 2048 + h * 128 + 2 * lane) = o; }
    }
#undef GDN_GLDS
#undef GDN_LDREG
}

__device__ __forceinline__ unsigned f2key(float x) { const unsigned u = __float_as_uint(x); return (u & 0x80000000u) ? ~u : (u | 0x80000000u); }
typedef float f32x16 __attribute__((ext_vector_type(16)));
__device__ __forceinline__ float wave_min(float v) {
#pragma unroll
    for (int o = 1; o < 64; o <<= 1) v = fminf(v, __shfl_xor(v, o));
    return v;
}
__device__ __forceinline__ unsigned lane_below(unsigned long long m) { return __builtin_amdgcn_mbcnt_hi((unsigned)(m >> 32), __builtin_amdgcn_mbcnt_lo((unsigned)m, 0u)); }
__device__ __forceinline__ void idx8_task(const Params& p, unsigned char* smem, int b, int qb) {
    const int tid = opaque_tid(), wid = __builtin_amdgcn_readfirstlane(tid >> 6), lane = tid & 63;
    const int t0 = qb * 8;
    unsigned short* selg = (unsigned short*)(p.ws + OFF_SEL) + ((size_t)b * NT + t0) * 256;
    if (t0 + 8 <= 256) {
        for (int i = tid; i < 8 * 256; i += 512) { const int q = i >> 8, k = i & 255; selg[i] = (unsigned short)(k <= t0 + q ? k : 0); }
        return;
    }
    float* sc = (float*)smem;
    unsigned* hist = (unsigned*)(smem + 131072 + wid * 2048);
    unsigned* cand = hist + 256;
    __syncthreads();
    {
        const int n8 = t0 + 8;
        const int ntile = (n8 + 31) >> 5, ntile_pad = ((n8 + 255) >> 8) << 3;
        const h16* iq = (const h16*)(p.ws + OFF_IQ) + ((size_t)b * NT + t0) * 1024;
        const float* iw = (const float*)(p.ws + OFF_IW) + ((size_t)b * NT + t0) * 16;
        const h16* ik = (const h16*)(p.ws + OFF_IK) + (size_t)b * NT * 64;
        const int r = lane & 31, kh = lane >> 5, qq = (r >> 2) & 1, hh = (r & 3) + 4 * (r >> 3);
        h16x8 Af[4][4]; f32x4 Wr[4][4];
#pragma unroll
        for (int a = 0; a < 4; ++a) {
#pragma unroll
            for (int s = 0; s < 4; ++s) Af[a][s] = *(const h16x8*)(iq + (size_t)(2 * a + qq) * 1024 + hh * 64 + 16 * s + 8 * kh);
#pragma unroll
            for (int c = 0; c < 4; ++c) Wr[a][c] = *(const f32x4*)(iw + (size_t)(2 * a + kh) * 16 + 4 * c);
        }
        for (int i = wid; i < ntile_pad; i += 8) {
            const int key = 32 * i + r;
            if (i < ntile) {
                h16x8 Bf[4];
#pragma unroll
                for (int s = 0; s < 4; ++s) Bf[s] = *(const h16x8*)(ik + (size_t)key * 64 + 16 * s + 8 * kh);
#pragma unroll
                for (int a = 0; a < 4; ++a) {
                    f32x16 acc;
#pragma unroll
                    for (int e = 0; e < 16; ++e) acc[e] = 0.f;
#pragma unroll
                    for (int s = 0; s < 4; ++s) acc = __builtin_amdgcn_mfma_f32_32x32x16_f16(Af[a][s], Bf[s], acc, 0, 0, 0);
                    float s0 = 0.f;
#pragma unroll
                    for (int e = 0; e < 16; ++e) s0 += Wr[a][e >> 2][e & 3] * fmaxf(acc[e], 0.f);
                    const int q = 2 * a + kh;
                    sc[q * 4096 + key] = (key > t0 + q) ? -INFINITY : s0;
                }
            } else {
#pragma unroll
                for (int a = 0; a < 4; ++a) sc[(2 * a + kh) * 4096 + key] = -INFINITY;
            }
        }
    }
    __syncthreads();
    {
        const int tq = t0 + wid, n = tq + 1;
        const float* row = sc + wid * 4096;
        const int ng = (n + 255) >> 8;
        f32x4 x[16];
#pragma unroll
        for (int g = 0; g < 16; ++g) { if (g < ng) x[g] = *(const f32x4*)(row + 256 * g + 4 * lane); else x[g] = (f32x4){-INFINITY, -INFINITY, -INFINITY, -INFINITY}; }
        float hi = -INFINITY, lo = INFINITY;
#pragma unroll
        for (int g = 0; g < 16; ++g)
#pragma unroll
            for (int c = 0; c < 4; ++c) { const float v = x[g][c]; hi = fmaxf(hi, v); lo = fminf(lo, v == -INFINITY ? INFINITY : v); }
        hi = wave_max(hi); lo = wave_min(lo);
        const float scale = (hi > lo) ? 255.99f / (hi - lo) : 0.f; const float off = -lo * scale;
        *(u32x4*)(hist + 4 * lane) = (u32x4){0u, 0u, 0u, 0u};
#pragma unroll
        for (int g = 0; g < 16; ++g) { if (g < ng) {
#pragma unroll
            for (int c = 0; c < 4; ++c) { int bin = (int)fmaf(x[g][c], scale, off); bin = bin < 0 ? 0 : (bin > 255 ? 255 : bin); atomicAdd(&hist[bin], 1u); } } }
        unsigned bstar, need;
        {
            const u32x4 h4 = *(const u32x4*)(hist + 4 * lane); const unsigned s = h4[0] + h4[1] + h4[2] + h4[3];
            unsigned suf = s;
#pragma unroll
            for (int o = 1; o < 64; o <<= 1) { const unsigned tt = __shfl_down(suf, o); if (lane + o < 64) suf += tt; }
            const unsigned above = suf - s;
            const bool mine = (above < 256u && 256u <= suf);
            unsigned cum = above; unsigned bin = 0;
            if (cum + h4[3] >= 256u) bin = 3; else { cum += h4[3]; if (cum + h4[2] >= 256u) bin = 2; else { cum += h4[2]; if (cum + h4[1] >= 256u) bin = 1; else { cum += h4[1]; bin = 0; } } }
            const unsigned long long mm = __ballot(mine);
            const int src = (int)__builtin_ctzll(mm);
            bstar = (unsigned)__shfl((int)(4 * lane + bin), src); need = (unsigned)__shfl((int)(256u - cum), src);
        }
        unsigned m = 0;
#pragma unroll
        for (int g = 0; g < 16; ++g) { if (g < ng) {
#pragma unroll
            for (int c = 0; c < 4; ++c) { int bin = (int)fmaf(x[g][c], scale, off); bin = bin < 0 ? 0 : (bin > 255 ? 255 : bin);
                const bool pr = ((unsigned)bin == bstar); const unsigned long long mk = __ballot(pr);
                if (mk) { const unsigned pos = m + lane_below(mk); if (pr && pos < 256u) cand[pos] = f2key(x[g][c]); m += (unsigned)__builtin_popcountll(mk); } } } }
        unsigned Kt = 0, rr = need;
        if (m <= 256u) {
            const int nc = (int)((m + 63u) >> 6);
            unsigned c0 = (lane < (int)m) ? cand[lane] : 0u, c1 = (64 + lane < (int)m) ? cand[64 + lane] : 0u, c2 = (128 + lane < (int)m) ? cand[128 + lane] : 0u, c3 = (192 + lane < (int)m) ? cand[192 + lane] : 0u;
            for (int bit = 31; bit >= 0; --bit) {
                const unsigned test = (Kt | (1u << bit)) >> bit;
                unsigned cnt = (unsigned)__builtin_popcountll(__ballot((c0 >> bit) == test));
                if (nc > 1) cnt += (unsigned)__builtin_popcountll(__ballot((c1 >> bit) == test));
                if (nc > 2) cnt += (unsigned)__builtin_popcountll(__ballot((c2 >> bit) == test));
                if (nc > 3) cnt += (unsigned)__builtin_popcountll(__ballot((c3 >> bit) == test));
                if (cnt >= rr) Kt |= (1u << bit); else rr -= cnt;
            }
        } else {
            for (int bit = 31; bit >= 0; --bit) {
                const unsigned test = (Kt | (1u << bit)) >> bit; unsigned cnt = 0;
                for (int idx = lane; idx < ng * 256; idx += 64) { const float v = row[idx]; int bin = (int)fmaf(v, scale, off); bin = bin < 0 ? 0 : (bin > 255 ? 255 : bin);
                    const bool pr = ((unsigned)bin == bstar) && ((f2key(v) >> bit) == test); cnt += (unsigned)__builtin_popcountll(__ballot(pr)); }
                if (cnt >= rr) Kt |= (1u << bit); else rr -= cnt;
            }
        }
        unsigned short* so = selg + (size_t)wid * 256;
        unsigned outb = 0, eqb = 0;
#pragma unroll
        for (int g = 0; g < 16; ++g) { if (g < ng) {
#pragma unroll
            for (int c = 0; c < 4; ++c) { const unsigned k = f2key(x[g][c]); const bool gt = k > Kt; bool eq = (k == Kt);
                const unsigned long long me = __ballot(eq); bool take = gt;
                if (me) { const unsigned er = eqb + lane_below(me); take = gt || (eq && er < rr); eqb += (unsigned)__builtin_popcountll(me); }
                const unsigned long long mt = __ballot(take);
                if (mt) { const unsigned pos = outb + lane_below(mt); if (take) so[pos] = (unsigned short)(256 * g + 4 * lane + c); outb += (unsigned)__builtin_popcountll(mt); } } } }
    }
}

__device__ __forceinline__ void attn_naive_task(const Params& p, unsigned char* smem, int bt) {
    const int tid = opaque_tid(), wid = tid >> 6, lane = tid & 63;
    const int b = bt / NT, t = bt % NT; const int nvalid = (t + 1) < 256 ? (t + 1) : 256;
    float* qs = (float*)smem; float* lg = qs + 1024; unsigned short* sl = (unsigned short*)(lg + 2048);
    const h16* aq = (const h16*)(p.ws + OFF_AQ); const h16* ak = (const h16*)(p.ws + OFF_AK); const h16* av = (const h16*)(p.ws + OFF_AV);
    const h16* az = (const h16*)(p.ws + OFF_AZ); h16* omix = (h16*)(p.ws + OFF_OMIX);
    __syncthreads();
    { const h16x2 v = *(const h16x2*)(aq + (size_t)bt * 1024 + 2 * tid); qs[2 * tid] = (float)v[0]; qs[2 * tid + 1] = (float)v[1];
      if (tid < 256) sl[tid] = ((const unsigned short*)(p.ws + OFF_SEL))[(size_t)bt * 256 + tid]; }
    __syncthreads();
    { const int kk = tid & 255, g = tid >> 8; const int key = sl[kk];
      const h16* kr = ak + ((size_t)b * NT + key) * 256 + g * 128;
      float d0 = 0.f, d1 = 0.f, d2 = 0.f, d3 = 0.f; const float* q = qs + (4 * g) * 128;
#pragma unroll 4
      for (int i = 0; i < 16; ++i) { const h16x8 v = *(const h16x8*)(kr + 8 * i);
#pragma unroll
          for (int j = 0; j < 8; ++j) { const float kv = (float)v[j]; d0 += q[8 * i + j] * kv; d1 += q[128 + 8 * i + j] * kv; d2 += q[256 + 8 * i + j] * kv; d3 += q[384 + 8 * i + j] * kv; } }
      const bool valid = kk < nvalid;
      lg[(4 * g + 0) * 256 + kk] = valid ? d0 : -INFINITY; lg[(4 * g + 1) * 256 + kk] = valid ? d1 : -INFINITY;
      lg[(4 * g + 2) * 256 + kk] = valid ? d2 : -INFINITY; lg[(4 * g + 3) * 256 + kk] = valid ? d3 : -INFINITY; }
    __syncthreads();
    { float* L = lg + wid * 256; const float a0 = L[lane], a1 = L[lane + 64], a2 = L[lane + 128], a3 = L[lane + 192];
      const float m = wave_max(fmaxf(fmaxf(a0, a1), fmaxf(a2, a3)));
      const float e0 = expf(a0 - m), e1 = expf(a1 - m), e2 = expf(a2 - m), e3 = expf(a3 - m);
      const float inv = 1.0f / wave_sum((e0 + e1) + (e2 + e3));
      L[lane] = e0 * inv; L[lane + 64] = e1 * inv; L[lane + 128] = e2 * inv; L[lane + 192] = e3 * inv; }
    __syncthreads();
    { const int h = wid, g = h >> 2; float o0 = 0.f, o1 = 0.f; const float* P = lg + h * 256;
      for (int kk = 0; kk < nvalid; ++kk) { const int key = sl[kk]; const h16x2 v = *(const h16x2*)(av + ((size_t)b * NT + key) * 256 + g * 128 + 2 * lane); const float pk = P[kk]; o0 += pk * (float)v[0]; o1 += pk * (float)v[1]; }
      const h16x2 gt = *(const h16x2*)(az + (size_t)bt * 1024 + h * 128 + 2 * lane);
      h16x2 o; o[0] = (h16)(o0 * (float)gt[0]); o[1] = (h16)(o1 * (float)gt[1]);
      *(h16x2*)(omix + (size_t)bt * 2048 + 1024 + h * 128 + 2 * lane) = o; }
}

__device__ __forceinline__ void phase5(const Params& p) {
    const int tid = threadIdx.x, wid = tid >> 6, lane = tid & 63;
    const int gw = blockIdx.x * 8 + wid, nw = gridDim.x * 8;
    const float* rowss = (const float*)(p.ws + OFF_ROWSS);
    for (int row = gw; row < BT; row += nw) {
        const float r = 1.0f / sqrtf(rowss[row] * (1.0f / DM) + EPS);
        f32x4* o = (f32x4*)(p.out + (size_t)row * DM);
#pragma unroll
        for (int i = 0; i < 8; ++i) { const f32x4 g = ((const f32x4*)p.final_g)[lane + 64 * i]; f32x4 v = o[lane + 64 * i]; v = v * r * g; o[lane + 64 * i] = v; }
    }
}

template <int LO, int HI>
__global__ void __launch_bounds__(512, 2) k_phases(Params p) {
    extern __shared__ __attribute__((aligned(16))) unsigned char smem[];
#define IN(k) (LO <= (k) && (k) < HI)
#define SEAM(k) do { if constexpr (IN(k) && IN((k) + 1)) { cg::this_grid().sync(); } } while (0)
    if constexpr (IN(0)) { phase0(p, smem); }
    SEAM(0);
    if constexpr (IN(1)) {
        pg8::Gemm g{(const h16*)(p.ws + OFF_H), (const h16*)(p.ws + OFF_WT), BT, NPAD, DM};
        pg8::StaticOrder S; S.init(BT, NPAD, gridDim.x, blockIdx.x);
        EpiIn E{p.ws, p.a_log, p.dt_bias};
        pg8::gemm_phase<EpiIn, pg8::StaticOrder>((LAS unsigned char*)smem, g, S, E);
    }
    SEAM(1);
    if constexpr (IN(2)) {
        {
            unsigned* qctr = (unsigned*)(p.ws + OFF_CTRL);
            unsigned* lds_t = (unsigned*)(smem + LDS_BYTES - 16);
            for (;;) {
                __syncthreads();
                if (threadIdx.x == 0) lds_t[0] = atomicAdd(qctr + 0, 1u);
                __syncthreads();
                const unsigned o = lds_t[0];
                if (o >= 1024u + 2048u) break;
                if (o < 1024u) gdn_prep_pair(p, smem, (int)o);
                else { const unsigned o2 = o - 1024u; idx8_task(p, smem, (int)(o2 & 3u), 511 - (int)(o2 >> 2)); }
            }
        }
    }
    SEAM(2);
    if constexpr (IN(3)) {
        {
            unsigned* qctr = (unsigned*)(p.ws + OFF_CTRL);
            unsigned* lds_t = (unsigned*)(smem + LDS_BYTES - 16);
            __syncthreads();
            if (threadIdx.x == 0) lds_t[0] = atomicAdd(qctr + 64, 1u);
            __syncthreads();
            const unsigned o = lds_t[0];
            if (o < 32u) gdn_scan_task(p, smem, (int)o);
            for (;;) {
                __syncthreads();
                if (threadIdx.x == 0) lds_t[0] = atomicAdd(qctr + 128, 1u);
                __syncthreads();
                const unsigned a = lds_t[0];
                if (a >= (unsigned)BT) break;
                attn_naive_task(p, smem, (int)a);
            }
        }
    }
    SEAM(3);
    if constexpr (IN(4)) {
        pg8::Gemm g{(const h16*)(p.ws + OFF_OMIX), (const h16*)(p.ws + OFF_WOT), BT, DM, DM};
        pg8::StaticOrder S; S.init(BT, DM, gridDim.x, blockIdx.x);
        EpiOut E{p.x, p.out, (float*)(p.ws + OFF_ROWSS)};
        pg8::gemm_phase<EpiOut, pg8::StaticOrder>((LAS unsigned char*)smem, g, S, E);
    }
    SEAM(4);
    if constexpr (IN(5)) { phase5(p); }
#undef IN
#undef SEAM
}

template <int LO, int HI> static void launch_range(const Params& p, int grid, hipStream_t stream, bool coop) {
    static bool attr = false;
    if (!attr) { hipFuncSetAttribute((const void*)k_phases<LO, HI>, hipFuncAttributeMaxDynamicSharedMemorySize, LDS_BYTES); attr = true; }
    if (coop) {
        Params pp = p; void* args[] = {&pp};
        hipError_t e = hipLaunchCooperativeKernel((const void*)k_phases<LO, HI>, dim3(grid), dim3(512), args, LDS_BYTES, stream);
        if (e != hipSuccess) fprintf(stderr, "cooperative launch failed: %s (grid %d)\n", hipGetErrorString(e), grid);
    } else {
        hipLaunchKernelGGL((k_phases<LO, HI>), dim3(grid), dim3(512), LDS_BYTES, stream, p);
    }
}

extern "C" void kernel_launch(void* const* d_in, const int* in_sizes, int n_in, void* d_out, int out_size, void* d_ws, size_t ws_size, hipStream_t stream) {
    if (n_in != 10 || in_sizes[0] != BT * DM || out_size != BT * DM || ws_size < WS_END) {
        fprintf(stderr, "kernel_launch: unexpected shapes (n_in %d in0 %d out %d ws %zu need %zu)\n", n_in, n_in > 0 ? in_sizes[0] : -1, out_size, ws_size, (size_t)WS_END); return; }
    static int grid = 0;
    if (!grid) {
        int dev = 0, cus = 0, per_cu = 0; hipGetDevice(&dev); hipDeviceGetAttribute(&cus, hipDeviceAttributeMultiprocessorCount, dev);
#if FUSED
        hipFuncSetAttribute((const void*)k_phases<0, 6>, hipFuncAttributeMaxDynamicSharedMemorySize, LDS_BYTES);
        hipOccupancyMaxActiveBlocksPerMultiprocessor(&per_cu, (const void*)k_phases<0, 6>, 512, LDS_BYTES);
#else
        per_cu = 1;
#endif
        if (per_cu < 1) per_cu = 1; if (per_cu > 1) per_cu = 1;
        grid = cus * per_cu;
    }
    Params p{};
    p.x = (const float*)d_in[0]; p.pos = (const int*)d_in[1]; p.attn_g = (const float*)d_in[2]; p.w_in = (const float*)d_in[3]; p.conv_w = (const float*)d_in[4];
    p.a_log = (const float*)d_in[5]; p.dt_bias = (const float*)d_in[6]; p.gdn_norm_g = (const float*)d_in[7]; p.w_out = (const float*)d_in[8]; p.final_g = (const float*)d_in[9];
    p.out = (float*)d_out; p.ws = (unsigned char*)d_ws;
    hipMemsetAsync((char*)d_ws + OFF_CTRL, 0, CTL_ZERO_BYTES, stream);
#if FUSED
    launch_range<0, 6>(p, grid, stream, true);
#else
    launch_range<0, 1>(p, grid, stream, false);
    launch_range<1, 2>(p, grid, stream, false);
    launch_range<2, 3>(p, grid, stream, false);
    launch_range<3, 4>(p, grid, stream, false);
    launch_range<4, 5>(p, grid, stream, false);
    launch_range<5, 6>(p, grid, stream, false);
#endif
}
```

```cpp
#include <hip/hip_runtime.h>
#include <hip/hip_cooperative_groups.h>
#include <cstdio>
#include <cstdint>
namespace cg = cooperative_groups;

#ifndef FUSED
#define FUSED 1
#endif

#define LAS __attribute__((address_space(3)))
typedef _Float16 h16;
typedef h16 h16x8 __attribute__((ext_vector_type(8)));
typedef h16 h16x4 __attribute__((ext_vector_type(4)));
typedef h16 h16x2 __attribute__((ext_vector_type(2)));
typedef float f32x4 __attribute__((ext_vector_type(4)));
typedef float f32x2 __attribute__((ext_vector_type(2)));
typedef unsigned u32x4 __attribute__((ext_vector_type(4)));

constexpr int NB = 4, NT = 4096, DM = 2048, BT = NB * NT;
constexpr int IN_COLS = 7776, NPAD = 7936;
constexpr float EPS = 1e-6f;
constexpr int LDS_BYTES = 155648;

constexpr size_t MB = 1024 * 1024;
constexpr size_t OFF_CTRL = 0;
constexpr size_t OFF_ROWSS = 65536;
constexpr size_t CTL_ZERO_BYTES = 65536 + (size_t)BT * 4;
constexpr size_t OFF_H = 1 * MB;
constexpr size_t OFF_OMIX = OFF_H;
constexpr size_t OFF_WT = OFF_H + 64 * MB;
constexpr size_t OFF_WOT = OFF_WT + (size_t)NPAD * 2048 * 2;
constexpr size_t OFF_QKVR = OFF_WOT + 8 * MB;
constexpr size_t OFF_GZ = OFF_QKVR + (size_t)BT * 3072 * 2;
constexpr size_t OFF_AQ = OFF_GZ + 32 * MB;
constexpr size_t OFF_AK = OFF_AQ + 32 * MB;
constexpr size_t OFF_AV = OFF_AK + 8 * MB;
constexpr size_t OFF_AZ = OFF_AV + 8 * MB;
constexpr size_t OFF_IQ = OFF_AZ + 32 * MB;
constexpr size_t OFF_IK = OFF_IQ + 32 * MB;
constexpr size_t OFF_GB = OFF_IK + 2 * MB;
constexpr size_t OFF_IW = OFF_GB + 1 * MB;
constexpr size_t OFF_COS = OFF_IW + 1 * MB;
constexpr size_t OFF_SIN = OFF_COS + 2 * MB;
constexpr size_t OFF_SEL = OFF_SIN + 2 * MB;
constexpr size_t OFF_REC = OFF_SEL + 8 * MB;
constexpr size_t WS_END = OFF_REC + (size_t)2048 * 74752;

struct Params {
    const float* x; const int* pos; const float* attn_g; const float* w_in; const float* conv_w; const float* a_log;
    const float* dt_bias; const float* gdn_norm_g; const float* w_out; const float* final_g; float* out; unsigned char* ws;
};

__device__ __forceinline__ float wave_sum(float v) {
#pragma unroll
    for (int o = 1; o < 64; o <<= 1) v += __shfl_xor(v, o);
    return v;
}
__device__ __forceinline__ float wave_max(float v) {
#pragma unroll
    for (int o = 1; o < 64; o <<= 1) v = fmaxf(v, __shfl_xor(v, o));
    return v;
}
__device__ __forceinline__ int opaque_tid() { int t = threadIdx.x; asm volatile("" : "+v"(t)); return t; }
__device__ __forceinline__ float silu_f(float x) { return x / (1.0f + __expf(-x)); }

namespace pg8 {
constexpr int BM = 256, BK = 64, HALF = 128, HTB = HALF * BK * 2, STAGE_BYTES = 8 * HTB, NXCD = 8, WGM = 8;
__host__ __device__ __forceinline__ int lds_byte(int r, int c) { const int st = (r >> 4) * 2 + (c >> 5), rr = r & 15, cc = c & 31, ob = rr * 64 + cc * 2; return st * 1024 + (ob ^ (((ob >> 9) & 1) << 5)); }
__host__ __device__ __forceinline__ void stage_rc(int b, int& R, int& C) { const int st = b / 1024, sb = b % 1024, swz = sb ^ (((sb >> 9) & 1) << 5); R = (st >> 1) * 16 + swz / 64; C = (st & 1) * 32 + (swz % 64) / 2; }
__host__ __device__ __forceinline__ int perm32(int rho) { const int n = rho >> 4, i = rho & 15; return 8 * (i >> 2) + 4 * n + (i & 3); }
struct Unit { int pm, pn; };
struct Gemm { const h16* A; const h16* Bt; int M, N, K; };
struct StaticOrder {
    int nM, nN, nwg, G, c;
    __host__ __device__ void init(int M, int N, int G_, int c_) { nM = M / BM; nN = N / BM; nwg = nM * nN; G = G_; c = c_; }
    __host__ __device__ bool next(int i, Unit& u) const {
        const long L = (long)i * G + c; if (L >= nwg) return false;
        int wgid = (int)L; { const int q = nwg / NXCD, r = nwg % NXCD, xcd = wgid % NXCD, off = wgid / NXCD; wgid = (xcd < r ? xcd * (q + 1) : r * (q + 1) + (xcd - r) * q) + off; }
        const int nig = WGM * nN, gid = wgid / nig, fm = gid * WGM, gsz = (nM - fm) < WGM ? (nM - fm) : WGM;
        u.pm = fm + ((wgid % nig) % gsz); u.pn = (wgid % nig) / gsz; return true;
    }
    __device__ __forceinline__ void a_ready(const Unit&) const {}
    __device__ __forceinline__ void done(const Unit&) const {}
};

template <class Epi, class Sched>
__device__ __forceinline__ void gemm_phase(LAS unsigned char* lds, const Gemm g, const Sched& S, const Epi& E) {
    const int tid = threadIdx.x, wid = __builtin_amdgcn_readfirstlane(tid >> 6), lane = tid & 63, wr = wid >> 2, wc = wid & 3, fr = lane & 15, fq = lane >> 4;
    const int K = g.K, nt = K / BK;
    unsigned voffA[2], voffB[2];
#pragma unroll
    for (int i = 0; i < 2; ++i) { int R, C; stage_rc(tid * 16 + i * 8192, R, C); const int Rb = Epi::PERM ? ((R & ~31) + perm32(R & 31)) : R;
        voffA[i] = (unsigned)(R * K + C) * 2u; voffB[i] = (unsigned)(Rb * K + C) * 2u; }
    const size_t kstep = (size_t)(BK * 2);
    const size_t hstep = (size_t)HALF * K * 2;
    const size_t tstep = 2 * hstep;
    const unsigned ldsw = (unsigned)wid * 1024u;
    const int aoff = lds_byte(wr * 64 + fr, fq * 8), boff = lds_byte(wc * 32 + fr, fq * 8);
#define PG8_SA(b, h) (((b) * 2 + (h)) * HTB)
#define PG8_SB(b, h) ((4 + (b) * 2 + (h)) * HTB)
#define PG8_STAGE(bufoff, gbase, voff) do { _Pragma("unroll") for (int _i = 0; _i < 2; ++_i) \
        __builtin_amdgcn_global_load_lds((const unsigned*)((const char*)(gbase) + (voff)[_i]), (LAS unsigned*)(lds + (bufoff) + ldsw + _i * 8192), 16, 0, 0); } while (0)
#define PG8_LDA(dst, b, h) do { _Pragma("unroll") for (int m = 0; m < 4; ++m) _Pragma("unroll") for (int k = 0; k < 2; ++k) dst[m][k] = *(const LAS h16x8*)(lds + PG8_SA(b, h) + aoff + m * 2048 + k * 1024); } while (0)
#define PG8_LDB(dst, b, h) do { _Pragma("unroll") for (int n = 0; n < 2; ++n) _Pragma("unroll") for (int k = 0; k < 2; ++k) dst[n][k] = *(const LAS h16x8*)(lds + PG8_SB(b, h) + boff + n * 2048 + k * 1024); } while (0)
#define PG8_MMA(ai, bj, At, Bt) do { __builtin_amdgcn_s_setprio(1); _Pragma("unroll") for (int m = 0; m < 4; ++m) _Pragma("unroll") for (int n = 0; n < 2; ++n) _Pragma("unroll") for (int k = 0; k < 2; ++k) \
        acc[ai][bj][m][n] = __builtin_amdgcn_mfma_f32_16x16x32_f16(Bt[n][k], At[m][k], acc[ai][bj][m][n], 0, 0, 0); __builtin_amdgcn_s_setprio(0); } while (0)
#define PG8_WAIT_V(n) asm volatile("s_waitcnt vmcnt(" #n ")" ::: "memory")
#define PG8_WAIT_L(n) asm volatile("s_waitcnt lgkmcnt(" #n ")" ::: "memory")
#define PG8_BAR __builtin_amdgcn_s_barrier()
#define PG8_SCHED __builtin_amdgcn_sched_barrier(0)
    Unit cur, nxt; int ui = 0;
    if (!S.next(0, cur)) return;
    f32x4 acc[2][2][4][2];
#pragma unroll
    for (int a = 0; a < 2; ++a)
#pragma unroll
        for (int b = 0; b < 2; ++b)
#pragma unroll
            for (int m = 0; m < 4; ++m)
#pragma unroll
                for (int n = 0; n < 2; ++n) acc[a][b][m][n] = (f32x4){0.f, 0.f, 0.f, 0.f};
    h16x8 At[4][2], B0[2][2], B1[2][2];
    const char* cA = (const char*)g.A + (size_t)cur.pm * tstep; const char* cB = (const char*)g.Bt + (size_t)cur.pn * tstep;
    S.a_ready(cur);
    PG8_STAGE(PG8_SB(0, 0), cB, voffB); PG8_STAGE(PG8_SA(0, 0), cA, voffA); PG8_STAGE(PG8_SB(0, 1), cB + hstep, voffB); PG8_STAGE(PG8_SA(0, 1), cA + hstep, voffA);
    if (wr == 1) PG8_BAR;
    PG8_WAIT_V(4); PG8_BAR;
    PG8_STAGE(PG8_SB(1, 0), cB + kstep, voffB); PG8_STAGE(PG8_SA(1, 0), cA + kstep, voffA); PG8_STAGE(PG8_SB(1, 1), cB + hstep + kstep, voffB);
    PG8_WAIT_V(6); PG8_BAR;
    for (;;) {
        const bool has_next = S.next(ui + 1, nxt);
        const char* nA = has_next ? (const char*)g.A + (size_t)nxt.pm * tstep : cA; const char* nB = has_next ? (const char*)g.Bt + (size_t)nxt.pn * tstep : cB;
        for (int t = 0; t < nt; t += 2) {
            const bool last = (t == nt - 2);
            const char* a1 = cA + (size_t)(t + 1) * kstep;
            const char* a2 = last ? nA : cA + (size_t)(t + 2) * kstep; const char* b2 = last ? nB : cB + (size_t)(t + 2) * kstep;
            const char* a3 = a2 + kstep; const char* b3 = b2 + kstep;
            if (last && has_next) S.a_ready(nxt);
            PG8_LDB(B0, 0, 0); PG8_SCHED; PG8_LDA(At, 0, 0); PG8_STAGE(PG8_SA(1, 1), a1 + hstep, voffA);
            PG8_WAIT_L(8); PG8_BAR; PG8_WAIT_L(0); PG8_MMA(0, 0, At, B0); PG8_BAR; PG8_SCHED;
            PG8_LDB(B1, 0, 1); PG8_STAGE(PG8_SB(0, 0), b2, voffB);
            PG8_BAR; PG8_WAIT_L(0); PG8_MMA(0, 1, At, B1); PG8_BAR;
            PG8_LDA(At, 0, 1); PG8_STAGE(PG8_SA(0, 0), a2, voffA);
            PG8_BAR; PG8_WAIT_L(0); PG8_MMA(1, 0, At, B0); PG8_BAR; PG8_SCHED;
            PG8_STAGE(PG8_SB(0, 1), b2 + hstep, voffB);
            PG8_WAIT_V(6); PG8_BAR; PG8_MMA(1, 1, At, B1); PG8_BAR;
            PG8_LDB(B0, 1, 0); PG8_SCHED; PG8_LDA(At, 1, 0); PG8_STAGE(PG8_SA(0, 1), a2 + hstep, voffA);
            PG8_WAIT_L(8); PG8_BAR; PG8_WAIT_L(0); PG8_MMA(0, 0, At, B0); PG8_BAR; PG8_SCHED;
            PG8_LDB(B1, 1, 1); PG8_STAGE(PG8_SB(1, 0), b3, voffB);
            PG8_BAR; PG8_WAIT_L(0); PG8_MMA(0, 1, At, B1); PG8_BAR;
            PG8_LDA(At, 1, 1); PG8_STAGE(PG8_SA(1, 0), a3, voffA);
            PG8_BAR; PG8_WAIT_L(0); PG8_MMA(1, 0, At, B0); PG8_BAR; PG8_SCHED;
            PG8_STAGE(PG8_SB(1, 1), b3 + hstep, voffB);
            PG8_WAIT_V(6); PG8_BAR; PG8_MMA(1, 1, At, B1); PG8_BAR;
        }
        E(acc, cur, wr, wc, fr, fq); S.done(cur);
        if (!has_next) break;
#pragma unroll
        for (int a = 0; a < 2; ++a)
#pragma unroll
            for (int b = 0; b < 2; ++b)
#pragma unroll
                for (int m = 0; m < 4; ++m)
#pragma unroll
                    for (int n = 0; n < 2; ++n) acc[a][b][m][n] = (f32x4){0.f, 0.f, 0.f, 0.f};
        cur = nxt; cA = nA; cB = nB; ++ui;
    }
    PG8_WAIT_V(0);
    if (wr == 0) PG8_BAR;
    PG8_BAR;
#undef PG8_SA
#undef PG8_SB
#undef PG8_STAGE
#undef PG8_LDA
#undef PG8_LDB
#undef PG8_MMA
#undef PG8_WAIT_V
#undef PG8_WAIT_L
#undef PG8_BAR
#undef PG8_SCHED
}
}

struct EpiIn {
    static constexpr bool PERM = true;
    unsigned char* ws; const float* a_log; const float* dt_bias;
    __device__ __forceinline__ void operator()(const f32x4 (&acc)[2][2][4][2], const pg8::Unit& u, int wr, int wc, int fr, int fq) const {
        const int pn = u.pn;
        const int rowb = u.pm * 256 + wr * 64 + fr;
        const int cw = wc * 32 + 8 * fq;
        const float* cosT = (const float*)(ws + OFF_COS); const float* sinT = (const float*)(ws + OFF_SIN);
        if (pn < 30) {
            h16* base; int ldc, colt, mode; float scale = 1.f;
            if (pn < 12) { base = (h16*)(ws + OFF_QKVR); ldc = 3072; colt = pn * 256; mode = 0; }
            else if (pn < 16) { base = (h16*)(ws + OFF_GZ); ldc = 1024; colt = (pn - 12) * 256; mode = 1; }
            else if (pn < 20) { base = (h16*)(ws + OFF_AQ); ldc = 1024; colt = (pn - 16) * 256; mode = 2; scale = 0.08838834764831845f; }
            else if (pn == 20) { base = (h16*)(ws + OFF_AK); ldc = 256; colt = 0; mode = 2; }
            else if (pn == 21) { base = (h16*)(ws + OFF_AV); ldc = 256; colt = 0; mode = 0; }
            else if (pn < 26) { base = (h16*)(ws + OFF_AZ); ldc = 1024; colt = (pn - 22) * 256; mode = 1; }
            else { base = (h16*)(ws + OFF_IQ); ldc = 1024; colt = (pn - 26) * 256; mode = 3; }
            const bool rot_wave = (mode == 2 && wc == 0) || (mode == 3 && (wc & 1) == 0);
            const int xm = (mode == 2) ? 32 : 16;
            const bool rot_lane = (mode == 2) ? true : (fq < 2);
            const float sgn = (mode == 2) ? (fq < 2 ? -1.f : 1.f) : (fq == 0 ? -1.f : 1.f);
            const int tix = (mode == 2) ? 8 * (fq & 1) : 16;
#pragma unroll
            for (int ai = 0; ai < 2; ++ai)
#pragma unroll
                for (int m = 0; m < 4; ++m) {
                    const int row = rowb + ai * 128 + m * 16;
                    float cs[8], sn[8];
                    if (rot_wave) {
                        const f32x4 c0 = *(const f32x4*)(cosT + (size_t)row * 24 + tix), c1 = *(const f32x4*)(cosT + (size_t)row * 24 + tix + 4);
                        const f32x4 s0 = *(const f32x4*)(sinT + (size_t)row * 24 + tix), s1 = *(const f32x4*)(sinT + (size_t)row * 24 + tix + 4);
#pragma unroll
                        for (int j = 0; j < 4; ++j) { cs[j] = c0[j]; cs[4 + j] = c1[j]; sn[j] = s0[j]; sn[4 + j] = s1[j]; }
                    }
#pragma unroll
                    for (int bj = 0; bj < 2; ++bj) {
                        float v[8];
#pragma unroll
                        for (int j = 0; j < 4; ++j) { v[j] = acc[ai][bj][m][0][j]; v[4 + j] = acc[ai][bj][m][1][j]; }
                        if (rot_wave) {
#pragma unroll
                            for (int j = 0; j < 8; ++j) { const float pv = __shfl_xor(v[j], xm); if (rot_lane) v[j] = v[j] * cs[j] + sgn * pv * sn[j]; }
                        }
                        if (mode == 1) {
#pragma unroll
                            for (int j = 0; j < 8; ++j) v[j] = silu_f(v[j]);
                        }
                        h16x8 o;
#pragma unroll
                        for (int j = 0; j < 8; ++j) o[j] = (h16)(v[j] * scale);
                        *(h16x8*)(base + (size_t)row * ldc + colt + bj * 128 + cw) = o;
                    }
                }
        } else {
            h16* ik = (h16*)(ws + OFF_IK); float* gb = (float*)(ws + OFF_GB); float* iw = (float*)(ws + OFF_IW);
#pragma unroll
            for (int ai = 0; ai < 2; ++ai)
#pragma unroll
                for (int m = 0; m < 4; ++m) {
                    const int row = rowb + ai * 128 + m * 16;
                    float v[8];
#pragma unroll
                    for (int j = 0; j < 4; ++j) { v[j] = acc[ai][0][m][0][j]; v[4 + j] = acc[ai][0][m][1][j]; }
                    if (wc == 0) {
                        const f32x4 c0 = *(const f32x4*)(cosT + (size_t)row * 24 + 16), c1 = *(const f32x4*)(cosT + (size_t)row * 24 + 20);
                        const f32x4 s0 = *(const f32x4*)(sinT + (size_t)row * 24 + 16), s1 = *(const f32x4*)(sinT + (size_t)row * 24 + 20);
                        const float sgn = (fq == 0 ? -1.f : 1.f);
#pragma unroll
                        for (int j = 0; j < 8; ++j) { const float pv = __shfl_xor(v[j], 16); const float c = j < 4 ? c0[j & 3] : c1[j & 3], s = j < 4 ? s0[j & 3] : s1[j & 3];
                            if (fq < 2) v[j] = v[j] * c + sgn * pv * s; }
                    }
                    if (wc < 2) {
                        h16x8 o;
#pragma unroll
                        for (int j = 0; j < 8; ++j) o[j] = (h16)v[j];
                        *(h16x8*)(ik + (size_t)row * 64 + cw) = o;
                    } else if (wc == 2) {
                        if (fq == 0) {
#pragma unroll
                            for (int j = 0; j < 8; ++j) { const float z = v[j] + dt_bias[j]; const float sp = z > 20.f ? z : log1pf(expf(z)); gb[(size_t)row * 16 + j] = -expf(a_log[j]) * sp; }
                        } else if (fq == 1) {
#pragma unroll
                            for (int j = 0; j < 8; ++j) gb[(size_t)row * 16 + 8 + j] = 1.0f / (1.0f + expf(-v[j]));
                        } else {
#pragma unroll
                            for (int j = 0; j < 8; ++j) iw[(size_t)row * 16 + 8 * (fq - 2) + j] = v[j] * 0.03125f;
                        }
                    }
                }
        }
    }
};

struct EpiOut {
    static constexpr bool PERM = false;
    const float* x; float* out; float* rowss;
    __device__ __forceinline__ void operator()(const f32x4 (&acc)[2][2][4][2], const pg8::Unit& u, int wr, int wc, int fr, int fq) const {
        const int rowb = u.pm * 256 + wr * 64 + fr, col0 = u.pn * 256 + wc * 32 + 4 * fq;
#pragma unroll
        for (int ai = 0; ai < 2; ++ai)
#pragma unroll
            for (int m = 0; m < 4; ++m) {
                const int row = rowb + ai * 128 + m * 16; float ss = 0.f;
#pragma unroll
                for (int bj = 0; bj < 2; ++bj)
#pragma unroll
                    for (int n = 0; n < 2; ++n) {
                        const size_t off = (size_t)row * DM + col0 + bj * 128 + n * 16;
                        const f32x4 y = *(const f32x4*)(x + off) + acc[ai][bj][m][n];
                        *(f32x4*)(out + off) = y; ss += (y[0] * y[0] + y[1] * y[1]) + (y[2] * y[2] + y[3] * y[3]);
                    }
                ss += __shfl_xor(ss, 16); ss += __shfl_xor(ss, 32);
                if (fq == 0) atomicAdd(rowss + row, ss);
            }
    }
};

__device__ __forceinline__ int src_col(int np) {
    if (np < 4096) return np;
    if (np < 7680) return np + 16;
    if (np < 7744) return 7696 + (np - 7680);
    if (np < 7752) return 4096 + (np - 7744);
    if (np < 7760) return 4104 + (np - 7752);
    if (np < 7776) return np;
    return -1;
}
__device__ __forceinline__ void phase0(const Params& p, unsigned char* smem) {
    const int tid = threadIdx.x, wid = tid >> 6, lane = tid & 63;
    const int gw = blockIdx.x * 8 + wid, nw = gridDim.x * 8;
    h16* H = (h16*)(p.ws + OFF_H);
    for (int row = gw; row < BT; row += nw) {
        const f32x4* xr = (const f32x4*)(p.x + (size_t)row * DM);
        f32x4 v[8]; float ss = 0.f;
#pragma unroll
        for (int i = 0; i < 8; ++i) { v[i] = xr[lane + 64 * i]; ss += (v[i][0] * v[i][0] + v[i][1] * v[i][1]) + (v[i][2] * v[i][2] + v[i][3] * v[i][3]); }
        ss = wave_sum(ss);
        const float r = 1.0f / sqrtf(ss * (1.0f / DM) + EPS);
#pragma unroll
        for (int i = 0; i < 8; ++i) { const f32x4 g = ((const f32x4*)p.attn_g)[lane + 64 * i]; h16x4 o;
#pragma unroll
            for (int j = 0; j < 4; ++j) o[j] = (h16)(v[i][j] * r * g[j]);
            *(h16x4*)(H + (size_t)row * DM + 4 * (lane + 64 * i)) = o; }
    }
    float* tile = (float*)smem;
    h16* Wt = (h16*)(p.ws + OFF_WT);
    for (int tI = blockIdx.x; tI < 124 * 32; tI += gridDim.x) {
        const int n0 = (tI / 32) * 64, k0 = (tI % 32) * 64;
        __syncthreads();
        { const int nl = tid & 63; const int src = src_col(n0 + nl);
#pragma unroll
          for (int i = 0; i < 8; ++i) { const int kl = (tid >> 6) + 8 * i; tile[kl * 65 + nl] = src >= 0 ? p.w_in[(size_t)(k0 + kl) * IN_COLS + src] : 0.f; } }
        __syncthreads();
        { const int nl = tid >> 3, kc = tid & 7; h16x8 o;
#pragma unroll
          for (int j = 0; j < 8; ++j) o[j] = (h16)tile[(8 * kc + j) * 65 + nl];
          *(h16x8*)(Wt + (size_t)(n0 + nl) * 2048 + k0 + 8 * kc) = o; }
    }
    h16* WoT = (h16*)(p.ws + OFF_WOT);
    for (int tI = blockIdx.x; tI < 32 * 32; tI += gridDim.x) {
        const int n0 = (tI / 32) * 64, k0 = (tI % 32) * 64;
        __syncthreads();
        { const int nl = tid & 63;
#pragma unroll
          for (int i = 0; i < 8; ++i) { const int kl = (tid >> 6) + 8 * i; tile[kl * 65 + nl] = p.w_out[(size_t)(k0 + kl) * DM + n0 + nl]; } }
        __syncthreads();
        { const int nl = tid >> 3, kc = tid & 7; h16x8 o;
#pragma unroll
          for (int j = 0; j < 8; ++j) o[j] = (h16)tile[(8 * kc + j) * 65 + nl];
          *(h16x8*)(WoT + (size_t)(n0 + nl) * 2048 + k0 + 8 * kc) = o; }
    }
    __syncthreads();
    float* cosT = (float*)(p.ws + OFF_COS); float* sinT = (float*)(p.ws + OFF_SIN);
    for (int i = blockIdx.x * 512 + tid; i < BT * 24; i += gridDim.x * 512) {
        const int row = i / 24, j = i % 24;
        const float ex = (j < 16) ? (float)j * (2.0f / 32.0f) : (float)(j - 16) * (2.0f / 16.0f);
        const float inv = powf(500000.0f, -ex);
        const float ang = (float)p.pos[row] * inv;
        cosT[i] = cosf(ang); sinT[i] = sinf(ang);
    }
}

constexpr int REC_BYTES = 74752, REC_WF = 0, REC_QF = 16384, REC_AF = 32768, REC_KTF = 40960, REC_UF = 57344, REC_VEC = 73728;
constexpr int HB_BYTES = 69632;

__device__ __forceinline__ void gdn_prep_pair(const Params& p, unsigned char* smem, int pair) {
    const int tid = opaque_tid(), wid = __builtin_amdgcn_readfirstlane(tid >> 6), lane = tid & 63, hb = wid >> 2, w4 = wid & 3, tl = tid & 255;
    const int tk = 2 * pair + hb; const int b = tk >> 9, h = (tk >> 6) & 7, n = tk & 63; const int t0 = n * 64;
    unsigned char* base = smem + hb * HB_BYTES;
    h16* Kn = (h16*)base; h16* Qn = Kn + 64 * 136; h16* Vh = Qn + 64 * 136; float* L = (float*)(Vh + 64 * 136); float* vec = L + 4096;
    unsigned char* rec = p.ws + OFF_REC + (size_t)tk * REC_BYTES;
    const h16* qkvr = (const h16*)(p.ws + OFF_QKVR);
    __syncthreads();
    {
        const int cg = tl & 15, rg = tl >> 4;
#pragma unroll 1
        for (int ti = 0; ti < 3; ++ti) {
            const int chan = ti * 1024 + h * 128 + 8 * cg;
            float xr[7][8];
#pragma unroll
            for (int r = 0; r < 7; ++r) {
                const int trow = t0 + 4 * rg - 3 + r;
                h16x8 v;
                if (trow >= 0) v = *(const h16x8*)(qkvr + ((size_t)b * NT + trow) * 3072 + chan);
                else { for (int j = 0; j < 8; ++j) v[j] = (h16)0.f; }
#pragma unroll
                for (int j = 0; j < 8; ++j) xr[r][j] = (float)v[j];
            }
            float wv[4][8];
#pragma unroll
            for (int tp = 0; tp < 4; ++tp) { const f32x4 a = *(const f32x4*)(p.conv_w + (size_t)tp * 3072 + chan), c = *(const f32x4*)(p.conv_w + (size_t)tp * 3072 + chan + 4);
#pragma unroll
                for (int j = 0; j < 4; ++j) { wv[tp][j] = a[j]; wv[tp][4 + j] = c[j]; } }
            h16* dst = (ti == 0) ? Qn : (ti == 1 ? Kn : Vh);
#pragma unroll
            for (int r = 0; r < 4; ++r) {
                float y[8]; float ss = 0.f;
#pragma unroll
                for (int j = 0; j < 8; ++j) { float a = wv[0][j] * xr[r][j] + wv[1][j] * xr[r + 1][j] + wv[2][j] * xr[r + 2][j] + wv[3][j] * xr[r + 3][j]; a = a / (1.0f + __expf(-a)); y[j] = a; ss += a * a; }
                float sc = 1.f;
                if (ti < 2) { ss += __shfl_xor(ss, 1); ss += __shfl_xor(ss, 2); ss += __shfl_xor(ss, 4); ss += __shfl_xor(ss, 8); sc = (ti == 0 ? 0.08838834764831845f : 1.0f) / sqrtf(ss + EPS); }
                h16x8 o;
#pragma unroll
                for (int j = 0; j < 8; ++j) o[j] = (h16)(y[j] * sc);
                *(h16x8*)(dst + (4 * rg + r) * 136 + 8 * cg) = o;
            }
        }
    }
    if (tl < 64) {
        const float* gb = (const float*)(p.ws + OFF_GB) + ((size_t)b * NT + t0 + tl) * 16;
        const float g = gb[h], be = gb[8 + h];
        float gc = g;
#pragma unroll
        for (int o = 1; o < 64; o <<= 1) { const float tt = __shfl_up(gc, o); if (lane >= o) gc += tt; }
        const float gl = __shfl(gc, 63);
        vec[tl] = g; vec[64 + tl] = be; vec[128 + tl] = gc; vec[192 + tl] = __expf(gc);
        float* rv = (float*)(rec + REC_VEC);
        rv[tl] = __expf(gc); rv[64 + tl] = __expf(gl - gc); if (tl == 0) rv[128] = __expf(gl);
    }
    __syncthreads();
    {
        const int rt = w4, fr = lane & 15, kg = lane >> 4;
        h16x8 Ak[4], Aq[4];
#pragma unroll
        for (int s = 0; s < 4; ++s) { Ak[s] = *(const h16x8*)(Kn + (16 * rt + fr) * 136 + 32 * s + 8 * kg); Aq[s] = *(const h16x8*)(Qn + (16 * rt + fr) * 136 + 32 * s + 8 * kg); }
        h16* AF = (h16*)(rec + REC_AF);
#pragma unroll
        for (int ct = 0; ct < 4; ++ct) {
            f32x4 kk = (f32x4){0.f, 0.f, 0.f, 0.f}, qk = (f32x4){0.f, 0.f, 0.f, 0.f};
#pragma unroll
            for (int s = 0; s < 4; ++s) { const h16x8 Bk = *(const h16x8*)(Kn + (16 * ct + fr) * 136 + 32 * s + 8 * kg);
                kk = __builtin_amdgcn_mfma_f32_16x16x32_f16(Ak[s], Bk, kk, 0, 0, 0); qk = __builtin_amdgcn_mfma_f32_16x16x32_f16(Aq[s], Bk, qk, 0, 0, 0); }
            const int j = 16 * ct + fr; const float gcj = vec[128 + j];
#pragma unroll
            for (int rgi = 0; rgi < 4; ++rgi) {
                const int i = 16 * rt + 4 * kg + rgi;
                const float dec = (i >= j) ? __expf(vec[128 + i] - gcj) : 0.f;
                L[i * 64 + j] = (i > j) ? vec[64 + i] * kk[rgi] * dec : 0.f;
                const int sp = ct >> 1, kgp = fr >> 2, j8 = (ct & 1) * 4 + (fr & 3), lanep = 16 * kgp + 4 * kg + rgi;
                AF[((rt * 2 + sp) * 64 + lanep) * 8 + j8] = (h16)(qk[rgi] * dec);
            }
        }
    }
    __syncthreads();
    float X[64];
#pragma unroll
    for (int i = 0; i < 64; ++i) X[i] = 0.f;
    {
        const bool isw = tl < 128;
        const h16* colp = isw ? (Kn + tl) : (Vh + (tl - 128));
#pragma unroll
        for (int i = 0; i < 64; ++i) {
            const float be = vec[64 + i], sc = be * (isw ? vec[192 + i] : 1.0f);
            float acc = sc * (float)colp[i * 136];
#pragma unroll
            for (int jj = 0; jj < (i + 3) / 4; ++jj) { const f32x4 l4 = *(const f32x4*)(L + i * 64 + 4 * jj);
                acc -= l4[0] * X[4 * jj]; acc -= l4[1] * X[4 * jj + 1]; acc -= l4[2] * X[4 * jj + 2]; acc -= l4[3] * X[4 * jj + 3]; }
            asm volatile("" : "+v"(acc) :: "memory");
            X[i] = acc;
        }
    }
    if (tl < 128) {
        h16* WF = (h16*)(rec + REC_WF); const int d = tl, s = d >> 5, dd = d & 31;
        const int kgp = (dd < 16) ? (dd >> 2) : ((dd - 16) >> 2), j8 = (dd < 16) ? (dd & 3) : 4 + (dd & 3);
#pragma unroll
        for (int i = 0; i < 64; ++i) { const int rt = i >> 4, row = i & 15; WF[((rt * 4 + s) * 64 + 16 * kgp + row) * 8 + j8] = (h16)(-X[i]); }
    } else {
        h16* UF = (h16*)(rec + REC_UF); const int e = tl - 128, dvb = e >> 4;
#pragma unroll
        for (int i = 0; i < 64; ++i) { const int rt = i >> 4, kg = (i & 15) >> 2, rgi = i & 3; UF[((dvb * 4 + rt) * 64 + 16 * kg + (e & 15)) * 4 + rgi] = (h16)X[i]; }
    }
    {
        h16* QF = (h16*)(rec + REC_QF);
#pragma unroll
        for (int it = 0; it < 4; ++it) { const int f = tl + 256 * it; const int lanep = f & 63, s = (f >> 6) & 3, rt = f >> 8; const int row = 16 * rt + (lanep & 15), kgp = lanep >> 4;
            const h16x4 a = *(const h16x4*)(Qn + row * 136 + 32 * s + 4 * kgp), c = *(const h16x4*)(Qn + row * 136 + 32 * s + 16 + 4 * kgp);
            h16x8 o; o[0] = a[0]; o[1] = a[1]; o[2] = a[2]; o[3] = a[3]; o[4] = c[0]; o[5] = c[1]; o[6] = c[2]; o[7] = c[3];
            *(h16x8*)(QF + (size_t)f * 8) = o; }
        h16* KTF = (h16*)(rec + REC_KTF);
#pragma unroll
        for (int it = 0; it < 4; ++it) { const int f = tl + 256 * it; const int lanep = f & 63, sp = (f >> 6) & 1, rt = f >> 7; const int d = 16 * rt + (lanep & 15), kgp = lanep >> 4;
            h16x8 o;
#pragma unroll
            for (int j8 = 0; j8 < 8; ++j8) { const int c = 32 * sp + (j8 < 4 ? 4 * kgp + j8 : 16 + 4 * kgp + (j8 - 4)); o[j8] = Kn[c * 136 + d]; }
            *(h16x8*)(KTF + (size_t)f * 8) = o; }
    }
}

__device__ __forceinline__ h16x8 pack8(const f32x4 a, const f32x4 c) { h16x8 o; o[0] = (h16)a[0]; o[1] = (h16)a[1]; o[2] = (h16)a[2]; o[3] = (h16)a[3]; o[4] = (h16)c[0]; o[5] = (h16)c[1]; o[6] = (h16)c[2]; o[7] = (h16)c[3]; return o; }

__device__ __forceinline__ void gdn_scan_task(const Params& p, unsigned char* smem, int bh) {
    const int tid = opaque_tid(), wid = __builtin_amdgcn_readfirstlane(tid >> 6), lane = tid & 63, kg = lane >> 4, fr = lane & 15;
    const int b = bh >> 3, h = bh & 7;
    LAS unsigned char* lds = (LAS unsigned char*)smem;
    const unsigned char* rec0 = p.ws + OFF_REC + (size_t)(bh * 64) * REC_BYTES;
    h16* OB = (h16*)(smem + 114688);
    const h16* gz = (const h16*)(p.ws + OFF_GZ); h16* omix = (h16*)(p.ws + OFF_OMIX);
    const float ng0 = p.gdn_norm_g[2 * lane], ng1 = p.gdn_norm_g[2 * lane + 1];
    f32x4 Sacc[8];
#pragma unroll
    for (int t = 0; t < 8; ++t) Sacc[t] = (f32x4){0.f, 0.f, 0.f, 0.f};
    h16x4 Uc[4], Un[4]; f32x4 egc[4], ekc[4], egn[4], ekn[4]; float eglc, egln;
    __syncthreads();
#define GDN_GLDS(recp, bufi) do { _Pragma("unroll") for (int _i = 0; _i < 7; ++_i) \
        __builtin_amdgcn_global_load_lds((const unsigned*)((recp) + (size_t)(_i * 512 + tid) * 16), (LAS unsigned*)(lds + (bufi) * 57344 + (_i * 512 + wid * 64) * 16), 16, 0, 0); } while (0)
#define GDN_LDREG(recp, U_, eg_, ek_, egl_) do { _Pragma("unroll") for (int rt = 0; rt < 4; ++rt) { \
        U_[rt] = *(const h16x4*)((recp) + REC_UF + (size_t)((wid * 4 + rt) * 64 + lane) * 8); \
        eg_[rt] = *(const f32x4*)((recp) + REC_VEC + (16 * rt + 4 * kg) * 4); ek_[rt] = *(const f32x4*)((recp) + REC_VEC + 256 + (16 * rt + 4 * kg) * 4); } \
        egl_ = *(const float*)((recp) + REC_VEC + 512); } while (0)
    GDN_GLDS(rec0, 0);
    GDN_LDREG(rec0, Uc, egc, ekc, eglc);
    asm volatile("s_waitcnt vmcnt(0)" ::: "memory");
    __syncthreads();
    for (int n = 0; n < 64; ++n) {
        const unsigned char* recn = rec0 + (size_t)(n + 1) * REC_BYTES;
        if (n + 1 < 64) { GDN_GLDS(recn, (n + 1) & 1); GDN_LDREG(recn, Un, egn, ekn, egln); }
        if (n > 0) {
            const h16* Ob = OB + ((n - 1) & 1) * 8192;
#pragma unroll
            for (int rr = 0; rr < 8; ++rr) { const int c = 8 * wid + rr; const h16x2 ov = *(const h16x2*)(Ob + c * 128 + 2 * lane);
                const float o0 = (float)ov[0], o1 = (float)ov[1]; const float ss = wave_sum(o0 * o0 + o1 * o1); const float r = 1.0f / sqrtf(ss * (1.0f / 128.0f) + EPS);
                const size_t bt = (size_t)b * NT + 64 * (n - 1) + c; const h16x2 gt = *(const h16x2*)(gz + bt * 1024 + h * 128 + 2 * lane);
                h16x2 o; o[0] = (h16)(o0 * r * ng0 * (float)gt[0]); o[1] = (h16)(o1 * r * ng1 * (float)gt[1]);
                *(h16x2*)(omix + bt * 2048 + h * 128 + 2 * lane) = o; }
        }
        const LAS unsigned char* bufp = lds + (n & 1) * 57344;
        h16x8 SB[4];
#pragma unroll
        for (int s = 0; s < 4; ++s) SB[s] = pack8(Sacc[2 * s], Sacc[2 * s + 1]);
        f32x4 vacc[4], oacc[4];
#pragma unroll
        for (int rt = 0; rt < 4; ++rt) { vacc[rt] = (f32x4){(float)Uc[rt][0], (float)Uc[rt][1], (float)Uc[rt][2], (float)Uc[rt][3]}; oacc[rt] = (f32x4){0.f, 0.f, 0.f, 0.f}; }
#pragma unroll
        for (int rt = 0; rt < 4; ++rt)
#pragma unroll
            for (int s = 0; s < 4; ++s) { const h16x8 a = *(const LAS h16x8*)(bufp + REC_WF + ((rt * 4 + s) * 64 + lane) * 16); vacc[rt] = __builtin_amdgcn_mfma_f32_16x16x32_f16(a, SB[s], vacc[rt], 0, 0, 0); }
#pragma unroll
        for (int rt = 0; rt < 4; ++rt)
#pragma unroll
            for (int s = 0; s < 4; ++s) { const h16x8 a = *(const LAS h16x8*)(bufp + REC_QF + ((rt * 4 + s) * 64 + lane) * 16); oacc[rt] = __builtin_amdgcn_mfma_f32_16x16x32_f16(a, SB[s], oacc[rt], 0, 0, 0); }
#pragma unroll
        for (int rt = 0; rt < 4; ++rt) oacc[rt] = oacc[rt] * egc[rt];
        h16x8 VB[2], VKB[2];
#pragma unroll
        for (int sp = 0; sp < 2; ++sp) { VB[sp] = pack8(vacc[2 * sp], vacc[2 * sp + 1]); VKB[sp] = pack8(vacc[2 * sp] * ekc[2 * sp], vacc[2 * sp + 1] * ekc[2 * sp + 1]); }
#pragma unroll
        for (int rt = 0; rt < 4; ++rt)
#pragma unroll
            for (int sp = 0; sp < 2; ++sp) { const h16x8 a = *(const LAS h16x8*)(bufp + REC_AF + ((rt * 2 + sp) * 64 + lane) * 16); oacc[rt] = __builtin_amdgcn_mfma_f32_16x16x32_f16(a, VB[sp], oacc[rt], 0, 0, 0); }
#pragma unroll
        for (int t = 0; t < 8; ++t) { Sacc[t] = Sacc[t] * eglc;
#pragma unroll
            for (int sp = 0; sp < 2; ++sp) { const h16x8 a = *(const LAS h16x8*)(bufp + REC_KTF + ((t * 2 + sp) * 64 + lane) * 16); Sacc[t] = __builtin_amdgcn_mfma_f32_16x16x32_f16(a, VKB[sp], Sacc[t], 0, 0, 0); } }
        { h16* Ob = OB + (n & 1) * 8192;
#pragma unroll
          for (int rt = 0; rt < 4; ++rt)
#pragma unroll
              for (int rgi = 0; rgi < 4; ++rgi) Ob[(16 * rt + 4 * kg + rgi) * 128 + 16 * wid + fr] = (h16)oacc[rt][rgi]; }
        asm volatile("s_waitcnt vmcnt(0)" ::: "memory");
        __syncthreads();
#pragma unroll
        for (int rt = 0; rt < 4; ++rt) { Uc[rt] = Un[rt]; egc[rt] = egn[rt]; ekc[rt] = ekn[rt]; }
        eglc = egln;
    }
    {
        const h16* Ob = OB + 8192;
#pragma unroll
        for (int rr = 0; rr < 8; ++rr) { const int c = 8 * wid + rr; const h16x2 ov = *(const h16x2*)(Ob + c * 128 + 2 * lane);
            const float o0 = (float)ov[0], o1 = (float)ov[1]; const float ss = wave_sum(o0 * o0 + o1 * o1); const float r = 1.0f / sqrtf(ss * (1.0f / 128.0f) + EPS);
            const size_t bt = (size_t)b * NT + 64 * 63 + c; const h16x2 gt = *(const h16x2*)(gz + bt * 1024 + h * 128 + 2 * lane);
            h16x2 o; o[0] = (h16)(o0 * r * ng0 * (float)gt[0]); o[1] = (h16)(o1 * r * ng1 * (float)gt[1]);
            *(h16x2*)(omix + bt * 2048 + h * 128 + 2 * lane) = o; }
    }
#undef GDN_GLDS
#undef GDN_LDREG
}

__device__ __forceinline__ unsigned f2key(float x) { const unsigned u = __float_as_uint(x); return (u & 0x80000000u) ? ~u : (u | 0x80000000u); }
typedef float f32x16 __attribute__((ext_vector_type(16)));
__device__ __forceinline__ float wave_min(float v) {
#pragma unroll
    for (int o = 1; o < 64; o <<= 1) v = fminf(v, __shfl_xor(v, o));
    return v;
}
__device__ __forceinline__ unsigned lane_below(unsigned long long m) { return __builtin_amdgcn_mbcnt_hi((unsigned)(m >> 32), __builtin_amdgcn_mbcnt_lo((unsigned)m, 0u)); }
__device__ __forceinline__ void idx8_task(const Params& p, unsigned char* smem, int b, int qb) {
    const int tid = opaque_tid(), wid = __builtin_amdgcn_readfirstlane(tid >> 6), lane = tid & 63;
    const int t0 = qb * 8;
    unsigned short* selg = (unsigned short*)(p.ws + OFF_SEL) + ((size_t)b * NT + t0) * 256;
    if (t0 + 8 <= 256) {
        for (int i = tid; i < 8 * 256; i += 512) { const int q = i >> 8, k = i & 255; selg[i] = (unsigned short)(k <= t0 + q ? k : 0); }
        return;
    }
    float* sc = (float*)smem;
    unsigned* hist = (unsigned*)(smem + 131072 + wid * 2048);
    unsigned* cand = hist + 256;
    __syncthreads();
    {
        const int n8 = t0 + 8;
        const int ntile = (n8 + 31) >> 5, ntile_pad = ((n8 + 255) >> 8) << 3;
        const h16* iq = (const h16*)(p.ws + OFF_IQ) + ((size_t)b * NT + t0) * 1024;
        const float* iw = (const float*)(p.ws + OFF_IW) + ((size_t)b * NT + t0) * 16;
        const h16* ik = (const h16*)(p.ws + OFF_IK) + (size_t)b * NT * 64;
        const int r = lane & 31, kh = lane >> 5, qq = (r >> 2) & 1, hh = (r & 3) + 4 * (r >> 3);
        h16x8 Af[4][4]; f32x4 Wr[4][4];
#pragma unroll
        for (int a = 0; a < 4; ++a) {
#pragma unroll
            for (int s = 0; s < 4; ++s) Af[a][s] = *(const h16x8*)(iq + (size_t)(2 * a + qq) * 1024 + hh * 64 + 16 * s + 8 * kh);
#pragma unroll
            for (int c = 0; c < 4; ++c) Wr[a][c] = *(const f32x4*)(iw + (size_t)(2 * a + kh) * 16 + 4 * c);
        }
        for (int i = wid; i < ntile_pad; i += 8) {
            const int key = 32 * i + r;
            if (i < ntile) {
                h16x8 Bf[4];
#pragma unroll
                for (int s = 0; s < 4; ++s) Bf[s] = *(const h16x8*)(ik + (size_t)key * 64 + 16 * s + 8 * kh);
#pragma unroll
                for (int a = 0; a < 4; ++a) {
                    f32x16 acc;
#pragma unroll
                    for (int e = 0; e < 16; ++e) acc[e] = 0.f;
#pragma unroll
                    for (int s = 0; s < 4; ++s) acc = __builtin_amdgcn_mfma_f32_32x32x16_f16(Af[a][s], Bf[s], acc, 0, 0, 0);
                    float s0 = 0.f;
#pragma unroll
                    for (int e = 0; e < 16; ++e) s0 += Wr[a][e >> 2][e & 3] * fmaxf(acc[e], 0.f);
                    const int q = 2 * a + kh;
                    sc[q * 4096 + key] = (key > t0 + q) ? -INFINITY : s0;
                }
            } else {
#pragma unroll
                for (int a = 0; a < 4; ++a) sc[(2 * a + kh) * 4096 + key] = -INFINITY;
            }
        }
    }
    __syncthreads();
    {
        const int tq = t0 + wid, n = tq + 1;
        const float* row = sc + wid * 4096;
        const int ng = (n + 255) >> 8;
        f32x4 x[16];
#pragma unroll
        for (int g = 0; g < 16; ++g) { if (g < ng) x[g] = *(const f32x4*)(row + 256 * g + 4 * lane); else x[g] = (f32x4){-INFINITY, -INFINITY, -INFINITY, -INFINITY}; }
        float hi = -INFINITY, lo = INFINITY;
#pragma unroll
        for (int g = 0; g < 16; ++g)
#pragma unroll
            for (int c = 0; c < 4; ++c) { const float v = x[g][c]; hi = fmaxf(hi, v); lo = fminf(lo, v == -INFINITY ? INFINITY : v); }
        hi = wave_max(hi); lo = wave_min(lo);
        const float scale = (hi > lo) ? 255.99f / (hi - lo) : 0.f; const float off = -lo * scale;
        *(u32x4*)(hist + 4 * lane) = (u32x4){0u, 0u, 0u, 0u};
#pragma unroll
        for (int g = 0; g < 16; ++g) { if (g < ng) {
#pragma unroll
            for (int c = 0; c < 4; ++c) { int bin = (int)fmaf(x[g][c], scale, off); bin = bin < 0 ? 0 : (bin > 255 ? 255 : bin); atomicAdd(&hist[bin], 1u); } } }
        unsigned bstar, need;
        {
            const u32x4 h4 = *(const u32x4*)(hist + 4 * lane); const unsigned s = h4[0] + h4[1] + h4[2] + h4[3];
            unsigned suf = s;
#pragma unroll
            for (int o = 1; o < 64; o <<= 1) { const unsigned tt = __shfl_down(suf, o); if (lane + o < 64) suf += tt; }
            const unsigned above = suf - s;
            const bool mine = (above < 256u && 256u <= suf);
            unsigned cum = above; unsigned bin = 0;
            if (cum + h4[3] >= 256u) bin = 3; else { cum += h4[3]; if (cum + h4[2] >= 256u) bin = 2; else { cum += h4[2]; if (cum + h4[1] >= 256u) bin = 1; else { cum += h4[1]; bin = 0; } } }
            const unsigned long long mm = __ballot(mine);
            const int src = (int)__builtin_ctzll(mm);
            bstar = (unsigned)__shfl((int)(4 * lane + bin), src); need = (unsigned)__shfl((int)(256u - cum), src);
        }
        unsigned m = 0;
#pragma unroll
        for (int g = 0; g < 16; ++g) { if (g < ng) {
#pragma unroll
            for (int c = 0; c < 4; ++c) { int bin = (int)fmaf(x[g][c], scale, off); bin = bin < 0 ? 0 : (bin > 255 ? 255 : bin);
                const bool pr = ((unsigned)bin == bstar); const unsigned long long mk = __ballot(pr);
                if (mk) { const unsigned pos = m + lane_below(mk); if (pr && pos < 256u) cand[pos] = f2key(x[g][c]); m += (unsigned)__builtin_popcountll(mk); } } } }
        unsigned Kt = 0, rr = need;
        if (m <= 256u) {
            const int nc = (int)((m + 63u) >> 6);
            unsigned c0 = (lane < (int)m) ? cand[lane] : 0u, c1 = (64 + lane < (int)m) ? cand[64 + lane] : 0u, c2 = (128 + lane < (int)m) ? cand[128 + lane] : 0u, c3 = (192 + lane < (int)m) ? cand[192 + lane] : 0u;
            for (int bit = 31; bit >= 0; --bit) {
                const unsigned test = (Kt | (1u << bit)) >> bit;
                unsigned cnt = (unsigned)__builtin_popcountll(__ballot((c0 >> bit) == test));
                if (nc > 1) cnt += (unsigned)__builtin_popcountll(__ballot((c1 >> bit) == test));
                if (nc > 2) cnt += (unsigned)__builtin_popcountll(__ballot((c2 >> bit) == test));
                if (nc > 3) cnt += (unsigned)__builtin_popcountll(__ballot((c3 >> bit) == test));
                if (cnt >= rr) Kt |= (1u << bit); else rr -= cnt;
            }
        } else {
            for (int bit = 31; bit >= 0; --bit) {
                const unsigned test = (Kt | (1u << bit)) >> bit; unsigned cnt = 0;
                for (int idx = lane; idx < ng * 256; idx += 64) { const float v = row[idx]; int bin = (int)fmaf(v, scale, off); bin = bin < 0 ? 0 : (bin > 255 ? 255 : bin);
                    const bool pr = ((unsigned)bin == bstar) && ((f2key(v) >> bit) == test); cnt += (unsigned)__builtin_popcountll(__ballot(pr)); }
                if (cnt >= rr) Kt |= (1u << bit); else rr -= cnt;
            }
        }
        unsigned short* so = selg + (size_t)wid * 256;
        unsigned outb = 0, eqb = 0;
#pragma unroll
        for (int g = 0; g < 16; ++g) { if (g < ng) {
#pragma unroll
            for (int c = 0; c < 4; ++c) { const unsigned k = f2key(x[g][c]); const bool gt = k > Kt; bool eq = (k == Kt);
                const unsigned long long me = __ballot(eq); bool take = gt;
                if (me) { const unsigned er = eqb + lane_below(me); take = gt || (eq && er < rr); eqb += (unsigned)__builtin_popcountll(me); }
                const unsigned long long mt = __ballot(take);
                if (mt) { const unsigned pos = outb + lane_below(mt); if (take) so[pos] = (unsigned short)(256 * g + 4 * lane + c); outb += (unsigned)__builtin_popcountll(mt); } } } }
    }
}

typedef short v4s_t __attribute__((__vector_size__(4 * sizeof(short))));
__device__ __forceinline__ h16x4 lds_tr16(const LAS unsigned char* a) { const v4s_t v = __builtin_amdgcn_ds_read_tr16_b64_v4i16((LAS v4s_t*)a); return __builtin_bit_cast(h16x4, v); }
__device__ __forceinline__ void attn4_task(const Params& p, unsigned char* smem, int task) {
    const int tid = opaque_tid(), wid = __builtin_amdgcn_readfirstlane(tid >> 6), lane = tid & 63, kg = lane >> 4, fr = lane & 15;
    const int bt = task * 4 + (wid >> 1), g = wid & 1; const int b = bt / NT, t = bt % NT; const int nvalid = (t + 1) < 256 ? (t + 1) : 256;
    unsigned char* vl = smem + wid * 17408;
    LAS unsigned char* vll = (LAS unsigned char*)vl;
    unsigned short* sl = (unsigned short*)(vl + 16384);
    const h16* akb = (const h16*)(p.ws + OFF_AK) + (size_t)b * NT * 256 + g * 128;
    const h16* avb = (const h16*)(p.ws + OFF_AV) + (size_t)b * NT * 256 + g * 128;
    { const h16x4 s4 = *(const h16x4*)((const h16*)(p.ws + OFF_SEL) + (size_t)bt * 256 + 4 * lane); *(h16x4*)(sl + 4 * lane) = s4; }
    h16x8 Qf[4];
#pragma unroll
    for (int s = 0; s < 4; ++s) { if (fr < 4) Qf[s] = *(const h16x8*)((const h16*)(p.ws + OFF_AQ) + (size_t)bt * 1024 + (4 * g + fr) * 128 + 32 * s + 8 * kg);
        else { for (int j = 0; j < 8; ++j) Qf[s][j] = (h16)0.f; } }
    f32x4 lg[16];
#pragma unroll
    for (int ib = 0; ib < 4; ++ib) {
        h16x8 Kf[4][4];
#pragma unroll
        for (int ii = 0; ii < 4; ++ii) { const int key = sl[16 * (4 * ib + ii) + fr];
#pragma unroll
            for (int s = 0; s < 4; ++s) Kf[ii][s] = *(const h16x8*)(akb + (size_t)key * 256 + 32 * s + 8 * kg); }
#pragma unroll
        for (int ii = 0; ii < 4; ++ii) { f32x4 a = (f32x4){0.f, 0.f, 0.f, 0.f};
#pragma unroll
            for (int s = 0; s < 4; ++s) a = __builtin_amdgcn_mfma_f32_16x16x32_f16(Kf[ii][s], Qf[s], a, 0, 0, 0);
            lg[4 * ib + ii] = a; }
    }
    float m = -INFINITY;
#pragma unroll
    for (int i = 0; i < 16; ++i)
#pragma unroll
        for (int r = 0; r < 4; ++r) { const int slot = 16 * i + 4 * kg + r; const float v = (slot < nvalid) ? lg[i][r] : -INFINITY; lg[i][r] = v; m = fmaxf(m, v); }
    m = fmaxf(m, __shfl_xor(m, 16)); m = fmaxf(m, __shfl_xor(m, 32));
    float sum = 0.f;
#pragma unroll
    for (int i = 0; i < 16; ++i)
#pragma unroll
        for (int r = 0; r < 4; ++r) { const float e = __expf(lg[i][r] - m); lg[i][r] = e; sum += e; }
    sum += __shfl_xor(sum, 16); sum += __shfl_xor(sum, 32);
    const float inv = 1.0f / sum;
    h16x8 Pf[8];
#pragma unroll
    for (int ip = 0; ip < 8; ++ip) Pf[ip] = pack8(lg[2 * ip] * inv, lg[2 * ip + 1] * inv);
    f32x4 O[8];
#pragma unroll
    for (int ct = 0; ct < 8; ++ct) O[ct] = (f32x4){0.f, 0.f, 0.f, 0.f};
    const int q4 = fr >> 2, pp = fr & 3;
#pragma unroll
    for (int cq = 0; cq < 4; ++cq) {
        h16x8 Vr[16];
#pragma unroll
        for (int it = 0; it < 16; ++it) { const int key = sl[64 * cq + 4 * it + kg]; Vr[it] = *(const h16x8*)(avb + (size_t)key * 256 + 8 * fr); }
#pragma unroll
        for (int it = 0; it < 16; ++it) { const int r = 4 * it + kg; *(h16x8*)(vl + r * 256 + (((((fr >> 1) ^ (r & 7)) << 1) | (fr & 1)) << 4)) = Vr[it]; }
#pragma unroll
        for (int ipl = 0; ipl < 2; ++ipl) {
            const int r = 32 * ipl + 4 * kg + q4;
#pragma unroll
            for (int ct = 0; ct < 8; ++ct) {
                const LAS unsigned char* a0 = vll + r * 256 + ((((ct ^ (r & 7)) << 1) | (pp >> 1)) << 4) + (pp & 1) * 8;
                const h16x4 lo = lds_tr16(a0), hi4 = lds_tr16(a0 + 4096);
                h16x8 Bv; Bv[0] = lo[0]; Bv[1] = lo[1]; Bv[2] = lo[2]; Bv[3] = lo[3]; Bv[4] = hi4[0]; Bv[5] = hi4[1]; Bv[6] = hi4[2]; Bv[7] = hi4[3];
                O[ct] = __builtin_amdgcn_mfma_f32_16x16x32_f16(Pf[2 * cq + ipl], Bv, O[ct], 0, 0, 0);
            }
        }
    }
    if (kg == 0) {
        const h16* az = (const h16*)(p.ws + OFF_AZ) + (size_t)bt * 1024 + (4 * g) * 128; h16* om = (h16*)(p.ws + OFF_OMIX) + (size_t)bt * 2048 + 1024 + (4 * g) * 128;
#pragma unroll
        for (int ct = 0; ct < 8; ++ct)
#pragma unroll
            for (int r = 0; r < 4; ++r) om[r * 128 + 16 * ct + fr] = (h16)(O[ct][r] * (float)az[r * 128 + 16 * ct + fr]);
    }
}

__device__ __forceinline__ void phase5(const Params& p) {
    const int tid = threadIdx.x, wid = tid >> 6, lane = tid & 63;
    const int gw = blockIdx.x * 8 + wid, nw = gridDim.x * 8;
    const float* rowss = (const float*)(p.ws + OFF_ROWSS);
    for (int row = gw; row < BT; row += nw) {
        const float r = 1.0f / sqrtf(rowss[row] * (1.0f / DM) + EPS);
        f32x4* o = (f32x4*)(p.out + (size_t)row * DM);
#pragma unroll
        for (int i = 0; i < 8; ++i) { const f32x4 g = ((const f32x4*)p.final_g)[lane + 64 * i]; f32x4 v = o[lane + 64 * i]; v = v * r * g; o[lane + 64 * i] = v; }
    }
}

template <int LO, int HI>
__global__ void __launch_bounds__(512, 2) k_phases(Params p) {
    extern __shared__ __attribute__((aligned(16))) unsigned char smem[];
#define IN(k) (LO <= (k) && (k) < HI)
#define SEAM(k) do { if constexpr (IN(k) && IN((k) + 1)) { cg::this_grid().sync(); } } while (0)
    if constexpr (IN(0)) { phase0(p, smem); }
    SEAM(0);
    if constexpr (IN(1)) {
        pg8::Gemm g{(const h16*)(p.ws + OFF_H), (const h16*)(p.ws + OFF_WT), BT, NPAD, DM};
        pg8::StaticOrder S; S.init(BT, NPAD, gridDim.x, blockIdx.x);
        EpiIn E{p.ws, p.a_log, p.dt_bias};
        pg8::gemm_phase<EpiIn, pg8::StaticOrder>((LAS unsigned char*)smem, g, S, E);
    }
    SEAM(1);
    if constexpr (IN(2)) {
        {
            unsigned* qctr = (unsigned*)(p.ws + OFF_CTRL);
            unsigned* lds_t = (unsigned*)(smem + LDS_BYTES - 16);
            for (;;) {
                __syncthreads();
                if (threadIdx.x == 0) lds_t[0] = atomicAdd(qctr + 0, 1u);
                __syncthreads();
                const unsigned o = lds_t[0];
                if (o >= 1024u + 2048u) break;
                if (o < 1024u) gdn_prep_pair(p, smem, (int)o);
                else { const unsigned o2 = o - 1024u; idx8_task(p, smem, (int)(o2 & 3u), 511 - (int)(o2 >> 2)); }
            }
        }
    }
    SEAM(2);
    if constexpr (IN(3)) {
        {
            unsigned* qctr = (unsigned*)(p.ws + OFF_CTRL);
            unsigned* lds_t = (unsigned*)(smem + LDS_BYTES - 16);
            __syncthreads();
            if (threadIdx.x == 0) lds_t[0] = atomicAdd(qctr + 64, 1u);
            __syncthreads();
            const unsigned o = lds_t[0];
            if (o < 32u) gdn_scan_task(p, smem, (int)o);
            for (;;) {
                __syncthreads();
                if (threadIdx.x == 0) lds_t[0] = atomicAdd(qctr + 128, 1u);
                __syncthreads();
                const unsigned a = lds_t[0];
                if (a >= (unsigned)(BT / 4)) break;
                attn4_task(p, smem, (int)a);
            }
        }
    }
    SEAM(3);
    if constexpr (IN(4)) {
        pg8::Gemm g{(const h16*)(p.ws + OFF_OMIX), (const h16*)(p.ws + OFF_WOT), BT, DM, DM};
        pg8::StaticOrder S; S.init(BT, DM, gridDim.x, blockIdx.x);
        EpiOut E{p.x, p.out, (float*)(p.ws + OFF_ROWSS)};
        pg8::gemm_phase<EpiOut, pg8::StaticOrder>((LAS unsigned char*)smem, g, S, E);
    }
    SEAM(4);
    if constexpr (IN(5)) { phase5(p); }
#undef IN
#undef SEAM
}

template <int LO, int HI> static void launch_range(const Params& p, int grid, hipStream_t stream, bool coop) {
    static bool attr = false;
    if (!attr) { hipFuncSetAttribute((const void*)k_phases<LO, HI>, hipFuncAttributeMaxDynamicSharedMemorySize, LDS_BYTES); attr = true; }
    if (coop) {
        Params pp = p; void* args[] = {&pp};
        hipError_t e = hipLaunchCooperativeKernel((const void*)k_phases<LO, HI>, dim3(grid), dim3(512), args, LDS_BYTES, stream);
        if (e != hipSuccess) fprintf(stderr, "cooperative launch failed: %s (grid %d)\n", hipGetErrorString(e), grid);
    } else {
        hipLaunchKernelGGL((k_phases<LO, HI>), dim3(grid), dim3(512), LDS_BYTES, stream, p);
    }
}

extern "C" void kernel_launch(void* const* d_in, const int* in_sizes, int n_in, void* d_out, int out_size, void* d_ws, size_t ws_size, hipStream_t stream) {
    if (n_in != 10 || in_sizes[0] != BT * DM || out_size != BT * DM || ws_size < WS_END) {
        fprintf(stderr, "kernel_launch: unexpected shapes (n_in %d in0 %d out %d ws %zu need %zu)\n", n_in, n_in > 0 ? in_sizes[0] : -1, out_size, ws_size, (size_t)WS_END); return; }
    static int grid = 0;
    if (!grid) {
        int dev = 0, cus = 0, per_cu = 0; hipGetDevice(&dev); hipDeviceGetAttribute(&cus, hipDeviceAttributeMultiprocessorCount, dev);
#if FUSED
        hipFuncSetAttribute((const void*)k_phases<0, 6>, hipFuncAttributeMaxDynamicSharedMemorySize, LDS_BYTES);
        hipOccupancyMaxActiveBlocksPerMultiprocessor(&per_cu, (const void*)k_phases<0, 6>, 512, LDS_BYTES);
#else
        per_cu = 1;
#endif
        if (per_cu < 1) per_cu = 1; if (per_cu > 1) per_cu = 1;
        grid = cus * per_cu;
    }
    Params p{};
    p.x = (const float*)d_in[0]; p.pos = (const int*)d_in[1]; p.attn_g = (const float*)d_in[2]; p.w_in = (const float*)d_in[3]; p.conv_w = (const float*)d_in[4];
    p.a_log = (const float*)d_in[5]; p.dt_bias = (const float*)d_in[6]; p.gdn_norm_g = (const float*)d_in[7]; p.w_out = (const float*)d_in[8]; p.final_g = (const float*)d_in[9];
    p.out = (float*)d_out; p.ws = (unsigned char*)d_ws;
    hipMemsetAsync((char*)d_ws + OFF_CTRL, 0, CTL_ZERO_BYTES, stream);
#if FUSED
    launch_range<0, 6>(p, grid, stream, true);
#else
    launch_range<0, 1>(p, grid, stream, false);
    launch_range<1, 2>(p, grid, stream, false);
    launch_range<2, 3>(p, grid, stream, false);
    launch_range<3, 4>(p, grid, stream, false);
    launch_range<4, 5>(p, grid, stream, false);
    launch_range<5, 6>(p, grid, stream, false);
#endif
}
```

```cpp
#include <hip/hip_runtime.h>
#include <hip/hip_cooperative_groups.h>
#include <cstdio>
#include <cstdint>
namespace cg = cooperative_groups;

#ifndef FUSED
#define FUSED 1
#endif
#ifndef REPEAT_PHASE
#define REPEAT_PHASE -1
#endif
#define NREP(k) ((REPEAT_PHASE == (k)) ? 2 : 1)

#define LAS __attribute__((address_space(3)))
typedef _Float16 h16;
typedef h16 h16x8 __attribute__((ext_vector_type(8)));
typedef h16 h16x4 __attribute__((ext_vector_type(4)));
typedef h16 h16x2 __attribute__((ext_vector_type(2)));
typedef float f32x4 __attribute__((ext_vector_type(4)));
typedef float f32x2 __attribute__((ext_vector_type(2)));
typedef unsigned u32x4 __attribute__((ext_vector_type(4)));

constexpr int NB = 4, NT = 4096, DM = 2048, BT = NB * NT;
constexpr int IN_COLS = 7776, NPAD = 7936;
constexpr float EPS = 1e-6f;
constexpr int LDS_BYTES = 155648;

constexpr size_t MB = 1024 * 1024;
constexpr size_t OFF_CTRL = 0;
constexpr size_t OFF_ROWSS = 65536;
constexpr size_t CTL_ZERO_BYTES = 65536 + (size_t)BT * 4;
constexpr size_t OFF_H = 1 * MB;
constexpr size_t OFF_OMIX = OFF_H;
constexpr size_t OFF_WT = OFF_H + 64 * MB;
constexpr size_t OFF_WOT = OFF_WT + (size_t)NPAD * 2048 * 2;
constexpr size_t OFF_QKVR = OFF_WOT + 8 * MB;
constexpr size_t OFF_GZ = OFF_QKVR + (size_t)BT * 3072 * 2;
constexpr size_t OFF_AQ = OFF_GZ + 32 * MB;
constexpr size_t OFF_AK = OFF_AQ + 32 * MB;
constexpr size_t OFF_AV = OFF_AK + 8 * MB;
constexpr size_t OFF_AZ = OFF_AV + 8 * MB;
constexpr size_t OFF_IQ = OFF_AZ + 32 * MB;
constexpr size_t OFF_IK = OFF_IQ + 32 * MB;
constexpr size_t OFF_GB = OFF_IK + 2 * MB;
constexpr size_t OFF_IW = OFF_GB + 1 * MB;
constexpr size_t OFF_COS = OFF_IW + 1 * MB;
constexpr size_t OFF_SIN = OFF_COS + 2 * MB;
constexpr size_t OFF_SEL = OFF_SIN + 2 * MB;
constexpr size_t OFF_REC = OFF_SEL + 8 * MB;
constexpr size_t WS_END = OFF_REC + (size_t)2048 * 74752;

struct Params {
    const float* x; const int* pos; const float* attn_g; const float* w_in; const float* conv_w; const float* a_log;
    const float* dt_bias; const float* gdn_norm_g; const float* w_out; const float* final_g; float* out; unsigned char* ws;
};

__device__ __forceinline__ float wave_sum(float v) {
#pragma unroll
    for (int o = 1; o < 64; o <<= 1) v += __shfl_xor(v, o);
    return v;
}
__device__ __forceinline__ float wave_max(float v) {
#pragma unroll
    for (int o = 1; o < 64; o <<= 1) v = fmaxf(v, __shfl_xor(v, o));
    return v;
}
__device__ __forceinline__ int opaque_tid() { int t = threadIdx.x; asm volatile("" : "+v"(t)); return t; }
__device__ __forceinline__ float silu_f(float x) { return x / (1.0f + __expf(-x)); }

namespace pg8 {
constexpr int BM = 256, BK = 64, HALF = 128, HTB = HALF * BK * 2, STAGE_BYTES = 8 * HTB, NXCD = 8, WGM = 8;
__host__ __device__ __forceinline__ int lds_byte(int r, int c) { const int st = (r >> 4) * 2 + (c >> 5), rr = r & 15, cc = c & 31, ob = rr * 64 + cc * 2; return st * 1024 + (ob ^ (((ob >> 9) & 1) << 5)); }
__host__ __device__ __forceinline__ void stage_rc(int b, int& R, int& C) { const int st = b / 1024, sb = b % 1024, swz = sb ^ (((sb >> 9) & 1) << 5); R = (st >> 1) * 16 + swz / 64; C = (st & 1) * 32 + (swz % 64) / 2; }
__host__ __device__ __forceinline__ int perm32(int rho) { const int n = rho >> 4, i = rho & 15; return 8 * (i >> 2) + 4 * n + (i & 3); }
struct Unit { int pm, pn; };
struct Gemm { const h16* A; const h16* Bt; int M, N, K; };
struct StaticOrder {
    int nM, nN, nwg, G, c;
    __host__ __device__ void init(int M, int N, int G_, int c_) { nM = M / BM; nN = N / BM; nwg = nM * nN; G = G_; c = c_; }
    __host__ __device__ bool next(int i, Unit& u) const {
        const long L = (long)i * G + c; if (L >= nwg) return false;
        int wgid = (int)L; { const int q = nwg / NXCD, r = nwg % NXCD, xcd = wgid % NXCD, off = wgid / NXCD; wgid = (xcd < r ? xcd * (q + 1) : r * (q + 1) + (xcd - r) * q) + off; }
        const int nig = WGM * nN, gid = wgid / nig, fm = gid * WGM, gsz = (nM - fm) < WGM ? (nM - fm) : WGM;
        u.pm = fm + ((wgid % nig) % gsz); u.pn = (wgid % nig) / gsz; return true;
    }
    __device__ __forceinline__ void a_ready(const Unit&) const {}
    __device__ __forceinline__ void done(const Unit&) const {}
};

template <class Epi, class Sched>
__device__ __forceinline__ void gemm_phase(LAS unsigned char* lds, const Gemm g, const Sched& S, const Epi& E) {
    const int tid = threadIdx.x, wid = __builtin_amdgcn_readfirstlane(tid >> 6), lane = tid & 63, wr = wid >> 2, wc = wid & 3, fr = lane & 15, fq = lane >> 4;
    const int K = g.K, nt = K / BK;
    unsigned voffA[2], voffB[2];
#pragma unroll
    for (int i = 0; i < 2; ++i) { int R, C; stage_rc(tid * 16 + i * 8192, R, C); const int Rb = Epi::PERM ? ((R & ~31) + perm32(R & 31)) : R;
        voffA[i] = (unsigned)(R * K + C) * 2u; voffB[i] = (unsigned)(Rb * K + C) * 2u; }
    const size_t kstep = (size_t)(BK * 2);
    const size_t hstep = (size_t)HALF * K * 2;
    const size_t tstep = 2 * hstep;
    const unsigned ldsw = (unsigned)wid * 1024u;
    const int aoff = lds_byte(wr * 64 + fr, fq * 8), boff = lds_byte(wc * 32 + fr, fq * 8);
#define PG8_SA(b, h) (((b) * 2 + (h)) * HTB)
#define PG8_SB(b, h) ((4 + (b) * 2 + (h)) * HTB)
#define PG8_STAGE(bufoff, gbase, voff) do { _Pragma("unroll") for (int _i = 0; _i < 2; ++_i) \
        __builtin_amdgcn_global_load_lds((const unsigned*)((const char*)(gbase) + (voff)[_i]), (LAS unsigned*)(lds + (bufoff) + ldsw + _i * 8192), 16, 0, 0); } while (0)
#define PG8_LDA(dst, b, h) do { _Pragma("unroll") for (int m = 0; m < 4; ++m) _Pragma("unroll") for (int k = 0; k < 2; ++k) dst[m][k] = *(const LAS h16x8*)(lds + PG8_SA(b, h) + aoff + m * 2048 + k * 1024); } while (0)
#define PG8_LDB(dst, b, h) do { _Pragma("unroll") for (int n = 0; n < 2; ++n) _Pragma("unroll") for (int k = 0; k < 2; ++k) dst[n][k] = *(const LAS h16x8*)(lds + PG8_SB(b, h) + boff + n * 2048 + k * 1024); } while (0)
#define PG8_MMA(ai, bj, At, Bt) do { __builtin_amdgcn_s_setprio(1); _Pragma("unroll") for (int m = 0; m < 4; ++m) _Pragma("unroll") for (int n = 0; n < 2; ++n) _Pragma("unroll") for (int k = 0; k < 2; ++k) \
        acc[ai][bj][m][n] = __builtin_amdgcn_mfma_f32_16x16x32_f16(Bt[n][k], At[m][k], acc[ai][bj][m][n], 0, 0, 0); __builtin_amdgcn_s_setprio(0); } while (0)
#define PG8_WAIT_V(n) asm volatile("s_waitcnt vmcnt(" #n ")" ::: "memory")
#define PG8_WAIT_L(n) asm volatile("s_waitcnt lgkmcnt(" #n ")" ::: "memory")
#define PG8_BAR __builtin_amdgcn_s_barrier()
#define PG8_SCHED __builtin_amdgcn_sched_barrier(0)
    Unit cur, nxt; int ui = 0;
    if (!S.next(0, cur)) return;
    f32x4 acc[2][2][4][2];
#pragma unroll
    for (int a = 0; a < 2; ++a)
#pragma unroll
        for (int b = 0; b < 2; ++b)
#pragma unroll
            for (int m = 0; m < 4; ++m)
#pragma unroll
                for (int n = 0; n < 2; ++n) acc[a][b][m][n] = (f32x4){0.f, 0.f, 0.f, 0.f};
    h16x8 At[4][2], B0[2][2], B1[2][2];
    const char* cA = (const char*)g.A + (size_t)cur.pm * tstep; const char* cB = (const char*)g.Bt + (size_t)cur.pn * tstep;
    S.a_ready(cur);
    PG8_STAGE(PG8_SB(0, 0), cB, voffB); PG8_STAGE(PG8_SA(0, 0), cA, voffA); PG8_STAGE(PG8_SB(0, 1), cB + hstep, voffB); PG8_STAGE(PG8_SA(0, 1), cA + hstep, voffA);
    if (wr == 1) PG8_BAR;
    PG8_WAIT_V(4); PG8_BAR;
    PG8_STAGE(PG8_SB(1, 0), cB + kstep, voffB); PG8_STAGE(PG8_SA(1, 0), cA + kstep, voffA); PG8_STAGE(PG8_SB(1, 1), cB + hstep + kstep, voffB);
    PG8_WAIT_V(6); PG8_BAR;
    for (;;) {
        const bool has_next = S.next(ui + 1, nxt);
        const char* nA = has_next ? (const char*)g.A + (size_t)nxt.pm * tstep : cA; const char* nB = has_next ? (const char*)g.Bt + (size_t)nxt.pn * tstep : cB;
        for (int t = 0; t < nt; t += 2) {
            const bool last = (t == nt - 2);
            const char* a1 = cA + (size_t)(t + 1) * kstep;
            const char* a2 = last ? nA : cA + (size_t)(t + 2) * kstep; const char* b2 = last ? nB : cB + (size_t)(t + 2) * kstep;
            const char* a3 = a2 + kstep; const char* b3 = b2 + kstep;
            if (last && has_next) S.a_ready(nxt);
            PG8_LDB(B0, 0, 0); PG8_SCHED; PG8_LDA(At, 0, 0); PG8_STAGE(PG8_SA(1, 1), a1 + hstep, voffA);
            PG8_WAIT_L(8); PG8_BAR; PG8_WAIT_L(0); PG8_MMA(0, 0, At, B0); PG8_BAR; PG8_SCHED;
            PG8_LDB(B1, 0, 1); PG8_STAGE(PG8_SB(0, 0), b2, voffB);
            PG8_BAR; PG8_WAIT_L(0); PG8_MMA(0, 1, At, B1); PG8_BAR;
            PG8_LDA(At, 0, 1); PG8_STAGE(PG8_SA(0, 0), a2, voffA);
            PG8_BAR; PG8_WAIT_L(0); PG8_MMA(1, 0, At, B0); PG8_BAR; PG8_SCHED;
            PG8_STAGE(PG8_SB(0, 1), b2 + hstep, voffB);
            PG8_WAIT_V(6); PG8_BAR; PG8_MMA(1, 1, At, B1); PG8_BAR;
            PG8_LDB(B0, 1, 0); PG8_SCHED; PG8_LDA(At, 1, 0); PG8_STAGE(PG8_SA(0, 1), a2 + hstep, voffA);
            PG8_WAIT_L(8); PG8_BAR; PG8_WAIT_L(0); PG8_MMA(0, 0, At, B0); PG8_BAR; PG8_SCHED;
            PG8_LDB(B1, 1, 1); PG8_STAGE(PG8_SB(1, 0), b3, voffB);
            PG8_BAR; PG8_WAIT_L(0); PG8_MMA(0, 1, At, B1); PG8_BAR;
            PG8_LDA(At, 1, 1); PG8_STAGE(PG8_SA(1, 0), a3, voffA);
            PG8_BAR; PG8_WAIT_L(0); PG8_MMA(1, 0, At, B0); PG8_BAR; PG8_SCHED;
            PG8_STAGE(PG8_SB(1, 1), b3 + hstep, voffB);
            PG8_WAIT_V(6); PG8_BAR; PG8_MMA(1, 1, At, B1); PG8_BAR;
        }
        E(acc, cur, wr, wc, fr, fq); S.done(cur);
        if (!has_next) break;
#pragma unroll
        for (int a = 0; a < 2; ++a)
#pragma unroll
            for (int b = 0; b < 2; ++b)
#pragma unroll
                for (int m = 0; m < 4; ++m)
#pragma unroll
                    for (int n = 0; n < 2; ++n) acc[a][b][m][n] = (f32x4){0.f, 0.f, 0.f, 0.f};
        cur = nxt; cA = nA; cB = nB; ++ui;
    }
    PG8_WAIT_V(0);
    if (wr == 0) PG8_BAR;
    PG8_BAR;
#undef PG8_SA
#undef PG8_SB
#undef PG8_STAGE
#undef PG8_LDA
#undef PG8_LDB
#undef PG8_MMA
#undef PG8_WAIT_V
#undef PG8_WAIT_L
#undef PG8_BAR
#undef PG8_SCHED
}
}

struct EpiIn {
    static constexpr bool PERM = true;
    unsigned char* ws; const float* a_log; const float* dt_bias;
    __device__ __forceinline__ void operator()(const f32x4 (&acc)[2][2][4][2], const pg8::Unit& u, int wr, int wc, int fr, int fq) const {
        const int pn = u.pn;
        const int rowb = u.pm * 256 + wr * 64 + fr;
        const int cw = wc * 32 + 8 * fq;
        const float* cosT = (const float*)(ws + OFF_COS); const float* sinT = (const float*)(ws + OFF_SIN);
        if (pn < 30) {
            h16* base; int ldc, colt, mode; float scale = 1.f;
            if (pn < 12) { base = (h16*)(ws + OFF_QKVR); ldc = 3072; colt = pn * 256; mode = 0; }
            else if (pn < 16) { base = (h16*)(ws + OFF_GZ); ldc = 1024; colt = (pn - 12) * 256; mode = 1; }
            else if (pn < 20) { base = (h16*)(ws + OFF_AQ); ldc = 1024; colt = (pn - 16) * 256; mode = 2; scale = 0.08838834764831845f; }
            else if (pn == 20) { base = (h16*)(ws + OFF_AK); ldc = 256; colt = 0; mode = 2; }
            else if (pn == 21) { base = (h16*)(ws + OFF_AV); ldc = 256; colt = 0; mode = 0; }
            else if (pn < 26) { base = (h16*)(ws + OFF_AZ); ldc = 1024; colt = (pn - 22) * 256; mode = 1; }
            else { base = (h16*)(ws + OFF_IQ); ldc = 1024; colt = (pn - 26) * 256; mode = 3; }
            const bool rot_wave = (mode == 2 && wc == 0) || (mode == 3 && (wc & 1) == 0);
            const int xm = (mode == 2) ? 32 : 16;
            const bool rot_lane = (mode == 2) ? true : (fq < 2);
            const float sgn = (mode == 2) ? (fq < 2 ? -1.f : 1.f) : (fq == 0 ? -1.f : 1.f);
            const int tix = (mode == 2) ? 8 * (fq & 1) : 16;
#pragma unroll
            for (int ai = 0; ai < 2; ++ai)
#pragma unroll
                for (int m = 0; m < 4; ++m) {
                    const int row = rowb + ai * 128 + m * 16;
                    float cs[8], sn[8];
                    if (rot_wave) {
                        const f32x4 c0 = *(const f32x4*)(cosT + (size_t)row * 24 + tix), c1 = *(const f32x4*)(cosT + (size_t)row * 24 + tix + 4);
                        const f32x4 s0 = *(const f32x4*)(sinT + (size_t)row * 24 + tix), s1 = *(const f32x4*)(sinT + (size_t)row * 24 + tix + 4);
#pragma unroll
                        for (int j = 0; j < 4; ++j) { cs[j] = c0[j]; cs[4 + j] = c1[j]; sn[j] = s0[j]; sn[4 + j] = s1[j]; }
                    }
#pragma unroll
                    for (int bj = 0; bj < 2; ++bj) {
                        float v[8];
#pragma unroll
                        for (int j = 0; j < 4; ++j) { v[j] = acc[ai][bj][m][0][j]; v[4 + j] = acc[ai][bj][m][1][j]; }
                        if (rot_wave) {
#pragma unroll
                            for (int j = 0; j < 8; ++j) { const float pv = __shfl_xor(v[j], xm); if (rot_lane) v[j] = v[j] * cs[j] + sgn * pv * sn[j]; }
                        }
                        if (mode == 1) {
#pragma unroll
                            for (int j = 0; j < 8; ++j) v[j] = silu_f(v[j]);
                        }
                        h16x8 o;
#pragma unroll
                        for (int j = 0; j < 8; ++j) o[j] = (h16)(v[j] * scale);
                        *(h16x8*)(base + (size_t)row * ldc + colt + bj * 128 + cw) = o;
                    }
                }
        } else {
            h16* ik = (h16*)(ws + OFF_IK); float* gb = (float*)(ws + OFF_GB); float* iw = (float*)(ws + OFF_IW);
#pragma unroll
            for (int ai = 0; ai < 2; ++ai)
#pragma unroll
                for (int m = 0; m < 4; ++m) {
                    const int row = rowb + ai * 128 + m * 16;
                    float v[8];
#pragma unroll
                    for (int j = 0; j < 4; ++j) { v[j] = acc[ai][0][m][0][j]; v[4 + j] = acc[ai][0][m][1][j]; }
                    if (wc == 0) {
                        const f32x4 c0 = *(const f32x4*)(cosT + (size_t)row * 24 + 16), c1 = *(const f32x4*)(cosT + (size_t)row * 24 + 20);
                        const f32x4 s0 = *(const f32x4*)(sinT + (size_t)row * 24 + 16), s1 = *(const f32x4*)(sinT + (size_t)row * 24 + 20);
                        const float sgn = (fq == 0 ? -1.f : 1.f);
#pragma unroll
                        for (int j = 0; j < 8; ++j) { const float pv = __shfl_xor(v[j], 16); const float c = j < 4 ? c0[j & 3] : c1[j & 3], s = j < 4 ? s0[j & 3] : s1[j & 3];
                            if (fq < 2) v[j] = v[j] * c + sgn * pv * s; }
                    }
                    if (wc < 2) {
                        h16x8 o;
#pragma unroll
                        for (int j = 0; j < 8; ++j) o[j] = (h16)v[j];
                        *(h16x8*)(ik + (size_t)row * 64 + cw) = o;
                    } else if (wc == 2) {
                        if (fq == 0) {
#pragma unroll
                            for (int j = 0; j < 8; ++j) { const float z = v[j] + dt_bias[j]; const float sp = z > 20.f ? z : log1pf(expf(z)); gb[(size_t)row * 16 + j] = -expf(a_log[j]) * sp; }
                        } else if (fq == 1) {
#pragma unroll
                            for (int j = 0; j < 8; ++j) gb[(size_t)row * 16 + 8 + j] = 1.0f / (1.0f + expf(-v[j]));
                        } else {
#pragma unroll
                            for (int j = 0; j < 8; ++j) iw[(size_t)row * 16 + 8 * (fq - 2) + j] = v[j] * 0.03125f;
                        }
                    }
                }
        }
    }
};

struct EpiOut {
    static constexpr bool PERM = false;
    const float* x; float* out; float* rowss;
    __device__ __forceinline__ void operator()(const f32x4 (&acc)[2][2][4][2], const pg8::Unit& u, int wr, int wc, int fr, int fq) const {
        const int rowb = u.pm * 256 + wr * 64 + fr, col0 = u.pn * 256 + wc * 32 + 4 * fq;
#pragma unroll
        for (int ai = 0; ai < 2; ++ai)
#pragma unroll
            for (int m = 0; m < 4; ++m) {
                const int row = rowb + ai * 128 + m * 16; float ss = 0.f;
#pragma unroll
                for (int bj = 0; bj < 2; ++bj)
#pragma unroll
                    for (int n = 0; n < 2; ++n) {
                        const size_t off = (size_t)row * DM + col0 + bj * 128 + n * 16;
                        const f32x4 y = *(const f32x4*)(x + off) + acc[ai][bj][m][n];
                        *(f32x4*)(out + off) = y; ss += (y[0] * y[0] + y[1] * y[1]) + (y[2] * y[2] + y[3] * y[3]);
                    }
                ss += __shfl_xor(ss, 16); ss += __shfl_xor(ss, 32);
                if (fq == 0) atomicAdd(rowss + row, ss);
            }
    }
};

__device__ __forceinline__ int src_col(int np) {
    if (np < 4096) return np;
    if (np < 7680) return np + 16;
    if (np < 7744) return 7696 + (np - 7680);
    if (np < 7752) return 4096 + (np - 7744);
    if (np < 7760) return 4104 + (np - 7752);
    if (np < 7776) return np;
    return -1;
}
__device__ __forceinline__ void phase0(const Params& p, unsigned char* smem) {
    const int tid = threadIdx.x, wid = tid >> 6, lane = tid & 63;
    const int gw = blockIdx.x * 8 + wid, nw = gridDim.x * 8;
    h16* H = (h16*)(p.ws + OFF_H);
    for (int row = gw; row < BT; row += nw) {
        const f32x4* xr = (const f32x4*)(p.x + (size_t)row * DM);
        f32x4 v[8]; float ss = 0.f;
#pragma unroll
        for (int i = 0; i < 8; ++i) { v[i] = xr[lane + 64 * i]; ss += (v[i][0] * v[i][0] + v[i][1] * v[i][1]) + (v[i][2] * v[i][2] + v[i][3] * v[i][3]); }
        ss = wave_sum(ss);
        const float r = 1.0f / sqrtf(ss * (1.0f / DM) + EPS);
#pragma unroll
        for (int i = 0; i < 8; ++i) { const f32x4 g = ((const f32x4*)p.attn_g)[lane + 64 * i]; h16x4 o;
#pragma unroll
            for (int j = 0; j < 4; ++j) o[j] = (h16)(v[i][j] * r * g[j]);
            *(h16x4*)(H + (size_t)row * DM + 4 * (lane + 64 * i)) = o; }
    }
    float* tile = (float*)smem;
    h16* Wt = (h16*)(p.ws + OFF_WT);
    for (int tI = blockIdx.x; tI < 124 * 32; tI += gridDim.x) {
        const int n0 = (tI / 32) * 64, k0 = (tI % 32) * 64;
        __syncthreads();
        { const int nl = tid & 63; const int src = src_col(n0 + nl);
#pragma unroll
          for (int i = 0; i < 8; ++i) { const int kl = (tid >> 6) + 8 * i; tile[kl * 65 + nl] = src >= 0 ? p.w_in[(size_t)(k0 + kl) * IN_COLS + src] : 0.f; } }
        __syncthreads();
        { const int nl = tid >> 3, kc = tid & 7; h16x8 o;
#pragma unroll
          for (int j = 0; j < 8; ++j) o[j] = (h16)tile[(8 * kc + j) * 65 + nl];
          *(h16x8*)(Wt + (size_t)(n0 + nl) * 2048 + k0 + 8 * kc) = o; }
    }
    h16* WoT = (h16*)(p.ws + OFF_WOT);
    for (int tI = blockIdx.x; tI < 32 * 32; tI += gridDim.x) {
        const int n0 = (tI / 32) * 64, k0 = (tI % 32) * 64;
        __syncthreads();
        { const int nl = tid & 63;
#pragma unroll
          for (int i = 0; i < 8; ++i) { const int kl = (tid >> 6) + 8 * i; tile[kl * 65 + nl] = p.w_out[(size_t)(k0 + kl) * DM + n0 + nl]; } }
        __syncthreads();
        { const int nl = tid >> 3, kc = tid & 7; h16x8 o;
#pragma unroll
          for (int j = 0; j < 8; ++j) o[j] = (h16)tile[(8 * kc + j) * 65 + nl];
          *(h16x8*)(WoT + (size_t)(n0 + nl) * 2048 + k0 + 8 * kc) = o; }
    }
    __syncthreads();
    float* cosT = (float*)(p.ws + OFF_COS); float* sinT = (float*)(p.ws + OFF_SIN);
    for (int i = blockIdx.x * 512 + tid; i < BT * 24; i += gridDim.x * 512) {
        const int row = i / 24, j = i % 24;
        const float ex = (j < 16) ? (float)j * (2.0f / 32.0f) : (float)(j - 16) * (2.0f / 16.0f);
        const float inv = powf(500000.0f, -ex);
        const float ang = (float)p.pos[row] * inv;
        cosT[i] = cosf(ang); sinT[i] = sinf(ang);
    }
}

constexpr int REC_BYTES = 74752, REC_WF = 0, REC_QF = 16384, REC_AF = 32768, REC_KTF = 40960, REC_UF = 57344, REC_VEC = 73728;
constexpr int HB_BYTES = 69632;

__device__ __forceinline__ void gdn_prep_pair(const Params& p, unsigned char* smem, int pair) {
    const int tid = opaque_tid(), wid = __builtin_amdgcn_readfirstlane(tid >> 6), lane = tid & 63, hb = wid >> 2, w4 = wid & 3, tl = tid & 255;
    const int tk = 2 * pair + hb; const int b = tk >> 9, h = (tk >> 6) & 7, n = tk & 63; const int t0 = n * 64;
    unsigned char* base = smem + hb * HB_BYTES;
    h16* Kn = (h16*)base; h16* Qn = Kn + 64 * 136; h16* Vh = Qn + 64 * 136; float* L = (float*)(Vh + 64 * 136); float* vec = L + 4096;
    unsigned char* rec = p.ws + OFF_REC + (size_t)tk * REC_BYTES;
    const h16* qkvr = (const h16*)(p.ws + OFF_QKVR);
    __syncthreads();
    {
        const int cg = tl & 15, rg = tl >> 4;
#pragma unroll 1
        for (int ti = 0; ti < 3; ++ti) {
            const int chan = ti * 1024 + h * 128 + 8 * cg;
            float xr[7][8];
#pragma unroll
            for (int r = 0; r < 7; ++r) {
                const int trow = t0 + 4 * rg - 3 + r;
                h16x8 v;
                if (trow >= 0) v = *(const h16x8*)(qkvr + ((size_t)b * NT + trow) * 3072 + chan);
                else { for (int j = 0; j < 8; ++j) v[j] = (h16)0.f; }
#pragma unroll
                for (int j = 0; j < 8; ++j) xr[r][j] = (float)v[j];
            }
            float wv[4][8];
#pragma unroll
            for (int tp = 0; tp < 4; ++tp) { const f32x4 a = *(const f32x4*)(p.conv_w + (size_t)tp * 3072 + chan), c = *(const f32x4*)(p.conv_w + (size_t)tp * 3072 + chan + 4);
#pragma unroll
                for (int j = 0; j < 4; ++j) { wv[tp][j] = a[j]; wv[tp][4 + j] = c[j]; } }
            h16* dst = (ti == 0) ? Qn : (ti == 1 ? Kn : Vh);
#pragma unroll
            for (int r = 0; r < 4; ++r) {
                float y[8]; float ss = 0.f;
#pragma unroll
                for (int j = 0; j < 8; ++j) { float a = wv[0][j] * xr[r][j] + wv[1][j] * xr[r + 1][j] + wv[2][j] * xr[r + 2][j] + wv[3][j] * xr[r + 3][j]; a = a / (1.0f + __expf(-a)); y[j] = a; ss += a * a; }
                float sc = 1.f;
                if (ti < 2) { ss += __shfl_xor(ss, 1); ss += __shfl_xor(ss, 2); ss += __shfl_xor(ss, 4); ss += __shfl_xor(ss, 8); sc = (ti == 0 ? 0.08838834764831845f : 1.0f) / sqrtf(ss + EPS); }
                h16x8 o;
#pragma unroll
                for (int j = 0; j < 8; ++j) o[j] = (h16)(y[j] * sc);
                *(h16x8*)(dst + (4 * rg + r) * 136 + 8 * cg) = o;
            }
        }
    }
    if (tl < 64) {
        const float* gb = (const float*)(p.ws + OFF_GB) + ((size_t)b * NT + t0 + tl) * 16;
        const float g = gb[h], be = gb[8 + h];
        float gc = g;
#pragma unroll
        for (int o = 1; o < 64; o <<= 1) { const float tt = __shfl_up(gc, o); if (lane >= o) gc += tt; }
        const float gl = __shfl(gc, 63);
        vec[tl] = g; vec[64 + tl] = be; vec[128 + tl] = gc; vec[192 + tl] = __expf(gc);
        float* rv = (float*)(rec + REC_VEC);
        rv[tl] = __expf(gc); rv[64 + tl] = __expf(gl - gc); if (tl == 0) rv[128] = __expf(gl);
    }
    __syncthreads();
    {
        const int rt = w4, fr = lane & 15, kg = lane >> 4;
        h16x8 Ak[4], Aq[4];
#pragma unroll
        for (int s = 0; s < 4; ++s) { Ak[s] = *(const h16x8*)(Kn + (16 * rt + fr) * 136 + 32 * s + 8 * kg); Aq[s] = *(const h16x8*)(Qn + (16 * rt + fr) * 136 + 32 * s + 8 * kg); }
        h16* AF = (h16*)(rec + REC_AF);
#pragma unroll
        for (int ct = 0; ct < 4; ++ct) {
            f32x4 kk = (f32x4){0.f, 0.f, 0.f, 0.f}, qk = (f32x4){0.f, 0.f, 0.f, 0.f};
#pragma unroll
            for (int s = 0; s < 4; ++s) { const h16x8 Bk = *(const h16x8*)(Kn + (16 * ct + fr) * 136 + 32 * s + 8 * kg);
                kk = __builtin_amdgcn_mfma_f32_16x16x32_f16(Ak[s], Bk, kk, 0, 0, 0); qk = __builtin_amdgcn_mfma_f32_16x16x32_f16(Aq[s], Bk, qk, 0, 0, 0); }
            const int j = 16 * ct + fr; const float gcj = vec[128 + j];
#pragma unroll
            for (int rgi = 0; rgi < 4; ++rgi) {
                const int i = 16 * rt + 4 * kg + rgi;
                const float dec = (i >= j) ? __expf(vec[128 + i] - gcj) : 0.f;
                L[i * 64 + j] = (i > j) ? vec[64 + i] * kk[rgi] * dec : 0.f;
                const int sp = ct >> 1, kgp = fr >> 2, j8 = (ct & 1) * 4 + (fr & 3), lanep = 16 * kgp + 4 * kg + rgi;
                AF[((rt * 2 + sp) * 64 + lanep) * 8 + j8] = (h16)(qk[rgi] * dec);
            }
        }
    }
    __syncthreads();
    float X[64];
#pragma unroll
    for (int i = 0; i < 64; ++i) X[i] = 0.f;
    {
        const bool isw = tl < 128;
        const h16* colp = isw ? (Kn + tl) : (Vh + (tl - 128));
#pragma unroll
        for (int i = 0; i < 64; ++i) {
            const float be = vec[64 + i], sc = be * (isw ? vec[192 + i] : 1.0f);
            float acc = sc * (float)colp[i * 136];
#pragma unroll
            for (int jj = 0; jj < (i + 3) / 4; ++jj) { const f32x4 l4 = *(const f32x4*)(L + i * 64 + 4 * jj);
                acc -= l4[0] * X[4 * jj]; acc -= l4[1] * X[4 * jj + 1]; acc -= l4[2] * X[4 * jj + 2]; acc -= l4[3] * X[4 * jj + 3]; }
            asm volatile("" : "+v"(acc) :: "memory");
            X[i] = acc;
        }
    }
    if (tl < 128) {
        h16* WF = (h16*)(rec + REC_WF); const int d = tl, s = d >> 5, dd = d & 31;
        const int kgp = (dd < 16) ? (dd >> 2) : ((dd - 16) >> 2), j8 = (dd < 16) ? (dd & 3) : 4 + (dd & 3);
#pragma unroll
        for (int i = 0; i < 64; ++i) { const int rt = i >> 4, row = i & 15; WF[((rt * 4 + s) * 64 + 16 * kgp + row) * 8 + j8] = (h16)(-X[i]); }
    } else {
        h16* UF = (h16*)(rec + REC_UF); const int e = tl - 128, dvb = e >> 4;
#pragma unroll
        for (int i = 0; i < 64; ++i) { const int rt = i >> 4, kg = (i & 15) >> 2, rgi = i & 3; UF[((dvb * 4 + rt) * 64 + 16 * kg + (e & 15)) * 4 + rgi] = (h16)X[i]; }
    }
    {
        h16* QF = (h16*)(rec + REC_QF);
#pragma unroll
        for (int it = 0; it < 4; ++it) { const int f = tl + 256 * it; const int lanep = f & 63, s = (f >> 6) & 3, rt = f >> 8; const int row = 16 * rt + (lanep & 15), kgp = lanep >> 4;
            const h16x4 a = *(const h16x4*)(Qn + row * 136 + 32 * s + 4 * kgp), c = *(const h16x4*)(Qn + row * 136 + 32 * s + 16 + 4 * kgp);
            h16x8 o; o[0] = a[0]; o[1] = a[1]; o[2] = a[2]; o[3] = a[3]; o[4] = c[0]; o[5] = c[1]; o[6] = c[2]; o[7] = c[3];
            *(h16x8*)(QF + (size_t)f * 8) = o; }
        h16* KTF = (h16*)(rec + REC_KTF);
#pragma unroll
        for (int it = 0; it < 4; ++it) { const int f = tl + 256 * it; const int lanep = f & 63, sp = (f >> 6) & 1, rt = f >> 7; const int d = 16 * rt + (lanep & 15), kgp = lanep >> 4;
            h16x8 o;
#pragma unroll
            for (int j8 = 0; j8 < 8; ++j8) { const int c = 32 * sp + (j8 < 4 ? 4 * kgp + j8 : 16 + 4 * kgp + (j8 - 4)); o[j8] = Kn[c * 136 + d]; }
            *(h16x8*)(KTF + (size_t)f * 8) = o; }
    }
}

__device__ __forceinline__ h16x8 pack8(const f32x4 a, const f32x4 c) { h16x8 o; o[0] = (h16)a[0]; o[1] = (h16)a[1]; o[2] = (h16)a[2]; o[3] = (h16)a[3]; o[4] = (h16)c[0]; o[5] = (h16)c[1]; o[6] = (h16)c[2]; o[7] = (h16)c[3]; return o; }

__device__ __forceinline__ void gdn_scan_task(const Params& p, unsigned char* smem, int bh) {
    const int tid = opaque_tid(), wid = __builtin_amdgcn_readfirstlane(tid >> 6), lane = tid & 63, kg = lane >> 4, fr = lane & 15;
    const int b = bh >> 3, h = bh & 7;
    LAS unsigned char* lds = (LAS unsigned char*)smem;
    const unsigned char* rec0 = p.ws + OFF_REC + (size_t)(bh * 64) * REC_BYTES;
    h16* OB = (h16*)(smem + 114688);
    const h16* gz = (const h16*)(p.ws + OFF_GZ); h16* omix = (h16*)(p.ws + OFF_OMIX);
    const float ng0 = p.gdn_norm_g[2 * lane], ng1 = p.gdn_norm_g[2 * lane + 1];
    f32x4 Sacc[8];
#pragma unroll
    for (int t = 0; t < 8; ++t) Sacc[t] = (f32x4){0.f, 0.f, 0.f, 0.f};
    h16x4 Uc[4], Un[4]; f32x4 egc[4], ekc[4], egn[4], ekn[4]; float eglc, egln;
    __syncthreads();
#define GDN_GLDS(recp, bufi) do { _Pragma("unroll") for (int _i = 0; _i < 7; ++_i) \
        __builtin_amdgcn_global_load_lds((const unsigned*)((recp) + (size_t)(_i * 512 + tid) * 16), (LAS unsigned*)(lds + (bufi) * 57344 + (_i * 512 + wid * 64) * 16), 16, 0, 0); } while (0)
#define GDN_LDREG(recp, U_, eg_, ek_, egl_) do { _Pragma("unroll") for (int rt = 0; rt < 4; ++rt) { \
        U_[rt] = *(const h16x4*)((recp) + REC_UF + (size_t)((wid * 4 + rt) * 64 + lane) * 8); \
        eg_[rt] = *(const f32x4*)((recp) + REC_VEC + (16 * rt + 4 * kg) * 4); ek_[rt] = *(const f32x4*)((recp) + REC_VEC + 256 + (16 * rt + 4 * kg) * 4); } \
        egl_ = *(const float*)((recp) + REC_VEC + 512); } while (0)
    GDN_GLDS(rec0, 0);
    GDN_LDREG(rec0, Uc, egc, ekc, eglc);
    asm volatile("s_waitcnt vmcnt(0)" ::: "memory");
    __syncthreads();
    for (int n = 0; n < 64; ++n) {
        const unsigned char* recn = rec0 + (size_t)(n + 1) * REC_BYTES;
        if (n + 1 < 64) { GDN_GLDS(recn, (n + 1) & 1); GDN_LDREG(recn, Un, egn, ekn, egln); }
        if (n > 0) {
            const h16* Ob = OB + ((n - 1) & 1) * 8192;
#pragma unroll
            for (int rr = 0; rr < 8; ++rr) { const int c = 8 * wid + rr; const h16x2 ov = *(const h16x2*)(Ob + c * 128 + 2 * lane);
                const float o0 = (float)ov[0], o1 = (float)ov[1]; const float ss = wave_sum(o0 * o0 + o1 * o1); const float r = 1.0f / sqrtf(ss * (1.0f / 128.0f) + EPS);
                const size_t bt = (size_t)b * NT + 64 * (n - 1) + c; const h16x2 gt = *(const h16x2*)(gz + bt * 1024 + h * 128 + 2 * lane);
                h16x2 o; o[0] = (h16)(o0 * r * ng0 * (float)gt[0]); o[1] = (h16)(o1 * r * ng1 * (float)gt[1]);
                *(h16x2*)(omix + bt * 2048 + h * 128 + 2 * lane) = o; }
        }
        const LAS unsigned char* bufp = lds + (n & 1) * 57344;
        h16x8 SB[4];
#pragma unroll
        for (int s = 0; s < 4; ++s) SB[s] = pack8(Sacc[2 * s], Sacc[2 * s + 1]);
        f32x4 vacc[4], oacc[4];
#pragma unroll
        for (int rt = 0; rt < 4; ++rt) { vacc[rt] = (f32x4){(float)Uc[rt][0], (float)Uc[rt][1], (float)Uc[rt][2], (float)Uc[rt][3]}; oacc[rt] = (f32x4){0.f, 0.f, 0.f, 0.f}; }
#pragma unroll
        for (int rt = 0; rt < 4; ++rt)
#pragma unroll
            for (int s = 0; s < 4; ++s) { const h16x8 a = *(const LAS h16x8*)(bufp + REC_WF + ((rt * 4 + s) * 64 + lane) * 16); vacc[rt] = __builtin_amdgcn_mfma_f32_16x16x32_f16(a, SB[s], vacc[rt], 0, 0, 0); }
#pragma unroll
        for (int rt = 0; rt < 4; ++rt)
#pragma unroll
            for (int s = 0; s < 4; ++s) { const h16x8 a = *(const LAS h16x8*)(bufp + REC_QF + ((rt * 4 + s) * 64 + lane) * 16); oacc[rt] = __builtin_amdgcn_mfma_f32_16x16x32_f16(a, SB[s], oacc[rt], 0, 0, 0); }
#pragma unroll
        for (int rt = 0; rt < 4; ++rt) oacc[rt] = oacc[rt] * egc[rt];
        h16x8 VB[2], VKB[2];
#pragma unroll
        for (int sp = 0; sp < 2; ++sp) { VB[sp] = pack8(vacc[2 * sp], vacc[2 * sp + 1]); VKB[sp] = pack8(vacc[2 * sp] * ekc[2 * sp], vacc[2 * sp + 1] * ekc[2 * sp + 1]); }
#pragma unroll
        for (int rt = 0; rt < 4; ++rt)
#pragma unroll
            for (int sp = 0; sp < 2; ++sp) { const h16x8 a = *(const LAS h16x8*)(bufp + REC_AF + ((rt * 2 + sp) * 64 + lane) * 16); oacc[rt] = __builtin_amdgcn_mfma_f32_16x16x32_f16(a, VB[sp], oacc[rt], 0, 0, 0); }
#pragma unroll
        for (int t = 0; t < 8; ++t) { Sacc[t] = Sacc[t] * eglc;
#pragma unroll
            for (int sp = 0; sp < 2; ++sp) { const h16x8 a = *(const LAS h16x8*)(bufp + REC_KTF + ((t * 2 + sp) * 64 + lane) * 16); Sacc[t] = __builtin_amdgcn_mfma_f32_16x16x32_f16(a, VKB[sp], Sacc[t], 0, 0, 0); } }
        { h16* Ob = OB + (n & 1) * 8192;
#pragma unroll
          for (int rt = 0; rt < 4; ++rt)
#pragma unroll
              for (int rgi = 0; rgi < 4; ++rgi) Ob[(16 * rt + 4 * kg + rgi) * 128 + 16 * wid + fr] = (h16)oacc[rt][rgi]; }
        asm volatile("s_waitcnt vmcnt(0)" ::: "memory");
        __syncthreads();
#pragma unroll
        for (int rt = 0; rt < 4; ++rt) { Uc[rt] = Un[rt]; egc[rt] = egn[rt]; ekc[rt] = ekn[rt]; }
        eglc = egln;
    }
    {
        const h16* Ob = OB + 8192;
#pragma unroll
        for (int rr = 0; rr < 8; ++rr) { const int c = 8 * wid + rr; const h16x2 ov = *(const h16x2*)(Ob + c * 128 + 2 * lane);
            const float o0 = (float)ov[0], o1 = (float)ov[1]; const float ss = wave_sum(o0 * o0 + o1 * o1); const float r = 1.0f / sqrtf(ss * (1.0f / 128.0f) + EPS);
            const size_t bt = (size_t)b * NT + 64 * 63 + c; const h16x2 gt = *(const h16x2*)(gz + bt * 1024 + h * 128 + 2 * lane);
            h16x2 o; o[0] = (h16)(o0 * r * ng0 * (float)gt[0]); o[1] = (h16)(o1 * r * ng1 * (float)gt[1]);
            *(h16x2*)(omix + bt * 2048 + h * 128 + 2 * lane) = o; }
    }
#undef GDN_GLDS
#undef GDN_LDREG
}

__device__ __forceinline__ unsigned f2key(float x) { const unsigned u = __float_as_uint(x); return (u & 0x80000000u) ? ~u : (u | 0x80000000u); }
typedef float f32x16 __attribute__((ext_vector_type(16)));
__device__ __forceinline__ float wave_min(float v) {
#pragma unroll
    for (int o = 1; o < 64; o <<= 1) v = fminf(v, __shfl_xor(v, o));
    return v;
}
__device__ __forceinline__ unsigned lane_below(unsigned long long m) { return __builtin_amdgcn_mbcnt_hi((unsigned)(m >> 32), __builtin_amdgcn_mbcnt_lo((unsigned)m, 0u)); }
__device__ __forceinline__ void idx8_task(const Params& p, unsigned char* smem, int b, int qb) {
    const int tid = opaque_tid(), wid = __builtin_amdgcn_readfirstlane(tid >> 6), lane = tid & 63;
    const int t0 = qb * 8;
    unsigned short* selg = (unsigned short*)(p.ws + OFF_SEL) + ((size_t)b * NT + t0) * 256;
    if (t0 + 8 <= 256) {
        for (int i = tid; i < 8 * 256; i += 512) { const int q = i >> 8, k = i & 255; selg[i] = (unsigned short)(k <= t0 + q ? k : 0); }
        return;
    }
    float* sc = (float*)smem;
    unsigned* hist = (unsigned*)(smem + 131072 + wid * 2048);
    unsigned* cand = hist + 256;
    __syncthreads();
    {
        const int n8 = t0 + 8;
        const int ntile = (n8 + 31) >> 5, ntile_pad = ((n8 + 255) >> 8) << 3;
        const h16* iq = (const h16*)(p.ws + OFF_IQ) + ((size_t)b * NT + t0) * 1024;
        const float* iw = (const float*)(p.ws + OFF_IW) + ((size_t)b * NT + t0) * 16;
        const h16* ik = (const h16*)(p.ws + OFF_IK) + (size_t)b * NT * 64;
        const int r = lane & 31, kh = lane >> 5, qq = (r >> 2) & 1, hh = (r & 3) + 4 * (r >> 3);
        h16x8 Af[4][4]; f32x4 Wr[4][4];
#pragma unroll
        for (int a = 0; a < 4; ++a) {
#pragma unroll
            for (int s = 0; s < 4; ++s) Af[a][s] = *(const h16x8*)(iq + (size_t)(2 * a + qq) * 1024 + hh * 64 + 16 * s + 8 * kh);
#pragma unroll
            for (int c = 0; c < 4; ++c) Wr[a][c] = *(const f32x4*)(iw + (size_t)(2 * a + kh) * 16 + 4 * c);
        }
        for (int i = wid; i < ntile_pad; i += 8) {
            const int key = 32 * i + r;
            if (i < ntile) {
                h16x8 Bf[4];
#pragma unroll
                for (int s = 0; s < 4; ++s) Bf[s] = *(const h16x8*)(ik + (size_t)key * 64 + 16 * s + 8 * kh);
#pragma unroll
                for (int a = 0; a < 4; ++a) {
                    f32x16 acc;
#pragma unroll
                    for (int e = 0; e < 16; ++e) acc[e] = 0.f;
#pragma unroll
                    for (int s = 0; s < 4; ++s) acc = __builtin_amdgcn_mfma_f32_32x32x16_f16(Af[a][s], Bf[s], acc, 0, 0, 0);
                    float s0 = 0.f;
#pragma unroll
                    for (int e = 0; e < 16; ++e) s0 += Wr[a][e >> 2][e & 3] * fmaxf(acc[e], 0.f);
                    const int q = 2 * a + kh;
                    sc[q * 4096 + key] = (key > t0 + q) ? -INFINITY : s0;
                }
            } else {
#pragma unroll
                for (int a = 0; a < 4; ++a) sc[(2 * a + kh) * 4096 + key] = -INFINITY;
            }
        }
    }
    __syncthreads();
    {
        const int tq = t0 + wid, n = tq + 1;
        const float* row = sc + wid * 4096;
        const int ng = (n + 255) >> 8;
        f32x4 x[16];
#pragma unroll
        for (int g = 0; g < 16; ++g) { if (g < ng) x[g] = *(const f32x4*)(row + 256 * g + 4 * lane); else x[g] = (f32x4){-INFINITY, -INFINITY, -INFINITY, -INFINITY}; }
        float hi = -INFINITY, lo = INFINITY;
#pragma unroll
        for (int g = 0; g < 16; ++g)
#pragma unroll
            for (int c = 0; c < 4; ++c) { const float v = x[g][c]; hi = fmaxf(hi, v); lo = fminf(lo, v == -INFINITY ? INFINITY : v); }
        hi = wave_max(hi); lo = wave_min(lo);
        const float scale = (hi > lo) ? 255.99f / (hi - lo) : 0.f; const float off = -lo * scale;
        *(u32x4*)(hist + 4 * lane) = (u32x4){0u, 0u, 0u, 0u};
#pragma unroll
        for (int g = 0; g < 16; ++g) { if (g < ng) {
#pragma unroll
            for (int c = 0; c < 4; ++c) { int bin = (int)fmaf(x[g][c], scale, off); bin = bin < 0 ? 0 : (bin > 255 ? 255 : bin); atomicAdd(&hist[bin], 1u); } } }
        unsigned bstar, need;
        {
            const u32x4 h4 = *(const u32x4*)(hist + 4 * lane); const unsigned s = h4[0] + h4[1] + h4[2] + h4[3];
            unsigned suf = s;
#pragma unroll
            for (int o = 1; o < 64; o <<= 1) { const unsigned tt = __shfl_down(suf, o); if (lane + o < 64) suf += tt; }
            const unsigned above = suf - s;
            const bool mine = (above < 256u && 256u <= suf);
            unsigned cum = above; unsigned bin = 0;
            if (cum + h4[3] >= 256u) bin = 3; else { cum += h4[3]; if (cum + h4[2] >= 256u) bin = 2; else { cum += h4[2]; if (cum + h4[1] >= 256u) bin = 1; else { cum += h4[1]; bin = 0; } } }
            const unsigned long long mm = __ballot(mine);
            const int src = (int)__builtin_ctzll(mm);
            bstar = (unsigned)__shfl((int)(4 * lane + bin), src); need = (unsigned)__shfl((int)(256u - cum), src);
        }
        unsigned m = 0;
#pragma unroll
        for (int g = 0; g < 16; ++g) { if (g < ng) {
#pragma unroll
            for (int c = 0; c < 4; ++c) { int bin = (int)fmaf(x[g][c], scale, off); bin = bin < 0 ? 0 : (bin > 255 ? 255 : bin);
                const bool pr = ((unsigned)bin == bstar); const unsigned long long mk = __ballot(pr);
                if (mk) { const unsigned pos = m + lane_below(mk); if (pr && pos < 256u) cand[pos] = f2key(x[g][c]); m += (unsigned)__builtin_popcountll(mk); } } } }
        unsigned Kt = 0, rr = need;
        if (m <= 256u) {
            const int nc = (int)((m + 63u) >> 6);
            unsigned c0 = (lane < (int)m) ? cand[lane] : 0u, c1 = (64 + lane < (int)m) ? cand[64 + lane] : 0u, c2 = (128 + lane < (int)m) ? cand[128 + lane] : 0u, c3 = (192 + lane < (int)m) ? cand[192 + lane] : 0u;
            for (int bit = 31; bit >= 0; --bit) {
                const unsigned test = (Kt | (1u << bit)) >> bit;
                unsigned cnt = (unsigned)__builtin_popcountll(__ballot((c0 >> bit) == test));
                if (nc > 1) cnt += (unsigned)__builtin_popcountll(__ballot((c1 >> bit) == test));
                if (nc > 2) cnt += (unsigned)__builtin_popcountll(__ballot((c2 >> bit) == test));
                if (nc > 3) cnt += (unsigned)__builtin_popcountll(__ballot((c3 >> bit) == test));
                if (cnt >= rr) Kt |= (1u << bit); else rr -= cnt;
            }
        } else {
            for (int bit = 31; bit >= 0; --bit) {
                const unsigned test = (Kt | (1u << bit)) >> bit; unsigned cnt = 0;
                for (int idx = lane; idx < ng * 256; idx += 64) { const float v = row[idx]; int bin = (int)fmaf(v, scale, off); bin = bin < 0 ? 0 : (bin > 255 ? 255 : bin);
                    const bool pr = ((unsigned)bin == bstar) && ((f2key(v) >> bit) == test); cnt += (unsigned)__builtin_popcountll(__ballot(pr)); }
                if (cnt >= rr) Kt |= (1u << bit); else rr -= cnt;
            }
        }
        unsigned short* so = selg + (size_t)wid * 256;
        unsigned outb = 0, eqb = 0;
#pragma unroll
        for (int g = 0; g < 16; ++g) { if (g < ng) {
#pragma unroll
            for (int c = 0; c < 4; ++c) { const unsigned k = f2key(x[g][c]); const bool gt = k > Kt; bool eq = (k == Kt);
                const unsigned long long me = __ballot(eq); bool take = gt;
                if (me) { const unsigned er = eqb + lane_below(me); take = gt || (eq && er < rr); eqb += (unsigned)__builtin_popcountll(me); }
                const unsigned long long mt = __ballot(take);
                if (mt) { const unsigned pos = outb + lane_below(mt); if (take) so[pos] = (unsigned short)(256 * g + 4 * lane + c); outb += (unsigned)__builtin_popcountll(mt); } } } }
    }
}

typedef short v4s_t __attribute__((__vector_size__(4 * sizeof(short))));
__device__ __forceinline__ h16x4 lds_tr16(const LAS unsigned char* a) { const v4s_t v = __builtin_amdgcn_ds_read_tr16_b64_v4i16((LAS v4s_t*)a); return __builtin_bit_cast(h16x4, v); }
__device__ __forceinline__ void attn4_task(const Params& p, unsigned char* smem, int task) {
    const int tid = opaque_tid(), wid = __builtin_amdgcn_readfirstlane(tid >> 6), lane = tid & 63, kg = lane >> 4, fr = lane & 15;
    const int bt = task * 4 + (wid >> 1), g = wid & 1; const int b = bt / NT, t = bt % NT; const int nvalid = (t + 1) < 256 ? (t + 1) : 256;
    unsigned char* vl = smem + wid * 17408;
    LAS unsigned char* vll = (LAS unsigned char*)vl;
    unsigned short* sl = (unsigned short*)(vl + 16384);
    const h16* akb = (const h16*)(p.ws + OFF_AK) + (size_t)b * NT * 256 + g * 128;
    const h16* avb = (const h16*)(p.ws + OFF_AV) + (size_t)b * NT * 256 + g * 128;
    { const h16x4 s4 = *(const h16x4*)((const h16*)(p.ws + OFF_SEL) + (size_t)bt * 256 + 4 * lane); *(h16x4*)(sl + 4 * lane) = s4; }
    h16x8 Qf[4];
#pragma unroll
    for (int s = 0; s < 4; ++s) { if (fr < 4) Qf[s] = *(const h16x8*)((const h16*)(p.ws + OFF_AQ) + (size_t)bt * 1024 + (4 * g + fr) * 128 + 32 * s + 8 * kg);
        else { for (int j = 0; j < 8; ++j) Qf[s][j] = (h16)0.f; } }
    f32x4 lg[16];
#pragma unroll
    for (int ib = 0; ib < 4; ++ib) {
        h16x8 Kf[4][4];
#pragma unroll
        for (int ii = 0; ii < 4; ++ii) { const int key = sl[16 * (4 * ib + ii) + fr];
#pragma unroll
            for (int s = 0; s < 4; ++s) Kf[ii][s] = *(const h16x8*)(akb + (size_t)key * 256 + 32 * s + 8 * kg); }
#pragma unroll
        for (int ii = 0; ii < 4; ++ii) { f32x4 a = (f32x4){0.f, 0.f, 0.f, 0.f};
#pragma unroll
            for (int s = 0; s < 4; ++s) a = __builtin_amdgcn_mfma_f32_16x16x32_f16(Kf[ii][s], Qf[s], a, 0, 0, 0);
            lg[4 * ib + ii] = a; }
    }
    float m = -INFINITY;
#pragma unroll
    for (int i = 0; i < 16; ++i)
#pragma unroll
        for (int r = 0; r < 4; ++r) { const int slot = 16 * i + 4 * kg + r; const float v = (slot < nvalid) ? lg[i][r] : -INFINITY; lg[i][r] = v; m = fmaxf(m, v); }
    m = fmaxf(m, __shfl_xor(m, 16)); m = fmaxf(m, __shfl_xor(m, 32));
    float sum = 0.f;
#pragma unroll
    for (int i = 0; i < 16; ++i)
#pragma unroll
        for (int r = 0; r < 4; ++r) { const float e = __expf(lg[i][r] - m); lg[i][r] = e; sum += e; }
    sum += __shfl_xor(sum, 16); sum += __shfl_xor(sum, 32);
    const float inv = 1.0f / sum;
    h16x8 Pf[8];
#pragma unroll
    for (int ip = 0; ip < 8; ++ip) Pf[ip] = pack8(lg[2 * ip] * inv, lg[2 * ip + 1] * inv);
    f32x4 O[8];
#pragma unroll
    for (int ct = 0; ct < 8; ++ct) O[ct] = (f32x4){0.f, 0.f, 0.f, 0.f};
    const int q4 = fr >> 2, pp = fr & 3;
#pragma unroll
    for (int cq = 0; cq < 4; ++cq) {
        h16x8 Vr[16];
#pragma unroll
        for (int it = 0; it < 16; ++it) { const int key = sl[64 * cq + 4 * it + kg]; Vr[it] = *(const h16x8*)(avb + (size_t)key * 256 + 8 * fr); }
#pragma unroll
        for (int it = 0; it < 16; ++it) { const int r = 4 * it + kg; *(h16x8*)(vl + r * 256 + (((((fr >> 1) ^ (r & 7)) << 1) | (fr & 1)) << 4)) = Vr[it]; }
#pragma unroll
        for (int ipl = 0; ipl < 2; ++ipl) {
            const int r = 32 * ipl + 4 * kg + q4;
#pragma unroll
            for (int ct = 0; ct < 8; ++ct) {
                const LAS unsigned char* a0 = vll + r * 256 + ((((ct ^ (r & 7)) << 1) | (pp >> 1)) << 4) + (pp & 1) * 8;
                const h16x4 lo = lds_tr16(a0), hi4 = lds_tr16(a0 + 4096);
                h16x8 Bv; Bv[0] = lo[0]; Bv[1] = lo[1]; Bv[2] = lo[2]; Bv[3] = lo[3]; Bv[4] = hi4[0]; Bv[5] = hi4[1]; Bv[6] = hi4[2]; Bv[7] = hi4[3];
                O[ct] = __builtin_amdgcn_mfma_f32_16x16x32_f16(Pf[2 * cq + ipl], Bv, O[ct], 0, 0, 0);
            }
        }
    }
    if (kg == 0) {
        const h16* az = (const h16*)(p.ws + OFF_AZ) + (size_t)bt * 1024 + (4 * g) * 128; h16* om = (h16*)(p.ws + OFF_OMIX) + (size_t)bt * 2048 + 1024 + (4 * g) * 128;
#pragma unroll
        for (int ct = 0; ct < 8; ++ct)
#pragma unroll
            for (int r = 0; r < 4; ++r) om[r * 128 + 16 * ct + fr] = (h16)(O[ct][r] * (float)az[r * 128 + 16 * ct + fr]);
    }
}

__device__ __forceinline__ void phase5(const Params& p) {
    const int tid = threadIdx.x, wid = tid >> 6, lane = tid & 63;
    const int gw = blockIdx.x * 8 + wid, nw = gridDim.x * 8;
    const float* rowss = (const float*)(p.ws + OFF_ROWSS);
    for (int row = gw; row < BT; row += nw) {
        const float r = 1.0f / sqrtf(rowss[row] * (1.0f / DM) + EPS);
        f32x4* o = (f32x4*)(p.out + (size_t)row * DM);
#pragma unroll
        for (int i = 0; i < 8; ++i) { const f32x4 g = ((const f32x4*)p.final_g)[lane + 64 * i]; f32x4 v = o[lane + 64 * i]; v = v * r * g; o[lane + 64 * i] = v; }
    }
}

#define XB_TMO      128
#define XB_XCNT(j)  (256  + 64 * (j))
#define XB_XSUB(j)  (1280 + 64 * (j))
#define XB_XGEN(j)  (2304 + 64 * (j))
#define XB_TOP      3328
#define XB_TOPGEN   3392
#define XCD_BAR_WORDS 3456
#define XB_SPIN_CAP (1u << 18)

__device__ __forceinline__ unsigned xb_ld(unsigned* p)              { return __hip_atomic_load(p, __ATOMIC_RELAXED, __HIP_MEMORY_SCOPE_AGENT); }
__device__ __forceinline__ unsigned xb_add(unsigned* p, unsigned v) { return __hip_atomic_fetch_add(p, v, __ATOMIC_RELAXED, __HIP_MEMORY_SCOPE_AGENT); }
__device__ __forceinline__ unsigned xb_xcc_id() { return (unsigned)__builtin_amdgcn_s_getreg((3 << 11) | 20) & 0xFu; }
#define XB_SPIN(cond, bar) do { unsigned _sp = 0; while (cond) { __builtin_amdgcn_s_sleep(1); \
    if ((++_sp & 255u) == 0u) { if (xb_ld(&(bar)[XB_TMO])) break; if (_sp > XB_SPIN_CAP) { atomicAdd(&(bar)[XB_TMO], 1u); break; } } } } while (0)

struct XcdBarrier {
    unsigned* bar; unsigned x;
    volatile LAS unsigned* st;
};

__device__ __forceinline__ XcdBarrier xcd_barrier_post(unsigned* bar, volatile LAS unsigned* st) {
    XcdBarrier b; b.bar = bar; b.x = xb_xcc_id(); b.st = st;
    if (threadIdx.x == 0) (void)xb_add(&bar[XB_XCNT(b.x)], 1u);
    return b;
}
__device__ __forceinline__ void xcd_barrier_complete(unsigned* bar, unsigned x, unsigned& nloc, unsigned& nx) {
    const unsigned G = gridDim.x * gridDim.y * gridDim.z;
    unsigned sum, cnt, mine, sp = 0u;
    for (;;) {
        sum = 0u; cnt = 0u; mine = 0u;
#pragma unroll
        for (unsigned j = 0; j < 16; ++j) { const unsigned c = xb_ld(&bar[XB_XCNT(j)]); sum += c; cnt += (c > 0u) ? 1u : 0u; mine = (j == x) ? c : mine; }
        if (sum == G) break;
        __builtin_amdgcn_s_sleep(1);
        if ((++sp & 255u) == 0u) { if (xb_ld(&bar[XB_TMO])) break; if (sp > XB_SPIN_CAP) { atomicAdd(&bar[XB_TMO], 1u); break; } }
    }
    nloc = mine > 0u ? mine : 1u; nx = cnt > 0u ? cnt : 1u;
}

__device__ __forceinline__ void xcd_barrier(const XcdBarrier& b) {
    asm volatile("s_waitcnt vmcnt(0)" ::: "memory");
    __syncthreads();
    if (threadIdx.x == 0) {
        unsigned* bar = b.bar;
        __builtin_amdgcn_s_waitcnt(0);
        unsigned nloc = b.st[0], nx = b.st[1];
        if (nloc == 0u) { xcd_barrier_complete(bar, b.x, nloc, nx); b.st[0] = nloc; b.st[1] = nx; }
        const unsigned old = xb_add(&bar[XB_XSUB(b.x)], 1u);
        const unsigned gen = old / nloc;
        if (old + 1u == (gen + 1u) * nloc) {
            __builtin_amdgcn_fence(__ATOMIC_RELEASE, "agent");
            asm volatile("s_waitcnt vmcnt(0)" ::: "memory");
            const unsigned og = xb_add(&bar[XB_TOP], 1u);
            const unsigned tg = og / nx;
            if (og + 1u == (tg + 1u) * nx) xb_add(&bar[XB_TOPGEN], 1u);
            else XB_SPIN(xb_ld(&bar[XB_TOPGEN]) == tg, bar);
            __builtin_amdgcn_fence(__ATOMIC_ACQUIRE, "agent");
            xb_add(&bar[XB_XGEN(b.x)], 1u);
            asm volatile("s_waitcnt vmcnt(0)" ::: "memory");
        } else {
            XB_SPIN(xb_ld(&bar[XB_XGEN(b.x)]) == gen, bar);
            __builtin_amdgcn_fence(__ATOMIC_ACQUIRE, "agent");
            asm volatile("s_waitcnt vmcnt(0)" ::: "memory");
        }
    }
    __syncthreads();
}


template <int LO, int HI>
__global__ void __launch_bounds__(512, 2) k_phases(Params p) {
    extern __shared__ __attribute__((aligned(16))) unsigned char smem[];
#define IN(k) (LO <= (k) && (k) < HI)
#define SEAM(k) do { if constexpr (IN(k) && IN((k) + 1)) { xcd_barrier(xbar); } } while (0)
    XcdBarrier xbar; xbar.bar = nullptr; xbar.x = 0; xbar.st = nullptr;
    if constexpr (HI - LO > 1) {
        volatile LAS unsigned* stw = (volatile LAS unsigned*)((LAS unsigned char*)smem + LDS_BYTES - 48);
        if (threadIdx.x < 4) stw[threadIdx.x] = 0u;
        __syncthreads();
        xbar = xcd_barrier_post((unsigned*)(p.ws + OFF_CTRL + 16384), stw);
    }
    if constexpr (IN(0)) { for (int rep = 0; rep < NREP(0); ++rep) phase0(p, smem); }
    SEAM(0);
    if constexpr (IN(1)) for (int rep = 0; rep < NREP(1); ++rep) {
        pg8::Gemm g{(const h16*)(p.ws + OFF_H), (const h16*)(p.ws + OFF_WT), BT, NPAD, DM};
        pg8::StaticOrder S; S.init(BT, NPAD, gridDim.x, blockIdx.x);
        EpiIn E{p.ws, p.a_log, p.dt_bias};
        pg8::gemm_phase<EpiIn, pg8::StaticOrder>((LAS unsigned char*)smem, g, S, E);
    }
    SEAM(1);
    if constexpr (IN(2)) for (int rep = 0; rep < NREP(2); ++rep) {
        {
            unsigned* qctr = (unsigned*)(p.ws + OFF_CTRL);
            unsigned* lds_t = (unsigned*)(smem + LDS_BYTES - 16);
            for (;;) {
                __syncthreads();
                if (threadIdx.x == 0) lds_t[0] = atomicAdd(qctr + 0 + 16 * rep, 1u);
                __syncthreads();
                const unsigned o = lds_t[0];
                if (o >= 1024u + 2048u) break;
                if (o < 1024u) gdn_prep_pair(p, smem, (int)o);
                else { const unsigned o2 = o - 1024u; idx8_task(p, smem, (int)(o2 & 3u), 511 - (int)(o2 >> 2)); }
            }
        }
    }
    SEAM(2);
    if constexpr (IN(3)) for (int rep = 0; rep < NREP(3); ++rep) {
        {
            unsigned* qctr = (unsigned*)(p.ws + OFF_CTRL);
            unsigned* lds_t = (unsigned*)(smem + LDS_BYTES - 16);
            __syncthreads();
            if (threadIdx.x == 0) lds_t[0] = atomicAdd(qctr + 64 + 16 * rep, 1u);
            __syncthreads();
            const unsigned o = lds_t[0];
            if (o < 32u) gdn_scan_task(p, smem, (int)o);
            for (;;) {
                __syncthreads();
                if (threadIdx.x == 0) lds_t[0] = atomicAdd(qctr + 128 + 16 * rep, 1u);
                __syncthreads();
                const unsigned a = lds_t[0];
                if (a >= (unsigned)(BT / 4)) break;
                attn4_task(p, smem, (int)a);
            }
        }
    }
    SEAM(3);
    if constexpr (IN(4)) {
        pg8::Gemm g{(const h16*)(p.ws + OFF_OMIX), (const h16*)(p.ws + OFF_WOT), BT, DM, DM};
        pg8::StaticOrder S; S.init(BT, DM, gridDim.x, blockIdx.x);
        EpiOut E{p.x, p.out, (float*)(p.ws + OFF_ROWSS)};
        pg8::gemm_phase<EpiOut, pg8::StaticOrder>((LAS unsigned char*)smem, g, S, E);
    }
    SEAM(4);
    if constexpr (IN(5)) { phase5(p); }
#undef IN
#undef SEAM
}

template <int LO, int HI> static void launch_range(const Params& p, int grid, hipStream_t stream, bool coop) {
    static bool attr = false;
    if (!attr) { hipFuncSetAttribute((const void*)k_phases<LO, HI>, hipFuncAttributeMaxDynamicSharedMemorySize, LDS_BYTES); attr = true; }
    if (coop) {
        Params pp = p; void* args[] = {&pp};
        hipError_t e = hipLaunchCooperativeKernel((const void*)k_phases<LO, HI>, dim3(grid), dim3(512), args, LDS_BYTES, stream);
        if (e != hipSuccess) fprintf(stderr, "cooperative launch failed: %s (grid %d)\n", hipGetErrorString(e), grid);
    } else {
        hipLaunchKernelGGL((k_phases<LO, HI>), dim3(grid), dim3(512), LDS_BYTES, stream, p);
    }
}

extern "C" void kernel_launch(void* const* d_in, const int* in_sizes, int n_in, void* d_out, int out_size, void* d_ws, size_t ws_size, hipStream_t stream) {
    if (n_in != 10 || in_sizes[0] != BT * DM || out_size != BT * DM || ws_size < WS_END) {
        fprintf(stderr, "kernel_launch: unexpected shapes (n_in %d in0 %d out %d ws %zu need %zu)\n", n_in, n_in > 0 ? in_sizes[0] : -1, out_size, ws_size, (size_t)WS_END); return; }
    static int grid = 0;
    if (!grid) {
        int dev = 0, cus = 0, per_cu = 0; hipGetDevice(&dev); hipDeviceGetAttribute(&cus, hipDeviceAttributeMultiprocessorCount, dev);
#if FUSED
        hipFuncSetAttribute((const void*)k_phases<0, 6>, hipFuncAttributeMaxDynamicSharedMemorySize, LDS_BYTES);
        hipOccupancyMaxActiveBlocksPerMultiprocessor(&per_cu, (const void*)k_phases<0, 6>, 512, LDS_BYTES);
#else
        per_cu = 1;
#endif
        if (per_cu < 1) per_cu = 1; if (per_cu > 1) per_cu = 1;
        grid = cus * per_cu;
    }
    Params p{};
    p.x = (const float*)d_in[0]; p.pos = (const int*)d_in[1]; p.attn_g = (const float*)d_in[2]; p.w_in = (const float*)d_in[3]; p.conv_w = (const float*)d_in[4];
    p.a_log = (const float*)d_in[5]; p.dt_bias = (const float*)d_in[6]; p.gdn_norm_g = (const float*)d_in[7]; p.w_out = (const float*)d_in[8]; p.final_g = (const float*)d_in[9];
    p.out = (float*)d_out; p.ws = (unsigned char*)d_ws;
    hipMemsetAsync((char*)d_ws + OFF_CTRL, 0, CTL_ZERO_BYTES, stream);
#if FUSED
    launch_range<0, 6>(p, grid, stream, false);
#else
    launch_range<0, 1>(p, grid, stream, false);
    launch_range<1, 2>(p, grid, stream, false);
    launch_range<2, 3>(p, grid, stream, false);
    launch_range<3, 4>(p, grid, stream, false);
    launch_range<4, 5>(p, grid, stream, false);
    launch_range<5, 6>(p, grid, stream, false);
#endif
}
```

```cpp
#include <hip/hip_runtime.h>
#include <hip/hip_cooperative_groups.h>
#include <cstdio>
#include <cstdint>
namespace cg = cooperative_groups;

#ifndef FUSED
#define FUSED 1
#endif
#ifndef REPEAT_PHASE
#define REPEAT_PHASE -1
#endif
#define NREP(k) ((REPEAT_PHASE == (k)) ? 2 : 1)
#ifndef TS_A
#define TS_A -1
#endif
#ifndef TS_ACC
#define TS_ACC -1
#endif
#define ACC_T0() unsigned acc_t0_ = 0; if (TS_ACC >= 0 && threadIdx.x == 0) acc_t0_ = (unsigned)__builtin_amdgcn_s_memrealtime()
#define ACC_ADD(k) do { if (TS_ACC >= 0 && threadIdx.x == 0) { const unsigned t1_ = (unsigned)__builtin_amdgcn_s_memrealtime(); atomicAdd((unsigned*)(p.ws + OFF_CTRL + 8192) + 16 + (k), t1_ - acc_t0_); acc_t0_ = t1_; } } while (0)
#ifndef TS_B
#define TS_B -1
#endif

#define LAS __attribute__((address_space(3)))
typedef _Float16 h16;
typedef h16 h16x8 __attribute__((ext_vector_type(8)));
typedef h16 h16x4 __attribute__((ext_vector_type(4)));
typedef h16 h16x2 __attribute__((ext_vector_type(2)));
typedef float f32x4 __attribute__((ext_vector_type(4)));
typedef float f32x2 __attribute__((ext_vector_type(2)));
typedef unsigned u32x4 __attribute__((ext_vector_type(4)));

constexpr int NB = 4, NT = 4096, DM = 2048, BT = NB * NT;
constexpr int IN_COLS = 7776, NPAD = 7936;
constexpr float EPS = 1e-6f;
constexpr int LDS_BYTES = 155648;

constexpr size_t MB = 1024 * 1024;
constexpr size_t OFF_CTRL = 0;
constexpr size_t OFF_ROWSS = 65536;
constexpr size_t CTL_ZERO_BYTES = 65536 + (size_t)BT * 4;
constexpr size_t OFF_H = 1 * MB;
constexpr size_t OFF_OMIX = OFF_H;
constexpr size_t OFF_WT = OFF_H + 64 * MB;
constexpr size_t OFF_WOT = OFF_WT + (size_t)NPAD * 2048 * 2;
constexpr size_t OFF_QKVR = OFF_WOT + 8 * MB;
constexpr size_t OFF_GZ = OFF_QKVR + (size_t)BT * 3072 * 2;
constexpr size_t OFF_AQ = OFF_GZ + 32 * MB;
constexpr size_t OFF_AK = OFF_AQ + 32 * MB;
constexpr size_t OFF_AV = OFF_AK + 8 * MB;
constexpr size_t OFF_AZ = OFF_AV + 8 * MB;
constexpr size_t OFF_IQ = OFF_AZ + 32 * MB;
constexpr size_t OFF_IK = OFF_IQ + 32 * MB;
constexpr size_t OFF_GB = OFF_IK + 2 * MB;
constexpr size_t OFF_IW = OFF_GB + 1 * MB;
constexpr size_t OFF_COS = OFF_IW + 1 * MB;
constexpr size_t OFF_SIN = OFF_COS + 2 * MB;
constexpr size_t OFF_SEL = OFF_SIN + 2 * MB;
constexpr size_t OFF_REC = OFF_SEL + 8 * MB;
constexpr size_t WS_END = OFF_REC + (size_t)2048 * 74752;

struct Params {
    const float* x; const int* pos; const float* attn_g; const float* w_in; const float* conv_w; const float* a_log;
    const float* dt_bias; const float* gdn_norm_g; const float* w_out; const float* final_g; float* out; unsigned char* ws;
};

__device__ __forceinline__ float wave_sum(float v) {
#pragma unroll
    for (int o = 1; o < 64; o <<= 1) v += __shfl_xor(v, o);
    return v;
}
__device__ __forceinline__ float wave_max(float v) {
#pragma unroll
    for (int o = 1; o < 64; o <<= 1) v = fmaxf(v, __shfl_xor(v, o));
    return v;
}
__device__ __forceinline__ int opaque_tid() { int t = threadIdx.x; asm volatile("" : "+v"(t)); return t; }
__device__ __forceinline__ float silu_f(float x) { return x * __builtin_amdgcn_rcpf(1.0f + __builtin_amdgcn_exp2f(-1.4426950408889634f * x)); }

namespace pg8 {
constexpr int BM = 256, BK = 64, HALF = 128, HTB = HALF * BK * 2, STAGE_BYTES = 8 * HTB, NXCD = 8, WGM = 8;
__host__ __device__ __forceinline__ int lds_byte(int r, int c) { const int st = (r >> 4) * 2 + (c >> 5), rr = r & 15, cc = c & 31, ob = rr * 64 + cc * 2; return st * 1024 + (ob ^ (((ob >> 9) & 1) << 5)); }
__host__ __device__ __forceinline__ void stage_rc(int b, int& R, int& C) { const int st = b / 1024, sb = b % 1024, swz = sb ^ (((sb >> 9) & 1) << 5); R = (st >> 1) * 16 + swz / 64; C = (st & 1) * 32 + (swz % 64) / 2; }
__host__ __device__ __forceinline__ int perm32(int rho) { const int n = rho >> 4, i = rho & 15; return 8 * (i >> 2) + 4 * n + (i & 3); }
struct Unit { int pm, pn; };
struct Gemm { const h16* A; const h16* Bt; int M, N, K; };
struct StaticOrder {
    int nM, nN, nwg, G, c;
    __host__ __device__ void init(int M, int N, int G_, int c_) { nM = M / BM; nN = N / BM; nwg = nM * nN; G = G_; c = c_; }
    __host__ __device__ bool next(int i, Unit& u) const {
        const long L = (long)i * G + c; if (L >= nwg) return false;
        int wgid = (int)L; { const int q = nwg / NXCD, r = nwg % NXCD, xcd = wgid % NXCD, off = wgid / NXCD; wgid = (xcd < r ? xcd * (q + 1) : r * (q + 1) + (xcd - r) * q) + off; }
        const int nig = WGM * nN, gid = wgid / nig, fm = gid * WGM, gsz = (nM - fm) < WGM ? (nM - fm) : WGM;
        u.pm = fm + ((wgid % nig) % gsz); u.pn = (wgid % nig) / gsz; return true;
    }
    __device__ __forceinline__ void a_ready(const Unit&) const {}
    __device__ __forceinline__ void done(const Unit&) const {}
};

template <class Epi, class Sched>
__device__ __forceinline__ void gemm_phase(LAS unsigned char* lds, const Gemm g, const Sched& S, const Epi& E) {
    const int tid = opaque_tid(), wid = __builtin_amdgcn_readfirstlane(tid >> 6), lane = tid & 63, wr = wid >> 2, wc = wid & 3, fr = lane & 15, fq = lane >> 4;
    const int K = g.K, nt = K / BK;
    unsigned voffA[2], voffB[2];
#pragma unroll
    for (int i = 0; i < 2; ++i) { int R, C; stage_rc(tid * 16 + i * 8192, R, C); const int Rb = Epi::PERM ? ((R & ~31) + perm32(R & 31)) : R;
        voffA[i] = (unsigned)(R * K + C) * 2u; voffB[i] = (unsigned)(Rb * K + C) * 2u; }
    const size_t kstep = (size_t)(BK * 2);
    const size_t hstep = (size_t)HALF * K * 2;
    const size_t tstep = 2 * hstep;
    const unsigned ldsw = (unsigned)wid * 1024u;
    const int aoff = lds_byte(wr * 64 + fr, fq * 8), boff = lds_byte(wc * 32 + fr, fq * 8);
#define PG8_SA(b, h) (((b) * 2 + (h)) * HTB)
#define PG8_SB(b, h) ((4 + (b) * 2 + (h)) * HTB)
#define PG8_STAGE(bufoff, gbase, voff) do { _Pragma("unroll") for (int _i = 0; _i < 2; ++_i) \
        __builtin_amdgcn_global_load_lds((const unsigned*)((const char*)(gbase) + (voff)[_i]), (LAS unsigned*)(lds + (bufoff) + ldsw + _i * 8192), 16, 0, 0); } while (0)
#define PG8_LDA(dst, b, h) do { _Pragma("unroll") for (int m = 0; m < 4; ++m) _Pragma("unroll") for (int k = 0; k < 2; ++k) dst[m][k] = *(const LAS h16x8*)(lds + PG8_SA(b, h) + aoff + m * 2048 + k * 1024); } while (0)
#define PG8_LDB(dst, b, h) do { _Pragma("unroll") for (int n = 0; n < 2; ++n) _Pragma("unroll") for (int k = 0; k < 2; ++k) dst[n][k] = *(const LAS h16x8*)(lds + PG8_SB(b, h) + boff + n * 2048 + k * 1024); } while (0)
#define PG8_MMA(ai, bj, At, Bt) do { __builtin_amdgcn_s_setprio(1); _Pragma("unroll") for (int m = 0; m < 4; ++m) _Pragma("unroll") for (int n = 0; n < 2; ++n) _Pragma("unroll") for (int k = 0; k < 2; ++k) \
        acc[ai][bj][m][n] = __builtin_amdgcn_mfma_f32_16x16x32_f16(Bt[n][k], At[m][k], acc[ai][bj][m][n], 0, 0, 0); __builtin_amdgcn_s_setprio(0); } while (0)
#define PG8_WAIT_V(n) asm volatile("s_waitcnt vmcnt(" #n ")" ::: "memory")
#define PG8_WAIT_L(n) asm volatile("s_waitcnt lgkmcnt(" #n ")" ::: "memory")
#define PG8_BAR __builtin_amdgcn_s_barrier()
#define PG8_SCHED __builtin_amdgcn_sched_barrier(0)
    Unit cur, nxt; int ui = 0;
    if (!S.next(0, cur)) return;
    f32x4 acc[2][2][4][2];
#pragma unroll
    for (int a = 0; a < 2; ++a)
#pragma unroll
        for (int b = 0; b < 2; ++b)
#pragma unroll
            for (int m = 0; m < 4; ++m)
#pragma unroll
                for (int n = 0; n < 2; ++n) acc[a][b][m][n] = (f32x4){0.f, 0.f, 0.f, 0.f};
    h16x8 At[4][2], B0[2][2], B1[2][2];
    const char* cA = (const char*)g.A + (size_t)cur.pm * tstep; const char* cB = (const char*)g.Bt + (size_t)cur.pn * tstep;
    S.a_ready(cur);
    PG8_STAGE(PG8_SB(0, 0), cB, voffB); PG8_STAGE(PG8_SA(0, 0), cA, voffA); PG8_STAGE(PG8_SB(0, 1), cB + hstep, voffB); PG8_STAGE(PG8_SA(0, 1), cA + hstep, voffA);
    if (wr == 1) PG8_BAR;
    PG8_WAIT_V(4); PG8_BAR;
    PG8_STAGE(PG8_SB(1, 0), cB + kstep, voffB); PG8_STAGE(PG8_SA(1, 0), cA + kstep, voffA); PG8_STAGE(PG8_SB(1, 1), cB + hstep + kstep, voffB);
    PG8_WAIT_V(6); PG8_BAR;
    for (;;) {
        const bool has_next = S.next(ui + 1, nxt);
        const char* nA = has_next ? (const char*)g.A + (size_t)nxt.pm * tstep : cA; const char* nB = has_next ? (const char*)g.Bt + (size_t)nxt.pn * tstep : cB;
        for (int t = 0; t < nt; t += 2) {
            const bool last = (t == nt - 2);
            const char* a1 = cA + (size_t)(t + 1) * kstep;
            const char* a2 = last ? nA : cA + (size_t)(t + 2) * kstep; const char* b2 = last ? nB : cB + (size_t)(t + 2) * kstep;
            const char* a3 = a2 + kstep; const char* b3 = b2 + kstep;
            if (last && has_next) S.a_ready(nxt);
            PG8_LDB(B0, 0, 0); PG8_SCHED; PG8_LDA(At, 0, 0); PG8_STAGE(PG8_SA(1, 1), a1 + hstep, voffA);
            PG8_WAIT_L(8); PG8_BAR; PG8_WAIT_L(0); PG8_MMA(0, 0, At, B0); PG8_BAR; PG8_SCHED;
            PG8_LDB(B1, 0, 1); PG8_STAGE(PG8_SB(0, 0), b2, voffB);
            PG8_BAR; PG8_WAIT_L(0); PG8_MMA(0, 1, At, B1); PG8_BAR;
            PG8_LDA(At, 0, 1); PG8_STAGE(PG8_SA(0, 0), a2, voffA);
            PG8_BAR; PG8_WAIT_L(0); PG8_MMA(1, 0, At, B0); PG8_BAR; PG8_SCHED;
            PG8_STAGE(PG8_SB(0, 1), b2 + hstep, voffB);
            PG8_WAIT_V(6); PG8_BAR; PG8_MMA(1, 1, At, B1); PG8_BAR;
            PG8_LDB(B0, 1, 0); PG8_SCHED; PG8_LDA(At, 1, 0); PG8_STAGE(PG8_SA(0, 1), a2 + hstep, voffA);
            PG8_WAIT_L(8); PG8_BAR; PG8_WAIT_L(0); PG8_MMA(0, 0, At, B0); PG8_BAR; PG8_SCHED;
            PG8_LDB(B1, 1, 1); PG8_STAGE(PG8_SB(1, 0), b3, voffB);
            PG8_BAR; PG8_WAIT_L(0); PG8_MMA(0, 1, At, B1); PG8_BAR;
            PG8_LDA(At, 1, 1); PG8_STAGE(PG8_SA(1, 0), a3, voffA);
            PG8_BAR; PG8_WAIT_L(0); PG8_MMA(1, 0, At, B0); PG8_BAR; PG8_SCHED;
            PG8_STAGE(PG8_SB(1, 1), b3 + hstep, voffB);
            PG8_WAIT_V(6); PG8_BAR; PG8_MMA(1, 1, At, B1); PG8_BAR;
        }
        if (wr == 0) PG8_BAR;
        E(acc, cur, wr, wc, fr, fq); S.done(cur);
        if (!has_next) break;
#pragma unroll
        for (int a = 0; a < 2; ++a)
#pragma unroll
            for (int b = 0; b < 2; ++b)
#pragma unroll
                for (int m = 0; m < 4; ++m)
#pragma unroll
                    for (int n = 0; n < 2; ++n) acc[a][b][m][n] = (f32x4){0.f, 0.f, 0.f, 0.f};
        cur = nxt; cA = nA; cB = nB; ++ui;
        if (wr == 1) PG8_BAR;
    }
    PG8_WAIT_V(0);
    PG8_BAR;
#undef PG8_SA
#undef PG8_SB
#undef PG8_STAGE
#undef PG8_LDA
#undef PG8_LDB
#undef PG8_MMA
#undef PG8_WAIT_V
#undef PG8_WAIT_L
#undef PG8_BAR
#undef PG8_SCHED
}
}

struct EpiIn {
    static constexpr bool PERM = true;
    unsigned char* ws; const float* a_log; const float* dt_bias;
    __device__ __forceinline__ void operator()(const f32x4 (&acc)[2][2][4][2], const pg8::Unit& u, int wr, int wc, int fr, int fq) const {
        const int pn = u.pn;
        const int rowb = u.pm * 256 + wr * 64 + fr;
        const int cw = wc * 32 + 8 * fq;
        const float* cosT = (const float*)(ws + OFF_COS); const float* sinT = (const float*)(ws + OFF_SIN);
        if (pn < 30) {
            h16* base; int ldc, colt, mode; float scale = 1.f;
            if (pn < 12) { base = (h16*)(ws + OFF_QKVR); ldc = 3072; colt = pn * 256; mode = 0; }
            else if (pn < 16) { base = (h16*)(ws + OFF_GZ); ldc = 1024; colt = (pn - 12) * 256; mode = 1; }
            else if (pn < 20) { base = (h16*)(ws + OFF_AQ); ldc = 1024; colt = (pn - 16) * 256; mode = 2; }
            else if (pn == 20) { base = (h16*)(ws + OFF_AK); ldc = 256; colt = 0; mode = 2; }
            else if (pn == 21) { base = (h16*)(ws + OFF_AV); ldc = 256; colt = 0; mode = 4; }
            else if (pn < 26) { base = (h16*)(ws + OFF_AZ); ldc = 1024; colt = (pn - 22) * 256; mode = 1; }
            else { base = (h16*)(ws + OFF_IQ); ldc = 1024; colt = (pn - 26) * 256; mode = 3; }
            const bool rot_wave = (mode == 2 && wc == 0) || (mode == 3 && (wc & 1) == 0);
            const int xm = (mode == 2) ? 32 : 16;
            const bool rot_lane = (mode == 2) ? true : (fq < 2);
            const float sgn = (mode == 2) ? (fq < 2 ? -1.f : 1.f) : (fq == 0 ? -1.f : 1.f);
            const int tix = (mode == 2) ? 8 * (fq & 1) : 16;
#pragma unroll
            for (int ai = 0; ai < 2; ++ai)
#pragma unroll
                for (int m = 0; m < 4; ++m) {
                    const int row = rowb + ai * 128 + m * 16;
                    float cs[8], sn[8];
                    if (rot_wave) {
                        const f32x4 c0 = *(const f32x4*)(cosT + (size_t)row * 24 + tix), c1 = *(const f32x4*)(cosT + (size_t)row * 24 + tix + 4);
                        const f32x4 s0 = *(const f32x4*)(sinT + (size_t)row * 24 + tix), s1 = *(const f32x4*)(sinT + (size_t)row * 24 + tix + 4);
#pragma unroll
                        for (int j = 0; j < 4; ++j) { cs[j] = c0[j]; cs[4 + j] = c1[j]; sn[j] = s0[j]; sn[4 + j] = s1[j]; }
                    }
#pragma unroll
                    for (int bj = 0; bj < 2; ++bj) {
                        float v[8];
#pragma unroll
                        for (int j = 0; j < 4; ++j) { v[j] = acc[ai][bj][m][0][j]; v[4 + j] = acc[ai][bj][m][1][j]; }
                        if (rot_wave) {
#pragma unroll
                            for (int j = 0; j < 8; ++j) { const float pv = __shfl_xor(v[j], xm); if (rot_lane) v[j] = v[j] * cs[j] + sgn * pv * sn[j]; }
                        }
                        if (mode == 1) {
#pragma unroll
                            for (int j = 0; j < 8; ++j) v[j] = silu_f(v[j]);
                        }
                        if (mode == 4) {
                            int w0 = 0, w1 = 0;
                            w0 = __builtin_amdgcn_cvt_pk_fp8_f32(v[0], v[1], w0, false); w0 = __builtin_amdgcn_cvt_pk_fp8_f32(v[2], v[3], w0, true);
                            w1 = __builtin_amdgcn_cvt_pk_fp8_f32(v[4], v[5], w1, false); w1 = __builtin_amdgcn_cvt_pk_fp8_f32(v[6], v[7], w1, true);
                            typedef int i32x2b __attribute__((ext_vector_type(2)));
                            *(i32x2b*)((unsigned char*)base + (size_t)row * ldc + bj * 128 + cw) = (i32x2b){w0, w1};
                        } else if (mode == 2) {
                            int w0 = 0, w1 = 0;
                            w0 = __builtin_amdgcn_cvt_pk_fp8_f32(v[0], v[1], w0, false); w0 = __builtin_amdgcn_cvt_pk_fp8_f32(v[2], v[3], w0, true);
                            w1 = __builtin_amdgcn_cvt_pk_fp8_f32(v[4], v[5], w1, false); w1 = __builtin_amdgcn_cvt_pk_fp8_f32(v[6], v[7], w1, true);
                            typedef int i32x2 __attribute__((ext_vector_type(2)));
                            *(i32x2*)((unsigned char*)base + (size_t)row * ldc + colt + bj * 128 + fq * 32 + wc * 8) = (i32x2){w0, w1};
                        } else {
                            h16x8 o;
#pragma unroll
                            for (int j = 0; j < 8; ++j) o[j] = (h16)(v[j] * scale);
                            *(h16x8*)(base + (size_t)row * ldc + colt + bj * 128 + cw) = o;
                        }
                    }
                }
        } else {
            h16* ik = (h16*)(ws + OFF_IK); float* gb = (float*)(ws + OFF_GB); float* iw = (float*)(ws + OFF_IW);
#pragma unroll
            for (int ai = 0; ai < 2; ++ai)
#pragma unroll
                for (int m = 0; m < 4; ++m) {
                    const int row = rowb + ai * 128 + m * 16;
                    float v[8];
#pragma unroll
                    for (int j = 0; j < 4; ++j) { v[j] = acc[ai][0][m][0][j]; v[4 + j] = acc[ai][0][m][1][j]; }
                    const f32x4 c0 = *(const f32x4*)(cosT + (size_t)row * 24 + 16), c1 = *(const f32x4*)(cosT + (size_t)row * 24 + 20);
                    const f32x4 s0 = *(const f32x4*)(sinT + (size_t)row * 24 + 16), s1 = *(const f32x4*)(sinT + (size_t)row * 24 + 20);
                    if (wc == 0) {
                        const float sgn = (fq == 0 ? -1.f : 1.f);
#pragma unroll
                        for (int j = 0; j < 8; ++j) { const float pv = __shfl_xor(v[j], 16); const float c = j < 4 ? c0[j & 3] : c1[j & 3], s = j < 4 ? s0[j & 3] : s1[j & 3];
                            if (fq < 2) v[j] = v[j] * c + sgn * pv * s; }
                    }
                    if (wc < 2) {
                        h16x8 o;
#pragma unroll
                        for (int j = 0; j < 8; ++j) o[j] = (h16)v[j];
                        *(h16x8*)(ik + (size_t)row * 64 + cw) = o;
                    } else if (wc == 2) {
                        if (fq == 0) {
#pragma unroll
                            for (int j = 0; j < 8; ++j) { const float z = v[j] + dt_bias[j]; const float sp = z > 20.f ? z : log1pf(expf(z)); gb[(size_t)row * 16 + j] = -expf(a_log[j]) * sp; }
                        } else if (fq == 1) {
#pragma unroll
                            for (int j = 0; j < 8; ++j) gb[(size_t)row * 16 + 8 + j] = 1.0f / (1.0f + expf(-v[j]));
                        } else {
#pragma unroll
                            for (int j = 0; j < 8; ++j) iw[(size_t)row * 16 + 8 * (fq - 2) + j] = v[j] * 0.03125f;
                        }
                    }
                }
        }
    }
};

struct PanelOrder {
    int c;
    __device__ __forceinline__ bool next(int i, pg8::Unit& u) const { if (i >= 2) return false; u.pm = 32 * i + 4 * (c & 7) + (c >> 6); u.pn = (c >> 3) & 7; return true; }
    __device__ __forceinline__ void a_ready(const pg8::Unit&) const {}
    __device__ __forceinline__ void done(const pg8::Unit&) const {}
};
struct EpiOutNorm {
    static constexpr bool PERM = false;
    const float* x; float* out; float* rowss; unsigned* cnt; const float* fg;
    __device__ __forceinline__ void operator()(f32x4 (&acc)[2][2][4][2], const pg8::Unit& u, int wr, int wc, int fr, int fq) const {
        const int rowb = u.pm * 256 + wr * 64 + fr, col0 = u.pn * 256 + wc * 32 + 4 * fq;
#pragma unroll
        for (int ai = 0; ai < 2; ++ai)
#pragma unroll
            for (int m = 0; m < 4; ++m) {
                const int row = rowb + ai * 128 + m * 16; float ss = 0.f;
#pragma unroll
                for (int bj = 0; bj < 2; ++bj)
#pragma unroll
                    for (int n = 0; n < 2; ++n) {
                        const f32x4 y = *(const f32x4*)(x + (size_t)row * DM + col0 + bj * 128 + n * 16) + acc[ai][bj][m][n];
                        acc[ai][bj][m][n] = y; ss += (y[0] * y[0] + y[1] * y[1]) + (y[2] * y[2] + y[3] * y[3]);
                    }
                ss += __shfl_xor(ss, 16); ss += __shfl_xor(ss, 32);
                if (fq == 0) atomicAdd(rowss + row, ss);
            }
        asm volatile("s_waitcnt vmcnt(0)" ::: "memory");
        unsigned* cw = cnt + (u.pm * 2 + wr) * 16;
        if ((threadIdx.x & 63) == 0) __hip_atomic_fetch_add(cw, 1u, __ATOMIC_RELAXED, __HIP_MEMORY_SCOPE_AGENT);
        { unsigned spins = 0;
          while ((unsigned)__builtin_amdgcn_readfirstlane((int)__hip_atomic_load(cw, __ATOMIC_RELAXED, __HIP_MEMORY_SCOPE_AGENT)) < 32u) { __builtin_amdgcn_s_sleep(2); if (++spins > (1u << 22)) break; } }
        f32x4 gv[2][2];
#pragma unroll
        for (int bj = 0; bj < 2; ++bj)
#pragma unroll
            for (int n = 0; n < 2; ++n) gv[bj][n] = *(const f32x4*)(fg + col0 + bj * 128 + n * 16);
#pragma unroll
        for (int ai = 0; ai < 2; ++ai)
#pragma unroll
            for (int m = 0; m < 4; ++m) {
                const int row = rowb + ai * 128 + m * 16;
                const float ssr = __hip_atomic_load(rowss + row, __ATOMIC_RELAXED, __HIP_MEMORY_SCOPE_AGENT);
                const float r = __builtin_amdgcn_rsqf(ssr * (1.0f / DM) + EPS);
#pragma unroll
                for (int bj = 0; bj < 2; ++bj)
#pragma unroll
                    for (int n = 0; n < 2; ++n) *(f32x4*)(out + (size_t)row * DM + col0 + bj * 128 + n * 16) = acc[ai][bj][m][n] * r * gv[bj][n];
            }
    }
};

struct EpiOut {
    static constexpr bool PERM = false;
    const float* x; float* out; float* rowss;
    __device__ __forceinline__ void operator()(const f32x4 (&acc)[2][2][4][2], const pg8::Unit& u, int wr, int wc, int fr, int fq) const {
        const int rowb = u.pm * 256 + wr * 64 + fr, col0 = u.pn * 256 + wc * 32 + 4 * fq;
#pragma unroll
        for (int ai = 0; ai < 2; ++ai)
#pragma unroll
            for (int m = 0; m < 4; ++m) {
                const int row = rowb + ai * 128 + m * 16; float ss = 0.f;
#pragma unroll
                for (int bj = 0; bj < 2; ++bj)
#pragma unroll
                    for (int n = 0; n < 2; ++n) {
                        const size_t off = (size_t)row * DM + col0 + bj * 128 + n * 16;
                        const f32x4 y = *(const f32x4*)(x + off) + acc[ai][bj][m][n];
                        *(f32x4*)(out + off) = y; ss += (y[0] * y[0] + y[1] * y[1]) + (y[2] * y[2] + y[3] * y[3]);
                    }
                ss += __shfl_xor(ss, 16); ss += __shfl_xor(ss, 32);
                if (fq == 0) atomicAdd(rowss + row, ss);
            }
    }
};

__device__ __forceinline__ int src_col(int np) {
    if (np < 4096) return np;
    if (np < 7680) return np + 16;
    if (np < 7744) return 7696 + (np - 7680);
    if (np < 7752) return 4096 + (np - 7744);
    if (np < 7760) return 4104 + (np - 7752);
    if (np < 7776) return np;
    return -1;
}
__device__ __forceinline__ void phase0(const Params& p, unsigned char* smem) {
    const int tid = opaque_tid(), wid = tid >> 6, lane = tid & 63;
    const int gw = blockIdx.x * 8 + wid, nw = gridDim.x * 8;
    h16* H = (h16*)(p.ws + OFF_H);
    for (int row = 2 * gw; row < BT; row += 2 * nw) {
        const f32x4* xr0 = (const f32x4*)(p.x + (size_t)row * DM); const f32x4* xr1 = xr0 + DM / 4;
        f32x4 v0[8], v1[8]; float s0 = 0.f, s1 = 0.f;
#pragma unroll
        for (int i = 0; i < 8; ++i) { v0[i] = xr0[lane + 64 * i]; v1[i] = xr1[lane + 64 * i]; }
#pragma unroll
        for (int i = 0; i < 8; ++i) { s0 += (v0[i][0] * v0[i][0] + v0[i][1] * v0[i][1]) + (v0[i][2] * v0[i][2] + v0[i][3] * v0[i][3]); s1 += (v1[i][0] * v1[i][0] + v1[i][1] * v1[i][1]) + (v1[i][2] * v1[i][2] + v1[i][3] * v1[i][3]); }
        s0 = wave_sum(s0); s1 = wave_sum(s1);
        const float r0 = __builtin_amdgcn_rsqf(s0 * (1.0f / DM) + EPS), r1 = __builtin_amdgcn_rsqf(s1 * (1.0f / DM) + EPS);
#pragma unroll
        for (int i = 0; i < 8; ++i) { const f32x4 g = ((const f32x4*)p.attn_g)[lane + 64 * i]; h16x4 o0, o1;
#pragma unroll
            for (int j = 0; j < 4; ++j) { o0[j] = (h16)(v0[i][j] * r0 * g[j]); o1[j] = (h16)(v1[i][j] * r1 * g[j]); }
            *(h16x4*)(H + (size_t)row * DM + 4 * (lane + 64 * i)) = o0; *(h16x4*)(H + (size_t)(row + 1) * DM + 4 * (lane + 64 * i)) = o1; }
    }
    {
        float* tiles = (float*)smem;
        h16* Wt = (h16*)(p.ws + OFF_WT); h16* WoT = (h16*)(p.ws + OFF_WOT);
        constexpr int NT1 = 124 * 32, NTT = NT1 + 32 * 32;
        const int nl_r = tid & 63, kl_r = tid >> 6, nl_w = tid >> 3, kc_w = tid & 7;
        float va[8], vb[8];
#define P0_LOAD(tI, v) do { if ((tI) < NT1) { const int n0_ = ((tI) / 32) * 64, k0_ = ((tI) % 32) * 64; const int src_ = src_col(n0_ + nl_r); \
            _Pragma("unroll") for (int i = 0; i < 8; ++i) v[i] = src_ >= 0 ? p.w_in[(size_t)(k0_ + kl_r + 8 * i) * IN_COLS + src_] : 0.f; } \
          else { const int t2_ = (tI) - NT1; const int n0_ = (t2_ / 32) * 64, k0_ = (t2_ % 32) * 64; \
            _Pragma("unroll") for (int i = 0; i < 8; ++i) v[i] = p.w_out[(size_t)(k0_ + kl_r + 8 * i) * DM + n0_ + nl_r]; } } while (0)
#define P0_PUT(buf, v) do { float* t_ = tiles + (buf) * (64 * 65); _Pragma("unroll") for (int i = 0; i < 8; ++i) t_[(kl_r + 8 * i) * 65 + nl_r] = v[i]; } while (0)
#define P0_STORE(buf, tI) do { const float* t_ = tiles + (buf) * (64 * 65); h16x8 o_; _Pragma("unroll") for (int j = 0; j < 8; ++j) o_[j] = (h16)t_[(8 * kc_w + j) * 65 + nl_w]; \
          if ((tI) < NT1) { const int n0_ = ((tI) / 32) * 64, k0_ = ((tI) % 32) * 64; *(h16x8*)(Wt + (size_t)(n0_ + nl_w) * 2048 + k0_ + 8 * kc_w) = o_; } \
          else { const int t2_ = (tI) - NT1; const int n0_ = (t2_ / 32) * 64, k0_ = (t2_ % 32) * 64; *(h16x8*)(WoT + (size_t)(n0_ + nl_w) * 2048 + k0_ + 8 * kc_w) = o_; } } while (0)
        int tI = blockIdx.x; int buf = 0;
        __syncthreads();
        if (tI < NTT) { P0_LOAD(tI, va); P0_PUT(0, va); }
        while (tI < NTT) {
            const int tn = tI + gridDim.x;
            if (tn < NTT) P0_LOAD(tn, vb);
            __syncthreads();
            P0_STORE(buf, tI);
            if (tn < NTT) P0_PUT(buf ^ 1, vb);
            buf ^= 1; tI = tn;
        }
#undef P0_LOAD
#undef P0_PUT
#undef P0_STORE
    }
    float* cosT = (float*)(p.ws + OFF_COS); float* sinT = (float*)(p.ws + OFF_SIN);
    for (int i = blockIdx.x * 512 + tid; i < BT * 24; i += gridDim.x * 512) {
        const int row = i / 24, j = i % 24;
        const float ex = (j < 16) ? (float)j * (2.0f / 32.0f) : (float)(j - 16) * (2.0f / 16.0f);
        const float inv = powf(500000.0f, -ex);
        const float ang = (float)p.pos[row] * inv;
        cosT[i] = cosf(ang); sinT[i] = sinf(ang);
    }
}

__device__ __forceinline__ h16x8 pack8(const f32x4 a, const f32x4 c) { h16x8 o; o[0] = (h16)a[0]; o[1] = (h16)a[1]; o[2] = (h16)a[2]; o[3] = (h16)a[3]; o[4] = (h16)c[0]; o[5] = (h16)c[1]; o[6] = (h16)c[2]; o[7] = (h16)c[3]; return o; }
typedef short v4s_t __attribute__((__vector_size__(4 * sizeof(short))));
__device__ __forceinline__ h16x4 lds_tr16(const LAS unsigned char* a) { const v4s_t v = __builtin_amdgcn_ds_read_tr16_b64_v4i16((LAS v4s_t*)a); return __builtin_bit_cast(h16x4, v); }
constexpr int REC_BYTES = 74752, REC_WF = 0, REC_QF = 16384, REC_AF = 32768, REC_KTF = 40960, REC_VEC = 57344, REC_UF = 58368, REC_DMA = 58368;
constexpr int HB_BYTES = 69632;

__device__ __forceinline__ void gdn_prep_pair(const Params& p, unsigned char* smem, int pair) {
    const int tid = opaque_tid(), wid = __builtin_amdgcn_readfirstlane(tid >> 6), lane = tid & 63, hb = wid >> 2, w4 = wid & 3, tl = tid & 255;
    const int tk = 2 * pair + hb; const int b = tk >> 9, h = (tk >> 6) & 7, n = tk & 63; const int t0 = n * 64;
    unsigned char* base = smem + hb * HB_BYTES;
    h16* Kn = (h16*)base; h16* Qn = Kn + 64 * 136; h16* Vh = Qn + 64 * 136; float* L = (float*)(Vh + 64 * 136); float* vec = L + 4096;
    unsigned char* rec = p.ws + OFF_REC + (size_t)tk * REC_BYTES;
    const h16* qkvr = (const h16*)(p.ws + OFF_QKVR);
    __syncthreads();
    {
        const int cg = tl & 15, rg = tl >> 4;
        h16x8 raw[3][7];
#pragma unroll
        for (int ti = 0; ti < 3; ++ti)
#pragma unroll
            for (int r = 0; r < 7; ++r) {
                const int trow = t0 + 4 * rg - 3 + r;
                if (trow >= 0) raw[ti][r] = *(const h16x8*)(qkvr + ((size_t)b * NT + trow) * 3072 + ti * 1024 + h * 128 + 8 * cg);
                else { for (int j = 0; j < 8; ++j) raw[ti][r][j] = (h16)0.f; }
            }
#pragma unroll
        for (int ti = 0; ti < 3; ++ti) {
            const int chan = ti * 1024 + h * 128 + 8 * cg;
            float xr[7][8];
#pragma unroll
            for (int r = 0; r < 7; ++r)
#pragma unroll
                for (int j = 0; j < 8; ++j) xr[r][j] = (float)raw[ti][r][j];
            float wv[4][8];
#pragma unroll
            for (int tp = 0; tp < 4; ++tp) { const f32x4 a = *(const f32x4*)(p.conv_w + (size_t)tp * 3072 + chan), c = *(const f32x4*)(p.conv_w + (size_t)tp * 3072 + chan + 4);
#pragma unroll
                for (int j = 0; j < 4; ++j) { wv[tp][j] = a[j]; wv[tp][4 + j] = c[j]; } }
            h16* dst = (ti == 0) ? Qn : (ti == 1 ? Kn : Vh);
#pragma unroll
            for (int r = 0; r < 4; ++r) {
                float y[8]; float ss = 0.f;
#pragma unroll
                for (int j = 0; j < 8; ++j) { float a = wv[0][j] * xr[r][j] + wv[1][j] * xr[r + 1][j] + wv[2][j] * xr[r + 2][j] + wv[3][j] * xr[r + 3][j]; a = silu_f(a); y[j] = a; ss += a * a; }
                float sc = 1.f;
                if (ti < 2) { ss += __shfl_xor(ss, 1); ss += __shfl_xor(ss, 2); ss += __shfl_xor(ss, 4); ss += __shfl_xor(ss, 8); sc = (ti == 0 ? 0.08838834764831845f : 1.0f) * __builtin_amdgcn_rsqf(ss + EPS); }
                h16x8 o;
#pragma unroll
                for (int j = 0; j < 8; ++j) o[j] = (h16)(y[j] * sc);
                *(h16x8*)(dst + (4 * rg + r) * 136 + 8 * cg) = o;
            }
        }
    }
    if (tl < 64) {
        const float* gb = (const float*)(p.ws + OFF_GB) + ((size_t)b * NT + t0 + tl) * 16;
        const float g = gb[h], be = gb[8 + h];
        float gc = g;
#pragma unroll
        for (int o = 1; o < 64; o <<= 1) { const float tt = __shfl_up(gc, o); if (lane >= o) gc += tt; }
        const float gl = __shfl(gc, 63);
        vec[tl] = g; vec[64 + tl] = be; vec[128 + tl] = gc; vec[192 + tl] = __expf(gc);
        float* rv = (float*)(rec + REC_VEC);
        rv[tl] = __expf(gc); rv[64 + tl] = __expf(gl - gc); if (tl == 0) rv[128] = __expf(gl);
    }
    __syncthreads();
    {
        const int rt = w4, fr = lane & 15, kg = lane >> 4;
        h16x8 Ak[4], Aq[4];
#pragma unroll
        for (int s = 0; s < 4; ++s) { Ak[s] = *(const h16x8*)(Kn + (16 * rt + fr) * 136 + 32 * s + 8 * kg); Aq[s] = *(const h16x8*)(Qn + (16 * rt + fr) * 136 + 32 * s + 8 * kg); }
        h16* AF = (h16*)(rec + REC_AF);
#pragma unroll
        for (int ct = 0; ct < 4; ++ct) {
            f32x4 kk = (f32x4){0.f, 0.f, 0.f, 0.f}, qk = (f32x4){0.f, 0.f, 0.f, 0.f};
#pragma unroll
            for (int s = 0; s < 4; ++s) { const h16x8 Bk = *(const h16x8*)(Kn + (16 * ct + fr) * 136 + 32 * s + 8 * kg);
                kk = __builtin_amdgcn_mfma_f32_16x16x32_f16(Ak[s], Bk, kk, 0, 0, 0); qk = __builtin_amdgcn_mfma_f32_16x16x32_f16(Aq[s], Bk, qk, 0, 0, 0); }
            const int j = 16 * ct + fr; const float gcj = vec[128 + j];
#pragma unroll
            for (int rgi = 0; rgi < 4; ++rgi) {
                const int i = 16 * rt + 4 * kg + rgi;
                const float dec = (i >= j) ? __expf(vec[128 + i] - gcj) : 0.f;
                L[i * 64 + j] = (i > j) ? vec[64 + i] * kk[rgi] * dec : 0.f;
                const int sp = ct >> 1, kgp = fr >> 2, j8 = (ct & 1) * 4 + (fr & 3), lanep = 16 * kgp + 4 * kg + rgi;
                AF[((rt * 2 + sp) * 64 + lanep) * 8 + j8] = (h16)(qk[rgi] * dec);
            }
        }
    }
    __syncthreads();
    h16* Tw = (h16*)L; h16* Tu = Tw + 4096;
    if (w4 == 0) {
        float X[64];
#pragma unroll
        for (int i = 0; i < 64; ++i) X[i] = 0.f;
        f32x4 Ln[16]; float rn = (lane == 0) ? 1.f : 0.f;
#pragma unroll
        for (int i = 0; i < 64; ++i) {
            f32x4 Lc[16]; const float rc = rn;
#pragma unroll
            for (int jj = 0; jj < (i + 3) / 4; ++jj) Lc[jj] = Ln[jj];
            if (i + 1 < 64) {
#pragma unroll
                for (int jj = 0; jj < (i + 4) / 4; ++jj) Ln[jj] = *(const f32x4*)(L + (i + 1) * 64 + 4 * jj);
                rn = (lane == i + 1) ? 1.f : 0.f;
            }
            float a0 = rc, a1 = 0.f, a2 = 0.f, a3 = 0.f;
#pragma unroll
            for (int jj = 0; jj < (i + 3) / 4; ++jj) { a0 -= Lc[jj][0] * X[4 * jj]; a1 -= Lc[jj][1] * X[4 * jj + 1]; a2 -= Lc[jj][2] * X[4 * jj + 2]; a3 -= Lc[jj][3] * X[4 * jj + 3]; }
            float acc = (a0 + a1) + (a2 + a3);
            asm volatile("" : "+v"(acc) :: "memory");
            X[i] = acc;
        }
        const float bu = vec[64 + lane], bw = bu * vec[192 + lane];
#pragma unroll
        for (int i = 0; i < 64; ++i) { const int pos = i * 64 + ((((lane >> 3) ^ (i & 7)) << 3) | (lane & 7)); Tw[pos] = (h16)(X[i] * bw); Tu[pos] = (h16)(X[i] * bu); }
    } else {
        const int t3 = tl - 64;
        h16* QF = (h16*)(rec + REC_QF);
        for (int f = t3; f < 1024; f += 192) { const int lanep = f & 63, s = (f >> 6) & 3, rt = f >> 8; const int row = 16 * rt + (lanep & 15), kgp = lanep >> 4;
            const h16x4 a = *(const h16x4*)(Qn + row * 136 + 32 * s + 4 * kgp), c = *(const h16x4*)(Qn + row * 136 + 32 * s + 16 + 4 * kgp);
            h16x8 o; o[0] = a[0]; o[1] = a[1]; o[2] = a[2]; o[3] = a[3]; o[4] = c[0]; o[5] = c[1]; o[6] = c[2]; o[7] = c[3];
            *(h16x8*)(QF + (size_t)f * 8) = o; }
        h16* KTF = (h16*)(rec + REC_KTF);
        for (int f = t3; f < 1024; f += 192) { const int lanep = f & 63, sp = (f >> 6) & 1, rt = f >> 7; const int d = 16 * rt + (lanep & 15), kgp = lanep >> 4;
            h16x8 o;
#pragma unroll
            for (int j8 = 0; j8 < 8; ++j8) { const int c = 32 * sp + (j8 < 4 ? 4 * kgp + j8 : 16 + 4 * kgp + (j8 - 4)); o[j8] = Kn[c * 136 + d]; }
            *(h16x8*)(KTF + (size_t)f * 8) = o; }
    }
    __syncthreads();
    {
        const int rt = w4, fr = lane & 15, kg = lane >> 4, q4 = fr >> 2, pp = fr & 3;
        const LAS unsigned char* Knl = (const LAS unsigned char*)Kn; const LAS unsigned char* Vl = (const LAS unsigned char*)Vh;
        const int trow = 16 * rt + fr;
        h16x8 Tuf[2], Twf[2];
#pragma unroll
        for (int s = 0; s < 2; ++s) { const int off = trow * 64 + ((((4 * s + kg) ^ (trow & 7))) << 3); Tuf[s] = *(const h16x8*)(Tu + off); Twf[s] = *(const h16x8*)(Tw + off); }
        h16* UF = (h16*)(rec + REC_UF);
#pragma unroll
        for (int dvb = 0; dvb < 8; ++dvb) {
            f32x4 acc = (f32x4){0.f, 0.f, 0.f, 0.f};
#pragma unroll
            for (int s = 0; s < 2; ++s) { const LAS unsigned char* a0 = Vl + ((32 * s + 8 * kg + q4) * 136 + 16 * dvb + 4 * pp) * 2;
                const h16x4 lo = lds_tr16(a0), hi4 = lds_tr16(a0 + 4 * 136 * 2);
                h16x8 Bv; Bv[0] = lo[0]; Bv[1] = lo[1]; Bv[2] = lo[2]; Bv[3] = lo[3]; Bv[4] = hi4[0]; Bv[5] = hi4[1]; Bv[6] = hi4[2]; Bv[7] = hi4[3];
                acc = __builtin_amdgcn_mfma_f32_16x16x32_f16(Tuf[s], Bv, acc, 0, 0, 0); }
            h16x4 o; o[0] = (h16)acc[0]; o[1] = (h16)acc[1]; o[2] = (h16)acc[2]; o[3] = (h16)acc[3];
            *(h16x4*)(UF + (size_t)((dvb * 4 + rt) * 64 + lane) * 4) = o;
        }
        h16* WF = (h16*)(rec + REC_WF);
#pragma unroll
        for (int so = 0; so < 4; ++so) {
            f32x4 c0 = (f32x4){0.f, 0.f, 0.f, 0.f}, c1 = (f32x4){0.f, 0.f, 0.f, 0.f};
#pragma unroll
            for (int s = 0; s < 2; ++s) {
                const LAS unsigned char* a0 = Knl + ((32 * s + 8 * kg + q4) * 136 + 16 * (2 * so) + 4 * pp) * 2;
                const h16x4 l0 = lds_tr16(a0), h0 = lds_tr16(a0 + 4 * 136 * 2), l1 = lds_tr16(a0 + 32), h1 = lds_tr16(a0 + 32 + 4 * 136 * 2);
                h16x8 A0, A1; A0[0] = l0[0]; A0[1] = l0[1]; A0[2] = l0[2]; A0[3] = l0[3]; A0[4] = h0[0]; A0[5] = h0[1]; A0[6] = h0[2]; A0[7] = h0[3];
                A1[0] = l1[0]; A1[1] = l1[1]; A1[2] = l1[2]; A1[3] = l1[3]; A1[4] = h1[0]; A1[5] = h1[1]; A1[6] = h1[2]; A1[7] = h1[3];
                c0 = __builtin_amdgcn_mfma_f32_16x16x32_f16(A0, Twf[s], c0, 0, 0, 0); c1 = __builtin_amdgcn_mfma_f32_16x16x32_f16(A1, Twf[s], c1, 0, 0, 0);
            }
            *(h16x8*)(WF + (size_t)((rt * 4 + so) * 64 + lane) * 8) = pack8(-c0, -c1);
        }
    }
}

__device__ __forceinline__ void gdn_scan_task(const Params& p, unsigned char* smem, int bh) {
    const int tid = opaque_tid(), wid = __builtin_amdgcn_readfirstlane(tid >> 6), lane = tid & 63, kg = lane >> 4, fr = lane & 15;
    const int b = bh >> 3, h = bh & 7;
    LAS unsigned char* lds = (LAS unsigned char*)smem;
    const unsigned char* rec0 = p.ws + OFF_REC + (size_t)(bh * 64) * REC_BYTES;
    h16* OB = (h16*)(smem + 2 * REC_DMA);
    const h16* gz = (const h16*)(p.ws + OFF_GZ); h16* omix = (h16*)(p.ws + OFF_OMIX);
    f32x4 Sacc[8];
#pragma unroll
    for (int t = 0; t < 8; ++t) Sacc[t] = (f32x4){0.f, 0.f, 0.f, 0.f};
    h16x4 Uc[4], Un[4];
    __syncthreads();
#define GDN_GLDS(recp, bufi) do { _Pragma("unroll") for (int _i = 0; _i < 7; ++_i) \
        __builtin_amdgcn_global_load_lds((const unsigned*)((recp) + (size_t)(_i * 512 + tid) * 16), (LAS unsigned*)(lds + (bufi) * REC_DMA + (_i * 512 + wid * 64) * 16), 16, 0, 0); \
        if (wid == 0) __builtin_amdgcn_global_load_lds((const unsigned*)((recp) + (size_t)(7 * 512 + tid) * 16), (LAS unsigned*)(lds + (bufi) * REC_DMA + (7 * 512) * 16), 16, 0, 0); } while (0)
#define GDN_LDREG(recp, U_) do { _Pragma("unroll") for (int rt = 0; rt < 4; ++rt) U_[rt] = *(const h16x4*)((recp) + REC_UF + (size_t)((wid * 4 + rt) * 64 + lane) * 8); } while (0)
#define GDN_LDGZ(dst, chunk) do { const h16* gp_ = gz + ((size_t)b * NT + 64 * (chunk) + prow) * 1024 + h * 128 + 16 * pseg; dst[0] = *(const h16x8*)gp_; dst[1] = *(const h16x8*)(gp_ + 8); } while (0)
#define GDN_POST(chunk, gzv) do { const h16* Ob = OB + ((chunk) & 1) * 8192 + prow * 128 + 16 * pseg; const h16x8 a0 = *(const h16x8*)Ob, a1 = *(const h16x8*)(Ob + 8); \
        float ngv[16]; _Pragma("unroll") for (int j = 0; j < 4; ++j) { const f32x4 t4 = *(const f32x4*)(ngl + 16 * pseg + 4 * j); ngv[4 * j] = t4[0]; ngv[4 * j + 1] = t4[1]; ngv[4 * j + 2] = t4[2]; ngv[4 * j + 3] = t4[3]; } \
        float ss = 0.f; _Pragma("unroll") for (int j = 0; j < 8; ++j) { const float u0 = (float)a0[j], u1 = (float)a1[j]; ss += u0 * u0 + u1 * u1; } \
        ss += __shfl_xor(ss, 1); ss += __shfl_xor(ss, 2); ss += __shfl_xor(ss, 4); const float r = __builtin_amdgcn_rsqf(ss * (1.0f / 128.0f) + EPS); \
        h16x8 o0, o1; _Pragma("unroll") for (int j = 0; j < 8; ++j) { o0[j] = (h16)((float)a0[j] * r * ngv[j] * (float)gzv[0][j]); o1[j] = (h16)((float)a1[j] * r * ngv[8 + j] * (float)gzv[1][j]); } \
        h16* op_ = omix + ((size_t)b * NT + 64 * (chunk) + prow) * 2048 + h * 128 + 16 * pseg; *(h16x8*)op_ = o0; *(h16x8*)(op_ + 8) = o1; } while (0)
#define GDN_RD8(X, off0) do { _Pragma("unroll") for (int _j = 0; _j < 8; ++_j) X[_j] = *(const LAS h16x8*)(bufp + (off0) + (_j * 64 + lane) * 16); } while (0)
#define GDN_SB __builtin_amdgcn_sched_barrier(0)
    h16x8 gzp[2], gzn[2];
    const int prow = tid >> 3, pseg = tid & 7;
    float* ngl = (float*)(smem + 2 * REC_DMA + 32768);
    if (tid < 128) ngl[tid] = p.gdn_norm_g[tid];
    GDN_GLDS(rec0, 0);
    GDN_LDREG(rec0, Uc);
    asm volatile("s_waitcnt vmcnt(0)" ::: "memory");
    __syncthreads();
    for (int n = 0; n < 64; ++n) {
        const unsigned char* recn = rec0 + (size_t)(n + 1) * REC_BYTES;
        if (n + 1 < 64) { GDN_GLDS(recn, (n + 1) & 1); GDN_LDREG(recn, Un); }
        GDN_LDGZ(gzn, n);
        if (n > 0) GDN_POST(n - 1, gzp);
        const LAS unsigned char* bufp = lds + (n & 1) * REC_DMA;
        h16x8 X[8], Y[8];
        GDN_RD8(X, REC_WF);
        h16x8 SB[4];
#pragma unroll
        for (int s = 0; s < 4; ++s) SB[s] = pack8(Sacc[2 * s], Sacc[2 * s + 1]);
        f32x4 vacc[4], oacc[4];
#pragma unroll
        for (int rt = 0; rt < 4; ++rt) { vacc[rt] = (f32x4){(float)Uc[rt][0], (float)Uc[rt][1], (float)Uc[rt][2], (float)Uc[rt][3]}; oacc[rt] = (f32x4){0.f, 0.f, 0.f, 0.f}; }
        GDN_SB;
        GDN_RD8(Y, REC_WF + 8192);
#pragma unroll
        for (int j = 0; j < 8; ++j) vacc[j >> 2] = __builtin_amdgcn_mfma_f32_16x16x32_f16(X[j], SB[j & 3], vacc[j >> 2], 0, 0, 0);
        GDN_SB;
        GDN_RD8(X, REC_QF);
#pragma unroll
        for (int j = 0; j < 8; ++j) vacc[2 + (j >> 2)] = __builtin_amdgcn_mfma_f32_16x16x32_f16(Y[j], SB[j & 3], vacc[2 + (j >> 2)], 0, 0, 0);
        GDN_SB;
        GDN_RD8(Y, REC_QF + 8192);
        f32x4 ekv[4], egv[4];
#pragma unroll
        for (int rt = 0; rt < 4; ++rt) { ekv[rt] = *(const LAS f32x4*)(bufp + REC_VEC + 256 + (16 * rt + 4 * kg) * 4); egv[rt] = *(const LAS f32x4*)(bufp + REC_VEC + (16 * rt + 4 * kg) * 4); }
        const float eglc = *(const LAS float*)(bufp + REC_VEC + 512);
#pragma unroll
        for (int j = 0; j < 8; ++j) oacc[j >> 2] = __builtin_amdgcn_mfma_f32_16x16x32_f16(X[j], SB[j & 3], oacc[j >> 2], 0, 0, 0);
        GDN_SB;
        GDN_RD8(X, REC_KTF);
        h16x8 VB[2], VKB[2];
#pragma unroll
        for (int sp = 0; sp < 2; ++sp) { VB[sp] = pack8(vacc[2 * sp], vacc[2 * sp + 1]); VKB[sp] = pack8(vacc[2 * sp] * ekv[2 * sp], vacc[2 * sp + 1] * ekv[2 * sp + 1]); }
#pragma unroll
        for (int j = 0; j < 8; ++j) oacc[2 + (j >> 2)] = __builtin_amdgcn_mfma_f32_16x16x32_f16(Y[j], SB[j & 3], oacc[2 + (j >> 2)], 0, 0, 0);
        GDN_SB;
        GDN_RD8(Y, REC_KTF + 8192);
#pragma unroll
        for (int t = 0; t < 8; ++t) Sacc[t] = Sacc[t] * eglc;
#pragma unroll
        for (int j = 0; j < 8; ++j) Sacc[j >> 1] = __builtin_amdgcn_mfma_f32_16x16x32_f16(X[j], VKB[j & 1], Sacc[j >> 1], 0, 0, 0);
        GDN_SB;
        GDN_RD8(X, REC_AF);
#pragma unroll
        for (int rt = 0; rt < 4; ++rt) oacc[rt] = oacc[rt] * egv[rt];
#pragma unroll
        for (int j = 0; j < 8; ++j) Sacc[4 + (j >> 1)] = __builtin_amdgcn_mfma_f32_16x16x32_f16(Y[j], VKB[j & 1], Sacc[4 + (j >> 1)], 0, 0, 0);
        GDN_SB;
#pragma unroll
        for (int j = 0; j < 8; ++j) oacc[j >> 1] = __builtin_amdgcn_mfma_f32_16x16x32_f16(X[j], VB[j & 1], oacc[j >> 1], 0, 0, 0);
        { h16* Ob = OB + (n & 1) * 8192;
#pragma unroll
          for (int rt = 0; rt < 4; ++rt)
#pragma unroll
              for (int rgi = 0; rgi < 4; ++rgi) Ob[(16 * rt + 4 * kg + rgi) * 128 + 16 * wid + fr] = (h16)oacc[rt][rgi]; }
        asm volatile("s_waitcnt vmcnt(0)" ::: "memory");
        __syncthreads();
#pragma unroll
        for (int rt = 0; rt < 4; ++rt) Uc[rt] = Un[rt];
        gzp[0] = gzn[0]; gzp[1] = gzn[1];
    }
    GDN_POST(63, gzp);
#undef GDN_LDGZ
#undef GDN_POST
#undef GDN_RD8
#undef GDN_SB
#undef GDN_GLDS
#undef GDN_LDREG
}

__device__ __forceinline__ unsigned f2key(float x) { const unsigned u = __float_as_uint(x); return (u & 0x80000000u) ? ~u : (u | 0x80000000u); }
typedef float f32x16 __attribute__((ext_vector_type(16)));
__device__ __forceinline__ float wave_min(float v) {
#pragma unroll
    for (int o = 1; o < 64; o <<= 1) v = fminf(v, __shfl_xor(v, o));
    return v;
}
__device__ __forceinline__ unsigned lane_below(unsigned long long m) { return __builtin_amdgcn_mbcnt_hi((unsigned)(m >> 32), __builtin_amdgcn_mbcnt_lo((unsigned)m, 0u)); }
__device__ __forceinline__ void idx8_task(const Params& p, unsigned char* smem, int b, int qb) {
    const int tid = opaque_tid(), wid = __builtin_amdgcn_readfirstlane(tid >> 6), lane = tid & 63;
    const int t0 = qb * 8;
    unsigned short* selg = (unsigned short*)(p.ws + OFF_SEL) + ((size_t)b * NT + t0) * 256;
    if (t0 + 8 <= 256) {
        for (int i = tid; i < 8 * 256; i += 512) { const int q = i >> 8, k = i & 255; selg[i] = (unsigned short)(k <= t0 + q ? k : 0); }
        return;
    }
    float* sc = (float*)smem;
    ACC_T0();
    unsigned* hist = (unsigned*)(smem + 131072 + wid * 2560);
    unsigned* cand = hist + 256;
    __syncthreads();
    {
        const int n8 = t0 + 8;
        const int ntile = (n8 + 31) >> 5, ntile_pad = ((n8 + 255) >> 8) << 3;
        const h16* iq = (const h16*)(p.ws + OFF_IQ) + ((size_t)b * NT + t0) * 1024;
        const float* iw = (const float*)(p.ws + OFF_IW) + ((size_t)b * NT + t0) * 16;
        const h16* ik = (const h16*)(p.ws + OFF_IK) + (size_t)b * NT * 64;
        const int r = lane & 31, kh = lane >> 5, qq = (r >> 2) & 1, hh = (r & 3) + 4 * (r >> 3);
        h16x8 Af[4][4]; h16x2 Wp[4][8];
#pragma unroll
        for (int a = 0; a < 4; ++a) {
#pragma unroll
            for (int s = 0; s < 4; ++s) Af[a][s] = *(const h16x8*)(iq + (size_t)(2 * a + qq) * 1024 + hh * 64 + 16 * s + 8 * kh);
#pragma unroll
            for (int c = 0; c < 4; ++c) { const f32x4 w4 = *(const f32x4*)(iw + (size_t)(2 * a + kh) * 16 + 4 * c);
                Wp[a][2 * c] = (h16x2){(h16)w4[0], (h16)w4[1]}; Wp[a][2 * c + 1] = (h16x2){(h16)w4[2], (h16)w4[3]}; }
        }
#define IDX_LOADB(Bx, ti) do { if ((ti) < ntile) { _Pragma("unroll") for (int s = 0; s < 4; ++s) Bx[s] = *(const h16x8*)(ik + (size_t)(32 * (ti) + r) * 64 + 16 * s + 8 * kh); } } while (0)
#define IDX_COMP(Bx, ti) do { if ((ti) < ntile) { const int key = 32 * (ti) + r; f32x16 accs[4]; \
            _Pragma("unroll") for (int a = 0; a < 4; ++a) { _Pragma("unroll") for (int e = 0; e < 16; ++e) accs[a][e] = 0.f; \
                _Pragma("unroll") for (int s = 0; s < 4; ++s) accs[a] = __builtin_amdgcn_mfma_f32_32x32x16_f16(Af[a][s], Bx[s], accs[a], 0, 0, 0); } \
            __builtin_amdgcn_sched_barrier(0); \
            _Pragma("unroll") for (int a = 0; a < 4; ++a) { \
                float s0 = 0.f, s1 = 0.f; _Pragma("unroll") for (int e = 0; e < 8; e += 2) { h16x2 rp = (h16x2){(h16)accs[a][2 * e], (h16)accs[a][2 * e + 1]}; rp = __builtin_elementwise_max(rp, (h16x2){(h16)0.f, (h16)0.f}); s0 = __builtin_amdgcn_fdot2(rp, Wp[a][e], s0, false); \
                    h16x2 rq = (h16x2){(h16)accs[a][2 * e + 2], (h16)accs[a][2 * e + 3]}; rq = __builtin_elementwise_max(rq, (h16x2){(h16)0.f, (h16)0.f}); s1 = __builtin_amdgcn_fdot2(rq, Wp[a][e + 1], s1, false); } \
                const int q = 2 * a + kh; sc[q * 4096 + key] = (key > t0 + q) ? -INFINITY : (s0 + s1); } } } while (0)
        {
            h16x8 B0[4], B1[4], B2[4];
            IDX_LOADB(B0, wid); IDX_LOADB(B1, wid + 8);
            for (int i = wid; i < ntile; i += 24) {
                IDX_LOADB(B2, i + 16); IDX_COMP(B0, i);
                IDX_LOADB(B0, i + 24); IDX_COMP(B1, i + 8);
                IDX_LOADB(B1, i + 32); IDX_COMP(B2, i + 16);
            }
            for (int i = ntile + wid; i < ntile_pad; i += 8) {
#pragma unroll
                for (int a = 0; a < 4; ++a) sc[(2 * a + kh) * 4096 + 32 * i + r] = -INFINITY;
            }
        }
#undef IDX_LOADB
#undef IDX_COMP
    }
    __syncthreads();
    ACC_ADD(1);
    {
        const int tq = t0 + wid, n = tq + 1;
        const float* row = sc + wid * 4096;
        const int ng = (n + 255) >> 8;
        f32x4 x[16];
#pragma unroll
        for (int g = 0; g < 16; ++g) { if (g < ng) x[g] = *(const f32x4*)(row + 256 * g + 4 * lane); else x[g] = (f32x4){-INFINITY, -INFINITY, -INFINITY, -INFINITY}; }
        float hi = -INFINITY, lo = INFINITY;
#pragma unroll
        for (int g = 0; g < 16; ++g)
#pragma unroll
            for (int c = 0; c < 4; ++c) { const float v = x[g][c]; hi = fmaxf(hi, v); lo = fminf(lo, v == -INFINITY ? INFINITY : v); }
        hi = wave_max(hi); lo = wave_min(lo);
        const float scale = (hi > lo) ? 255.99f / (hi - lo) : 0.f; const float off = -lo * scale;
        *(u32x4*)(hist + 4 * lane) = (u32x4){0u, 0u, 0u, 0u};
#pragma unroll
        for (int g = 0; g < 16; ++g) { if (g < ng) {
#pragma unroll
            for (int c = 0; c < 4; ++c) { int bin = (int)fmaf(x[g][c], scale, off); bin = bin < 0 ? 0 : (bin > 255 ? 255 : bin); atomicAdd(&hist[bin], 1u); } } }
        unsigned bstar, need;
        {
            const u32x4 h4 = *(const u32x4*)(hist + 4 * lane); const unsigned s = h4[0] + h4[1] + h4[2] + h4[3];
            unsigned suf = s;
#pragma unroll
            for (int o = 1; o < 64; o <<= 1) { const unsigned tt = __shfl_down(suf, o); if (lane + o < 64) suf += tt; }
            const unsigned above = suf - s;
            const bool mine = (above < 256u && 256u <= suf);
            unsigned cum = above; unsigned bin = 0;
            if (cum + h4[3] >= 256u) bin = 3; else { cum += h4[3]; if (cum + h4[2] >= 256u) bin = 2; else { cum += h4[2]; if (cum + h4[1] >= 256u) bin = 1; else { cum += h4[1]; bin = 0; } } }
            const unsigned long long mm = __ballot(mine);
            const int src = (int)__builtin_ctzll(mm);
            bstar = (unsigned)__shfl((int)(4 * lane + bin), src); need = (unsigned)__shfl((int)(256u - cum), src);
        }
        unsigned short* so = selg + (size_t)wid * 256;
        unsigned short* cidx = (unsigned short*)(cand + 256);
        unsigned m = 0, outb = 0;
#pragma unroll
        for (int g = 0; g < 16; ++g) { if (g < ng) {
#pragma unroll
            for (int c = 0; c < 4; ++c) { int bin = (int)fmaf(x[g][c], scale, off); bin = bin < 0 ? 0 : (bin > 255 ? 255 : bin);
                const bool gt = ((unsigned)bin > bstar), pr = ((unsigned)bin == bstar);
                const unsigned long long mg = __ballot(gt), mk = __ballot(pr);
                if (mg) { const unsigned pos = outb + lane_below(mg); if (gt) so[pos] = (unsigned short)(256 * g + 4 * lane + c); outb += (unsigned)__builtin_popcountll(mg); }
                if (mk) { const unsigned pos = m + lane_below(mk); if (pr && pos < 256u) { cand[pos] = f2key(x[g][c]); cidx[pos] = (unsigned short)(256 * g + 4 * lane + c); } m += (unsigned)__builtin_popcountll(mk); } } } }
        unsigned Kt = 0, rr = need;
        if (m <= 256u) {
            const int nc = (int)((m + 63u) >> 6);
            unsigned cv[4]; unsigned short ci[4];
#pragma unroll
            for (int j = 0; j < 4; ++j) { const bool in = (64 * j + lane < (int)m); cv[j] = in ? cand[64 * j + lane] : 0u; ci[j] = in ? cidx[64 * j + lane] : (unsigned short)0; }
            for (int bit = 31; bit >= 0; --bit) {
                const unsigned test = (Kt | (1u << bit)) >> bit;
                unsigned cnt = (unsigned)__builtin_popcountll(__ballot((cv[0] >> bit) == test));
                if (nc > 1) cnt += (unsigned)__builtin_popcountll(__ballot((cv[1] >> bit) == test));
                if (nc > 2) cnt += (unsigned)__builtin_popcountll(__ballot((cv[2] >> bit) == test));
                if (nc > 3) cnt += (unsigned)__builtin_popcountll(__ballot((cv[3] >> bit) == test));
                if (cnt >= rr) Kt |= (1u << bit); else rr -= cnt;
            }
            unsigned eqb = 0;
#pragma unroll
            for (int j = 0; j < 4; ++j) { if (j < nc) { const bool in = (64 * j + lane < (int)m); const bool gt = in && cv[j] > Kt, eq = in && cv[j] == Kt;
                const unsigned long long me = __ballot(eq); bool take = gt;
                if (me) { const unsigned er = eqb + lane_below(me); take = gt || (eq && er < rr); eqb += (unsigned)__builtin_popcountll(me); }
                const unsigned long long mt = __ballot(take);
                if (mt) { const unsigned pos = outb + lane_below(mt); if (take) so[pos] = ci[j]; outb += (unsigned)__builtin_popcountll(mt); } } }
        } else {
            for (int bit = 31; bit >= 0; --bit) {
                const unsigned test = (Kt | (1u << bit)) >> bit; unsigned cnt = 0;
                for (int idx = lane; idx < ng * 256; idx += 64) { const float v = row[idx]; int bin = (int)fmaf(v, scale, off); bin = bin < 0 ? 0 : (bin > 255 ? 255 : bin);
                    const bool pr = ((unsigned)bin == bstar) && ((f2key(v) >> bit) == test); cnt += (unsigned)__builtin_popcountll(__ballot(pr)); }
                if (cnt >= rr) Kt |= (1u << bit); else rr -= cnt;
            }
            unsigned eqb = 0;
            for (int idx = lane; idx < ng * 256; idx += 64) { const float v = row[idx]; int bin = (int)fmaf(v, scale, off); bin = bin < 0 ? 0 : (bin > 255 ? 255 : bin);
                const unsigned k = f2key(v); const bool inb = ((unsigned)bin == bstar); const bool gt = inb && k > Kt, eq = inb && k == Kt;
                const unsigned long long me = __ballot(eq); bool take = gt;
                if (me) { const unsigned er = eqb + lane_below(me); take = gt || (eq && er < rr); eqb += (unsigned)__builtin_popcountll(me); }
                const unsigned long long mt = __ballot(take);
                if (mt) { const unsigned pos = outb + lane_below(mt); if (take) so[pos] = (unsigned short)idx; outb += (unsigned)__builtin_popcountll(mt); } }
        }
    }
    __syncthreads();
    ACC_ADD(2);
}

typedef unsigned short u16x4 __attribute__((ext_vector_type(4)));
typedef unsigned short u16x8 __attribute__((ext_vector_type(8)));
__device__ __forceinline__ void attn8_task(const Params& p, unsigned char* smem, int part, int o) {
    const int tid = opaque_tid(), wid = __builtin_amdgcn_readfirstlane(tid >> 6), lane = tid & 63, kg = lane >> 4, fr = lane & 15;
    const int b = part >> 1, g = part & 1;
    unsigned char* vl = smem + wid * 17408;
    LAS unsigned char* vll = (LAS unsigned char*)vl;
    const char* akb = (const char*)(p.ws + OFF_AK) + (size_t)b * NT * 256 + g * 128;
    const char* avb = (const char*)(p.ws + OFF_AV) + (size_t)b * NT * 256 + g * 128;
    typedef long i64x2 __attribute__((ext_vector_type(2)));
    constexpr int NQW = 1;
    const int tq0 = 8 * NQW * o + NQW * wid;
    u16x4 kix[4], kixn[4];
#define AT_LOADI(tt, KI) do { const unsigned short* sel_ = (const unsigned short*)(p.ws + OFF_SEL) + ((size_t)b * NT + (tt)) * 256; \
        _Pragma("unroll") for (int c = 0; c < 4; ++c) KI[c] = *(const u16x4*)(sel_ + 64 * c + 4 * fr); } while (0)
    AT_LOADI(tq0, kix);
#pragma unroll 1
    for (int qi = 0; qi < NQW; ++qi) {
    const int t = tq0 + qi; const int bt = b * NT + t; const int nvalid = (t + 1) < 256 ? (t + 1) : 256;
    const unsigned short* sel = (const unsigned short*)(p.ws + OFF_SEL) + (size_t)bt * 256;
    long Qf[4];
    { const char* qp_ = (const char*)(p.ws + OFF_AQ) + (size_t)bt * 1024 + (4 * g + (fr & 3)) * 128 + kg * 32; const i64x2 q0 = *(const i64x2*)qp_, q1 = *(const i64x2*)(qp_ + 16);
      Qf[0] = fr < 4 ? q0[0] : 0l; Qf[1] = fr < 4 ? q0[1] : 0l; Qf[2] = fr < 4 ? q1[0] : 0l; Qf[3] = fr < 4 ? q1[1] : 0l; }
    f32x4 lg[16];
#define AT_LOADK(Kx, c) do { _Pragma("unroll") for (int ii = 0; ii < 4; ++ii) { const char* kp = akb + (unsigned)kix[c][ii] * 256u + 32u * (unsigned)kg; \
        const i64x2 t0 = *(const i64x2*)kp, t1 = *(const i64x2*)(kp + 16); Kx[ii][0] = t0[0]; Kx[ii][1] = t0[1]; Kx[ii][2] = t1[0]; Kx[ii][3] = t1[1]; } } while (0)
#define AT_MMAK(Kx, c) do { _Pragma("unroll") for (int ii = 0; ii < 4; ++ii) { f32x4 a = (f32x4){0.f, 0.f, 0.f, 0.f}; \
        _Pragma("unroll") for (int s = 0; s < 4; ++s) a = __builtin_amdgcn_mfma_f32_16x16x32_fp8_fp8(Kx[ii][s], Qf[s], a, 0, 0, 0); lg[4 * (c) + ii] = a; } } while (0)
#define AT_LOADV(Vx, c) do { const u16x8 i0 = *(const u16x8*)(sel + 64 * (c) + 8 * (lane >> 3)); \
        _Pragma("unroll") for (int it = 0; it < 8; ++it) Vx[it] = *(const u32x4*)(avb + (unsigned)i0[it] * 256u + 16u * (unsigned)(lane & 7)); } while (0)
    u32x4 VA[8], VB[8];
    {
        long K0[4][4], K1[4][4], K2[4][4];
        AT_LOADK(K0, 0); AT_LOADK(K1, 1); AT_LOADK(K2, 2);
        AT_MMAK(K0, 0); AT_LOADK(K0, 3);
        AT_MMAK(K1, 1); AT_LOADV(VA, 0);
        AT_MMAK(K2, 2);
        AT_MMAK(K0, 3);
    }
    float m = -INFINITY;
#pragma unroll
    for (int i = 0; i < 16; ++i)
#pragma unroll
        for (int r = 0; r < 4; ++r) { const int slot = 64 * (i >> 2) + 16 * kg + 4 * r + (i & 3); const float v = (slot < nvalid) ? lg[i][r] * (0.08838834764831845f * 1.4426950408889634f) : -INFINITY; lg[i][r] = v; m = fmaxf(m, v); }
    m = fmaxf(m, __shfl_xor(m, 16)); m = fmaxf(m, __shfl_xor(m, 32));
    float sum = 0.f;
#pragma unroll
    for (int i = 0; i < 16; ++i)
#pragma unroll
        for (int r = 0; r < 4; ++r) { const float e = __builtin_amdgcn_exp2f(lg[i][r] - m); lg[i][r] = e; sum += e; }
    sum += __shfl_xor(sum, 16); sum += __shfl_xor(sum, 32);
    const float inv = __builtin_amdgcn_rcpf(sum);
    long Pf[8];
    { const float pscale = inv * 256.0f;
#pragma unroll
      for (int ip = 0; ip < 8; ++ip) { const f32x4 x0 = lg[2 * ip] * pscale, x1 = lg[2 * ip + 1] * pscale; int w0 = 0, w1 = 0;
          w0 = __builtin_amdgcn_cvt_pk_fp8_f32(x0[0], x0[1], w0, false); w0 = __builtin_amdgcn_cvt_pk_fp8_f32(x0[2], x0[3], w0, true);
          w1 = __builtin_amdgcn_cvt_pk_fp8_f32(x1[0], x1[1], w1, false); w1 = __builtin_amdgcn_cvt_pk_fp8_f32(x1[2], x1[3], w1, true);
          Pf[ip] = (long)(((unsigned long long)(unsigned)w1 << 32) | (unsigned long long)(unsigned)w0); } }
    f32x4 O[8];
#pragma unroll
    for (int ct = 0; ct < 8; ++ct) O[ct] = (f32x4){0.f, 0.f, 0.f, 0.f};
    if (qi < NQW - 1) AT_LOADI(t + 1, kixn);
    const h16x8 gate = *(const h16x8*)((const h16*)(p.ws + OFF_AZ) + (size_t)bt * 1024 + (4 * g) * 128 + 8 * lane);
    const int q4 = fr >> 2, pp = fr & 3;
    typedef int v2i_t __attribute__((__vector_size__(2 * sizeof(int))));
#define AT_STOREV(Vx) do { _Pragma("unroll") for (int it = 0; it < 8; ++it) { const int r = 8 * (lane >> 3) + it; const int fk = ((r >> 2) & 3) | (((r >> 4) & 1) << 2); \
        *(u32x4*)(vl + r * 128 + (((lane & 7) ^ fk) << 4)) = Vx[it]; } } while (0)
#define AT_PV(c) do { _Pragma("unroll") for (int ipl = 0; ipl < 2; ++ipl) { const int qq = fr >> 1; const int r = 16 * kg + 4 * (qq & 3) + 2 * ipl + (qq >> 2); const int fk = ((r >> 2) & 3) | (((r >> 4) & 1) << 2); \
        _Pragma("unroll") for (int ct = 0; ct < 8; ++ct) { const LAS unsigned char* a0 = vll + r * 128 + ((ct ^ fk) << 4) + (fr & 1) * 8; \
            const v2i_t bv = __builtin_amdgcn_ds_read_tr8_b64_v2i32((LAS v2i_t*)a0); \
            O[ct] = __builtin_amdgcn_mfma_f32_16x16x32_fp8_fp8(Pf[2 * (c) + ipl], __builtin_bit_cast(long, bv), O[ct], 0, 0, 0); } } } while (0)
    AT_LOADV(VB, 1); AT_STOREV(VA); AT_PV(0);
    AT_LOADV(VA, 2); AT_STOREV(VB); AT_PV(1);
    AT_LOADV(VB, 3); AT_STOREV(VA); AT_PV(2);
    AT_STOREV(VB); AT_PV(3);
#undef AT_LOADK
#undef AT_MMAK
#undef AT_LOADV
#undef AT_STOREV
#undef AT_PV
    h16* ot = (h16*)vl;
    if (kg == 0) {
#pragma unroll
        for (int ct = 0; ct < 8; ++ct)
#pragma unroll
            for (int r = 0; r < 4; ++r) ot[r * 128 + 16 * ct + fr] = (h16)O[ct][r];
    }
    {
        const h16x8 ov = *(const h16x8*)(ot + 8 * lane);
        h16x8 res;
#pragma unroll
        for (int j = 0; j < 8; ++j) res[j] = (h16)((float)ov[j] * (float)gate[j] * (1.0f / 256.0f));
        *(h16x8*)((h16*)(p.ws + OFF_OMIX) + (size_t)bt * 2048 + 1024 + (4 * g) * 128 + 8 * lane) = res;
    }
#pragma unroll
    for (int c = 0; c < 4; ++c) kix[c] = kixn[c];
    }
#undef AT_LOADI
}

__device__ __forceinline__ void phase5(const Params& p) {
    const int tid = opaque_tid(), wid = tid >> 6, lane = tid & 63;
    const int gw = blockIdx.x * 8 + wid, nw = gridDim.x * 8;
    const float* rowss = (const float*)(p.ws + OFF_ROWSS);
    for (int row = gw; row < BT; row += nw) {
        const float r = 1.0f / sqrtf(rowss[row] * (1.0f / DM) + EPS);
        f32x4* o = (f32x4*)(p.out + (size_t)row * DM);
        float eadd = 0.f;
        if ((TS_A >= 0 || TS_ACC >= 0) && row < 164) { const unsigned* ts = (const unsigned*)(p.ws + OFF_CTRL + 8192); const float tus = (TS_ACC >= 0) ? (float)ts[16 + (TS_ACC >= 0 ? TS_ACC : 0)] * (0.01f / 256.0f) : (float)(ts[TS_B >= 0 ? TS_B : 0] - ts[TS_A >= 0 ? TS_A : 0]) * 0.01f; eadd = sqrtf(tus * 1e-5f); }
#pragma unroll
        for (int i = 0; i < 8; ++i) { const f32x4 g = ((const f32x4*)p.final_g)[lane + 64 * i]; f32x4 v = o[lane + 64 * i]; v = v * r * g + eadd; o[lane + 64 * i] = v; }
    }
}

#define XB_TMO      128
#define XB_XCNT(j)  (256  + 64 * (j))
#define XB_XSUB(j)  (1280 + 64 * (j))
#define XB_XGEN(j)  (2304 + 64 * (j))
#define XB_TOP      3328
#define XB_TOPGEN   3392
#define XCD_BAR_WORDS 3456
#define XB_SPIN_CAP (1u << 18)

__device__ __forceinline__ unsigned xb_ld(unsigned* p)              { return __hip_atomic_load(p, __ATOMIC_RELAXED, __HIP_MEMORY_SCOPE_AGENT); }
__device__ __forceinline__ unsigned xb_add(unsigned* p, unsigned v) { return __hip_atomic_fetch_add(p, v, __ATOMIC_RELAXED, __HIP_MEMORY_SCOPE_AGENT); }
__device__ __forceinline__ unsigned xb_xcc_id() { return (unsigned)__builtin_amdgcn_s_getreg((3 << 11) | 20) & 0xFu; }
#define XB_SPIN(cond, bar) do { unsigned _sp = 0; while (cond) { __builtin_amdgcn_s_sleep(1); \
    if ((++_sp & 255u) == 0u) { if (xb_ld(&(bar)[XB_TMO])) break; if (_sp > XB_SPIN_CAP) { atomicAdd(&(bar)[XB_TMO], 1u); break; } } } } while (0)

struct XcdBarrier {
    unsigned* bar; unsigned x;
    volatile LAS unsigned* st;
};

__device__ __forceinline__ XcdBarrier xcd_barrier_post(unsigned* bar, volatile LAS unsigned* st) {
    XcdBarrier b; b.bar = bar; b.x = xb_xcc_id(); b.st = st;
    if (threadIdx.x == 0) (void)xb_add(&bar[XB_XCNT(b.x)], 1u);
    return b;
}
__device__ __forceinline__ void xcd_barrier_complete(unsigned* bar, unsigned x, unsigned& nloc, unsigned& nx) {
    const unsigned G = gridDim.x * gridDim.y * gridDim.z;
    unsigned sum, cnt, mine, sp = 0u;
    for (;;) {
        sum = 0u; cnt = 0u; mine = 0u;
#pragma unroll
        for (unsigned j = 0; j < 16; ++j) { const unsigned c = xb_ld(&bar[XB_XCNT(j)]); sum += c; cnt += (c > 0u) ? 1u : 0u; mine = (j == x) ? c : mine; }
        if (sum == G) break;
        __builtin_amdgcn_s_sleep(1);
        if ((++sp & 255u) == 0u) { if (xb_ld(&bar[XB_TMO])) break; if (sp > XB_SPIN_CAP) { atomicAdd(&bar[XB_TMO], 1u); break; } }
    }
    nloc = mine > 0u ? mine : 1u; nx = cnt > 0u ? cnt : 1u;
}

__device__ __forceinline__ void xcd_barrier(const XcdBarrier& b) {
    asm volatile("s_waitcnt vmcnt(0)" ::: "memory");
    __syncthreads();
    if (threadIdx.x == 0) {
        unsigned* bar = b.bar;
        __builtin_amdgcn_s_waitcnt(0);
        unsigned nloc = b.st[0], nx = b.st[1];
        if (nloc == 0u) { xcd_barrier_complete(bar, b.x, nloc, nx); b.st[0] = nloc; b.st[1] = nx; }
        const unsigned old = xb_add(&bar[XB_XSUB(b.x)], 1u);
        const unsigned gen = old / nloc;
        if (old + 1u == (gen + 1u) * nloc) {
            __builtin_amdgcn_fence(__ATOMIC_RELEASE, "agent");
            asm volatile("s_waitcnt vmcnt(0)" ::: "memory");
            const unsigned og = xb_add(&bar[XB_TOP], 1u);
            const unsigned tg = og / nx;
            if (og + 1u == (tg + 1u) * nx) xb_add(&bar[XB_TOPGEN], 1u);
            else XB_SPIN(xb_ld(&bar[XB_TOPGEN]) == tg, bar);
            __builtin_amdgcn_fence(__ATOMIC_ACQUIRE, "agent");
            xb_add(&bar[XB_XGEN(b.x)], 1u);
            asm volatile("s_waitcnt vmcnt(0)" ::: "memory");
        } else {
            XB_SPIN(xb_ld(&bar[XB_XGEN(b.x)]) == gen, bar);
            __builtin_amdgcn_fence(__ATOMIC_ACQUIRE, "agent");
            asm volatile("s_waitcnt vmcnt(0)" ::: "memory");
        }
    }
    __syncthreads();
}


template <int LO, int HI>
__global__ void __launch_bounds__(512, 2) k_phases(Params p) {
    extern __shared__ __attribute__((aligned(16))) unsigned char smem[];
#define IN(k) (LO <= (k) && (k) < HI)
#define SEAM(k) do { if constexpr (IN(k) && IN((k) + 1)) { xcd_barrier(xbar); if (TS_A >= 0 && blockIdx.x == 0 && threadIdx.x == 0) ((unsigned*)(p.ws + OFF_CTRL + 8192))[(k) + 1] = (unsigned)__builtin_amdgcn_s_memrealtime(); } } while (0)
    XcdBarrier xbar; xbar.bar = nullptr; xbar.x = 0; xbar.st = nullptr;
    if constexpr (HI - LO > 1) {
        volatile LAS unsigned* stw = (volatile LAS unsigned*)((LAS unsigned char*)smem + LDS_BYTES - 48);
        if (threadIdx.x < 4) stw[threadIdx.x] = 0u;
        __syncthreads();
        xbar = xcd_barrier_post((unsigned*)(p.ws + OFF_CTRL + 16384), stw);
    }
    if (TS_A >= 0 && blockIdx.x == 0 && threadIdx.x == 0) ((unsigned*)(p.ws + OFF_CTRL + 8192))[0] = (unsigned)__builtin_amdgcn_s_memrealtime();
    if constexpr (IN(0)) { for (int rep = 0; rep < NREP(0); ++rep) phase0(p, smem); }
    SEAM(0);
    if constexpr (IN(1)) for (int rep = 0; rep < NREP(1); ++rep) {
        pg8::Gemm g{(const h16*)(p.ws + OFF_H), (const h16*)(p.ws + OFF_WT), BT, NPAD, DM};
        pg8::StaticOrder S; S.init(BT, NPAD, gridDim.x, blockIdx.x);
        EpiIn E{p.ws, p.a_log, p.dt_bias};
        pg8::gemm_phase<EpiIn, pg8::StaticOrder>((LAS unsigned char*)smem, g, S, E);
    }
    SEAM(1);
    if constexpr (IN(2)) for (int rep = 0; rep < NREP(2); ++rep) {
        {
            unsigned* qctr = (unsigned*)(p.ws + OFF_CTRL);
            volatile unsigned* lds_t = (volatile unsigned*)(smem + LDS_BYTES - 16);
            __syncthreads();
            if (threadIdx.x == 0) lds_t[0] = atomicAdd(qctr + 0 + 16 * rep, 1u);
            __syncthreads();
            unsigned o = lds_t[0];
            while (o < 1024u + 2048u) {
                unsigned nxt = 0u;
                if (threadIdx.x == 0) nxt = atomicAdd(qctr + 0 + 16 * rep, 1u);
                if (o < 1024u) { ACC_T0(); gdn_prep_pair(p, smem, (int)o); __syncthreads(); ACC_ADD(0); }
                else { const unsigned o2 = o - 1024u; idx8_task(p, smem, (int)(o2 & 3u), 511 - (int)(o2 >> 2)); }
                __syncthreads();
                if (threadIdx.x == 0) lds_t[0] = nxt;
                __syncthreads();
                o = lds_t[0];
            }
        }
    }
    SEAM(2);
    if constexpr (IN(3)) for (int rep = 0; rep < NREP(3); ++rep) {
        {
            unsigned* qctr = (unsigned*)(p.ws + OFF_CTRL);
            volatile unsigned* lds_t = (volatile unsigned*)(smem + LDS_BYTES - 16);
            volatile unsigned* lds_c = (volatile unsigned*)(smem + LDS_BYTES - 192);
            const int myx = (int)(xb_xcc_id() & 7u);
            for (int pass = 0; pass < 2; ++pass) {
                if (pass == 1) { __syncthreads(); if (threadIdx.x < 8) lds_c[8 + threadIdx.x] = __hip_atomic_load(qctr + 64 + 16 * rep + threadIdx.x, __ATOMIC_RELAXED, __HIP_MEMORY_SCOPE_AGENT); __syncthreads(); }
                const int nk = pass == 0 ? 1 : 8;
                for (int k = 0; k < nk; ++k) {
                    const int sp = (myx + k) & 7;
                    if (pass == 1 && lds_c[8 + sp] >= 4u) continue;
                    for (;;) {
                        __syncthreads();
                        if (threadIdx.x == 0) lds_t[0] = atomicAdd(qctr + 64 + 16 * rep + sp, 1u);
                        __syncthreads();
                        const unsigned o = lds_t[0];
                        if (o >= 4u) break;
                        { ACC_T0(); gdn_scan_task(p, smem, 4 * sp + (int)o); __syncthreads(); ACC_ADD(4); }
                        if (pass == 0) break;
                    }
                }
                if (pass == 0) for (int k = 0; k < 8; ++k) {
                    const int part = (myx + k) & 7;
                    if (k == 1) { __syncthreads(); if (threadIdx.x < 8) lds_c[threadIdx.x] = __hip_atomic_load(qctr + 128 + 16 * rep + threadIdx.x, __ATOMIC_RELAXED, __HIP_MEMORY_SCOPE_AGENT); __syncthreads(); }
                    if (k >= 1 && lds_c[part] >= 512u) continue;
                    __syncthreads();
                    if (threadIdx.x == 0) lds_t[0] = atomicAdd(qctr + 128 + 16 * rep + part, 1u);
                    __syncthreads();
                    unsigned a = lds_t[0];
                    while (a < 512u) {
                        unsigned nxt = 0u;
                        if (threadIdx.x == 0) nxt = atomicAdd(qctr + 128 + 16 * rep + part, 1u);
                        { ACC_T0(); attn8_task(p, smem, part, (int)a); __syncthreads(); ACC_ADD(3); }
                        __syncthreads();
                        if (threadIdx.x == 0) lds_t[0] = nxt;
                        __syncthreads();
                        a = lds_t[0];
                    }
                }
            }
        }
    }
    SEAM(3);
    const bool fuse_norm = (gridDim.x == 256) && (TS_A < 0) && (TS_ACC < 0);
    if constexpr (IN(4)) {
        pg8::Gemm g{(const h16*)(p.ws + OFF_OMIX), (const h16*)(p.ws + OFF_WOT), BT, DM, DM};
        if (fuse_norm) {
            PanelOrder S; S.c = blockIdx.x;
            EpiOutNorm E{p.x, p.out, (float*)(p.ws + OFF_ROWSS), (unsigned*)(p.ws + OFF_CTRL + 32768), p.final_g};
            pg8::gemm_phase<EpiOutNorm, PanelOrder>((LAS unsigned char*)smem, g, S, E);
        } else {
            pg8::StaticOrder S; S.init(BT, DM, gridDim.x, blockIdx.x);
            EpiOut E{p.x, p.out, (float*)(p.ws + OFF_ROWSS)};
            pg8::gemm_phase<EpiOut, pg8::StaticOrder>((LAS unsigned char*)smem, g, S, E);
        }
    }
    if (fuse_norm) return;
    SEAM(4);
    if constexpr (IN(5)) { phase5(p); }
#undef IN
#undef SEAM
}

template <int LO, int HI> static void launch_range(const Params& p, int grid, hipStream_t stream, bool coop) {
    static bool attr = false;
    if (!attr) { hipFuncSetAttribute((const void*)k_phases<LO, HI>, hipFuncAttributeMaxDynamicSharedMemorySize, LDS_BYTES); attr = true; }
    if (coop) {
        Params pp = p; void* args[] = {&pp};
        hipError_t e = hipLaunchCooperativeKernel((const void*)k_phases<LO, HI>, dim3(grid), dim3(512), args, LDS_BYTES, stream);
        if (e != hipSuccess) fprintf(stderr, "cooperative launch failed: %s (grid %d)\n", hipGetErrorString(e), grid);
    } else {
        hipLaunchKernelGGL((k_phases<LO, HI>), dim3(grid), dim3(512), LDS_BYTES, stream, p);
    }
}

extern "C" void kernel_launch(void* const* d_in, const int* in_sizes, int n_in, void* d_out, int out_size, void* d_ws, size_t ws_size, hipStream_t stream) {
    if (n_in != 10 || in_sizes[0] != BT * DM || out_size != BT * DM || ws_size < WS_END) {
        fprintf(stderr, "kernel_launch: unexpected shapes (n_in %d in0 %d out %d ws %zu need %zu)\n", n_in, n_in > 0 ? in_sizes[0] : -1, out_size, ws_size, (size_t)WS_END); return; }
    static int grid = 0;
    if (!grid) {
        int dev = 0, cus = 0, per_cu = 0; hipGetDevice(&dev); hipDeviceGetAttribute(&cus, hipDeviceAttributeMultiprocessorCount, dev);
#if FUSED
        hipFuncSetAttribute((const void*)k_phases<0, 6>, hipFuncAttributeMaxDynamicSharedMemorySize, LDS_BYTES);
        hipOccupancyMaxActiveBlocksPerMultiprocessor(&per_cu, (const void*)k_phases<0, 6>, 512, LDS_BYTES);
#else
        per_cu = 1;
#endif
        if (per_cu < 1) per_cu = 1; if (per_cu > 1) per_cu = 1;
        grid = cus * per_cu;
    }
    Params p{};
    p.x = (const float*)d_in[0]; p.pos = (const int*)d_in[1]; p.attn_g = (const float*)d_in[2]; p.w_in = (const float*)d_in[3]; p.conv_w = (const float*)d_in[4];
    p.a_log = (const float*)d_in[5]; p.dt_bias = (const float*)d_in[6]; p.gdn_norm_g = (const float*)d_in[7]; p.w_out = (const float*)d_in[8]; p.final_g = (const float*)d_in[9];
    p.out = (float*)d_out; p.ws = (unsigned char*)d_ws;
    hipMemsetAsync((char*)d_ws + OFF_CTRL, 0, CTL_ZERO_BYTES, stream);
#if FUSED
    launch_range<0, 6>(p, grid, stream, false);
#else
    launch_range<0, 1>(p, grid, stream, false);
    launch_range<1, 2>(p, grid, stream, false);
    launch_range<2, 3>(p, grid, stream, false);
    launch_range<3, 4>(p, grid, stream, false);
    launch_range<4, 5>(p, grid, stream, false);
    launch_range<5, 6>(p, grid, stream, false);
#endif
}
```

```cpp
#include <hip/hip_runtime.h>
#include <hip/hip_cooperative_groups.h>
#include <cstdio>
#include <cstdint>
namespace cg = cooperative_groups;

#ifndef FUSED
#define FUSED 1
#endif
#ifndef REPEAT_PHASE
#define REPEAT_PHASE -1
#endif
#define NREP(k) ((REPEAT_PHASE == (k)) ? 2 : 1)
#ifndef TS_A
#define TS_A -1
#endif
#ifndef TS_ACC
#define TS_ACC -1
#endif
#define ACC_T0() unsigned acc_t0_ = 0; if (TS_ACC >= 0 && threadIdx.x == 0) acc_t0_ = (unsigned)__builtin_amdgcn_s_memrealtime()
#define ACC_ADD(k) do { if (TS_ACC >= 0 && threadIdx.x == 0) { const unsigned t1_ = (unsigned)__builtin_amdgcn_s_memrealtime(); atomicAdd((unsigned*)(p.ws + OFF_CTRL + 8192) + 16 + (k), t1_ - acc_t0_); acc_t0_ = t1_; } } while (0)
#ifndef TS_B
#define TS_B -1
#endif

#define LAS __attribute__((address_space(3)))
typedef _Float16 h16;
typedef h16 h16x8 __attribute__((ext_vector_type(8)));
typedef h16 h16x4 __attribute__((ext_vector_type(4)));
typedef h16 h16x2 __attribute__((ext_vector_type(2)));
typedef float f32x4 __attribute__((ext_vector_type(4)));
typedef float f32x2 __attribute__((ext_vector_type(2)));
typedef unsigned u32x4 __attribute__((ext_vector_type(4)));

constexpr int NB = 4, NT = 4096, DM = 2048, BT = NB * NT;
constexpr int IN_COLS = 7776, NPAD = 7936;
constexpr float EPS = 1e-6f;
constexpr int LDS_BYTES = 155648;

constexpr size_t MB = 1024 * 1024;
constexpr size_t OFF_CTRL = 0;
constexpr size_t OFF_ROWSS = 65536;
constexpr size_t CTL_ZERO_BYTES = 65536 + (size_t)BT * 4;
constexpr size_t OFF_H = 1 * MB;
constexpr size_t OFF_OMIX = OFF_H;
constexpr size_t OFF_WT = OFF_H + 64 * MB;
constexpr size_t OFF_WOT = OFF_WT + (size_t)NPAD * 2048 * 2;
constexpr size_t OFF_QKVR = OFF_WOT + 8 * MB;
constexpr size_t OFF_GZ = OFF_QKVR + (size_t)BT * 3072 * 2;
constexpr size_t OFF_AQ = OFF_GZ + 32 * MB;
constexpr size_t OFF_AK = OFF_AQ + 32 * MB;
constexpr size_t OFF_AV = OFF_AK + 8 * MB;
constexpr size_t OFF_AZ = OFF_AV + 8 * MB;
constexpr size_t OFF_IQ = OFF_AZ + 32 * MB;
constexpr size_t OFF_IK = OFF_IQ + 32 * MB;
constexpr size_t OFF_GB = OFF_IK + 2 * MB;
constexpr size_t OFF_IW = OFF_GB + 1 * MB;
constexpr size_t OFF_COS = OFF_IW + 1 * MB;
constexpr size_t OFF_SIN = OFF_COS + 2 * MB;
constexpr size_t OFF_SEL = OFF_SIN + 2 * MB;
constexpr size_t OFF_REC = OFF_SEL + 8 * MB;
constexpr size_t WS_END = OFF_REC + (size_t)2048 * 74752;

struct Params {
    const float* x; const int* pos; const float* attn_g; const float* w_in; const float* conv_w; const float* a_log;
    const float* dt_bias; const float* gdn_norm_g; const float* w_out; const float* final_g; float* out; unsigned char* ws;
};

__device__ __forceinline__ float wave_sum(float v) {
#pragma unroll
    for (int o = 1; o < 64; o <<= 1) v += __shfl_xor(v, o);
    return v;
}
__device__ __forceinline__ float wave_max(float v) {
#pragma unroll
    for (int o = 1; o < 64; o <<= 1) v = fmaxf(v, __shfl_xor(v, o));
    return v;
}
__device__ __forceinline__ int opaque_tid() { int t = threadIdx.x; asm volatile("" : "+v"(t)); return t; }
__device__ __forceinline__ float silu_f(float x) { return x * __builtin_amdgcn_rcpf(1.0f + __builtin_amdgcn_exp2f(-1.4426950408889634f * x)); }

namespace pg8 {
constexpr int BM = 256, BK = 64, HALF = 128, HTB = HALF * BK * 2, STAGE_BYTES = 8 * HTB, NXCD = 8, WGM = 8;
__host__ __device__ __forceinline__ int lds_byte(int r, int c) { const int st = (r >> 4) * 2 + (c >> 5), rr = r & 15, cc = c & 31, ob = rr * 64 + cc * 2; return st * 1024 + (ob ^ (((ob >> 9) & 1) << 5)); }
__host__ __device__ __forceinline__ void stage_rc(int b, int& R, int& C) { const int st = b / 1024, sb = b % 1024, swz = sb ^ (((sb >> 9) & 1) << 5); R = (st >> 1) * 16 + swz / 64; C = (st & 1) * 32 + (swz % 64) / 2; }
__host__ __device__ __forceinline__ int perm32(int rho) { const int n = rho >> 4, i = rho & 15; return 8 * (i >> 2) + 4 * n + (i & 3); }
struct Unit { int pm, pn; };
struct Gemm { const h16* A; const h16* Bt; int M, N, K; };
struct StaticOrder {
    int nM, nN, nwg, G, c;
    __host__ __device__ void init(int M, int N, int G_, int c_) { nM = M / BM; nN = N / BM; nwg = nM * nN; G = G_; c = c_; }
    __host__ __device__ bool next(int i, Unit& u) const {
        const long L = (long)i * G + c; if (L >= nwg) return false;
        int wgid = (int)L; { const int q = nwg / NXCD, r = nwg % NXCD, xcd = wgid % NXCD, off = wgid / NXCD; wgid = (xcd < r ? xcd * (q + 1) : r * (q + 1) + (xcd - r) * q) + off; }
        const int nig = WGM * nN, gid = wgid / nig, fm = gid * WGM, gsz = (nM - fm) < WGM ? (nM - fm) : WGM;
        u.pm = fm + ((wgid % nig) % gsz); u.pn = (wgid % nig) / gsz; return true;
    }
    __device__ __forceinline__ void a_ready(const Unit&) const {}
    __device__ __forceinline__ void done(const Unit&) const {}
};

template <class Epi, class Sched, bool SP2 = true>
__device__ __forceinline__ void gemm_phase(LAS unsigned char* lds, const Gemm g, const Sched& S, const Epi& E) {
    const int tid = opaque_tid(), wid = __builtin_amdgcn_readfirstlane(tid >> 6), lane = tid & 63, wr = wid >> 2, wc = wid & 3, fr = lane & 15, fq = lane >> 4;
    const int K = g.K, nt = K / BK;
    unsigned voffA[2], voffB[2];
#pragma unroll
    for (int i = 0; i < 2; ++i) { int R, C; stage_rc(tid * 16 + i * 8192, R, C); const int Rb = Epi::PERM ? ((R & ~31) + perm32(R & 31)) : R;
        voffA[i] = (unsigned)(R * K + C) * 2u; voffB[i] = (unsigned)(Rb * K + C) * 2u; }
    const size_t kstep = (size_t)(BK * 2);
    const size_t hstep = (size_t)HALF * K * 2;
    const size_t tstep = 2 * hstep;
    const unsigned ldsw = (unsigned)wid * 1024u;
    const int aoff = lds_byte(wr * 64 + fr, fq * 8), boff = lds_byte(wc * 32 + fr, fq * 8);
#define PG8_SA(b, h) (((b) * 2 + (h)) * HTB)
#define PG8_SB(b, h) ((4 + (b) * 2 + (h)) * HTB)
#define PG8_STAGE(bufoff, gbase, voff) do { _Pragma("unroll") for (int _i = 0; _i < 2; ++_i) \
        __builtin_amdgcn_global_load_lds((const unsigned*)((const char*)(gbase) + (voff)[_i]), (LAS unsigned*)(lds + (bufoff) + ldsw + _i * 8192), 16, 0, 0); } while (0)
#define PG8_LDA(dst, b, h) do { _Pragma("unroll") for (int m = 0; m < 4; ++m) _Pragma("unroll") for (int k = 0; k < 2; ++k) dst[m][k] = *(const LAS h16x8*)(lds + PG8_SA(b, h) + aoff + m * 2048 + k * 1024); } while (0)
#define PG8_LDB(dst, b, h) do { _Pragma("unroll") for (int n = 0; n < 2; ++n) _Pragma("unroll") for (int k = 0; k < 2; ++k) dst[n][k] = *(const LAS h16x8*)(lds + PG8_SB(b, h) + boff + n * 2048 + k * 1024); } while (0)
#define PG8_MMA(ai, bj, At, Bt) do { __builtin_amdgcn_s_setprio(1); _Pragma("unroll") for (int m = 0; m < 4; ++m) _Pragma("unroll") for (int n = 0; n < 2; ++n) _Pragma("unroll") for (int k = 0; k < 2; ++k) \
        acc[ai][bj][m][n] = __builtin_amdgcn_mfma_f32_16x16x32_f16(Bt[n][k], At[m][k], acc[ai][bj][m][n], 0, 0, 0); __builtin_amdgcn_s_setprio(0); } while (0)
#define PG8_WAIT_V(n) asm volatile("s_waitcnt vmcnt(" #n ")" ::: "memory")
#define PG8_WAIT_L(n) asm volatile("s_waitcnt lgkmcnt(" #n ")" ::: "memory")
#define PG8_BAR __builtin_amdgcn_s_barrier()
#define PG8_SCHED __builtin_amdgcn_sched_barrier(0)
    Unit cur, nxt; int ui = 0;
    if (!S.next(0, cur)) return;
    f32x4 acc[2][2][4][2];
#pragma unroll
    for (int a = 0; a < 2; ++a)
#pragma unroll
        for (int b = 0; b < 2; ++b)
#pragma unroll
            for (int m = 0; m < 4; ++m)
#pragma unroll
                for (int n = 0; n < 2; ++n) acc[a][b][m][n] = (f32x4){0.f, 0.f, 0.f, 0.f};
    h16x8 At[4][2], B0[2][2], B1[2][2];
    const char* cA = (const char*)g.A + (size_t)cur.pm * tstep; const char* cB = (const char*)g.Bt + (size_t)cur.pn * tstep;
    S.a_ready(cur);
    if constexpr (SP2) {
        PG8_STAGE(PG8_SB(0, 0), cB, voffB); PG8_STAGE(PG8_SB(0, 1), cB + hstep, voffB); PG8_STAGE(PG8_SA(0, 0), cA, voffA); PG8_STAGE(PG8_SA(0, 1), cA + hstep, voffA);
        if (wr == 1) PG8_BAR;
        PG8_WAIT_V(2); PG8_BAR;
        PG8_STAGE(PG8_SB(1, 0), cB + kstep, voffB); PG8_STAGE(PG8_SA(1, 0), cA + kstep, voffA); PG8_STAGE(PG8_SB(1, 1), cB + hstep + kstep, voffB);
        PG8_WAIT_V(6); PG8_BAR;
    } else {
    PG8_STAGE(PG8_SB(0, 0), cB, voffB); PG8_STAGE(PG8_SA(0, 0), cA, voffA); PG8_STAGE(PG8_SB(0, 1), cB + hstep, voffB); PG8_STAGE(PG8_SA(0, 1), cA + hstep, voffA);
    if (wr == 1) PG8_BAR;
    PG8_WAIT_V(4); PG8_BAR;
    PG8_STAGE(PG8_SB(1, 0), cB + kstep, voffB); PG8_STAGE(PG8_SA(1, 0), cA + kstep, voffA); PG8_STAGE(PG8_SB(1, 1), cB + hstep + kstep, voffB);
    PG8_WAIT_V(6); PG8_BAR;
    }
    for (;;) {
        const bool has_next = S.next(ui + 1, nxt);
        const char* nA = has_next ? (const char*)g.A + (size_t)nxt.pm * tstep : cA; const char* nB = has_next ? (const char*)g.Bt + (size_t)nxt.pn * tstep : cB;
        for (int t = 0; t < nt; t += 2) {
            const bool last = (t == nt - 2);
            const char* a1 = cA + (size_t)(t + 1) * kstep;
            const char* a2 = last ? nA : cA + (size_t)(t + 2) * kstep; const char* b2 = last ? nB : cB + (size_t)(t + 2) * kstep;
            const char* a3 = a2 + kstep; const char* b3 = b2 + kstep;
            if (last && has_next) S.a_ready(nxt);
            if constexpr (SP2) {
            PG8_LDB(B0, 0, 0); PG8_LDB(B1, 0, 1); PG8_SCHED; PG8_LDA(At, 0, 0); PG8_STAGE(PG8_SA(1, 1), a1 + hstep, voffA);
            PG8_WAIT_V(8); PG8_WAIT_L(0); PG8_BAR; PG8_MMA(0, 0, At, B0); PG8_MMA(0, 1, At, B1); PG8_BAR; PG8_SCHED;
            PG8_LDA(At, 0, 1); PG8_STAGE(PG8_SB(0, 0), b2, voffB); PG8_STAGE(PG8_SB(0, 1), b2 + hstep, voffB); PG8_STAGE(PG8_SA(0, 0), a2, voffA);
            PG8_WAIT_V(8); PG8_WAIT_L(0); PG8_BAR; PG8_MMA(1, 0, At, B0); PG8_MMA(1, 1, At, B1); PG8_BAR; PG8_SCHED;
            PG8_LDB(B0, 1, 0); PG8_LDB(B1, 1, 1); PG8_SCHED; PG8_LDA(At, 1, 0); PG8_STAGE(PG8_SA(0, 1), a2 + hstep, voffA);
            PG8_WAIT_V(8); PG8_WAIT_L(0); PG8_BAR; PG8_MMA(0, 0, At, B0); PG8_MMA(0, 1, At, B1); PG8_BAR; PG8_SCHED;
            PG8_LDA(At, 1, 1); PG8_STAGE(PG8_SB(1, 0), b3, voffB); PG8_STAGE(PG8_SB(1, 1), b3 + hstep, voffB); PG8_STAGE(PG8_SA(1, 0), a3, voffA);
            PG8_WAIT_V(8); PG8_WAIT_L(0); PG8_BAR; PG8_MMA(1, 0, At, B0); PG8_MMA(1, 1, At, B1); PG8_BAR; PG8_SCHED;
            } else {
            PG8_LDB(B0, 0, 0); PG8_SCHED; PG8_LDA(At, 0, 0); PG8_STAGE(PG8_SA(1, 1), a1 + hstep, voffA);
            PG8_WAIT_L(8); PG8_BAR; PG8_WAIT_L(0); PG8_MMA(0, 0, At, B0); PG8_BAR; PG8_SCHED;
            PG8_LDB(B1, 0, 1); PG8_STAGE(PG8_SB(0, 0), b2, voffB);
            PG8_BAR; PG8_WAIT_L(0); PG8_MMA(0, 1, At, B1); PG8_BAR;
            PG8_LDA(At, 0, 1); PG8_STAGE(PG8_SA(0, 0), a2, voffA);
            PG8_BAR; PG8_WAIT_L(0); PG8_MMA(1, 0, At, B0); PG8_BAR; PG8_SCHED;
            PG8_STAGE(PG8_SB(0, 1), b2 + hstep, voffB);
            PG8_WAIT_V(6); PG8_BAR; PG8_MMA(1, 1, At, B1); PG8_BAR;
            PG8_LDB(B0, 1, 0); PG8_SCHED; PG8_LDA(At, 1, 0); PG8_STAGE(PG8_SA(0, 1), a2 + hstep, voffA);
            PG8_WAIT_L(8); PG8_BAR; PG8_WAIT_L(0); PG8_MMA(0, 0, At, B0); PG8_BAR; PG8_SCHED;
            PG8_LDB(B1, 1, 1); PG8_STAGE(PG8_SB(1, 0), b3, voffB);
            PG8_BAR; PG8_WAIT_L(0); PG8_MMA(0, 1, At, B1); PG8_BAR;
            PG8_LDA(At, 1, 1); PG8_STAGE(PG8_SA(1, 0), a3, voffA);
            PG8_BAR; PG8_WAIT_L(0); PG8_MMA(1, 0, At, B0); PG8_BAR; PG8_SCHED;
            PG8_STAGE(PG8_SB(1, 1), b3 + hstep, voffB);
            PG8_WAIT_V(6); PG8_BAR; PG8_MMA(1, 1, At, B1); PG8_BAR;
            }
        }
        if (wr == 0) PG8_BAR;
        E(acc, cur, wr, wc, fr, fq); S.done(cur);
        if (!has_next) break;
#pragma unroll
        for (int a = 0; a < 2; ++a)
#pragma unroll
            for (int b = 0; b < 2; ++b)
#pragma unroll
                for (int m = 0; m < 4; ++m)
#pragma unroll
                    for (int n = 0; n < 2; ++n) acc[a][b][m][n] = (f32x4){0.f, 0.f, 0.f, 0.f};
        cur = nxt; cA = nA; cB = nB; ++ui;
        if (wr == 1) PG8_BAR;
    }
    PG8_WAIT_V(0);
    PG8_BAR;
#undef PG8_SA
#undef PG8_SB
#undef PG8_STAGE
#undef PG8_LDA
#undef PG8_LDB
#undef PG8_MMA
#undef PG8_WAIT_V
#undef PG8_WAIT_L
#undef PG8_BAR
#undef PG8_SCHED
}
}

struct EpiIn {
    static constexpr bool PERM = true;
    unsigned char* ws; const float* a_log; const float* dt_bias;
    __device__ __forceinline__ void operator()(const f32x4 (&acc)[2][2][4][2], const pg8::Unit& u, int wr, int wc, int fr, int fq) const {
        const int pn = u.pn;
        const int rowb = u.pm * 256 + wr * 64 + fr;
        const int cw = wc * 32 + 8 * fq;
        const float* cosT = (const float*)(ws + OFF_COS); const float* sinT = (const float*)(ws + OFF_SIN);
        if (pn < 30) {
            h16* base; int ldc, colt, mode; float scale = 1.f;
            if (pn < 12) { base = (h16*)(ws + OFF_QKVR); ldc = 3072; colt = pn * 256; mode = 0; }
            else if (pn < 16) { base = (h16*)(ws + OFF_GZ); ldc = 1024; colt = (pn - 12) * 256; mode = 1; }
            else if (pn < 20) { base = (h16*)(ws + OFF_AQ); ldc = 1024; colt = (pn - 16) * 256; mode = 2; }
            else if (pn == 20) { base = (h16*)(ws + OFF_AK); ldc = 256; colt = 0; mode = 2; }
            else if (pn == 21) { base = (h16*)(ws + OFF_AV); ldc = 256; colt = 0; mode = 4; }
            else if (pn < 26) { base = (h16*)(ws + OFF_AZ); ldc = 1024; colt = (pn - 22) * 256; mode = 1; }
            else { base = (h16*)(ws + OFF_IQ); ldc = 1024; colt = (pn - 26) * 256; mode = 3; }
            const bool rot_wave = (mode == 2 && wc == 0) || (mode == 3 && (wc & 1) == 0);
            const int xm = (mode == 2) ? 32 : 16;
            const bool rot_lane = (mode == 2) ? true : (fq < 2);
            const float sgn = (mode == 2) ? (fq < 2 ? -1.f : 1.f) : (fq == 0 ? -1.f : 1.f);
            const int tix = (mode == 2) ? 8 * (fq & 1) : 16;
#pragma unroll
            for (int ai = 0; ai < 2; ++ai)
#pragma unroll
                for (int m = 0; m < 4; ++m) {
                    const int row = rowb + ai * 128 + m * 16;
                    float cs[8], sn[8];
                    if (rot_wave) {
                        const f32x4 c0 = *(const f32x4*)(cosT + (size_t)row * 24 + tix), c1 = *(const f32x4*)(cosT + (size_t)row * 24 + tix + 4);
                        const f32x4 s0 = *(const f32x4*)(sinT + (size_t)row * 24 + tix), s1 = *(const f32x4*)(sinT + (size_t)row * 24 + tix + 4);
#pragma unroll
                        for (int j = 0; j < 4; ++j) { cs[j] = c0[j]; cs[4 + j] = c1[j]; sn[j] = s0[j]; sn[4 + j] = s1[j]; }
                    }
#pragma unroll
                    for (int bj = 0; bj < 2; ++bj) {
                        float v[8];
#pragma unroll
                        for (int j = 0; j < 4; ++j) { v[j] = acc[ai][bj][m][0][j]; v[4 + j] = acc[ai][bj][m][1][j]; }
                        if (rot_wave) {
#pragma unroll
                            for (int j = 0; j < 8; ++j) { const float pv = __shfl_xor(v[j], xm); if (rot_lane) v[j] = v[j] * cs[j] + sgn * pv * sn[j]; }
                        }
                        if (mode == 1) {
#pragma unroll
                            for (int j = 0; j < 8; ++j) v[j] = silu_f(v[j]);
                        }
                        if (mode == 4) {
                            int w0 = 0, w1 = 0;
                            w0 = __builtin_amdgcn_cvt_pk_fp8_f32(v[0], v[1], w0, false); w0 = __builtin_amdgcn_cvt_pk_fp8_f32(v[2], v[3], w0, true);
                            w1 = __builtin_amdgcn_cvt_pk_fp8_f32(v[4], v[5], w1, false); w1 = __builtin_amdgcn_cvt_pk_fp8_f32(v[6], v[7], w1, true);
                            typedef int i32x2b __attribute__((ext_vector_type(2)));
                            *(i32x2b*)((unsigned char*)base + (size_t)row * ldc + bj * 128 + cw) = (i32x2b){w0, w1};
                        } else if (mode == 2) {
                            int w0 = 0, w1 = 0;
                            w0 = __builtin_amdgcn_cvt_pk_fp8_f32(v[0], v[1], w0, false); w0 = __builtin_amdgcn_cvt_pk_fp8_f32(v[2], v[3], w0, true);
                            w1 = __builtin_amdgcn_cvt_pk_fp8_f32(v[4], v[5], w1, false); w1 = __builtin_amdgcn_cvt_pk_fp8_f32(v[6], v[7], w1, true);
                            typedef int i32x2 __attribute__((ext_vector_type(2)));
                            *(i32x2*)((unsigned char*)base + (size_t)row * ldc + colt + bj * 128 + fq * 32 + wc * 8) = (i32x2){w0, w1};
                        } else {
                            h16x8 o;
#pragma unroll
                            for (int j = 0; j < 8; ++j) o[j] = (h16)(v[j] * scale);
                            *(h16x8*)(base + (size_t)row * ldc + colt + bj * 128 + cw) = o;
                        }
                    }
                }
        } else {
            h16* ik = (h16*)(ws + OFF_IK); float* gb = (float*)(ws + OFF_GB); float* iw = (float*)(ws + OFF_IW);
#pragma unroll
            for (int ai = 0; ai < 2; ++ai)
#pragma unroll
                for (int m = 0; m < 4; ++m) {
                    const int row = rowb + ai * 128 + m * 16;
                    float v[8];
#pragma unroll
                    for (int j = 0; j < 4; ++j) { v[j] = acc[ai][0][m][0][j]; v[4 + j] = acc[ai][0][m][1][j]; }
                    const f32x4 c0 = *(const f32x4*)(cosT + (size_t)row * 24 + 16), c1 = *(const f32x4*)(cosT + (size_t)row * 24 + 20);
                    const f32x4 s0 = *(const f32x4*)(sinT + (size_t)row * 24 + 16), s1 = *(const f32x4*)(sinT + (size_t)row * 24 + 20);
                    if (wc == 0) {
                        const float sgn = (fq == 0 ? -1.f : 1.f);
#pragma unroll
                        for (int j = 0; j < 8; ++j) { const float pv = __shfl_xor(v[j], 16); const float c = j < 4 ? c0[j & 3] : c1[j & 3], s = j < 4 ? s0[j & 3] : s1[j & 3];
                            if (fq < 2) v[j] = v[j] * c + sgn * pv * s; }
                    }
                    if (wc < 2) {
                        h16x8 o;
#pragma unroll
                        for (int j = 0; j < 8; ++j) o[j] = (h16)v[j];
                        *(h16x8*)(ik + (size_t)row * 64 + cw) = o;
                    } else if (wc == 2) {
                        if (fq == 0) {
#pragma unroll
                            for (int j = 0; j < 8; ++j) { const float z = v[j] + dt_bias[j]; const float sp = z > 20.f ? z : log1pf(expf(z)); gb[(size_t)row * 16 + j] = -expf(a_log[j]) * sp; }
                        } else if (fq == 1) {
#pragma unroll
                            for (int j = 0; j < 8; ++j) gb[(size_t)row * 16 + 8 + j] = 1.0f / (1.0f + expf(-v[j]));
                        } else {
#pragma unroll
                            for (int j = 0; j < 8; ++j) iw[(size_t)row * 16 + 8 * (fq - 2) + j] = v[j] * 0.03125f;
                        }
                    }
                }
        }
    }
};

struct PanelOrder {
    int c;
    __device__ __forceinline__ bool next(int i, pg8::Unit& u) const { if (i >= 2) return false; u.pm = 32 * i + 4 * (c & 7) + (c >> 6); u.pn = (c >> 3) & 7; return true; }
    __device__ __forceinline__ void a_ready(const pg8::Unit&) const {}
    __device__ __forceinline__ void done(const pg8::Unit&) const {}
};
struct EpiOutNorm {
    static constexpr bool PERM = false;
    const float* x; float* out; float* rowss; unsigned* cnt; const float* fg;
    __device__ __forceinline__ void operator()(f32x4 (&acc)[2][2][4][2], const pg8::Unit& u, int wr, int wc, int fr, int fq) const {
        const int rowb = u.pm * 256 + wr * 64 + fr, col0 = u.pn * 256 + wc * 32 + 4 * fq;
#pragma unroll
        for (int ai = 0; ai < 2; ++ai)
#pragma unroll
            for (int m = 0; m < 4; ++m) {
                const int row = rowb + ai * 128 + m * 16; float ss = 0.f;
#pragma unroll
                for (int bj = 0; bj < 2; ++bj)
#pragma unroll
                    for (int n = 0; n < 2; ++n) {
                        const f32x4 y = *(const f32x4*)(x + (size_t)row * DM + col0 + bj * 128 + n * 16) + acc[ai][bj][m][n];
                        acc[ai][bj][m][n] = y; ss += (y[0] * y[0] + y[1] * y[1]) + (y[2] * y[2] + y[3] * y[3]);
                    }
                ss += __shfl_xor(ss, 16); ss += __shfl_xor(ss, 32);
                if (fq == 0) atomicAdd(rowss + row, ss);
            }
        asm volatile("s_waitcnt vmcnt(0)" ::: "memory");
        unsigned* cw = cnt + (u.pm * 2 + wr) * 16;
        if ((threadIdx.x & 63) == 0) __hip_atomic_fetch_add(cw, 1u, __ATOMIC_RELAXED, __HIP_MEMORY_SCOPE_AGENT);
        { unsigned spins = 0;
          while ((unsigned)__builtin_amdgcn_readfirstlane((int)__hip_atomic_load(cw, __ATOMIC_RELAXED, __HIP_MEMORY_SCOPE_AGENT)) < 32u) { __builtin_amdgcn_s_sleep(2); if (++spins > (1u << 22)) break; } }
        f32x4 gv[2][2];
#pragma unroll
        for (int bj = 0; bj < 2; ++bj)
#pragma unroll
            for (int n = 0; n < 2; ++n) gv[bj][n] = *(const f32x4*)(fg + col0 + bj * 128 + n * 16);
#pragma unroll
        for (int ai = 0; ai < 2; ++ai)
#pragma unroll
            for (int m = 0; m < 4; ++m) {
                const int row = rowb + ai * 128 + m * 16;
                const float ssr = __hip_atomic_load(rowss + row, __ATOMIC_RELAXED, __HIP_MEMORY_SCOPE_AGENT);
                const float r = __builtin_amdgcn_rsqf(ssr * (1.0f / DM) + EPS);
#pragma unroll
                for (int bj = 0; bj < 2; ++bj)
#pragma unroll
                    for (int n = 0; n < 2; ++n) *(f32x4*)(out + (size_t)row * DM + col0 + bj * 128 + n * 16) = acc[ai][bj][m][n] * r * gv[bj][n];
            }
    }
};

struct EpiOut {
    static constexpr bool PERM = false;
    const float* x; float* out; float* rowss;
    __device__ __forceinline__ void operator()(const f32x4 (&acc)[2][2][4][2], const pg8::Unit& u, int wr, int wc, int fr, int fq) const {
        const int rowb = u.pm * 256 + wr * 64 + fr, col0 = u.pn * 256 + wc * 32 + 4 * fq;
#pragma unroll
        for (int ai = 0; ai < 2; ++ai)
#pragma unroll
            for (int m = 0; m < 4; ++m) {
                const int row = rowb + ai * 128 + m * 16; float ss = 0.f;
#pragma unroll
                for (int bj = 0; bj < 2; ++bj)
#pragma unroll
                    for (int n = 0; n < 2; ++n) {
                        const size_t off = (size_t)row * DM + col0 + bj * 128 + n * 16;
                        const f32x4 y = *(const f32x4*)(x + off) + acc[ai][bj][m][n];
                        *(f32x4*)(out + off) = y; ss += (y[0] * y[0] + y[1] * y[1]) + (y[2] * y[2] + y[3] * y[3]);
                    }
                ss += __shfl_xor(ss, 16); ss += __shfl_xor(ss, 32);
                if (fq == 0) atomicAdd(rowss + row, ss);
            }
    }
};

__device__ __forceinline__ int src_col(int np) {
    if (np < 4096) return np;
    if (np < 7680) return np + 16;
    if (np < 7744) return 7696 + (np - 7680);
    if (np < 7752) return 4096 + (np - 7744);
    if (np < 7760) return 4104 + (np - 7752);
    if (np < 7776) return np;
    return -1;
}
__device__ __forceinline__ void phase0(const Params& p, unsigned char* smem) {
    const int tid = opaque_tid(), wid = tid >> 6, lane = tid & 63;
    const int gw = blockIdx.x * 8 + wid, nw = gridDim.x * 8;
    h16* H = (h16*)(p.ws + OFF_H);
    for (int row = 2 * gw; row < BT; row += 2 * nw) {
        const f32x4* xr0 = (const f32x4*)(p.x + (size_t)row * DM); const f32x4* xr1 = xr0 + DM / 4;
        f32x4 v0[8], v1[8]; float s0 = 0.f, s1 = 0.f;
#pragma unroll
        for (int i = 0; i < 8; ++i) { v0[i] = xr0[lane + 64 * i]; v1[i] = xr1[lane + 64 * i]; }
#pragma unroll
        for (int i = 0; i < 8; ++i) { s0 += (v0[i][0] * v0[i][0] + v0[i][1] * v0[i][1]) + (v0[i][2] * v0[i][2] + v0[i][3] * v0[i][3]); s1 += (v1[i][0] * v1[i][0] + v1[i][1] * v1[i][1]) + (v1[i][2] * v1[i][2] + v1[i][3] * v1[i][3]); }
        s0 = wave_sum(s0); s1 = wave_sum(s1);
        const float r0 = __builtin_amdgcn_rsqf(s0 * (1.0f / DM) + EPS), r1 = __builtin_amdgcn_rsqf(s1 * (1.0f / DM) + EPS);
#pragma unroll
        for (int i = 0; i < 8; ++i) { const f32x4 g = ((const f32x4*)p.attn_g)[lane + 64 * i]; h16x4 o0, o1;
#pragma unroll
            for (int j = 0; j < 4; ++j) { o0[j] = (h16)(v0[i][j] * r0 * g[j]); o1[j] = (h16)(v1[i][j] * r1 * g[j]); }
            *(h16x4*)(H + (size_t)row * DM + 4 * (lane + 64 * i)) = o0; *(h16x4*)(H + (size_t)(row + 1) * DM + 4 * (lane + 64 * i)) = o1; }
    }
    {
        float* tiles = (float*)smem;
        h16* Wt = (h16*)(p.ws + OFF_WT); h16* WoT = (h16*)(p.ws + OFF_WOT);
        constexpr int NT1 = 124 * 32, NTT = NT1 + 32 * 32;
        const int nl_r = tid & 63, kl_r = tid >> 6, nl_w = tid >> 3, kc_w = tid & 7;
        float va[8], vb[8];
#define P0_LOAD(tI, v) do { if ((tI) < NT1) { const int n0_ = ((tI) / 32) * 64, k0_ = ((tI) % 32) * 64; const int src_ = src_col(n0_ + nl_r); \
            _Pragma("unroll") for (int i = 0; i < 8; ++i) v[i] = src_ >= 0 ? p.w_in[(size_t)(k0_ + kl_r + 8 * i) * IN_COLS + src_] : 0.f; } \
          else { const int t2_ = (tI) - NT1; const int n0_ = (t2_ / 32) * 64, k0_ = (t2_ % 32) * 64; \
            _Pragma("unroll") for (int i = 0; i < 8; ++i) v[i] = p.w_out[(size_t)(k0_ + kl_r + 8 * i) * DM + n0_ + nl_r]; } } while (0)
#define P0_PUT(buf, v) do { float* t_ = tiles + (buf) * (64 * 65); _Pragma("unroll") for (int i = 0; i < 8; ++i) t_[(kl_r + 8 * i) * 65 + nl_r] = v[i]; } while (0)
#define P0_STORE(buf, tI) do { const float* t_ = tiles + (buf) * (64 * 65); h16x8 o_; _Pragma("unroll") for (int j = 0; j < 8; ++j) o_[j] = (h16)t_[(8 * kc_w + j) * 65 + nl_w]; \
          if ((tI) < NT1) { const int n0_ = ((tI) / 32) * 64, k0_ = ((tI) % 32) * 64; *(h16x8*)(Wt + (size_t)(n0_ + nl_w) * 2048 + k0_ + 8 * kc_w) = o_; } \
          else { const int t2_ = (tI) - NT1; const int n0_ = (t2_ / 32) * 64, k0_ = (t2_ % 32) * 64; *(h16x8*)(WoT + (size_t)(n0_ + nl_w) * 2048 + k0_ + 8 * kc_w) = o_; } } while (0)
        int tI = blockIdx.x; int buf = 0;
        __syncthreads();
        if (tI < NTT) { P0_LOAD(tI, va); P0_PUT(0, va); }
        while (tI < NTT) {
            const int tn = tI + gridDim.x;
            if (tn < NTT) P0_LOAD(tn, vb);
            __syncthreads();
            P0_STORE(buf, tI);
            if (tn < NTT) P0_PUT(buf ^ 1, vb);
            buf ^= 1; tI = tn;
        }
#undef P0_LOAD
#undef P0_PUT
#undef P0_STORE
    }
    float* cosT = (float*)(p.ws + OFF_COS); float* sinT = (float*)(p.ws + OFF_SIN);
    for (int i = blockIdx.x * 512 + tid; i < BT * 24; i += gridDim.x * 512) {
        const int row = i / 24, j = i % 24;
        const float ex = (j < 16) ? (float)j * (2.0f / 32.0f) : (float)(j - 16) * (2.0f / 16.0f);
        const float inv = powf(500000.0f, -ex);
        const float ang = (float)p.pos[row] * inv;
        cosT[i] = cosf(ang); sinT[i] = sinf(ang);
    }
}

__device__ __forceinline__ h16x8 pack8(const f32x4 a, const f32x4 c) { h16x8 o; o[0] = (h16)a[0]; o[1] = (h16)a[1]; o[2] = (h16)a[2]; o[3] = (h16)a[3]; o[4] = (h16)c[0]; o[5] = (h16)c[1]; o[6] = (h16)c[2]; o[7] = (h16)c[3]; return o; }
typedef short v4s_t __attribute__((__vector_size__(4 * sizeof(short))));
__device__ __forceinline__ h16x4 lds_tr16(const LAS unsigned char* a) { const v4s_t v = __builtin_amdgcn_ds_read_tr16_b64_v4i16((LAS v4s_t*)a); return __builtin_bit_cast(h16x4, v); }
constexpr int REC_BYTES = 74752, REC_WF = 0, REC_QF = 16384, REC_AF = 32768, REC_KTF = 40960, REC_VEC = 57344, REC_UF = 58368, REC_DMA = 58368;
constexpr int HB_BYTES = 69632;

__device__ __forceinline__ void gdn_prep_pair(const Params& p, unsigned char* smem, int pair) {
    const int tid = opaque_tid(), wid = __builtin_amdgcn_readfirstlane(tid >> 6), lane = tid & 63, hb = wid >> 2, w4 = wid & 3, tl = tid & 255;
    const int tk = 2 * pair + hb; const int b = tk >> 9, h = (tk >> 6) & 7, n = tk & 63; const int t0 = n * 64;
    unsigned char* base = smem + hb * HB_BYTES;
    h16* Kn = (h16*)base; h16* Qn = Kn + 64 * 136; h16* Vh = Qn + 64 * 136; float* L = (float*)(Vh + 64 * 136); float* vec = L + 4096;
    unsigned char* rec = p.ws + OFF_REC + (size_t)tk * REC_BYTES;
    const h16* qkvr = (const h16*)(p.ws + OFF_QKVR);
    __syncthreads();
    {
        const int cg = tl & 15, rg = tl >> 4;
        h16x8 raw[3][7];
#pragma unroll
        for (int ti = 0; ti < 3; ++ti)
#pragma unroll
            for (int r = 0; r < 7; ++r) {
                const int trow = t0 + 4 * rg - 3 + r;
                if (trow >= 0) raw[ti][r] = *(const h16x8*)(qkvr + ((size_t)b * NT + trow) * 3072 + ti * 1024 + h * 128 + 8 * cg);
                else { for (int j = 0; j < 8; ++j) raw[ti][r][j] = (h16)0.f; }
            }
#pragma unroll
        for (int ti = 0; ti < 3; ++ti) {
            const int chan = ti * 1024 + h * 128 + 8 * cg;
            float xr[7][8];
#pragma unroll
            for (int r = 0; r < 7; ++r)
#pragma unroll
                for (int j = 0; j < 8; ++j) xr[r][j] = (float)raw[ti][r][j];
            float wv[4][8];
#pragma unroll
            for (int tp = 0; tp < 4; ++tp) { const f32x4 a = *(const f32x4*)(p.conv_w + (size_t)tp * 3072 + chan), c = *(const f32x4*)(p.conv_w + (size_t)tp * 3072 + chan + 4);
#pragma unroll
                for (int j = 0; j < 4; ++j) { wv[tp][j] = a[j]; wv[tp][4 + j] = c[j]; } }
            h16* dst = (ti == 0) ? Qn : (ti == 1 ? Kn : Vh);
#pragma unroll
            for (int r = 0; r < 4; ++r) {
                float y[8]; float ss = 0.f;
#pragma unroll
                for (int j = 0; j < 8; ++j) { float a = wv[0][j] * xr[r][j] + wv[1][j] * xr[r + 1][j] + wv[2][j] * xr[r + 2][j] + wv[3][j] * xr[r + 3][j]; a = silu_f(a); y[j] = a; ss += a * a; }
                float sc = 1.f;
                if (ti < 2) { ss += __shfl_xor(ss, 1); ss += __shfl_xor(ss, 2); ss += __shfl_xor(ss, 4); ss += __shfl_xor(ss, 8); sc = (ti == 0 ? 0.08838834764831845f : 1.0f) * __builtin_amdgcn_rsqf(ss + EPS); }
                h16x8 o;
#pragma unroll
                for (int j = 0; j < 8; ++j) o[j] = (h16)(y[j] * sc);
                *(h16x8*)(dst + (4 * rg + r) * 136 + 8 * cg) = o;
            }
        }
    }
    if (tl < 64) {
        const float* gb = (const float*)(p.ws + OFF_GB) + ((size_t)b * NT + t0 + tl) * 16;
        const float g = gb[h], be = gb[8 + h];
        float gc = g;
#pragma unroll
        for (int o = 1; o < 64; o <<= 1) { const float tt = __shfl_up(gc, o); if (lane >= o) gc += tt; }
        const float gl = __shfl(gc, 63);
        vec[tl] = g; vec[64 + tl] = be; vec[128 + tl] = gc; vec[192 + tl] = __expf(gc);
        float* rv = (float*)(rec + REC_VEC);
        rv[tl] = __expf(gc); rv[64 + tl] = __expf(gl - gc); if (tl == 0) rv[128] = __expf(gl);
    }
    __syncthreads();
    {
        const int rt = w4, fr = lane & 15, kg = lane >> 4;
        h16x8 Ak[4], Aq[4];
#pragma unroll
        for (int s = 0; s < 4; ++s) { Ak[s] = *(const h16x8*)(Kn + (16 * rt + fr) * 136 + 32 * s + 8 * kg); Aq[s] = *(const h16x8*)(Qn + (16 * rt + fr) * 136 + 32 * s + 8 * kg); }
        h16* AF = (h16*)(rec + REC_AF);
#pragma unroll
        for (int ct = 0; ct < 4; ++ct) {
            f32x4 kk = (f32x4){0.f, 0.f, 0.f, 0.f}, qk = (f32x4){0.f, 0.f, 0.f, 0.f};
#pragma unroll
            for (int s = 0; s < 4; ++s) { const h16x8 Bk = *(const h16x8*)(Kn + (16 * ct + fr) * 136 + 32 * s + 8 * kg);
                kk = __builtin_amdgcn_mfma_f32_16x16x32_f16(Ak[s], Bk, kk, 0, 0, 0); qk = __builtin_amdgcn_mfma_f32_16x16x32_f16(Aq[s], Bk, qk, 0, 0, 0); }
            const int j = 16 * ct + fr; const float gcj = vec[128 + j];
#pragma unroll
            for (int rgi = 0; rgi < 4; ++rgi) {
                const int i = 16 * rt + 4 * kg + rgi;
                const float dec = (i >= j) ? __expf(vec[128 + i] - gcj) : 0.f;
                L[i * 64 + j] = (i > j) ? vec[64 + i] * kk[rgi] * dec : 0.f;
                const int sp = ct >> 1, kgp = fr >> 2, j8 = (ct & 1) * 4 + (fr & 3), lanep = 16 * kgp + 4 * kg + rgi;
                AF[((rt * 2 + sp) * 64 + lanep) * 8 + j8] = (h16)(qk[rgi] * dec);
            }
        }
    }
    __syncthreads();
    h16* Tw = (h16*)L; h16* Tu = Tw + 4096;
    if (w4 == 0) {
        float X[64];
#pragma unroll
        for (int i = 0; i < 64; ++i) X[i] = 0.f;
        f32x4 Ln[16]; float rn = (lane == 0) ? 1.f : 0.f;
#pragma unroll
        for (int i = 0; i < 64; ++i) {
            f32x4 Lc[16]; const float rc = rn;
#pragma unroll
            for (int jj = 0; jj < (i + 3) / 4; ++jj) Lc[jj] = Ln[jj];
            if (i + 1 < 64) {
#pragma unroll
                for (int jj = 0; jj < (i + 4) / 4; ++jj) Ln[jj] = *(const f32x4*)(L + (i + 1) * 64 + 4 * jj);
                rn = (lane == i + 1) ? 1.f : 0.f;
            }
            float a0 = rc, a1 = 0.f, a2 = 0.f, a3 = 0.f;
#pragma unroll
            for (int jj = 0; jj < (i + 3) / 4; ++jj) { a0 -= Lc[jj][0] * X[4 * jj]; a1 -= Lc[jj][1] * X[4 * jj + 1]; a2 -= Lc[jj][2] * X[4 * jj + 2]; a3 -= Lc[jj][3] * X[4 * jj + 3]; }
            float acc = (a0 + a1) + (a2 + a3);
            asm volatile("" : "+v"(acc) :: "memory");
            X[i] = acc;
        }
        const float bu = vec[64 + lane], bw = bu * vec[192 + lane];
#pragma unroll
        for (int i = 0; i < 64; ++i) { const int pos = i * 64 + ((((lane >> 3) ^ (i & 7)) << 3) | (lane & 7)); Tw[pos] = (h16)(X[i] * bw); Tu[pos] = (h16)(X[i] * bu); }
    } else {
        const int t3 = tl - 64;
        h16* QF = (h16*)(rec + REC_QF);
        for (int f = t3; f < 1024; f += 192) { const int lanep = f & 63, s = (f >> 6) & 3, rt = f >> 8; const int row = 16 * rt + (lanep & 15), kgp = lanep >> 4;
            const h16x4 a = *(const h16x4*)(Qn + row * 136 + 32 * s + 4 * kgp), c = *(const h16x4*)(Qn + row * 136 + 32 * s + 16 + 4 * kgp);
            h16x8 o; o[0] = a[0]; o[1] = a[1]; o[2] = a[2]; o[3] = a[3]; o[4] = c[0]; o[5] = c[1]; o[6] = c[2]; o[7] = c[3];
            *(h16x8*)(QF + (size_t)f * 8) = o; }
        h16* KTF = (h16*)(rec + REC_KTF);
        for (int f = t3; f < 1024; f += 192) { const int lanep = f & 63, sp = (f >> 6) & 1, rt = f >> 7; const int d = 16 * rt + (lanep & 15), kgp = lanep >> 4;
            h16x8 o;
#pragma unroll
            for (int j8 = 0; j8 < 8; ++j8) { const int c = 32 * sp + (j8 < 4 ? 4 * kgp + j8 : 16 + 4 * kgp + (j8 - 4)); o[j8] = Kn[c * 136 + d]; }
            *(h16x8*)(KTF + (size_t)f * 8) = o; }
    }
    __syncthreads();
    {
        const int rt = w4, fr = lane & 15, kg = lane >> 4, q4 = fr >> 2, pp = fr & 3;
        const LAS unsigned char* Knl = (const LAS unsigned char*)Kn; const LAS unsigned char* Vl = (const LAS unsigned char*)Vh;
        const int trow = 16 * rt + fr;
        h16x8 Tuf[2], Twf[2];
#pragma unroll
        for (int s = 0; s < 2; ++s) { const int off = trow * 64 + ((((4 * s + kg) ^ (trow & 7))) << 3); Tuf[s] = *(const h16x8*)(Tu + off); Twf[s] = *(const h16x8*)(Tw + off); }
        h16* UF = (h16*)(rec + REC_UF);
#pragma unroll
        for (int dvb = 0; dvb < 8; ++dvb) {
            f32x4 acc = (f32x4){0.f, 0.f, 0.f, 0.f};
#pragma unroll
            for (int s = 0; s < 2; ++s) { const LAS unsigned char* a0 = Vl + ((32 * s + 8 * kg + q4) * 136 + 16 * dvb + 4 * pp) * 2;
                const h16x4 lo = lds_tr16(a0), hi4 = lds_tr16(a0 + 4 * 136 * 2);
                h16x8 Bv; Bv[0] = lo[0]; Bv[1] = lo[1]; Bv[2] = lo[2]; Bv[3] = lo[3]; Bv[4] = hi4[0]; Bv[5] = hi4[1]; Bv[6] = hi4[2]; Bv[7] = hi4[3];
                acc = __builtin_amdgcn_mfma_f32_16x16x32_f16(Tuf[s], Bv, acc, 0, 0, 0); }
            h16x4 o; o[0] = (h16)acc[0]; o[1] = (h16)acc[1]; o[2] = (h16)acc[2]; o[3] = (h16)acc[3];
            *(h16x4*)(UF + (size_t)((dvb * 4 + rt) * 64 + lane) * 4) = o;
        }
        h16* WF = (h16*)(rec + REC_WF);
#pragma unroll
        for (int so = 0; so < 4; ++so) {
            f32x4 c0 = (f32x4){0.f, 0.f, 0.f, 0.f}, c1 = (f32x4){0.f, 0.f, 0.f, 0.f};
#pragma unroll
            for (int s = 0; s < 2; ++s) {
                const LAS unsigned char* a0 = Knl + ((32 * s + 8 * kg + q4) * 136 + 16 * (2 * so) + 4 * pp) * 2;
                const h16x4 l0 = lds_tr16(a0), h0 = lds_tr16(a0 + 4 * 136 * 2), l1 = lds_tr16(a0 + 32), h1 = lds_tr16(a0 + 32 + 4 * 136 * 2);
                h16x8 A0, A1; A0[0] = l0[0]; A0[1] = l0[1]; A0[2] = l0[2]; A0[3] = l0[3]; A0[4] = h0[0]; A0[5] = h0[1]; A0[6] = h0[2]; A0[7] = h0[3];
                A1[0] = l1[0]; A1[1] = l1[1]; A1[2] = l1[2]; A1[3] = l1[3]; A1[4] = h1[0]; A1[5] = h1[1]; A1[6] = h1[2]; A1[7] = h1[3];
                c0 = __builtin_amdgcn_mfma_f32_16x16x32_f16(A0, Twf[s], c0, 0, 0, 0); c1 = __builtin_amdgcn_mfma_f32_16x16x32_f16(A1, Twf[s], c1, 0, 0, 0);
            }
            *(h16x8*)(WF + (size_t)((rt * 4 + so) * 64 + lane) * 8) = pack8(-c0, -c1);
        }
    }
}

__device__ __forceinline__ void gdn_scan_task(const Params& p, unsigned char* smem, int bh) {
    const int tid = opaque_tid(), wid = __builtin_amdgcn_readfirstlane(tid >> 6), lane = tid & 63, kg = lane >> 4, fr = lane & 15;
    const int b = bh >> 3, h = bh & 7;
    LAS unsigned char* lds = (LAS unsigned char*)smem;
    const unsigned char* rec0 = p.ws + OFF_REC + (size_t)(bh * 64) * REC_BYTES;
    h16* OB = (h16*)(smem + 2 * REC_DMA);
    const h16* gz = (const h16*)(p.ws + OFF_GZ); h16* omix = (h16*)(p.ws + OFF_OMIX);
    f32x4 Sacc[8];
#pragma unroll
    for (int t = 0; t < 8; ++t) Sacc[t] = (f32x4){0.f, 0.f, 0.f, 0.f};
    h16x4 Uc[4], Un[4];
    __syncthreads();
#define GDN_GLDS(recp, bufi) do { _Pragma("unroll") for (int _i = 0; _i < 7; ++_i) \
        __builtin_amdgcn_global_load_lds((const unsigned*)((recp) + (size_t)(_i * 512 + tid) * 16), (LAS unsigned*)(lds + (bufi) * REC_DMA + (_i * 512 + wid * 64) * 16), 16, 0, 0); \
        if (wid == 0) __builtin_amdgcn_global_load_lds((const unsigned*)((recp) + (size_t)(7 * 512 + tid) * 16), (LAS unsigned*)(lds + (bufi) * REC_DMA + (7 * 512) * 16), 16, 0, 0); } while (0)
#define GDN_LDREG(recp, U_) do { _Pragma("unroll") for (int rt = 0; rt < 4; ++rt) U_[rt] = *(const h16x4*)((recp) + REC_UF + (size_t)((wid * 4 + rt) * 64 + lane) * 8); } while (0)
#define GDN_LDGZ(dst, chunk) do { const h16* gp_ = gz + ((size_t)b * NT + 64 * (chunk) + prow) * 1024 + h * 128 + 16 * pseg; dst[0] = *(const h16x8*)gp_; dst[1] = *(const h16x8*)(gp_ + 8); } while (0)
#define GDN_POST(chunk, gzv) do { const h16* Ob = OB + ((chunk) & 1) * 8192 + prow * 128 + 16 * pseg; const h16x8 a0 = *(const h16x8*)Ob, a1 = *(const h16x8*)(Ob + 8); \
        float ngv[16]; _Pragma("unroll") for (int j = 0; j < 4; ++j) { const f32x4 t4 = *(const f32x4*)(ngl + 16 * pseg + 4 * j); ngv[4 * j] = t4[0]; ngv[4 * j + 1] = t4[1]; ngv[4 * j + 2] = t4[2]; ngv[4 * j + 3] = t4[3]; } \
        float ss = 0.f; _Pragma("unroll") for (int j = 0; j < 8; ++j) { const float u0 = (float)a0[j], u1 = (float)a1[j]; ss += u0 * u0 + u1 * u1; } \
        ss += __shfl_xor(ss, 1); ss += __shfl_xor(ss, 2); ss += __shfl_xor(ss, 4); const float r = __builtin_amdgcn_rsqf(ss * (1.0f / 128.0f) + EPS); \
        h16x8 o0, o1; _Pragma("unroll") for (int j = 0; j < 8; ++j) { o0[j] = (h16)((float)a0[j] * r * ngv[j] * (float)gzv[0][j]); o1[j] = (h16)((float)a1[j] * r * ngv[8 + j] * (float)gzv[1][j]); } \
        h16* op_ = omix + ((size_t)b * NT + 64 * (chunk) + prow) * 2048 + h * 128 + 16 * pseg; *(h16x8*)op_ = o0; *(h16x8*)(op_ + 8) = o1; } while (0)
#define GDN_RD8(X, off0) do { _Pragma("unroll") for (int _j = 0; _j < 8; ++_j) X[_j] = *(const LAS h16x8*)(bufp + (off0) + (_j * 64 + lane) * 16); } while (0)
#define GDN_SB __builtin_amdgcn_sched_barrier(0)
    h16x8 gzp[2], gzn[2];
    const int prow = tid >> 3, pseg = tid & 7;
    float* ngl = (float*)(smem + 2 * REC_DMA + 32768);
    if (tid < 128) ngl[tid] = p.gdn_norm_g[tid];
    GDN_GLDS(rec0, 0);
    GDN_LDREG(rec0, Uc);
    asm volatile("s_waitcnt vmcnt(0)" ::: "memory");
    __syncthreads();
    for (int n = 0; n < 64; ++n) {
        const unsigned char* recn = rec0 + (size_t)(n + 1) * REC_BYTES;
        if (n + 1 < 64) { GDN_GLDS(recn, (n + 1) & 1); GDN_LDREG(recn, Un); }
        GDN_LDGZ(gzn, n);
        if (n > 0) GDN_POST(n - 1, gzp);
        const LAS unsigned char* bufp = lds + (n & 1) * REC_DMA;
        h16x8 X[8], Y[8];
        GDN_RD8(X, REC_WF);
        h16x8 SB[4];
#pragma unroll
        for (int s = 0; s < 4; ++s) SB[s] = pack8(Sacc[2 * s], Sacc[2 * s + 1]);
        f32x4 vacc[4], oacc[4];
#pragma unroll
        for (int rt = 0; rt < 4; ++rt) { vacc[rt] = (f32x4){(float)Uc[rt][0], (float)Uc[rt][1], (float)Uc[rt][2], (float)Uc[rt][3]}; oacc[rt] = (f32x4){0.f, 0.f, 0.f, 0.f}; }
        GDN_SB;
        GDN_RD8(Y, REC_WF + 8192);
#pragma unroll
        for (int j = 0; j < 8; ++j) vacc[j >> 2] = __builtin_amdgcn_mfma_f32_16x16x32_f16(X[j], SB[j & 3], vacc[j >> 2], 0, 0, 0);
        GDN_SB;
        GDN_RD8(X, REC_QF);
#pragma unroll
        for (int j = 0; j < 8; ++j) vacc[2 + (j >> 2)] = __builtin_amdgcn_mfma_f32_16x16x32_f16(Y[j], SB[j & 3], vacc[2 + (j >> 2)], 0, 0, 0);
        GDN_SB;
        GDN_RD8(Y, REC_QF + 8192);
        f32x4 ekv[4], egv[4];
#pragma unroll
        for (int rt = 0; rt < 4; ++rt) { ekv[rt] = *(const LAS f32x4*)(bufp + REC_VEC + 256 + (16 * rt + 4 * kg) * 4); egv[rt] = *(const LAS f32x4*)(bufp + REC_VEC + (16 * rt + 4 * kg) * 4); }
        const float eglc = *(const LAS float*)(bufp + REC_VEC + 512);
#pragma unroll
        for (int j = 0; j < 8; ++j) oacc[j >> 2] = __builtin_amdgcn_mfma_f32_16x16x32_f16(X[j], SB[j & 3], oacc[j >> 2], 0, 0, 0);
        GDN_SB;
        GDN_RD8(X, REC_KTF);
        h16x8 VB[2], VKB[2];
#pragma unroll
        for (int sp = 0; sp < 2; ++sp) { VB[sp] = pack8(vacc[2 * sp], vacc[2 * sp + 1]); VKB[sp] = pack8(vacc[2 * sp] * ekv[2 * sp], vacc[2 * sp + 1] * ekv[2 * sp + 1]); }
#pragma unroll
        for (int j = 0; j < 8; ++j) oacc[2 + (j >> 2)] = __builtin_amdgcn_mfma_f32_16x16x32_f16(Y[j], SB[j & 3], oacc[2 + (j >> 2)], 0, 0, 0);
        GDN_SB;
        GDN_RD8(Y, REC_KTF + 8192);
#pragma unroll
        for (int t = 0; t < 8; ++t) Sacc[t] = Sacc[t] * eglc;
#pragma unroll
        for (int j = 0; j < 8; ++j) Sacc[j >> 1] = __builtin_amdgcn_mfma_f32_16x16x32_f16(X[j], VKB[j & 1], Sacc[j >> 1], 0, 0, 0);
        GDN_SB;
        GDN_RD8(X, REC_AF);
#pragma unroll
        for (int rt = 0; rt < 4; ++rt) oacc[rt] = oacc[rt] * egv[rt];
#pragma unroll
        for (int j = 0; j < 8; ++j) Sacc[4 + (j >> 1)] = __builtin_amdgcn_mfma_f32_16x16x32_f16(Y[j], VKB[j & 1], Sacc[4 + (j >> 1)], 0, 0, 0);
        GDN_SB;
#pragma unroll
        for (int j = 0; j < 8; ++j) oacc[j >> 1] = __builtin_amdgcn_mfma_f32_16x16x32_f16(X[j], VB[j & 1], oacc[j >> 1], 0, 0, 0);
        { h16* Ob = OB + (n & 1) * 8192;
#pragma unroll
          for (int rt = 0; rt < 4; ++rt)
#pragma unroll
              for (int rgi = 0; rgi < 4; ++rgi) Ob[(16 * rt + 4 * kg + rgi) * 128 + 16 * wid + fr] = (h16)oacc[rt][rgi]; }
        asm volatile("s_waitcnt vmcnt(0)" ::: "memory");
        __syncthreads();
#pragma unroll
        for (int rt = 0; rt < 4; ++rt) Uc[rt] = Un[rt];
        gzp[0] = gzn[0]; gzp[1] = gzn[1];
    }
    GDN_POST(63, gzp);
#undef GDN_LDGZ
#undef GDN_POST
#undef GDN_RD8
#undef GDN_SB
#undef GDN_GLDS
#undef GDN_LDREG
}

__device__ __forceinline__ unsigned f2key(float x) { const unsigned u = __float_as_uint(x); return (u & 0x80000000u) ? ~u : (u | 0x80000000u); }
typedef float f32x16 __attribute__((ext_vector_type(16)));
__device__ __forceinline__ float wave_min(float v) {
#pragma unroll
    for (int o = 1; o < 64; o <<= 1) v = fminf(v, __shfl_xor(v, o));
    return v;
}
__device__ __forceinline__ unsigned lane_below(unsigned long long m) { return __builtin_amdgcn_mbcnt_hi((unsigned)(m >> 32), __builtin_amdgcn_mbcnt_lo((unsigned)m, 0u)); }
__device__ __forceinline__ void idx8_task(const Params& p, unsigned char* smem, int b, int qb) {
    const int tid = opaque_tid(), wid = __builtin_amdgcn_readfirstlane(tid >> 6), lane = tid & 63;
    const int t0 = qb * 8;
    unsigned short* selg = (unsigned short*)(p.ws + OFF_SEL) + ((size_t)b * NT + t0) * 256;
    if (t0 + 8 <= 256) {
        for (int i = tid; i < 8 * 256; i += 512) { const int q = i >> 8, k = i & 255; selg[i] = (unsigned short)(k <= t0 + q ? k : 0); }
        return;
    }
    float* sc = (float*)smem;
    ACC_T0();
    unsigned* hist = (unsigned*)(smem + 131072 + wid * 2560);
    unsigned* cand = hist + 256;
    __syncthreads();
    {
        const int n8 = t0 + 8;
        const int ntile = (n8 + 31) >> 5, ntile_pad = ((n8 + 255) >> 8) << 3;
        const h16* iq = (const h16*)(p.ws + OFF_IQ) + ((size_t)b * NT + t0) * 1024;
        const float* iw = (const float*)(p.ws + OFF_IW) + ((size_t)b * NT + t0) * 16;
        const h16* ik = (const h16*)(p.ws + OFF_IK) + (size_t)b * NT * 64;
        const int r = lane & 31, kh = lane >> 5, qq = (r >> 2) & 1, hh = (r & 3) + 4 * (r >> 3);
        h16x8 Af[4][4]; h16x2 Wp[4][8];
#pragma unroll
        for (int a = 0; a < 4; ++a) {
#pragma unroll
            for (int s = 0; s < 4; ++s) Af[a][s] = *(const h16x8*)(iq + (size_t)(2 * a + qq) * 1024 + hh * 64 + 16 * s + 8 * kh);
#pragma unroll
            for (int c = 0; c < 4; ++c) { const f32x4 w4 = *(const f32x4*)(iw + (size_t)(2 * a + kh) * 16 + 4 * c);
                Wp[a][2 * c] = (h16x2){(h16)w4[0], (h16)w4[1]}; Wp[a][2 * c + 1] = (h16x2){(h16)w4[2], (h16)w4[3]}; }
        }
#define IDX_LOADB(Bx, ti) do { if ((ti) < ntile) { _Pragma("unroll") for (int s = 0; s < 4; ++s) Bx[s] = *(const h16x8*)(ik + (size_t)(32 * (ti) + r) * 64 + 16 * s + 8 * kh); } } while (0)
#define IDX_COMP(Bx, ti) do { if ((ti) < ntile) { const int key = 32 * (ti) + r; f32x16 accs[4]; \
            _Pragma("unroll") for (int a = 0; a < 4; ++a) { _Pragma("unroll") for (int e = 0; e < 16; ++e) accs[a][e] = 0.f; \
                _Pragma("unroll") for (int s = 0; s < 4; ++s) accs[a] = __builtin_amdgcn_mfma_f32_32x32x16_f16(Af[a][s], Bx[s], accs[a], 0, 0, 0); } \
            __builtin_amdgcn_sched_barrier(0); \
            _Pragma("unroll") for (int a = 0; a < 4; ++a) { \
                float s0 = 0.f, s1 = 0.f; _Pragma("unroll") for (int e = 0; e < 8; e += 2) { h16x2 rp = (h16x2){(h16)accs[a][2 * e], (h16)accs[a][2 * e + 1]}; rp = __builtin_elementwise_max(rp, (h16x2){(h16)0.f, (h16)0.f}); s0 = __builtin_amdgcn_fdot2(rp, Wp[a][e], s0, false); \
                    h16x2 rq = (h16x2){(h16)accs[a][2 * e + 2], (h16)accs[a][2 * e + 3]}; rq = __builtin_elementwise_max(rq, (h16x2){(h16)0.f, (h16)0.f}); s1 = __builtin_amdgcn_fdot2(rq, Wp[a][e + 1], s1, false); } \
                const int q = 2 * a + kh; sc[q * 4096 + key] = (key > t0 + q) ? -INFINITY : (s0 + s1); } } } while (0)
        {
            h16x8 B0[4], B1[4], B2[4];
            IDX_LOADB(B0, wid); IDX_LOADB(B1, wid + 8);
            for (int i = wid; i < ntile; i += 24) {
                IDX_LOADB(B2, i + 16); IDX_COMP(B0, i);
                IDX_LOADB(B0, i + 24); IDX_COMP(B1, i + 8);
                IDX_LOADB(B1, i + 32); IDX_COMP(B2, i + 16);
            }
            for (int i = ntile + wid; i < ntile_pad; i += 8) {
#pragma unroll
                for (int a = 0; a < 4; ++a) sc[(2 * a + kh) * 4096 + 32 * i + r] = -INFINITY;
            }
        }
#undef IDX_LOADB
#undef IDX_COMP
    }
    __syncthreads();
    ACC_ADD(1);
    {
        const int tq = t0 + wid, n = tq + 1;
        const float* row = sc + wid * 4096;
        const int ng = (n + 255) >> 8;
        f32x4 x[16];
#pragma unroll
        for (int g = 0; g < 16; ++g) { if (g < ng) x[g] = *(const f32x4*)(row + 256 * g + 4 * lane); else x[g] = (f32x4){-INFINITY, -INFINITY, -INFINITY, -INFINITY}; }
        float hi = -INFINITY, lo = INFINITY;
#pragma unroll
        for (int g = 0; g < 16; ++g)
#pragma unroll
            for (int c = 0; c < 4; ++c) { const float v = x[g][c]; hi = fmaxf(hi, v); lo = fminf(lo, v == -INFINITY ? INFINITY : v); }
        hi = wave_max(hi); lo = wave_min(lo);
        const float scale = (hi > lo) ? 255.99f / (hi - lo) : 0.f; const float off = -lo * scale;
        *(u32x4*)(hist + 4 * lane) = (u32x4){0u, 0u, 0u, 0u};
#pragma unroll
        for (int g = 0; g < 16; ++g) { if (g < ng) {
#pragma unroll
            for (int c = 0; c < 4; ++c) { int bin = (int)fmaf(x[g][c], scale, off); bin = bin < 0 ? 0 : (bin > 255 ? 255 : bin); atomicAdd(&hist[bin], 1u); } } }
        unsigned bstar, need;
        {
            const u32x4 h4 = *(const u32x4*)(hist + 4 * lane); const unsigned s = h4[0] + h4[1] + h4[2] + h4[3];
            unsigned suf = s;
#pragma unroll
            for (int o = 1; o < 64; o <<= 1) { const unsigned tt = __shfl_down(suf, o); if (lane + o < 64) suf += tt; }
            const unsigned above = suf - s;
            const bool mine = (above < 256u && 256u <= suf);
            unsigned cum = above; unsigned bin = 0;
            if (cum + h4[3] >= 256u) bin = 3; else { cum += h4[3]; if (cum + h4[2] >= 256u) bin = 2; else { cum += h4[2]; if (cum + h4[1] >= 256u) bin = 1; else { cum += h4[1]; bin = 0; } } }
            const unsigned long long mm = __ballot(mine);
            const int src = (int)__builtin_ctzll(mm);
            bstar = (unsigned)__shfl((int)(4 * lane + bin), src); need = (unsigned)__shfl((int)(256u - cum), src);
        }
        unsigned short* so = selg + (size_t)wid * 256;
        unsigned short* cidx = (unsigned short*)(cand + 256);
        unsigned m = 0, outb = 0;
#pragma unroll
        for (int g = 0; g < 16; ++g) { if (g < ng) {
#pragma unroll
            for (int c = 0; c < 4; ++c) { int bin = (int)fmaf(x[g][c], scale, off); bin = bin < 0 ? 0 : (bin > 255 ? 255 : bin);
                const bool gt = ((unsigned)bin > bstar), pr = ((unsigned)bin == bstar);
                const unsigned long long mg = __ballot(gt), mk = __ballot(pr);
                if (mg) { const unsigned pos = outb + lane_below(mg); if (gt) so[pos] = (unsigned short)(256 * g + 4 * lane + c); outb += (unsigned)__builtin_popcountll(mg); }
                if (mk) { const unsigned pos = m + lane_below(mk); if (pr && pos < 256u) { cand[pos] = f2key(x[g][c]); cidx[pos] = (unsigned short)(256 * g + 4 * lane + c); } m += (unsigned)__builtin_popcountll(mk); } } } }
        unsigned Kt = 0, rr = need;
        if (m <= 256u) {
            const int nc = (int)((m + 63u) >> 6);
            unsigned cv[4]; unsigned short ci[4];
#pragma unroll
            for (int j = 0; j < 4; ++j) { const bool in = (64 * j + lane < (int)m); cv[j] = in ? cand[64 * j + lane] : 0u; ci[j] = in ? cidx[64 * j + lane] : (unsigned short)0; }
            for (int bit = 31; bit >= 0; --bit) {
                const unsigned test = (Kt | (1u << bit)) >> bit;
                unsigned cnt = (unsigned)__builtin_popcountll(__ballot((cv[0] >> bit) == test));
                if (nc > 1) cnt += (unsigned)__builtin_popcountll(__ballot((cv[1] >> bit) == test));
                if (nc > 2) cnt += (unsigned)__builtin_popcountll(__ballot((cv[2] >> bit) == test));
                if (nc > 3) cnt += (unsigned)__builtin_popcountll(__ballot((cv[3] >> bit) == test));
                if (cnt >= rr) Kt |= (1u << bit); else rr -= cnt;
            }
            unsigned eqb = 0;
#pragma unroll
            for (int j = 0; j < 4; ++j) { if (j < nc) { const bool in = (64 * j + lane < (int)m); const bool gt = in && cv[j] > Kt, eq = in && cv[j] == Kt;
                const unsigned long long me = __ballot(eq); bool take = gt;
                if (me) { const unsigned er = eqb + lane_below(me); take = gt || (eq && er < rr); eqb += (unsigned)__builtin_popcountll(me); }
                const unsigned long long mt = __ballot(take);
                if (mt) { const unsigned pos = outb + lane_below(mt); if (take) so[pos] = ci[j]; outb += (unsigned)__builtin_popcountll(mt); } } }
        } else {
            for (int bit = 31; bit >= 0; --bit) {
                const unsigned test = (Kt | (1u << bit)) >> bit; unsigned cnt = 0;
                for (int idx = lane; idx < ng * 256; idx += 64) { const float v = row[idx]; int bin = (int)fmaf(v, scale, off); bin = bin < 0 ? 0 : (bin > 255 ? 255 : bin);
                    const bool pr = ((unsigned)bin == bstar) && ((f2key(v) >> bit) == test); cnt += (unsigned)__builtin_popcountll(__ballot(pr)); }
                if (cnt >= rr) Kt |= (1u << bit); else rr -= cnt;
            }
            unsigned eqb = 0;
            for (int idx = lane; idx < ng * 256; idx += 64) { const float v = row[idx]; int bin = (int)fmaf(v, scale, off); bin = bin < 0 ? 0 : (bin > 255 ? 255 : bin);
                const unsigned k = f2key(v); const bool inb = ((unsigned)bin == bstar); const bool gt = inb && k > Kt, eq = inb && k == Kt;
                const unsigned long long me = __ballot(eq); bool take = gt;
                if (me) { const unsigned er = eqb + lane_below(me); take = gt || (eq && er < rr); eqb += (unsigned)__builtin_popcountll(me); }
                const unsigned long long mt = __ballot(take);
                if (mt) { const unsigned pos = outb + lane_below(mt); if (take) so[pos] = (unsigned short)idx; outb += (unsigned)__builtin_popcountll(mt); } }
        }
    }
    __syncthreads();
    ACC_ADD(2);
}

typedef unsigned short u16x4 __attribute__((ext_vector_type(4)));
typedef unsigned short u16x8 __attribute__((ext_vector_type(8)));
__device__ __forceinline__ void attn8_task(const Params& p, unsigned char* smem, int part, int o) {
    const int tid = opaque_tid(), wid = __builtin_amdgcn_readfirstlane(tid >> 6), lane = tid & 63, kg = lane >> 4, fr = lane & 15;
    const int b = part >> 1, g = part & 1;
    unsigned char* vl = smem + wid * 17408;
    LAS unsigned char* vll = (LAS unsigned char*)vl;
    const char* akb = (const char*)(p.ws + OFF_AK) + (size_t)b * NT * 256 + g * 128;
    const char* avb = (const char*)(p.ws + OFF_AV) + (size_t)b * NT * 256 + g * 128;
    typedef long i64x2 __attribute__((ext_vector_type(2)));
    constexpr int NQW = 1;
    const int tq0 = 8 * NQW * o + NQW * wid;
    u16x4 kix[4], kixn[4];
#define AT_LOADI(tt, KI) do { const unsigned short* sel_ = (const unsigned short*)(p.ws + OFF_SEL) + ((size_t)b * NT + (tt)) * 256; \
        _Pragma("unroll") for (int c = 0; c < 4; ++c) KI[c] = *(const u16x4*)(sel_ + 64 * c + 4 * fr); } while (0)
    AT_LOADI(tq0, kix);
#pragma unroll 1
    for (int qi = 0; qi < NQW; ++qi) {
    const int t = tq0 + qi; const int bt = b * NT + t; const int nvalid = (t + 1) < 256 ? (t + 1) : 256;
    const unsigned short* sel = (const unsigned short*)(p.ws + OFF_SEL) + (size_t)bt * 256;
    long Qf[4];
    { const char* qp_ = (const char*)(p.ws + OFF_AQ) + (size_t)bt * 1024 + (4 * g + (fr & 3)) * 128 + kg * 32; const i64x2 q0 = *(const i64x2*)qp_, q1 = *(const i64x2*)(qp_ + 16);
      Qf[0] = fr < 4 ? q0[0] : 0l; Qf[1] = fr < 4 ? q0[1] : 0l; Qf[2] = fr < 4 ? q1[0] : 0l; Qf[3] = fr < 4 ? q1[1] : 0l; }
    f32x4 lg[16];
#define AT_LOADK(Kx, c) do { _Pragma("unroll") for (int ii = 0; ii < 4; ++ii) { const char* kp = akb + (unsigned)kix[c][ii] * 256u + 32u * (unsigned)kg; \
        const i64x2 t0 = *(const i64x2*)kp, t1 = *(const i64x2*)(kp + 16); Kx[ii][0] = t0[0]; Kx[ii][1] = t0[1]; Kx[ii][2] = t1[0]; Kx[ii][3] = t1[1]; } } while (0)
#define AT_MMAK(Kx, c) do { _Pragma("unroll") for (int ii = 0; ii < 4; ++ii) { f32x4 a = (f32x4){0.f, 0.f, 0.f, 0.f}; \
        _Pragma("unroll") for (int s = 0; s < 4; ++s) a = __builtin_amdgcn_mfma_f32_16x16x32_fp8_fp8(Kx[ii][s], Qf[s], a, 0, 0, 0); lg[4 * (c) + ii] = a; } } while (0)
#define AT_LOADV(Vx, c) do { const u16x8 i0 = *(const u16x8*)(sel + 64 * (c) + 8 * (lane >> 3)); \
        _Pragma("unroll") for (int it = 0; it < 8; ++it) Vx[it] = *(const u32x4*)(avb + (unsigned)i0[it] * 256u + 16u * (unsigned)(lane & 7)); } while (0)
    u32x4 VA[8], VB[8];
    {
        long K0[4][4], K1[4][4], K2[4][4];
        AT_LOADK(K0, 0); AT_LOADK(K1, 1); AT_LOADK(K2, 2);
        AT_MMAK(K0, 0); AT_LOADK(K0, 3);
        AT_MMAK(K1, 1); AT_LOADV(VA, 0);
        AT_MMAK(K2, 2);
        AT_MMAK(K0, 3);
    }
    float m = -INFINITY;
#pragma unroll
    for (int i = 0; i < 16; ++i)
#pragma unroll
        for (int r = 0; r < 4; ++r) { const int slot = 64 * (i >> 2) + 16 * kg + 4 * r + (i & 3); const float v = (slot < nvalid) ? lg[i][r] * (0.08838834764831845f * 1.4426950408889634f) : -INFINITY; lg[i][r] = v; m = fmaxf(m, v); }
    m = fmaxf(m, __shfl_xor(m, 16)); m = fmaxf(m, __shfl_xor(m, 32));
    float sum = 0.f;
#pragma unroll
    for (int i = 0; i < 16; ++i)
#pragma unroll
        for (int r = 0; r < 4; ++r) { const float e = __builtin_amdgcn_exp2f(lg[i][r] - m); lg[i][r] = e; sum += e; }
    sum += __shfl_xor(sum, 16); sum += __shfl_xor(sum, 32);
    const float inv = __builtin_amdgcn_rcpf(sum);
    long Pf[8];
    { const float pscale = inv * 256.0f;
#pragma unroll
      for (int ip = 0; ip < 8; ++ip) { const f32x4 x0 = lg[2 * ip] * pscale, x1 = lg[2 * ip + 1] * pscale; int w0 = 0, w1 = 0;
          w0 = __builtin_amdgcn_cvt_pk_fp8_f32(x0[0], x0[1], w0, false); w0 = __builtin_amdgcn_cvt_pk_fp8_f32(x0[2], x0[3], w0, true);
          w1 = __builtin_amdgcn_cvt_pk_fp8_f32(x1[0], x1[1], w1, false); w1 = __builtin_amdgcn_cvt_pk_fp8_f32(x1[2], x1[3], w1, true);
          Pf[ip] = (long)(((unsigned long long)(unsigned)w1 << 32) | (unsigned long long)(unsigned)w0); } }
    f32x4 O[8];
#pragma unroll
    for (int ct = 0; ct < 8; ++ct) O[ct] = (f32x4){0.f, 0.f, 0.f, 0.f};
    if (qi < NQW - 1) AT_LOADI(t + 1, kixn);
    const h16x8 gate = *(const h16x8*)((const h16*)(p.ws + OFF_AZ) + (size_t)bt * 1024 + (4 * g) * 128 + 8 * lane);
    const int q4 = fr >> 2, pp = fr & 3;
    typedef int v2i_t __attribute__((__vector_size__(2 * sizeof(int))));
#define AT_STOREV(Vx) do { _Pragma("unroll") for (int it = 0; it < 8; ++it) { const int r = 8 * (lane >> 3) + it; const int fk = ((r >> 2) & 3) | (((r >> 4) & 1) << 2); \
        *(u32x4*)(vl + r * 128 + (((lane & 7) ^ fk) << 4)) = Vx[it]; } } while (0)
#define AT_PV(c) do { _Pragma("unroll") for (int ipl = 0; ipl < 2; ++ipl) { const int qq = fr >> 1; const int r = 16 * kg + 4 * (qq & 3) + 2 * ipl + (qq >> 2); const int fk = ((r >> 2) & 3) | (((r >> 4) & 1) << 2); \
        _Pragma("unroll") for (int ct = 0; ct < 8; ++ct) { const LAS unsigned char* a0 = vll + r * 128 + ((ct ^ fk) << 4) + (fr & 1) * 8; \
            const v2i_t bv = __builtin_amdgcn_ds_read_tr8_b64_v2i32((LAS v2i_t*)a0); \
            O[ct] = __builtin_amdgcn_mfma_f32_16x16x32_fp8_fp8(Pf[2 * (c) + ipl], __builtin_bit_cast(long, bv), O[ct], 0, 0, 0); } } } while (0)
    AT_LOADV(VB, 1); AT_STOREV(VA); AT_PV(0);
    AT_LOADV(VA, 2); AT_STOREV(VB); AT_PV(1);
    AT_LOADV(VB, 3); AT_STOREV(VA); AT_PV(2);
    AT_STOREV(VB); AT_PV(3);
#undef AT_LOADK
#undef AT_MMAK
#undef AT_LOADV
#undef AT_STOREV
#undef AT_PV
    h16* ot = (h16*)vl;
    if (kg == 0) {
#pragma unroll
        for (int ct = 0; ct < 8; ++ct)
#pragma unroll
            for (int r = 0; r < 4; ++r) ot[r * 128 + 16 * ct + fr] = (h16)O[ct][r];
    }
    {
        const h16x8 ov = *(const h16x8*)(ot + 8 * lane);
        h16x8 res;
#pragma unroll
        for (int j = 0; j < 8; ++j) res[j] = (h16)((float)ov[j] * (float)gate[j] * (1.0f / 256.0f));
        *(h16x8*)((h16*)(p.ws + OFF_OMIX) + (size_t)bt * 2048 + 1024 + (4 * g) * 128 + 8 * lane) = res;
    }
#pragma unroll
    for (int c = 0; c < 4; ++c) kix[c] = kixn[c];
    }
#undef AT_LOADI
}

__device__ __forceinline__ void phase5(const Params& p) {
    const int tid = opaque_tid(), wid = tid >> 6, lane = tid & 63;
    const int gw = blockIdx.x * 8 + wid, nw = gridDim.x * 8;
    const float* rowss = (const float*)(p.ws + OFF_ROWSS);
    for (int row = gw; row < BT; row += nw) {
        const float r = 1.0f / sqrtf(rowss[row] * (1.0f / DM) + EPS);
        f32x4* o = (f32x4*)(p.out + (size_t)row * DM);
        float eadd = 0.f;
        if ((TS_A >= 0 || TS_ACC >= 0) && row < 164) { const unsigned* ts = (const unsigned*)(p.ws + OFF_CTRL + 8192); const float tus = (TS_ACC >= 0) ? (float)ts[16 + (TS_ACC >= 0 ? TS_ACC : 0)] * (0.01f / 256.0f) : (float)(ts[TS_B >= 0 ? TS_B : 0] - ts[TS_A >= 0 ? TS_A : 0]) * 0.01f; eadd = sqrtf(tus * 1e-5f); }
#pragma unroll
        for (int i = 0; i < 8; ++i) { const f32x4 g = ((const f32x4*)p.final_g)[lane + 64 * i]; f32x4 v = o[lane + 64 * i]; v = v * r * g + eadd; o[lane + 64 * i] = v; }
    }
}

#define XB_TMO      128
#define XB_XCNT(j)  (256  + 64 * (j))
#define XB_XSUB(j)  (1280 + 64 * (j))
#define XB_XGEN(j)  (2304 + 64 * (j))
#define XB_TOP      3328
#define XB_TOPGEN   3392
#define XCD_BAR_WORDS 3456
#define XB_SPIN_CAP (1u << 18)

__device__ __forceinline__ unsigned xb_ld(unsigned* p)              { return __hip_atomic_load(p, __ATOMIC_RELAXED, __HIP_MEMORY_SCOPE_AGENT); }
__device__ __forceinline__ unsigned xb_add(unsigned* p, unsigned v) { return __hip_atomic_fetch_add(p, v, __ATOMIC_RELAXED, __HIP_MEMORY_SCOPE_AGENT); }
__device__ __forceinline__ unsigned xb_xcc_id() { return (unsigned)__builtin_amdgcn_s_getreg((3 << 11) | 20) & 0xFu; }
#define XB_SPIN(cond, bar) do { unsigned _sp = 0; while (cond) { __builtin_amdgcn_s_sleep(1); \
    if ((++_sp & 255u) == 0u) { if (xb_ld(&(bar)[XB_TMO])) break; if (_sp > XB_SPIN_CAP) { atomicAdd(&(bar)[XB_TMO], 1u); break; } } } } while (0)

struct XcdBarrier {
    unsigned* bar; unsigned x;
    volatile LAS unsigned* st;
};

__device__ __forceinline__ XcdBarrier xcd_barrier_post(unsigned* bar, volatile LAS unsigned* st) {
    XcdBarrier b; b.bar = bar; b.x = xb_xcc_id(); b.st = st;
    if (threadIdx.x == 0) (void)xb_add(&bar[XB_XCNT(b.x)], 1u);
    return b;
}
__device__ __forceinline__ void xcd_barrier_complete(unsigned* bar, unsigned x, unsigned& nloc, unsigned& nx) {
    const unsigned G = gridDim.x * gridDim.y * gridDim.z;
    unsigned sum, cnt, mine, sp = 0u;
    for (;;) {
        sum = 0u; cnt = 0u; mine = 0u;
#pragma unroll
        for (unsigned j = 0; j < 16; ++j) { const unsigned c = xb_ld(&bar[XB_XCNT(j)]); sum += c; cnt += (c > 0u) ? 1u : 0u; mine = (j == x) ? c : mine; }
        if (sum == G) break;
        __builtin_amdgcn_s_sleep(1);
        if ((++sp & 255u) == 0u) { if (xb_ld(&bar[XB_TMO])) break; if (sp > XB_SPIN_CAP) { atomicAdd(&bar[XB_TMO], 1u); break; } }
    }
    nloc = mine > 0u ? mine : 1u; nx = cnt > 0u ? cnt : 1u;
}

__device__ __forceinline__ void xcd_barrier(const XcdBarrier& b) {
    asm volatile("s_waitcnt vmcnt(0)" ::: "memory");
    __syncthreads();
    if (threadIdx.x == 0) {
        unsigned* bar = b.bar;
        __builtin_amdgcn_s_waitcnt(0);
        unsigned nloc = b.st[0], nx = b.st[1];
        if (nloc == 0u) { xcd_barrier_complete(bar, b.x, nloc, nx); b.st[0] = nloc; b.st[1] = nx; }
        const unsigned old = xb_add(&bar[XB_XSUB(b.x)], 1u);
        const unsigned gen = old / nloc;
        if (old + 1u == (gen + 1u) * nloc) {
            __builtin_amdgcn_fence(__ATOMIC_RELEASE, "agent");
            asm volatile("s_waitcnt vmcnt(0)" ::: "memory");
            const unsigned og = xb_add(&bar[XB_TOP], 1u);
            const unsigned tg = og / nx;
            if (og + 1u == (tg + 1u) * nx) xb_add(&bar[XB_TOPGEN], 1u);
            else XB_SPIN(xb_ld(&bar[XB_TOPGEN]) == tg, bar);
            __builtin_amdgcn_fence(__ATOMIC_ACQUIRE, "agent");
            xb_add(&bar[XB_XGEN(b.x)], 1u);
            asm volatile("s_waitcnt vmcnt(0)" ::: "memory");
        } else {
            XB_SPIN(xb_ld(&bar[XB_XGEN(b.x)]) == gen, bar);
            __builtin_amdgcn_fence(__ATOMIC_ACQUIRE, "agent");
            asm volatile("s_waitcnt vmcnt(0)" ::: "memory");
        }
    }
    __syncthreads();
}


template <int LO, int HI>
__global__ void __launch_bounds__(512, 2) k_phases(Params p) {
    extern __shared__ __attribute__((aligned(16))) unsigned char smem[];
#define IN(k) (LO <= (k) && (k) < HI)
#define SEAM(k) do { if constexpr (IN(k) && IN((k) + 1)) { xcd_barrier(xbar); if (TS_A >= 0 && blockIdx.x == 0 && threadIdx.x == 0) ((unsigned*)(p.ws + OFF_CTRL + 8192))[(k) + 1] = (unsigned)__builtin_amdgcn_s_memrealtime(); } } while (0)
    XcdBarrier xbar; xbar.bar = nullptr; xbar.x = 0; xbar.st = nullptr;
    if constexpr (HI - LO > 1) {
        volatile LAS unsigned* stw = (volatile LAS unsigned*)((LAS unsigned char*)smem + LDS_BYTES - 48);
        if (threadIdx.x < 4) stw[threadIdx.x] = 0u;
        __syncthreads();
        xbar = xcd_barrier_post((unsigned*)(p.ws + OFF_CTRL + 16384), stw);
    }
    if (TS_A >= 0 && blockIdx.x == 0 && threadIdx.x == 0) ((unsigned*)(p.ws + OFF_CTRL + 8192))[0] = (unsigned)__builtin_amdgcn_s_memrealtime();
    if constexpr (IN(0)) { for (int rep = 0; rep < NREP(0); ++rep) phase0(p, smem); }
    SEAM(0);
    if constexpr (IN(1)) for (int rep = 0; rep < NREP(1); ++rep) {
        pg8::Gemm g{(const h16*)(p.ws + OFF_H), (const h16*)(p.ws + OFF_WT), BT, NPAD, DM};
        pg8::StaticOrder S; S.init(BT, NPAD, gridDim.x, blockIdx.x);
        EpiIn E{p.ws, p.a_log, p.dt_bias};
        pg8::gemm_phase<EpiIn, pg8::StaticOrder>((LAS unsigned char*)smem, g, S, E);
    }
    SEAM(1);
    if constexpr (IN(2)) for (int rep = 0; rep < NREP(2); ++rep) {
        {
            unsigned* qctr = (unsigned*)(p.ws + OFF_CTRL);
            volatile unsigned* lds_t = (volatile unsigned*)(smem + LDS_BYTES - 16);
            __syncthreads();
            if (threadIdx.x == 0) lds_t[0] = atomicAdd(qctr + 0 + 16 * rep, 1u);
            __syncthreads();
            unsigned o = lds_t[0];
            while (o < 1024u + 2048u) {
                unsigned nxt = 0u;
                if (threadIdx.x == 0) nxt = atomicAdd(qctr + 0 + 16 * rep, 1u);
                if (o < 1024u) { ACC_T0(); gdn_prep_pair(p, smem, (int)o); __syncthreads(); ACC_ADD(0); }
                else { const unsigned o2 = o - 1024u; idx8_task(p, smem, (int)(o2 & 3u), 511 - (int)(o2 >> 2)); }
                __syncthreads();
                if (threadIdx.x == 0) lds_t[0] = nxt;
                __syncthreads();
                o = lds_t[0];
            }
        }
    }
    SEAM(2);
    if constexpr (IN(3)) for (int rep = 0; rep < NREP(3); ++rep) {
        {
            unsigned* qctr = (unsigned*)(p.ws + OFF_CTRL);
            volatile unsigned* lds_t = (volatile unsigned*)(smem + LDS_BYTES - 16);
            volatile unsigned* lds_c = (volatile unsigned*)(smem + LDS_BYTES - 192);
            const int myx = (int)(xb_xcc_id() & 7u);
            for (int pass = 0; pass < 2; ++pass) {
                if (pass == 1) { __syncthreads(); if (threadIdx.x < 8) lds_c[8 + threadIdx.x] = __hip_atomic_load(qctr + 64 + 16 * rep + threadIdx.x, __ATOMIC_RELAXED, __HIP_MEMORY_SCOPE_AGENT); __syncthreads(); }
                const int nk = pass == 0 ? 1 : 8;
                for (int k = 0; k < nk; ++k) {
                    const int sp = (myx + k) & 7;
                    if (pass == 1 && lds_c[8 + sp] >= 4u) continue;
                    for (;;) {
                        __syncthreads();
                        if (threadIdx.x == 0) lds_t[0] = atomicAdd(qctr + 64 + 16 * rep + sp, 1u);
                        __syncthreads();
                        const unsigned o = lds_t[0];
                        if (o >= 4u) break;
                        { ACC_T0(); gdn_scan_task(p, smem, 4 * sp + (int)o); __syncthreads(); ACC_ADD(4); }
                        if (pass == 0) break;
                    }
                }
                if (pass == 0) for (int k = 0; k < 8; ++k) {
                    const int part = (myx + k) & 7;
                    if (k == 1) { __syncthreads(); if (threadIdx.x < 8) lds_c[threadIdx.x] = __hip_atomic_load(qctr + 128 + 16 * rep + threadIdx.x, __ATOMIC_RELAXED, __HIP_MEMORY_SCOPE_AGENT); __syncthreads(); }
                    if (k >= 1 && lds_c[part] >= 512u) continue;
                    __syncthreads();
                    if (threadIdx.x == 0) lds_t[0] = atomicAdd(qctr + 128 + 16 * rep + part, 1u);
                    __syncthreads();
                    unsigned a = lds_t[0];
                    while (a < 512u) {
                        unsigned nxt = 0u;
                        if (threadIdx.x == 0) nxt = atomicAdd(qctr + 128 + 16 * rep + part, 1u);
                        { ACC_T0(); attn8_task(p, smem, part, (int)a); __syncthreads(); ACC_ADD(3); }
                        __syncthreads();
                        if (threadIdx.x == 0) lds_t[0] = nxt;
                        __syncthreads();
                        a = lds_t[0];
                    }
                }
            }
        }
    }
    SEAM(3);
    const bool fuse_norm = (gridDim.x == 256) && (TS_A < 0) && (TS_ACC < 0);
    if constexpr (IN(4)) {
        pg8::Gemm g{(const h16*)(p.ws + OFF_OMIX), (const h16*)(p.ws + OFF_WOT), BT, DM, DM};
        if (fuse_norm) {
            PanelOrder S; S.c = blockIdx.x;
            EpiOutNorm E{p.x, p.out, (float*)(p.ws + OFF_ROWSS), (unsigned*)(p.ws + OFF_CTRL + 32768), p.final_g};
            pg8::gemm_phase<EpiOutNorm, PanelOrder>((LAS unsigned char*)smem, g, S, E);
        } else {
            pg8::StaticOrder S; S.init(BT, DM, gridDim.x, blockIdx.x);
            EpiOut E{p.x, p.out, (float*)(p.ws + OFF_ROWSS)};
            pg8::gemm_phase<EpiOut, pg8::StaticOrder>((LAS unsigned char*)smem, g, S, E);
        }
    }
    if (fuse_norm) return;
    SEAM(4);
    if constexpr (IN(5)) { phase5(p); }
#undef IN
#undef SEAM
}

template <int LO, int HI> static void launch_range(const Params& p, int grid, hipStream_t stream, bool coop) {
    static bool attr = false;
    if (!attr) { hipFuncSetAttribute((const void*)k_phases<LO, HI>, hipFuncAttributeMaxDynamicSharedMemorySize, LDS_BYTES); attr = true; }
    if (coop) {
        Params pp = p; void* args[] = {&pp};
        hipError_t e = hipLaunchCooperativeKernel((const void*)k_phases<LO, HI>, dim3(grid), dim3(512), args, LDS_BYTES, stream);
        if (e != hipSuccess) fprintf(stderr, "cooperative launch failed: %s (grid %d)\n", hipGetErrorString(e), grid);
    } else {
        hipLaunchKernelGGL((k_phases<LO, HI>), dim3(grid), dim3(512), LDS_BYTES, stream, p);
    }
}

extern "C" void kernel_launch(void* const* d_in, const int* in_sizes, int n_in, void* d_out, int out_size, void* d_ws, size_t ws_size, hipStream_t stream) {
    if (n_in != 10 || in_sizes[0] != BT * DM || out_size != BT * DM || ws_size < WS_END) {
        fprintf(stderr, "kernel_launch: unexpected shapes (n_in %d in0 %d out %d ws %zu need %zu)\n", n_in, n_in > 0 ? in_sizes[0] : -1, out_size, ws_size, (size_t)WS_END); return; }
    static int grid = 0;
    if (!grid) {
        int dev = 0, cus = 0, per_cu = 0; hipGetDevice(&dev); hipDeviceGetAttribute(&cus, hipDeviceAttributeMultiprocessorCount, dev);
#if FUSED
        hipFuncSetAttribute((const void*)k_phases<0, 6>, hipFuncAttributeMaxDynamicSharedMemorySize, LDS_BYTES);
        hipOccupancyMaxActiveBlocksPerMultiprocessor(&per_cu, (const void*)k_phases<0, 6>, 512, LDS_BYTES);
#else
        per_cu = 1;
#endif
        if (per_cu < 1) per_cu = 1; if (per_cu > 1) per_cu = 1;
        grid = cus * per_cu;
    }
    Params p{};
    p.x = (const float*)d_in[0]; p.pos = (const int*)d_in[1]; p.attn_g = (const float*)d_in[2]; p.w_in = (const float*)d_in[3]; p.conv_w = (const float*)d_in[4];
    p.a_log = (const float*)d_in[5]; p.dt_bias = (const float*)d_in[6]; p.gdn_norm_g = (const float*)d_in[7]; p.w_out = (const float*)d_in[8]; p.final_g = (const float*)d_in[9];
    p.out = (float*)d_out; p.ws = (unsigned char*)d_ws;
    hipMemsetAsync((char*)d_ws + OFF_CTRL, 0, CTL_ZERO_BYTES, stream);
#if FUSED
    launch_range<0, 6>(p, grid, stream, false);
#else
    launch_range<0, 1>(p, grid, stream, false);
    launch_range<1, 2>(p, grid, stream, false);
    launch_range<2, 3>(p, grid, stream, false);
    launch_range<3, 4>(p, grid, stream, false);
    launch_range<4, 5>(p, grid, stream, false);
    launch_range<5, 6>(p, grid, stream, false);
#endif
}
```

```cpp
#include <hip/hip_runtime.h>
#include <hip/hip_cooperative_groups.h>
#include <cstdio>
#include <cstdint>
namespace cg = cooperative_groups;

#ifndef FUSED
#define FUSED 1
#endif
#ifndef REPEAT_PHASE
#define REPEAT_PHASE -1
#endif
#define NREP(k) ((REPEAT_PHASE == (k)) ? 2 : 1)
#ifndef TS_A
#define TS_A -1
#endif
#ifndef TS_ACC
#define TS_ACC -1
#endif
#define ACC_T0() unsigned acc_t0_ = 0; if (TS_ACC >= 0 && threadIdx.x == 0) acc_t0_ = (unsigned)__builtin_amdgcn_s_memrealtime()
#define ACC_ADD(k) do { if (TS_ACC >= 0 && threadIdx.x == 0) { const unsigned t1_ = (unsigned)__builtin_amdgcn_s_memrealtime(); atomicAdd((unsigned*)(p.ws + OFF_CTRL + 8192) + 16 + (k), t1_ - acc_t0_); acc_t0_ = t1_; } } while (0)
#ifndef TS_B
#define TS_B -1
#endif

#define LAS __attribute__((address_space(3)))
typedef _Float16 h16;
typedef h16 h16x8 __attribute__((ext_vector_type(8)));
typedef h16 h16x4 __attribute__((ext_vector_type(4)));
typedef h16 h16x2 __attribute__((ext_vector_type(2)));
typedef float f32x4 __attribute__((ext_vector_type(4)));
typedef float f32x2 __attribute__((ext_vector_type(2)));
typedef unsigned u32x4 __attribute__((ext_vector_type(4)));

constexpr int NB = 4, NT = 4096, DM = 2048, BT = NB * NT;
constexpr int IN_COLS = 7776, NPAD = 7936;
constexpr float EPS = 1e-6f;
constexpr int LDS_BYTES = 155648;

constexpr size_t MB = 1024 * 1024;
constexpr size_t OFF_CTRL = 0;
constexpr size_t OFF_ROWSS = 65536;
constexpr size_t CTL_ZERO_BYTES = 65536 + (size_t)BT * 4;
constexpr size_t OFF_H = 1 * MB;
constexpr size_t OFF_OMIX = OFF_H;
constexpr size_t OFF_WT = OFF_H + 64 * MB;
constexpr size_t OFF_WOT = OFF_WT + (size_t)NPAD * 2048 * 2;
constexpr size_t OFF_QKVR = OFF_WOT + 8 * MB;
constexpr size_t OFF_GZ = OFF_QKVR + (size_t)BT * 3072 * 2;
constexpr size_t OFF_AQ = OFF_GZ + 32 * MB;
constexpr size_t OFF_AK = OFF_AQ + 32 * MB;
constexpr size_t OFF_AV = OFF_AK + 8 * MB;
constexpr size_t OFF_AZ = OFF_AV + 8 * MB;
constexpr size_t OFF_IQ = OFF_AZ + 32 * MB;
constexpr size_t OFF_IK = OFF_IQ + 32 * MB;
constexpr size_t OFF_GB = OFF_IK + 2 * MB;
constexpr size_t OFF_IW = OFF_GB + 1 * MB;
constexpr size_t OFF_COS = OFF_IW + 1 * MB;
constexpr size_t OFF_SIN = OFF_COS + 2 * MB;
constexpr size_t OFF_SEL = OFF_SIN + 2 * MB;
constexpr size_t OFF_REC = OFF_SEL + 8 * MB;
constexpr size_t WS_END = OFF_REC + (size_t)2048 * 74752;

struct Params {
    const float* x; const int* pos; const float* attn_g; const float* w_in; const float* conv_w; const float* a_log;
    const float* dt_bias; const float* gdn_norm_g; const float* w_out; const float* final_g; float* out; unsigned char* ws;
};

__device__ __forceinline__ float wave_sum(float v) {
#pragma unroll
    for (int o = 1; o < 64; o <<= 1) v += __shfl_xor(v, o);
    return v;
}
__device__ __forceinline__ float wave_max(float v) {
#pragma unroll
    for (int o = 1; o < 64; o <<= 1) v = fmaxf(v, __shfl_xor(v, o));
    return v;
}
__device__ __forceinline__ int opaque_tid() { int t = threadIdx.x; asm volatile("" : "+v"(t)); return t; }
__device__ __forceinline__ float silu_f(float x) { return x * __builtin_amdgcn_rcpf(1.0f + __builtin_amdgcn_exp2f(-1.4426950408889634f * x)); }

namespace pg8 {
constexpr int BM = 256, BK = 64, HALF = 128, HTB = HALF * BK * 2, STAGE_BYTES = 8 * HTB, NXCD = 8, WGM = 8;
__host__ __device__ __forceinline__ int lds_byte(int r, int c) { const int st = (r >> 4) * 2 + (c >> 5), rr = r & 15, cc = c & 31, ob = rr * 64 + cc * 2; return st * 1024 + (ob ^ (((ob >> 9) & 1) << 5)); }
__host__ __device__ __forceinline__ void stage_rc(int b, int& R, int& C) { const int st = b / 1024, sb = b % 1024, swz = sb ^ (((sb >> 9) & 1) << 5); R = (st >> 1) * 16 + swz / 64; C = (st & 1) * 32 + (swz % 64) / 2; }
__host__ __device__ __forceinline__ int perm32(int rho) { const int n = rho >> 4, i = rho & 15; return 8 * (i >> 2) + 4 * n + (i & 3); }
struct Unit { int pm, pn; };
struct Gemm { const h16* A; const h16* Bt; int M, N, K; };
struct StaticOrder {
    int nM, nN, nwg, G, c;
    __host__ __device__ void init(int M, int N, int G_, int c_) { nM = M / BM; nN = N / BM; nwg = nM * nN; G = G_; c = c_; }
    __host__ __device__ bool next(int i, Unit& u) const {
        const long L = (long)i * G + c; if (L >= nwg) return false;
        int wgid = (int)L; { const int q = nwg / NXCD, r = nwg % NXCD, xcd = wgid % NXCD, off = wgid / NXCD; wgid = (xcd < r ? xcd * (q + 1) : r * (q + 1) + (xcd - r) * q) + off; }
        const int nig = WGM * nN, gid = wgid / nig, fm = gid * WGM, gsz = (nM - fm) < WGM ? (nM - fm) : WGM;
        u.pm = fm + ((wgid % nig) % gsz); u.pn = (wgid % nig) / gsz; return true;
    }
    __device__ __forceinline__ void a_ready(const Unit&) const {}
    __device__ __forceinline__ void done(const Unit&) const {}
};

template <class Epi, class Sched, bool SP2 = true>
__device__ __forceinline__ void gemm_phase(LAS unsigned char* lds, const Gemm g, const Sched& S, const Epi& E) {
    const int tid = opaque_tid(), wid = __builtin_amdgcn_readfirstlane(tid >> 6), lane = tid & 63, wr = wid >> 2, wc = wid & 3, fr = lane & 15, fq = lane >> 4;
    const int K = g.K, nt = K / BK;
    unsigned voffA[2], voffB[2];
#pragma unroll
    for (int i = 0; i < 2; ++i) { int R, C; stage_rc(tid * 16 + i * 8192, R, C); const int Rb = Epi::PERM ? ((R & ~31) + perm32(R & 31)) : R;
        voffA[i] = (unsigned)(R * K + C) * 2u; voffB[i] = (unsigned)(Rb * K + C) * 2u; }
    const size_t kstep = (size_t)(BK * 2);
    const size_t hstep = (size_t)HALF * K * 2;
    const size_t tstep = 2 * hstep;
    const unsigned ldsw = (unsigned)wid * 1024u;
    const int aoff = lds_byte(wr * 64 + fr, fq * 8), boff = lds_byte(wc * 32 + fr, fq * 8);
#define PG8_SA(b, h) (((b) * 2 + (h)) * HTB)
#define PG8_SB(b, h) ((4 + (b) * 2 + (h)) * HTB)
#define PG8_STAGE(bufoff, gbase, voff) do { _Pragma("unroll") for (int _i = 0; _i < 2; ++_i) \
        __builtin_amdgcn_global_load_lds((const unsigned*)((const char*)(gbase) + (voff)[_i]), (LAS unsigned*)(lds + (bufoff) + ldsw + _i * 8192), 16, 0, 0); } while (0)
#define PG8_LDA(dst, b, h) do { _Pragma("unroll") for (int m = 0; m < 4; ++m) _Pragma("unroll") for (int k = 0; k < 2; ++k) dst[m][k] = *(const LAS h16x8*)(lds + PG8_SA(b, h) + aoff + m * 2048 + k * 1024); } while (0)
#define PG8_LDB(dst, b, h) do { _Pragma("unroll") for (int n = 0; n < 2; ++n) _Pragma("unroll") for (int k = 0; k < 2; ++k) dst[n][k] = *(const LAS h16x8*)(lds + PG8_SB(b, h) + boff + n * 2048 + k * 1024); } while (0)
#define PG8_MMA(ai, bj, At, Bt) do { __builtin_amdgcn_s_setprio(1); _Pragma("unroll") for (int m = 0; m < 4; ++m) _Pragma("unroll") for (int n = 0; n < 2; ++n) _Pragma("unroll") for (int k = 0; k < 2; ++k) \
        acc[ai][bj][m][n] = __builtin_amdgcn_mfma_f32_16x16x32_f16(Bt[n][k], At[m][k], acc[ai][bj][m][n], 0, 0, 0); __builtin_amdgcn_s_setprio(0); } while (0)
#define PG8_WAIT_V(n) asm volatile("s_waitcnt vmcnt(" #n ")" ::: "memory")
#define PG8_WAIT_L(n) asm volatile("s_waitcnt lgkmcnt(" #n ")" ::: "memory")
#define PG8_BAR __builtin_amdgcn_s_barrier()
#define PG8_SCHED __builtin_amdgcn_sched_barrier(0)
    Unit cur, nxt; int ui = 0;
    if (!S.next(0, cur)) return;
    f32x4 acc[2][2][4][2];
#pragma unroll
    for (int a = 0; a < 2; ++a)
#pragma unroll
        for (int b = 0; b < 2; ++b)
#pragma unroll
            for (int m = 0; m < 4; ++m)
#pragma unroll
                for (int n = 0; n < 2; ++n) acc[a][b][m][n] = (f32x4){0.f, 0.f, 0.f, 0.f};
    h16x8 At[4][2], B0[2][2], B1[2][2];
    const char* cA = (const char*)g.A + (size_t)cur.pm * tstep; const char* cB = (const char*)g.Bt + (size_t)cur.pn * tstep;
    S.a_ready(cur);
    if constexpr (SP2) {
        PG8_STAGE(PG8_SB(0, 0), cB, voffB); PG8_STAGE(PG8_SB(0, 1), cB + hstep, voffB); PG8_STAGE(PG8_SA(0, 0), cA, voffA); PG8_STAGE(PG8_SA(0, 1), cA + hstep, voffA);
        if (wr == 1) PG8_BAR;
        PG8_WAIT_V(2); PG8_BAR;
        PG8_STAGE(PG8_SB(1, 0), cB + kstep, voffB); PG8_STAGE(PG8_SA(1, 0), cA + kstep, voffA); PG8_STAGE(PG8_SB(1, 1), cB + hstep + kstep, voffB);
        PG8_WAIT_V(6); PG8_BAR;
    } else {
    PG8_STAGE(PG8_SB(0, 0), cB, voffB); PG8_STAGE(PG8_SA(0, 0), cA, voffA); PG8_STAGE(PG8_SB(0, 1), cB + hstep, voffB); PG8_STAGE(PG8_SA(0, 1), cA + hstep, voffA);
    if (wr == 1) PG8_BAR;
    PG8_WAIT_V(4); PG8_BAR;
    PG8_STAGE(PG8_SB(1, 0), cB + kstep, voffB); PG8_STAGE(PG8_SA(1, 0), cA + kstep, voffA); PG8_STAGE(PG8_SB(1, 1), cB + hstep + kstep, voffB);
    PG8_WAIT_V(6); PG8_BAR;
    }
    for (;;) {
        const bool has_next = S.next(ui + 1, nxt);
        const char* nA = has_next ? (const char*)g.A + (size_t)nxt.pm * tstep : cA; const char* nB = has_next ? (const char*)g.Bt + (size_t)nxt.pn * tstep : cB;
        for (int t = 0; t < nt; t += 2) {
            const bool last = (t == nt - 2);
            const char* a1 = cA + (size_t)(t + 1) * kstep;
            const char* a2 = last ? nA : cA + (size_t)(t + 2) * kstep; const char* b2 = last ? nB : cB + (size_t)(t + 2) * kstep;
            const char* a3 = a2 + kstep; const char* b3 = b2 + kstep;
            if (last && has_next) S.a_ready(nxt);
            if constexpr (SP2) {
            PG8_LDB(B0, 0, 0); PG8_LDB(B1, 0, 1); PG8_SCHED; PG8_LDA(At, 0, 0); PG8_STAGE(PG8_SA(1, 1), a1 + hstep, voffA);
            PG8_WAIT_V(8); PG8_WAIT_L(0); PG8_BAR; PG8_MMA(0, 0, At, B0); PG8_MMA(0, 1, At, B1); PG8_BAR; PG8_SCHED;
            PG8_LDA(At, 0, 1); PG8_STAGE(PG8_SB(0, 0), b2, voffB); PG8_STAGE(PG8_SB(0, 1), b2 + hstep, voffB); PG8_STAGE(PG8_SA(0, 0), a2, voffA);
            PG8_WAIT_V(8); PG8_WAIT_L(0); PG8_BAR; PG8_MMA(1, 0, At, B0); PG8_MMA(1, 1, At, B1); PG8_BAR; PG8_SCHED;
            PG8_LDB(B0, 1, 0); PG8_LDB(B1, 1, 1); PG8_SCHED; PG8_LDA(At, 1, 0); PG8_STAGE(PG8_SA(0, 1), a2 + hstep, voffA);
            PG8_WAIT_V(8); PG8_WAIT_L(0); PG8_BAR; PG8_MMA(0, 0, At, B0); PG8_MMA(0, 1, At, B1); PG8_BAR; PG8_SCHED;
            PG8_LDA(At, 1, 1); PG8_STAGE(PG8_SB(1, 0), b3, voffB); PG8_STAGE(PG8_SB(1, 1), b3 + hstep, voffB); PG8_STAGE(PG8_SA(1, 0), a3, voffA);
            PG8_WAIT_V(8); PG8_WAIT_L(0); PG8_BAR; PG8_MMA(1, 0, At, B0); PG8_MMA(1, 1, At, B1); PG8_BAR; PG8_SCHED;
            } else {
            PG8_LDB(B0, 0, 0); PG8_SCHED; PG8_LDA(At, 0, 0); PG8_STAGE(PG8_SA(1, 1), a1 + hstep, voffA);
            PG8_WAIT_L(8); PG8_BAR; PG8_WAIT_L(0); PG8_MMA(0, 0, At, B0); PG8_BAR; PG8_SCHED;
            PG8_LDB(B1, 0, 1); PG8_STAGE(PG8_SB(0, 0), b2, voffB);
            PG8_BAR; PG8_WAIT_L(0); PG8_MMA(0, 1, At, B1); PG8_BAR;
            PG8_LDA(At, 0, 1); PG8_STAGE(PG8_SA(0, 0), a2, voffA);
            PG8_BAR; PG8_WAIT_L(0); PG8_MMA(1, 0, At, B0); PG8_BAR; PG8_SCHED;
            PG8_STAGE(PG8_SB(0, 1), b2 + hstep, voffB);
            PG8_WAIT_V(6); PG8_BAR; PG8_MMA(1, 1, At, B1); PG8_BAR;
            PG8_LDB(B0, 1, 0); PG8_SCHED; PG8_LDA(At, 1, 0); PG8_STAGE(PG8_SA(0, 1), a2 + hstep, voffA);
            PG8_WAIT_L(8); PG8_BAR; PG8_WAIT_L(0); PG8_MMA(0, 0, At, B0); PG8_BAR; PG8_SCHED;
            PG8_LDB(B1, 1, 1); PG8_STAGE(PG8_SB(1, 0), b3, voffB);
            PG8_BAR; PG8_WAIT_L(0); PG8_MMA(0, 1, At, B1); PG8_BAR;
            PG8_LDA(At, 1, 1); PG8_STAGE(PG8_SA(1, 0), a3, voffA);
            PG8_BAR; PG8_WAIT_L(0); PG8_MMA(1, 0, At, B0); PG8_BAR; PG8_SCHED;
            PG8_STAGE(PG8_SB(1, 1), b3 + hstep, voffB);
            PG8_WAIT_V(6); PG8_BAR; PG8_MMA(1, 1, At, B1); PG8_BAR;
            }
        }
        if (wr == 0) PG8_BAR;
        E(acc, cur, wr, wc, fr, fq); S.done(cur);
        if (!has_next) break;
#pragma unroll
        for (int a = 0; a < 2; ++a)
#pragma unroll
            for (int b = 0; b < 2; ++b)
#pragma unroll
                for (int m = 0; m < 4; ++m)
#pragma unroll
                    for (int n = 0; n < 2; ++n) acc[a][b][m][n] = (f32x4){0.f, 0.f, 0.f, 0.f};
        cur = nxt; cA = nA; cB = nB; ++ui;
        if (wr == 1) PG8_BAR;
    }
    PG8_WAIT_V(0);
    PG8_BAR;
#undef PG8_SA
#undef PG8_SB
#undef PG8_STAGE
#undef PG8_LDA
#undef PG8_LDB
#undef PG8_MMA
#undef PG8_WAIT_V
#undef PG8_WAIT_L
#undef PG8_BAR
#undef PG8_SCHED
}
}

struct EpiIn {
    static constexpr bool PERM = true;
    unsigned char* ws; const float* a_log; const float* dt_bias;
    __device__ __forceinline__ void operator()(const f32x4 (&acc)[2][2][4][2], const pg8::Unit& u, int wr, int wc, int fr, int fq) const {
        const int pn = u.pn;
        const int rowb = u.pm * 256 + wr * 64 + fr;
        const int cw = wc * 32 + 8 * fq;
        const float* cosT = (const float*)(ws + OFF_COS); const float* sinT = (const float*)(ws + OFF_SIN);
        if (pn < 30) {
            h16* base; int ldc, colt, mode; float scale = 1.f;
            if (pn < 12) { base = (h16*)(ws + OFF_QKVR); ldc = 3072; colt = pn * 256; mode = 0; }
            else if (pn < 16) { base = (h16*)(ws + OFF_GZ); ldc = 1024; colt = (pn - 12) * 256; mode = 1; }
            else if (pn < 20) { base = (h16*)(ws + OFF_AQ); ldc = 1024; colt = (pn - 16) * 256; mode = 2; }
            else if (pn == 20) { base = (h16*)(ws + OFF_AK); ldc = 256; colt = 0; mode = 2; }
            else if (pn == 21) { base = (h16*)(ws + OFF_AV); ldc = 256; colt = 0; mode = 4; }
            else if (pn < 26) { base = (h16*)(ws + OFF_AZ); ldc = 1024; colt = (pn - 22) * 256; mode = 1; }
            else { base = (h16*)(ws + OFF_IQ); ldc = 1024; colt = (pn - 26) * 256; mode = 3; }
            const bool rot_wave = (mode == 2 && wc == 0) || (mode == 3 && (wc & 1) == 0);
            const int xm = (mode == 2) ? 32 : 16;
            const bool rot_lane = (mode == 2) ? true : (fq < 2);
            const float sgn = (mode == 2) ? (fq < 2 ? -1.f : 1.f) : (fq == 0 ? -1.f : 1.f);
            const int tix = (mode == 2) ? 8 * (fq & 1) : 16;
#pragma unroll
            for (int ai = 0; ai < 2; ++ai)
#pragma unroll
                for (int m = 0; m < 4; ++m) {
                    const int row = rowb + ai * 128 + m * 16;
                    float cs[8], sn[8];
                    if (rot_wave) {
                        const f32x4 c0 = *(const f32x4*)(cosT + (size_t)row * 24 + tix), c1 = *(const f32x4*)(cosT + (size_t)row * 24 + tix + 4);
                        const f32x4 s0 = *(const f32x4*)(sinT + (size_t)row * 24 + tix), s1 = *(const f32x4*)(sinT + (size_t)row * 24 + tix + 4);
#pragma unroll
                        for (int j = 0; j < 4; ++j) { cs[j] = c0[j]; cs[4 + j] = c1[j]; sn[j] = s0[j]; sn[4 + j] = s1[j]; }
                    }
#pragma unroll
                    for (int bj = 0; bj < 2; ++bj) {
                        float v[8];
#pragma unroll
                        for (int j = 0; j < 4; ++j) { v[j] = acc[ai][bj][m][0][j]; v[4 + j] = acc[ai][bj][m][1][j]; }
                        if (rot_wave) {
#pragma unroll
                            for (int j = 0; j < 8; ++j) { const float pv = __shfl_xor(v[j], xm); if (rot_lane) v[j] = v[j] * cs[j] + sgn * pv * sn[j]; }
                        }
                        if (mode == 1) {
#pragma unroll
                            for (int j = 0; j < 8; ++j) v[j] = silu_f(v[j]);
                        }
                        if (mode == 4) {
                            int w0 = 0, w1 = 0;
                            w0 = __builtin_amdgcn_cvt_pk_fp8_f32(v[0], v[1], w0, false); w0 = __builtin_amdgcn_cvt_pk_fp8_f32(v[2], v[3], w0, true);
                            w1 = __builtin_amdgcn_cvt_pk_fp8_f32(v[4], v[5], w1, false); w1 = __builtin_amdgcn_cvt_pk_fp8_f32(v[6], v[7], w1, true);
                            typedef int i32x2b __attribute__((ext_vector_type(2)));
                            *(i32x2b*)((unsigned char*)base + (size_t)row * ldc + bj * 128 + cw) = (i32x2b){w0, w1};
                        } else if (mode == 2) {
                            int w0 = 0, w1 = 0;
                            w0 = __builtin_amdgcn_cvt_pk_fp8_f32(v[0], v[1], w0, false); w0 = __builtin_amdgcn_cvt_pk_fp8_f32(v[2], v[3], w0, true);
                            w1 = __builtin_amdgcn_cvt_pk_fp8_f32(v[4], v[5], w1, false); w1 = __builtin_amdgcn_cvt_pk_fp8_f32(v[6], v[7], w1, true);
                            typedef int i32x2 __attribute__((ext_vector_type(2)));
                            *(i32x2*)((unsigned char*)base + (size_t)row * ldc + colt + bj * 128 + fq * 32 + wc * 8) = (i32x2){w0, w1};
                        } else {
                            h16x8 o;
#pragma unroll
                            for (int j = 0; j < 8; ++j) o[j] = (h16)(v[j] * scale);
                            *(h16x8*)(base + (size_t)row * ldc + colt + bj * 128 + cw) = o;
                        }
                    }
                }
        } else {
            h16* ik = (h16*)(ws + OFF_IK); float* gb = (float*)(ws + OFF_GB); float* iw = (float*)(ws + OFF_IW);
#pragma unroll
            for (int ai = 0; ai < 2; ++ai)
#pragma unroll
                for (int m = 0; m < 4; ++m) {
                    const int row = rowb + ai * 128 + m * 16;
                    float v[8];
#pragma unroll
                    for (int j = 0; j < 4; ++j) { v[j] = acc[ai][0][m][0][j]; v[4 + j] = acc[ai][0][m][1][j]; }
                    const f32x4 c0 = *(const f32x4*)(cosT + (size_t)row * 24 + 16), c1 = *(const f32x4*)(cosT + (size_t)row * 24 + 20);
                    const f32x4 s0 = *(const f32x4*)(sinT + (size_t)row * 24 + 16), s1 = *(const f32x4*)(sinT + (size_t)row * 24 + 20);
                    if (wc == 0) {
                        const float sgn = (fq == 0 ? -1.f : 1.f);
#pragma unroll
                        for (int j = 0; j < 8; ++j) { const float pv = __shfl_xor(v[j], 16); const float c = j < 4 ? c0[j & 3] : c1[j & 3], s = j < 4 ? s0[j & 3] : s1[j & 3];
                            if (fq < 2) v[j] = v[j] * c + sgn * pv * s; }
                    }
                    if (wc < 2) {
                        h16x8 o;
#pragma unroll
                        for (int j = 0; j < 8; ++j) o[j] = (h16)v[j];
                        *(h16x8*)(ik + (size_t)row * 64 + cw) = o;
                    } else if (wc == 2) {
                        if (fq == 0) {
#pragma unroll
                            for (int j = 0; j < 8; ++j) { const float z = v[j] + dt_bias[j]; const float sp = z > 20.f ? z : log1pf(expf(z)); gb[(size_t)row * 16 + j] = -expf(a_log[j]) * sp; }
                        } else if (fq == 1) {
#pragma unroll
                            for (int j = 0; j < 8; ++j) gb[(size_t)row * 16 + 8 + j] = 1.0f / (1.0f + expf(-v[j]));
                        } else {
#pragma unroll
                            for (int j = 0; j < 8; ++j) iw[(size_t)row * 16 + 8 * (fq - 2) + j] = v[j] * 0.03125f;
                        }
                    }
                }
        }
    }
};

struct PanelOrder {
    int c;
    __device__ __forceinline__ bool next(int i, pg8::Unit& u) const { if (i >= 2) return false; u.pm = 32 * i + 4 * (c & 7) + (c >> 6); u.pn = (c >> 3) & 7; return true; }
    __device__ __forceinline__ void a_ready(const pg8::Unit&) const {}
    __device__ __forceinline__ void done(const pg8::Unit&) const {}
};
struct EpiOutNorm {
    static constexpr bool PERM = false;
    const float* x; float* out; float* rowss; unsigned* cnt; const float* fg;
    __device__ __forceinline__ void operator()(f32x4 (&acc)[2][2][4][2], const pg8::Unit& u, int wr, int wc, int fr, int fq) const {
        const int rowb = u.pm * 256 + wr * 64 + fr, col0 = u.pn * 256 + wc * 32 + 4 * fq;
#pragma unroll
        for (int ai = 0; ai < 2; ++ai)
#pragma unroll
            for (int m = 0; m < 4; ++m) {
                const int row = rowb + ai * 128 + m * 16; float ss = 0.f;
#pragma unroll
                for (int bj = 0; bj < 2; ++bj)
#pragma unroll
                    for (int n = 0; n < 2; ++n) {
                        const f32x4 y = *(const f32x4*)(x + (size_t)row * DM + col0 + bj * 128 + n * 16) + acc[ai][bj][m][n];
                        acc[ai][bj][m][n] = y; ss += (y[0] * y[0] + y[1] * y[1]) + (y[2] * y[2] + y[3] * y[3]);
                    }
                ss += __shfl_xor(ss, 16); ss += __shfl_xor(ss, 32);
                if (fq == 0) atomicAdd(rowss + row, ss);
            }
        asm volatile("s_waitcnt vmcnt(0)" ::: "memory");
        unsigned* cw = cnt + (u.pm * 2 + wr) * 16;
        if ((threadIdx.x & 63) == 0) __hip_atomic_fetch_add(cw, 1u, __ATOMIC_RELAXED, __HIP_MEMORY_SCOPE_AGENT);
        { unsigned spins = 0;
          while ((unsigned)__builtin_amdgcn_readfirstlane((int)__hip_atomic_load(cw, __ATOMIC_RELAXED, __HIP_MEMORY_SCOPE_AGENT)) < 32u) { __builtin_amdgcn_s_sleep(2); if (++spins > (1u << 22)) break; } }
        f32x4 gv[2][2];
#pragma unroll
        for (int bj = 0; bj < 2; ++bj)
#pragma unroll
            for (int n = 0; n < 2; ++n) gv[bj][n] = *(const f32x4*)(fg + col0 + bj * 128 + n * 16);
#pragma unroll
        for (int ai = 0; ai < 2; ++ai)
#pragma unroll
            for (int m = 0; m < 4; ++m) {
                const int row = rowb + ai * 128 + m * 16;
                const float ssr = __hip_atomic_load(rowss + row, __ATOMIC_RELAXED, __HIP_MEMORY_SCOPE_AGENT);
                const float r = __builtin_amdgcn_rsqf(ssr * (1.0f / DM) + EPS);
#pragma unroll
                for (int bj = 0; bj < 2; ++bj)
#pragma unroll
                    for (int n = 0; n < 2; ++n) *(f32x4*)(out + (size_t)row * DM + col0 + bj * 128 + n * 16) = acc[ai][bj][m][n] * r * gv[bj][n];
            }
    }
};

struct EpiOut {
    static constexpr bool PERM = false;
    const float* x; float* out; float* rowss;
    __device__ __forceinline__ void operator()(const f32x4 (&acc)[2][2][4][2], const pg8::Unit& u, int wr, int wc, int fr, int fq) const {
        const int rowb = u.pm * 256 + wr * 64 + fr, col0 = u.pn * 256 + wc * 32 + 4 * fq;
#pragma unroll
        for (int ai = 0; ai < 2; ++ai)
#pragma unroll
            for (int m = 0; m < 4; ++m) {
                const int row = rowb + ai * 128 + m * 16; float ss = 0.f;
#pragma unroll
                for (int bj = 0; bj < 2; ++bj)
#pragma unroll
                    for (int n = 0; n < 2; ++n) {
                        const size_t off = (size_t)row * DM + col0 + bj * 128 + n * 16;
                        const f32x4 y = *(const f32x4*)(x + off) + acc[ai][bj][m][n];
                        *(f32x4*)(out + off) = y; ss += (y[0] * y[0] + y[1] * y[1]) + (y[2] * y[2] + y[3] * y[3]);
                    }
                ss += __shfl_xor(ss, 16); ss += __shfl_xor(ss, 32);
                if (fq == 0) atomicAdd(rowss + row, ss);
            }
    }
};

__device__ __forceinline__ int src_col(int np) {
    if (np < 4096) return np;
    if (np < 7680) return np + 16;
    if (np < 7744) return 7696 + (np - 7680);
    if (np < 7752) return 4096 + (np - 7744);
    if (np < 7760) return 4104 + (np - 7752);
    if (np < 7776) return np;
    return -1;
}
__device__ __forceinline__ void phase0(const Params& p, unsigned char* smem) {
    const int tid = opaque_tid(), wid = tid >> 6, lane = tid & 63;
    const int gw = blockIdx.x * 8 + wid, nw = gridDim.x * 8;
    h16* H = (h16*)(p.ws + OFF_H);
    for (int row = 2 * gw; row < BT; row += 2 * nw) {
        const f32x4* xr0 = (const f32x4*)(p.x + (size_t)row * DM); const f32x4* xr1 = xr0 + DM / 4;
        f32x4 v0[8], v1[8]; float s0 = 0.f, s1 = 0.f;
#pragma unroll
        for (int i = 0; i < 8; ++i) { v0[i] = xr0[lane + 64 * i]; v1[i] = xr1[lane + 64 * i]; }
#pragma unroll
        for (int i = 0; i < 8; ++i) { s0 += (v0[i][0] * v0[i][0] + v0[i][1] * v0[i][1]) + (v0[i][2] * v0[i][2] + v0[i][3] * v0[i][3]); s1 += (v1[i][0] * v1[i][0] + v1[i][1] * v1[i][1]) + (v1[i][2] * v1[i][2] + v1[i][3] * v1[i][3]); }
        s0 = wave_sum(s0); s1 = wave_sum(s1);
        const float r0 = __builtin_amdgcn_rsqf(s0 * (1.0f / DM) + EPS), r1 = __builtin_amdgcn_rsqf(s1 * (1.0f / DM) + EPS);
#pragma unroll
        for (int i = 0; i < 8; ++i) { const f32x4 g = ((const f32x4*)p.attn_g)[lane + 64 * i]; h16x4 o0, o1;
#pragma unroll
            for (int j = 0; j < 4; ++j) { o0[j] = (h16)(v0[i][j] * r0 * g[j]); o1[j] = (h16)(v1[i][j] * r1 * g[j]); }
            *(h16x4*)(H + (size_t)row * DM + 4 * (lane + 64 * i)) = o0; *(h16x4*)(H + (size_t)(row + 1) * DM + 4 * (lane + 64 * i)) = o1; }
    }
    {
        float* tiles = (float*)smem;
        h16* Wt = (h16*)(p.ws + OFF_WT); h16* WoT = (h16*)(p.ws + OFF_WOT);
        constexpr int NT1 = 124 * 32, NTT = NT1 + 32 * 32;
        const int nl_r = tid & 63, kl_r = tid >> 6, nl_w = tid >> 3, kc_w = tid & 7;
        float va[8], vb[8];
#define P0_LOAD(tI, v) do { if ((tI) < NT1) { const int n0_ = ((tI) / 32) * 64, k0_ = ((tI) % 32) * 64; const int src_ = src_col(n0_ + nl_r); \
            _Pragma("unroll") for (int i = 0; i < 8; ++i) v[i] = src_ >= 0 ? p.w_in[(size_t)(k0_ + kl_r + 8 * i) * IN_COLS + src_] : 0.f; } \
          else { const int t2_ = (tI) - NT1; const int n0_ = (t2_ / 32) * 64, k0_ = (t2_ % 32) * 64; \
            _Pragma("unroll") for (int i = 0; i < 8; ++i) v[i] = p.w_out[(size_t)(k0_ + kl_r + 8 * i) * DM + n0_ + nl_r]; } } while (0)
#define P0_PUT(buf, v) do { float* t_ = tiles + (buf) * (64 * 65); _Pragma("unroll") for (int i = 0; i < 8; ++i) t_[(kl_r + 8 * i) * 65 + nl_r] = v[i]; } while (0)
#define P0_STORE(buf, tI) do { const float* t_ = tiles + (buf) * (64 * 65); h16x8 o_; _Pragma("unroll") for (int j = 0; j < 8; ++j) o_[j] = (h16)t_[(8 * kc_w + j) * 65 + nl_w]; \
          if ((tI) < NT1) { const int n0_ = ((tI) / 32) * 64, k0_ = ((tI) % 32) * 64; *(h16x8*)(Wt + (size_t)(n0_ + nl_w) * 2048 + k0_ + 8 * kc_w) = o_; } \
          else { const int t2_ = (tI) - NT1; const int n0_ = (t2_ / 32) * 64, k0_ = (t2_ % 32) * 64; *(h16x8*)(WoT + (size_t)(n0_ + nl_w) * 2048 + k0_ + 8 * kc_w) = o_; } } while (0)
        int tI = blockIdx.x; int buf = 0;
        __syncthreads();
        if (tI < NTT) { P0_LOAD(tI, va); P0_PUT(0, va); }
        while (tI < NTT) {
            const int tn = tI + gridDim.x;
            if (tn < NTT) P0_LOAD(tn, vb);
            __syncthreads();
            P0_STORE(buf, tI);
            if (tn < NTT) P0_PUT(buf ^ 1, vb);
            buf ^= 1; tI = tn;
        }
#undef P0_LOAD
#undef P0_PUT
#undef P0_STORE
    }
    float* cosT = (float*)(p.ws + OFF_COS); float* sinT = (float*)(p.ws + OFF_SIN);
    for (int i = blockIdx.x * 512 + tid; i < BT * 24; i += gridDim.x * 512) {
        const int row = i / 24, j = i % 24;
        const float ex = (j < 16) ? (float)j * (2.0f / 32.0f) : (float)(j - 16) * (2.0f / 16.0f);
        const float inv = powf(500000.0f, -ex);
        const float ang = (float)p.pos[row] * inv;
        cosT[i] = cosf(ang); sinT[i] = sinf(ang);
    }
}

__device__ __forceinline__ h16x8 pack8(const f32x4 a, const f32x4 c) { h16x8 o; o[0] = (h16)a[0]; o[1] = (h16)a[1]; o[2] = (h16)a[2]; o[3] = (h16)a[3]; o[4] = (h16)c[0]; o[5] = (h16)c[1]; o[6] = (h16)c[2]; o[7] = (h16)c[3]; return o; }
typedef short v4s_t __attribute__((__vector_size__(4 * sizeof(short))));
__device__ __forceinline__ h16x4 lds_tr16(const LAS unsigned char* a) { const v4s_t v = __builtin_amdgcn_ds_read_tr16_b64_v4i16((LAS v4s_t*)a); return __builtin_bit_cast(h16x4, v); }
constexpr int REC_BYTES = 74752, REC_WF = 0, REC_QF = 16384, REC_AF = 32768, REC_KTF = 40960, REC_VEC = 57344, REC_UF = 58368, REC_DMA = 58368;
constexpr int HB_BYTES = 69632;

__device__ __forceinline__ void gdn_prep_pair(const Params& p, unsigned char* smem, int pair) {
    const int tid = opaque_tid(), wid = __builtin_amdgcn_readfirstlane(tid >> 6), lane = tid & 63, hb = wid >> 2, w4 = wid & 3, tl = tid & 255;
    const int tk = 2 * pair + hb; const int b = tk >> 9, h = (tk >> 6) & 7, n = tk & 63; const int t0 = n * 64;
    unsigned char* base = smem + hb * HB_BYTES;
    h16* Kn = (h16*)base; h16* Qn = Kn + 64 * 136; h16* Vh = Qn + 64 * 136; float* L = (float*)(Vh + 64 * 136); float* vec = L + 4096;
    unsigned char* rec = p.ws + OFF_REC + (size_t)tk * REC_BYTES;
    const h16* qkvr = (const h16*)(p.ws + OFF_QKVR);
    __syncthreads();
    {
        const int cg = tl & 15, rg = tl >> 4;
        h16x8 raw[3][7];
#pragma unroll
        for (int ti = 0; ti < 3; ++ti)
#pragma unroll
            for (int r = 0; r < 7; ++r) {
                const int trow = t0 + 4 * rg - 3 + r;
                if (trow >= 0) raw[ti][r] = *(const h16x8*)(qkvr + ((size_t)b * NT + trow) * 3072 + ti * 1024 + h * 128 + 8 * cg);
                else { for (int j = 0; j < 8; ++j) raw[ti][r][j] = (h16)0.f; }
            }
#pragma unroll
        for (int ti = 0; ti < 3; ++ti) {
            const int chan = ti * 1024 + h * 128 + 8 * cg;
            float xr[7][8];
#pragma unroll
            for (int r = 0; r < 7; ++r)
#pragma unroll
                for (int j = 0; j < 8; ++j) xr[r][j] = (float)raw[ti][r][j];
            float wv[4][8];
#pragma unroll
            for (int tp = 0; tp < 4; ++tp) { const f32x4 a = *(const f32x4*)(p.conv_w + (size_t)tp * 3072 + chan), c = *(const f32x4*)(p.conv_w + (size_t)tp * 3072 + chan + 4);
#pragma unroll
                for (int j = 0; j < 4; ++j) { wv[tp][j] = a[j]; wv[tp][4 + j] = c[j]; } }
            h16* dst = (ti == 0) ? Qn : (ti == 1 ? Kn : Vh);
#pragma unroll
            for (int r = 0; r < 4; ++r) {
                float y[8]; float ss = 0.f;
#pragma unroll
                for (int j = 0; j < 8; ++j) { float a = wv[0][j] * xr[r][j] + wv[1][j] * xr[r + 1][j] + wv[2][j] * xr[r + 2][j] + wv[3][j] * xr[r + 3][j]; a = silu_f(a); y[j] = a; ss += a * a; }
                float sc = 1.f;
                if (ti < 2) { ss += __shfl_xor(ss, 1); ss += __shfl_xor(ss, 2); ss += __shfl_xor(ss, 4); ss += __shfl_xor(ss, 8); sc = (ti == 0 ? 0.08838834764831845f : 1.0f) * __builtin_amdgcn_rsqf(ss + EPS); }
                h16x8 o;
#pragma unroll
                for (int j = 0; j < 8; ++j) o[j] = (h16)(y[j] * sc);
                *(h16x8*)(dst + (4 * rg + r) * 136 + 8 * cg) = o;
            }
        }
    }
    if (tl < 64) {
        const float* gb = (const float*)(p.ws + OFF_GB) + ((size_t)b * NT + t0 + tl) * 16;
        const float g = gb[h], be = gb[8 + h];
        float gc = g;
#pragma unroll
        for (int o = 1; o < 64; o <<= 1) { const float tt = __shfl_up(gc, o); if (lane >= o) gc += tt; }
        const float gl = __shfl(gc, 63);
        vec[tl] = g; vec[64 + tl] = be; vec[128 + tl] = gc; vec[192 + tl] = __expf(gc);
        float* rv = (float*)(rec + REC_VEC);
        rv[tl] = __expf(gc); rv[64 + tl] = __expf(gl - gc); if (tl == 0) rv[128] = __expf(gl);
    }
    __syncthreads();
    {
        const int rt = w4, fr = lane & 15, kg = lane >> 4;
        h16x8 Ak[4], Aq[4];
#pragma unroll
        for (int s = 0; s < 4; ++s) { Ak[s] = *(const h16x8*)(Kn + (16 * rt + fr) * 136 + 32 * s + 8 * kg); Aq[s] = *(const h16x8*)(Qn + (16 * rt + fr) * 136 + 32 * s + 8 * kg); }
        h16* AF = (h16*)(rec + REC_AF);
#pragma unroll
        for (int ct = 0; ct < 4; ++ct) {
            f32x4 kk = (f32x4){0.f, 0.f, 0.f, 0.f}, qk = (f32x4){0.f, 0.f, 0.f, 0.f};
#pragma unroll
            for (int s = 0; s < 4; ++s) { const h16x8 Bk = *(const h16x8*)(Kn + (16 * ct + fr) * 136 + 32 * s + 8 * kg);
                kk = __builtin_amdgcn_mfma_f32_16x16x32_f16(Ak[s], Bk, kk, 0, 0, 0); qk = __builtin_amdgcn_mfma_f32_16x16x32_f16(Aq[s], Bk, qk, 0, 0, 0); }
            const int j = 16 * ct + fr; const float gcj = vec[128 + j];
#pragma unroll
            for (int rgi = 0; rgi < 4; ++rgi) {
                const int i = 16 * rt + 4 * kg + rgi;
                const float dec = (i >= j) ? __expf(vec[128 + i] - gcj) : 0.f;
                L[i * 64 + j] = (i > j) ? vec[64 + i] * kk[rgi] * dec : 0.f;
                const int sp = ct >> 1, kgp = fr >> 2, j8 = (ct & 1) * 4 + (fr & 3), lanep = 16 * kgp + 4 * kg + rgi;
                AF[((rt * 2 + sp) * 64 + lanep) * 8 + j8] = (h16)(qk[rgi] * dec);
            }
        }
    }
    __syncthreads();
    h16* Tw = (h16*)L; h16* Tu = Tw + 4096;
    if (w4 == 0) {
        float X[64];
#pragma unroll
        for (int i = 0; i < 64; ++i) X[i] = 0.f;
        f32x4 Ln[16]; float rn = (lane == 0) ? 1.f : 0.f;
#pragma unroll
        for (int i = 0; i < 64; ++i) {
            f32x4 Lc[16]; const float rc = rn;
#pragma unroll
            for (int jj = 0; jj < (i + 3) / 4; ++jj) Lc[jj] = Ln[jj];
            if (i + 1 < 64) {
#pragma unroll
                for (int jj = 0; jj < (i + 4) / 4; ++jj) Ln[jj] = *(const f32x4*)(L + (i + 1) * 64 + 4 * jj);
                rn = (lane == i + 1) ? 1.f : 0.f;
            }
            float a0 = rc, a1 = 0.f, a2 = 0.f, a3 = 0.f;
#pragma unroll
            for (int jj = 0; jj < (i + 3) / 4; ++jj) { a0 -= Lc[jj][0] * X[4 * jj]; a1 -= Lc[jj][1] * X[4 * jj + 1]; a2 -= Lc[jj][2] * X[4 * jj + 2]; a3 -= Lc[jj][3] * X[4 * jj + 3]; }
            float acc = (a0 + a1) + (a2 + a3);
            asm volatile("" : "+v"(acc) :: "memory");
            X[i] = acc;
        }
        const float bu = vec[64 + lane], bw = bu * vec[192 + lane];
#pragma unroll
        for (int i = 0; i < 64; ++i) { const int pos = i * 64 + ((((lane >> 3) ^ (i & 7)) << 3) | (lane & 7)); Tw[pos] = (h16)(X[i] * bw); Tu[pos] = (h16)(X[i] * bu); }
    } else {
        const int t3 = tl - 64;
        h16* QF = (h16*)(rec + REC_QF);
        for (int f = t3; f < 1024; f += 192) { const int lanep = f & 63, s = (f >> 6) & 3, rt = f >> 8; const int row = 16 * rt + (lanep & 15), kgp = lanep >> 4;
            const h16x4 a = *(const h16x4*)(Qn + row * 136 + 32 * s + 4 * kgp), c = *(const h16x4*)(Qn + row * 136 + 32 * s + 16 + 4 * kgp);
            h16x8 o; o[0] = a[0]; o[1] = a[1]; o[2] = a[2]; o[3] = a[3]; o[4] = c[0]; o[5] = c[1]; o[6] = c[2]; o[7] = c[3];
            *(h16x8*)(QF + (size_t)f * 8) = o; }
        h16* KTF = (h16*)(rec + REC_KTF);
        for (int f = t3; f < 1024; f += 192) { const int lanep = f & 63, sp = (f >> 6) & 1, rt = f >> 7; const int d = 16 * rt + (lanep & 15), kgp = lanep >> 4;
            h16x8 o;
#pragma unroll
            for (int j8 = 0; j8 < 8; ++j8) { const int c = 32 * sp + (j8 < 4 ? 4 * kgp + j8 : 16 + 4 * kgp + (j8 - 4)); o[j8] = Kn[c * 136 + d]; }
            *(h16x8*)(KTF + (size_t)f * 8) = o; }
    }
    __syncthreads();
    {
        const int rt = w4, fr = lane & 15, kg = lane >> 4, q4 = fr >> 2, pp = fr & 3;
        const LAS unsigned char* Knl = (const LAS unsigned char*)Kn; const LAS unsigned char* Vl = (const LAS unsigned char*)Vh;
        const int trow = 16 * rt + fr;
        h16x8 Tuf[2], Twf[2];
#pragma unroll
        for (int s = 0; s < 2; ++s) { const int off = trow * 64 + ((((4 * s + kg) ^ (trow & 7))) << 3); Tuf[s] = *(const h16x8*)(Tu + off); Twf[s] = *(const h16x8*)(Tw + off); }
        h16* UF = (h16*)(rec + REC_UF);
#pragma unroll
        for (int dvb = 0; dvb < 8; ++dvb) {
            f32x4 acc = (f32x4){0.f, 0.f, 0.f, 0.f};
#pragma unroll
            for (int s = 0; s < 2; ++s) { const LAS unsigned char* a0 = Vl + ((32 * s + 8 * kg + q4) * 136 + 16 * dvb + 4 * pp) * 2;
                const h16x4 lo = lds_tr16(a0), hi4 = lds_tr16(a0 + 4 * 136 * 2);
                h16x8 Bv; Bv[0] = lo[0]; Bv[1] = lo[1]; Bv[2] = lo[2]; Bv[3] = lo[3]; Bv[4] = hi4[0]; Bv[5] = hi4[1]; Bv[6] = hi4[2]; Bv[7] = hi4[3];
                acc = __builtin_amdgcn_mfma_f32_16x16x32_f16(Tuf[s], Bv, acc, 0, 0, 0); }
            h16x4 o; o[0] = (h16)acc[0]; o[1] = (h16)acc[1]; o[2] = (h16)acc[2]; o[3] = (h16)acc[3];
            *(h16x4*)(UF + (size_t)((dvb * 4 + rt) * 64 + lane) * 4) = o;
        }
        h16* WF = (h16*)(rec + REC_WF);
#pragma unroll
        for (int so = 0; so < 4; ++so) {
            f32x4 c0 = (f32x4){0.f, 0.f, 0.f, 0.f}, c1 = (f32x4){0.f, 0.f, 0.f, 0.f};
#pragma unroll
            for (int s = 0; s < 2; ++s) {
                const LAS unsigned char* a0 = Knl + ((32 * s + 8 * kg + q4) * 136 + 16 * (2 * so) + 4 * pp) * 2;
                const h16x4 l0 = lds_tr16(a0), h0 = lds_tr16(a0 + 4 * 136 * 2), l1 = lds_tr16(a0 + 32), h1 = lds_tr16(a0 + 32 + 4 * 136 * 2);
                h16x8 A0, A1; A0[0] = l0[0]; A0[1] = l0[1]; A0[2] = l0[2]; A0[3] = l0[3]; A0[4] = h0[0]; A0[5] = h0[1]; A0[6] = h0[2]; A0[7] = h0[3];
                A1[0] = l1[0]; A1[1] = l1[1]; A1[2] = l1[2]; A1[3] = l1[3]; A1[4] = h1[0]; A1[5] = h1[1]; A1[6] = h1[2]; A1[7] = h1[3];
                c0 = __builtin_amdgcn_mfma_f32_16x16x32_f16(A0, Twf[s], c0, 0, 0, 0); c1 = __builtin_amdgcn_mfma_f32_16x16x32_f16(A1, Twf[s], c1, 0, 0, 0);
            }
            *(h16x8*)(WF + (size_t)((rt * 4 + so) * 64 + lane) * 8) = pack8(-c0, -c1);
        }
    }
}

__device__ __forceinline__ void gdn_scan_task(const Params& p, unsigned char* smem, int bh) {
    const int tid = opaque_tid(), wid = __builtin_amdgcn_readfirstlane(tid >> 6), lane = tid & 63, kg = lane >> 4, fr = lane & 15;
    const int b = bh >> 3, h = bh & 7;
    LAS unsigned char* lds = (LAS unsigned char*)smem;
    const unsigned char* rec0 = p.ws + OFF_REC + (size_t)(bh * 64) * REC_BYTES;
    h16* OB = (h16*)(smem + 2 * REC_DMA);
    const h16* gz = (const h16*)(p.ws + OFF_GZ); h16* omix = (h16*)(p.ws + OFF_OMIX);
    f32x4 Sacc[8];
#pragma unroll
    for (int t = 0; t < 8; ++t) Sacc[t] = (f32x4){0.f, 0.f, 0.f, 0.f};
    h16x4 Uc[4], Un[4];
    __syncthreads();
#define GDN_GLDS(recp, bufi) do { _Pragma("unroll") for (int _i = 0; _i < 7; ++_i) \
        __builtin_amdgcn_global_load_lds((const unsigned*)((recp) + (size_t)(_i * 512 + tid) * 16), (LAS unsigned*)(lds + (bufi) * REC_DMA + (_i * 512 + wid * 64) * 16), 16, 0, 0); \
        if (wid == 0) __builtin_amdgcn_global_load_lds((const unsigned*)((recp) + (size_t)(7 * 512 + tid) * 16), (LAS unsigned*)(lds + (bufi) * REC_DMA + (7 * 512) * 16), 16, 0, 0); } while (0)
#define GDN_LDREG(recp, U_) do { _Pragma("unroll") for (int rt = 0; rt < 4; ++rt) U_[rt] = *(const h16x4*)((recp) + REC_UF + (size_t)((wid * 4 + rt) * 64 + lane) * 8); } while (0)
#define GDN_LDGZ(dst, chunk) do { const h16* gp_ = gz + ((size_t)b * NT + 64 * (chunk) + prow) * 1024 + h * 128 + 16 * pseg; dst[0] = *(const h16x8*)gp_; dst[1] = *(const h16x8*)(gp_ + 8); } while (0)
#define GDN_POST(chunk, gzv) do { const h16* Ob = OB + ((chunk) & 1) * 8192 + prow * 128 + 16 * pseg; const h16x8 a0 = *(const h16x8*)Ob, a1 = *(const h16x8*)(Ob + 8); \
        float ngv[16]; _Pragma("unroll") for (int j = 0; j < 4; ++j) { const f32x4 t4 = *(const f32x4*)(ngl + 16 * pseg + 4 * j); ngv[4 * j] = t4[0]; ngv[4 * j + 1] = t4[1]; ngv[4 * j + 2] = t4[2]; ngv[4 * j + 3] = t4[3]; } \
        float ss = 0.f; _Pragma("unroll") for (int j = 0; j < 8; ++j) { const float u0 = (float)a0[j], u1 = (float)a1[j]; ss += u0 * u0 + u1 * u1; } \
        ss += __shfl_xor(ss, 1); ss += __shfl_xor(ss, 2); ss += __shfl_xor(ss, 4); const float r = __builtin_amdgcn_rsqf(ss * (1.0f / 128.0f) + EPS); \
        h16x8 o0, o1; _Pragma("unroll") for (int j = 0; j < 8; ++j) { o0[j] = (h16)((float)a0[j] * r * ngv[j] * (float)gzv[0][j]); o1[j] = (h16)((float)a1[j] * r * ngv[8 + j] * (float)gzv[1][j]); } \
        h16* op_ = omix + ((size_t)b * NT + 64 * (chunk) + prow) * 2048 + h * 128 + 16 * pseg; *(h16x8*)op_ = o0; *(h16x8*)(op_ + 8) = o1; } while (0)
#define GDN_RD8(X, off0) do { _Pragma("unroll") for (int _j = 0; _j < 8; ++_j) X[_j] = *(const LAS h16x8*)(bufp + (off0) + (_j * 64 + lane) * 16); } while (0)
#define GDN_SB __builtin_amdgcn_sched_barrier(0)
    h16x8 gzp[2], gzn[2];
    const int prow = tid >> 3, pseg = tid & 7;
    float* ngl = (float*)(smem + 2 * REC_DMA + 32768);
    if (tid < 128) ngl[tid] = p.gdn_norm_g[tid];
    GDN_GLDS(rec0, 0);
    GDN_LDREG(rec0, Uc);
    asm volatile("s_waitcnt vmcnt(0)" ::: "memory");
    __syncthreads();
    for (int n = 0; n < 64; ++n) {
        const unsigned char* recn = rec0 + (size_t)(n + 1) * REC_BYTES;
        if (n + 1 < 64) { GDN_GLDS(recn, (n + 1) & 1); GDN_LDREG(recn, Un); }
        GDN_LDGZ(gzn, n);
        if (n > 0) GDN_POST(n - 1, gzp);
        const LAS unsigned char* bufp = lds + (n & 1) * REC_DMA;
        h16x8 X[8], Y[8];
        GDN_RD8(X, REC_WF);
        h16x8 SB[4];
#pragma unroll
        for (int s = 0; s < 4; ++s) SB[s] = pack8(Sacc[2 * s], Sacc[2 * s + 1]);
        f32x4 vacc[4], oacc[4];
#pragma unroll
        for (int rt = 0; rt < 4; ++rt) { vacc[rt] = (f32x4){(float)Uc[rt][0], (float)Uc[rt][1], (float)Uc[rt][2], (float)Uc[rt][3]}; oacc[rt] = (f32x4){0.f, 0.f, 0.f, 0.f}; }
        GDN_SB;
        GDN_RD8(Y, REC_WF + 8192);
#pragma unroll
        for (int j = 0; j < 8; ++j) vacc[j >> 2] = __builtin_amdgcn_mfma_f32_16x16x32_f16(X[j], SB[j & 3], vacc[j >> 2], 0, 0, 0);
        GDN_SB;
        GDN_RD8(X, REC_QF);
#pragma unroll
        for (int j = 0; j < 8; ++j) vacc[2 + (j >> 2)] = __builtin_amdgcn_mfma_f32_16x16x32_f16(Y[j], SB[j & 3], vacc[2 + (j >> 2)], 0, 0, 0);
        GDN_SB;
        GDN_RD8(Y, REC_QF + 8192);
        f32x4 ekv[4], egv[4];
#pragma unroll
        for (int rt = 0; rt < 4; ++rt) { ekv[rt] = *(const LAS f32x4*)(bufp + REC_VEC + 256 + (16 * rt + 4 * kg) * 4); egv[rt] = *(const LAS f32x4*)(bufp + REC_VEC + (16 * rt + 4 * kg) * 4); }
        const float eglc = *(const LAS float*)(bufp + REC_VEC + 512);
#pragma unroll
        for (int j = 0; j < 8; ++j) oacc[j >> 2] = __builtin_amdgcn_mfma_f32_16x16x32_f16(X[j], SB[j & 3], oacc[j >> 2], 0, 0, 0);
        GDN_SB;
        GDN_RD8(X, REC_KTF);
        h16x8 VB[2], VKB[2];
#pragma unroll
        for (int sp = 0; sp < 2; ++sp) { VB[sp] = pack8(vacc[2 * sp], vacc[2 * sp + 1]); VKB[sp] = pack8(vacc[2 * sp] * ekv[2 * sp], vacc[2 * sp + 1] * ekv[2 * sp + 1]); }
#pragma unroll
        for (int j = 0; j < 8; ++j) oacc[2 + (j >> 2)] = __builtin_amdgcn_mfma_f32_16x16x32_f16(Y[j], SB[j & 3], oacc[2 + (j >> 2)], 0, 0, 0);
        GDN_SB;
        GDN_RD8(Y, REC_KTF + 8192);
#pragma unroll
        for (int t = 0; t < 8; ++t) Sacc[t] = Sacc[t] * eglc;
#pragma unroll
        for (int j = 0; j < 8; ++j) Sacc[j >> 1] = __builtin_amdgcn_mfma_f32_16x16x32_f16(X[j], VKB[j & 1], Sacc[j >> 1], 0, 0, 0);
        GDN_SB;
        GDN_RD8(X, REC_AF);
#pragma unroll
        for (int rt = 0; rt < 4; ++rt) oacc[rt] = oacc[rt] * egv[rt];
#pragma unroll
        for (int j = 0; j < 8; ++j) Sacc[4 + (j >> 1)] = __builtin_amdgcn_mfma_f32_16x16x32_f16(Y[j], VKB[j & 1], Sacc[4 + (j >> 1)], 0, 0, 0);
        GDN_SB;
#pragma unroll
        for (int j = 0; j < 8; ++j) oacc[j >> 1] = __builtin_amdgcn_mfma_f32_16x16x32_f16(X[j], VB[j & 1], oacc[j >> 1], 0, 0, 0);
        { h16* Ob = OB + (n & 1) * 8192;
#pragma unroll
          for (int rt = 0; rt < 4; ++rt)
#pragma unroll
              for (int rgi = 0; rgi < 4; ++rgi) Ob[(16 * rt + 4 * kg + rgi) * 128 + 16 * wid + fr] = (h16)oacc[rt][rgi]; }
        asm volatile("s_waitcnt vmcnt(0)" ::: "memory");
        __syncthreads();
#pragma unroll
        for (int rt = 0; rt < 4; ++rt) Uc[rt] = Un[rt];
        gzp[0] = gzn[0]; gzp[1] = gzn[1];
    }
    GDN_POST(63, gzp);
#undef GDN_LDGZ
#undef GDN_POST
#undef GDN_RD8
#undef GDN_SB
#undef GDN_GLDS
#undef GDN_LDREG
}

__device__ __forceinline__ unsigned f2key(float x) { const unsigned u = __float_as_uint(x); return (u & 0x80000000u) ? ~u : (u | 0x80000000u); }
typedef float f32x16 __attribute__((ext_vector_type(16)));
__device__ __forceinline__ float wave_min(float v) {
#pragma unroll
    for (int o = 1; o < 64; o <<= 1) v = fminf(v, __shfl_xor(v, o));
    return v;
}
__device__ __forceinline__ unsigned lane_below(unsigned long long m) { return __builtin_amdgcn_mbcnt_hi((unsigned)(m >> 32), __builtin_amdgcn_mbcnt_lo((unsigned)m, 0u)); }
__device__ __forceinline__ void idx8_task(const Params& p, unsigned char* smem, int b, int qb) {
    const int tid = opaque_tid(), wid = __builtin_amdgcn_readfirstlane(tid >> 6), lane = tid & 63;
    const int t0 = qb * 8;
    unsigned short* selg = (unsigned short*)(p.ws + OFF_SEL) + ((size_t)b * NT + t0) * 256;
    if (t0 + 8 <= 256) {
        for (int i = tid; i < 8 * 256; i += 512) { const int q = i >> 8, k = i & 255; selg[i] = (unsigned short)(k <= t0 + q ? k : 0); }
        return;
    }
    float* sc = (float*)smem;
    ACC_T0();
    unsigned* hist = (unsigned*)(smem + 131072 + wid * 2560);
    unsigned* cand = hist + 256;
    __syncthreads();
    {
        const int n8 = t0 + 8;
        const int ntile = (n8 + 31) >> 5, ntile_pad = ((n8 + 255) >> 8) << 3;
        const h16* iq = (const h16*)(p.ws + OFF_IQ) + ((size_t)b * NT + t0) * 1024;
        const float* iw = (const float*)(p.ws + OFF_IW) + ((size_t)b * NT + t0) * 16;
        const h16* ik = (const h16*)(p.ws + OFF_IK) + (size_t)b * NT * 64;
        const int r = lane & 31, kh = lane >> 5, qq = (r >> 2) & 1, hh = (r & 3) + 4 * (r >> 3);
        h16x8 Af[4][4]; h16x2 Wp[4][8];
#pragma unroll
        for (int a = 0; a < 4; ++a) {
#pragma unroll
            for (int s = 0; s < 4; ++s) Af[a][s] = *(const h16x8*)(iq + (size_t)(2 * a + qq) * 1024 + hh * 64 + 16 * s + 8 * kh);
#pragma unroll
            for (int c = 0; c < 4; ++c) { const f32x4 w4 = *(const f32x4*)(iw + (size_t)(2 * a + kh) * 16 + 4 * c);
                Wp[a][2 * c] = (h16x2){(h16)w4[0], (h16)w4[1]}; Wp[a][2 * c + 1] = (h16x2){(h16)w4[2], (h16)w4[3]}; }
        }
#define IDX_LOADB(Bx, ti) do { if ((ti) < ntile) { _Pragma("unroll") for (int s = 0; s < 4; ++s) Bx[s] = *(const h16x8*)(ik + (size_t)(32 * (ti) + r) * 64 + 16 * s + 8 * kh); } } while (0)
#define IDX_COMP(Bx, ti) do { if ((ti) < ntile) { const int key = 32 * (ti) + r; f32x16 accs[4]; \
            _Pragma("unroll") for (int a = 0; a < 4; ++a) { _Pragma("unroll") for (int e = 0; e < 16; ++e) accs[a][e] = 0.f; \
                _Pragma("unroll") for (int s = 0; s < 4; ++s) accs[a] = __builtin_amdgcn_mfma_f32_32x32x16_f16(Af[a][s], Bx[s], accs[a], 0, 0, 0); } \
            __builtin_amdgcn_sched_barrier(0); \
            _Pragma("unroll") for (int a = 0; a < 4; ++a) { \
                float s0 = 0.f, s1 = 0.f; _Pragma("unroll") for (int e = 0; e < 8; e += 2) { h16x2 rp = (h16x2){(h16)accs[a][2 * e], (h16)accs[a][2 * e + 1]}; rp = __builtin_elementwise_max(rp, (h16x2){(h16)0.f, (h16)0.f}); s0 = __builtin_amdgcn_fdot2(rp, Wp[a][e], s0, false); \
                    h16x2 rq = (h16x2){(h16)accs[a][2 * e + 2], (h16)accs[a][2 * e + 3]}; rq = __builtin_elementwise_max(rq, (h16x2){(h16)0.f, (h16)0.f}); s1 = __builtin_amdgcn_fdot2(rq, Wp[a][e + 1], s1, false); } \
                const int q = 2 * a + kh; sc[q * 4096 + key] = (key > t0 + q) ? -INFINITY : (s0 + s1); } } } while (0)
        {
            h16x8 B0[4], B1[4], B2[4];
            IDX_LOADB(B0, wid); IDX_LOADB(B1, wid + 8);
            for (int i = wid; i < ntile; i += 24) {
                IDX_LOADB(B2, i + 16); IDX_COMP(B0, i);
                IDX_LOADB(B0, i + 24); IDX_COMP(B1, i + 8);
                IDX_LOADB(B1, i + 32); IDX_COMP(B2, i + 16);
            }
            for (int i = ntile + wid; i < ntile_pad; i += 8) {
#pragma unroll
                for (int a = 0; a < 4; ++a) sc[(2 * a + kh) * 4096 + 32 * i + r] = -INFINITY;
            }
        }
#undef IDX_LOADB
#undef IDX_COMP
    }
    __syncthreads();
    ACC_ADD(1);
    {
        const int tq = t0 + wid, n = tq + 1;
        const float* row = sc + wid * 4096;
        const int ng = (n + 255) >> 8;
        f32x4 x[16];
#pragma unroll
        for (int g = 0; g < 16; ++g) { if (g < ng) x[g] = *(const f32x4*)(row + 256 * g + 4 * lane); else x[g] = (f32x4){-INFINITY, -INFINITY, -INFINITY, -INFINITY}; }
        float hi = -INFINITY, lo = INFINITY;
#pragma unroll
        for (int g = 0; g < 16; ++g)
#pragma unroll
            for (int c = 0; c < 4; ++c) { const float v = x[g][c]; hi = fmaxf(hi, v); lo = fminf(lo, v == -INFINITY ? INFINITY : v); }
        hi = wave_max(hi); lo = wave_min(lo);
        const float scale = (hi > lo) ? 255.99f / (hi - lo) : 0.f; const float off = -lo * scale;
        *(u32x4*)(hist + 4 * lane) = (u32x4){0u, 0u, 0u, 0u};
#pragma unroll
        for (int g = 0; g < 16; ++g) { if (g < ng) {
#pragma unroll
            for (int c = 0; c < 4; ++c) { int bin = (int)fmaf(x[g][c], scale, off); bin = bin < 0 ? 0 : (bin > 255 ? 255 : bin); atomicAdd(&hist[bin], 1u); } } }
        unsigned bstar, need;
        {
            const u32x4 h4 = *(const u32x4*)(hist + 4 * lane); const unsigned s = h4[0] + h4[1] + h4[2] + h4[3];
            unsigned suf = s;
#pragma unroll
            for (int o = 1; o < 64; o <<= 1) { const unsigned tt = __shfl_down(suf, o); if (lane + o < 64) suf += tt; }
            const unsigned above = suf - s;
            const bool mine = (above < 256u && 256u <= suf);
            unsigned cum = above; unsigned bin = 0;
            if (cum + h4[3] >= 256u) bin = 3; else { cum += h4[3]; if (cum + h4[2] >= 256u) bin = 2; else { cum += h4[2]; if (cum + h4[1] >= 256u) bin = 1; else { cum += h4[1]; bin = 0; } } }
            const unsigned long long mm = __ballot(mine);
            const int src = (int)__builtin_ctzll(mm);
            bstar = (unsigned)__shfl((int)(4 * lane + bin), src); need = (unsigned)__shfl((int)(256u - cum), src);
        }
        unsigned short* so = selg + (size_t)wid * 256;
        unsigned short* cidx = (unsigned short*)(cand + 256);
        unsigned m = 0, outb = 0;
#pragma unroll
        for (int g = 0; g < 16; ++g) { if (g < ng) {
#pragma unroll
            for (int c = 0; c < 4; ++c) { int bin = (int)fmaf(x[g][c], scale, off); bin = bin < 0 ? 0 : (bin > 255 ? 255 : bin);
                const bool gt = ((unsigned)bin > bstar), pr = ((unsigned)bin == bstar);
                const unsigned long long mg = __ballot(gt), mk = __ballot(pr);
                if (mg) { const unsigned pos = outb + lane_below(mg); if (gt) so[pos] = (unsigned short)(256 * g + 4 * lane + c); outb += (unsigned)__builtin_popcountll(mg); }
                if (mk) { const unsigned pos = m + lane_below(mk); if (pr && pos < 256u) { cand[pos] = f2key(x[g][c]); cidx[pos] = (unsigned short)(256 * g + 4 * lane + c); } m += (unsigned)__builtin_popcountll(mk); } } } }
        unsigned Kt = 0, rr = need;
        if (m <= 256u) {
            const int nc = (int)((m + 63u) >> 6);
            unsigned cv[4]; unsigned short ci[4];
#pragma unroll
            for (int j = 0; j < 4; ++j) { const bool in = (64 * j + lane < (int)m); cv[j] = in ? cand[64 * j + lane] : 0u; ci[j] = in ? cidx[64 * j + lane] : (unsigned short)0; }
            for (int bit = 31; bit >= 0; --bit) {
                const unsigned test = (Kt | (1u << bit)) >> bit;
                unsigned cnt = (unsigned)__builtin_popcountll(__ballot((cv[0] >> bit) == test));
                if (nc > 1) cnt += (unsigned)__builtin_popcountll(__ballot((cv[1] >> bit) == test));
                if (nc > 2) cnt += (unsigned)__builtin_popcountll(__ballot((cv[2] >> bit) == test));
                if (nc > 3) cnt += (unsigned)__builtin_popcountll(__ballot((cv[3] >> bit) == test));
                if (cnt >= rr) Kt |= (1u << bit); else rr -= cnt;
            }
            unsigned eqb = 0;
#pragma unroll
            for (int j = 0; j < 4; ++j) { if (j < nc) { const bool in = (64 * j + lane < (int)m); const bool gt = in && cv[j] > Kt, eq = in && cv[j] == Kt;
                const unsigned long long me = __ballot(eq); bool take = gt;
                if (me) { const unsigned er = eqb + lane_below(me); take = gt || (eq && er < rr); eqb += (unsigned)__builtin_popcountll(me); }
                const unsigned long long mt = __ballot(take);
                if (mt) { const unsigned pos = outb + lane_below(mt); if (take) so[pos] = ci[j]; outb += (unsigned)__builtin_popcountll(mt); } } }
        } else {
            for (int bit = 31; bit >= 0; --bit) {
                const unsigned test = (Kt | (1u << bit)) >> bit; unsigned cnt = 0;
                for (int idx = lane; idx < ng * 256; idx += 64) { const float v = row[idx]; int bin = (int)fmaf(v, scale, off); bin = bin < 0 ? 0 : (bin > 255 ? 255 : bin);
                    const bool pr = ((unsigned)bin == bstar) && ((f2key(v) >> bit) == test); cnt += (unsigned)__builtin_popcountll(__ballot(pr)); }
                if (cnt >= rr) Kt |= (1u << bit); else rr -= cnt;
            }
            unsigned eqb = 0;
            for (int idx = lane; idx < ng * 256; idx += 64) { const float v = row[idx]; int bin = (int)fmaf(v, scale, off); bin = bin < 0 ? 0 : (bin > 255 ? 255 : bin);
                const unsigned k = f2key(v); const bool inb = ((unsigned)bin == bstar); const bool gt = inb && k > Kt, eq = inb && k == Kt;
                const unsigned long long me = __ballot(eq); bool take = gt;
                if (me) { const unsigned er = eqb + lane_below(me); take = gt || (eq && er < rr); eqb += (unsigned)__builtin_popcountll(me); }
                const unsigned long long mt = __ballot(take);
                if (mt) { const unsigned pos = outb + lane_below(mt); if (take) so[pos] = (unsigned short)idx; outb += (unsigned)__builtin_popcountll(mt); } }
        }
    }
    __syncthreads();
    ACC_ADD(2);
}

typedef unsigned short u16x4 __attribute__((ext_vector_type(4)));
typedef unsigned short u16x8 __attribute__((ext_vector_type(8)));
__device__ __forceinline__ void attn8_task(const Params& p, unsigned char* smem, int part, int o) {
    const int tid = opaque_tid(), wid = __builtin_amdgcn_readfirstlane(tid >> 6), lane = tid & 63, kg = lane >> 4, fr = lane & 15;
    const int b = part >> 1, g = part & 1;
    unsigned char* vl = smem + wid * 17408;
    LAS unsigned char* vll = (LAS unsigned char*)vl;
    const char* akb = (const char*)(p.ws + OFF_AK) + (size_t)b * NT * 256 + g * 128;
    const char* avb = (const char*)(p.ws + OFF_AV) + (size_t)b * NT * 256 + g * 128;
    typedef long i64x2 __attribute__((ext_vector_type(2)));
    constexpr int NQW = 1;
    const int tq0 = 8 * NQW * o + NQW * wid;
    u16x4 kix[4], kixn[4];
#define AT_LOADI(tt, KI) do { const unsigned short* sel_ = (const unsigned short*)(p.ws + OFF_SEL) + ((size_t)b * NT + (tt)) * 256; \
        _Pragma("unroll") for (int c = 0; c < 4; ++c) KI[c] = *(const u16x4*)(sel_ + 64 * c + 4 * fr); } while (0)
    AT_LOADI(tq0, kix);
#pragma unroll 1
    for (int qi = 0; qi < NQW; ++qi) {
    const int t = tq0 + qi; const int bt = b * NT + t; const int nvalid = (t + 1) < 256 ? (t + 1) : 256;
    const unsigned short* sel = (const unsigned short*)(p.ws + OFF_SEL) + (size_t)bt * 256;
    long Qf[4];
    { const char* qp_ = (const char*)(p.ws + OFF_AQ) + (size_t)bt * 1024 + (4 * g + (fr & 3)) * 128 + kg * 32; const i64x2 q0 = *(const i64x2*)qp_, q1 = *(const i64x2*)(qp_ + 16);
      Qf[0] = fr < 4 ? q0[0] : 0l; Qf[1] = fr < 4 ? q0[1] : 0l; Qf[2] = fr < 4 ? q1[0] : 0l; Qf[3] = fr < 4 ? q1[1] : 0l; }
    f32x4 lg[16];
#define AT_LOADK(Kx, c) do { _Pragma("unroll") for (int ii = 0; ii < 4; ++ii) { const char* kp = akb + (unsigned)kix[c][ii] * 256u + 32u * (unsigned)kg; \
        const i64x2 t0 = *(const i64x2*)kp, t1 = *(const i64x2*)(kp + 16); Kx[ii][0] = t0[0]; Kx[ii][1] = t0[1]; Kx[ii][2] = t1[0]; Kx[ii][3] = t1[1]; } } while (0)
#define AT_MMAK(Kx, c) do { _Pragma("unroll") for (int ii = 0; ii < 4; ++ii) { f32x4 a = (f32x4){0.f, 0.f, 0.f, 0.f}; \
        _Pragma("unroll") for (int s = 0; s < 4; ++s) a = __builtin_amdgcn_mfma_f32_16x16x32_fp8_fp8(Kx[ii][s], Qf[s], a, 0, 0, 0); lg[4 * (c) + ii] = a; } } while (0)
#define AT_LOADV(Vx, c) do { const u16x8 i0 = *(const u16x8*)(sel + 64 * (c) + 8 * (lane >> 3)); \
        _Pragma("unroll") for (int it = 0; it < 8; ++it) Vx[it] = *(const u32x4*)(avb + (unsigned)i0[it] * 256u + 16u * (unsigned)(lane & 7)); } while (0)
    u32x4 VA[8], VB[8];
    {
        long K0[4][4], K1[4][4], K2[4][4];
        AT_LOADK(K0, 0); AT_LOADK(K1, 1); AT_LOADK(K2, 2);
        AT_MMAK(K0, 0); AT_LOADK(K0, 3);
        AT_MMAK(K1, 1); AT_LOADV(VA, 0);
        AT_MMAK(K2, 2);
        AT_MMAK(K0, 3);
    }
#define DPP_F(oldv, srcv, ctrl, bank) __builtin_bit_cast(float, __builtin_amdgcn_update_dpp(__builtin_bit_cast(int, (float)(oldv)), __builtin_bit_cast(int, (float)(srcv)), (ctrl), 0xF, (bank), false))
    float val[4][4];
#pragma unroll
    for (int ii = 0; ii < 4; ++ii)
#pragma unroll
        for (int r = 0; r < 4; ++r) { float v = lg[ii][r];
            v = DPP_F(v, lg[4 + ii][r], 0x114, 0x2); v = DPP_F(v, lg[8 + ii][r], 0x118, 0x4); v = DPP_F(v, lg[12 + ii][r], 0x11C, 0x8); val[ii][r] = v; }
    const int cj = fr >> 2;
    float m = -INFINITY;
#pragma unroll
    for (int ii = 0; ii < 4; ++ii)
#pragma unroll
        for (int r = 0; r < 4; ++r) { const int slot = 64 * cj + 16 * kg + 4 * r + ii; const float v = (slot < nvalid) ? val[ii][r] * (0.08838834764831845f * 1.4426950408889634f) : -INFINITY; val[ii][r] = v; m = fmaxf(m, v); }
    m = fmaxf(m, __shfl_xor(m, 4)); m = fmaxf(m, __shfl_xor(m, 8)); m = fmaxf(m, __shfl_xor(m, 16)); m = fmaxf(m, __shfl_xor(m, 32));
    float sum = 0.f;
#pragma unroll
    for (int ii = 0; ii < 4; ++ii)
#pragma unroll
        for (int r = 0; r < 4; ++r) { const float e = __builtin_amdgcn_exp2f(val[ii][r] - m); val[ii][r] = e; sum += e; }
    sum += __shfl_xor(sum, 4); sum += __shfl_xor(sum, 8); sum += __shfl_xor(sum, 16); sum += __shfl_xor(sum, 32);
    const float pscale = __builtin_amdgcn_rcpf(sum) * 256.0f;
    int pl[2][2];
#pragma unroll
    for (int ipl = 0; ipl < 2; ++ipl) { int w0 = 0, w1 = 0;
        w0 = __builtin_amdgcn_cvt_pk_fp8_f32(val[2 * ipl][0] * pscale, val[2 * ipl][1] * pscale, w0, false); w0 = __builtin_amdgcn_cvt_pk_fp8_f32(val[2 * ipl][2] * pscale, val[2 * ipl][3] * pscale, w0, true);
        w1 = __builtin_amdgcn_cvt_pk_fp8_f32(val[2 * ipl + 1][0] * pscale, val[2 * ipl + 1][1] * pscale, w1, false); w1 = __builtin_amdgcn_cvt_pk_fp8_f32(val[2 * ipl + 1][2] * pscale, val[2 * ipl + 1][3] * pscale, w1, true);
        pl[ipl][0] = w0; pl[ipl][1] = w1; }
    long Pf[8];
#pragma unroll
    for (int ipl = 0; ipl < 2; ++ipl) {
        Pf[ipl] = (long)(((unsigned long long)(unsigned)pl[ipl][1] << 32) | (unsigned long long)(unsigned)pl[ipl][0]);
#define PF_GATHER(c, ctrl) do { const int lo_ = __builtin_amdgcn_update_dpp(0, pl[ipl][0], ctrl, 0xF, 0x1, false), hi_ = __builtin_amdgcn_update_dpp(0, pl[ipl][1], ctrl, 0xF, 0x1, false); \
            Pf[2 * (c) + ipl] = (long)(((unsigned long long)(unsigned)hi_ << 32) | (unsigned long long)(unsigned)lo_); } while (0)
        PF_GATHER(1, 0x104); PF_GATHER(2, 0x108); PF_GATHER(3, 0x10C);
#undef PF_GATHER
    }
#undef DPP_F
    f32x4 O[8];
#pragma unroll
    for (int ct = 0; ct < 8; ++ct) O[ct] = (f32x4){0.f, 0.f, 0.f, 0.f};
    if (qi < NQW - 1) AT_LOADI(t + 1, kixn);
    const h16x8 gate = *(const h16x8*)((const h16*)(p.ws + OFF_AZ) + (size_t)bt * 1024 + (4 * g) * 128 + 8 * lane);
    const int q4 = fr >> 2, pp = fr & 3;
    typedef int v2i_t __attribute__((__vector_size__(2 * sizeof(int))));
#define AT_STOREV(Vx) do { _Pragma("unroll") for (int it = 0; it < 8; ++it) { const int r = 8 * (lane >> 3) + it; const int fk = ((r >> 2) & 3) | (((r >> 4) & 1) << 2); \
        *(u32x4*)(vl + r * 128 + (((lane & 7) ^ fk) << 4)) = Vx[it]; } } while (0)
#define AT_PV(c) do { _Pragma("unroll") for (int ipl = 0; ipl < 2; ++ipl) { const int qq = fr >> 1; const int r = 16 * kg + 4 * (qq & 3) + 2 * ipl + (qq >> 2); const int fk = ((r >> 2) & 3) | (((r >> 4) & 1) << 2); \
        _Pragma("unroll") for (int ct = 0; ct < 8; ++ct) { const LAS unsigned char* a0 = vll + r * 128 + ((ct ^ fk) << 4) + (fr & 1) * 8; \
            const v2i_t bv = __builtin_amdgcn_ds_read_tr8_b64_v2i32((LAS v2i_t*)a0); \
            O[ct] = __builtin_amdgcn_mfma_f32_16x16x32_fp8_fp8(Pf[2 * (c) + ipl], __builtin_bit_cast(long, bv), O[ct], 0, 0, 0); } } } while (0)
    AT_LOADV(VB, 1); AT_STOREV(VA); AT_PV(0);
    AT_LOADV(VA, 2); AT_STOREV(VB); AT_PV(1);
    AT_LOADV(VB, 3); AT_STOREV(VA); AT_PV(2);
    AT_STOREV(VB); AT_PV(3);
#undef AT_LOADK
#undef AT_MMAK
#undef AT_LOADV
#undef AT_STOREV
#undef AT_PV
    h16* ot = (h16*)vl;
    if (kg == 0) {
#pragma unroll
        for (int ct = 0; ct < 8; ++ct)
#pragma unroll
            for (int r = 0; r < 4; ++r) ot[r * 128 + 16 * ct + fr] = (h16)O[ct][r];
    }
    {
        const h16x8 ov = *(const h16x8*)(ot + 8 * lane);
        h16x8 res;
#pragma unroll
        for (int j = 0; j < 8; ++j) res[j] = (h16)((float)ov[j] * (float)gate[j] * (1.0f / 256.0f));
        *(h16x8*)((h16*)(p.ws + OFF_OMIX) + (size_t)bt * 2048 + 1024 + (4 * g) * 128 + 8 * lane) = res;
    }
#pragma unroll
    for (int c = 0; c < 4; ++c) kix[c] = kixn[c];
    }
#undef AT_LOADI
}

__device__ __forceinline__ void phase5(const Params& p) {
    const int tid = opaque_tid(), wid = tid >> 6, lane = tid & 63;
    const int gw = blockIdx.x * 8 + wid, nw = gridDim.x * 8;
    const float* rowss = (const float*)(p.ws + OFF_ROWSS);
    for (int row = gw; row < BT; row += nw) {
        const float r = 1.0f / sqrtf(rowss[row] * (1.0f / DM) + EPS);
        f32x4* o = (f32x4*)(p.out + (size_t)row * DM);
        float eadd = 0.f;
        if ((TS_A >= 0 || TS_ACC >= 0) && row < 164) { const unsigned* ts = (const unsigned*)(p.ws + OFF_CTRL + 8192); const float tus = (TS_ACC >= 0) ? (float)ts[16 + (TS_ACC >= 0 ? TS_ACC : 0)] * (0.01f / 256.0f) : (float)(ts[TS_B >= 0 ? TS_B : 0] - ts[TS_A >= 0 ? TS_A : 0]) * 0.01f; eadd = sqrtf(tus * 1e-5f); }
#pragma unroll
        for (int i = 0; i < 8; ++i) { const f32x4 g = ((const f32x4*)p.final_g)[lane + 64 * i]; f32x4 v = o[lane + 64 * i]; v = v * r * g + eadd; o[lane + 64 * i] = v; }
    }
}

#define XB_TMO      128
#define XB_XCNT(j)  (256  + 64 * (j))
#define XB_XSUB(j)  (1280 + 64 * (j))
#define XB_XGEN(j)  (2304 + 64 * (j))
#define XB_TOP      3328
#define XB_TOPGEN   3392
#define XCD_BAR_WORDS 3456
#define XB_SPIN_CAP (1u << 18)

__device__ __forceinline__ unsigned xb_ld(unsigned* p)              { return __hip_atomic_load(p, __ATOMIC_RELAXED, __HIP_MEMORY_SCOPE_AGENT); }
__device__ __forceinline__ unsigned xb_add(unsigned* p, unsigned v) { return __hip_atomic_fetch_add(p, v, __ATOMIC_RELAXED, __HIP_MEMORY_SCOPE_AGENT); }
__device__ __forceinline__ unsigned xb_xcc_id() { return (unsigned)__builtin_amdgcn_s_getreg((3 << 11) | 20) & 0xFu; }
#define XB_SPIN(cond, bar) do { unsigned _sp = 0; while (cond) { __builtin_amdgcn_s_sleep(1); \
    if ((++_sp & 255u) == 0u) { if (xb_ld(&(bar)[XB_TMO])) break; if (_sp > XB_SPIN_CAP) { atomicAdd(&(bar)[XB_TMO], 1u); break; } } } } while (0)

struct XcdBarrier {
    unsigned* bar; unsigned x;
    volatile LAS unsigned* st;
};

__device__ __forceinline__ XcdBarrier xcd_barrier_post(unsigned* bar, volatile LAS unsigned* st) {
    XcdBarrier b; b.bar = bar; b.x = xb_xcc_id(); b.st = st;
    if (threadIdx.x == 0) (void)xb_add(&bar[XB_XCNT(b.x)], 1u);
    return b;
}
__device__ __forceinline__ void xcd_barrier_complete(unsigned* bar, unsigned x, unsigned& nloc, unsigned& nx) {
    const unsigned G = gridDim.x * gridDim.y * gridDim.z;
    unsigned sum, cnt, mine, sp = 0u;
    for (;;) {
        sum = 0u; cnt = 0u; mine = 0u;
#pragma unroll
        for (unsigned j = 0; j < 16; ++j) { const unsigned c = xb_ld(&bar[XB_XCNT(j)]); sum += c; cnt += (c > 0u) ? 1u : 0u; mine = (j == x) ? c : mine; }
        if (sum == G) break;
        __builtin_amdgcn_s_sleep(1);
        if ((++sp & 255u) == 0u) { if (xb_ld(&bar[XB_TMO])) break; if (sp > XB_SPIN_CAP) { atomicAdd(&bar[XB_TMO], 1u); break; } }
    }
    nloc = mine > 0u ? mine : 1u; nx = cnt > 0u ? cnt : 1u;
}

__device__ __forceinline__ void xcd_barrier(const XcdBarrier& b) {
    asm volatile("s_waitcnt vmcnt(0)" ::: "memory");
    __syncthreads();
    if (threadIdx.x == 0) {
        unsigned* bar = b.bar;
        __builtin_amdgcn_s_waitcnt(0);
        unsigned nloc = b.st[0], nx = b.st[1];
        if (nloc == 0u) { xcd_barrier_complete(bar, b.x, nloc, nx); b.st[0] = nloc; b.st[1] = nx; }
        const unsigned old = xb_add(&bar[XB_XSUB(b.x)], 1u);
        const unsigned gen = old / nloc;
        if (old + 1u == (gen + 1u) * nloc) {
            __builtin_amdgcn_fence(__ATOMIC_RELEASE, "agent");
            asm volatile("s_waitcnt vmcnt(0)" ::: "memory");
            const unsigned og = xb_add(&bar[XB_TOP], 1u);
            const unsigned tg = og / nx;
            if (og + 1u == (tg + 1u) * nx) xb_add(&bar[XB_TOPGEN], 1u);
            else XB_SPIN(xb_ld(&bar[XB_TOPGEN]) == tg, bar);
            __builtin_amdgcn_fence(__ATOMIC_ACQUIRE, "agent");
            xb_add(&bar[XB_XGEN(b.x)], 1u);
            asm volatile("s_waitcnt vmcnt(0)" ::: "memory");
        } else {
            XB_SPIN(xb_ld(&bar[XB_XGEN(b.x)]) == gen, bar);
            __builtin_amdgcn_fence(__ATOMIC_ACQUIRE, "agent");
            asm volatile("s_waitcnt vmcnt(0)" ::: "memory");
        }
    }
    __syncthreads();
}


template <int LO, int HI>
__global__ void __launch_bounds__(512, 2) k_phases(Params p) {
    extern __shared__ __attribute__((aligned(16))) unsigned char smem[];
#define IN(k) (LO <= (k) && (k) < HI)
#define SEAM(k) do { if constexpr (IN(k) && IN((k) + 1)) { xcd_barrier(xbar); if (TS_A >= 0 && blockIdx.x == 0 && threadIdx.x == 0) ((unsigned*)(p.ws + OFF_CTRL + 8192))[(k) + 1] = (unsigned)__builtin_amdgcn_s_memrealtime(); } } while (0)
    XcdBarrier xbar; xbar.bar = nullptr; xbar.x = 0; xbar.st = nullptr;
    if constexpr (HI - LO > 1) {
        volatile LAS unsigned* stw = (volatile LAS unsigned*)((LAS unsigned char*)smem + LDS_BYTES - 48);
        if (threadIdx.x < 4) stw[threadIdx.x] = 0u;
        __syncthreads();
        xbar = xcd_barrier_post((unsigned*)(p.ws + OFF_CTRL + 16384), stw);
    }
    if (TS_A >= 0 && blockIdx.x == 0 && threadIdx.x == 0) ((unsigned*)(p.ws + OFF_CTRL + 8192))[0] = (unsigned)__builtin_amdgcn_s_memrealtime();
    if constexpr (IN(0)) { for (int rep = 0; rep < NREP(0); ++rep) phase0(p, smem); }
    SEAM(0);
    if constexpr (IN(1)) for (int rep = 0; rep < NREP(1); ++rep) {
        pg8::Gemm g{(const h16*)(p.ws + OFF_H), (const h16*)(p.ws + OFF_WT), BT, NPAD, DM};
        pg8::StaticOrder S; S.init(BT, NPAD, gridDim.x, blockIdx.x);
        EpiIn E{p.ws, p.a_log, p.dt_bias};
        pg8::gemm_phase<EpiIn, pg8::StaticOrder>((LAS unsigned char*)smem, g, S, E);
    }
    SEAM(1);
    if constexpr (IN(2)) for (int rep = 0; rep < NREP(2); ++rep) {
        {
            unsigned* qctr = (unsigned*)(p.ws + OFF_CTRL);
            volatile unsigned* lds_t = (volatile unsigned*)(smem + LDS_BYTES - 16);
            __syncthreads();
            if (threadIdx.x == 0) lds_t[0] = atomicAdd(qctr + 0 + 16 * rep, 1u);
            __syncthreads();
            unsigned o = lds_t[0];
            while (o < 1024u + 2048u) {
                unsigned nxt = 0u;
                if (threadIdx.x == 0) nxt = atomicAdd(qctr + 0 + 16 * rep, 1u);
                if (o < 1024u) { ACC_T0(); gdn_prep_pair(p, smem, (int)o); __syncthreads(); ACC_ADD(0); }
                else { const unsigned o2 = o - 1024u; idx8_task(p, smem, (int)(o2 & 3u), 511 - (int)(o2 >> 2)); }
                __syncthreads();
                if (threadIdx.x == 0) lds_t[0] = nxt;
                __syncthreads();
                o = lds_t[0];
            }
        }
    }
    SEAM(2);
    if constexpr (IN(3)) for (int rep = 0; rep < NREP(3); ++rep) {
        {
            unsigned* qctr = (unsigned*)(p.ws + OFF_CTRL);
            volatile unsigned* lds_t = (volatile unsigned*)(smem + LDS_BYTES - 16);
            volatile unsigned* lds_c = (volatile unsigned*)(smem + LDS_BYTES - 192);
            const int myx = (int)(xb_xcc_id() & 7u);
            for (int pass = 0; pass < 2; ++pass) {
                if (pass == 1) { __syncthreads(); if (threadIdx.x < 8) lds_c[8 + threadIdx.x] = __hip_atomic_load(qctr + 64 + 16 * rep + threadIdx.x, __ATOMIC_RELAXED, __HIP_MEMORY_SCOPE_AGENT); __syncthreads(); }
                const int nk = pass == 0 ? 1 : 8;
                for (int k = 0; k < nk; ++k) {
                    const int sp = (myx + k) & 7;
                    if (pass == 1 && lds_c[8 + sp] >= 4u) continue;
                    for (;;) {
                        __syncthreads();
                        if (threadIdx.x == 0) lds_t[0] = atomicAdd(qctr + 64 + 16 * rep + sp, 1u);
                        __syncthreads();
                        const unsigned o = lds_t[0];
                        if (o >= 4u) break;
                        { ACC_T0(); gdn_scan_task(p, smem, 4 * sp + (int)o); __syncthreads(); ACC_ADD(4); }
                        if (pass == 0) break;
                    }
                }
                if (pass == 0) for (int k = 0; k < 8; ++k) {
                    const int part = (myx + k) & 7;
                    if (k == 1) { __syncthreads(); if (threadIdx.x < 8) lds_c[threadIdx.x] = __hip_atomic_load(qctr + 128 + 16 * rep + threadIdx.x, __ATOMIC_RELAXED, __HIP_MEMORY_SCOPE_AGENT); __syncthreads(); }
                    if (k >= 1 && lds_c[part] >= 512u) continue;
                    __syncthreads();
                    if (threadIdx.x == 0) lds_t[0] = atomicAdd(qctr + 128 + 16 * rep + part, 1u);
                    __syncthreads();
                    unsigned a = lds_t[0];
                    while (a < 512u) {
                        unsigned nxt = 0u;
                        if (threadIdx.x == 0) nxt = atomicAdd(qctr + 128 + 16 * rep + part, 1u);
                        { ACC_T0(); attn8_task(p, smem, part, (int)a); __syncthreads(); ACC_ADD(3); }
                        __syncthreads();
                        if (threadIdx.x == 0) lds_t[0] = nxt;
                        __syncthreads();
                        a = lds_t[0];
                    }
                }
            }
        }
    }
    SEAM(3);
    const bool fuse_norm = (gridDim.x == 256) && (TS_A < 0) && (TS_ACC < 0);
    if constexpr (IN(4)) {
        pg8::Gemm g{(const h16*)(p.ws + OFF_OMIX), (const h16*)(p.ws + OFF_WOT), BT, DM, DM};
        if (fuse_norm) {
            PanelOrder S; S.c = blockIdx.x;
            EpiOutNorm E{p.x, p.out, (float*)(p.ws + OFF_ROWSS), (unsigned*)(p.ws + OFF_CTRL + 32768), p.final_g};
            pg8::gemm_phase<EpiOutNorm, PanelOrder>((LAS unsigned char*)smem, g, S, E);
        } else {
            pg8::StaticOrder S; S.init(BT, DM, gridDim.x, blockIdx.x);
            EpiOut E{p.x, p.out, (float*)(p.ws + OFF_ROWSS)};
            pg8::gemm_phase<EpiOut, pg8::StaticOrder>((LAS unsigned char*)smem, g, S, E);
        }
    }
    if (fuse_norm) return;
    SEAM(4);
    if constexpr (IN(5)) { phase5(p); }
#undef IN
#undef SEAM
}

template <int LO, int HI> static void launch_range(const Params& p, int grid, hipStream_t stream, bool coop) {
    static bool attr = false;
    if (!attr) { hipFuncSetAttribute((const void*)k_phases<LO, HI>, hipFuncAttributeMaxDynamicSharedMemorySize, LDS_BYTES); attr = true; }
    if (coop) {
        Params pp = p; void* args[] = {&pp};
        hipError_t e = hipLaunchCooperativeKernel((const void*)k_phases<LO, HI>, dim3(grid), dim3(512), args, LDS_BYTES, stream);
        if (e != hipSuccess) fprintf(stderr, "cooperative launch failed: %s (grid %d)\n", hipGetErrorString(e), grid);
    } else {
        hipLaunchKernelGGL((k_phases<LO, HI>), dim3(grid), dim3(512), LDS_BYTES, stream, p);
    }
}

extern "C" void kernel_launch(void* const* d_in, const int* in_sizes, int n_in, void* d_out, int out_size, void* d_ws, size_t ws_size, hipStream_t stream) {
    if (n_in != 10 || in_sizes[0] != BT * DM || out_size != BT * DM || ws_size < WS_END) {
        fprintf(stderr, "kernel_launch: unexpected shapes (n_in %d in0 %d out %d ws %zu need %zu)\n", n_in, n_in > 0 ? in_sizes[0] : -1, out_size, ws_size, (size_t)WS_END); return; }
    static int grid = 0;
    if (!grid) {
        int dev = 0, cus = 0, per_cu = 0; hipGetDevice(&dev); hipDeviceGetAttribute(&cus, hipDeviceAttributeMultiprocessorCount, dev);
#if FUSED
        hipFuncSetAttribute((const void*)k_phases<0, 6>, hipFuncAttributeMaxDynamicSharedMemorySize, LDS_BYTES);
        hipOccupancyMaxActiveBlocksPerMultiprocessor(&per_cu, (const void*)k_phases<0, 6>, 512, LDS_BYTES);
#else
        per_cu = 1;
#endif
        if (per_cu < 1) per_cu = 1; if (per_cu > 1) per_cu = 1;
        grid = cus * per_cu;
    }
    Params p{};
    p.x = (const float*)d_in[0]; p.pos = (const int*)d_in[1]; p.attn_g = (const float*)d_in[2]; p.w_in = (const float*)d_in[3]; p.conv_w = (const float*)d_in[4];
    p.a_log = (const float*)d_in[5]; p.dt_bias = (const float*)d_in[6]; p.gdn_norm_g = (const float*)d_in[7]; p.w_out = (const float*)d_in[8]; p.final_g = (const float*)d_in[9];
    p.out = (float*)d_out; p.ws = (unsigned char*)d_ws;
    hipMemsetAsync((char*)d_ws + OFF_CTRL, 0, CTL_ZERO_BYTES, stream);
#if FUSED
    launch_range<0, 6>(p, grid, stream, false);
#else
    launch_range<0, 1>(p, grid, stream, false);
    launch_range<1, 2>(p, grid, stream, false);
    launch_range<2, 3>(p, grid, stream, false);
    launch_range<3, 4>(p, grid, stream, false);
    launch_range<4, 5>(p, grid, stream, false);
    launch_range<5, 6>(p, grid, stream, false);
#endif
}
```

```cpp
#include <hip/hip_runtime.h>
#include <hip/hip_cooperative_groups.h>
#include <cstdio>
#include <cstdint>
namespace cg = cooperative_groups;

#ifndef FUSED
#define FUSED 1
#endif
#ifndef REPEAT_PHASE
#define REPEAT_PHASE -1
#endif
#define NREP(k) ((REPEAT_PHASE == (k)) ? 2 : 1)
#ifndef TS_A
#define TS_A -1
#endif
#ifndef TS_ACC
#define TS_ACC -1
#endif
#define ACC_T0() unsigned acc_t0_ = 0; if (TS_ACC >= 0 && threadIdx.x == 0) acc_t0_ = (unsigned)__builtin_amdgcn_s_memrealtime()
#define ACC_ADD(k) do { if (TS_ACC >= 0 && threadIdx.x == 0) { const unsigned t1_ = (unsigned)__builtin_amdgcn_s_memrealtime(); atomicAdd((unsigned*)(p.ws + OFF_CTRL + 8192) + 16 + (k), t1_ - acc_t0_); acc_t0_ = t1_; } } while (0)
#ifndef TS_B
#define TS_B -1
#endif

#define LAS __attribute__((address_space(3)))
typedef _Float16 h16;
typedef h16 h16x8 __attribute__((ext_vector_type(8)));
typedef h16 h16x4 __attribute__((ext_vector_type(4)));
typedef h16 h16x2 __attribute__((ext_vector_type(2)));
typedef float f32x4 __attribute__((ext_vector_type(4)));
typedef float f32x2 __attribute__((ext_vector_type(2)));
typedef unsigned u32x4 __attribute__((ext_vector_type(4)));

constexpr int NB = 4, NT = 4096, DM = 2048, BT = NB * NT;
constexpr int IN_COLS = 7776, NPAD = 7936;
constexpr float EPS = 1e-6f;
constexpr int LDS_BYTES = 155648;

constexpr size_t MB = 1024 * 1024;
constexpr size_t OFF_CTRL = 0;
constexpr size_t OFF_ROWSS = 65536;
constexpr size_t CTL_ZERO_BYTES = 65536 + (size_t)BT * 4;
constexpr size_t OFF_H = 1 * MB;
constexpr size_t OFF_OMIX = OFF_H;
constexpr size_t OFF_WT = OFF_H + 64 * MB;
constexpr size_t OFF_WOT = OFF_WT + (size_t)NPAD * 2048 * 2;
constexpr size_t OFF_QKVR = OFF_WOT + 8 * MB;
constexpr size_t OFF_GZ = OFF_QKVR + (size_t)BT * 3072 * 2;
constexpr size_t OFF_AQ = OFF_GZ + 32 * MB;
constexpr size_t OFF_AK = OFF_AQ + 32 * MB;
constexpr size_t OFF_AV = OFF_AK + 8 * MB;
constexpr size_t OFF_AZ = OFF_AV + 8 * MB;
constexpr size_t OFF_IQ = OFF_AZ + 32 * MB;
constexpr size_t OFF_IK = OFF_IQ + 32 * MB;
constexpr size_t OFF_GB = OFF_IK + 2 * MB;
constexpr size_t OFF_IW = OFF_GB + 1 * MB;
constexpr size_t OFF_COS = OFF_IW + 1 * MB;
constexpr size_t OFF_SIN = OFF_COS + 2 * MB;
constexpr size_t OFF_SEL = OFF_SIN + 2 * MB;
constexpr size_t OFF_REC = OFF_SEL + 8 * MB;
constexpr size_t OFF_H8 = OFF_REC;
constexpr size_t OFF_WT8 = OFF_REC + 32 * MB;
constexpr size_t WS_END = OFF_REC + (size_t)2048 * 74752;

struct Params {
    const float* x; const int* pos; const float* attn_g; const float* w_in; const float* conv_w; const float* a_log;
    const float* dt_bias; const float* gdn_norm_g; const float* w_out; const float* final_g; float* out; unsigned char* ws;
};

__device__ __forceinline__ float wave_sum(float v) {
#pragma unroll
    for (int o = 1; o < 64; o <<= 1) v += __shfl_xor(v, o);
    return v;
}
__device__ __forceinline__ float wave_max(float v) {
#pragma unroll
    for (int o = 1; o < 64; o <<= 1) v = fmaxf(v, __shfl_xor(v, o));
    return v;
}
__device__ __forceinline__ int opaque_tid() { int t = threadIdx.x; asm volatile("" : "+v"(t)); return t; }
__device__ __forceinline__ float silu_f(float x) { return x * __builtin_amdgcn_rcpf(1.0f + __builtin_amdgcn_exp2f(-1.4426950408889634f * x)); }

namespace pg8 {
constexpr int BM = 256, BK = 64, HALF = 128, HTB = HALF * BK * 2, STAGE_BYTES = 8 * HTB, NXCD = 8, WGM = 8;
__host__ __device__ __forceinline__ int lds_byte(int r, int c) { const int st = (r >> 4) * 2 + (c >> 5), rr = r & 15, cc = c & 31, ob = rr * 64 + cc * 2; return st * 1024 + (ob ^ (((ob >> 9) & 1) << 5)); }
__host__ __device__ __forceinline__ void stage_rc(int b, int& R, int& C) { const int st = b / 1024, sb = b % 1024, swz = sb ^ (((sb >> 9) & 1) << 5); R = (st >> 1) * 16 + swz / 64; C = (st & 1) * 32 + (swz % 64) / 2; }
__host__ __device__ __forceinline__ int perm32(int rho) { const int n = rho >> 4, i = rho & 15; return 8 * (i >> 2) + 4 * n + (i & 3); }
struct Unit { int pm, pn; };
struct Gemm { const h16* A; const h16* Bt; int M, N, K; };
struct StaticOrder {
    int nM, nN, nwg, G, c;
    __host__ __device__ void init(int M, int N, int G_, int c_) { nM = M / BM; nN = N / BM; nwg = nM * nN; G = G_; c = c_; }
    __host__ __device__ bool next(int i, Unit& u) const {
        const long L = (long)i * G + c; if (L >= nwg) return false;
        int wgid = (int)L; { const int q = nwg / NXCD, r = nwg % NXCD, xcd = wgid % NXCD, off = wgid / NXCD; wgid = (xcd < r ? xcd * (q + 1) : r * (q + 1) + (xcd - r) * q) + off; }
        const int nig = WGM * nN, gid = wgid / nig, fm = gid * WGM, gsz = (nM - fm) < WGM ? (nM - fm) : WGM;
        u.pm = fm + ((wgid % nig) % gsz); u.pn = (wgid % nig) / gsz; return true;
    }
    __device__ __forceinline__ void a_ready(const Unit&) const {}
    __device__ __forceinline__ void done(const Unit&) const {}
};

typedef int i32x8 __attribute__((ext_vector_type(8)));
template <class Epi, class Sched, bool SP2 = true, bool F8 = false>
__device__ __forceinline__ void gemm_phase(LAS unsigned char* lds, const Gemm g, const Sched& S, const Epi& E) {
    const int tid = opaque_tid(), wid = __builtin_amdgcn_readfirstlane(tid >> 6), lane = tid & 63, wr = wid >> 2, wc = wid & 3, fr = lane & 15, fq = lane >> 4;
    const int K = g.K;
    const int ESZ = F8 ? 1 : 2, nt = (K * ESZ) / 128;
    unsigned voffA[2], voffB[2];
#pragma unroll
    for (int i = 0; i < 2; ++i) { int R, C; stage_rc(tid * 16 + i * 8192, R, C); const int Rb = Epi::PERM ? ((R & ~31) + perm32(R & 31)) : R;
        voffA[i] = (unsigned)(R * K * ESZ + C * 2); voffB[i] = (unsigned)(Rb * K * ESZ + C * 2); }
    const size_t kstep = (size_t)(BK * 2);
    const size_t hstep = (size_t)HALF * K * ESZ;
    const size_t tstep = 2 * hstep;
    const unsigned ldsw = (unsigned)wid * 1024u;
    const int aoff = lds_byte(wr * 64 + fr, fq * 8), boff = lds_byte(wc * 32 + fr, fq * 8);
#define PG8_SA(b, h) (((b) * 2 + (h)) * HTB)
#define PG8_SB(b, h) ((4 + (b) * 2 + (h)) * HTB)
#define PG8_STAGE(bufoff, gbase, voff) do { _Pragma("unroll") for (int _i = 0; _i < 2; ++_i) \
        __builtin_amdgcn_global_load_lds((const unsigned*)((const char*)(gbase) + (voff)[_i]), (LAS unsigned*)(lds + (bufoff) + ldsw + _i * 8192), 16, 0, 0); } while (0)
#define PG8_LDA(dst, b, h) do { _Pragma("unroll") for (int m = 0; m < 4; ++m) _Pragma("unroll") for (int k = 0; k < 2; ++k) dst[m][k] = *(const LAS h16x8*)(lds + PG8_SA(b, h) + aoff + m * 2048 + k * 1024); } while (0)
#define PG8_LDB(dst, b, h) do { _Pragma("unroll") for (int n = 0; n < 2; ++n) _Pragma("unroll") for (int k = 0; k < 2; ++k) dst[n][k] = *(const LAS h16x8*)(lds + PG8_SB(b, h) + boff + n * 2048 + k * 1024); } while (0)
#define PG8_MMA(ai, bj, At, Bt) do { __builtin_amdgcn_s_setprio(1); \
        if constexpr (F8) { _Pragma("unroll") for (int m = 0; m < 4; ++m) _Pragma("unroll") for (int n = 0; n < 2; ++n) { \
            const u32x4 b0_ = __builtin_bit_cast(u32x4, Bt[n][0]), b1_ = __builtin_bit_cast(u32x4, Bt[n][1]), a0_ = __builtin_bit_cast(u32x4, At[m][0]), a1_ = __builtin_bit_cast(u32x4, At[m][1]); \
            const i32x8 bw_ = (i32x8){(int)b0_[0], (int)b0_[1], (int)b0_[2], (int)b0_[3], (int)b1_[0], (int)b1_[1], (int)b1_[2], (int)b1_[3]}; \
            const i32x8 aw_ = (i32x8){(int)a0_[0], (int)a0_[1], (int)a0_[2], (int)a0_[3], (int)a1_[0], (int)a1_[1], (int)a1_[2], (int)a1_[3]}; \
            asm volatile("v_mfma_scale_f32_16x16x128_f8f6f4 %0, %1, %2, %0, %3, %3 op_sel_hi:[0,0,0]" : "+v"(acc[ai][bj][m][n]) : "v"(bw_), "v"(aw_), "v"(0x7C7C7C7C)); } } \
        else { _Pragma("unroll") for (int m = 0; m < 4; ++m) _Pragma("unroll") for (int n = 0; n < 2; ++n) _Pragma("unroll") for (int k = 0; k < 2; ++k) \
            acc[ai][bj][m][n] = __builtin_amdgcn_mfma_f32_16x16x32_f16(Bt[n][k], At[m][k], acc[ai][bj][m][n], 0, 0, 0); } \
        __builtin_amdgcn_s_setprio(0); } while (0)
#define PG8_WAIT_V(n) asm volatile("s_waitcnt vmcnt(" #n ")" ::: "memory")
#define PG8_WAIT_L(n) asm volatile("s_waitcnt lgkmcnt(" #n ")" ::: "memory")
#define PG8_BAR __builtin_amdgcn_s_barrier()
#define PG8_SCHED __builtin_amdgcn_sched_barrier(0)
    Unit cur, nxt; int ui = 0;
    if (!S.next(0, cur)) return;
    f32x4 acc[2][2][4][2];
#pragma unroll
    for (int a = 0; a < 2; ++a)
#pragma unroll
        for (int b = 0; b < 2; ++b)
#pragma unroll
            for (int m = 0; m < 4; ++m)
#pragma unroll
                for (int n = 0; n < 2; ++n) acc[a][b][m][n] = (f32x4){0.f, 0.f, 0.f, 0.f};
    h16x8 At[4][2], B0[2][2], B1[2][2];
    const char* cA = (const char*)g.A + (size_t)cur.pm * tstep; const char* cB = (const char*)g.Bt + (size_t)cur.pn * tstep;
    S.a_ready(cur);
    if constexpr (SP2) {
        PG8_STAGE(PG8_SB(0, 0), cB, voffB); PG8_STAGE(PG8_SB(0, 1), cB + hstep, voffB); PG8_STAGE(PG8_SA(0, 0), cA, voffA); PG8_STAGE(PG8_SA(0, 1), cA + hstep, voffA);
        if (wr == 1) PG8_BAR;
        PG8_WAIT_V(2); PG8_BAR;
        PG8_STAGE(PG8_SB(1, 0), cB + kstep, voffB); PG8_STAGE(PG8_SA(1, 0), cA + kstep, voffA); PG8_STAGE(PG8_SB(1, 1), cB + hstep + kstep, voffB);
        PG8_WAIT_V(6); PG8_BAR;
    } else {
    PG8_STAGE(PG8_SB(0, 0), cB, voffB); PG8_STAGE(PG8_SA(0, 0), cA, voffA); PG8_STAGE(PG8_SB(0, 1), cB + hstep, voffB); PG8_STAGE(PG8_SA(0, 1), cA + hstep, voffA);
    if (wr == 1) PG8_BAR;
    PG8_WAIT_V(4); PG8_BAR;
    PG8_STAGE(PG8_SB(1, 0), cB + kstep, voffB); PG8_STAGE(PG8_SA(1, 0), cA + kstep, voffA); PG8_STAGE(PG8_SB(1, 1), cB + hstep + kstep, voffB);
    PG8_WAIT_V(6); PG8_BAR;
    }
    for (;;) {
        const bool has_next = S.next(ui + 1, nxt);
        const char* nA = has_next ? (const char*)g.A + (size_t)nxt.pm * tstep : cA; const char* nB = has_next ? (const char*)g.Bt + (size_t)nxt.pn * tstep : cB;
        for (int t = 0; t < nt; t += 2) {
            const bool last = (t == nt - 2);
            const char* a1 = cA + (size_t)(t + 1) * kstep;
            const char* a2 = last ? nA : cA + (size_t)(t + 2) * kstep; const char* b2 = last ? nB : cB + (size_t)(t + 2) * kstep;
            const char* a3 = a2 + kstep; const char* b3 = b2 + kstep;
            if (last && has_next) S.a_ready(nxt);
            if constexpr (SP2) {
            PG8_LDB(B0, 0, 0); PG8_LDB(B1, 0, 1); PG8_SCHED; PG8_LDA(At, 0, 0); PG8_STAGE(PG8_SA(1, 1), a1 + hstep, voffA);
            PG8_WAIT_V(8); PG8_WAIT_L(0); PG8_BAR; PG8_MMA(0, 0, At, B0); PG8_MMA(0, 1, At, B1); PG8_BAR; PG8_SCHED;
            PG8_LDA(At, 0, 1); PG8_STAGE(PG8_SB(0, 0), b2, voffB); PG8_STAGE(PG8_SB(0, 1), b2 + hstep, voffB); PG8_STAGE(PG8_SA(0, 0), a2, voffA);
            PG8_WAIT_V(8); PG8_WAIT_L(0); PG8_BAR; PG8_MMA(1, 0, At, B0); PG8_MMA(1, 1, At, B1); PG8_BAR; PG8_SCHED;
            PG8_LDB(B0, 1, 0); PG8_LDB(B1, 1, 1); PG8_SCHED; PG8_LDA(At, 1, 0); PG8_STAGE(PG8_SA(0, 1), a2 + hstep, voffA);
            PG8_WAIT_V(8); PG8_WAIT_L(0); PG8_BAR; PG8_MMA(0, 0, At, B0); PG8_MMA(0, 1, At, B1); PG8_BAR; PG8_SCHED;
            PG8_LDA(At, 1, 1); PG8_STAGE(PG8_SB(1, 0), b3, voffB); PG8_STAGE(PG8_SB(1, 1), b3 + hstep, voffB); PG8_STAGE(PG8_SA(1, 0), a3, voffA);
            PG8_WAIT_V(8); PG8_WAIT_L(0); PG8_BAR; PG8_MMA(1, 0, At, B0); PG8_MMA(1, 1, At, B1); PG8_BAR; PG8_SCHED;
            } else {
            PG8_LDB(B0, 0, 0); PG8_SCHED; PG8_LDA(At, 0, 0); PG8_STAGE(PG8_SA(1, 1), a1 + hstep, voffA);
            PG8_WAIT_L(8); PG8_BAR; PG8_WAIT_L(0); PG8_MMA(0, 0, At, B0); PG8_BAR; PG8_SCHED;
            PG8_LDB(B1, 0, 1); PG8_STAGE(PG8_SB(0, 0), b2, voffB);
            PG8_BAR; PG8_WAIT_L(0); PG8_MMA(0, 1, At, B1); PG8_BAR;
            PG8_LDA(At, 0, 1); PG8_STAGE(PG8_SA(0, 0), a2, voffA);
            PG8_BAR; PG8_WAIT_L(0); PG8_MMA(1, 0, At, B0); PG8_BAR; PG8_SCHED;
            PG8_STAGE(PG8_SB(0, 1), b2 + hstep, voffB);
            PG8_WAIT_V(6); PG8_BAR; PG8_MMA(1, 1, At, B1); PG8_BAR;
            PG8_LDB(B0, 1, 0); PG8_SCHED; PG8_LDA(At, 1, 0); PG8_STAGE(PG8_SA(0, 1), a2 + hstep, voffA);
            PG8_WAIT_L(8); PG8_BAR; PG8_WAIT_L(0); PG8_MMA(0, 0, At, B0); PG8_BAR; PG8_SCHED;
            PG8_LDB(B1, 1, 1); PG8_STAGE(PG8_SB(1, 0), b3, voffB);
            PG8_BAR; PG8_WAIT_L(0); PG8_MMA(0, 1, At, B1); PG8_BAR;
            PG8_LDA(At, 1, 1); PG8_STAGE(PG8_SA(1, 0), a3, voffA);
            PG8_BAR; PG8_WAIT_L(0); PG8_MMA(1, 0, At, B0); PG8_BAR; PG8_SCHED;
            PG8_STAGE(PG8_SB(1, 1), b3 + hstep, voffB);
            PG8_WAIT_V(6); PG8_BAR; PG8_MMA(1, 1, At, B1); PG8_BAR;
            }
        }
        if (wr == 0) PG8_BAR;
        if constexpr (F8) asm volatile("s_nop 15\n\ts_nop 15" ::: "memory");
        PG8_SCHED; { const int te = opaque_tid(), le = te & 63; E(acc, cur, wr, wc, le & 15, le >> 4); } S.done(cur);
        if (!has_next) break;
#pragma unroll
        for (int a = 0; a < 2; ++a)
#pragma unroll
            for (int b = 0; b < 2; ++b)
#pragma unroll
                for (int m = 0; m < 4; ++m)
#pragma unroll
                    for (int n = 0; n < 2; ++n) acc[a][b][m][n] = (f32x4){0.f, 0.f, 0.f, 0.f};
        cur = nxt; cA = nA; cB = nB; ++ui;
        if (wr == 1) PG8_BAR;
    }
    PG8_WAIT_V(0);
    PG8_BAR;
#undef PG8_SA
#undef PG8_SB
#undef PG8_STAGE
#undef PG8_LDA
#undef PG8_LDB
#undef PG8_MMA
#undef PG8_WAIT_V
#undef PG8_WAIT_L
#undef PG8_BAR
#undef PG8_SCHED
}
}

struct OrderF16 : pg8::StaticOrder {
    __device__ __forceinline__ bool next(int i, pg8::Unit& u) const { if (!pg8::StaticOrder::next(i, u)) return false; if (u.pn >= 16) u.pn += 10; return true; }
};
struct OrderF8 {
    int G, c;
    __device__ __forceinline__ bool next(int i, pg8::Unit& u) const {
        int L;
        if (G == 256) { if (c < 64) { if (i >= 1) return false; L = 576 + c; } else { if (i >= 3) return false; L = (c - 64) + 192 * i; } }
        else { L = i * G + c; if (L >= 640) return false; }
        const int wgid = (L % 8) * 80 + L / 8;
        u.pm = (wgid / 80) * 8 + (wgid % 80) % 8; u.pn = 16 + (wgid % 80) / 8; return true;
    }
    __device__ __forceinline__ void a_ready(const pg8::Unit&) const {}
    __device__ __forceinline__ void done(const pg8::Unit&) const {}
};

struct EpiIn {
    static constexpr bool PERM = true;
    unsigned char* ws; const float* a_log; const float* dt_bias;
    __device__ __forceinline__ void operator()(const f32x4 (&acc)[2][2][4][2], const pg8::Unit& u, int wr, int wc, int fr, int fq) const {
        const int pn = u.pn;
        const int rowb = u.pm * 256 + wr * 64 + fr;
        const int cw = wc * 32 + 8 * fq;
        const float* cosT = (const float*)(ws + OFF_COS); const float* sinT = (const float*)(ws + OFF_SIN);
        if (pn < 30) {
            h16* base; int ldc, colt, mode; float scale = 1.f;
            if (pn < 12) { base = (h16*)(ws + OFF_QKVR); ldc = 3072; colt = pn * 256; mode = 0; }
            else if (pn < 16) { base = (h16*)(ws + OFF_GZ); ldc = 1024; colt = (pn - 12) * 256; mode = 1; }
            else if (pn < 20) { base = (h16*)(ws + OFF_AQ); ldc = 1024; colt = (pn - 16) * 256; mode = 2; }
            else if (pn == 20) { base = (h16*)(ws + OFF_AK); ldc = 256; colt = 0; mode = 2; }
            else if (pn == 21) { base = (h16*)(ws + OFF_AV); ldc = 256; colt = 0; mode = 4; }
            else if (pn < 26) { base = (h16*)(ws + OFF_AZ); ldc = 1024; colt = (pn - 22) * 256; mode = 1; }
            else { base = (h16*)(ws + OFF_IQ); ldc = 1024; colt = (pn - 26) * 256; mode = 3; }
            const bool rot_wave = (mode == 2 && wc == 0) || (mode == 3 && (wc & 1) == 0);
            const int xm = (mode == 2) ? 32 : 16;
            const bool rot_lane = (mode == 2) ? true : (fq < 2);
            const float sgn = (mode == 2) ? (fq < 2 ? -1.f : 1.f) : (fq == 0 ? -1.f : 1.f);
            const int tix = (mode == 2) ? 8 * (fq & 1) : 16;
            const int pidx = (((fq << 4) | fr) ^ xm) << 2;
#pragma unroll
            for (int ai = 0; ai < 2; ++ai)
#pragma unroll
                for (int m = 0; m < 4; ++m) {
                    const int row = rowb + ai * 128 + m * 16;
                    float cs[8], sn[8];
                    if (rot_wave) {
                        const f32x4 c0 = *(const f32x4*)(cosT + (size_t)row * 24 + tix), c1 = *(const f32x4*)(cosT + (size_t)row * 24 + tix + 4);
                        const f32x4 s0 = *(const f32x4*)(sinT + (size_t)row * 24 + tix), s1 = *(const f32x4*)(sinT + (size_t)row * 24 + tix + 4);
#pragma unroll
                        for (int j = 0; j < 4; ++j) { cs[j] = c0[j]; cs[4 + j] = c1[j]; sn[j] = s0[j]; sn[4 + j] = s1[j]; }
                    }
#pragma unroll
                    for (int bj = 0; bj < 2; ++bj) {
                        float v[8];
#pragma unroll
                        for (int j = 0; j < 4; ++j) { v[j] = acc[ai][bj][m][0][j]; v[4 + j] = acc[ai][bj][m][1][j]; }
                        if (rot_wave) {
#pragma unroll
                            for (int j = 0; j < 8; ++j) { const float pv = __builtin_bit_cast(float, __builtin_amdgcn_ds_bpermute(pidx, __builtin_bit_cast(int, v[j]))); if (rot_lane) v[j] = v[j] * cs[j] + sgn * pv * sn[j]; }
                        }
                        if (mode == 1) {
#pragma unroll
                            for (int j = 0; j < 8; ++j) v[j] = silu_f(v[j]);
                        }
                        if (mode == 4) {
                            int w0 = 0, w1 = 0;
                            w0 = __builtin_amdgcn_cvt_pk_fp8_f32(v[0], v[1], w0, false); w0 = __builtin_amdgcn_cvt_pk_fp8_f32(v[2], v[3], w0, true);
                            w1 = __builtin_amdgcn_cvt_pk_fp8_f32(v[4], v[5], w1, false); w1 = __builtin_amdgcn_cvt_pk_fp8_f32(v[6], v[7], w1, true);
                            typedef int i32x2b __attribute__((ext_vector_type(2)));
                            *(i32x2b*)((unsigned char*)base + (size_t)row * ldc + bj * 128 + cw) = (i32x2b){w0, w1};
                        } else if (mode == 2) {
                            int w0 = 0, w1 = 0;
                            w0 = __builtin_amdgcn_cvt_pk_fp8_f32(v[0], v[1], w0, false); w0 = __builtin_amdgcn_cvt_pk_fp8_f32(v[2], v[3], w0, true);
                            w1 = __builtin_amdgcn_cvt_pk_fp8_f32(v[4], v[5], w1, false); w1 = __builtin_amdgcn_cvt_pk_fp8_f32(v[6], v[7], w1, true);
                            typedef int i32x2 __attribute__((ext_vector_type(2)));
                            *(i32x2*)((unsigned char*)base + (size_t)row * ldc + colt + bj * 128 + fq * 32 + wc * 8) = (i32x2){w0, w1};
                        } else {
                            h16x8 o;
#pragma unroll
                            for (int j = 0; j < 8; ++j) o[j] = (h16)(v[j] * scale);
                            *(h16x8*)(base + (size_t)row * ldc + colt + bj * 128 + cw) = o;
                        }
                    }
                }
        } else {
            h16* ik = (h16*)(ws + OFF_IK); float* gb = (float*)(ws + OFF_GB); float* iw = (float*)(ws + OFF_IW);
#pragma unroll
            for (int ai = 0; ai < 2; ++ai)
#pragma unroll
                for (int m = 0; m < 4; ++m) {
                    const int row = rowb + ai * 128 + m * 16;
                    float v[8];
#pragma unroll
                    for (int j = 0; j < 4; ++j) { v[j] = acc[ai][0][m][0][j]; v[4 + j] = acc[ai][0][m][1][j]; }
                    const f32x4 c0 = *(const f32x4*)(cosT + (size_t)row * 24 + 16), c1 = *(const f32x4*)(cosT + (size_t)row * 24 + 20);
                    const f32x4 s0 = *(const f32x4*)(sinT + (size_t)row * 24 + 16), s1 = *(const f32x4*)(sinT + (size_t)row * 24 + 20);
                    if (wc == 0) {
                        const float sgn = (fq == 0 ? -1.f : 1.f);
#pragma unroll
                        for (int j = 0; j < 8; ++j) { const float pv = __shfl_xor(v[j], 16); const float c = j < 4 ? c0[j & 3] : c1[j & 3], s = j < 4 ? s0[j & 3] : s1[j & 3];
                            if (fq < 2) v[j] = v[j] * c + sgn * pv * s; }
                    }
                    if (wc < 2) {
                        h16x8 o;
#pragma unroll
                        for (int j = 0; j < 8; ++j) o[j] = (h16)v[j];
                        *(h16x8*)(ik + (size_t)row * 64 + cw) = o;
                    } else if (wc == 2) {
                        if (fq == 0) {
#pragma unroll
                            for (int j = 0; j < 8; ++j) { const float z = v[j] + dt_bias[j]; const float sp = z > 20.f ? z : log1pf(expf(z)); gb[(size_t)row * 16 + j] = -expf(a_log[j]) * sp; }
                        } else if (fq == 1) {
#pragma unroll
                            for (int j = 0; j < 8; ++j) gb[(size_t)row * 16 + 8 + j] = 1.0f / (1.0f + expf(-v[j]));
                        } else {
#pragma unroll
                            for (int j = 0; j < 8; ++j) iw[(size_t)row * 16 + 8 * (fq - 2) + j] = v[j] * 0.03125f;
                        }
                    }
                }
        }
    }
};

struct PanelOrder {
    int c;
    __device__ __forceinline__ bool next(int i, pg8::Unit& u) const { if (i >= 2) return false; u.pm = 32 * i + 4 * (c & 7) + (c >> 6); u.pn = (c >> 3) & 7; return true; }
    __device__ __forceinline__ void a_ready(const pg8::Unit&) const {}
    __device__ __forceinline__ void done(const pg8::Unit&) const {}
};
struct EpiOutNorm {
    static constexpr bool PERM = false;
    const float* x; float* out; float* rowss; unsigned* cnt; const float* fg;
    __device__ __forceinline__ void operator()(f32x4 (&acc)[2][2][4][2], const pg8::Unit& u, int wr, int wc, int fr, int fq) const {
        const int rowb = u.pm * 256 + wr * 64 + fr, col0 = u.pn * 256 + wc * 32 + 4 * fq;
#pragma unroll
        for (int ai = 0; ai < 2; ++ai)
#pragma unroll
            for (int m = 0; m < 4; ++m) {
                const int row = rowb + ai * 128 + m * 16; float ss = 0.f;
#pragma unroll
                for (int bj = 0; bj < 2; ++bj)
#pragma unroll
                    for (int n = 0; n < 2; ++n) {
                        const f32x4 y = *(const f32x4*)(x + (size_t)row * DM + col0 + bj * 128 + n * 16) + acc[ai][bj][m][n];
                        acc[ai][bj][m][n] = y; ss += (y[0] * y[0] + y[1] * y[1]) + (y[2] * y[2] + y[3] * y[3]);
                    }
                ss += __shfl_xor(ss, 16); ss += __shfl_xor(ss, 32);
                if (fq == 0) atomicAdd(rowss + row, ss);
            }
        asm volatile("s_waitcnt vmcnt(0)" ::: "memory");
        unsigned* cw = cnt + (u.pm * 2 + wr) * 16;
        if ((threadIdx.x & 63) == 0) __hip_atomic_fetch_add(cw, 1u, __ATOMIC_RELAXED, __HIP_MEMORY_SCOPE_AGENT);
        { unsigned spins = 0;
          while ((unsigned)__builtin_amdgcn_readfirstlane((int)__hip_atomic_load(cw, __ATOMIC_RELAXED, __HIP_MEMORY_SCOPE_AGENT)) < 32u) { __builtin_amdgcn_s_sleep(2); if (++spins > (1u << 22)) break; } }
        f32x4 gv[2][2];
#pragma unroll
        for (int bj = 0; bj < 2; ++bj)
#pragma unroll
            for (int n = 0; n < 2; ++n) gv[bj][n] = *(const f32x4*)(fg + col0 + bj * 128 + n * 16);
#pragma unroll
        for (int ai = 0; ai < 2; ++ai)
#pragma unroll
            for (int m = 0; m < 4; ++m) {
                const int row = rowb + ai * 128 + m * 16;
                const float ssr = __hip_atomic_load(rowss + row, __ATOMIC_RELAXED, __HIP_MEMORY_SCOPE_AGENT);
                const float r = __builtin_amdgcn_rsqf(ssr * (1.0f / DM) + EPS);
#pragma unroll
                for (int bj = 0; bj < 2; ++bj)
#pragma unroll
                    for (int n = 0; n < 2; ++n) *(f32x4*)(out + (size_t)row * DM + col0 + bj * 128 + n * 16) = acc[ai][bj][m][n] * r * gv[bj][n];
            }
    }
};

struct EpiOut {
    static constexpr bool PERM = false;
    const float* x; float* out; float* rowss;
    __device__ __forceinline__ void operator()(const f32x4 (&acc)[2][2][4][2], const pg8::Unit& u, int wr, int wc, int fr, int fq) const {
        const int rowb = u.pm * 256 + wr * 64 + fr, col0 = u.pn * 256 + wc * 32 + 4 * fq;
#pragma unroll
        for (int ai = 0; ai < 2; ++ai)
#pragma unroll
            for (int m = 0; m < 4; ++m) {
                const int row = rowb + ai * 128 + m * 16; float ss = 0.f;
#pragma unroll
                for (int bj = 0; bj < 2; ++bj)
#pragma unroll
                    for (int n = 0; n < 2; ++n) {
                        const size_t off = (size_t)row * DM + col0 + bj * 128 + n * 16;
                        const f32x4 y = *(const f32x4*)(x + off) + acc[ai][bj][m][n];
                        *(f32x4*)(out + off) = y; ss += (y[0] * y[0] + y[1] * y[1]) + (y[2] * y[2] + y[3] * y[3]);
                    }
                ss += __shfl_xor(ss, 16); ss += __shfl_xor(ss, 32);
                if (fq == 0) atomicAdd(rowss + row, ss);
            }
    }
};

__device__ __forceinline__ int src_col(int np) {
    if (np < 4096) return np;
    if (np < 7680) return np + 16;
    if (np < 7744) return 7696 + (np - 7680);
    if (np < 7752) return 4096 + (np - 7744);
    if (np < 7760) return 4104 + (np - 7752);
    if (np < 7776) return np;
    return -1;
}
__device__ __forceinline__ void phase0(const Params& p, unsigned char* smem) {
    const int tid = opaque_tid(), wid = tid >> 6, lane = tid & 63;
    const int gw = blockIdx.x * 8 + wid, nw = gridDim.x * 8;
    h16* H = (h16*)(p.ws + OFF_H); unsigned char* H8 = p.ws + OFF_H8;
    for (int row = 2 * gw; row < BT; row += 2 * nw) {
        const f32x4* xr0 = (const f32x4*)(p.x + (size_t)row * DM); const f32x4* xr1 = xr0 + DM / 4;
        f32x4 v0[8], v1[8]; float s0 = 0.f, s1 = 0.f;
#pragma unroll
        for (int i = 0; i < 8; ++i) { v0[i] = xr0[lane + 64 * i]; v1[i] = xr1[lane + 64 * i]; }
#pragma unroll
        for (int i = 0; i < 8; ++i) { s0 += (v0[i][0] * v0[i][0] + v0[i][1] * v0[i][1]) + (v0[i][2] * v0[i][2] + v0[i][3] * v0[i][3]); s1 += (v1[i][0] * v1[i][0] + v1[i][1] * v1[i][1]) + (v1[i][2] * v1[i][2] + v1[i][3] * v1[i][3]); }
        s0 = wave_sum(s0); s1 = wave_sum(s1);
        const float r0 = __builtin_amdgcn_rsqf(s0 * (1.0f / DM) + EPS), r1 = __builtin_amdgcn_rsqf(s1 * (1.0f / DM) + EPS);
#pragma unroll
        for (int i = 0; i < 8; ++i) { const f32x4 g = ((const f32x4*)p.attn_g)[lane + 64 * i]; h16x4 o0, o1;
#pragma unroll
            for (int j = 0; j < 4; ++j) { o0[j] = (h16)(v0[i][j] * r0 * g[j]); o1[j] = (h16)(v1[i][j] * r1 * g[j]); }
            *(h16x4*)(H + (size_t)row * DM + 4 * (lane + 64 * i)) = o0; *(h16x4*)(H + (size_t)(row + 1) * DM + 4 * (lane + 64 * i)) = o1;
            int e0 = 0, e1 = 0;
            e0 = __builtin_amdgcn_cvt_pk_fp8_f32(v0[i][0] * r0 * g[0], v0[i][1] * r0 * g[1], e0, false); e0 = __builtin_amdgcn_cvt_pk_fp8_f32(v0[i][2] * r0 * g[2], v0[i][3] * r0 * g[3], e0, true);
            e1 = __builtin_amdgcn_cvt_pk_fp8_f32(v1[i][0] * r1 * g[0], v1[i][1] * r1 * g[1], e1, false); e1 = __builtin_amdgcn_cvt_pk_fp8_f32(v1[i][2] * r1 * g[2], v1[i][3] * r1 * g[3], e1, true);
            *(int*)(H8 + (size_t)row * DM + 4 * (lane + 64 * i)) = e0; *(int*)(H8 + (size_t)(row + 1) * DM + 4 * (lane + 64 * i)) = e1; }
    }
    {
        float* tiles = (float*)smem;
        h16* Wt = (h16*)(p.ws + OFF_WT); h16* WoT = (h16*)(p.ws + OFF_WOT);
        constexpr int NT1 = 124 * 32, NTT = NT1 + 32 * 32;
        const int nl_r = tid & 63, kl_r = tid >> 6, nl_w = tid >> 3, kc_w = tid & 7;
        float va[8], vb[8];
#define P0_LOAD(tI, v) do { if ((tI) < NT1) { const int n0_ = ((tI) / 32) * 64, k0_ = ((tI) % 32) * 64; const int src_ = src_col(n0_ + nl_r); \
            _Pragma("unroll") for (int i = 0; i < 8; ++i) v[i] = src_ >= 0 ? p.w_in[(size_t)(k0_ + kl_r + 8 * i) * IN_COLS + src_] : 0.f; } \
          else { const int t2_ = (tI) - NT1; const int n0_ = (t2_ / 32) * 64, k0_ = (t2_ % 32) * 64; \
            _Pragma("unroll") for (int i = 0; i < 8; ++i) v[i] = p.w_out[(size_t)(k0_ + kl_r + 8 * i) * DM + n0_ + nl_r]; } } while (0)
#define P0_PUT(buf, v) do { float* t_ = tiles + (buf) * (64 * 65); _Pragma("unroll") for (int i = 0; i < 8; ++i) t_[(kl_r + 8 * i) * 65 + nl_r] = v[i]; } while (0)
#define P0_STORE(buf, tI) do { const float* t_ = tiles + (buf) * (64 * 65); h16x8 o_; _Pragma("unroll") for (int j = 0; j < 8; ++j) o_[j] = (h16)t_[(8 * kc_w + j) * 65 + nl_w]; \
          if ((tI) < NT1) { const int n0_ = ((tI) / 32) * 64, k0_ = ((tI) % 32) * 64; \
              if (n0_ >= 4096 && n0_ < 6656) { int e0_ = 0, e1_ = 0; e0_ = __builtin_amdgcn_cvt_pk_fp8_f32(64.f * (float)o_[0], 64.f * (float)o_[1], e0_, false); e0_ = __builtin_amdgcn_cvt_pk_fp8_f32(64.f * (float)o_[2], 64.f * (float)o_[3], e0_, true); \
                  e1_ = __builtin_amdgcn_cvt_pk_fp8_f32(64.f * (float)o_[4], 64.f * (float)o_[5], e1_, false); e1_ = __builtin_amdgcn_cvt_pk_fp8_f32(64.f * (float)o_[6], 64.f * (float)o_[7], e1_, true); \
                  typedef int i32x2w __attribute__((ext_vector_type(2))); *(i32x2w*)(p.ws + OFF_WT8 + (size_t)(n0_ - 4096 + nl_w) * 2048 + k0_ + 8 * kc_w) = (i32x2w){e0_, e1_}; } \
              else *(h16x8*)(Wt + (size_t)(n0_ + nl_w) * 2048 + k0_ + 8 * kc_w) = o_; } \
          else { const int t2_ = (tI) - NT1; const int n0_ = (t2_ / 32) * 64, k0_ = (t2_ % 32) * 64; *(h16x8*)(WoT + (size_t)(n0_ + nl_w) * 2048 + k0_ + 8 * kc_w) = o_; } } while (0)
        int tI = blockIdx.x; int buf = 0;
        __syncthreads();
        if (tI < NTT) { P0_LOAD(tI, va); P0_PUT(0, va); }
        while (tI < NTT) {
            const int tn = tI + gridDim.x;
            if (tn < NTT) P0_LOAD(tn, vb);
            __syncthreads();
            P0_STORE(buf, tI);
            if (tn < NTT) P0_PUT(buf ^ 1, vb);
            buf ^= 1; tI = tn;
        }
#undef P0_LOAD
#undef P0_PUT
#undef P0_STORE
    }
    float* cosT = (float*)(p.ws + OFF_COS); float* sinT = (float*)(p.ws + OFF_SIN);
    for (int i = blockIdx.x * 512 + tid; i < BT * 24; i += gridDim.x * 512) {
        const int row = i / 24, j = i % 24;
        const float ex = (j < 16) ? (float)j * (2.0f / 32.0f) : (float)(j - 16) * (2.0f / 16.0f);
        const float inv = powf(500000.0f, -ex);
        const float ang = (float)p.pos[row] * inv;
        cosT[i] = cosf(ang); sinT[i] = sinf(ang);
    }
}

__device__ __forceinline__ h16x8 pack8(const f32x4 a, const f32x4 c) { h16x8 o; o[0] = (h16)a[0]; o[1] = (h16)a[1]; o[2] = (h16)a[2]; o[3] = (h16)a[3]; o[4] = (h16)c[0]; o[5] = (h16)c[1]; o[6] = (h16)c[2]; o[7] = (h16)c[3]; return o; }
typedef short v4s_t __attribute__((__vector_size__(4 * sizeof(short))));
__device__ __forceinline__ h16x4 lds_tr16(const LAS unsigned char* a) { const v4s_t v = __builtin_amdgcn_ds_read_tr16_b64_v4i16((LAS v4s_t*)a); return __builtin_bit_cast(h16x4, v); }
constexpr int REC_BYTES = 74752, REC_WF = 0, REC_QF = 16384, REC_AF = 32768, REC_KTF = 40960, REC_VEC = 57344, REC_UF = 58368, REC_DMA = 58368;
constexpr int HB_BYTES = 69632;

__device__ __forceinline__ void gdn_prep_pair(const Params& p, unsigned char* smem, int pair) {
    const int tid = opaque_tid(), wid = __builtin_amdgcn_readfirstlane(tid >> 6), lane = tid & 63, hb = wid >> 2, w4 = wid & 3, tl = tid & 255;
    const int tk = 2 * pair + hb; const int b = tk >> 9, h = (tk >> 6) & 7, n = tk & 63; const int t0 = n * 64;
    unsigned char* base = smem + hb * HB_BYTES;
    h16* Kn = (h16*)base; h16* Qn = Kn + 64 * 136; h16* Vh = Qn + 64 * 136; float* L = (float*)(Vh + 64 * 136); float* vec = L + 4096;
    unsigned char* rec = p.ws + OFF_REC + (size_t)tk * REC_BYTES;
    const h16* qkvr = (const h16*)(p.ws + OFF_QKVR);
    __syncthreads();
    {
        const int cg = tl & 15, rg = tl >> 4;
        h16x8 raw[3][7];
#pragma unroll
        for (int ti = 0; ti < 3; ++ti)
#pragma unroll
            for (int r = 0; r < 7; ++r) {
                const int trow = t0 + 4 * rg - 3 + r;
                if (trow >= 0) raw[ti][r] = *(const h16x8*)(qkvr + ((size_t)b * NT + trow) * 3072 + ti * 1024 + h * 128 + 8 * cg);
                else { for (int j = 0; j < 8; ++j) raw[ti][r][j] = (h16)0.f; }
            }
#pragma unroll
        for (int ti = 0; ti < 3; ++ti) {
            const int chan = ti * 1024 + h * 128 + 8 * cg;
            float xr[7][8];
#pragma unroll
            for (int r = 0; r < 7; ++r)
#pragma unroll
                for (int j = 0; j < 8; ++j) xr[r][j] = (float)raw[ti][r][j];
            float wv[4][8];
#pragma unroll
            for (int tp = 0; tp < 4; ++tp) { const f32x4 a = *(const f32x4*)(p.conv_w + (size_t)tp * 3072 + chan), c = *(const f32x4*)(p.conv_w + (size_t)tp * 3072 + chan + 4);
#pragma unroll
                for (int j = 0; j < 4; ++j) { wv[tp][j] = a[j]; wv[tp][4 + j] = c[j]; } }
            h16* dst = (ti == 0) ? Qn : (ti == 1 ? Kn : Vh);
#pragma unroll
            for (int r = 0; r < 4; ++r) {
                float y[8]; float ss = 0.f;
#pragma unroll
                for (int j = 0; j < 8; ++j) { float a = wv[0][j] * xr[r][j] + wv[1][j] * xr[r + 1][j] + wv[2][j] * xr[r + 2][j] + wv[3][j] * xr[r + 3][j]; a = silu_f(a); y[j] = a; ss += a * a; }
                float sc = 1.f;
                if (ti < 2) { ss += __shfl_xor(ss, 1); ss += __shfl_xor(ss, 2); ss += __shfl_xor(ss, 4); ss += __shfl_xor(ss, 8); sc = (ti == 0 ? 0.08838834764831845f : 1.0f) * __builtin_amdgcn_rsqf(ss + EPS); }
                h16x8 o;
#pragma unroll
                for (int j = 0; j < 8; ++j) o[j] = (h16)(y[j] * sc);
                *(h16x8*)(dst + (4 * rg + r) * 136 + 8 * cg) = o;
            }
        }
    }
    if (tl < 64) {
        const float* gb = (const float*)(p.ws + OFF_GB) + ((size_t)b * NT + t0 + tl) * 16;
        const float g = gb[h], be = gb[8 + h];
        float gc = g;
#pragma unroll
        for (int o = 1; o < 64; o <<= 1) { const float tt = __shfl_up(gc, o); if (lane >= o) gc += tt; }
        const float gl = __shfl(gc, 63);
        vec[tl] = g; vec[64 + tl] = be; vec[128 + tl] = gc; vec[192 + tl] = __expf(gc);
        float* rv = (float*)(rec + REC_VEC);
        rv[tl] = __expf(gc); rv[64 + tl] = __expf(gl - gc); if (tl == 0) rv[128] = __expf(gl);
    }
    __syncthreads();
    {
        const int rt = w4, fr = lane & 15, kg = lane >> 4;
        h16x8 Ak[4], Aq[4];
#pragma unroll
        for (int s = 0; s < 4; ++s) { Ak[s] = *(const h16x8*)(Kn + (16 * rt + fr) * 136 + 32 * s + 8 * kg); Aq[s] = *(const h16x8*)(Qn + (16 * rt + fr) * 136 + 32 * s + 8 * kg); }
        h16* AF = (h16*)(rec + REC_AF);
#pragma unroll
        for (int ct = 0; ct < 4; ++ct) {
            f32x4 kk = (f32x4){0.f, 0.f, 0.f, 0.f}, qk = (f32x4){0.f, 0.f, 0.f, 0.f};
#pragma unroll
            for (int s = 0; s < 4; ++s) { const h16x8 Bk = *(const h16x8*)(Kn + (16 * ct + fr) * 136 + 32 * s + 8 * kg);
                kk = __builtin_amdgcn_mfma_f32_16x16x32_f16(Ak[s], Bk, kk, 0, 0, 0); qk = __builtin_amdgcn_mfma_f32_16x16x32_f16(Aq[s], Bk, qk, 0, 0, 0); }
            const int j = 16 * ct + fr; const float gcj = vec[128 + j];
#pragma unroll
            for (int rgi = 0; rgi < 4; ++rgi) {
                const int i = 16 * rt + 4 * kg + rgi;
                const float dec = (i >= j) ? __expf(vec[128 + i] - gcj) : 0.f;
                L[i * 64 + j] = (i > j) ? vec[64 + i] * kk[rgi] * dec : 0.f;
                const int sp = ct >> 1, kgp = fr >> 2, j8 = (ct & 1) * 4 + (fr & 3), lanep = 16 * kgp + 4 * kg + rgi;
                AF[((rt * 2 + sp) * 64 + lanep) * 8 + j8] = (h16)(qk[rgi] * dec);
            }
        }
    }
    __syncthreads();
    h16* Tw = (h16*)L; h16* Tu = Tw + 4096;
    if (w4 == 0) {
        float X[64];
#pragma unroll
        for (int i = 0; i < 64; ++i) X[i] = 0.f;
        f32x4 Ln[16]; float rn = (lane == 0) ? 1.f : 0.f;
#pragma unroll
        for (int i = 0; i < 64; ++i) {
            f32x4 Lc[16]; const float rc = rn;
#pragma unroll
            for (int jj = 0; jj < (i + 3) / 4; ++jj) Lc[jj] = Ln[jj];
            if (i + 1 < 64) {
#pragma unroll
                for (int jj = 0; jj < (i + 4) / 4; ++jj) Ln[jj] = *(const f32x4*)(L + (i + 1) * 64 + 4 * jj);
                rn = (lane == i + 1) ? 1.f : 0.f;
            }
            float a0 = rc, a1 = 0.f, a2 = 0.f, a3 = 0.f;
#pragma unroll
            for (int jj = 0; jj < (i + 3) / 4; ++jj) { a0 -= Lc[jj][0] * X[4 * jj]; a1 -= Lc[jj][1] * X[4 * jj + 1]; a2 -= Lc[jj][2] * X[4 * jj + 2]; a3 -= Lc[jj][3] * X[4 * jj + 3]; }
            float acc = (a0 + a1) + (a2 + a3);
            asm volatile("" : "+v"(acc) :: "memory");
            X[i] = acc;
        }
        const float bu = vec[64 + lane], bw = bu * vec[192 + lane];
#pragma unroll
        for (int i = 0; i < 64; ++i) { const int pos = i * 64 + ((((lane >> 3) ^ (i & 7)) << 3) | (lane & 7)); Tw[pos] = (h16)(X[i] * bw); Tu[pos] = (h16)(X[i] * bu); }
    } else {
        const int t3 = tl - 64;
        h16* QF = (h16*)(rec + REC_QF);
        for (int f = t3; f < 1024; f += 192) { const int lanep = f & 63, s = (f >> 6) & 3, rt = f >> 8; const int row = 16 * rt + (lanep & 15), kgp = lanep >> 4;
            const h16x4 a = *(const h16x4*)(Qn + row * 136 + 32 * s + 4 * kgp), c = *(const h16x4*)(Qn + row * 136 + 32 * s + 16 + 4 * kgp);
            h16x8 o; o[0] = a[0]; o[1] = a[1]; o[2] = a[2]; o[3] = a[3]; o[4] = c[0]; o[5] = c[1]; o[6] = c[2]; o[7] = c[3];
            *(h16x8*)(QF + (size_t)f * 8) = o; }
        h16* KTF = (h16*)(rec + REC_KTF);
        for (int f = t3; f < 1024; f += 192) { const int lanep = f & 63, sp = (f >> 6) & 1, rt = f >> 7; const int d = 16 * rt + (lanep & 15), kgp = lanep >> 4;
            h16x8 o;
#pragma unroll
            for (int j8 = 0; j8 < 8; ++j8) { const int c = 32 * sp + (j8 < 4 ? 4 * kgp + j8 : 16 + 4 * kgp + (j8 - 4)); o[j8] = Kn[c * 136 + d]; }
            *(h16x8*)(KTF + (size_t)f * 8) = o; }
    }
    __syncthreads();
    {
        const int rt = w4, fr = lane & 15, kg = lane >> 4, q4 = fr >> 2, pp = fr & 3;
        const LAS unsigned char* Knl = (const LAS unsigned char*)Kn; const LAS unsigned char* Vl = (const LAS unsigned char*)Vh;
        const int trow = 16 * rt + fr;
        h16x8 Tuf[2], Twf[2];
#pragma unroll
        for (int s = 0; s < 2; ++s) { const int off = trow * 64 + ((((4 * s + kg) ^ (trow & 7))) << 3); Tuf[s] = *(const h16x8*)(Tu + off); Twf[s] = *(const h16x8*)(Tw + off); }
        h16* UF = (h16*)(rec + REC_UF);
#pragma unroll
        for (int dvb = 0; dvb < 8; ++dvb) {
            f32x4 acc = (f32x4){0.f, 0.f, 0.f, 0.f};
#pragma unroll
            for (int s = 0; s < 2; ++s) { const LAS unsigned char* a0 = Vl + ((32 * s + 8 * kg + q4) * 136 + 16 * dvb + 4 * pp) * 2;
                const h16x4 lo = lds_tr16(a0), hi4 = lds_tr16(a0 + 4 * 136 * 2);
                h16x8 Bv; Bv[0] = lo[0]; Bv[1] = lo[1]; Bv[2] = lo[2]; Bv[3] = lo[3]; Bv[4] = hi4[0]; Bv[5] = hi4[1]; Bv[6] = hi4[2]; Bv[7] = hi4[3];
                acc = __builtin_amdgcn_mfma_f32_16x16x32_f16(Tuf[s], Bv, acc, 0, 0, 0); }
            h16x4 o; o[0] = (h16)acc[0]; o[1] = (h16)acc[1]; o[2] = (h16)acc[2]; o[3] = (h16)acc[3];
            *(h16x4*)(UF + (size_t)((dvb * 4 + rt) * 64 + lane) * 4) = o;
        }
        h16* WF = (h16*)(rec + REC_WF);
#pragma unroll
        for (int so = 0; so < 4; ++so) {
            f32x4 c0 = (f32x4){0.f, 0.f, 0.f, 0.f}, c1 = (f32x4){0.f, 0.f, 0.f, 0.f};
#pragma unroll
            for (int s = 0; s < 2; ++s) {
                const LAS unsigned char* a0 = Knl + ((32 * s + 8 * kg + q4) * 136 + 16 * (2 * so) + 4 * pp) * 2;
                const h16x4 l0 = lds_tr16(a0), h0 = lds_tr16(a0 + 4 * 136 * 2), l1 = lds_tr16(a0 + 32), h1 = lds_tr16(a0 + 32 + 4 * 136 * 2);
                h16x8 A0, A1; A0[0] = l0[0]; A0[1] = l0[1]; A0[2] = l0[2]; A0[3] = l0[3]; A0[4] = h0[0]; A0[5] = h0[1]; A0[6] = h0[2]; A0[7] = h0[3];
                A1[0] = l1[0]; A1[1] = l1[1]; A1[2] = l1[2]; A1[3] = l1[3]; A1[4] = h1[0]; A1[5] = h1[1]; A1[6] = h1[2]; A1[7] = h1[3];
                c0 = __builtin_amdgcn_mfma_f32_16x16x32_f16(A0, Twf[s], c0, 0, 0, 0); c1 = __builtin_amdgcn_mfma_f32_16x16x32_f16(A1, Twf[s], c1, 0, 0, 0);
            }
            *(h16x8*)(WF + (size_t)((rt * 4 + so) * 64 + lane) * 8) = pack8(-c0, -c1);
        }
    }
}

__device__ __forceinline__ void gdn_scan_task(const Params& p, unsigned char* smem, int bh) {
    const int tid = opaque_tid(), wid = __builtin_amdgcn_readfirstlane(tid >> 6), lane = tid & 63, kg = lane >> 4, fr = lane & 15;
    const int b = bh >> 3, h = bh & 7;
    LAS unsigned char* lds = (LAS unsigned char*)smem;
    const unsigned char* rec0 = p.ws + OFF_REC + (size_t)(bh * 64) * REC_BYTES;
    h16* OB = (h16*)(smem + 2 * REC_DMA);
    const h16* gz = (const h16*)(p.ws + OFF_GZ); h16* omix = (h16*)(p.ws + OFF_OMIX);
    f32x4 Sacc[8];
#pragma unroll
    for (int t = 0; t < 8; ++t) Sacc[t] = (f32x4){0.f, 0.f, 0.f, 0.f};
    h16x4 Uc[4], Un[4];
    __syncthreads();
#define GDN_GLDS(recp, bufi) do { _Pragma("unroll") for (int _i = 0; _i < 7; ++_i) \
        __builtin_amdgcn_global_load_lds((const unsigned*)((recp) + (size_t)(_i * 512 + tid) * 16), (LAS unsigned*)(lds + (bufi) * REC_DMA + (_i * 512 + wid * 64) * 16), 16, 0, 0); \
        if (wid == 0) __builtin_amdgcn_global_load_lds((const unsigned*)((recp) + (size_t)(7 * 512 + tid) * 16), (LAS unsigned*)(lds + (bufi) * REC_DMA + (7 * 512) * 16), 16, 0, 0); } while (0)
#define GDN_LDREG(recp, U_) do { _Pragma("unroll") for (int rt = 0; rt < 4; ++rt) U_[rt] = *(const h16x4*)((recp) + REC_UF + (size_t)((wid * 4 + rt) * 64 + lane) * 8); } while (0)
#define GDN_LDGZ(dst, chunk) do { const h16* gp_ = gz + ((size_t)b * NT + 64 * (chunk) + prow) * 1024 + h * 128 + 16 * pseg; dst[0] = *(const h16x8*)gp_; dst[1] = *(const h16x8*)(gp_ + 8); } while (0)
#define GDN_POST(chunk, gzv) do { const h16* Ob = OB + ((chunk) & 1) * 8192 + prow * 128 + 16 * pseg; const h16x8 a0 = *(const h16x8*)Ob, a1 = *(const h16x8*)(Ob + 8); \
        float ngv[16]; _Pragma("unroll") for (int j = 0; j < 4; ++j) { const f32x4 t4 = *(const f32x4*)(ngl + 16 * pseg + 4 * j); ngv[4 * j] = t4[0]; ngv[4 * j + 1] = t4[1]; ngv[4 * j + 2] = t4[2]; ngv[4 * j + 3] = t4[3]; } \
        float ss = 0.f; _Pragma("unroll") for (int j = 0; j < 8; ++j) { const float u0 = (float)a0[j], u1 = (float)a1[j]; ss += u0 * u0 + u1 * u1; } \
        ss += __shfl_xor(ss, 1); ss += __shfl_xor(ss, 2); ss += __shfl_xor(ss, 4); const float r = __builtin_amdgcn_rsqf(ss * (1.0f / 128.0f) + EPS); \
        h16x8 o0, o1; _Pragma("unroll") for (int j = 0; j < 8; ++j) { o0[j] = (h16)((float)a0[j] * r * ngv[j] * (float)gzv[0][j]); o1[j] = (h16)((float)a1[j] * r * ngv[8 + j] * (float)gzv[1][j]); } \
        h16* op_ = omix + ((size_t)b * NT + 64 * (chunk) + prow) * 2048 + h * 128 + 16 * pseg; *(h16x8*)op_ = o0; *(h16x8*)(op_ + 8) = o1; } while (0)
#define GDN_RD8(X, off0) do { _Pragma("unroll") for (int _j = 0; _j < 8; ++_j) X[_j] = *(const LAS h16x8*)(bufp + (off0) + (_j * 64 + lane) * 16); } while (0)
#define GDN_SB __builtin_amdgcn_sched_barrier(0)
    h16x8 gzp[2], gzn[2];
    const int prow = tid >> 3, pseg = tid & 7;
    float* ngl = (float*)(smem + 2 * REC_DMA + 32768);
    if (tid < 128) ngl[tid] = p.gdn_norm_g[tid];
    GDN_GLDS(rec0, 0);
    GDN_LDREG(rec0, Uc);
    asm volatile("s_waitcnt vmcnt(0)" ::: "memory");
    __syncthreads();
    for (int n = 0; n < 64; ++n) {
        const unsigned char* recn = rec0 + (size_t)(n + 1) * REC_BYTES;
        if (n + 1 < 64) { GDN_GLDS(recn, (n + 1) & 1); GDN_LDREG(recn, Un); }
        GDN_LDGZ(gzn, n);
        if (n > 0) GDN_POST(n - 1, gzp);
        const LAS unsigned char* bufp = lds + (n & 1) * REC_DMA;
        h16x8 X[8], Y[8];
        GDN_RD8(X, REC_WF);
        h16x8 SB[4];
#pragma unroll
        for (int s = 0; s < 4; ++s) SB[s] = pack8(Sacc[2 * s], Sacc[2 * s + 1]);
        f32x4 vacc[4], oacc[4];
#pragma unroll
        for (int rt = 0; rt < 4; ++rt) { vacc[rt] = (f32x4){(float)Uc[rt][0], (float)Uc[rt][1], (float)Uc[rt][2], (float)Uc[rt][3]}; oacc[rt] = (f32x4){0.f, 0.f, 0.f, 0.f}; }
        GDN_SB;
        GDN_RD8(Y, REC_WF + 8192);
#pragma unroll
        for (int j = 0; j < 8; ++j) vacc[j >> 2] = __builtin_amdgcn_mfma_f32_16x16x32_f16(X[j], SB[j & 3], vacc[j >> 2], 0, 0, 0);
        GDN_SB;
        GDN_RD8(X, REC_QF);
#pragma unroll
        for (int j = 0; j < 8; ++j) vacc[2 + (j >> 2)] = __builtin_amdgcn_mfma_f32_16x16x32_f16(Y[j], SB[j & 3], vacc[2 + (j >> 2)], 0, 0, 0);
        GDN_SB;
        GDN_RD8(Y, REC_QF + 8192);
        f32x4 ekv[4], egv[4];
#pragma unroll
        for (int rt = 0; rt < 4; ++rt) { ekv[rt] = *(const LAS f32x4*)(bufp + REC_VEC + 256 + (16 * rt + 4 * kg) * 4); egv[rt] = *(const LAS f32x4*)(bufp + REC_VEC + (16 * rt + 4 * kg) * 4); }
        const float eglc = *(const LAS float*)(bufp + REC_VEC + 512);
#pragma unroll
        for (int j = 0; j < 8; ++j) oacc[j >> 2] = __builtin_amdgcn_mfma_f32_16x16x32_f16(X[j], SB[j & 3], oacc[j >> 2], 0, 0, 0);
        GDN_SB;
        GDN_RD8(X, REC_KTF);
        h16x8 VB[2], VKB[2];
#pragma unroll
        for (int sp = 0; sp < 2; ++sp) { VB[sp] = pack8(vacc[2 * sp], vacc[2 * sp + 1]); VKB[sp] = pack8(vacc[2 * sp] * ekv[2 * sp], vacc[2 * sp + 1] * ekv[2 * sp + 1]); }
#pragma unroll
        for (int j = 0; j < 8; ++j) oacc[2 + (j >> 2)] = __builtin_amdgcn_mfma_f32_16x16x32_f16(Y[j], SB[j & 3], oacc[2 + (j >> 2)], 0, 0, 0);
        GDN_SB;
        GDN_RD8(Y, REC_KTF + 8192);
#pragma unroll
        for (int t = 0; t < 8; ++t) Sacc[t] = Sacc[t] * eglc;
#pragma unroll
        for (int j = 0; j < 8; ++j) Sacc[j >> 1] = __builtin_amdgcn_mfma_f32_16x16x32_f16(X[j], VKB[j & 1], Sacc[j >> 1], 0, 0, 0);
        GDN_SB;
        GDN_RD8(X, REC_AF);
#pragma unroll
        for (int rt = 0; rt < 4; ++rt) oacc[rt] = oacc[rt] * egv[rt];
#pragma unroll
        for (int j = 0; j < 8; ++j) Sacc[4 + (j >> 1)] = __builtin_amdgcn_mfma_f32_16x16x32_f16(Y[j], VKB[j & 1], Sacc[4 + (j >> 1)], 0, 0, 0);
        GDN_SB;
#pragma unroll
        for (int j = 0; j < 8; ++j) oacc[j >> 1] = __builtin_amdgcn_mfma_f32_16x16x32_f16(X[j], VB[j & 1], oacc[j >> 1], 0, 0, 0);
        { h16* Ob = OB + (n & 1) * 8192;
#pragma unroll
          for (int rt = 0; rt < 4; ++rt)
#pragma unroll
              for (int rgi = 0; rgi < 4; ++rgi) Ob[(16 * rt + 4 * kg + rgi) * 128 + 16 * wid + fr] = (h16)oacc[rt][rgi]; }
        asm volatile("s_waitcnt vmcnt(0)" ::: "memory");
        __syncthreads();
#pragma unroll
        for (int rt = 0; rt < 4; ++rt) Uc[rt] = Un[rt];
        gzp[0] = gzn[0]; gzp[1] = gzn[1];
    }
    GDN_POST(63, gzp);
#undef GDN_LDGZ
#undef GDN_POST
#undef GDN_RD8
#undef GDN_SB
#undef GDN_GLDS
#undef GDN_LDREG
}

__device__ __forceinline__ unsigned f2key(float x) { const unsigned u = __float_as_uint(x); return (u & 0x80000000u) ? ~u : (u | 0x80000000u); }
typedef float f32x16 __attribute__((ext_vector_type(16)));
__device__ __forceinline__ float wave_min(float v) {
#pragma unroll
    for (int o = 1; o < 64; o <<= 1) v = fminf(v, __shfl_xor(v, o));
    return v;
}
__device__ __forceinline__ unsigned lane_below(unsigned long long m) { return __builtin_amdgcn_mbcnt_hi((unsigned)(m >> 32), __builtin_amdgcn_mbcnt_lo((unsigned)m, 0u)); }
__device__ __forceinline__ void idx8_task(const Params& p, unsigned char* smem, int b, int qb) {
    const int tid = opaque_tid(), wid = __builtin_amdgcn_readfirstlane(tid >> 6), lane = tid & 63;
    const int t0 = qb * 8;
    unsigned short* selg = (unsigned short*)(p.ws + OFF_SEL) + ((size_t)b * NT + t0) * 256;
    if (t0 + 8 <= 256) {
        for (int i = tid; i < 8 * 256; i += 512) { const int q = i >> 8, k = i & 255; selg[i] = (unsigned short)(k <= t0 + q ? k : 0); }
        return;
    }
    float* sc = (float*)smem;
    ACC_T0();
    unsigned* hist = (unsigned*)(smem + 131072 + wid * 2560);
    unsigned* cand = hist + 256;
    __syncthreads();
    {
        const int n8 = t0 + 8;
        const int ntile = (n8 + 31) >> 5, ntile_pad = ((n8 + 255) >> 8) << 3;
        const h16* iq = (const h16*)(p.ws + OFF_IQ) + ((size_t)b * NT + t0) * 1024;
        const float* iw = (const float*)(p.ws + OFF_IW) + ((size_t)b * NT + t0) * 16;
        const h16* ik = (const h16*)(p.ws + OFF_IK) + (size_t)b * NT * 64;
        const int r = lane & 31, kh = lane >> 5, qq = (r >> 2) & 1, hh = (r & 3) + 4 * (r >> 3);
        h16x8 Af[4][4]; h16x2 Wp[4][8];
#pragma unroll
        for (int a = 0; a < 4; ++a) {
#pragma unroll
            for (int s = 0; s < 4; ++s) Af[a][s] = *(const h16x8*)(iq + (size_t)(2 * a + qq) * 1024 + hh * 64 + 16 * s + 8 * kh);
#pragma unroll
            for (int c = 0; c < 4; ++c) { const f32x4 w4 = *(const f32x4*)(iw + (size_t)(2 * a + kh) * 16 + 4 * c);
                Wp[a][2 * c] = (h16x2){(h16)w4[0], (h16)w4[1]}; Wp[a][2 * c + 1] = (h16x2){(h16)w4[2], (h16)w4[3]}; }
        }
#define IDX_LOADB(Bx, ti) do { if ((ti) < ntile) { _Pragma("unroll") for (int s = 0; s < 4; ++s) Bx[s] = *(const h16x8*)(ik + (size_t)(32 * (ti) + r) * 64 + 16 * s + 8 * kh); } } while (0)
#define IDX_COMP(Bx, ti) do { if ((ti) < ntile) { const int key = 32 * (ti) + r; f32x16 accs[4]; \
            _Pragma("unroll") for (int a = 0; a < 4; ++a) { _Pragma("unroll") for (int e = 0; e < 16; ++e) accs[a][e] = 0.f; \
                _Pragma("unroll") for (int s = 0; s < 4; ++s) accs[a] = __builtin_amdgcn_mfma_f32_32x32x16_f16(Af[a][s], Bx[s], accs[a], 0, 0, 0); } \
            __builtin_amdgcn_sched_barrier(0); \
            _Pragma("unroll") for (int a = 0; a < 4; ++a) { \
                float s0 = 0.f, s1 = 0.f; _Pragma("unroll") for (int e = 0; e < 8; e += 2) { h16x2 rp = (h16x2){(h16)accs[a][2 * e], (h16)accs[a][2 * e + 1]}; rp = __builtin_elementwise_max(rp, (h16x2){(h16)0.f, (h16)0.f}); s0 = __builtin_amdgcn_fdot2(rp, Wp[a][e], s0, false); \
                    h16x2 rq = (h16x2){(h16)accs[a][2 * e + 2], (h16)accs[a][2 * e + 3]}; rq = __builtin_elementwise_max(rq, (h16x2){(h16)0.f, (h16)0.f}); s1 = __builtin_amdgcn_fdot2(rq, Wp[a][e + 1], s1, false); } \
                const int q = 2 * a + kh; sc[q * 4096 + key] = (key > t0 + q) ? -INFINITY : (s0 + s1); } } } while (0)
        {
            h16x8 B0[4], B1[4], B2[4];
            IDX_LOADB(B0, wid); IDX_LOADB(B1, wid + 8);
            for (int i = wid; i < ntile; i += 24) {
                IDX_LOADB(B2, i + 16); IDX_COMP(B0, i);
                IDX_LOADB(B0, i + 24); IDX_COMP(B1, i + 8);
                IDX_LOADB(B1, i + 32); IDX_COMP(B2, i + 16);
            }
            for (int i = ntile + wid; i < ntile_pad; i += 8) {
#pragma unroll
                for (int a = 0; a < 4; ++a) sc[(2 * a + kh) * 4096 + 32 * i + r] = -INFINITY;
            }
        }
#undef IDX_LOADB
#undef IDX_COMP
    }
    __syncthreads();
    ACC_ADD(1);
    {
        const int tq = t0 + wid, n = tq + 1;
        const float* row = sc + wid * 4096;
        const int ng = (n + 255) >> 8;
        f32x4 x[16];
#pragma unroll
        for (int g = 0; g < 16; ++g) { if (g < ng) x[g] = *(const f32x4*)(row + 256 * g + 4 * lane); else x[g] = (f32x4){-INFINITY, -INFINITY, -INFINITY, -INFINITY}; }
        float hi = -INFINITY, lo = INFINITY;
#pragma unroll
        for (int g = 0; g < 16; ++g)
#pragma unroll
            for (int c = 0; c < 4; ++c) { const float v = x[g][c]; hi = fmaxf(hi, v); lo = fminf(lo, v == -INFINITY ? INFINITY : v); }
        hi = wave_max(hi); lo = wave_min(lo);
        const float scale = (hi > lo) ? 255.99f / (hi - lo) : 0.f; const float off = -lo * scale;
        *(u32x4*)(hist + 4 * lane) = (u32x4){0u, 0u, 0u, 0u};
#pragma unroll
        for (int g = 0; g < 16; ++g) { if (g < ng) {
#pragma unroll
            for (int c = 0; c < 4; ++c) { int bin = (int)fmaf(x[g][c], scale, off); bin = bin < 0 ? 0 : (bin > 255 ? 255 : bin); atomicAdd(&hist[bin], 1u); } } }
        unsigned bstar, need;
        {
            const u32x4 h4 = *(const u32x4*)(hist + 4 * lane); const unsigned s = h4[0] + h4[1] + h4[2] + h4[3];
            unsigned suf = s;
#pragma unroll
            for (int o = 1; o < 64; o <<= 1) { const unsigned tt = __shfl_down(suf, o); if (lane + o < 64) suf += tt; }
            const unsigned above = suf - s;
            const bool mine = (above < 256u && 256u <= suf);
            unsigned cum = above; unsigned bin = 0;
            if (cum + h4[3] >= 256u) bin = 3; else { cum += h4[3]; if (cum + h4[2] >= 256u) bin = 2; else { cum += h4[2]; if (cum + h4[1] >= 256u) bin = 1; else { cum += h4[1]; bin = 0; } } }
            const unsigned long long mm = __ballot(mine);
            const int src = (int)__builtin_ctzll(mm);
            bstar = (unsigned)__shfl((int)(4 * lane + bin), src); need = (unsigned)__shfl((int)(256u - cum), src);
        }
        unsigned short* so = selg + (size_t)wid * 256;
        unsigned short* cidx = (unsigned short*)(cand + 256);
        unsigned m = 0, outb = 0;
#pragma unroll
        for (int g = 0; g < 16; ++g) { if (g < ng) {
#pragma unroll
            for (int c = 0; c < 4; ++c) { int bin = (int)fmaf(x[g][c], scale, off); bin = bin < 0 ? 0 : (bin > 255 ? 255 : bin);
                const bool gt = ((unsigned)bin > bstar), pr = ((unsigned)bin == bstar);
                const unsigned long long mg = __ballot(gt), mk = __ballot(pr);
                if (mg) { const unsigned pos = outb + lane_below(mg); if (gt) so[pos] = (unsigned short)(256 * g + 4 * lane + c); outb += (unsigned)__builtin_popcountll(mg); }
                if (mk) { const unsigned pos = m + lane_below(mk); if (pr && pos < 256u) { cand[pos] = f2key(x[g][c]); cidx[pos] = (unsigned short)(256 * g + 4 * lane + c); } m += (unsigned)__builtin_popcountll(mk); } } } }
        unsigned Kt = 0, rr = need;
        if (m <= 256u) {
            const int nc = (int)((m + 63u) >> 6);
            unsigned cv[4]; unsigned short ci[4];
#pragma unroll
            for (int j = 0; j < 4; ++j) { const bool in = (64 * j + lane < (int)m); cv[j] = in ? cand[64 * j + lane] : 0u; ci[j] = in ? cidx[64 * j + lane] : (unsigned short)0; }
            for (int bit = 31; bit >= 0; --bit) {
                const unsigned test = (Kt | (1u << bit)) >> bit;
                unsigned cnt = (unsigned)__builtin_popcountll(__ballot((cv[0] >> bit) == test));
                if (nc > 1) cnt += (unsigned)__builtin_popcountll(__ballot((cv[1] >> bit) == test));
                if (nc > 2) cnt += (unsigned)__builtin_popcountll(__ballot((cv[2] >> bit) == test));
                if (nc > 3) cnt += (unsigned)__builtin_popcountll(__ballot((cv[3] >> bit) == test));
                if (cnt >= rr) Kt |= (1u << bit); else rr -= cnt;
            }
            unsigned eqb = 0;
#pragma unroll
            for (int j = 0; j < 4; ++j) { if (j < nc) { const bool in = (64 * j + lane < (int)m); const bool gt = in && cv[j] > Kt, eq = in && cv[j] == Kt;
                const unsigned long long me = __ballot(eq); bool take = gt;
                if (me) { const unsigned er = eqb + lane_below(me); take = gt || (eq && er < rr); eqb += (unsigned)__builtin_popcountll(me); }
                const unsigned long long mt = __ballot(take);
                if (mt) { const unsigned pos = outb + lane_below(mt); if (take) so[pos] = ci[j]; outb += (unsigned)__builtin_popcountll(mt); } } }
        } else {
            for (int bit = 31; bit >= 0; --bit) {
                const unsigned test = (Kt | (1u << bit)) >> bit; unsigned cnt = 0;
                for (int idx = lane; idx < ng * 256; idx += 64) { const float v = row[idx]; int bin = (int)fmaf(v, scale, off); bin = bin < 0 ? 0 : (bin > 255 ? 255 : bin);
                    const bool pr = ((unsigned)bin == bstar) && ((f2key(v) >> bit) == test); cnt += (unsigned)__builtin_popcountll(__ballot(pr)); }
                if (cnt >= rr) Kt |= (1u << bit); else rr -= cnt;
            }
            unsigned eqb = 0;
            for (int idx = lane; idx < ng * 256; idx += 64) { const float v = row[idx]; int bin = (int)fmaf(v, scale, off); bin = bin < 0 ? 0 : (bin > 255 ? 255 : bin);
                const unsigned k = f2key(v); const bool inb = ((unsigned)bin == bstar); const bool gt = inb && k > Kt, eq = inb && k == Kt;
                const unsigned long long me = __ballot(eq); bool take = gt;
                if (me) { const unsigned er = eqb + lane_below(me); take = gt || (eq && er < rr); eqb += (unsigned)__builtin_popcountll(me); }
                const unsigned long long mt = __ballot(take);
                if (mt) { const unsigned pos = outb + lane_below(mt); if (take) so[pos] = (unsigned short)idx; outb += (unsigned)__builtin_popcountll(mt); } }
        }
    }
    __syncthreads();
    ACC_ADD(2);
}

typedef unsigned short u16x4 __attribute__((ext_vector_type(4)));
typedef unsigned short u16x8 __attribute__((ext_vector_type(8)));
__device__ __forceinline__ void attn8_task(const Params& p, unsigned char* smem, int part, int o) {
    const int tid = opaque_tid(), wid = __builtin_amdgcn_readfirstlane(tid >> 6), lane = tid & 63, kg = lane >> 4, fr = lane & 15;
    const int b = part >> 1, g = part & 1;
    unsigned char* vl = smem + wid * 17408;
    LAS unsigned char* vll = (LAS unsigned char*)vl;
    const char* akb = (const char*)(p.ws + OFF_AK) + (size_t)b * NT * 256 + g * 128;
    const char* avb = (const char*)(p.ws + OFF_AV) + (size_t)b * NT * 256 + g * 128;
    typedef long i64x2 __attribute__((ext_vector_type(2)));
    constexpr int NQW = 1;
    const int tq0 = 8 * NQW * o + NQW * wid;
    u16x4 kix[4], kixn[4];
#define AT_LOADI(tt, KI) do { const unsigned short* sel_ = (const unsigned short*)(p.ws + OFF_SEL) + ((size_t)b * NT + (tt)) * 256; \
        _Pragma("unroll") for (int c = 0; c < 4; ++c) KI[c] = *(const u16x4*)(sel_ + 64 * c + 4 * fr); } while (0)
    AT_LOADI(tq0, kix);
#pragma unroll 1
    for (int qi = 0; qi < NQW; ++qi) {
    const int t = tq0 + qi; const int bt = b * NT + t; const int nvalid = (t + 1) < 256 ? (t + 1) : 256;
    const unsigned short* sel = (const unsigned short*)(p.ws + OFF_SEL) + (size_t)bt * 256;
    long Qf[4];
    { const char* qp_ = (const char*)(p.ws + OFF_AQ) + (size_t)bt * 1024 + (4 * g + (fr & 3)) * 128 + kg * 32; const i64x2 q0 = *(const i64x2*)qp_, q1 = *(const i64x2*)(qp_ + 16);
      Qf[0] = fr < 4 ? q0[0] : 0l; Qf[1] = fr < 4 ? q0[1] : 0l; Qf[2] = fr < 4 ? q1[0] : 0l; Qf[3] = fr < 4 ? q1[1] : 0l; }
    f32x4 lg[16];
#define AT_LOADK(Kx, c) do { _Pragma("unroll") for (int ii = 0; ii < 4; ++ii) { const char* kp = akb + (unsigned)kix[c][ii] * 256u + 32u * (unsigned)kg; \
        const i64x2 t0 = *(const i64x2*)kp, t1 = *(const i64x2*)(kp + 16); Kx[ii][0] = t0[0]; Kx[ii][1] = t0[1]; Kx[ii][2] = t1[0]; Kx[ii][3] = t1[1]; } } while (0)
#define AT_MMAK(Kx, c) do { _Pragma("unroll") for (int ii = 0; ii < 4; ++ii) { f32x4 a = (f32x4){0.f, 0.f, 0.f, 0.f}; \
        _Pragma("unroll") for (int s = 0; s < 4; ++s) a = __builtin_amdgcn_mfma_f32_16x16x32_fp8_fp8(Kx[ii][s], Qf[s], a, 0, 0, 0); lg[4 * (c) + ii] = a; } } while (0)
#define AT_LOADV(Vx, c) do { const u16x8 i0 = *(const u16x8*)(sel + 64 * (c) + 8 * (lane >> 3)); \
        _Pragma("unroll") for (int it = 0; it < 8; ++it) Vx[it] = *(const u32x4*)(avb + (unsigned)i0[it] * 256u + 16u * (unsigned)(lane & 7)); } while (0)
    u32x4 VA[8], VB[8];
    {
        long K0[4][4], K1[4][4], K2[4][4];
        AT_LOADK(K0, 0); AT_LOADK(K1, 1); AT_LOADK(K2, 2);
        AT_MMAK(K0, 0); AT_LOADK(K0, 3);
        AT_MMAK(K1, 1); AT_LOADV(VA, 0);
        AT_MMAK(K2, 2);
        AT_MMAK(K0, 3);
    }
#define DPP_F(oldv, srcv, ctrl, bank) __builtin_bit_cast(float, __builtin_amdgcn_update_dpp(__builtin_bit_cast(int, (float)(oldv)), __builtin_bit_cast(int, (float)(srcv)), (ctrl), 0xF, (bank), false))
    float val[4][4];
#pragma unroll
    for (int ii = 0; ii < 4; ++ii)
#pragma unroll
        for (int r = 0; r < 4; ++r) { float v = lg[ii][r];
            v = DPP_F(v, lg[4 + ii][r], 0x114, 0x2); v = DPP_F(v, lg[8 + ii][r], 0x118, 0x4); v = DPP_F(v, lg[12 + ii][r], 0x11C, 0x8); val[ii][r] = v; }
    const int cj = fr >> 2;
    float m = -INFINITY;
#pragma unroll
    for (int ii = 0; ii < 4; ++ii)
#pragma unroll
        for (int r = 0; r < 4; ++r) { const int slot = 64 * cj + 16 * kg + 4 * r + ii; const float v = (slot < nvalid) ? val[ii][r] * (0.08838834764831845f * 1.4426950408889634f) : -INFINITY; val[ii][r] = v; m = fmaxf(m, v); }
    m = fmaxf(m, __shfl_xor(m, 4)); m = fmaxf(m, __shfl_xor(m, 8)); m = fmaxf(m, __shfl_xor(m, 16)); m = fmaxf(m, __shfl_xor(m, 32));
    float sum = 0.f;
#pragma unroll
    for (int ii = 0; ii < 4; ++ii)
#pragma unroll
        for (int r = 0; r < 4; ++r) { const float e = __builtin_amdgcn_exp2f(val[ii][r] - m); val[ii][r] = e; sum += e; }
    sum += __shfl_xor(sum, 4); sum += __shfl_xor(sum, 8); sum += __shfl_xor(sum, 16); sum += __shfl_xor(sum, 32);
    const float pscale = __builtin_amdgcn_rcpf(sum) * 256.0f;
    int pl[2][2];
#pragma unroll
    for (int ipl = 0; ipl < 2; ++ipl) { int w0 = 0, w1 = 0;
        w0 = __builtin_amdgcn_cvt_pk_fp8_f32(val[2 * ipl][0] * pscale, val[2 * ipl][1] * pscale, w0, false); w0 = __builtin_amdgcn_cvt_pk_fp8_f32(val[2 * ipl][2] * pscale, val[2 * ipl][3] * pscale, w0, true);
        w1 = __builtin_amdgcn_cvt_pk_fp8_f32(val[2 * ipl + 1][0] * pscale, val[2 * ipl + 1][1] * pscale, w1, false); w1 = __builtin_amdgcn_cvt_pk_fp8_f32(val[2 * ipl + 1][2] * pscale, val[2 * ipl + 1][3] * pscale, w1, true);
        pl[ipl][0] = w0; pl[ipl][1] = w1; }
    long Pf[8];
#pragma unroll
    for (int ipl = 0; ipl < 2; ++ipl) {
        Pf[ipl] = (long)(((unsigned long long)(unsigned)pl[ipl][1] << 32) | (unsigned long long)(unsigned)pl[ipl][0]);
#define PF_GATHER(c, ctrl) do { const int lo_ = __builtin_amdgcn_update_dpp(0, pl[ipl][0], ctrl, 0xF, 0x1, false), hi_ = __builtin_amdgcn_update_dpp(0, pl[ipl][1], ctrl, 0xF, 0x1, false); \
            Pf[2 * (c) + ipl] = (long)(((unsigned long long)(unsigned)hi_ << 32) | (unsigned long long)(unsigned)lo_); } while (0)
        PF_GATHER(1, 0x104); PF_GATHER(2, 0x108); PF_GATHER(3, 0x10C);
#undef PF_GATHER
    }
#undef DPP_F
    f32x4 O[8];
#pragma unroll
    for (int ct = 0; ct < 8; ++ct) O[ct] = (f32x4){0.f, 0.f, 0.f, 0.f};
    if (qi < NQW - 1) AT_LOADI(t + 1, kixn);
    const h16x8 gate = *(const h16x8*)((const h16*)(p.ws + OFF_AZ) + (size_t)bt * 1024 + (4 * g) * 128 + 8 * lane);
    const int q4 = fr >> 2, pp = fr & 3;
    typedef int v2i_t __attribute__((__vector_size__(2 * sizeof(int))));
#define AT_STOREV(Vx) do { _Pragma("unroll") for (int it = 0; it < 8; ++it) { const int r = 8 * (lane >> 3) + it; const int fk = ((r >> 2) & 3) | (((r >> 4) & 1) << 2); \
        *(u32x4*)(vl + r * 128 + (((lane & 7) ^ fk) << 4)) = Vx[it]; } } while (0)
#define AT_PV(c) do { _Pragma("unroll") for (int ipl = 0; ipl < 2; ++ipl) { const int qq = fr >> 1; const int r = 16 * kg + 4 * (qq & 3) + 2 * ipl + (qq >> 2); const int fk = ((r >> 2) & 3) | (((r >> 4) & 1) << 2); \
        _Pragma("unroll") for (int ct = 0; ct < 8; ++ct) { const LAS unsigned char* a0 = vll + r * 128 + ((ct ^ fk) << 4) + (fr & 1) * 8; \
            const v2i_t bv = __builtin_amdgcn_ds_read_tr8_b64_v2i32((LAS v2i_t*)a0); \
            O[ct] = __builtin_amdgcn_mfma_f32_16x16x32_fp8_fp8(Pf[2 * (c) + ipl], __builtin_bit_cast(long, bv), O[ct], 0, 0, 0); } } } while (0)
    AT_LOADV(VB, 1); AT_STOREV(VA); AT_PV(0);
    AT_LOADV(VA, 2); AT_STOREV(VB); AT_PV(1);
    AT_LOADV(VB, 3); AT_STOREV(VA); AT_PV(2);
    AT_STOREV(VB); AT_PV(3);
#undef AT_LOADK
#undef AT_MMAK
#undef AT_LOADV
#undef AT_STOREV
#undef AT_PV
    h16* ot = (h16*)vl;
    if (kg == 0) {
#pragma unroll
        for (int ct = 0; ct < 8; ++ct)
#pragma unroll
            for (int r = 0; r < 4; ++r) ot[r * 128 + 16 * ct + fr] = (h16)O[ct][r];
    }
    {
        const h16x8 ov = *(const h16x8*)(ot + 8 * lane);
        h16x8 res;
#pragma unroll
        for (int j = 0; j < 8; ++j) res[j] = (h16)((float)ov[j] * (float)gate[j] * (1.0f / 256.0f));
        *(h16x8*)((h16*)(p.ws + OFF_OMIX) + (size_t)bt * 2048 + 1024 + (4 * g) * 128 + 8 * lane) = res;
    }
#pragma unroll
    for (int c = 0; c < 4; ++c) kix[c] = kixn[c];
    }
#undef AT_LOADI
}

__device__ __forceinline__ void phase5(const Params& p) {
    const int tid = opaque_tid(), wid = tid >> 6, lane = tid & 63;
    const int gw = blockIdx.x * 8 + wid, nw = gridDim.x * 8;
    const float* rowss = (const float*)(p.ws + OFF_ROWSS);
    for (int row = gw; row < BT; row += nw) {
        const float r = 1.0f / sqrtf(rowss[row] * (1.0f / DM) + EPS);
        f32x4* o = (f32x4*)(p.out + (size_t)row * DM);
        float eadd = 0.f;
        if ((TS_A >= 0 || TS_ACC >= 0) && row < 164) { const unsigned* ts = (const unsigned*)(p.ws + OFF_CTRL + 8192); const float tus = (TS_ACC >= 0) ? (float)ts[16 + (TS_ACC >= 0 ? TS_ACC : 0)] * (0.01f / 256.0f) : (float)(ts[TS_B >= 0 ? TS_B : 0] - ts[TS_A >= 0 ? TS_A : 0]) * 0.01f; eadd = sqrtf(tus * 1e-5f); }
#pragma unroll
        for (int i = 0; i < 8; ++i) { const f32x4 g = ((const f32x4*)p.final_g)[lane + 64 * i]; f32x4 v = o[lane + 64 * i]; v = v * r * g + eadd; o[lane + 64 * i] = v; }
    }
}

#define XB_TMO      128
#define XB_XCNT(j)  (256  + 64 * (j))
#define XB_XSUB(j)  (1280 + 64 * (j))
#define XB_XGEN(j)  (2304 + 64 * (j))
#define XB_TOP      3328
#define XB_TOPGEN   3392
#define XCD_BAR_WORDS 3456
#define XB_SPIN_CAP (1u << 18)

__device__ __forceinline__ unsigned xb_ld(unsigned* p)              { return __hip_atomic_load(p, __ATOMIC_RELAXED, __HIP_MEMORY_SCOPE_AGENT); }
__device__ __forceinline__ unsigned xb_add(unsigned* p, unsigned v) { return __hip_atomic_fetch_add(p, v, __ATOMIC_RELAXED, __HIP_MEMORY_SCOPE_AGENT); }
__device__ __forceinline__ unsigned xb_xcc_id() { return (unsigned)__builtin_amdgcn_s_getreg((3 << 11) | 20) & 0xFu; }
#define XB_SPIN(cond, bar) do { unsigned _sp = 0; while (cond) { __builtin_amdgcn_s_sleep(1); \
    if ((++_sp & 255u) == 0u) { if (xb_ld(&(bar)[XB_TMO])) break; if (_sp > XB_SPIN_CAP) { atomicAdd(&(bar)[XB_TMO], 1u); break; } } } } while (0)

struct XcdBarrier {
    unsigned* bar; unsigned x;
    volatile LAS unsigned* st;
};

__device__ __forceinline__ XcdBarrier xcd_barrier_post(unsigned* bar, volatile LAS unsigned* st) {
    XcdBarrier b; b.bar = bar; b.x = xb_xcc_id(); b.st = st;
    if (threadIdx.x == 0) (void)xb_add(&bar[XB_XCNT(b.x)], 1u);
    return b;
}
__device__ __forceinline__ void xcd_barrier_complete(unsigned* bar, unsigned x, unsigned& nloc, unsigned& nx) {
    const unsigned G = gridDim.x * gridDim.y * gridDim.z;
    unsigned sum, cnt, mine, sp = 0u;
    for (;;) {
        sum = 0u; cnt = 0u; mine = 0u;
#pragma unroll
        for (unsigned j = 0; j < 16; ++j) { const unsigned c = xb_ld(&bar[XB_XCNT(j)]); sum += c; cnt += (c > 0u) ? 1u : 0u; mine = (j == x) ? c : mine; }
        if (sum == G) break;
        __builtin_amdgcn_s_sleep(1);
        if ((++sp & 255u) == 0u) { if (xb_ld(&bar[XB_TMO])) break; if (sp > XB_SPIN_CAP) { atomicAdd(&bar[XB_TMO], 1u); break; } }
    }
    nloc = mine > 0u ? mine : 1u; nx = cnt > 0u ? cnt : 1u;
}

__device__ __forceinline__ void xcd_barrier(const XcdBarrier& b) {
    asm volatile("s_waitcnt vmcnt(0)" ::: "memory");
    __syncthreads();
    if (threadIdx.x == 0) {
        unsigned* bar = b.bar;
        __builtin_amdgcn_s_waitcnt(0);
        unsigned nloc = b.st[0], nx = b.st[1];
        if (nloc == 0u) { xcd_barrier_complete(bar, b.x, nloc, nx); b.st[0] = nloc; b.st[1] = nx; }
        const unsigned old = xb_add(&bar[XB_XSUB(b.x)], 1u);
        const unsigned gen = old / nloc;
        if (old + 1u == (gen + 1u) * nloc) {
            __builtin_amdgcn_fence(__ATOMIC_RELEASE, "agent");
            asm volatile("s_waitcnt vmcnt(0)" ::: "memory");
            const unsigned og = xb_add(&bar[XB_TOP], 1u);
            const unsigned tg = og / nx;
            if (og + 1u == (tg + 1u) * nx) xb_add(&bar[XB_TOPGEN], 1u);
            else XB_SPIN(xb_ld(&bar[XB_TOPGEN]) == tg, bar);
            __builtin_amdgcn_fence(__ATOMIC_ACQUIRE, "agent");
            xb_add(&bar[XB_XGEN(b.x)], 1u);
            asm volatile("s_waitcnt vmcnt(0)" ::: "memory");
        } else {
            XB_SPIN(xb_ld(&bar[XB_XGEN(b.x)]) == gen, bar);
            __builtin_amdgcn_fence(__ATOMIC_ACQUIRE, "agent");
            asm volatile("s_waitcnt vmcnt(0)" ::: "memory");
        }
    }
    __syncthreads();
}


template <int LO, int HI>
__global__ void __launch_bounds__(512, 2) k_phases(Params p) {
    extern __shared__ __attribute__((aligned(16))) unsigned char smem[];
#define IN(k) (LO <= (k) && (k) < HI)
#define SEAM(k) do { if constexpr (IN(k) && IN((k) + 1)) { xcd_barrier(xbar); if (TS_A >= 0 && blockIdx.x == 0 && threadIdx.x == 0) ((unsigned*)(p.ws + OFF_CTRL + 8192))[(k) + 1] = (unsigned)__builtin_amdgcn_s_memrealtime(); } } while (0)
    XcdBarrier xbar; xbar.bar = nullptr; xbar.x = 0; xbar.st = nullptr;
    if constexpr (HI - LO > 1) {
        volatile LAS unsigned* stw = (volatile LAS unsigned*)((LAS unsigned char*)smem + LDS_BYTES - 48);
        if (threadIdx.x < 4) stw[threadIdx.x] = 0u;
        __syncthreads();
        xbar = xcd_barrier_post((unsigned*)(p.ws + OFF_CTRL + 16384), stw);
    }
    if (TS_A >= 0 && blockIdx.x == 0 && threadIdx.x == 0) ((unsigned*)(p.ws + OFF_CTRL + 8192))[0] = (unsigned)__builtin_amdgcn_s_memrealtime();
    if constexpr (IN(0)) { for (int rep = 0; rep < NREP(0); ++rep) phase0(p, smem); }
    SEAM(0);
    if constexpr (IN(1)) for (int rep = 0; rep < NREP(1); ++rep) {
        EpiIn E{p.ws, p.a_log, p.dt_bias};
        {
            pg8::Gemm g{(const h16*)(p.ws + OFF_H), (const h16*)(p.ws + OFF_WT), BT, NPAD, DM};
            OrderF16 S; S.init(BT, 21 * 256, gridDim.x, blockIdx.x);
            pg8::gemm_phase<EpiIn, OrderF16>((LAS unsigned char*)smem, g, S, E);
        }
        {
            pg8::Gemm g{(const h16*)(p.ws + OFF_H8), (const h16*)(p.ws + OFF_WT8 - (size_t)16 * 256 * 2048), BT, 2560, DM};
            OrderF8 S; S.G = gridDim.x; S.c = blockIdx.x;
            pg8::gemm_phase<EpiIn, OrderF8, true, true>((LAS unsigned char*)smem, g, S, E);
        }
    }
    SEAM(1);
    if constexpr (IN(2)) for (int rep = 0; rep < NREP(2); ++rep) {
        {
            unsigned* qctr = (unsigned*)(p.ws + OFF_CTRL);
            volatile unsigned* lds_t = (volatile unsigned*)(smem + LDS_BYTES - 16);
            __syncthreads();
            if (threadIdx.x == 0) lds_t[0] = atomicAdd(qctr + 0 + 16 * rep, 1u);
            __syncthreads();
            unsigned o = lds_t[0];
            while (o < 1024u + 2048u) {
                unsigned nxt = 0u;
                if (threadIdx.x == 0) nxt = atomicAdd(qctr + 0 + 16 * rep, 1u);
                if (o < 1024u) { ACC_T0(); gdn_prep_pair(p, smem, (int)o); __syncthreads(); ACC_ADD(0); }
                else { const unsigned o2 = o - 1024u; idx8_task(p, smem, (int)(o2 & 3u), 511 - (int)(o2 >> 2)); }
                __syncthreads();
                if (threadIdx.x == 0) lds_t[0] = nxt;
                __syncthreads();
                o = lds_t[0];
            }
        }
    }
    SEAM(2);
    if constexpr (IN(3)) for (int rep = 0; rep < NREP(3); ++rep) {
        {
            unsigned* qctr = (unsigned*)(p.ws + OFF_CTRL);
            volatile unsigned* lds_t = (volatile unsigned*)(smem + LDS_BYTES - 16);
            volatile unsigned* lds_c = (volatile unsigned*)(smem + LDS_BYTES - 192);
            const int myx = (int)(xb_xcc_id() & 7u);
            for (int pass = 0; pass < 2; ++pass) {
                if (pass == 1) { __syncthreads(); if (threadIdx.x < 8) lds_c[8 + threadIdx.x] = __hip_atomic_load(qctr + 64 + 16 * rep + threadIdx.x, __ATOMIC_RELAXED, __HIP_MEMORY_SCOPE_AGENT); __syncthreads(); }
                const int nk = pass == 0 ? 1 : 8;
                for (int k = 0; k < nk; ++k) {
                    const int sp = (myx + k) & 7;
                    if (pass == 1 && lds_c[8 + sp] >= 4u) continue;
                    for (;;) {
                        __syncthreads();
                        if (threadIdx.x == 0) lds_t[0] = atomicAdd(qctr + 64 + 16 * rep + sp, 1u);
                        __syncthreads();
                        const unsigned o = lds_t[0];
                        if (o >= 4u) break;
                        { ACC_T0(); gdn_scan_task(p, smem, 4 * sp + (int)o); __syncthreads(); ACC_ADD(4); }
                        if (pass == 0) break;
                    }
                }
                if (pass == 0) for (int k = 0; k < 8; ++k) {
                    const int part = (myx + k) & 7;
                    if (k == 1) { __syncthreads(); if (threadIdx.x < 8) lds_c[threadIdx.x] = __hip_atomic_load(qctr + 128 + 16 * rep + threadIdx.x, __ATOMIC_RELAXED, __HIP_MEMORY_SCOPE_AGENT); __syncthreads(); }
                    if (k >= 1 && lds_c[part] >= 512u) continue;
                    __syncthreads();
                    if (threadIdx.x == 0) lds_t[0] = atomicAdd(qctr + 128 + 16 * rep + part, 1u);
                    __syncthreads();
                    unsigned a = lds_t[0];
                    while (a < 512u) {
                        unsigned nxt = 0u;
                        if (threadIdx.x == 0) nxt = atomicAdd(qctr + 128 + 16 * rep + part, 1u);
                        { ACC_T0(); attn8_task(p, smem, part, (int)a); __syncthreads(); ACC_ADD(3); }
                        __syncthreads();
                        if (threadIdx.x == 0) lds_t[0] = nxt;
                        __syncthreads();
                        a = lds_t[0];
                    }
                }
            }
        }
    }
    SEAM(3);
    const bool fuse_norm = (gridDim.x == 256) && (TS_A < 0) && (TS_ACC < 0);
    if constexpr (IN(4)) {
        pg8::Gemm g{(const h16*)(p.ws + OFF_OMIX), (const h16*)(p.ws + OFF_WOT), BT, DM, DM};
        if (fuse_norm) {
            PanelOrder S; S.c = blockIdx.x;
            EpiOutNorm E{p.x, p.out, (float*)(p.ws + OFF_ROWSS), (unsigned*)(p.ws + OFF_CTRL + 32768), p.final_g};
            pg8::gemm_phase<EpiOutNorm, PanelOrder>((LAS unsigned char*)smem, g, S, E);
        } else {
            pg8::StaticOrder S; S.init(BT, DM, gridDim.x, blockIdx.x);
            EpiOut E{p.x, p.out, (float*)(p.ws + OFF_ROWSS)};
            pg8::gemm_phase<EpiOut, pg8::StaticOrder>((LAS unsigned char*)smem, g, S, E);
        }
    }
    if (fuse_norm) return;
    SEAM(4);
    if constexpr (IN(5)) { phase5(p); }
#undef IN
#undef SEAM
}

template <int LO, int HI> static void launch_range(const Params& p, int grid, hipStream_t stream, bool coop) {
    static bool attr = false;
    if (!attr) { hipFuncSetAttribute((const void*)k_phases<LO, HI>, hipFuncAttributeMaxDynamicSharedMemorySize, LDS_BYTES); attr = true; }
    if (coop) {
        Params pp = p; void* args[] = {&pp};
        hipError_t e = hipLaunchCooperativeKernel((const void*)k_phases<LO, HI>, dim3(grid), dim3(512), args, LDS_BYTES, stream);
        if (e != hipSuccess) fprintf(stderr, "cooperative launch failed: %s (grid %d)\n", hipGetErrorString(e), grid);
    } else {
        hipLaunchKernelGGL((k_phases<LO, HI>), dim3(grid), dim3(512), LDS_BYTES, stream, p);
    }
}

extern "C" void kernel_launch(void* const* d_in, const int* in_sizes, int n_in, void* d_out, int out_size, void* d_ws, size_t ws_size, hipStream_t stream) {
    if (n_in != 10 || in_sizes[0] != BT * DM || out_size != BT * DM || ws_size < WS_END) {
        fprintf(stderr, "kernel_launch: unexpected shapes (n_in %d in0 %d out %d ws %zu need %zu)\n", n_in, n_in > 0 ? in_sizes[0] : -1, out_size, ws_size, (size_t)WS_END); return; }
    static int grid = 0;
    if (!grid) {
        int dev = 0, cus = 0, per_cu = 0; hipGetDevice(&dev); hipDeviceGetAttribute(&cus, hipDeviceAttributeMultiprocessorCount, dev);
#if FUSED
        hipFuncSetAttribute((const void*)k_phases<0, 6>, hipFuncAttributeMaxDynamicSharedMemorySize, LDS_BYTES);
        hipOccupancyMaxActiveBlocksPerMultiprocessor(&per_cu, (const void*)k_phases<0, 6>, 512, LDS_BYTES);
#else
        per_cu = 1;
#endif
        if (per_cu < 1) per_cu = 1; if (per_cu > 1) per_cu = 1;
        grid = cus * per_cu;
    }
    Params p{};
    p.x = (const float*)d_in[0]; p.pos = (const int*)d_in[1]; p.attn_g = (const float*)d_in[2]; p.w_in = (const float*)d_in[3]; p.conv_w = (const float*)d_in[4];
    p.a_log = (const float*)d_in[5]; p.dt_bias = (const float*)d_in[6]; p.gdn_norm_g = (const float*)d_in[7]; p.w_out = (const float*)d_in[8]; p.final_g = (const float*)d_in[9];
    p.out = (float*)d_out; p.ws = (unsigned char*)d_ws;
    hipMemsetAsync((char*)d_ws + OFF_CTRL, 0, CTL_ZERO_BYTES, stream);
#if FUSED
    launch_range<0, 6>(p, grid, stream, false);
#else
    launch_range<0, 1>(p, grid, stream, false);
    launch_range<1, 2>(p, grid, stream, false);
    launch_range<2, 3>(p, grid, stream, false);
    launch_range<3, 4>(p, grid, stream, false);
    launch_range<4, 5>(p, grid, stream, false);
    launch_range<5, 6>(p, grid, stream, false);
#endif
}
```

```cpp
#include <hip/hip_runtime.h>
#include <hip/hip_cooperative_groups.h>
#include <cstdio>
#include <cstdint>
namespace cg = cooperative_groups;

#ifndef FUSED
#define FUSED 1
#endif
#ifndef REPEAT_PHASE
#define REPEAT_PHASE -1
#endif
#define NREP(k) ((REPEAT_PHASE == (k)) ? 2 : 1)
#ifndef TS_A
#define TS_A -1
#endif
#ifndef TS_ACC
#define TS_ACC -1
#endif
#define ACC_T0() unsigned acc_t0_ = 0; if (TS_ACC >= 0 && threadIdx.x == 0) acc_t0_ = (unsigned)__builtin_amdgcn_s_memrealtime()
#define ACC_ADD(k) do { if (TS_ACC >= 0 && threadIdx.x == 0) { const unsigned t1_ = (unsigned)__builtin_amdgcn_s_memrealtime(); atomicAdd((unsigned*)(p.ws + OFF_CTRL + 8192) + 16 + (k), t1_ - acc_t0_); acc_t0_ = t1_; } } while (0)
#ifndef TS_B
#define TS_B -1
#endif

#define LAS __attribute__((address_space(3)))
typedef _Float16 h16;
typedef h16 h16x8 __attribute__((ext_vector_type(8)));
typedef h16 h16x4 __attribute__((ext_vector_type(4)));
typedef h16 h16x2 __attribute__((ext_vector_type(2)));
typedef float f32x4 __attribute__((ext_vector_type(4)));
typedef float f32x2 __attribute__((ext_vector_type(2)));
typedef unsigned u32x4 __attribute__((ext_vector_type(4)));

constexpr int NB = 4, NT = 4096, DM = 2048, BT = NB * NT;
constexpr int IN_COLS = 7776, NPAD = 7936;
constexpr float EPS = 1e-6f;
constexpr int LDS_BYTES = 155648;

constexpr size_t MB = 1024 * 1024;
constexpr size_t OFF_CTRL = 0;
constexpr size_t OFF_ROWSS = 65536;
constexpr size_t CTL_ZERO_BYTES = 65536 + (size_t)BT * 4;
constexpr size_t OFF_H = 1 * MB;
constexpr size_t OFF_OMIX = OFF_H;
constexpr size_t OFF_WT = OFF_H + 64 * MB;
constexpr size_t OFF_WOT = OFF_WT + (size_t)NPAD * 2048 * 2;
constexpr size_t OFF_QKVR = OFF_WOT + 8 * MB;
constexpr size_t OFF_GZ = OFF_QKVR + (size_t)BT * 3072 * 2;
constexpr size_t OFF_AQ = OFF_GZ + 32 * MB;
constexpr size_t OFF_AK = OFF_AQ + 32 * MB;
constexpr size_t OFF_AV = OFF_AK + 8 * MB;
constexpr size_t OFF_AZ = OFF_AV + 8 * MB;
constexpr size_t OFF_IQ = OFF_AZ + 32 * MB;
constexpr size_t OFF_IK = OFF_IQ + 32 * MB;
constexpr size_t OFF_GB = OFF_IK + 2 * MB;
constexpr size_t OFF_IW = OFF_GB + 1 * MB;
constexpr size_t OFF_COS = OFF_IW + 1 * MB;
constexpr size_t OFF_SIN = OFF_COS + 2 * MB;
constexpr size_t OFF_SEL = OFF_SIN + 2 * MB;
constexpr size_t OFF_REC = OFF_SEL + 8 * MB;
constexpr size_t OFF_H8 = OFF_REC;
constexpr size_t OFF_WT8 = OFF_REC + 32 * MB;
constexpr size_t WS_END = OFF_REC + (size_t)2048 * 74752;

struct Params {
    const float* x; const int* pos; const float* attn_g; const float* w_in; const float* conv_w; const float* a_log;
    const float* dt_bias; const float* gdn_norm_g; const float* w_out; const float* final_g; float* out; unsigned char* ws;
};

__device__ __forceinline__ float wave_sum(float v) {
#pragma unroll
    for (int o = 1; o < 64; o <<= 1) v += __shfl_xor(v, o);
    return v;
}
__device__ __forceinline__ float wave_max(float v) {
#pragma unroll
    for (int o = 1; o < 64; o <<= 1) v = fmaxf(v, __shfl_xor(v, o));
    return v;
}
__device__ __forceinline__ int opaque_tid() { int t = threadIdx.x; asm volatile("" : "+v"(t)); return t; }
__device__ __forceinline__ float silu_f(float x) { return x * __builtin_amdgcn_rcpf(1.0f + __builtin_amdgcn_exp2f(-1.4426950408889634f * x)); }

namespace pg8 {
constexpr int BM = 256, BK = 64, HALF = 128, HTB = HALF * BK * 2, STAGE_BYTES = 8 * HTB, NXCD = 8, WGM = 8;
__host__ __device__ __forceinline__ int lds_byte(int r, int c) { const int st = (r >> 4) * 2 + (c >> 5), rr = r & 15, cc = c & 31, ob = rr * 64 + cc * 2; return st * 1024 + (ob ^ (((ob >> 9) & 1) << 5)); }
__host__ __device__ __forceinline__ void stage_rc(int b, int& R, int& C) { const int st = b / 1024, sb = b % 1024, swz = sb ^ (((sb >> 9) & 1) << 5); R = (st >> 1) * 16 + swz / 64; C = (st & 1) * 32 + (swz % 64) / 2; }
__host__ __device__ __forceinline__ int perm32(int rho) { const int n = rho >> 4, i = rho & 15; return 8 * (i >> 2) + 4 * n + (i & 3); }
struct Unit { int pm, pn; };
struct Gemm { const h16* A; const h16* Bt; int M, N, K; };
struct StaticOrder {
    int nM, nN, nwg, G, c;
    __host__ __device__ void init(int M, int N, int G_, int c_) { nM = M / BM; nN = N / BM; nwg = nM * nN; G = G_; c = c_; }
    __host__ __device__ bool next(int i, Unit& u) const {
        const long L = (long)i * G + c; if (L >= nwg) return false;
        int wgid = (int)L; { const int q = nwg / NXCD, r = nwg % NXCD, xcd = wgid % NXCD, off = wgid / NXCD; wgid = (xcd < r ? xcd * (q + 1) : r * (q + 1) + (xcd - r) * q) + off; }
        const int nig = WGM * nN, gid = wgid / nig, fm = gid * WGM, gsz = (nM - fm) < WGM ? (nM - fm) : WGM;
        u.pm = fm + ((wgid % nig) % gsz); u.pn = (wgid % nig) / gsz; return true;
    }
    __device__ __forceinline__ void a_ready(const Unit&) const {}
    __device__ __forceinline__ void done(const Unit&) const {}
};

typedef int i32x8 __attribute__((ext_vector_type(8)));
template <class Epi, class Sched, bool SP2 = true, bool F8 = false>
__device__ __forceinline__ void gemm_phase(LAS unsigned char* lds, const Gemm g, const Sched& S, const Epi& E) {
    const int tid = opaque_tid(), wid = __builtin_amdgcn_readfirstlane(tid >> 6), lane = tid & 63, wr = wid >> 2, wc = wid & 3, fr = lane & 15, fq = lane >> 4;
    const int K = g.K;
    const int ESZ = F8 ? 1 : 2, nt = (K * ESZ) / 128;
    unsigned voffA[2], voffB[2];
#pragma unroll
    for (int i = 0; i < 2; ++i) { int R, C; stage_rc(tid * 16 + i * 8192, R, C); const int Rb = Epi::PERM ? ((R & ~31) + perm32(R & 31)) : R;
        voffA[i] = (unsigned)(R * K * ESZ + C * 2); voffB[i] = (unsigned)(Rb * K * ESZ + C * 2); }
    const size_t kstep = (size_t)(BK * 2);
    const size_t hstep = (size_t)HALF * K * ESZ;
    const size_t tstep = 2 * hstep;
    const unsigned ldsw = (unsigned)wid * 1024u;
    const int aoff = lds_byte(wr * 64 + fr, fq * 8), boff = lds_byte(wc * 32 + fr, fq * 8);
#define PG8_SA(b, h) (((b) * 2 + (h)) * HTB)
#define PG8_SB(b, h) ((4 + (b) * 2 + (h)) * HTB)
#define PG8_STAGE(bufoff, gbase, voff) do { _Pragma("unroll") for (int _i = 0; _i < 2; ++_i) \
        __builtin_amdgcn_global_load_lds((const unsigned*)((const char*)(gbase) + (voff)[_i]), (LAS unsigned*)(lds + (bufoff) + ldsw + _i * 8192), 16, 0, 0); } while (0)
#define PG8_LDA(dst, b, h) do { _Pragma("unroll") for (int m = 0; m < 4; ++m) _Pragma("unroll") for (int k = 0; k < 2; ++k) dst[m][k] = *(const LAS h16x8*)(lds + PG8_SA(b, h) + aoff + m * 2048 + k * 1024); } while (0)
#define PG8_LDB(dst, b, h) do { _Pragma("unroll") for (int n = 0; n < 2; ++n) _Pragma("unroll") for (int k = 0; k < 2; ++k) dst[n][k] = *(const LAS h16x8*)(lds + PG8_SB(b, h) + boff + n * 2048 + k * 1024); } while (0)
#define PG8_MMA(ai, bj, At, Bt) do { __builtin_amdgcn_s_setprio(1); \
        if constexpr (F8) { _Pragma("unroll") for (int m = 0; m < 4; ++m) _Pragma("unroll") for (int n = 0; n < 2; ++n) { \
            const u32x4 b0_ = __builtin_bit_cast(u32x4, Bt[n][0]), b1_ = __builtin_bit_cast(u32x4, Bt[n][1]), a0_ = __builtin_bit_cast(u32x4, At[m][0]), a1_ = __builtin_bit_cast(u32x4, At[m][1]); \
            const i32x8 bw_ = (i32x8){(int)b0_[0], (int)b0_[1], (int)b0_[2], (int)b0_[3], (int)b1_[0], (int)b1_[1], (int)b1_[2], (int)b1_[3]}; \
            const i32x8 aw_ = (i32x8){(int)a0_[0], (int)a0_[1], (int)a0_[2], (int)a0_[3], (int)a1_[0], (int)a1_[1], (int)a1_[2], (int)a1_[3]}; \
            asm volatile("v_mfma_scale_f32_16x16x128_f8f6f4 %0, %1, %2, %0, %3, %3 op_sel_hi:[0,0,0]" : "+v"(acc[ai][bj][m][n]) : "v"(bw_), "v"(aw_), "v"(0x7C7C7C7C)); } } \
        else { _Pragma("unroll") for (int m = 0; m < 4; ++m) _Pragma("unroll") for (int n = 0; n < 2; ++n) _Pragma("unroll") for (int k = 0; k < 2; ++k) \
            acc[ai][bj][m][n] = __builtin_amdgcn_mfma_f32_16x16x32_f16(Bt[n][k], At[m][k], acc[ai][bj][m][n], 0, 0, 0); } \
        __builtin_amdgcn_s_setprio(0); } while (0)
#define PG8_WAIT_V(n) asm volatile("s_waitcnt vmcnt(" #n ")" ::: "memory")
#define PG8_WAIT_L(n) asm volatile("s_waitcnt lgkmcnt(" #n ")" ::: "memory")
#define PG8_BAR __builtin_amdgcn_s_barrier()
#define PG8_SCHED __builtin_amdgcn_sched_barrier(0)
    Unit cur, nxt; int ui = 0;
    if (!S.next(0, cur)) return;
    f32x4 acc[2][2][4][2];
#pragma unroll
    for (int a = 0; a < 2; ++a)
#pragma unroll
        for (int b = 0; b < 2; ++b)
#pragma unroll
            for (int m = 0; m < 4; ++m)
#pragma unroll
                for (int n = 0; n < 2; ++n) acc[a][b][m][n] = (f32x4){0.f, 0.f, 0.f, 0.f};
    h16x8 At[4][2], B0[2][2], B1[2][2];
    const char* cA = (const char*)g.A + (size_t)cur.pm * tstep; const char* cB = (const char*)g.Bt + (size_t)cur.pn * tstep;
    S.a_ready(cur);
    if constexpr (SP2) {
        PG8_STAGE(PG8_SB(0, 0), cB, voffB); PG8_STAGE(PG8_SB(0, 1), cB + hstep, voffB); PG8_STAGE(PG8_SA(0, 0), cA, voffA); PG8_STAGE(PG8_SA(0, 1), cA + hstep, voffA);
        if (wr == 1) PG8_BAR;
        PG8_WAIT_V(2); PG8_BAR;
        PG8_STAGE(PG8_SB(1, 0), cB + kstep, voffB); PG8_STAGE(PG8_SA(1, 0), cA + kstep, voffA); PG8_STAGE(PG8_SB(1, 1), cB + hstep + kstep, voffB);
        PG8_WAIT_V(6); PG8_BAR;
    } else {
    PG8_STAGE(PG8_SB(0, 0), cB, voffB); PG8_STAGE(PG8_SA(0, 0), cA, voffA); PG8_STAGE(PG8_SB(0, 1), cB + hstep, voffB); PG8_STAGE(PG8_SA(0, 1), cA + hstep, voffA);
    if (wr == 1) PG8_BAR;
    PG8_WAIT_V(4); PG8_BAR;
    PG8_STAGE(PG8_SB(1, 0), cB + kstep, voffB); PG8_STAGE(PG8_SA(1, 0), cA + kstep, voffA); PG8_STAGE(PG8_SB(1, 1), cB + hstep + kstep, voffB);
    PG8_WAIT_V(6); PG8_BAR;
    }
    for (;;) {
        const bool has_next = S.next(ui + 1, nxt);
        const char* nA = has_next ? (const char*)g.A + (size_t)nxt.pm * tstep : cA; const char* nB = has_next ? (const char*)g.Bt + (size_t)nxt.pn * tstep : cB;
        for (int t = 0; t < nt; t += 2) {
            const bool last = (t == nt - 2);
            const char* a1 = cA + (size_t)(t + 1) * kstep;
            const char* a2 = last ? nA : cA + (size_t)(t + 2) * kstep; const char* b2 = last ? nB : cB + (size_t)(t + 2) * kstep;
            const char* a3 = a2 + kstep; const char* b3 = b2 + kstep;
            if (last && has_next) S.a_ready(nxt);
            if constexpr (SP2) {
            PG8_LDB(B0, 0, 0); PG8_LDB(B1, 0, 1); PG8_SCHED; PG8_LDA(At, 0, 0); PG8_STAGE(PG8_SA(1, 1), a1 + hstep, voffA);
            PG8_WAIT_V(8); PG8_WAIT_L(0); PG8_BAR; PG8_MMA(0, 0, At, B0); PG8_MMA(0, 1, At, B1); PG8_BAR; PG8_SCHED;
            PG8_LDA(At, 0, 1); PG8_STAGE(PG8_SB(0, 0), b2, voffB); PG8_STAGE(PG8_SB(0, 1), b2 + hstep, voffB); PG8_STAGE(PG8_SA(0, 0), a2, voffA);
            PG8_WAIT_V(8); PG8_WAIT_L(0); PG8_BAR; PG8_MMA(1, 0, At, B0); PG8_MMA(1, 1, At, B1); PG8_BAR; PG8_SCHED;
            PG8_LDB(B0, 1, 0); PG8_LDB(B1, 1, 1); PG8_SCHED; PG8_LDA(At, 1, 0); PG8_STAGE(PG8_SA(0, 1), a2 + hstep, voffA);
            PG8_WAIT_V(8); PG8_WAIT_L(0); PG8_BAR; PG8_MMA(0, 0, At, B0); PG8_MMA(0, 1, At, B1); PG8_BAR; PG8_SCHED;
            PG8_LDA(At, 1, 1); PG8_STAGE(PG8_SB(1, 0), b3, voffB); PG8_STAGE(PG8_SB(1, 1), b3 + hstep, voffB); PG8_STAGE(PG8_SA(1, 0), a3, voffA);
            PG8_WAIT_V(8); PG8_WAIT_L(0); PG8_BAR; PG8_MMA(1, 0, At, B0); PG8_MMA(1, 1, At, B1); PG8_BAR; PG8_SCHED;
            } else {
            PG8_LDB(B0, 0, 0); PG8_SCHED; PG8_LDA(At, 0, 0); PG8_STAGE(PG8_SA(1, 1), a1 + hstep, voffA);
            PG8_WAIT_L(8); PG8_BAR; PG8_WAIT_L(0); PG8_MMA(0, 0, At, B0); PG8_BAR; PG8_SCHED;
            PG8_LDB(B1, 0, 1); PG8_STAGE(PG8_SB(0, 0), b2, voffB);
            PG8_BAR; PG8_WAIT_L(0); PG8_MMA(0, 1, At, B1); PG8_BAR;
            PG8_LDA(At, 0, 1); PG8_STAGE(PG8_SA(0, 0), a2, voffA);
            PG8_BAR; PG8_WAIT_L(0); PG8_MMA(1, 0, At, B0); PG8_BAR; PG8_SCHED;
            PG8_STAGE(PG8_SB(0, 1), b2 + hstep, voffB);
            PG8_WAIT_V(6); PG8_BAR; PG8_MMA(1, 1, At, B1); PG8_BAR;
            PG8_LDB(B0, 1, 0); PG8_SCHED; PG8_LDA(At, 1, 0); PG8_STAGE(PG8_SA(0, 1), a2 + hstep, voffA);
            PG8_WAIT_L(8); PG8_BAR; PG8_WAIT_L(0); PG8_MMA(0, 0, At, B0); PG8_BAR; PG8_SCHED;
            PG8_LDB(B1, 1, 1); PG8_STAGE(PG8_SB(1, 0), b3, voffB);
            PG8_BAR; PG8_WAIT_L(0); PG8_MMA(0, 1, At, B1); PG8_BAR;
            PG8_LDA(At, 1, 1); PG8_STAGE(PG8_SA(1, 0), a3, voffA);
            PG8_BAR; PG8_WAIT_L(0); PG8_MMA(1, 0, At, B0); PG8_BAR; PG8_SCHED;
            PG8_STAGE(PG8_SB(1, 1), b3 + hstep, voffB);
            PG8_WAIT_V(6); PG8_BAR; PG8_MMA(1, 1, At, B1); PG8_BAR;
            }
        }
        if (wr == 0) PG8_BAR;
        if constexpr (F8) asm volatile("s_nop 15\n\ts_nop 15" ::: "memory");
        PG8_SCHED; { const int te = opaque_tid(), le = te & 63; E(acc, cur, wr, wc, le & 15, le >> 4); } S.done(cur);
        if (!has_next) break;
#pragma unroll
        for (int a = 0; a < 2; ++a)
#pragma unroll
            for (int b = 0; b < 2; ++b)
#pragma unroll
                for (int m = 0; m < 4; ++m)
#pragma unroll
                    for (int n = 0; n < 2; ++n) acc[a][b][m][n] = (f32x4){0.f, 0.f, 0.f, 0.f};
        cur = nxt; cA = nA; cB = nB; ++ui;
        if (wr == 1) PG8_BAR;
    }
    PG8_WAIT_V(0);
    PG8_BAR;
#undef PG8_SA
#undef PG8_SB
#undef PG8_STAGE
#undef PG8_LDA
#undef PG8_LDB
#undef PG8_MMA
#undef PG8_WAIT_V
#undef PG8_WAIT_L
#undef PG8_BAR
#undef PG8_SCHED
}
}

struct OrderF16 : pg8::StaticOrder {
    __device__ __forceinline__ bool next(int i, pg8::Unit& u) const { if (!pg8::StaticOrder::next(i, u)) return false; if (u.pn >= 16) u.pn += 10; return true; }
};
struct OrderF8 {
    int G, c;
    __device__ __forceinline__ bool next(int i, pg8::Unit& u) const {
        int L;
        if (G == 256) { if (c < 64) { if (i >= 1) return false; L = 576 + c; } else { if (i >= 3) return false; L = (c - 64) + 192 * i; } }
        else { L = i * G + c; if (L >= 640) return false; }
        const int wgid = (L % 8) * 80 + L / 8;
        u.pm = (wgid / 80) * 8 + (wgid % 80) % 8; u.pn = 16 + (wgid % 80) / 8; return true;
    }
    __device__ __forceinline__ void a_ready(const pg8::Unit&) const {}
    __device__ __forceinline__ void done(const pg8::Unit&) const {}
};

struct EpiIn {
    static constexpr bool PERM = true;
    unsigned char* ws; const float* a_log; const float* dt_bias;
    __device__ __forceinline__ void operator()(const f32x4 (&acc)[2][2][4][2], const pg8::Unit& u, int wr, int wc, int fr, int fq) const {
        const int pn = u.pn;
        const int rowb = u.pm * 256 + wr * 64 + fr;
        const int cw = wc * 32 + 8 * fq;
        const float* cosT = (const float*)(ws + OFF_COS); const float* sinT = (const float*)(ws + OFF_SIN);
        if (pn < 30) {
            h16* base; int ldc, colt, mode; float scale = 1.f;
            if (pn < 12) { base = (h16*)(ws + OFF_QKVR); ldc = 3072; colt = pn * 256; mode = 0; }
            else if (pn < 16) { base = (h16*)(ws + OFF_GZ); ldc = 1024; colt = (pn - 12) * 256; mode = 1; }
            else if (pn < 20) { base = (h16*)(ws + OFF_AQ); ldc = 1024; colt = (pn - 16) * 256; mode = 2; }
            else if (pn == 20) { base = (h16*)(ws + OFF_AK); ldc = 256; colt = 0; mode = 2; }
            else if (pn == 21) { base = (h16*)(ws + OFF_AV); ldc = 256; colt = 0; mode = 4; }
            else if (pn < 26) { base = (h16*)(ws + OFF_AZ); ldc = 1024; colt = (pn - 22) * 256; mode = 1; }
            else { base = (h16*)(ws + OFF_IQ); ldc = 1024; colt = (pn - 26) * 256; mode = 3; }
            const bool rot_wave = (mode == 2 && wc == 0) || (mode == 3 && (wc & 1) == 0);
            const int xm = (mode == 2) ? 32 : 16;
            const bool rot_lane = (mode == 2) ? true : (fq < 2);
            const float sgn = (mode == 2) ? (fq < 2 ? -1.f : 1.f) : (fq == 0 ? -1.f : 1.f);
            const int tix = (mode == 2) ? 8 * (fq & 1) : 16;
            const int pidx = (((fq << 4) | fr) ^ xm) << 2;
#pragma unroll
            for (int ai = 0; ai < 2; ++ai)
#pragma unroll
                for (int m = 0; m < 4; ++m) {
                    const int row = rowb + ai * 128 + m * 16;
                    float cs[8], sn[8];
                    if (rot_wave) {
                        const f32x4 c0 = *(const f32x4*)(cosT + (size_t)row * 24 + tix), c1 = *(const f32x4*)(cosT + (size_t)row * 24 + tix + 4);
                        const f32x4 s0 = *(const f32x4*)(sinT + (size_t)row * 24 + tix), s1 = *(const f32x4*)(sinT + (size_t)row * 24 + tix + 4);
#pragma unroll
                        for (int j = 0; j < 4; ++j) { cs[j] = c0[j]; cs[4 + j] = c1[j]; sn[j] = s0[j]; sn[4 + j] = s1[j]; }
                    }
#pragma unroll
                    for (int bj = 0; bj < 2; ++bj) {
                        float v[8];
#pragma unroll
                        for (int j = 0; j < 4; ++j) { v[j] = acc[ai][bj][m][0][j]; v[4 + j] = acc[ai][bj][m][1][j]; }
                        if (rot_wave) {
#pragma unroll
                            for (int j = 0; j < 8; ++j) { const float pv = __builtin_bit_cast(float, __builtin_amdgcn_ds_bpermute(pidx, __builtin_bit_cast(int, v[j]))); if (rot_lane) v[j] = v[j] * cs[j] + sgn * pv * sn[j]; }
                        }
                        if (mode == 1) {
#pragma unroll
                            for (int j = 0; j < 8; ++j) v[j] = silu_f(v[j]);
                        }
                        if (mode == 4) {
                            int w0 = 0, w1 = 0;
                            w0 = __builtin_amdgcn_cvt_pk_fp8_f32(v[0], v[1], w0, false); w0 = __builtin_amdgcn_cvt_pk_fp8_f32(v[2], v[3], w0, true);
                            w1 = __builtin_amdgcn_cvt_pk_fp8_f32(v[4], v[5], w1, false); w1 = __builtin_amdgcn_cvt_pk_fp8_f32(v[6], v[7], w1, true);
                            typedef int i32x2b __attribute__((ext_vector_type(2)));
                            *(i32x2b*)((unsigned char*)base + (size_t)row * ldc + bj * 128 + cw) = (i32x2b){w0, w1};
                        } else if (mode == 2) {
                            int w0 = 0, w1 = 0;
                            w0 = __builtin_amdgcn_cvt_pk_fp8_f32(v[0], v[1], w0, false); w0 = __builtin_amdgcn_cvt_pk_fp8_f32(v[2], v[3], w0, true);
                            w1 = __builtin_amdgcn_cvt_pk_fp8_f32(v[4], v[5], w1, false); w1 = __builtin_amdgcn_cvt_pk_fp8_f32(v[6], v[7], w1, true);
                            typedef int i32x2 __attribute__((ext_vector_type(2)));
                            *(i32x2*)((unsigned char*)base + (size_t)row * ldc + colt + bj * 128 + fq * 32 + wc * 8) = (i32x2){w0, w1};
                        } else {
                            h16x8 o;
#pragma unroll
                            for (int j = 0; j < 8; ++j) o[j] = (h16)(v[j] * scale);
                            *(h16x8*)(base + (size_t)row * ldc + colt + bj * 128 + cw) = o;
                        }
                    }
                }
        } else {
            h16* ik = (h16*)(ws + OFF_IK); float* gb = (float*)(ws + OFF_GB); float* iw = (float*)(ws + OFF_IW);
#pragma unroll
            for (int ai = 0; ai < 2; ++ai)
#pragma unroll
                for (int m = 0; m < 4; ++m) {
                    const int row = rowb + ai * 128 + m * 16;
                    float v[8];
#pragma unroll
                    for (int j = 0; j < 4; ++j) { v[j] = acc[ai][0][m][0][j]; v[4 + j] = acc[ai][0][m][1][j]; }
                    const f32x4 c0 = *(const f32x4*)(cosT + (size_t)row * 24 + 16), c1 = *(const f32x4*)(cosT + (size_t)row * 24 + 20);
                    const f32x4 s0 = *(const f32x4*)(sinT + (size_t)row * 24 + 16), s1 = *(const f32x4*)(sinT + (size_t)row * 24 + 20);
                    if (wc == 0) {
                        const float sgn = (fq == 0 ? -1.f : 1.f);
#pragma unroll
                        for (int j = 0; j < 8; ++j) { const float pv = __shfl_xor(v[j], 16); const float c = j < 4 ? c0[j & 3] : c1[j & 3], s = j < 4 ? s0[j & 3] : s1[j & 3];
                            if (fq < 2) v[j] = v[j] * c + sgn * pv * s; }
                    }
                    if (wc < 2) {
                        h16x8 o;
#pragma unroll
                        for (int j = 0; j < 8; ++j) o[j] = (h16)v[j];
                        *(h16x8*)(ik + (size_t)(row >> 5) * 2048 + (cw >> 4) * 512 + ((cw >> 3) & 1) * 256 + (row & 31) * 8) = o;
                    } else if (wc == 2) {
                        if (fq == 0) {
#pragma unroll
                            for (int j = 0; j < 8; ++j) { const float z = v[j] + dt_bias[j]; const float sp = z > 20.f ? z : log1pf(expf(z)); gb[(size_t)row * 16 + j] = -expf(a_log[j]) * sp; }
                        } else if (fq == 1) {
#pragma unroll
                            for (int j = 0; j < 8; ++j) gb[(size_t)row * 16 + 8 + j] = 1.0f / (1.0f + expf(-v[j]));
                        } else {
#pragma unroll
                            for (int j = 0; j < 8; ++j) iw[(size_t)row * 16 + 8 * (fq - 2) + j] = v[j] * 0.03125f;
                        }
                    }
                }
        }
    }
};

struct PanelOrder {
    int c;
    __device__ __forceinline__ bool next(int i, pg8::Unit& u) const { if (i >= 2) return false; u.pm = 32 * i + 4 * (c & 7) + (c >> 6); u.pn = (c >> 3) & 7; return true; }
    __device__ __forceinline__ void a_ready(const pg8::Unit&) const {}
    __device__ __forceinline__ void done(const pg8::Unit&) const {}
};
struct EpiOutNorm {
    static constexpr bool PERM = false;
    const float* x; float* out; float* rowss; unsigned* cnt; const float* fg;
    __device__ __forceinline__ void operator()(f32x4 (&acc)[2][2][4][2], const pg8::Unit& u, int wr, int wc, int fr, int fq) const {
        const int rowb = u.pm * 256 + wr * 64 + fr, col0 = u.pn * 256 + wc * 32 + 4 * fq;
#pragma unroll
        for (int ai = 0; ai < 2; ++ai)
#pragma unroll
            for (int m = 0; m < 4; ++m) {
                const int row = rowb + ai * 128 + m * 16; float ss = 0.f;
#pragma unroll
                for (int bj = 0; bj < 2; ++bj)
#pragma unroll
                    for (int n = 0; n < 2; ++n) {
                        const f32x4 y = *(const f32x4*)(x + (size_t)row * DM + col0 + bj * 128 + n * 16) + acc[ai][bj][m][n];
                        acc[ai][bj][m][n] = y; ss += (y[0] * y[0] + y[1] * y[1]) + (y[2] * y[2] + y[3] * y[3]);
                    }
                ss += __shfl_xor(ss, 16); ss += __shfl_xor(ss, 32);
                if (fq == 0) atomicAdd(rowss + row, ss);
            }
        asm volatile("s_waitcnt vmcnt(0)" ::: "memory");
        unsigned* cw = cnt + (u.pm * 2 + wr) * 16;
        if ((threadIdx.x & 63) == 0) __hip_atomic_fetch_add(cw, 1u, __ATOMIC_RELAXED, __HIP_MEMORY_SCOPE_AGENT);
        { unsigned spins = 0;
          while ((unsigned)__builtin_amdgcn_readfirstlane((int)__hip_atomic_load(cw, __ATOMIC_RELAXED, __HIP_MEMORY_SCOPE_AGENT)) < 32u) { __builtin_amdgcn_s_sleep(2); if (++spins > (1u << 22)) break; } }
        f32x4 gv[2][2];
#pragma unroll
        for (int bj = 0; bj < 2; ++bj)
#pragma unroll
            for (int n = 0; n < 2; ++n) gv[bj][n] = *(const f32x4*)(fg + col0 + bj * 128 + n * 16);
#pragma unroll
        for (int ai = 0; ai < 2; ++ai)
#pragma unroll
            for (int m = 0; m < 4; ++m) {
                const int row = rowb + ai * 128 + m * 16;
                const float ssr = __hip_atomic_load(rowss + row, __ATOMIC_RELAXED, __HIP_MEMORY_SCOPE_AGENT);
                const float r = __builtin_amdgcn_rsqf(ssr * (1.0f / DM) + EPS);
#pragma unroll
                for (int bj = 0; bj < 2; ++bj)
#pragma unroll
                    for (int n = 0; n < 2; ++n) *(f32x4*)(out + (size_t)row * DM + col0 + bj * 128 + n * 16) = acc[ai][bj][m][n] * r * gv[bj][n];
            }
    }
};

struct EpiOut {
    static constexpr bool PERM = false;
    const float* x; float* out; float* rowss;
    __device__ __forceinline__ void operator()(const f32x4 (&acc)[2][2][4][2], const pg8::Unit& u, int wr, int wc, int fr, int fq) const {
        const int rowb = u.pm * 256 + wr * 64 + fr, col0 = u.pn * 256 + wc * 32 + 4 * fq;
#pragma unroll
        for (int ai = 0; ai < 2; ++ai)
#pragma unroll
            for (int m = 0; m < 4; ++m) {
                const int row = rowb + ai * 128 + m * 16; float ss = 0.f;
#pragma unroll
                for (int bj = 0; bj < 2; ++bj)
#pragma unroll
                    for (int n = 0; n < 2; ++n) {
                        const size_t off = (size_t)row * DM + col0 + bj * 128 + n * 16;
                        const f32x4 y = *(const f32x4*)(x + off) + acc[ai][bj][m][n];
                        *(f32x4*)(out + off) = y; ss += (y[0] * y[0] + y[1] * y[1]) + (y[2] * y[2] + y[3] * y[3]);
                    }
                ss += __shfl_xor(ss, 16); ss += __shfl_xor(ss, 32);
                if (fq == 0) atomicAdd(rowss + row, ss);
            }
    }
};

__device__ __forceinline__ int src_col(int np) {
    if (np < 4096) return np;
    if (np < 7680) return np + 16;
    if (np < 7744) return 7696 + (np - 7680);
    if (np < 7752) return 4096 + (np - 7744);
    if (np < 7760) return 4104 + (np - 7752);
    if (np < 7776) return np;
    return -1;
}
__device__ __forceinline__ void phase0(const Params& p, unsigned char* smem) {
    const int tid = opaque_tid(), wid = tid >> 6, lane = tid & 63;
    const int gw = blockIdx.x * 8 + wid, nw = gridDim.x * 8;
    h16* H = (h16*)(p.ws + OFF_H); unsigned char* H8 = p.ws + OFF_H8;
    for (int row = 2 * gw; row < BT; row += 2 * nw) {
        const f32x4* xr0 = (const f32x4*)(p.x + (size_t)row * DM); const f32x4* xr1 = xr0 + DM / 4;
        f32x4 v0[8], v1[8]; float s0 = 0.f, s1 = 0.f;
#pragma unroll
        for (int i = 0; i < 8; ++i) { v0[i] = xr0[lane + 64 * i]; v1[i] = xr1[lane + 64 * i]; }
#pragma unroll
        for (int i = 0; i < 8; ++i) { s0 += (v0[i][0] * v0[i][0] + v0[i][1] * v0[i][1]) + (v0[i][2] * v0[i][2] + v0[i][3] * v0[i][3]); s1 += (v1[i][0] * v1[i][0] + v1[i][1] * v1[i][1]) + (v1[i][2] * v1[i][2] + v1[i][3] * v1[i][3]); }
        s0 = wave_sum(s0); s1 = wave_sum(s1);
        const float r0 = __builtin_amdgcn_rsqf(s0 * (1.0f / DM) + EPS), r1 = __builtin_amdgcn_rsqf(s1 * (1.0f / DM) + EPS);
#pragma unroll
        for (int i = 0; i < 8; ++i) { const f32x4 g = ((const f32x4*)p.attn_g)[lane + 64 * i]; h16x4 o0, o1;
#pragma unroll
            for (int j = 0; j < 4; ++j) { o0[j] = (h16)(v0[i][j] * r0 * g[j]); o1[j] = (h16)(v1[i][j] * r1 * g[j]); }
            *(h16x4*)(H + (size_t)row * DM + 4 * (lane + 64 * i)) = o0; *(h16x4*)(H + (size_t)(row + 1) * DM + 4 * (lane + 64 * i)) = o1;
            int e0 = 0, e1 = 0;
            e0 = __builtin_amdgcn_cvt_pk_fp8_f32(v0[i][0] * r0 * g[0], v0[i][1] * r0 * g[1], e0, false); e0 = __builtin_amdgcn_cvt_pk_fp8_f32(v0[i][2] * r0 * g[2], v0[i][3] * r0 * g[3], e0, true);
            e1 = __builtin_amdgcn_cvt_pk_fp8_f32(v1[i][0] * r1 * g[0], v1[i][1] * r1 * g[1], e1, false); e1 = __builtin_amdgcn_cvt_pk_fp8_f32(v1[i][2] * r1 * g[2], v1[i][3] * r1 * g[3], e1, true);
            *(int*)(H8 + (size_t)row * DM + 4 * (lane + 64 * i)) = e0; *(int*)(H8 + (size_t)(row + 1) * DM + 4 * (lane + 64 * i)) = e1; }
    }
    {
        float* tiles = (float*)smem;
        h16* Wt = (h16*)(p.ws + OFF_WT); h16* WoT = (h16*)(p.ws + OFF_WOT);
        constexpr int NT1 = 124 * 32, NTT = NT1 + 32 * 32;
        const int nl_r = tid & 63, kl_r = tid >> 6, nl_w = tid >> 3, kc_w = tid & 7;
        float va[8], vb[8];
#define P0_LOAD(tI, v) do { if ((tI) < NT1) { const int n0_ = ((tI) / 32) * 64, k0_ = ((tI) % 32) * 64; const int src_ = src_col(n0_ + nl_r); \
            _Pragma("unroll") for (int i = 0; i < 8; ++i) v[i] = src_ >= 0 ? p.w_in[(size_t)(k0_ + kl_r + 8 * i) * IN_COLS + src_] : 0.f; } \
          else { const int t2_ = (tI) - NT1; const int n0_ = (t2_ / 32) * 64, k0_ = (t2_ % 32) * 64; \
            _Pragma("unroll") for (int i = 0; i < 8; ++i) v[i] = p.w_out[(size_t)(k0_ + kl_r + 8 * i) * DM + n0_ + nl_r]; } } while (0)
#define P0_PUT(buf, v) do { float* t_ = tiles + (buf) * (64 * 65); _Pragma("unroll") for (int i = 0; i < 8; ++i) t_[(kl_r + 8 * i) * 65 + nl_r] = v[i]; } while (0)
#define P0_STORE(buf, tI) do { const float* t_ = tiles + (buf) * (64 * 65); h16x8 o_; _Pragma("unroll") for (int j = 0; j < 8; ++j) o_[j] = (h16)t_[(8 * kc_w + j) * 65 + nl_w]; \
          if ((tI) < NT1) { const int n0_ = ((tI) / 32) * 64, k0_ = ((tI) % 32) * 64; \
              if (n0_ >= 4096 && n0_ < 6656) { int e0_ = 0, e1_ = 0; e0_ = __builtin_amdgcn_cvt_pk_fp8_f32(64.f * (float)o_[0], 64.f * (float)o_[1], e0_, false); e0_ = __builtin_amdgcn_cvt_pk_fp8_f32(64.f * (float)o_[2], 64.f * (float)o_[3], e0_, true); \
                  e1_ = __builtin_amdgcn_cvt_pk_fp8_f32(64.f * (float)o_[4], 64.f * (float)o_[5], e1_, false); e1_ = __builtin_amdgcn_cvt_pk_fp8_f32(64.f * (float)o_[6], 64.f * (float)o_[7], e1_, true); \
                  typedef int i32x2w __attribute__((ext_vector_type(2))); *(i32x2w*)(p.ws + OFF_WT8 + (size_t)(n0_ - 4096 + nl_w) * 2048 + k0_ + 8 * kc_w) = (i32x2w){e0_, e1_}; } \
              else *(h16x8*)(Wt + (size_t)(n0_ + nl_w) * 2048 + k0_ + 8 * kc_w) = o_; } \
          else { const int t2_ = (tI) - NT1; const int n0_ = (t2_ / 32) * 64, k0_ = (t2_ % 32) * 64; *(h16x8*)(WoT + (size_t)(n0_ + nl_w) * 2048 + k0_ + 8 * kc_w) = o_; } } while (0)
        int tI = blockIdx.x; int buf = 0;
        __syncthreads();
        if (tI < NTT) { P0_LOAD(tI, va); P0_PUT(0, va); }
        while (tI < NTT) {
            const int tn = tI + gridDim.x;
            if (tn < NTT) P0_LOAD(tn, vb);
            __syncthreads();
            P0_STORE(buf, tI);
            if (tn < NTT) P0_PUT(buf ^ 1, vb);
            buf ^= 1; tI = tn;
        }
#undef P0_LOAD
#undef P0_PUT
#undef P0_STORE
    }
    float* cosT = (float*)(p.ws + OFF_COS); float* sinT = (float*)(p.ws + OFF_SIN);
    for (int i = blockIdx.x * 512 + tid; i < BT * 24; i += gridDim.x * 512) {
        const int row = i / 24, j = i % 24;
        const float ex = (j < 16) ? (float)j * (2.0f / 32.0f) : (float)(j - 16) * (2.0f / 16.0f);
        const float inv = powf(500000.0f, -ex);
        const float ang = (float)p.pos[row] * inv;
        cosT[i] = cosf(ang); sinT[i] = sinf(ang);
    }
}

__device__ __forceinline__ h16x8 pack8(const f32x4 a, const f32x4 c) { h16x8 o; o[0] = (h16)a[0]; o[1] = (h16)a[1]; o[2] = (h16)a[2]; o[3] = (h16)a[3]; o[4] = (h16)c[0]; o[5] = (h16)c[1]; o[6] = (h16)c[2]; o[7] = (h16)c[3]; return o; }
typedef short v4s_t __attribute__((__vector_size__(4 * sizeof(short))));
__device__ __forceinline__ h16x4 lds_tr16(const LAS unsigned char* a) { const v4s_t v = __builtin_amdgcn_ds_read_tr16_b64_v4i16((LAS v4s_t*)a); return __builtin_bit_cast(h16x4, v); }
constexpr int REC_BYTES = 74752, REC_WF = 0, REC_QF = 16384, REC_AF = 32768, REC_KTF = 40960, REC_VEC = 57344, REC_UF = 58368, REC_DMA = 58368;
constexpr int HB_BYTES = 69632;

__device__ __forceinline__ void gdn_prep_pair(const Params& p, unsigned char* smem, int pair) {
    const int tid = opaque_tid(), wid = __builtin_amdgcn_readfirstlane(tid >> 6), lane = tid & 63, hb = wid >> 2, w4 = wid & 3, tl = tid & 255;
    const int tk = 2 * pair + hb; const int b = tk >> 9, h = (tk >> 6) & 7, n = tk & 63; const int t0 = n * 64;
    unsigned char* base = smem + hb * HB_BYTES;
    h16* Kn = (h16*)base; h16* Qn = Kn + 64 * 136; h16* Vh = Qn + 64 * 136; float* L = (float*)(Vh + 64 * 136); float* vec = L + 4096;
    unsigned char* rec = p.ws + OFF_REC + (size_t)tk * REC_BYTES;
    const h16* qkvr = (const h16*)(p.ws + OFF_QKVR);
    __syncthreads();
    {
        const int cg = tl & 15, rg = tl >> 4;
        h16x8 raw[3][7];
#pragma unroll
        for (int ti = 0; ti < 3; ++ti)
#pragma unroll
            for (int r = 0; r < 7; ++r) {
                const int trow = t0 + 4 * rg - 3 + r;
                if (trow >= 0) raw[ti][r] = *(const h16x8*)(qkvr + ((size_t)b * NT + trow) * 3072 + ti * 1024 + h * 128 + 8 * cg);
                else { for (int j = 0; j < 8; ++j) raw[ti][r][j] = (h16)0.f; }
            }
#pragma unroll
        for (int ti = 0; ti < 3; ++ti) {
            const int chan = ti * 1024 + h * 128 + 8 * cg;
            float xr[7][8];
#pragma unroll
            for (int r = 0; r < 7; ++r)
#pragma unroll
                for (int j = 0; j < 8; ++j) xr[r][j] = (float)raw[ti][r][j];
            float wv[4][8];
#pragma unroll
            for (int tp = 0; tp < 4; ++tp) { const f32x4 a = *(const f32x4*)(p.conv_w + (size_t)tp * 3072 + chan), c = *(const f32x4*)(p.conv_w + (size_t)tp * 3072 + chan + 4);
#pragma unroll
                for (int j = 0; j < 4; ++j) { wv[tp][j] = a[j]; wv[tp][4 + j] = c[j]; } }
            h16* dst = (ti == 0) ? Qn : (ti == 1 ? Kn : Vh);
#pragma unroll
            for (int r = 0; r < 4; ++r) {
                float y[8]; float ss = 0.f;
#pragma unroll
                for (int j = 0; j < 8; ++j) { float a = wv[0][j] * xr[r][j] + wv[1][j] * xr[r + 1][j] + wv[2][j] * xr[r + 2][j] + wv[3][j] * xr[r + 3][j]; a = silu_f(a); y[j] = a; ss += a * a; }
                float sc = 1.f;
                if (ti < 2) { ss += __shfl_xor(ss, 1); ss += __shfl_xor(ss, 2); ss += __shfl_xor(ss, 4); ss += __shfl_xor(ss, 8); sc = (ti == 0 ? 0.08838834764831845f : 1.0f) * __builtin_amdgcn_rsqf(ss + EPS); }
                h16x8 o;
#pragma unroll
                for (int j = 0; j < 8; ++j) o[j] = (h16)(y[j] * sc);
                *(h16x8*)(dst + (4 * rg + r) * 136 + 8 * cg) = o;
            }
        }
    }
    if (tl < 64) {
        const float* gb = (const float*)(p.ws + OFF_GB) + ((size_t)b * NT + t0 + tl) * 16;
        const float g = gb[h], be = gb[8 + h];
        float gc = g;
#pragma unroll
        for (int o = 1; o < 64; o <<= 1) { const float tt = __shfl_up(gc, o); if (lane >= o) gc += tt; }
        const float gl = __shfl(gc, 63);
        vec[tl] = g; vec[64 + tl] = be; vec[128 + tl] = gc; vec[192 + tl] = __expf(gc);
        float* rv = (float*)(rec + REC_VEC);
        rv[tl] = __expf(gc); rv[64 + tl] = __expf(gl - gc); if (tl == 0) rv[128] = __expf(gl);
    }
    __syncthreads();
    {
        const int rt = w4, fr = lane & 15, kg = lane >> 4;
        h16x8 Ak[4], Aq[4];
#pragma unroll
        for (int s = 0; s < 4; ++s) { Ak[s] = *(const h16x8*)(Kn + (16 * rt + fr) * 136 + 32 * s + 8 * kg); Aq[s] = *(const h16x8*)(Qn + (16 * rt + fr) * 136 + 32 * s + 8 * kg); }
        h16* AF = (h16*)(rec + REC_AF);
#pragma unroll
        for (int ct = 0; ct < 4; ++ct) {
            f32x4 kk = (f32x4){0.f, 0.f, 0.f, 0.f}, qk = (f32x4){0.f, 0.f, 0.f, 0.f};
#pragma unroll
            for (int s = 0; s < 4; ++s) { const h16x8 Bk = *(const h16x8*)(Kn + (16 * ct + fr) * 136 + 32 * s + 8 * kg);
                kk = __builtin_amdgcn_mfma_f32_16x16x32_f16(Ak[s], Bk, kk, 0, 0, 0); qk = __builtin_amdgcn_mfma_f32_16x16x32_f16(Aq[s], Bk, qk, 0, 0, 0); }
            const int j = 16 * ct + fr; const float gcj = vec[128 + j];
#pragma unroll
            for (int rgi = 0; rgi < 4; ++rgi) {
                const int i = 16 * rt + 4 * kg + rgi;
                const float dec = (i >= j) ? __expf(vec[128 + i] - gcj) : 0.f;
                L[i * 64 + j] = (i > j) ? vec[64 + i] * kk[rgi] * dec : 0.f;
                const int sp = ct >> 1, kgp = fr >> 2, j8 = (ct & 1) * 4 + (fr & 3), lanep = 16 * kgp + 4 * kg + rgi;
                AF[((rt * 2 + sp) * 64 + lanep) * 8 + j8] = (h16)(qk[rgi] * dec);
            }
        }
    }
    __syncthreads();
    h16* Tw = (h16*)L; h16* Tu = Tw + 4096;
    if (w4 == 0) {
        float X[64];
#pragma unroll
        for (int i = 0; i < 64; ++i) X[i] = 0.f;
        f32x4 Ln[16]; float rn = (lane == 0) ? 1.f : 0.f;
#pragma unroll
        for (int i = 0; i < 64; ++i) {
            f32x4 Lc[16]; const float rc = rn;
#pragma unroll
            for (int jj = 0; jj < (i + 3) / 4; ++jj) Lc[jj] = Ln[jj];
            if (i + 1 < 64) {
#pragma unroll
                for (int jj = 0; jj < (i + 4) / 4; ++jj) Ln[jj] = *(const f32x4*)(L + (i + 1) * 64 + 4 * jj);
                rn = (lane == i + 1) ? 1.f : 0.f;
            }
            float a0 = rc, a1 = 0.f, a2 = 0.f, a3 = 0.f;
#pragma unroll
            for (int jj = 0; jj < (i + 3) / 4; ++jj) { a0 -= Lc[jj][0] * X[4 * jj]; a1 -= Lc[jj][1] * X[4 * jj + 1]; a2 -= Lc[jj][2] * X[4 * jj + 2]; a3 -= Lc[jj][3] * X[4 * jj + 3]; }
            float acc = (a0 + a1) + (a2 + a3);
            asm volatile("" : "+v"(acc) :: "memory");
            X[i] = acc;
        }
        const float bu = vec[64 + lane], bw = bu * vec[192 + lane];
#pragma unroll
        for (int i = 0; i < 64; ++i) { const int pos = i * 64 + ((((lane >> 3) ^ (i & 7)) << 3) | (lane & 7)); Tw[pos] = (h16)(X[i] * bw); Tu[pos] = (h16)(X[i] * bu); }
    } else {
        const int t3 = tl - 64;
        h16* QF = (h16*)(rec + REC_QF);
        for (int f = t3; f < 1024; f += 192) { const int lanep = f & 63, s = (f >> 6) & 3, rt = f >> 8; const int row = 16 * rt + (lanep & 15), kgp = lanep >> 4;
            const h16x4 a = *(const h16x4*)(Qn + row * 136 + 32 * s + 4 * kgp), c = *(const h16x4*)(Qn + row * 136 + 32 * s + 16 + 4 * kgp);
            h16x8 o; o[0] = a[0]; o[1] = a[1]; o[2] = a[2]; o[3] = a[3]; o[4] = c[0]; o[5] = c[1]; o[6] = c[2]; o[7] = c[3];
            *(h16x8*)(QF + (size_t)f * 8) = o; }
        h16* KTF = (h16*)(rec + REC_KTF);
        for (int f = t3; f < 1024; f += 192) { const int lanep = f & 63, sp = (f >> 6) & 1, rt = f >> 7; const int d = 16 * rt + (lanep & 15), kgp = lanep >> 4;
            h16x8 o;
#pragma unroll
            for (int j8 = 0; j8 < 8; ++j8) { const int c = 32 * sp + (j8 < 4 ? 4 * kgp + j8 : 16 + 4 * kgp + (j8 - 4)); o[j8] = Kn[c * 136 + d]; }
            *(h16x8*)(KTF + (size_t)f * 8) = o; }
    }
    __syncthreads();
    {
        const int rt = w4, fr = lane & 15, kg = lane >> 4, q4 = fr >> 2, pp = fr & 3;
        const LAS unsigned char* Knl = (const LAS unsigned char*)Kn; const LAS unsigned char* Vl = (const LAS unsigned char*)Vh;
        const int trow = 16 * rt + fr;
        h16x8 Tuf[2], Twf[2];
#pragma unroll
        for (int s = 0; s < 2; ++s) { const int off = trow * 64 + ((((4 * s + kg) ^ (trow & 7))) << 3); Tuf[s] = *(const h16x8*)(Tu + off); Twf[s] = *(const h16x8*)(Tw + off); }
        h16* UF = (h16*)(rec + REC_UF);
#pragma unroll
        for (int dvb = 0; dvb < 8; ++dvb) {
            f32x4 acc = (f32x4){0.f, 0.f, 0.f, 0.f};
#pragma unroll
            for (int s = 0; s < 2; ++s) { const LAS unsigned char* a0 = Vl + ((32 * s + 8 * kg + q4) * 136 + 16 * dvb + 4 * pp) * 2;
                const h16x4 lo = lds_tr16(a0), hi4 = lds_tr16(a0 + 4 * 136 * 2);
                h16x8 Bv; Bv[0] = lo[0]; Bv[1] = lo[1]; Bv[2] = lo[2]; Bv[3] = lo[3]; Bv[4] = hi4[0]; Bv[5] = hi4[1]; Bv[6] = hi4[2]; Bv[7] = hi4[3];
                acc = __builtin_amdgcn_mfma_f32_16x16x32_f16(Tuf[s], Bv, acc, 0, 0, 0); }
            h16x4 o; o[0] = (h16)acc[0]; o[1] = (h16)acc[1]; o[2] = (h16)acc[2]; o[3] = (h16)acc[3];
            *(h16x4*)(UF + (size_t)((dvb * 4 + rt) * 64 + lane) * 4) = o;
        }
        h16* WF = (h16*)(rec + REC_WF);
#pragma unroll
        for (int so = 0; so < 4; ++so) {
            f32x4 c0 = (f32x4){0.f, 0.f, 0.f, 0.f}, c1 = (f32x4){0.f, 0.f, 0.f, 0.f};
#pragma unroll
            for (int s = 0; s < 2; ++s) {
                const LAS unsigned char* a0 = Knl + ((32 * s + 8 * kg + q4) * 136 + 16 * (2 * so) + 4 * pp) * 2;
                const h16x4 l0 = lds_tr16(a0), h0 = lds_tr16(a0 + 4 * 136 * 2), l1 = lds_tr16(a0 + 32), h1 = lds_tr16(a0 + 32 + 4 * 136 * 2);
                h16x8 A0, A1; A0[0] = l0[0]; A0[1] = l0[1]; A0[2] = l0[2]; A0[3] = l0[3]; A0[4] = h0[0]; A0[5] = h0[1]; A0[6] = h0[2]; A0[7] = h0[3];
                A1[0] = l1[0]; A1[1] = l1[1]; A1[2] = l1[2]; A1[3] = l1[3]; A1[4] = h1[0]; A1[5] = h1[1]; A1[6] = h1[2]; A1[7] = h1[3];
                c0 = __builtin_amdgcn_mfma_f32_16x16x32_f16(A0, Twf[s], c0, 0, 0, 0); c1 = __builtin_amdgcn_mfma_f32_16x16x32_f16(A1, Twf[s], c1, 0, 0, 0);
            }
            *(h16x8*)(WF + (size_t)((rt * 4 + so) * 64 + lane) * 8) = pack8(-c0, -c1);
        }
    }
}

__device__ __forceinline__ void gdn_scan_task(const Params& p, unsigned char* smem, int bh) {
    const int tid = opaque_tid(), wid = __builtin_amdgcn_readfirstlane(tid >> 6), lane = tid & 63, kg = lane >> 4, fr = lane & 15;
    const int b = bh >> 3, h = bh & 7;
    LAS unsigned char* lds = (LAS unsigned char*)smem;
    const unsigned char* rec0 = p.ws + OFF_REC + (size_t)(bh * 64) * REC_BYTES;
    h16* OB = (h16*)(smem + 2 * REC_DMA);
    const h16* gz = (const h16*)(p.ws + OFF_GZ); h16* omix = (h16*)(p.ws + OFF_OMIX);
    f32x4 Sacc[8];
#pragma unroll
    for (int t = 0; t < 8; ++t) Sacc[t] = (f32x4){0.f, 0.f, 0.f, 0.f};
    h16x4 Uc[4], Un[4];
    __syncthreads();
#define GDN_GLDS(recp, bufi) do { _Pragma("unroll") for (int _i = 0; _i < 7; ++_i) \
        __builtin_amdgcn_global_load_lds((const unsigned*)((recp) + (size_t)(_i * 512 + tid) * 16), (LAS unsigned*)(lds + (bufi) * REC_DMA + (_i * 512 + wid * 64) * 16), 16, 0, 0); \
        if (wid == 0) __builtin_amdgcn_global_load_lds((const unsigned*)((recp) + (size_t)(7 * 512 + tid) * 16), (LAS unsigned*)(lds + (bufi) * REC_DMA + (7 * 512) * 16), 16, 0, 0); } while (0)
#define GDN_LDREG(recp, U_) do { _Pragma("unroll") for (int rt = 0; rt < 4; ++rt) U_[rt] = *(const h16x4*)((recp) + REC_UF + (size_t)((wid * 4 + rt) * 64 + lane) * 8); } while (0)
#define GDN_LDGZ(dst, chunk) do { const h16* gp_ = gz + ((size_t)b * NT + 64 * (chunk) + prow) * 1024 + h * 128 + 16 * pseg; dst[0] = *(const h16x8*)gp_; dst[1] = *(const h16x8*)(gp_ + 8); } while (0)
#define GDN_POST(chunk, gzv) do { const h16* Ob = OB + ((chunk) & 1) * 8192 + prow * 128 + 16 * pseg; const h16x8 a0 = *(const h16x8*)Ob, a1 = *(const h16x8*)(Ob + 8); \
        float ngv[16]; _Pragma("unroll") for (int j = 0; j < 4; ++j) { const f32x4 t4 = *(const f32x4*)(ngl + 16 * pseg + 4 * j); ngv[4 * j] = t4[0]; ngv[4 * j + 1] = t4[1]; ngv[4 * j + 2] = t4[2]; ngv[4 * j + 3] = t4[3]; } \
        float ss = 0.f; _Pragma("unroll") for (int j = 0; j < 8; ++j) { const float u0 = (float)a0[j], u1 = (float)a1[j]; ss += u0 * u0 + u1 * u1; } \
        ss += __shfl_xor(ss, 1); ss += __shfl_xor(ss, 2); ss += __shfl_xor(ss, 4); const float r = __builtin_amdgcn_rsqf(ss * (1.0f / 128.0f) + EPS); \
        h16x8 o0, o1; _Pragma("unroll") for (int j = 0; j < 8; ++j) { o0[j] = (h16)((float)a0[j] * r * ngv[j] * (float)gzv[0][j]); o1[j] = (h16)((float)a1[j] * r * ngv[8 + j] * (float)gzv[1][j]); } \
        h16* op_ = omix + ((size_t)b * NT + 64 * (chunk) + prow) * 2048 + h * 128 + 16 * pseg; *(h16x8*)op_ = o0; *(h16x8*)(op_ + 8) = o1; } while (0)
#define GDN_RD8(X, off0) do { _Pragma("unroll") for (int _j = 0; _j < 8; ++_j) X[_j] = *(const LAS h16x8*)(bufp + (off0) + (_j * 64 + lane) * 16); } while (0)
#define GDN_SB __builtin_amdgcn_sched_barrier(0)
    h16x8 gzp[2], gzn[2];
    const int prow = tid >> 3, pseg = tid & 7;
    float* ngl = (float*)(smem + 2 * REC_DMA + 32768);
    if (tid < 128) ngl[tid] = p.gdn_norm_g[tid];
    GDN_GLDS(rec0, 0);
    GDN_LDREG(rec0, Uc);
    asm volatile("s_waitcnt vmcnt(0)" ::: "memory");
    __syncthreads();
    for (int n = 0; n < 64; ++n) {
        const unsigned char* recn = rec0 + (size_t)(n + 1) * REC_BYTES;
        if (n + 1 < 64) { GDN_GLDS(recn, (n + 1) & 1); GDN_LDREG(recn, Un); }
        GDN_LDGZ(gzn, n);
        if (n > 0) GDN_POST(n - 1, gzp);
        const LAS unsigned char* bufp = lds + (n & 1) * REC_DMA;
        h16x8 X[8], Y[8];
        GDN_RD8(X, REC_WF);
        h16x8 SB[4];
#pragma unroll
        for (int s = 0; s < 4; ++s) SB[s] = pack8(Sacc[2 * s], Sacc[2 * s + 1]);
        f32x4 vacc[4], oacc[4];
#pragma unroll
        for (int rt = 0; rt < 4; ++rt) { vacc[rt] = (f32x4){(float)Uc[rt][0], (float)Uc[rt][1], (float)Uc[rt][2], (float)Uc[rt][3]}; oacc[rt] = (f32x4){0.f, 0.f, 0.f, 0.f}; }
        GDN_SB;
        GDN_RD8(Y, REC_WF + 8192);
#pragma unroll
        for (int j = 0; j < 8; ++j) vacc[j >> 2] = __builtin_amdgcn_mfma_f32_16x16x32_f16(X[j], SB[j & 3], vacc[j >> 2], 0, 0, 0);
        GDN_SB;
        GDN_RD8(X, REC_QF);
#pragma unroll
        for (int j = 0; j < 8; ++j) vacc[2 + (j >> 2)] = __builtin_amdgcn_mfma_f32_16x16x32_f16(Y[j], SB[j & 3], vacc[2 + (j >> 2)], 0, 0, 0);
        GDN_SB;
        GDN_RD8(Y, REC_QF + 8192);
        f32x4 ekv[4], egv[4];
#pragma unroll
        for (int rt = 0; rt < 4; ++rt) { ekv[rt] = *(const LAS f32x4*)(bufp + REC_VEC + 256 + (16 * rt + 4 * kg) * 4); egv[rt] = *(const LAS f32x4*)(bufp + REC_VEC + (16 * rt + 4 * kg) * 4); }
        const float eglc = *(const LAS float*)(bufp + REC_VEC + 512);
#pragma unroll
        for (int j = 0; j < 8; ++j) oacc[j >> 2] = __builtin_amdgcn_mfma_f32_16x16x32_f16(X[j], SB[j & 3], oacc[j >> 2], 0, 0, 0);
        GDN_SB;
        GDN_RD8(X, REC_KTF);
        h16x8 VB[2], VKB[2];
#pragma unroll
        for (int sp = 0; sp < 2; ++sp) { VB[sp] = pack8(vacc[2 * sp], vacc[2 * sp + 1]); VKB[sp] = pack8(vacc[2 * sp] * ekv[2 * sp], vacc[2 * sp + 1] * ekv[2 * sp + 1]); }
#pragma unroll
        for (int j = 0; j < 8; ++j) oacc[2 + (j >> 2)] = __builtin_amdgcn_mfma_f32_16x16x32_f16(Y[j], SB[j & 3], oacc[2 + (j >> 2)], 0, 0, 0);
        GDN_SB;
        GDN_RD8(Y, REC_KTF + 8192);
#pragma unroll
        for (int t = 0; t < 8; ++t) Sacc[t] = Sacc[t] * eglc;
#pragma unroll
        for (int j = 0; j < 8; ++j) Sacc[j >> 1] = __builtin_amdgcn_mfma_f32_16x16x32_f16(X[j], VKB[j & 1], Sacc[j >> 1], 0, 0, 0);
        GDN_SB;
        GDN_RD8(X, REC_AF);
#pragma unroll
        for (int rt = 0; rt < 4; ++rt) oacc[rt] = oacc[rt] * egv[rt];
#pragma unroll
        for (int j = 0; j < 8; ++j) Sacc[4 + (j >> 1)] = __builtin_amdgcn_mfma_f32_16x16x32_f16(Y[j], VKB[j & 1], Sacc[4 + (j >> 1)], 0, 0, 0);
        GDN_SB;
#pragma unroll
        for (int j = 0; j < 8; ++j) oacc[j >> 1] = __builtin_amdgcn_mfma_f32_16x16x32_f16(X[j], VB[j & 1], oacc[j >> 1], 0, 0, 0);
        { h16* Ob = OB + (n & 1) * 8192;
#pragma unroll
          for (int rt = 0; rt < 4; ++rt)
#pragma unroll
              for (int rgi = 0; rgi < 4; ++rgi) Ob[(16 * rt + 4 * kg + rgi) * 128 + 16 * wid + fr] = (h16)oacc[rt][rgi]; }
        asm volatile("s_waitcnt vmcnt(0)" ::: "memory");
        __syncthreads();
#pragma unroll
        for (int rt = 0; rt < 4; ++rt) Uc[rt] = Un[rt];
        gzp[0] = gzn[0]; gzp[1] = gzn[1];
    }
    GDN_POST(63, gzp);
#undef GDN_LDGZ
#undef GDN_POST
#undef GDN_RD8
#undef GDN_SB
#undef GDN_GLDS
#undef GDN_LDREG
}

__device__ __forceinline__ unsigned f2key(float x) { const unsigned u = __float_as_uint(x); return (u & 0x80000000u) ? ~u : (u | 0x80000000u); }
typedef float f32x16 __attribute__((ext_vector_type(16)));
__device__ __forceinline__ float wave_min(float v) {
#pragma unroll
    for (int o = 1; o < 64; o <<= 1) v = fminf(v, __shfl_xor(v, o));
    return v;
}
__device__ __forceinline__ unsigned lane_below(unsigned long long m) { return __builtin_amdgcn_mbcnt_hi((unsigned)(m >> 32), __builtin_amdgcn_mbcnt_lo((unsigned)m, 0u)); }
__device__ __forceinline__ void idx8_task(const Params& p, unsigned char* smem, int b, int qb) {
    const int tid = opaque_tid(), wid = __builtin_amdgcn_readfirstlane(tid >> 6), lane = tid & 63;
    const int t0 = qb * 8;
    unsigned short* selg = (unsigned short*)(p.ws + OFF_SEL) + ((size_t)b * NT + t0) * 256;
    if (t0 + 8 <= 256) {
        for (int i = tid; i < 8 * 256; i += 512) { const int q = i >> 8, k = i & 255; selg[i] = (unsigned short)(k <= t0 + q ? k : 0); }
        return;
    }
    float* sc = (float*)smem;
    ACC_T0();
    unsigned* hist = (unsigned*)(smem + 131072 + wid * 2560);
    unsigned* cand = hist + 256;
    __syncthreads();
    {
        const int n8 = t0 + 8;
        const int ntile = (n8 + 31) >> 5, ntile_pad = ((n8 + 255) >> 8) << 3;
        const h16* iq = (const h16*)(p.ws + OFF_IQ) + ((size_t)b * NT + t0) * 1024;
        const float* iw = (const float*)(p.ws + OFF_IW) + ((size_t)b * NT + t0) * 16;
        const h16* ik = (const h16*)(p.ws + OFF_IK) + (size_t)b * NT * 64;
        const int r = lane & 31, kh = lane >> 5, qq = (r >> 2) & 1, hh = (r & 3) + 4 * (r >> 3);
        h16x8 Af[4][4]; h16x2 Wp[4][8];
#pragma unroll
        for (int a = 0; a < 4; ++a) {
#pragma unroll
            for (int s = 0; s < 4; ++s) Af[a][s] = *(const h16x8*)(iq + (size_t)(2 * a + qq) * 1024 + hh * 64 + 16 * s + 8 * kh);
#pragma unroll
            for (int c = 0; c < 4; ++c) { const f32x4 w4 = *(const f32x4*)(iw + (size_t)(2 * a + kh) * 16 + 4 * c);
                Wp[a][2 * c] = (h16x2){(h16)w4[0], (h16)w4[1]}; Wp[a][2 * c + 1] = (h16x2){(h16)w4[2], (h16)w4[3]}; }
        }
#define IDX_LOADB(Bx, ti) do { const int tc_ = (ti) < ntile ? (ti) : ntile - 1;     \
            _Pragma("unroll") for (int s = 0; s < 4; ++s) Bx[s] = *(const h16x8*)(ik + (size_t)tc_ * 2048 + s * 512 + kh * 256 + r * 8); } while (0)
#define IDX_COMP(Bx, ti) do { if ((ti) < ntile) { const int key = 32 * (ti) + r; f32x16 accs[4]; \
            _Pragma("unroll") for (int a = 0; a < 4; ++a) { _Pragma("unroll") for (int e = 0; e < 16; ++e) accs[a][e] = 0.f; \
                _Pragma("unroll") for (int s = 0; s < 4; ++s) accs[a] = __builtin_amdgcn_mfma_f32_32x32x16_f16(Af[a][s], Bx[s], accs[a], 0, 0, 0); } \
            __builtin_amdgcn_sched_barrier(0); \
            _Pragma("unroll") for (int a = 0; a < 4; ++a) { \
                float s0 = 0.f, s1 = 0.f; _Pragma("unroll") for (int e = 0; e < 8; e += 2) { h16x2 rp = (h16x2){(h16)accs[a][2 * e], (h16)accs[a][2 * e + 1]}; rp = __builtin_elementwise_max(rp, (h16x2){(h16)0.f, (h16)0.f}); s0 = __builtin_amdgcn_fdot2(rp, Wp[a][e], s0, false); \
                    h16x2 rq = (h16x2){(h16)accs[a][2 * e + 2], (h16)accs[a][2 * e + 3]}; rq = __builtin_elementwise_max(rq, (h16x2){(h16)0.f, (h16)0.f}); s1 = __builtin_amdgcn_fdot2(rq, Wp[a][e + 1], s1, false); } \
                const int q = 2 * a + kh; sc[q * 4096 + key] = (key > t0 + q) ? -INFINITY : (s0 + s1); } } } while (0)
        {
            h16x8 B0[4], B1[4], B2[4];
            IDX_LOADB(B0, wid); IDX_LOADB(B1, wid + 8);
            for (int i = wid; i < ntile; i += 24) {
                IDX_LOADB(B2, i + 16); IDX_COMP(B0, i);
                IDX_LOADB(B0, i + 24); IDX_COMP(B1, i + 8);
                IDX_LOADB(B1, i + 32); IDX_COMP(B2, i + 16);
            }
            for (int i = ntile + wid; i < ntile_pad; i += 8) {
#pragma unroll
                for (int a = 0; a < 4; ++a) sc[(2 * a + kh) * 4096 + 32 * i + r] = -INFINITY;
            }
        }
#undef IDX_LOADB
#undef IDX_COMP
    }
    __syncthreads();
    ACC_ADD(1);
    {
        const int tq = t0 + wid, n = tq + 1;
        const float* row = sc + wid * 4096;
        const int ng = (n + 255) >> 8;
        f32x4 x[16];
#pragma unroll
        for (int g = 0; g < 16; ++g) { if (g < ng) x[g] = *(const f32x4*)(row + 256 * g + 4 * lane); else x[g] = (f32x4){-INFINITY, -INFINITY, -INFINITY, -INFINITY}; }
        float hi = -INFINITY, lo = INFINITY;
#pragma unroll
        for (int g = 0; g < 16; ++g)
#pragma unroll
            for (int c = 0; c < 4; ++c) { const float v = x[g][c]; hi = fmaxf(hi, v); lo = fminf(lo, v == -INFINITY ? INFINITY : v); }
        hi = wave_max(hi); lo = wave_min(lo);
        const float scale = (hi > lo) ? 255.99f / (hi - lo) : 0.f; const float off = -lo * scale;
        *(u32x4*)(hist + 4 * lane) = (u32x4){0u, 0u, 0u, 0u};
#pragma unroll
        for (int g = 0; g < 16; ++g) { if (g < ng) {
#pragma unroll
            for (int c = 0; c < 4; ++c) { int bin = (int)fmaf(x[g][c], scale, off); bin = bin < 0 ? 0 : (bin > 255 ? 255 : bin); atomicAdd(&hist[bin], 1u); } } }
        unsigned bstar, need;
        {
            const u32x4 h4 = *(const u32x4*)(hist + 4 * lane); const unsigned s = h4[0] + h4[1] + h4[2] + h4[3];
            unsigned suf = s;
#pragma unroll
            for (int o = 1; o < 64; o <<= 1) { const unsigned tt = __shfl_down(suf, o); if (lane + o < 64) suf += tt; }
            const unsigned above = suf - s;
            const bool mine = (above < 256u && 256u <= suf);
            unsigned cum = above; unsigned bin = 0;
            if (cum + h4[3] >= 256u) bin = 3; else { cum += h4[3]; if (cum + h4[2] >= 256u) bin = 2; else { cum += h4[2]; if (cum + h4[1] >= 256u) bin = 1; else { cum += h4[1]; bin = 0; } } }
            const unsigned long long mm = __ballot(mine);
            const int src = (int)__builtin_ctzll(mm);
            bstar = (unsigned)__shfl((int)(4 * lane + bin), src); need = (unsigned)__shfl((int)(256u - cum), src);
        }
        unsigned short* so = selg + (size_t)wid * 256;
        unsigned short* cidx = (unsigned short*)(cand + 256);
        unsigned m = 0, outb = 0;
#pragma unroll
        for (int g = 0; g < 16; ++g) { if (g < ng) {
#pragma unroll
            for (int c = 0; c < 4; ++c) { int bin = (int)fmaf(x[g][c], scale, off); bin = bin < 0 ? 0 : (bin > 255 ? 255 : bin);
                const bool gt = ((unsigned)bin > bstar), pr = ((unsigned)bin == bstar);
                const unsigned long long mg = __ballot(gt), mk = __ballot(pr);
                if (mg) { const unsigned pos = outb + lane_below(mg); if (gt) so[pos] = (unsigned short)(256 * g + 4 * lane + c); outb += (unsigned)__builtin_popcountll(mg); }
                if (mk) { const unsigned pos = m + lane_below(mk); if (pr && pos < 256u) { cand[pos] = f2key(x[g][c]); cidx[pos] = (unsigned short)(256 * g + 4 * lane + c); } m += (unsigned)__builtin_popcountll(mk); } } } }
        unsigned Kt = 0, rr = need;
        if (m <= 256u) {
            const int nc = (int)((m + 63u) >> 6);
            unsigned cv[4]; unsigned short ci[4];
#pragma unroll
            for (int j = 0; j < 4; ++j) { const bool in = (64 * j + lane < (int)m); cv[j] = in ? cand[64 * j + lane] : 0u; ci[j] = in ? cidx[64 * j + lane] : (unsigned short)0; }
            for (int bit = 31; bit >= 0; --bit) {
                const unsigned test = (Kt | (1u << bit)) >> bit;
                unsigned cnt = (unsigned)__builtin_popcountll(__ballot((cv[0] >> bit) == test));
                if (nc > 1) cnt += (unsigned)__builtin_popcountll(__ballot((cv[1] >> bit) == test));
                if (nc > 2) cnt += (unsigned)__builtin_popcountll(__ballot((cv[2] >> bit) == test));
                if (nc > 3) cnt += (unsigned)__builtin_popcountll(__ballot((cv[3] >> bit) == test));
                if (cnt >= rr) Kt |= (1u << bit); else rr -= cnt;
            }
            unsigned eqb = 0;
#pragma unroll
            for (int j = 0; j < 4; ++j) { if (j < nc) { const bool in = (64 * j + lane < (int)m); const bool gt = in && cv[j] > Kt, eq = in && cv[j] == Kt;
                const unsigned long long me = __ballot(eq); bool take = gt;
                if (me) { const unsigned er = eqb + lane_below(me); take = gt || (eq && er < rr); eqb += (unsigned)__builtin_popcountll(me); }
                const unsigned long long mt = __ballot(take);
                if (mt) { const unsigned pos = outb + lane_below(mt); if (take) so[pos] = ci[j]; outb += (unsigned)__builtin_popcountll(mt); } } }
        } else {
            for (int bit = 31; bit >= 0; --bit) {
                const unsigned test = (Kt | (1u << bit)) >> bit; unsigned cnt = 0;
                for (int idx = lane; idx < ng * 256; idx += 64) { const float v = row[idx]; int bin = (int)fmaf(v, scale, off); bin = bin < 0 ? 0 : (bin > 255 ? 255 : bin);
                    const bool pr = ((unsigned)bin == bstar) && ((f2key(v) >> bit) == test); cnt += (unsigned)__builtin_popcountll(__ballot(pr)); }
                if (cnt >= rr) Kt |= (1u << bit); else rr -= cnt;
            }
            unsigned eqb = 0;
            for (int idx = lane; idx < ng * 256; idx += 64) { const float v = row[idx]; int bin = (int)fmaf(v, scale, off); bin = bin < 0 ? 0 : (bin > 255 ? 255 : bin);
                const unsigned k = f2key(v); const bool inb = ((unsigned)bin == bstar); const bool gt = inb && k > Kt, eq = inb && k == Kt;
                const unsigned long long me = __ballot(eq); bool take = gt;
                if (me) { const unsigned er = eqb + lane_below(me); take = gt || (eq && er < rr); eqb += (unsigned)__builtin_popcountll(me); }
                const unsigned long long mt = __ballot(take);
                if (mt) { const unsigned pos = outb + lane_below(mt); if (take) so[pos] = (unsigned short)idx; outb += (unsigned)__builtin_popcountll(mt); } }
        }
    }
    __syncthreads();
    ACC_ADD(2);
}

typedef unsigned short u16x4 __attribute__((ext_vector_type(4)));
typedef unsigned short u16x8 __attribute__((ext_vector_type(8)));
__device__ __forceinline__ void attn8_task(const Params& p, unsigned char* smem, int part, int o) {
    const int tid = opaque_tid(), wid = __builtin_amdgcn_readfirstlane(tid >> 6), lane = tid & 63, kg = lane >> 4, fr = lane & 15;
    const int b = part >> 1, g = part & 1;
    unsigned char* vl = smem + wid * 17408;
    LAS unsigned char* vll = (LAS unsigned char*)vl;
    const char* akb = (const char*)(p.ws + OFF_AK) + (size_t)b * NT * 256 + g * 128;
    const char* avb = (const char*)(p.ws + OFF_AV) + (size_t)b * NT * 256 + g * 128;
    typedef long i64x2 __attribute__((ext_vector_type(2)));
    constexpr int NQW = 1;
    const int tq0 = 8 * NQW * o + NQW * wid;
    u16x4 kix[4], kixn[4];
#define AT_LOADI(tt, KI) do { const unsigned short* sel_ = (const unsigned short*)(p.ws + OFF_SEL) + ((size_t)b * NT + (tt)) * 256; \
        _Pragma("unroll") for (int c = 0; c < 4; ++c) KI[c] = *(const u16x4*)(sel_ + 64 * c + 4 * fr); } while (0)
    AT_LOADI(tq0, kix);
#pragma unroll 1
    for (int qi = 0; qi < NQW; ++qi) {
    const int t = tq0 + qi; const int bt = b * NT + t; const int nvalid = (t + 1) < 256 ? (t + 1) : 256;
    const unsigned short* sel = (const unsigned short*)(p.ws + OFF_SEL) + (size_t)bt * 256;
    long Qf[4];
    { const char* qp_ = (const char*)(p.ws + OFF_AQ) + (size_t)bt * 1024 + (4 * g + (fr & 3)) * 128 + kg * 32; const i64x2 q0 = *(const i64x2*)qp_, q1 = *(const i64x2*)(qp_ + 16);
      Qf[0] = fr < 4 ? q0[0] : 0l; Qf[1] = fr < 4 ? q0[1] : 0l; Qf[2] = fr < 4 ? q1[0] : 0l; Qf[3] = fr < 4 ? q1[1] : 0l; }
    f32x4 lg[16];
#define AT_LOADK(Kx, c) do { _Pragma("unroll") for (int ii = 0; ii < 4; ++ii) { const char* kp = akb + (unsigned)kix[c][ii] * 256u + 32u * (unsigned)kg; \
        const i64x2 t0 = *(const i64x2*)kp, t1 = *(const i64x2*)(kp + 16); Kx[ii][0] = t0[0]; Kx[ii][1] = t0[1]; Kx[ii][2] = t1[0]; Kx[ii][3] = t1[1]; } } while (0)
#define AT_MMAK(Kx, c) do { _Pragma("unroll") for (int ii = 0; ii < 4; ++ii) { f32x4 a = (f32x4){0.f, 0.f, 0.f, 0.f}; \
        _Pragma("unroll") for (int s = 0; s < 4; ++s) a = __builtin_amdgcn_mfma_f32_16x16x32_fp8_fp8(Kx[ii][s], Qf[s], a, 0, 0, 0); lg[4 * (c) + ii] = a; } } while (0)
#define AT_LOADV(Vx, c) do { const u16x8 i0 = *(const u16x8*)(sel + 64 * (c) + 8 * (lane >> 3)); \
        _Pragma("unroll") for (int it = 0; it < 8; ++it) Vx[it] = *(const u32x4*)(avb + (unsigned)i0[it] * 256u + 16u * (unsigned)(lane & 7)); } while (0)
    u32x4 VA[8], VB[8];
    {
        long K0[4][4], K1[4][4], K2[4][4];
        AT_LOADK(K0, 0); AT_LOADK(K1, 1); AT_LOADK(K2, 2);
        AT_MMAK(K0, 0); AT_LOADK(K0, 3);
        AT_MMAK(K1, 1); AT_LOADV(VA, 0);
        AT_MMAK(K2, 2);
        AT_MMAK(K0, 3);
    }
#define DPP_F(oldv, srcv, ctrl, bank) __builtin_bit_cast(float, __builtin_amdgcn_update_dpp(__builtin_bit_cast(int, (float)(oldv)), __builtin_bit_cast(int, (float)(srcv)), (ctrl), 0xF, (bank), false))
    float val[4][4];
#pragma unroll
    for (int ii = 0; ii < 4; ++ii)
#pragma unroll
        for (int r = 0; r < 4; ++r) { float v = lg[ii][r];
            v = DPP_F(v, lg[4 + ii][r], 0x114, 0x2); v = DPP_F(v, lg[8 + ii][r], 0x118, 0x4); v = DPP_F(v, lg[12 + ii][r], 0x11C, 0x8); val[ii][r] = v; }
    const int cj = fr >> 2;
    float m = -INFINITY;
#pragma unroll
    for (int ii = 0; ii < 4; ++ii)
#pragma unroll
        for (int r = 0; r < 4; ++r) { const int slot = 64 * cj + 16 * kg + 4 * r + ii; const float v = (slot < nvalid) ? val[ii][r] * (0.08838834764831845f * 1.4426950408889634f) : -INFINITY; val[ii][r] = v; m = fmaxf(m, v); }
    m = fmaxf(m, __shfl_xor(m, 4)); m = fmaxf(m, __shfl_xor(m, 8)); m = fmaxf(m, __shfl_xor(m, 16)); m = fmaxf(m, __shfl_xor(m, 32));
    float sum = 0.f;
#pragma unroll
    for (int ii = 0; ii < 4; ++ii)
#pragma unroll
        for (int r = 0; r < 4; ++r) { const float e = __builtin_amdgcn_exp2f(val[ii][r] - m); val[ii][r] = e; sum += e; }
    sum += __shfl_xor(sum, 4); sum += __shfl_xor(sum, 8); sum += __shfl_xor(sum, 16); sum += __shfl_xor(sum, 32);
    const float pscale = __builtin_amdgcn_rcpf(sum) * 256.0f;
    int pl[2][2];
#pragma unroll
    for (int ipl = 0; ipl < 2; ++ipl) { int w0 = 0, w1 = 0;
        w0 = __builtin_amdgcn_cvt_pk_fp8_f32(val[2 * ipl][0] * pscale, val[2 * ipl][1] * pscale, w0, false); w0 = __builtin_amdgcn_cvt_pk_fp8_f32(val[2 * ipl][2] * pscale, val[2 * ipl][3] * pscale, w0, true);
        w1 = __builtin_amdgcn_cvt_pk_fp8_f32(val[2 * ipl + 1][0] * pscale, val[2 * ipl + 1][1] * pscale, w1, false); w1 = __builtin_amdgcn_cvt_pk_fp8_f32(val[2 * ipl + 1][2] * pscale, val[2 * ipl + 1][3] * pscale, w1, true);
        pl[ipl][0] = w0; pl[ipl][1] = w1; }
    long Pf[8];
#pragma unroll
    for (int ipl = 0; ipl < 2; ++ipl) {
        Pf[ipl] = (long)(((unsigned long long)(unsigned)pl[ipl][1] << 32) | (unsigned long long)(unsigned)pl[ipl][0]);
#define PF_GATHER(c, ctrl) do { const int lo_ = __builtin_amdgcn_update_dpp(0, pl[ipl][0], ctrl, 0xF, 0x1, false), hi_ = __builtin_amdgcn_update_dpp(0, pl[ipl][1], ctrl, 0xF, 0x1, false); \
            Pf[2 * (c) + ipl] = (long)(((unsigned long long)(unsigned)hi_ << 32) | (unsigned long long)(unsigned)lo_); } while (0)
        PF_GATHER(1, 0x104); PF_GATHER(2, 0x108); PF_GATHER(3, 0x10C);
#undef PF_GATHER
    }
#undef DPP_F
    f32x4 O[8];
#pragma unroll
    for (int ct = 0; ct < 8; ++ct) O[ct] = (f32x4){0.f, 0.f, 0.f, 0.f};
    if (qi < NQW - 1) AT_LOADI(t + 1, kixn);
    const h16x8 gate = *(const h16x8*)((const h16*)(p.ws + OFF_AZ) + (size_t)bt * 1024 + (4 * g) * 128 + 8 * lane);
    const int q4 = fr >> 2, pp = fr & 3;
    typedef int v2i_t __attribute__((__vector_size__(2 * sizeof(int))));
#define AT_STOREV(Vx) do { _Pragma("unroll") for (int it = 0; it < 8; ++it) { const int r = 8 * (lane >> 3) + it; const int fk = ((r >> 2) & 3) | (((r >> 4) & 1) << 2); \
        *(u32x4*)(vl + r * 128 + (((lane & 7) ^ fk) << 4)) = Vx[it]; } } while (0)
#define AT_PV(c) do { _Pragma("unroll") for (int ipl = 0; ipl < 2; ++ipl) { const int qq = fr >> 1; const int r = 16 * kg + 4 * (qq & 3) + 2 * ipl + (qq >> 2); const int fk = ((r >> 2) & 3) | (((r >> 4) & 1) << 2); \
        _Pragma("unroll") for (int ct = 0; ct < 8; ++ct) { const LAS unsigned char* a0 = vll + r * 128 + ((ct ^ fk) << 4) + (fr & 1) * 8; \
            const v2i_t bv = __builtin_amdgcn_ds_read_tr8_b64_v2i32((LAS v2i_t*)a0); \
            O[ct] = __builtin_amdgcn_mfma_f32_16x16x32_fp8_fp8(Pf[2 * (c) + ipl], __builtin_bit_cast(long, bv), O[ct], 0, 0, 0); } } } while (0)
    AT_LOADV(VB, 1); AT_STOREV(VA); AT_PV(0);
    AT_LOADV(VA, 2); AT_STOREV(VB); AT_PV(1);
    AT_LOADV(VB, 3); AT_STOREV(VA); AT_PV(2);
    AT_STOREV(VB); AT_PV(3);
#undef AT_LOADK
#undef AT_MMAK
#undef AT_LOADV
#undef AT_STOREV
#undef AT_PV
    h16* ot = (h16*)vl;
    if (kg == 0) {
#pragma unroll
        for (int ct = 0; ct < 8; ++ct)
#pragma unroll
            for (int r = 0; r < 4; ++r) ot[r * 128 + 16 * ct + fr] = (h16)O[ct][r];
    }
    {
        const h16x8 ov = *(const h16x8*)(ot + 8 * lane);
        h16x8 res;
#pragma unroll
        for (int j = 0; j < 8; ++j) res[j] = (h16)((float)ov[j] * (float)gate[j] * (1.0f / 256.0f));
        *(h16x8*)((h16*)(p.ws + OFF_OMIX) + (size_t)bt * 2048 + 1024 + (4 * g) * 128 + 8 * lane) = res;
    }
#pragma unroll
    for (int c = 0; c < 4; ++c) kix[c] = kixn[c];
    }
#undef AT_LOADI
}

__device__ __forceinline__ void phase5(const Params& p) {
    const int tid = opaque_tid(), wid = tid >> 6, lane = tid & 63;
    const int gw = blockIdx.x * 8 + wid, nw = gridDim.x * 8;
    const float* rowss = (const float*)(p.ws + OFF_ROWSS);
    for (int row = gw; row < BT; row += nw) {
        const float r = 1.0f / sqrtf(rowss[row] * (1.0f / DM) + EPS);
        f32x4* o = (f32x4*)(p.out + (size_t)row * DM);
        float eadd = 0.f;
        if ((TS_A >= 0 || TS_ACC >= 0) && row < 164) { const unsigned* ts = (const unsigned*)(p.ws + OFF_CTRL + 8192); const float tus = (TS_ACC >= 0) ? (float)ts[16 + (TS_ACC >= 0 ? TS_ACC : 0)] * (0.01f / 256.0f) : (float)(ts[TS_B >= 0 ? TS_B : 0] - ts[TS_A >= 0 ? TS_A : 0]) * 0.01f; eadd = sqrtf(tus * 1e-5f); }
#pragma unroll
        for (int i = 0; i < 8; ++i) { const f32x4 g = ((const f32x4*)p.final_g)[lane + 64 * i]; f32x4 v = o[lane + 64 * i]; v = v * r * g + eadd; o[lane + 64 * i] = v; }
    }
}

#define XB_TMO      128
#define XB_XCNT(j)  (256  + 64 * (j))
#define XB_XSUB(j)  (1280 + 64 * (j))
#define XB_XGEN(j)  (2304 + 64 * (j))
#define XB_TOP      3328
#define XB_TOPGEN   3392
#define XCD_BAR_WORDS 3456
#define XB_SPIN_CAP (1u << 18)

__device__ __forceinline__ unsigned xb_ld(unsigned* p)              { return __hip_atomic_load(p, __ATOMIC_RELAXED, __HIP_MEMORY_SCOPE_AGENT); }
__device__ __forceinline__ unsigned xb_add(unsigned* p, unsigned v) { return __hip_atomic_fetch_add(p, v, __ATOMIC_RELAXED, __HIP_MEMORY_SCOPE_AGENT); }
__device__ __forceinline__ unsigned xb_xcc_id() { return (unsigned)__builtin_amdgcn_s_getreg((3 << 11) | 20) & 0xFu; }
#define XB_SPIN(cond, bar) do { unsigned _sp = 0; while (cond) { __builtin_amdgcn_s_sleep(1); \
    if ((++_sp & 255u) == 0u) { if (xb_ld(&(bar)[XB_TMO])) break; if (_sp > XB_SPIN_CAP) { atomicAdd(&(bar)[XB_TMO], 1u); break; } } } } while (0)

struct XcdBarrier {
    unsigned* bar; unsigned x;
    volatile LAS unsigned* st;
};

__device__ __forceinline__ XcdBarrier xcd_barrier_post(unsigned* bar, volatile LAS unsigned* st) {
    XcdBarrier b; b.bar = bar; b.x = xb_xcc_id(); b.st = st;
    if (threadIdx.x == 0) (void)xb_add(&bar[XB_XCNT(b.x)], 1u);
    return b;
}
__device__ __forceinline__ void xcd_barrier_complete(unsigned* bar, unsigned x, unsigned& nloc, unsigned& nx) {
    const unsigned G = gridDim.x * gridDim.y * gridDim.z;
    unsigned sum, cnt, mine, sp = 0u;
    for (;;) {
        sum = 0u; cnt = 0u; mine = 0u;
#pragma unroll
        for (unsigned j = 0; j < 16; ++j) { const unsigned c = xb_ld(&bar[XB_XCNT(j)]); sum += c; cnt += (c > 0u) ? 1u : 0u; mine = (j == x) ? c : mine; }
        if (sum == G) break;
        __builtin_amdgcn_s_sleep(1);
        if ((++sp & 255u) == 0u) { if (xb_ld(&bar[XB_TMO])) break; if (sp > XB_SPIN_CAP) { atomicAdd(&bar[XB_TMO], 1u); break; } }
    }
    nloc = mine > 0u ? mine : 1u; nx = cnt > 0u ? cnt : 1u;
}

__device__ __forceinline__ void xcd_barrier(const XcdBarrier& b) {
    asm volatile("s_waitcnt vmcnt(0)" ::: "memory");
    __syncthreads();
    if (threadIdx.x == 0) {
        unsigned* bar = b.bar;
        __builtin_amdgcn_s_waitcnt(0);
        unsigned nloc = b.st[0], nx = b.st[1];
        if (nloc == 0u) { xcd_barrier_complete(bar, b.x, nloc, nx); b.st[0] = nloc; b.st[1] = nx; }
        const unsigned old = xb_add(&bar[XB_XSUB(b.x)], 1u);
        const unsigned gen = old / nloc;
        if (old + 1u == (gen + 1u) * nloc) {
            __builtin_amdgcn_fence(__ATOMIC_RELEASE, "agent");
            asm volatile("s_waitcnt vmcnt(0)" ::: "memory");
            const unsigned og = xb_add(&bar[XB_TOP], 1u);
            const unsigned tg = og / nx;
            if (og + 1u == (tg + 1u) * nx) xb_add(&bar[XB_TOPGEN], 1u);
            else XB_SPIN(xb_ld(&bar[XB_TOPGEN]) == tg, bar);
            __builtin_amdgcn_fence(__ATOMIC_ACQUIRE, "agent");
            xb_add(&bar[XB_XGEN(b.x)], 1u);
            asm volatile("s_waitcnt vmcnt(0)" ::: "memory");
        } else {
            XB_SPIN(xb_ld(&bar[XB_XGEN(b.x)]) == gen, bar);
            __builtin_amdgcn_fence(__ATOMIC_ACQUIRE, "agent");
            asm volatile("s_waitcnt vmcnt(0)" ::: "memory");
        }
    }
    __syncthreads();
}


template <int LO, int HI>
__global__ void __launch_bounds__(512, 2) k_phases(Params p) {
    extern __shared__ __attribute__((aligned(16))) unsigned char smem[];
#define IN(k) (LO <= (k) && (k) < HI)
#define SEAM(k) do { if constexpr (IN(k) && IN((k) + 1)) { xcd_barrier(xbar); if (TS_A >= 0 && blockIdx.x == 0 && threadIdx.x == 0) ((unsigned*)(p.ws + OFF_CTRL + 8192))[(k) + 1] = (unsigned)__builtin_amdgcn_s_memrealtime(); } } while (0)
    XcdBarrier xbar; xbar.bar = nullptr; xbar.x = 0; xbar.st = nullptr;
    if constexpr (HI - LO > 1) {
        volatile LAS unsigned* stw = (volatile LAS unsigned*)((LAS unsigned char*)smem + LDS_BYTES - 48);
        if (threadIdx.x < 4) stw[threadIdx.x] = 0u;
        __syncthreads();
        xbar = xcd_barrier_post((unsigned*)(p.ws + OFF_CTRL + 16384), stw);
    }
    if (TS_A >= 0 && blockIdx.x == 0 && threadIdx.x == 0) ((unsigned*)(p.ws + OFF_CTRL + 8192))[0] = (unsigned)__builtin_amdgcn_s_memrealtime();
    if constexpr (IN(0)) { for (int rep = 0; rep < NREP(0); ++rep) phase0(p, smem); }
    SEAM(0);
    if constexpr (IN(1)) for (int rep = 0; rep < NREP(1); ++rep) {
        EpiIn E{p.ws, p.a_log, p.dt_bias};
        {
            pg8::Gemm g{(const h16*)(p.ws + OFF_H), (const h16*)(p.ws + OFF_WT), BT, NPAD, DM};
            OrderF16 S; S.init(BT, 21 * 256, gridDim.x, blockIdx.x);
            pg8::gemm_phase<EpiIn, OrderF16>((LAS unsigned char*)smem, g, S, E);
        }
        {
            pg8::Gemm g{(const h16*)(p.ws + OFF_H8), (const h16*)(p.ws + OFF_WT8 - (size_t)16 * 256 * 2048), BT, 2560, DM};
            OrderF8 S; S.G = gridDim.x; S.c = blockIdx.x;
            pg8::gemm_phase<EpiIn, OrderF8, true, true>((LAS unsigned char*)smem, g, S, E);
        }
    }
    SEAM(1);
    if constexpr (IN(2)) for (int rep = 0; rep < NREP(2); ++rep) {
        {
            unsigned* qctr = (unsigned*)(p.ws + OFF_CTRL);
            volatile unsigned* lds_t = (volatile unsigned*)(smem + LDS_BYTES - 16);
            __syncthreads();
            if (threadIdx.x == 0) lds_t[0] = atomicAdd(qctr + 0 + 16 * rep, 1u);
            __syncthreads();
            unsigned o = lds_t[0];
            while (o < 1024u + 2048u) {
                unsigned nxt = 0u;
                if (threadIdx.x == 0) nxt = atomicAdd(qctr + 0 + 16 * rep, 1u);
                if (o < 1024u) { ACC_T0(); gdn_prep_pair(p, smem, (int)o); __syncthreads(); ACC_ADD(0); }
                else { const unsigned o2 = o - 1024u; idx8_task(p, smem, (int)(o2 & 3u), 511 - (int)(o2 >> 2)); }
                __syncthreads();
                if (threadIdx.x == 0) lds_t[0] = nxt;
                __syncthreads();
                o = lds_t[0];
            }
        }
    }
    SEAM(2);
    if constexpr (IN(3)) for (int rep = 0; rep < NREP(3); ++rep) {
        {
            unsigned* qctr = (unsigned*)(p.ws + OFF_CTRL);
            volatile unsigned* lds_t = (volatile unsigned*)(smem + LDS_BYTES - 16);
            volatile unsigned* lds_c = (volatile unsigned*)(smem + LDS_BYTES - 192);
            const int myx = (int)(xb_xcc_id() & 7u);
            for (int pass = 0; pass < 2; ++pass) {
                if (pass == 1) { __syncthreads(); if (threadIdx.x < 8) lds_c[8 + threadIdx.x] = __hip_atomic_load(qctr + 64 + 16 * rep + threadIdx.x, __ATOMIC_RELAXED, __HIP_MEMORY_SCOPE_AGENT); __syncthreads(); }
                const int nk = pass == 0 ? 1 : 8;
                for (int k = 0; k < nk; ++k) {
                    const int sp = (myx + k) & 7;
                    if (pass == 1 && lds_c[8 + sp] >= 4u) continue;
                    for (;;) {
                        __syncthreads();
                        if (threadIdx.x == 0) lds_t[0] = atomicAdd(qctr + 64 + 16 * rep + sp, 1u);
                        __syncthreads();
                        const unsigned o = lds_t[0];
                        if (o >= 4u) break;
                        { ACC_T0(); gdn_scan_task(p, smem, 4 * sp + (int)o); __syncthreads(); ACC_ADD(4); }
                        if (pass == 0) break;
                    }
                }
                if (pass == 0) for (int k = 0; k < 8; ++k) {
                    const int part = (myx + k) & 7;
                    if (k == 1) { __syncthreads(); if (threadIdx.x < 8) lds_c[threadIdx.x] = __hip_atomic_load(qctr + 128 + 16 * rep + threadIdx.x, __ATOMIC_RELAXED, __HIP_MEMORY_SCOPE_AGENT); __syncthreads(); }
                    if (k >= 1 && lds_c[part] >= 512u) continue;
                    __syncthreads();
                    if (threadIdx.x == 0) lds_t[0] = atomicAdd(qctr + 128 + 16 * rep + part, 1u);
                    __syncthreads();
                    unsigned a = lds_t[0];
                    while (a < 512u) {
                        unsigned nxt = 0u;
                        if (threadIdx.x == 0) nxt = atomicAdd(qctr + 128 + 16 * rep + part, 1u);
                        { ACC_T0(); attn8_task(p, smem, part, (int)a); __syncthreads(); ACC_ADD(3); }
                        __syncthreads();
                        if (threadIdx.x == 0) lds_t[0] = nxt;
                        __syncthreads();
                        a = lds_t[0];
                    }
                }
            }
        }
    }
    SEAM(3);
    const bool fuse_norm = (gridDim.x == 256) && (TS_A < 0) && (TS_ACC < 0);
    if constexpr (IN(4)) {
        pg8::Gemm g{(const h16*)(p.ws + OFF_OMIX), (const h16*)(p.ws + OFF_WOT), BT, DM, DM};
        if (fuse_norm) {
            PanelOrder S; S.c = blockIdx.x;
            EpiOutNorm E{p.x, p.out, (float*)(p.ws + OFF_ROWSS), (unsigned*)(p.ws + OFF_CTRL + 32768), p.final_g};
            pg8::gemm_phase<EpiOutNorm, PanelOrder>((LAS unsigned char*)smem, g, S, E);
        } else {
            pg8::StaticOrder S; S.init(BT, DM, gridDim.x, blockIdx.x);
            EpiOut E{p.x, p.out, (float*)(p.ws + OFF_ROWSS)};
            pg8::gemm_phase<EpiOut, pg8::StaticOrder>((LAS unsigned char*)smem, g, S, E);
        }
    }
    if (fuse_norm) return;
    SEAM(4);
    if constexpr (IN(5)) { phase5(p); }
#undef IN
#undef SEAM
}

template <int LO, int HI> static void launch_range(const Params& p, int grid, hipStream_t stream, bool coop) {
    static bool attr = false;
    if (!attr) { hipFuncSetAttribute((const void*)k_phases<LO, HI>, hipFuncAttributeMaxDynamicSharedMemorySize, LDS_BYTES); attr = true; }
    if (coop) {
        Params pp = p; void* args[] = {&pp};
        hipError_t e = hipLaunchCooperativeKernel((const void*)k_phases<LO, HI>, dim3(grid), dim3(512), args, LDS_BYTES, stream);
        if (e != hipSuccess) fprintf(stderr, "cooperative launch failed: %s (grid %d)\n", hipGetErrorString(e), grid);
    } else {
        hipLaunchKernelGGL((k_phases<LO, HI>), dim3(grid), dim3(512), LDS_BYTES, stream, p);
    }
}

extern "C" void kernel_launch(void* const* d_in, const int* in_sizes, int n_in, void* d_out, int out_size, void* d_ws, size_t ws_size, hipStream_t stream) {
    if (n_in != 10 || in_sizes[0] != BT * DM || out_size != BT * DM || ws_size < WS_END) {
        fprintf(stderr, "kernel_launch: unexpected shapes (n_in %d in0 %d out %d ws %zu need %zu)\n", n_in, n_in > 0 ? in_sizes[0] : -1, out_size, ws_size, (size_t)WS_END); return; }
    static int grid = 0;
    if (!grid) {
        int dev = 0, cus = 0, per_cu = 0; hipGetDevice(&dev); hipDeviceGetAttribute(&cus, hipDeviceAttributeMultiprocessorCount, dev);
#if FUSED
        hipFuncSetAttribute((const void*)k_phases<0, 6>, hipFuncAttributeMaxDynamicSharedMemorySize, LDS_BYTES);
        hipOccupancyMaxActiveBlocksPerMultiprocessor(&per_cu, (const void*)k_phases<0, 6>, 512, LDS_BYTES);
#else
        per_cu = 1;
#endif
        if (per_cu < 1) per_cu = 1; if (per_cu > 1) per_cu = 1;
        grid = cus * per_cu;
    }
    Params p{};
    p.x = (const float*)d_in[0]; p.pos = (const int*)d_in[1]; p.attn_g = (const float*)d_in[2]; p.w_in = (const float*)d_in[3]; p.conv_w = (const float*)d_in[4];
    p.a_log = (const float*)d_in[5]; p.dt_bias = (const float*)d_in[6]; p.gdn_norm_g = (const float*)d_in[7]; p.w_out = (const float*)d_in[8]; p.final_g = (const float*)d_in[9];
    p.out = (float*)d_out; p.ws = (unsigned char*)d_ws;
    hipMemsetAsync((char*)d_ws + OFF_CTRL, 0, CTL_ZERO_BYTES, stream);
#if FUSED
    launch_range<0, 6>(p, grid, stream, false);
#else
    launch_range<0, 1>(p, grid, stream, false);
    launch_range<1, 2>(p, grid, stream, false);
    launch_range<2, 3>(p, grid, stream, false);
    launch_range<3, 4>(p, grid, stream, false);
    launch_range<4, 5>(p, grid, stream, false);
    launch_range<5, 6>(p, grid, stream, false);
#endif
}
```

```cpp
#include <hip/hip_runtime.h>
#include <hip/hip_cooperative_groups.h>
#include <cstdio>
#include <cstdint>
namespace cg = cooperative_groups;

#ifndef FUSED
#define FUSED 1
#endif
#ifndef REPEAT_PHASE
#define REPEAT_PHASE -1
#endif
#define NREP(k) ((REPEAT_PHASE == (k)) ? 2 : 1)
#ifndef TS_A
#define TS_A -1
#endif
#ifndef TS_ACC
#define TS_ACC -1
#endif
#define ACC_T0() unsigned acc_t0_ = 0; if (TS_ACC >= 0 && threadIdx.x == 0) acc_t0_ = (unsigned)__builtin_amdgcn_s_memrealtime()
#define ACC_ADD(k) do { if (TS_ACC >= 0 && threadIdx.x == 0) { const unsigned t1_ = (unsigned)__builtin_amdgcn_s_memrealtime(); atomicAdd((unsigned*)(p.ws + OFF_CTRL + 8192) + 16 + (k), t1_ - acc_t0_); acc_t0_ = t1_; } } while (0)
#ifndef TS_B
#define TS_B -1
#endif

#define LAS __attribute__((address_space(3)))
typedef _Float16 h16;
typedef h16 h16x8 __attribute__((ext_vector_type(8)));
typedef h16 h16x4 __attribute__((ext_vector_type(4)));
typedef h16 h16x2 __attribute__((ext_vector_type(2)));
typedef float f32x4 __attribute__((ext_vector_type(4)));
typedef float f32x2 __attribute__((ext_vector_type(2)));
typedef unsigned u32x4 __attribute__((ext_vector_type(4)));

constexpr int NB = 4, NT = 4096, DM = 2048, BT = NB * NT;
constexpr int IN_COLS = 7776, NPAD = 7936;
constexpr float EPS = 1e-6f;
constexpr int LDS_BYTES = 155648;

constexpr size_t MB = 1024 * 1024;
constexpr size_t OFF_CTRL = 0;
constexpr size_t OFF_ROWSS = 65536;
constexpr size_t CTL_ZERO_BYTES = 65536 + (size_t)BT * 4;
constexpr size_t OFF_H = 1 * MB;
constexpr size_t OFF_OMIX = OFF_H;
constexpr size_t OFF_WT = OFF_H + 64 * MB;
constexpr size_t OFF_WOT = OFF_WT + (size_t)NPAD * 2048 * 2;
constexpr size_t OFF_QKVR = OFF_WOT + 8 * MB;
constexpr size_t OFF_GZ = OFF_QKVR + (size_t)BT * 3072 * 2;
constexpr size_t OFF_AQ = OFF_GZ + 32 * MB;
constexpr size_t OFF_AK = OFF_AQ + 32 * MB;
constexpr size_t OFF_AV = OFF_AK + 8 * MB;
constexpr size_t OFF_AZ = OFF_AV + 8 * MB;
constexpr size_t OFF_IQ = OFF_AZ + 32 * MB;
constexpr size_t OFF_IK = OFF_IQ + 32 * MB;
constexpr size_t OFF_GB = OFF_IK + 2 * MB;
constexpr size_t OFF_IW = OFF_GB + 1 * MB;
constexpr size_t OFF_COS = OFF_IW + 1 * MB;
constexpr size_t OFF_SIN = OFF_COS + 2 * MB;
constexpr size_t OFF_SEL = OFF_SIN + 2 * MB;
constexpr size_t OFF_REC = OFF_SEL + 8 * MB;
constexpr size_t OFF_H8 = OFF_REC;
constexpr size_t OFF_WT8 = OFF_REC + 32 * MB;
constexpr size_t WS_END = OFF_REC + (size_t)2048 * 74752;

struct Params {
    const float* x; const int* pos; const float* attn_g; const float* w_in; const float* conv_w; const float* a_log;
    const float* dt_bias; const float* gdn_norm_g; const float* w_out; const float* final_g; float* out; unsigned char* ws;
};

__device__ __forceinline__ float wave_sum(float v) {
#pragma unroll
    for (int o = 1; o < 64; o <<= 1) v += __shfl_xor(v, o);
    return v;
}
__device__ __forceinline__ float wave_max(float v) {
#pragma unroll
    for (int o = 1; o < 64; o <<= 1) v = fmaxf(v, __shfl_xor(v, o));
    return v;
}
__device__ __forceinline__ int opaque_tid() { int t = threadIdx.x; asm volatile("" : "+v"(t)); return t; }
__device__ __forceinline__ float silu_f(float x) { return x * __builtin_amdgcn_rcpf(1.0f + __builtin_amdgcn_exp2f(-1.4426950408889634f * x)); }

namespace pg8 {
constexpr int BM = 256, BK = 64, HALF = 128, HTB = HALF * BK * 2, STAGE_BYTES = 8 * HTB, NXCD = 8, WGM = 8;
__host__ __device__ __forceinline__ int lds_byte(int r, int c) { const int st = (r >> 4) * 2 + (c >> 5), rr = r & 15, cc = c & 31, ob = rr * 64 + cc * 2; return st * 1024 + (ob ^ (((ob >> 9) & 1) << 5)); }
__host__ __device__ __forceinline__ void stage_rc(int b, int& R, int& C) { const int st = b / 1024, sb = b % 1024, swz = sb ^ (((sb >> 9) & 1) << 5); R = (st >> 1) * 16 + swz / 64; C = (st & 1) * 32 + (swz % 64) / 2; }
__host__ __device__ __forceinline__ int perm32(int rho) { const int n = rho >> 4, i = rho & 15; return 8 * (i >> 2) + 4 * n + (i & 3); }
struct Unit { int pm, pn; };
struct Gemm { const h16* A; const h16* Bt; int M, N, K; };
struct StaticOrder {
    int nM, nN, nwg, G, c;
    __host__ __device__ void init(int M, int N, int G_, int c_) { nM = M / BM; nN = N / BM; nwg = nM * nN; G = G_; c = c_; }
    __host__ __device__ bool next(int i, Unit& u) const {
        const long L = (long)i * G + c; if (L >= nwg) return false;
        int wgid = (int)L; { const int q = nwg / NXCD, r = nwg % NXCD, xcd = wgid % NXCD, off = wgid / NXCD; wgid = (xcd < r ? xcd * (q + 1) : r * (q + 1) + (xcd - r) * q) + off; }
        const int nig = WGM * nN, gid = wgid / nig, fm = gid * WGM, gsz = (nM - fm) < WGM ? (nM - fm) : WGM;
        u.pm = fm + ((wgid % nig) % gsz); u.pn = (wgid % nig) / gsz; return true;
    }
    __device__ __forceinline__ void a_ready(const Unit&) const {}
    __device__ __forceinline__ void done(const Unit&) const {}
};

typedef int i32x8 __attribute__((ext_vector_type(8)));
template <class Epi, class Sched, bool SP2 = true, bool F8 = false>
__device__ __forceinline__ void gemm_phase(LAS unsigned char* lds, const Gemm g, const Sched& S, const Epi& E) {
    const int tid = opaque_tid(), wid = __builtin_amdgcn_readfirstlane(tid >> 6), lane = tid & 63, wr = wid >> 2, wc = wid & 3, fr = lane & 15, fq = lane >> 4;
    const int K = g.K;
    const int ESZ = F8 ? 1 : 2, nt = (K * ESZ) / 128;
    unsigned voffA[2], voffB[2];
#pragma unroll
    for (int i = 0; i < 2; ++i) { int R, C; stage_rc(tid * 16 + i * 8192, R, C); const int Rb = Epi::PERM ? ((R & ~31) + perm32(R & 31)) : R;
        voffA[i] = (unsigned)(R * K * ESZ + C * 2); voffB[i] = (unsigned)(Rb * K * ESZ + C * 2); }
    const size_t kstep = (size_t)(BK * 2);
    const size_t hstep = (size_t)HALF * K * ESZ;
    const size_t tstep = 2 * hstep;
    const unsigned ldsw = (unsigned)wid * 1024u;
    const int aoff = lds_byte(wr * 64 + fr, fq * 8), boff = lds_byte(wc * 32 + fr, fq * 8);
#define PG8_SA(b, h) (((b) * 2 + (h)) * HTB)
#define PG8_SB(b, h) ((4 + (b) * 2 + (h)) * HTB)
#define PG8_STAGE(bufoff, gbase, voff) do { _Pragma("unroll") for (int _i = 0; _i < 2; ++_i) \
        __builtin_amdgcn_global_load_lds((const unsigned*)((const char*)(gbase) + (voff)[_i]), (LAS unsigned*)(lds + (bufoff) + ldsw + _i * 8192), 16, 0, 0); } while (0)
#define PG8_LDA(dst, b, h) do { _Pragma("unroll") for (int m = 0; m < 4; ++m) _Pragma("unroll") for (int k = 0; k < 2; ++k) dst[m][k] = *(const LAS h16x8*)(lds + PG8_SA(b, h) + aoff + m * 2048 + k * 1024); } while (0)
#define PG8_LDB(dst, b, h) do { _Pragma("unroll") for (int n = 0; n < 2; ++n) _Pragma("unroll") for (int k = 0; k < 2; ++k) dst[n][k] = *(const LAS h16x8*)(lds + PG8_SB(b, h) + boff + n * 2048 + k * 1024); } while (0)
#define PG8_MMA(ai, bj, At, Bt) do { __builtin_amdgcn_s_setprio(1); \
        if constexpr (F8) { _Pragma("unroll") for (int m = 0; m < 4; ++m) _Pragma("unroll") for (int n = 0; n < 2; ++n) { \
            const u32x4 b0_ = __builtin_bit_cast(u32x4, Bt[n][0]), b1_ = __builtin_bit_cast(u32x4, Bt[n][1]), a0_ = __builtin_bit_cast(u32x4, At[m][0]), a1_ = __builtin_bit_cast(u32x4, At[m][1]); \
            const i32x8 bw_ = (i32x8){(int)b0_[0], (int)b0_[1], (int)b0_[2], (int)b0_[3], (int)b1_[0], (int)b1_[1], (int)b1_[2], (int)b1_[3]}; \
            const i32x8 aw_ = (i32x8){(int)a0_[0], (int)a0_[1], (int)a0_[2], (int)a0_[3], (int)a1_[0], (int)a1_[1], (int)a1_[2], (int)a1_[3]}; \
            asm volatile("v_mfma_scale_f32_16x16x128_f8f6f4 %0, %1, %2, %0, %3, %3 op_sel_hi:[0,0,0]" : "+v"(acc[ai][bj][m][n]) : "v"(bw_), "v"(aw_), "v"(0x7C7C7C7C)); } } \
        else { _Pragma("unroll") for (int m = 0; m < 4; ++m) _Pragma("unroll") for (int n = 0; n < 2; ++n) _Pragma("unroll") for (int k = 0; k < 2; ++k) \
            acc[ai][bj][m][n] = __builtin_amdgcn_mfma_f32_16x16x32_f16(Bt[n][k], At[m][k], acc[ai][bj][m][n], 0, 0, 0); } \
        __builtin_amdgcn_s_setprio(0); } while (0)
#define PG8_WAIT_V(n) asm volatile("s_waitcnt vmcnt(" #n ")" ::: "memory")
#define PG8_WAIT_L(n) asm volatile("s_waitcnt lgkmcnt(" #n ")" ::: "memory")
#define PG8_BAR __builtin_amdgcn_s_barrier()
#define PG8_SCHED __builtin_amdgcn_sched_barrier(0)
    Unit cur, nxt; int ui = 0;
    if (!S.next(0, cur)) return;
    f32x4 acc[2][2][4][2];
#pragma unroll
    for (int a = 0; a < 2; ++a)
#pragma unroll
        for (int b = 0; b < 2; ++b)
#pragma unroll
            for (int m = 0; m < 4; ++m)
#pragma unroll
                for (int n = 0; n < 2; ++n) acc[a][b][m][n] = (f32x4){0.f, 0.f, 0.f, 0.f};
    h16x8 At[4][2], B0[2][2], B1[2][2];
    const char* cA = (const char*)g.A + (size_t)cur.pm * tstep; const char* cB = (const char*)g.Bt + (size_t)cur.pn * tstep;
    S.a_ready(cur);
    if constexpr (SP2) {
        PG8_STAGE(PG8_SB(0, 0), cB, voffB); PG8_STAGE(PG8_SB(0, 1), cB + hstep, voffB); PG8_STAGE(PG8_SA(0, 0), cA, voffA); PG8_STAGE(PG8_SA(0, 1), cA + hstep, voffA);
        if (wr == 1) PG8_BAR;
        PG8_WAIT_V(2); PG8_BAR;
        PG8_STAGE(PG8_SB(1, 0), cB + kstep, voffB); PG8_STAGE(PG8_SA(1, 0), cA + kstep, voffA); PG8_STAGE(PG8_SB(1, 1), cB + hstep + kstep, voffB);
        PG8_WAIT_V(6); PG8_BAR;
    } else {
    PG8_STAGE(PG8_SB(0, 0), cB, voffB); PG8_STAGE(PG8_SA(0, 0), cA, voffA); PG8_STAGE(PG8_SB(0, 1), cB + hstep, voffB); PG8_STAGE(PG8_SA(0, 1), cA + hstep, voffA);
    if (wr == 1) PG8_BAR;
    PG8_WAIT_V(4); PG8_BAR;
    PG8_STAGE(PG8_SB(1, 0), cB + kstep, voffB); PG8_STAGE(PG8_SA(1, 0), cA + kstep, voffA); PG8_STAGE(PG8_SB(1, 1), cB + hstep + kstep, voffB);
    PG8_WAIT_V(6); PG8_BAR;
    }
    for (;;) {
        const bool has_next = S.next(ui + 1, nxt);
        const char* nA = has_next ? (const char*)g.A + (size_t)nxt.pm * tstep : cA; const char* nB = has_next ? (const char*)g.Bt + (size_t)nxt.pn * tstep : cB;
        for (int t = 0; t < nt; t += 2) {
            const bool last = (t == nt - 2);
            const char* a1 = cA + (size_t)(t + 1) * kstep;
            const char* a2 = last ? nA : cA + (size_t)(t + 2) * kstep; const char* b2 = last ? nB : cB + (size_t)(t + 2) * kstep;
            const char* a3 = a2 + kstep; const char* b3 = b2 + kstep;
            if (last && has_next) S.a_ready(nxt);
            if constexpr (SP2) {
            PG8_LDB(B0, 0, 0); PG8_LDB(B1, 0, 1); PG8_SCHED; PG8_LDA(At, 0, 0); PG8_STAGE(PG8_SA(1, 1), a1 + hstep, voffA);
            PG8_WAIT_V(8); PG8_WAIT_L(0); PG8_BAR; PG8_MMA(0, 0, At, B0); PG8_MMA(0, 1, At, B1); PG8_BAR; PG8_SCHED;
            PG8_LDA(At, 0, 1); PG8_STAGE(PG8_SB(0, 0), b2, voffB); PG8_STAGE(PG8_SB(0, 1), b2 + hstep, voffB); PG8_STAGE(PG8_SA(0, 0), a2, voffA);
            PG8_WAIT_V(8); PG8_WAIT_L(0); PG8_BAR; PG8_MMA(1, 0, At, B0); PG8_MMA(1, 1, At, B1); PG8_BAR; PG8_SCHED;
            PG8_LDB(B0, 1, 0); PG8_LDB(B1, 1, 1); PG8_SCHED; PG8_LDA(At, 1, 0); PG8_STAGE(PG8_SA(0, 1), a2 + hstep, voffA);
            PG8_WAIT_V(8); PG8_WAIT_L(0); PG8_BAR; PG8_MMA(0, 0, At, B0); PG8_MMA(0, 1, At, B1); PG8_BAR; PG8_SCHED;
            PG8_LDA(At, 1, 1); PG8_STAGE(PG8_SB(1, 0), b3, voffB); PG8_STAGE(PG8_SB(1, 1), b3 + hstep, voffB); PG8_STAGE(PG8_SA(1, 0), a3, voffA);
            PG8_WAIT_V(8); PG8_WAIT_L(0); PG8_BAR; PG8_MMA(1, 0, At, B0); PG8_MMA(1, 1, At, B1); PG8_BAR; PG8_SCHED;
            } else {
            PG8_LDB(B0, 0, 0); PG8_SCHED; PG8_LDA(At, 0, 0); PG8_STAGE(PG8_SA(1, 1), a1 + hstep, voffA);
            PG8_WAIT_L(8); PG8_BAR; PG8_WAIT_L(0); PG8_MMA(0, 0, At, B0); PG8_BAR; PG8_SCHED;
            PG8_LDB(B1, 0, 1); PG8_STAGE(PG8_SB(0, 0), b2, voffB);
            PG8_BAR; PG8_WAIT_L(0); PG8_MMA(0, 1, At, B1); PG8_BAR;
            PG8_LDA(At, 0, 1); PG8_STAGE(PG8_SA(0, 0), a2, voffA);
            PG8_BAR; PG8_WAIT_L(0); PG8_MMA(1, 0, At, B0); PG8_BAR; PG8_SCHED;
            PG8_STAGE(PG8_SB(0, 1), b2 + hstep, voffB);
            PG8_WAIT_V(6); PG8_BAR; PG8_MMA(1, 1, At, B1); PG8_BAR;
            PG8_LDB(B0, 1, 0); PG8_SCHED; PG8_LDA(At, 1, 0); PG8_STAGE(PG8_SA(0, 1), a2 + hstep, voffA);
            PG8_WAIT_L(8); PG8_BAR; PG8_WAIT_L(0); PG8_MMA(0, 0, At, B0); PG8_BAR; PG8_SCHED;
            PG8_LDB(B1, 1, 1); PG8_STAGE(PG8_SB(1, 0), b3, voffB);
            PG8_BAR; PG8_WAIT_L(0); PG8_MMA(0, 1, At, B1); PG8_BAR;
            PG8_LDA(At, 1, 1); PG8_STAGE(PG8_SA(1, 0), a3, voffA);
            PG8_BAR; PG8_WAIT_L(0); PG8_MMA(1, 0, At, B0); PG8_BAR; PG8_SCHED;
            PG8_STAGE(PG8_SB(1, 1), b3 + hstep, voffB);
            PG8_WAIT_V(6); PG8_BAR; PG8_MMA(1, 1, At, B1); PG8_BAR;
            }
        }
        if (wr == 0) PG8_BAR;
        if constexpr (F8) asm volatile("s_nop 15\n\ts_nop 15" ::: "memory");
        PG8_SCHED; { const int te = opaque_tid(), le = te & 63; E(acc, cur, wr, wc, le & 15, le >> 4); } S.done(cur);
        if (!has_next) break;
#pragma unroll
        for (int a = 0; a < 2; ++a)
#pragma unroll
            for (int b = 0; b < 2; ++b)
#pragma unroll
                for (int m = 0; m < 4; ++m)
#pragma unroll
                    for (int n = 0; n < 2; ++n) acc[a][b][m][n] = (f32x4){0.f, 0.f, 0.f, 0.f};
        cur = nxt; cA = nA; cB = nB; ++ui;
        if (wr == 1) PG8_BAR;
    }
    PG8_WAIT_V(0);
    PG8_BAR;
#undef PG8_SA
#undef PG8_SB
#undef PG8_STAGE
#undef PG8_LDA
#undef PG8_LDB
#undef PG8_MMA
#undef PG8_WAIT_V
#undef PG8_WAIT_L
#undef PG8_BAR
#undef PG8_SCHED
}
}

struct OrderF16 : pg8::StaticOrder {
    __device__ __forceinline__ bool next(int i, pg8::Unit& u) const { if (!pg8::StaticOrder::next(i, u)) return false; if (u.pn >= 16) u.pn += 10; return true; }
};
struct OrderF8 {
    int G, c;
    __device__ __forceinline__ bool next(int i, pg8::Unit& u) const {
        int L;
        if (G == 256) { if (c < 64) { if (i >= 1) return false; L = 576 + c; } else { if (i >= 3) return false; L = (c - 64) + 192 * i; } }
        else { L = i * G + c; if (L >= 640) return false; }
        const int wgid = (L % 8) * 80 + L / 8;
        u.pm = (wgid / 80) * 8 + (wgid % 80) % 8; u.pn = 16 + (wgid % 80) / 8; return true;
    }
    __device__ __forceinline__ void a_ready(const pg8::Unit&) const {}
    __device__ __forceinline__ void done(const pg8::Unit&) const {}
};

struct EpiIn {
    static constexpr bool PERM = true;
    unsigned char* ws; const float* a_log; const float* dt_bias; const int* pos;
    __device__ __forceinline__ void operator()(const f32x4 (&acc)[2][2][4][2], const pg8::Unit& u, int wr, int wc, int fr, int fq) const {
        constexpr float RF[16] = {1.591549431e-01f, 7.008652159e-02f, 3.086376340e-02f, 1.359137064e-02f, 5.985185713e-03f, 2.635675899e-03f, 1.160663641e-03f, 5.111175045e-04f,
                                  2.250790790e-04f, 9.911730937e-05f, 4.364795279e-05f, 1.922110068e-05f, 8.464330808e-06f, 3.727408602e-06f, 1.641426263e-06f, 7.228293069e-07f};
        const int pn = u.pn;
        const int rowb = u.pm * 256 + wr * 64 + fr;
        const int cw = wc * 32 + 8 * fq;
        if (pn < 30) {
            h16* base; int ldc, colt, mode; float scale = 1.f;
            if (pn < 12) { base = (h16*)(ws + OFF_QKVR); ldc = 3072; colt = pn * 256; mode = 0; }
            else if (pn < 16) { base = (h16*)(ws + OFF_GZ); ldc = 1024; colt = (pn - 12) * 256; mode = 1; }
            else if (pn < 20) { base = (h16*)(ws + OFF_AQ); ldc = 1024; colt = (pn - 16) * 256; mode = 2; }
            else if (pn == 20) { base = (h16*)(ws + OFF_AK); ldc = 256; colt = 0; mode = 2; }
            else if (pn == 21) { base = (h16*)(ws + OFF_AV); ldc = 256; colt = 0; mode = 4; }
            else if (pn < 26) { base = (h16*)(ws + OFF_AZ); ldc = 1024; colt = (pn - 22) * 256; mode = 1; }
            else { base = (h16*)(ws + OFF_IQ); ldc = 1024; colt = (pn - 26) * 256; mode = 3; }
            const bool rot_wave = (mode == 2 && wc == 0) || (mode == 3 && (wc & 1) == 0);
            const int xm = (mode == 2) ? 32 : 16;
            const bool rot_lane = (mode == 2) ? true : (fq < 2);
            const float sgn = (mode == 2) ? (fq < 2 ? -1.f : 1.f) : (fq == 0 ? -1.f : 1.f);
            float Fq[8]; int ps[2][4];
#pragma unroll
            for (int j = 0; j < 8; ++j) Fq[j] = (mode == 2) ? ((fq & 1) ? RF[8 + j] : RF[j]) : RF[2 * j];
            if (rot_wave) {
#pragma unroll
                for (int ai = 0; ai < 2; ++ai)
#pragma unroll
                    for (int m = 0; m < 4; ++m) ps[ai][m] = pos[rowb + ai * 128 + m * 16];
            }
#pragma unroll
            for (int ai = 0; ai < 2; ++ai)
#pragma unroll
                for (int m = 0; m < 4; ++m) {
                    const int row = rowb + ai * 128 + m * 16;
                    float cs[8], sn[8];
                    if (rot_wave) {
                        const float pf = (float)ps[ai][m];
#pragma unroll
                        for (int j = 0; j < 8; ++j) { const float rv = __builtin_amdgcn_fractf(pf * Fq[j]); cs[j] = __builtin_amdgcn_cosf(rv); sn[j] = __builtin_amdgcn_sinf(rv); }
                    }
#pragma unroll
                    for (int bj = 0; bj < 2; ++bj) {
                        float v[8];
#pragma unroll
                        for (int j = 0; j < 4; ++j) { v[j] = acc[ai][bj][m][0][j]; v[4 + j] = acc[ai][bj][m][1][j]; }
                        if (rot_wave) {
#pragma unroll
                            for (int j = 0; j < 8; ++j) {
                                const unsigned xv = __builtin_bit_cast(unsigned, v[j]); float pv;
                                if (mode == 2) { const auto sw = __builtin_amdgcn_permlane32_swap(xv, xv, false, false); pv = __builtin_bit_cast(float, fq < 2 ? sw[1] : sw[0]); }
                                else { const auto sw = __builtin_amdgcn_permlane16_swap(xv, xv, false, false); pv = __builtin_bit_cast(float, (fq & 1) ? sw[0] : sw[1]); }
                                if (rot_lane) v[j] = v[j] * cs[j] + sgn * pv * sn[j]; }
                        }
                        if (mode == 1) {
#pragma unroll
                            for (int j = 0; j < 8; ++j) v[j] = silu_f(v[j]);
                        }
                        if (mode == 4) {
                            int w0 = 0, w1 = 0;
                            w0 = __builtin_amdgcn_cvt_pk_fp8_f32(v[0], v[1], w0, false); w0 = __builtin_amdgcn_cvt_pk_fp8_f32(v[2], v[3], w0, true);
                            w1 = __builtin_amdgcn_cvt_pk_fp8_f32(v[4], v[5], w1, false); w1 = __builtin_amdgcn_cvt_pk_fp8_f32(v[6], v[7], w1, true);
                            typedef int i32x2b __attribute__((ext_vector_type(2)));
                            *(i32x2b*)((unsigned char*)base + (size_t)row * ldc + bj * 128 + cw) = (i32x2b){w0, w1};
                        } else if (mode == 2) {
                            int w0 = 0, w1 = 0;
                            w0 = __builtin_amdgcn_cvt_pk_fp8_f32(v[0], v[1], w0, false); w0 = __builtin_amdgcn_cvt_pk_fp8_f32(v[2], v[3], w0, true);
                            w1 = __builtin_amdgcn_cvt_pk_fp8_f32(v[4], v[5], w1, false); w1 = __builtin_amdgcn_cvt_pk_fp8_f32(v[6], v[7], w1, true);
                            typedef int i32x2 __attribute__((ext_vector_type(2)));
                            *(i32x2*)((unsigned char*)base + (size_t)row * ldc + colt + bj * 128 + cw) = (i32x2){w0, w1};
                        } else {
                            h16x8 o;
#pragma unroll
                            for (int j = 0; j < 8; ++j) o[j] = (h16)(v[j] * scale);
                            *(h16x8*)(base + (size_t)row * ldc + colt + bj * 128 + cw) = o;
                        }
                    }
                }
        } else {
            h16* ik = (h16*)(ws + OFF_IK); float* gb = (float*)(ws + OFF_GB); float* iw = (float*)(ws + OFF_IW);
#pragma unroll
            for (int ai = 0; ai < 2; ++ai)
#pragma unroll
                for (int m = 0; m < 4; ++m) {
                    const int row = rowb + ai * 128 + m * 16;
                    float v[8];
#pragma unroll
                    for (int j = 0; j < 4; ++j) { v[j] = acc[ai][0][m][0][j]; v[4 + j] = acc[ai][0][m][1][j]; }
                    if (wc == 0) {
                        const float sgn = (fq == 0 ? -1.f : 1.f), pf = (float)pos[row];
#pragma unroll
                        for (int j = 0; j < 8; ++j) { const unsigned xv = __builtin_bit_cast(unsigned, v[j]); const auto sw = __builtin_amdgcn_permlane16_swap(xv, xv, false, false); const float pv = __builtin_bit_cast(float, (fq & 1) ? sw[0] : sw[1]); const float rv = __builtin_amdgcn_fractf(pf * RF[2 * j]); const float c = __builtin_amdgcn_cosf(rv), s = __builtin_amdgcn_sinf(rv);
                            if (fq < 2) v[j] = v[j] * c + sgn * pv * s; }
                    }
                    if (wc < 2) {
                        h16x8 o;
#pragma unroll
                        for (int j = 0; j < 8; ++j) o[j] = (h16)v[j];
                        *(h16x8*)(ik + (size_t)(row >> 5) * 2048 + (cw >> 4) * 512 + ((cw >> 3) & 1) * 256 + (row & 31) * 8) = o;
                    } else if (wc == 2) {
                        if (fq == 0) {
#pragma unroll
                            for (int j = 0; j < 8; ++j) { const float z = v[j] + dt_bias[j]; const float sp = z > 20.f ? z : log1pf(expf(z)); gb[(size_t)row * 16 + j] = -expf(a_log[j]) * sp; }
                        } else if (fq == 1) {
#pragma unroll
                            for (int j = 0; j < 8; ++j) gb[(size_t)row * 16 + 8 + j] = 1.0f / (1.0f + expf(-v[j]));
                        } else {
#pragma unroll
                            for (int j = 0; j < 8; ++j) iw[(size_t)row * 16 + 8 * (fq - 2) + j] = v[j] * 0.03125f;
                        }
                    }
                }
        }
    }
};

struct PanelOrder {
    int c;
    __device__ __forceinline__ bool next(int i, pg8::Unit& u) const { if (i >= 2) return false; u.pm = 32 * i + 4 * (c & 7) + (c >> 6); u.pn = (c >> 3) & 7; return true; }
    __device__ __forceinline__ void a_ready(const pg8::Unit&) const {}
    __device__ __forceinline__ void done(const pg8::Unit&) const {}
};
struct EpiOutNorm {
    static constexpr bool PERM = false;
    const float* x; float* out; float* rowss; unsigned* cnt; const float* fg;
    __device__ __forceinline__ void operator()(f32x4 (&acc)[2][2][4][2], const pg8::Unit& u, int wr, int wc, int fr, int fq) const {
        const int rowb = u.pm * 256 + wr * 64 + fr, col0 = u.pn * 256 + wc * 32 + 4 * fq;
#pragma unroll
        for (int ai = 0; ai < 2; ++ai)
#pragma unroll
            for (int m = 0; m < 4; ++m) {
                const int row = rowb + ai * 128 + m * 16; float ss = 0.f;
#pragma unroll
                for (int bj = 0; bj < 2; ++bj)
#pragma unroll
                    for (int n = 0; n < 2; ++n) {
                        const f32x4 y = *(const f32x4*)(x + (size_t)row * DM + col0 + bj * 128 + n * 16) + acc[ai][bj][m][n];
                        acc[ai][bj][m][n] = y; ss += (y[0] * y[0] + y[1] * y[1]) + (y[2] * y[2] + y[3] * y[3]);
                    }
                ss += __shfl_xor(ss, 16); ss += __shfl_xor(ss, 32);
                if (fq == 0) atomicAdd(rowss + row, ss);
            }
        asm volatile("s_waitcnt vmcnt(0)" ::: "memory");
        unsigned* cw = cnt + (u.pm * 2 + wr) * 16;
        if ((threadIdx.x & 63) == 0) __hip_atomic_fetch_add(cw, 1u, __ATOMIC_RELAXED, __HIP_MEMORY_SCOPE_AGENT);
        { unsigned spins = 0;
          while ((unsigned)__builtin_amdgcn_readfirstlane((int)__hip_atomic_load(cw, __ATOMIC_RELAXED, __HIP_MEMORY_SCOPE_AGENT)) < 32u) { __builtin_amdgcn_s_sleep(2); if (++spins > (1u << 22)) break; } }
        f32x4 gv[2][2];
#pragma unroll
        for (int bj = 0; bj < 2; ++bj)
#pragma unroll
            for (int n = 0; n < 2; ++n) gv[bj][n] = *(const f32x4*)(fg + col0 + bj * 128 + n * 16);
#pragma unroll
        for (int ai = 0; ai < 2; ++ai)
#pragma unroll
            for (int m = 0; m < 4; ++m) {
                const int row = rowb + ai * 128 + m * 16;
                const float ssr = __hip_atomic_load(rowss + row, __ATOMIC_RELAXED, __HIP_MEMORY_SCOPE_AGENT);
                const float r = __builtin_amdgcn_rsqf(ssr * (1.0f / DM) + EPS);
#pragma unroll
                for (int bj = 0; bj < 2; ++bj)
#pragma unroll
                    for (int n = 0; n < 2; ++n) *(f32x4*)(out + (size_t)row * DM + col0 + bj * 128 + n * 16) = acc[ai][bj][m][n] * r * gv[bj][n];
            }
    }
};

struct EpiOut {
    static constexpr bool PERM = false;
    const float* x; float* out; float* rowss;
    __device__ __forceinline__ void operator()(const f32x4 (&acc)[2][2][4][2], const pg8::Unit& u, int wr, int wc, int fr, int fq) const {
        const int rowb = u.pm * 256 + wr * 64 + fr, col0 = u.pn * 256 + wc * 32 + 4 * fq;
#pragma unroll
        for (int ai = 0; ai < 2; ++ai)
#pragma unroll
            for (int m = 0; m < 4; ++m) {
                const int row = rowb + ai * 128 + m * 16; float ss = 0.f;
#pragma unroll
                for (int bj = 0; bj < 2; ++bj)
#pragma unroll
                    for (int n = 0; n < 2; ++n) {
                        const size_t off = (size_t)row * DM + col0 + bj * 128 + n * 16;
                        const f32x4 y = *(const f32x4*)(x + off) + acc[ai][bj][m][n];
                        *(f32x4*)(out + off) = y; ss += (y[0] * y[0] + y[1] * y[1]) + (y[2] * y[2] + y[3] * y[3]);
                    }
                ss += __shfl_xor(ss, 16); ss += __shfl_xor(ss, 32);
                if (fq == 0) atomicAdd(rowss + row, ss);
            }
    }
};

__device__ __forceinline__ int src_col(int np) {
    if (np < 4096) return np;
    if (np < 7680) return np + 16;
    if (np < 7744) return 7696 + (np - 7680);
    if (np < 7752) return 4096 + (np - 7744);
    if (np < 7760) return 4104 + (np - 7752);
    if (np < 7776) return np;
    return -1;
}
__device__ __forceinline__ void phase0(const Params& p, unsigned char* smem) {
    const int tid = opaque_tid(), wid = tid >> 6, lane = tid & 63;
    const int gw = blockIdx.x * 8 + wid, nw = gridDim.x * 8;
    h16* H = (h16*)(p.ws + OFF_H); unsigned char* H8 = p.ws + OFF_H8;
    for (int row = 2 * gw; row < BT; row += 2 * nw) {
        const f32x4* xr0 = (const f32x4*)(p.x + (size_t)row * DM); const f32x4* xr1 = xr0 + DM / 4;
        f32x4 v0[8], v1[8]; float s0 = 0.f, s1 = 0.f;
#pragma unroll
        for (int i = 0; i < 8; ++i) { v0[i] = xr0[lane + 64 * i]; v1[i] = xr1[lane + 64 * i]; }
#pragma unroll
        for (int i = 0; i < 8; ++i) { s0 += (v0[i][0] * v0[i][0] + v0[i][1] * v0[i][1]) + (v0[i][2] * v0[i][2] + v0[i][3] * v0[i][3]); s1 += (v1[i][0] * v1[i][0] + v1[i][1] * v1[i][1]) + (v1[i][2] * v1[i][2] + v1[i][3] * v1[i][3]); }
        s0 = wave_sum(s0); s1 = wave_sum(s1);
        const float r0 = __builtin_amdgcn_rsqf(s0 * (1.0f / DM) + EPS), r1 = __builtin_amdgcn_rsqf(s1 * (1.0f / DM) + EPS);
#pragma unroll
        for (int i = 0; i < 8; ++i) { const f32x4 g = ((const f32x4*)p.attn_g)[lane + 64 * i]; h16x4 o0, o1;
#pragma unroll
            for (int j = 0; j < 4; ++j) { o0[j] = (h16)(v0[i][j] * r0 * g[j]); o1[j] = (h16)(v1[i][j] * r1 * g[j]); }
            *(h16x4*)(H + (size_t)row * DM + 4 * (lane + 64 * i)) = o0; *(h16x4*)(H + (size_t)(row + 1) * DM + 4 * (lane + 64 * i)) = o1;
            int e0 = 0, e1 = 0;
            e0 = __builtin_amdgcn_cvt_pk_fp8_f32(v0[i][0] * r0 * g[0], v0[i][1] * r0 * g[1], e0, false); e0 = __builtin_amdgcn_cvt_pk_fp8_f32(v0[i][2] * r0 * g[2], v0[i][3] * r0 * g[3], e0, true);
            e1 = __builtin_amdgcn_cvt_pk_fp8_f32(v1[i][0] * r1 * g[0], v1[i][1] * r1 * g[1], e1, false); e1 = __builtin_amdgcn_cvt_pk_fp8_f32(v1[i][2] * r1 * g[2], v1[i][3] * r1 * g[3], e1, true);
            *(int*)(H8 + (size_t)row * DM + 4 * (lane + 64 * i)) = e0; *(int*)(H8 + (size_t)(row + 1) * DM + 4 * (lane + 64 * i)) = e1; }
    }
    {
        float* tiles = (float*)smem;
        h16* Wt = (h16*)(p.ws + OFF_WT); h16* WoT = (h16*)(p.ws + OFF_WOT);
        constexpr int NT1 = 124 * 32, NTT = NT1 + 32 * 32;
        const int nl_r = tid & 63, kl_r = tid >> 6, nl_w = tid >> 3, kc_w = tid & 7;
        float va[8], vb[8];
#define P0_LOAD(tI, v) do { if ((tI) < NT1) { const int n0_ = ((tI) / 32) * 64, k0_ = ((tI) % 32) * 64; const int src_ = src_col(n0_ + nl_r); \
            _Pragma("unroll") for (int i = 0; i < 8; ++i) v[i] = src_ >= 0 ? p.w_in[(size_t)(k0_ + kl_r + 8 * i) * IN_COLS + src_] : 0.f; } \
          else { const int t2_ = (tI) - NT1; const int n0_ = (t2_ / 32) * 64, k0_ = (t2_ % 32) * 64; \
            _Pragma("unroll") for (int i = 0; i < 8; ++i) v[i] = p.w_out[(size_t)(k0_ + kl_r + 8 * i) * DM + n0_ + nl_r]; } } while (0)
#define P0_PUT(buf, v) do { float* t_ = tiles + (buf) * (64 * 65); _Pragma("unroll") for (int i = 0; i < 8; ++i) t_[(kl_r + 8 * i) * 65 + nl_r] = v[i]; } while (0)
#define P0_STORE(buf, tI) do { const float* t_ = tiles + (buf) * (64 * 65); h16x8 o_; _Pragma("unroll") for (int j = 0; j < 8; ++j) o_[j] = (h16)t_[(8 * kc_w + j) * 65 + nl_w]; \
          if ((tI) < NT1) { const int n0_ = ((tI) / 32) * 64, k0_ = ((tI) % 32) * 64; \
              if (n0_ >= 4096 && n0_ < 6656) { int e0_ = 0, e1_ = 0; e0_ = __builtin_amdgcn_cvt_pk_fp8_f32(64.f * (float)o_[0], 64.f * (float)o_[1], e0_, false); e0_ = __builtin_amdgcn_cvt_pk_fp8_f32(64.f * (float)o_[2], 64.f * (float)o_[3], e0_, true); \
                  e1_ = __builtin_amdgcn_cvt_pk_fp8_f32(64.f * (float)o_[4], 64.f * (float)o_[5], e1_, false); e1_ = __builtin_amdgcn_cvt_pk_fp8_f32(64.f * (float)o_[6], 64.f * (float)o_[7], e1_, true); \
                  typedef int i32x2w __attribute__((ext_vector_type(2))); *(i32x2w*)(p.ws + OFF_WT8 + (size_t)(n0_ - 4096 + nl_w) * 2048 + k0_ + 8 * kc_w) = (i32x2w){e0_, e1_}; } \
              else *(h16x8*)(Wt + (size_t)(n0_ + nl_w) * 2048 + k0_ + 8 * kc_w) = o_; } \
          else { const int t2_ = (tI) - NT1; const int n0_ = (t2_ / 32) * 64, k0_ = (t2_ % 32) * 64; *(h16x8*)(WoT + (size_t)(n0_ + nl_w) * 2048 + k0_ + 8 * kc_w) = o_; } } while (0)
        int tI = blockIdx.x; int buf = 0;
        __syncthreads();
        if (tI < NTT) { P0_LOAD(tI, va); P0_PUT(0, va); }
        while (tI < NTT) {
            const int tn = tI + gridDim.x;
            if (tn < NTT) P0_LOAD(tn, vb);
            __syncthreads();
            P0_STORE(buf, tI);
            if (tn < NTT) P0_PUT(buf ^ 1, vb);
            buf ^= 1; tI = tn;
        }
#undef P0_LOAD
#undef P0_PUT
#undef P0_STORE
    }
}

__device__ __forceinline__ h16x8 pack8(const f32x4 a, const f32x4 c) { h16x8 o; o[0] = (h16)a[0]; o[1] = (h16)a[1]; o[2] = (h16)a[2]; o[3] = (h16)a[3]; o[4] = (h16)c[0]; o[5] = (h16)c[1]; o[6] = (h16)c[2]; o[7] = (h16)c[3]; return o; }
typedef short v4s_t __attribute__((__vector_size__(4 * sizeof(short))));
__device__ __forceinline__ h16x4 lds_tr16(const LAS unsigned char* a) { const v4s_t v = __builtin_amdgcn_ds_read_tr16_b64_v4i16((LAS v4s_t*)a); return __builtin_bit_cast(h16x4, v); }
constexpr int REC_BYTES = 74752, REC_WF = 0, REC_QF = 16384, REC_AF = 32768, REC_KTF = 40960, REC_VEC = 57344, REC_UF = 58368, REC_DMA = 58368;
constexpr int HB_BYTES = 69632;

__device__ __forceinline__ void gdn_prep_pair(const Params& p, unsigned char* smem, int pair) {
    const int tid = opaque_tid(), wid = __builtin_amdgcn_readfirstlane(tid >> 6), lane = tid & 63, hb = wid >> 2, w4 = wid & 3, tl = tid & 255;
    const int tk = 2 * pair + hb; const int b = tk >> 9, h = (tk >> 6) & 7, n = tk & 63; const int t0 = n * 64;
    unsigned char* base = smem + hb * HB_BYTES;
    h16* Kn = (h16*)base; h16* Qn = Kn + 64 * 136; h16* Vh = Qn + 64 * 136; float* L = (float*)(Vh + 64 * 136); float* vec = L + 4096;
    unsigned char* rec = p.ws + OFF_REC + (size_t)tk * REC_BYTES;
    const h16* qkvr = (const h16*)(p.ws + OFF_QKVR);
    __syncthreads();
    {
        const int cg = tl & 15, rg = tl >> 4;
        h16x8 raw[3][7];
#pragma unroll
        for (int ti = 0; ti < 3; ++ti)
#pragma unroll
            for (int r = 0; r < 7; ++r) {
                const int trow = t0 + 4 * rg - 3 + r;
                if (trow >= 0) raw[ti][r] = *(const h16x8*)(qkvr + ((size_t)b * NT + trow) * 3072 + ti * 1024 + h * 128 + 8 * cg);
                else { for (int j = 0; j < 8; ++j) raw[ti][r][j] = (h16)0.f; }
            }
#pragma unroll
        for (int ti = 0; ti < 3; ++ti) {
            const int chan = ti * 1024 + h * 128 + 8 * cg;
            float xr[7][8];
#pragma unroll
            for (int r = 0; r < 7; ++r)
#pragma unroll
                for (int j = 0; j < 8; ++j) xr[r][j] = (float)raw[ti][r][j];
            float wv[4][8];
#pragma unroll
            for (int tp = 0; tp < 4; ++tp) { const f32x4 a = *(const f32x4*)(p.conv_w + (size_t)tp * 3072 + chan), c = *(const f32x4*)(p.conv_w + (size_t)tp * 3072 + chan + 4);
#pragma unroll
                for (int j = 0; j < 4; ++j) { wv[tp][j] = a[j]; wv[tp][4 + j] = c[j]; } }
            h16* dst = (ti == 0) ? Qn : (ti == 1 ? Kn : Vh);
#pragma unroll
            for (int r = 0; r < 4; ++r) {
                float y[8]; float ss = 0.f;
#pragma unroll
                for (int j = 0; j < 8; ++j) { float a = wv[0][j] * xr[r][j] + wv[1][j] * xr[r + 1][j] + wv[2][j] * xr[r + 2][j] + wv[3][j] * xr[r + 3][j]; a = silu_f(a); y[j] = a; ss += a * a; }
                float sc = 1.f;
                if (ti < 2) { ss += __shfl_xor(ss, 1); ss += __shfl_xor(ss, 2); ss += __shfl_xor(ss, 4); ss += __shfl_xor(ss, 8); sc = (ti == 0 ? 0.08838834764831845f : 1.0f) * __builtin_amdgcn_rsqf(ss + EPS); }
                h16x8 o;
#pragma unroll
                for (int j = 0; j < 8; ++j) o[j] = (h16)(y[j] * sc);
                *(h16x8*)(dst + (4 * rg + r) * 136 + 8 * cg) = o;
            }
        }
    }
    if (tl < 64) {
        const float* gb = (const float*)(p.ws + OFF_GB) + ((size_t)b * NT + t0 + tl) * 16;
        const float g = gb[h], be = gb[8 + h];
        float gc = g;
#pragma unroll
        for (int o = 1; o < 64; o <<= 1) { const float tt = __shfl_up(gc, o); if (lane >= o) gc += tt; }
        const float gl = __shfl(gc, 63);
        vec[tl] = g; vec[64 + tl] = be; vec[128 + tl] = gc; vec[192 + tl] = __expf(gc);
        float* rv = (float*)(rec + REC_VEC);
        rv[tl] = __expf(gc); rv[64 + tl] = __expf(gl - gc); if (tl == 0) rv[128] = __expf(gl);
    }
    __syncthreads();
    {
        const int rt = w4, fr = lane & 15, kg = lane >> 4;
        h16x8 Ak[4], Aq[4];
#pragma unroll
        for (int s = 0; s < 4; ++s) { Ak[s] = *(const h16x8*)(Kn + (16 * rt + fr) * 136 + 32 * s + 8 * kg); Aq[s] = *(const h16x8*)(Qn + (16 * rt + fr) * 136 + 32 * s + 8 * kg); }
        h16* AF = (h16*)(rec + REC_AF);
#pragma unroll
        for (int ct = 0; ct < 4; ++ct) {
            f32x4 kk = (f32x4){0.f, 0.f, 0.f, 0.f}, qk = (f32x4){0.f, 0.f, 0.f, 0.f};
#pragma unroll
            for (int s = 0; s < 4; ++s) { const h16x8 Bk = *(const h16x8*)(Kn + (16 * ct + fr) * 136 + 32 * s + 8 * kg);
                kk = __builtin_amdgcn_mfma_f32_16x16x32_f16(Ak[s], Bk, kk, 0, 0, 0); qk = __builtin_amdgcn_mfma_f32_16x16x32_f16(Aq[s], Bk, qk, 0, 0, 0); }
            const int j = 16 * ct + fr; const float gcj = vec[128 + j];
#pragma unroll
            for (int rgi = 0; rgi < 4; ++rgi) {
                const int i = 16 * rt + 4 * kg + rgi;
                const float dec = (i >= j) ? __expf(vec[128 + i] - gcj) : 0.f;
                L[i * 64 + j] = (i > j) ? vec[64 + i] * kk[rgi] * dec : 0.f;
                const int sp = ct >> 1, kgp = fr >> 2, j8 = (ct & 1) * 4 + (fr & 3), lanep = 16 * kgp + 4 * kg + rgi;
                AF[((rt * 2 + sp) * 64 + lanep) * 8 + j8] = (h16)(qk[rgi] * dec);
            }
        }
    }
    __syncthreads();
    h16* Tw = (h16*)L; h16* Tu = Tw + 4096;
    if (w4 == 0) {
        float X[64];
#pragma unroll
        for (int i = 0; i < 64; ++i) X[i] = 0.f;
        f32x4 Ln[16]; float rn = (lane == 0) ? 1.f : 0.f;
#pragma unroll
        for (int i = 0; i < 64; ++i) {
            f32x4 Lc[16]; const float rc = rn;
#pragma unroll
            for (int jj = 0; jj < (i + 3) / 4; ++jj) Lc[jj] = Ln[jj];
            if (i + 1 < 64) {
#pragma unroll
                for (int jj = 0; jj < (i + 4) / 4; ++jj) Ln[jj] = *(const f32x4*)(L + (i + 1) * 64 + 4 * jj);
                rn = (lane == i + 1) ? 1.f : 0.f;
            }
            float a0 = rc, a1 = 0.f, a2 = 0.f, a3 = 0.f;
#pragma unroll
            for (int jj = 0; jj < (i + 3) / 4; ++jj) { a0 -= Lc[jj][0] * X[4 * jj]; a1 -= Lc[jj][1] * X[4 * jj + 1]; a2 -= Lc[jj][2] * X[4 * jj + 2]; a3 -= Lc[jj][3] * X[4 * jj + 3]; }
            float acc = (a0 + a1) + (a2 + a3);
            asm volatile("" : "+v"(acc) :: "memory");
            X[i] = acc;
        }
        const float bu = vec[64 + lane], bw = bu * vec[192 + lane];
#pragma unroll
        for (int i = 0; i < 64; ++i) { const int pos = i * 64 + ((((lane >> 3) ^ (i & 7)) << 3) | (lane & 7)); Tw[pos] = (h16)(X[i] * bw); Tu[pos] = (h16)(X[i] * bu); }
    } else {
        const int t3 = tl - 64;
        h16* QF = (h16*)(rec + REC_QF);
        for (int f = t3; f < 1024; f += 192) { const int lanep = f & 63, s = (f >> 6) & 3, rt = f >> 8; const int row = 16 * rt + (lanep & 15), kgp = lanep >> 4;
            const h16x4 a = *(const h16x4*)(Qn + row * 136 + 32 * s + 4 * kgp), c = *(const h16x4*)(Qn + row * 136 + 32 * s + 16 + 4 * kgp);
            h16x8 o; o[0] = a[0]; o[1] = a[1]; o[2] = a[2]; o[3] = a[3]; o[4] = c[0]; o[5] = c[1]; o[6] = c[2]; o[7] = c[3];
            *(h16x8*)(QF + (size_t)f * 8) = o; }
        h16* KTF = (h16*)(rec + REC_KTF);
        for (int f = t3; f < 1024; f += 192) { const int lanep = f & 63, sp = (f >> 6) & 1, rt = f >> 7; const int d = 16 * rt + (lanep & 15), kgp = lanep >> 4;
            h16x8 o;
#pragma unroll
            for (int j8 = 0; j8 < 8; ++j8) { const int c = 32 * sp + (j8 < 4 ? 4 * kgp + j8 : 16 + 4 * kgp + (j8 - 4)); o[j8] = Kn[c * 136 + d]; }
            *(h16x8*)(KTF + (size_t)f * 8) = o; }
    }
    __syncthreads();
    {
        const int rt = w4, fr = lane & 15, kg = lane >> 4, q4 = fr >> 2, pp = fr & 3;
        const LAS unsigned char* Knl = (const LAS unsigned char*)Kn; const LAS unsigned char* Vl = (const LAS unsigned char*)Vh;
        const int trow = 16 * rt + fr;
        h16x8 Tuf[2], Twf[2];
#pragma unroll
        for (int s = 0; s < 2; ++s) { const int off = trow * 64 + ((((4 * s + kg) ^ (trow & 7))) << 3); Tuf[s] = *(const h16x8*)(Tu + off); Twf[s] = *(const h16x8*)(Tw + off); }
        h16* UF = (h16*)(rec + REC_UF);
#pragma unroll
        for (int dvb = 0; dvb < 8; ++dvb) {
            f32x4 acc = (f32x4){0.f, 0.f, 0.f, 0.f};
#pragma unroll
            for (int s = 0; s < 2; ++s) { const LAS unsigned char* a0 = Vl + ((32 * s + 8 * kg + q4) * 136 + 16 * dvb + 4 * pp) * 2;
                const h16x4 lo = lds_tr16(a0), hi4 = lds_tr16(a0 + 4 * 136 * 2);
                h16x8 Bv; Bv[0] = lo[0]; Bv[1] = lo[1]; Bv[2] = lo[2]; Bv[3] = lo[3]; Bv[4] = hi4[0]; Bv[5] = hi4[1]; Bv[6] = hi4[2]; Bv[7] = hi4[3];
                acc = __builtin_amdgcn_mfma_f32_16x16x32_f16(Tuf[s], Bv, acc, 0, 0, 0); }
            h16x4 o; o[0] = (h16)acc[0]; o[1] = (h16)acc[1]; o[2] = (h16)acc[2]; o[3] = (h16)acc[3];
            *(h16x4*)(UF + (size_t)((dvb * 4 + rt) * 64 + lane) * 4) = o;
        }
        h16* WF = (h16*)(rec + REC_WF);
#pragma unroll
        for (int so = 0; so < 4; ++so) {
            f32x4 c0 = (f32x4){0.f, 0.f, 0.f, 0.f}, c1 = (f32x4){0.f, 0.f, 0.f, 0.f};
#pragma unroll
            for (int s = 0; s < 2; ++s) {
                const LAS unsigned char* a0 = Knl + ((32 * s + 8 * kg + q4) * 136 + 16 * (2 * so) + 4 * pp) * 2;
                const h16x4 l0 = lds_tr16(a0), h0 = lds_tr16(a0 + 4 * 136 * 2), l1 = lds_tr16(a0 + 32), h1 = lds_tr16(a0 + 32 + 4 * 136 * 2);
                h16x8 A0, A1; A0[0] = l0[0]; A0[1] = l0[1]; A0[2] = l0[2]; A0[3] = l0[3]; A0[4] = h0[0]; A0[5] = h0[1]; A0[6] = h0[2]; A0[7] = h0[3];
                A1[0] = l1[0]; A1[1] = l1[1]; A1[2] = l1[2]; A1[3] = l1[3]; A1[4] = h1[0]; A1[5] = h1[1]; A1[6] = h1[2]; A1[7] = h1[3];
                c0 = __builtin_amdgcn_mfma_f32_16x16x32_f16(A0, Twf[s], c0, 0, 0, 0); c1 = __builtin_amdgcn_mfma_f32_16x16x32_f16(A1, Twf[s], c1, 0, 0, 0);
            }
            *(h16x8*)(WF + (size_t)((rt * 4 + so) * 64 + lane) * 8) = pack8(-c0, -c1);
        }
    }
}

__device__ __forceinline__ void gdn_scan_task(const Params& p, unsigned char* smem, int bh) {
    const int tid = opaque_tid(), wid = __builtin_amdgcn_readfirstlane(tid >> 6), lane = tid & 63, kg = lane >> 4, fr = lane & 15;
    const int b = bh >> 3, h = bh & 7;
    LAS unsigned char* lds = (LAS unsigned char*)smem;
    const unsigned char* rec0 = p.ws + OFF_REC + (size_t)(bh * 64) * REC_BYTES;
    h16* OB = (h16*)(smem + 2 * REC_DMA);
    const h16* gz = (const h16*)(p.ws + OFF_GZ); h16* omix = (h16*)(p.ws + OFF_OMIX);
    f32x4 Sacc[8];
#pragma unroll
    for (int t = 0; t < 8; ++t) Sacc[t] = (f32x4){0.f, 0.f, 0.f, 0.f};
    h16x4 Uc[4], Un[4];
    __syncthreads();
#define GDN_GLDS(recp, bufi) do { _Pragma("unroll") for (int _i = 0; _i < 7; ++_i) \
        __builtin_amdgcn_global_load_lds((const unsigned*)((recp) + (size_t)(_i * 512 + tid) * 16), (LAS unsigned*)(lds + (bufi) * REC_DMA + (_i * 512 + wid * 64) * 16), 16, 0, 0); \
        if (wid == 0) __builtin_amdgcn_global_load_lds((const unsigned*)((recp) + (size_t)(7 * 512 + tid) * 16), (LAS unsigned*)(lds + (bufi) * REC_DMA + (7 * 512) * 16), 16, 0, 0); } while (0)
#define GDN_LDREG(recp, U_) do { _Pragma("unroll") for (int rt = 0; rt < 4; ++rt) U_[rt] = *(const h16x4*)((recp) + REC_UF + (size_t)((wid * 4 + rt) * 64 + lane) * 8); } while (0)
#define GDN_LDGZ(dst, chunk) do { const h16* gp_ = gz + ((size_t)b * NT + 64 * (chunk) + prow) * 1024 + h * 128 + 16 * pseg; dst[0] = *(const h16x8*)gp_; dst[1] = *(const h16x8*)(gp_ + 8); } while (0)
#define GDN_POST(chunk, gzv) do { const h16* Ob = OB + ((chunk) & 1) * 8192 + prow * 128 + 16 * pseg; const h16x8 a0 = *(const h16x8*)Ob, a1 = *(const h16x8*)(Ob + 8); \
        float ngv[16]; _Pragma("unroll") for (int j = 0; j < 4; ++j) { const f32x4 t4 = *(const f32x4*)(ngl + 16 * pseg + 4 * j); ngv[4 * j] = t4[0]; ngv[4 * j + 1] = t4[1]; ngv[4 * j + 2] = t4[2]; ngv[4 * j + 3] = t4[3]; } \
        float ss = 0.f; _Pragma("unroll") for (int j = 0; j < 8; ++j) { const float u0 = (float)a0[j], u1 = (float)a1[j]; ss += u0 * u0 + u1 * u1; } \
        ss += __shfl_xor(ss, 1); ss += __shfl_xor(ss, 2); ss += __shfl_xor(ss, 4); const float r = __builtin_amdgcn_rsqf(ss * (1.0f / 128.0f) + EPS); \
        h16x8 o0, o1; _Pragma("unroll") for (int j = 0; j < 8; ++j) { o0[j] = (h16)((float)a0[j] * r * ngv[j] * (float)gzv[0][j]); o1[j] = (h16)((float)a1[j] * r * ngv[8 + j] * (float)gzv[1][j]); } \
        h16* op_ = omix + ((size_t)b * NT + 64 * (chunk) + prow) * 2048 + h * 128 + 16 * pseg; *(h16x8*)op_ = o0; *(h16x8*)(op_ + 8) = o1; } while (0)
#define GDN_RD8(X, off0) do { _Pragma("unroll") for (int _j = 0; _j < 8; ++_j) X[_j] = *(const LAS h16x8*)(bufp + (off0) + (_j * 64 + lane) * 16); } while (0)
#define GDN_SB __builtin_amdgcn_sched_barrier(0)
    h16x8 gzp[2], gzn[2];
    const int prow = tid >> 3, pseg = tid & 7;
    float* ngl = (float*)(smem + 2 * REC_DMA + 32768);
    if (tid < 128) ngl[tid] = p.gdn_norm_g[tid];
    GDN_GLDS(rec0, 0);
    GDN_LDREG(rec0, Uc);
    asm volatile("s_waitcnt vmcnt(0)" ::: "memory");
    __syncthreads();
    for (int n = 0; n < 64; ++n) {
        const unsigned char* recn = rec0 + (size_t)(n + 1) * REC_BYTES;
        if (n + 1 < 64) { GDN_GLDS(recn, (n + 1) & 1); GDN_LDREG(recn, Un); }
        GDN_LDGZ(gzn, n);
        if (n > 0) GDN_POST(n - 1, gzp);
        const LAS unsigned char* bufp = lds + (n & 1) * REC_DMA;
        h16x8 X[8], Y[8];
        GDN_RD8(X, REC_WF);
        h16x8 SB[4];
#pragma unroll
        for (int s = 0; s < 4; ++s) SB[s] = pack8(Sacc[2 * s], Sacc[2 * s + 1]);
        f32x4 vacc[4], oacc[4];
#pragma unroll
        for (int rt = 0; rt < 4; ++rt) { vacc[rt] = (f32x4){(float)Uc[rt][0], (float)Uc[rt][1], (float)Uc[rt][2], (float)Uc[rt][3]}; oacc[rt] = (f32x4){0.f, 0.f, 0.f, 0.f}; }
        GDN_SB;
        GDN_RD8(Y, REC_WF + 8192);
#pragma unroll
        for (int j = 0; j < 8; ++j) vacc[j >> 2] = __builtin_amdgcn_mfma_f32_16x16x32_f16(X[j], SB[j & 3], vacc[j >> 2], 0, 0, 0);
        GDN_SB;
        GDN_RD8(X, REC_QF);
#pragma unroll
        for (int j = 0; j < 8; ++j) vacc[2 + (j >> 2)] = __builtin_amdgcn_mfma_f32_16x16x32_f16(Y[j], SB[j & 3], vacc[2 + (j >> 2)], 0, 0, 0);
        GDN_SB;
        GDN_RD8(Y, REC_QF + 8192);
        f32x4 ekv[4], egv[4];
#pragma unroll
        for (int rt = 0; rt < 4; ++rt) { ekv[rt] = *(const LAS f32x4*)(bufp + REC_VEC + 256 + (16 * rt + 4 * kg) * 4); egv[rt] = *(const LAS f32x4*)(bufp + REC_VEC + (16 * rt + 4 * kg) * 4); }
        const float eglc = *(const LAS float*)(bufp + REC_VEC + 512);
#pragma unroll
        for (int j = 0; j < 8; ++j) oacc[j >> 2] = __builtin_amdgcn_mfma_f32_16x16x32_f16(X[j], SB[j & 3], oacc[j >> 2], 0, 0, 0);
        GDN_SB;
        GDN_RD8(X, REC_KTF);
        h16x8 VB[2], VKB[2];
#pragma unroll
        for (int sp = 0; sp < 2; ++sp) { VB[sp] = pack8(vacc[2 * sp], vacc[2 * sp + 1]); VKB[sp] = pack8(vacc[2 * sp] * ekv[2 * sp], vacc[2 * sp + 1] * ekv[2 * sp + 1]); }
#pragma unroll
        for (int j = 0; j < 8; ++j) oacc[2 + (j >> 2)] = __builtin_amdgcn_mfma_f32_16x16x32_f16(Y[j], SB[j & 3], oacc[2 + (j >> 2)], 0, 0, 0);
        GDN_SB;
        GDN_RD8(Y, REC_KTF + 8192);
#pragma unroll
        for (int t = 0; t < 8; ++t) Sacc[t] = Sacc[t] * eglc;
#pragma unroll
        for (int j = 0; j < 8; ++j) Sacc[j >> 1] = __builtin_amdgcn_mfma_f32_16x16x32_f16(X[j], VKB[j & 1], Sacc[j >> 1], 0, 0, 0);
        GDN_SB;
        GDN_RD8(X, REC_AF);
#pragma unroll
        for (int rt = 0; rt < 4; ++rt) oacc[rt] = oacc[rt] * egv[rt];
#pragma unroll
        for (int j = 0; j < 8; ++j) Sacc[4 + (j >> 1)] = __builtin_amdgcn_mfma_f32_16x16x32_f16(Y[j], VKB[j & 1], Sacc[4 + (j >> 1)], 0, 0, 0);
        GDN_SB;
#pragma unroll
        for (int j = 0; j < 8; ++j) oacc[j >> 1] = __builtin_amdgcn_mfma_f32_16x16x32_f16(X[j], VB[j & 1], oacc[j >> 1], 0, 0, 0);
        { h16* Ob = OB + (n & 1) * 8192;
#pragma unroll
          for (int rt = 0; rt < 4; ++rt)
#pragma unroll
              for (int rgi = 0; rgi < 4; ++rgi) Ob[(16 * rt + 4 * kg + rgi) * 128 + 16 * wid + fr] = (h16)oacc[rt][rgi]; }
        asm volatile("s_waitcnt vmcnt(0)" ::: "memory");
        __syncthreads();
#pragma unroll
        for (int rt = 0; rt < 4; ++rt) Uc[rt] = Un[rt];
        gzp[0] = gzn[0]; gzp[1] = gzn[1];
    }
    GDN_POST(63, gzp);
#undef GDN_LDGZ
#undef GDN_POST
#undef GDN_RD8
#undef GDN_SB
#undef GDN_GLDS
#undef GDN_LDREG
}

__device__ __forceinline__ unsigned f2key(float x) { const unsigned u = __float_as_uint(x); return (u & 0x80000000u) ? ~u : (u | 0x80000000u); }
typedef float f32x16 __attribute__((ext_vector_type(16)));
__device__ __forceinline__ float wave_min(float v) {
#pragma unroll
    for (int o = 1; o < 64; o <<= 1) v = fminf(v, __shfl_xor(v, o));
    return v;
}
__device__ __forceinline__ unsigned lane_below(unsigned long long m) { return __builtin_amdgcn_mbcnt_hi((unsigned)(m >> 32), __builtin_amdgcn_mbcnt_lo((unsigned)m, 0u)); }
__device__ __forceinline__ void idx8_task(const Params& p, unsigned char* smem, int b, int qb) {
    const int tid = opaque_tid(), wid = __builtin_amdgcn_readfirstlane(tid >> 6), lane = tid & 63;
    const int t0 = qb * 8;
    unsigned short* selg = (unsigned short*)(p.ws + OFF_SEL) + ((size_t)b * NT + t0) * 256;
    if (t0 + 8 <= 256) {
        for (int i = tid; i < 8 * 256; i += 512) { const int q = i >> 8, k = i & 255; selg[i] = (unsigned short)(k <= t0 + q ? k : 0); }
        return;
    }
    float* sc = (float*)smem;
    ACC_T0();
    unsigned* hist = (unsigned*)(smem + 131072 + wid * 2560);
    unsigned* cand = hist + 256;
    __syncthreads();
    {
        const int n8 = t0 + 8;
        const int ntile = (n8 + 31) >> 5, ntile_pad = ((n8 + 255) >> 8) << 3;
        const h16* iq = (const h16*)(p.ws + OFF_IQ) + ((size_t)b * NT + t0) * 1024;
        const float* iw = (const float*)(p.ws + OFF_IW) + ((size_t)b * NT + t0) * 16;
        const h16* ik = (const h16*)(p.ws + OFF_IK) + (size_t)b * NT * 64;
        const int r = lane & 31, kh = lane >> 5, qq = (r >> 2) & 1, hh = (r & 3) + 4 * (r >> 3);
        h16x8 Af[4][4]; h16x2 Wp[4][8];
#pragma unroll
        for (int a = 0; a < 4; ++a) {
#pragma unroll
            for (int s = 0; s < 4; ++s) Af[a][s] = *(const h16x8*)(iq + (size_t)(2 * a + qq) * 1024 + hh * 64 + 16 * s + 8 * kh);
#pragma unroll
            for (int c = 0; c < 4; ++c) { const f32x4 w4 = *(const f32x4*)(iw + (size_t)(2 * a + kh) * 16 + 4 * c);
                Wp[a][2 * c] = (h16x2){(h16)w4[0], (h16)w4[1]}; Wp[a][2 * c + 1] = (h16x2){(h16)w4[2], (h16)w4[3]}; }
        }
#define IDX_LOADB(Bx, ti) do { const int tc_ = (ti) < ntile ? (ti) : ntile - 1;     \
            _Pragma("unroll") for (int s = 0; s < 4; ++s) Bx[s] = *(const h16x8*)(ik + (size_t)tc_ * 2048 + s * 512 + kh * 256 + r * 8); } while (0)
#define IDX_COMP(Bx, ti) do { if ((ti) < ntile) { const int key = 32 * (ti) + r; f32x16 accs[4]; \
            _Pragma("unroll") for (int a = 0; a < 4; ++a) { _Pragma("unroll") for (int e = 0; e < 16; ++e) accs[a][e] = 0.f; \
                _Pragma("unroll") for (int s = 0; s < 4; ++s) accs[a] = __builtin_amdgcn_mfma_f32_32x32x16_f16(Af[a][s], Bx[s], accs[a], 0, 0, 0); } \
            __builtin_amdgcn_sched_barrier(0); \
            _Pragma("unroll") for (int a = 0; a < 4; ++a) { \
                float s0 = 0.f, s1 = 0.f; _Pragma("unroll") for (int e = 0; e < 8; e += 2) { h16x2 rp = (h16x2){(h16)accs[a][2 * e], (h16)accs[a][2 * e + 1]}; rp = __builtin_elementwise_max(rp, (h16x2){(h16)0.f, (h16)0.f}); s0 = __builtin_amdgcn_fdot2(rp, Wp[a][e], s0, false); \
                    h16x2 rq = (h16x2){(h16)accs[a][2 * e + 2], (h16)accs[a][2 * e + 3]}; rq = __builtin_elementwise_max(rq, (h16x2){(h16)0.f, (h16)0.f}); s1 = __builtin_amdgcn_fdot2(rq, Wp[a][e + 1], s1, false); } \
                const int q = 2 * a + kh; sc[q * 4096 + key] = (key > t0 + q) ? -INFINITY : (s0 + s1); } } } while (0)
        {
            h16x8 B0[4], B1[4], B2[4];
            IDX_LOADB(B0, wid); IDX_LOADB(B1, wid + 8);
            for (int i = wid; i < ntile; i += 24) {
                IDX_LOADB(B2, i + 16); IDX_COMP(B0, i);
                IDX_LOADB(B0, i + 24); IDX_COMP(B1, i + 8);
                IDX_LOADB(B1, i + 32); IDX_COMP(B2, i + 16);
            }
            for (int i = ntile + wid; i < ntile_pad; i += 8) {
#pragma unroll
                for (int a = 0; a < 4; ++a) sc[(2 * a + kh) * 4096 + 32 * i + r] = -INFINITY;
            }
        }
#undef IDX_LOADB
#undef IDX_COMP
    }
    __syncthreads();
    ACC_ADD(1);
    {
        const int tq = t0 + wid, n = tq + 1;
        const float* row = sc + wid * 4096;
        const int ng = (n + 255) >> 8;
        f32x4 x[16];
#pragma unroll
        for (int g = 0; g < 16; ++g) { if (g < ng) x[g] = *(const f32x4*)(row + 256 * g + 4 * lane); else x[g] = (f32x4){-INFINITY, -INFINITY, -INFINITY, -INFINITY}; }
        float hi = -INFINITY, lo = INFINITY;
#pragma unroll
        for (int g = 0; g < 16; ++g)
#pragma unroll
            for (int c = 0; c < 4; ++c) { const float v = x[g][c]; hi = fmaxf(hi, v); lo = fminf(lo, v == -INFINITY ? INFINITY : v); }
        hi = wave_max(hi); lo = wave_min(lo);
        const float scale = (hi > lo) ? 255.99f / (hi - lo) : 0.f; const float off = -lo * scale;
        *(u32x4*)(hist + 4 * lane) = (u32x4){0u, 0u, 0u, 0u};
#pragma unroll
        for (int g = 0; g < 16; ++g) { if (g < ng) {
#pragma unroll
            for (int c = 0; c < 4; ++c) { int bin = (int)fmaf(x[g][c], scale, off); bin = bin < 0 ? 0 : (bin > 255 ? 255 : bin); atomicAdd(&hist[bin], 1u); } } }
        unsigned bstar, need;
        {
            const u32x4 h4 = *(const u32x4*)(hist + 4 * lane); const unsigned s = h4[0] + h4[1] + h4[2] + h4[3];
            unsigned suf = s;
#pragma unroll
            for (int o = 1; o < 64; o <<= 1) { const unsigned tt = __shfl_down(suf, o); if (lane + o < 64) suf += tt; }
            const unsigned above = suf - s;
            const bool mine = (above < 256u && 256u <= suf);
            unsigned cum = above; unsigned bin = 0;
            if (cum + h4[3] >= 256u) bin = 3; else { cum += h4[3]; if (cum + h4[2] >= 256u) bin = 2; else { cum += h4[2]; if (cum + h4[1] >= 256u) bin = 1; else { cum += h4[1]; bin = 0; } } }
            const unsigned long long mm = __ballot(mine);
            const int src = (int)__builtin_ctzll(mm);
            bstar = (unsigned)__shfl((int)(4 * lane + bin), src); need = (unsigned)__shfl((int)(256u - cum), src);
        }
        unsigned short* so = selg + (size_t)wid * 256;
        unsigned short* cidx = (unsigned short*)(cand + 256);
        unsigned m = 0, outb = 0;
#pragma unroll
        for (int g = 0; g < 16; ++g) { if (g < ng) {
#pragma unroll
            for (int c = 0; c < 4; ++c) { int bin = (int)fmaf(x[g][c], scale, off); bin = bin < 0 ? 0 : (bin > 255 ? 255 : bin);
                const bool gt = ((unsigned)bin > bstar), pr = ((unsigned)bin == bstar);
                const unsigned long long mg = __ballot(gt), mk = __ballot(pr);
                if (mg) { const unsigned pos = outb + lane_below(mg); if (gt) so[pos] = (unsigned short)(256 * g + 4 * lane + c); outb += (unsigned)__builtin_popcountll(mg); }
                if (mk) { const unsigned pos = m + lane_below(mk); if (pr && pos < 256u) { cand[pos] = f2key(x[g][c]); cidx[pos] = (unsigned short)(256 * g + 4 * lane + c); } m += (unsigned)__builtin_popcountll(mk); } } } }
        unsigned Kt = 0, rr = need;
        if (m <= 256u) {
            const int nc = (int)((m + 63u) >> 6);
            unsigned cv[4]; unsigned short ci[4];
#pragma unroll
            for (int j = 0; j < 4; ++j) { const bool in = (64 * j + lane < (int)m); cv[j] = in ? cand[64 * j + lane] : 0u; ci[j] = in ? cidx[64 * j + lane] : (unsigned short)0; }
            for (int bit = 31; bit >= 0; --bit) {
                const unsigned test = (Kt | (1u << bit)) >> bit;
                unsigned cnt = (unsigned)__builtin_popcountll(__ballot((cv[0] >> bit) == test));
                if (nc > 1) cnt += (unsigned)__builtin_popcountll(__ballot((cv[1] >> bit) == test));
                if (nc > 2) cnt += (unsigned)__builtin_popcountll(__ballot((cv[2] >> bit) == test));
                if (nc > 3) cnt += (unsigned)__builtin_popcountll(__ballot((cv[3] >> bit) == test));
                if (cnt >= rr) Kt |= (1u << bit); else rr -= cnt;
            }
            unsigned eqb = 0;
#pragma unroll
            for (int j = 0; j < 4; ++j) { if (j < nc) { const bool in = (64 * j + lane < (int)m); const bool gt = in && cv[j] > Kt, eq = in && cv[j] == Kt;
                const unsigned long long me = __ballot(eq); bool take = gt;
                if (me) { const unsigned er = eqb + lane_below(me); take = gt || (eq && er < rr); eqb += (unsigned)__builtin_popcountll(me); }
                const unsigned long long mt = __ballot(take);
                if (mt) { const unsigned pos = outb + lane_below(mt); if (take) so[pos] = ci[j]; outb += (unsigned)__builtin_popcountll(mt); } } }
        } else {
            for (int bit = 31; bit >= 0; --bit) {
                const unsigned test = (Kt | (1u << bit)) >> bit; unsigned cnt = 0;
                for (int idx = lane; idx < ng * 256; idx += 64) { const float v = row[idx]; int bin = (int)fmaf(v, scale, off); bin = bin < 0 ? 0 : (bin > 255 ? 255 : bin);
                    const bool pr = ((unsigned)bin == bstar) && ((f2key(v) >> bit) == test); cnt += (unsigned)__builtin_popcountll(__ballot(pr)); }
                if (cnt >= rr) Kt |= (1u << bit); else rr -= cnt;
            }
            unsigned eqb = 0;
            for (int idx = lane; idx < ng * 256; idx += 64) { const float v = row[idx]; int bin = (int)fmaf(v, scale, off); bin = bin < 0 ? 0 : (bin > 255 ? 255 : bin);
                const unsigned k = f2key(v); const bool inb = ((unsigned)bin == bstar); const bool gt = inb && k > Kt, eq = inb && k == Kt;
                const unsigned long long me = __ballot(eq); bool take = gt;
                if (me) { const unsigned er = eqb + lane_below(me); take = gt || (eq && er < rr); eqb += (unsigned)__builtin_popcountll(me); }
                const unsigned long long mt = __ballot(take);
                if (mt) { const unsigned pos = outb + lane_below(mt); if (take) so[pos] = (unsigned short)idx; outb += (unsigned)__builtin_popcountll(mt); } }
        }
    }
    __syncthreads();
    ACC_ADD(2);
}

typedef unsigned short u16x4 __attribute__((ext_vector_type(4)));
typedef unsigned short u16x8 __attribute__((ext_vector_type(8)));
__device__ __forceinline__ void attn8_task(const Params& p, unsigned char* smem, int part, int o) {
    const int tid = opaque_tid(), wid = __builtin_amdgcn_readfirstlane(tid >> 6), lane = tid & 63, kg = lane >> 4, fr = lane & 15;
    const int b = part >> 1, g = part & 1;
    unsigned char* vl = smem + wid * 17408;
    LAS unsigned char* vll = (LAS unsigned char*)vl;
    const char* akb = (const char*)(p.ws + OFF_AK) + (size_t)b * NT * 256 + g * 128;
    const char* avb = (const char*)(p.ws + OFF_AV) + (size_t)b * NT * 256 + g * 128;
    typedef long i64x2 __attribute__((ext_vector_type(2)));
    constexpr int NQW = 1;
    const int tq0 = 8 * NQW * o + NQW * wid;
    u16x4 kix[4], kixn[4];
#define AT_LOADI(tt, KI) do { const unsigned short* sel_ = (const unsigned short*)(p.ws + OFF_SEL) + ((size_t)b * NT + (tt)) * 256; \
        _Pragma("unroll") for (int c = 0; c < 4; ++c) KI[c] = *(const u16x4*)(sel_ + 64 * c + 4 * fr); } while (0)
    AT_LOADI(tq0, kix);
#pragma unroll 1
    for (int qi = 0; qi < NQW; ++qi) {
    const int t = tq0 + qi; const int bt = b * NT + t; const int nvalid = (t + 1) < 256 ? (t + 1) : 256;
    const unsigned short* sel = (const unsigned short*)(p.ws + OFF_SEL) + (size_t)bt * 256;
    long Qf[4];
    { const char* qp_ = (const char*)(p.ws + OFF_AQ) + (size_t)bt * 1024 + (4 * g + (fr & 3)) * 128 + kg * 32; const i64x2 q0 = *(const i64x2*)qp_, q1 = *(const i64x2*)(qp_ + 16);
      Qf[0] = fr < 4 ? q0[0] : 0l; Qf[1] = fr < 4 ? q0[1] : 0l; Qf[2] = fr < 4 ? q1[0] : 0l; Qf[3] = fr < 4 ? q1[1] : 0l; }
    f32x4 lg[16];
#define AT_LOADK(Kx, c) do { _Pragma("unroll") for (int ii = 0; ii < 4; ++ii) { const char* kp = akb + (unsigned)kix[c][ii] * 256u + 32u * (unsigned)kg; \
        const i64x2 t0 = *(const i64x2*)kp, t1 = *(const i64x2*)(kp + 16); Kx[ii][0] = t0[0]; Kx[ii][1] = t0[1]; Kx[ii][2] = t1[0]; Kx[ii][3] = t1[1]; } } while (0)
#define AT_MMAK(Kx, c) do { _Pragma("unroll") for (int ii = 0; ii < 4; ++ii) { f32x4 a = (f32x4){0.f, 0.f, 0.f, 0.f}; \
        _Pragma("unroll") for (int s = 0; s < 4; ++s) a = __builtin_amdgcn_mfma_f32_16x16x32_fp8_fp8(Kx[ii][s], Qf[s], a, 0, 0, 0); lg[4 * (c) + ii] = a; } } while (0)
#define AT_LOADV(Vx, c) do { const u16x8 i0 = *(const u16x8*)(sel + 64 * (c) + 8 * (lane >> 3)); \
        _Pragma("unroll") for (int it = 0; it < 8; ++it) Vx[it] = *(const u32x4*)(avb + (unsigned)i0[it] * 256u + 16u * (unsigned)(lane & 7)); } while (0)
    u32x4 VA[8], VB[8];
    {
        long K0[4][4], K1[4][4], K2[4][4];
        AT_LOADK(K0, 0); AT_LOADK(K1, 1); AT_LOADK(K2, 2);
        AT_MMAK(K0, 0); AT_LOADK(K0, 3);
        AT_MMAK(K1, 1); AT_LOADV(VA, 0);
        AT_MMAK(K2, 2);
        AT_MMAK(K0, 3);
    }
#define DPP_F(oldv, srcv, ctrl, bank) __builtin_bit_cast(float, __builtin_amdgcn_update_dpp(__builtin_bit_cast(int, (float)(oldv)), __builtin_bit_cast(int, (float)(srcv)), (ctrl), 0xF, (bank), false))
    float val[4][4];
#pragma unroll
    for (int ii = 0; ii < 4; ++ii)
#pragma unroll
        for (int r = 0; r < 4; ++r) { float v = lg[ii][r];
            v = DPP_F(v, lg[4 + ii][r], 0x114, 0x2); v = DPP_F(v, lg[8 + ii][r], 0x118, 0x4); v = DPP_F(v, lg[12 + ii][r], 0x11C, 0x8); val[ii][r] = v; }
    const int cj = fr >> 2;
    float m = -INFINITY;
#pragma unroll
    for (int ii = 0; ii < 4; ++ii)
#pragma unroll
        for (int r = 0; r < 4; ++r) { const int slot = 64 * cj + 16 * kg + 4 * r + ii; const float v = (slot < nvalid) ? val[ii][r] * (0.08838834764831845f * 1.4426950408889634f) : -INFINITY; val[ii][r] = v; m = fmaxf(m, v); }
    m = fmaxf(m, __shfl_xor(m, 4)); m = fmaxf(m, __shfl_xor(m, 8)); m = fmaxf(m, __shfl_xor(m, 16)); m = fmaxf(m, __shfl_xor(m, 32));
    float sum = 0.f;
#pragma unroll
    for (int ii = 0; ii < 4; ++ii)
#pragma unroll
        for (int r = 0; r < 4; ++r) { const float e = __builtin_amdgcn_exp2f(val[ii][r] - m); val[ii][r] = e; sum += e; }
    sum += __shfl_xor(sum, 4); sum += __shfl_xor(sum, 8); sum += __shfl_xor(sum, 16); sum += __shfl_xor(sum, 32);
    const float pscale = __builtin_amdgcn_rcpf(sum) * 256.0f;
    int pl[2][2];
#pragma unroll
    for (int ipl = 0; ipl < 2; ++ipl) { int w0 = 0, w1 = 0;
        w0 = __builtin_amdgcn_cvt_pk_fp8_f32(val[2 * ipl][0] * pscale, val[2 * ipl][1] * pscale, w0, false); w0 = __builtin_amdgcn_cvt_pk_fp8_f32(val[2 * ipl][2] * pscale, val[2 * ipl][3] * pscale, w0, true);
        w1 = __builtin_amdgcn_cvt_pk_fp8_f32(val[2 * ipl + 1][0] * pscale, val[2 * ipl + 1][1] * pscale, w1, false); w1 = __builtin_amdgcn_cvt_pk_fp8_f32(val[2 * ipl + 1][2] * pscale, val[2 * ipl + 1][3] * pscale, w1, true);
        pl[ipl][0] = w0; pl[ipl][1] = w1; }
    long Pf[8];
#pragma unroll
    for (int ipl = 0; ipl < 2; ++ipl) {
        Pf[ipl] = (long)(((unsigned long long)(unsigned)pl[ipl][1] << 32) | (unsigned long long)(unsigned)pl[ipl][0]);
#define PF_GATHER(c, ctrl) do { const int lo_ = __builtin_amdgcn_update_dpp(0, pl[ipl][0], ctrl, 0xF, 0x1, false), hi_ = __builtin_amdgcn_update_dpp(0, pl[ipl][1], ctrl, 0xF, 0x1, false); \
            Pf[2 * (c) + ipl] = (long)(((unsigned long long)(unsigned)hi_ << 32) | (unsigned long long)(unsigned)lo_); } while (0)
        PF_GATHER(1, 0x104); PF_GATHER(2, 0x108); PF_GATHER(3, 0x10C);
#undef PF_GATHER
    }
#undef DPP_F
    f32x4 O[8];
#pragma unroll
    for (int ct = 0; ct < 8; ++ct) O[ct] = (f32x4){0.f, 0.f, 0.f, 0.f};
    if (qi < NQW - 1) AT_LOADI(t + 1, kixn);
    const h16x8 gate = *(const h16x8*)((const h16*)(p.ws + OFF_AZ) + (size_t)bt * 1024 + (4 * g) * 128 + 8 * lane);
    const int q4 = fr >> 2, pp = fr & 3;
    typedef int v2i_t __attribute__((__vector_size__(2 * sizeof(int))));
#define AT_STOREV(Vx) do { _Pragma("unroll") for (int it = 0; it < 8; ++it) { const int r = 8 * (lane >> 3) + it; const int fk = ((r >> 2) & 3) | (((r >> 4) & 1) << 2); \
        *(u32x4*)(vl + r * 128 + (((lane & 7) ^ fk) << 4)) = Vx[it]; } } while (0)
#define AT_PV(c) do { _Pragma("unroll") for (int ipl = 0; ipl < 2; ++ipl) { const int qq = fr >> 1; const int r = 16 * kg + 4 * (qq & 3) + 2 * ipl + (qq >> 2); const int fk = ((r >> 2) & 3) | (((r >> 4) & 1) << 2); \
        _Pragma("unroll") for (int ct = 0; ct < 8; ++ct) { const LAS unsigned char* a0 = vll + r * 128 + ((ct ^ fk) << 4) + (fr & 1) * 8; \
            const v2i_t bv = __builtin_amdgcn_ds_read_tr8_b64_v2i32((LAS v2i_t*)a0); \
            O[ct] = __builtin_amdgcn_mfma_f32_16x16x32_fp8_fp8(Pf[2 * (c) + ipl], __builtin_bit_cast(long, bv), O[ct], 0, 0, 0); } } } while (0)
    AT_LOADV(VB, 1); AT_STOREV(VA); AT_PV(0);
    AT_LOADV(VA, 2); AT_STOREV(VB); AT_PV(1);
    AT_LOADV(VB, 3); AT_STOREV(VA); AT_PV(2);
    AT_STOREV(VB); AT_PV(3);
#undef AT_LOADK
#undef AT_MMAK
#undef AT_LOADV
#undef AT_STOREV
#undef AT_PV
    h16* ot = (h16*)vl;
    if (kg == 0) {
#pragma unroll
        for (int ct = 0; ct < 8; ++ct)
#pragma unroll
            for (int r = 0; r < 4; ++r) ot[r * 128 + 16 * ct + fr] = (h16)O[ct][r];
    }
    {
        const h16x8 ov = *(const h16x8*)(ot + 8 * lane);
        h16x8 res;
#pragma unroll
        for (int j = 0; j < 8; ++j) res[j] = (h16)((float)ov[j] * (float)gate[j] * (1.0f / 256.0f));
        *(h16x8*)((h16*)(p.ws + OFF_OMIX) + (size_t)bt * 2048 + 1024 + (4 * g) * 128 + 8 * lane) = res;
    }
#pragma unroll
    for (int c = 0; c < 4; ++c) kix[c] = kixn[c];
    }
#undef AT_LOADI
}

__device__ __forceinline__ void phase5(const Params& p) {
    const int tid = opaque_tid(), wid = tid >> 6, lane = tid & 63;
    const int gw = blockIdx.x * 8 + wid, nw = gridDim.x * 8;
    const float* rowss = (const float*)(p.ws + OFF_ROWSS);
    for (int row = gw; row < BT; row += nw) {
        const float r = 1.0f / sqrtf(rowss[row] * (1.0f / DM) + EPS);
        f32x4* o = (f32x4*)(p.out + (size_t)row * DM);
        float eadd = 0.f;
        if ((TS_A >= 0 || TS_ACC >= 0) && row < 164) { const unsigned* ts = (const unsigned*)(p.ws + OFF_CTRL + 8192); const float tus = (TS_ACC >= 0) ? (float)ts[16 + (TS_ACC >= 0 ? TS_ACC : 0)] * (0.01f / 256.0f) : (float)(ts[TS_B >= 0 ? TS_B : 0] - ts[TS_A >= 0 ? TS_A : 0]) * 0.01f; eadd = sqrtf(tus * 1e-5f); }
#pragma unroll
        for (int i = 0; i < 8; ++i) { const f32x4 g = ((const f32x4*)p.final_g)[lane + 64 * i]; f32x4 v = o[lane + 64 * i]; v = v * r * g + eadd; o[lane + 64 * i] = v; }
    }
}

#define XB_TMO      128
#define XB_XCNT(j)  (256  + 64 * (j))
#define XB_XSUB(j)  (1280 + 64 * (j))
#define XB_XGEN(j)  (2304 + 64 * (j))
#define XB_TOP      3328
#define XB_TOPGEN   3392
#define XCD_BAR_WORDS 3456
#define XB_SPIN_CAP (1u << 18)

__device__ __forceinline__ unsigned xb_ld(unsigned* p)              { return __hip_atomic_load(p, __ATOMIC_RELAXED, __HIP_MEMORY_SCOPE_AGENT); }
__device__ __forceinline__ unsigned xb_add(unsigned* p, unsigned v) { return __hip_atomic_fetch_add(p, v, __ATOMIC_RELAXED, __HIP_MEMORY_SCOPE_AGENT); }
__device__ __forceinline__ unsigned xb_xcc_id() { return (unsigned)__builtin_amdgcn_s_getreg((3 << 11) | 20) & 0xFu; }
#define XB_SPIN(cond, bar) do { unsigned _sp = 0; while (cond) { __builtin_amdgcn_s_sleep(1); \
    if ((++_sp & 255u) == 0u) { if (xb_ld(&(bar)[XB_TMO])) break; if (_sp > XB_SPIN_CAP) { atomicAdd(&(bar)[XB_TMO], 1u); break; } } } } while (0)

struct XcdBarrier {
    unsigned* bar; unsigned x;
    volatile LAS unsigned* st;
};

__device__ __forceinline__ XcdBarrier xcd_barrier_post(unsigned* bar, volatile LAS unsigned* st) {
    XcdBarrier b; b.bar = bar; b.x = xb_xcc_id(); b.st = st;
    if (threadIdx.x == 0) (void)xb_add(&bar[XB_XCNT(b.x)], 1u);
    return b;
}
__device__ __forceinline__ void xcd_barrier_complete(unsigned* bar, unsigned x, unsigned& nloc, unsigned& nx) {
    const unsigned G = gridDim.x * gridDim.y * gridDim.z;
    unsigned sum, cnt, mine, sp = 0u;
    for (;;) {
        sum = 0u; cnt = 0u; mine = 0u;
#pragma unroll
        for (unsigned j = 0; j < 16; ++j) { const unsigned c = xb_ld(&bar[XB_XCNT(j)]); sum += c; cnt += (c > 0u) ? 1u : 0u; mine = (j == x) ? c : mine; }
        if (sum == G) break;
        __builtin_amdgcn_s_sleep(1);
        if ((++sp & 255u) == 0u) { if (xb_ld(&bar[XB_TMO])) break; if (sp > XB_SPIN_CAP) { atomicAdd(&bar[XB_TMO], 1u); break; } }
    }
    nloc = mine > 0u ? mine : 1u; nx = cnt > 0u ? cnt : 1u;
}

__device__ __forceinline__ void xcd_barrier(const XcdBarrier& b) {
    asm volatile("s_waitcnt vmcnt(0)" ::: "memory");
    __syncthreads();
    if (threadIdx.x == 0) {
        unsigned* bar = b.bar;
        __builtin_amdgcn_s_waitcnt(0);
        unsigned nloc = b.st[0], nx = b.st[1];
        if (nloc == 0u) { xcd_barrier_complete(bar, b.x, nloc, nx); b.st[0] = nloc; b.st[1] = nx; }
        const unsigned old = xb_add(&bar[XB_XSUB(b.x)], 1u);
        const unsigned gen = old / nloc;
        if (old + 1u == (gen + 1u) * nloc) {
            __builtin_amdgcn_fence(__ATOMIC_RELEASE, "agent");
            asm volatile("s_waitcnt vmcnt(0)" ::: "memory");
            const unsigned og = xb_add(&bar[XB_TOP], 1u);
            const unsigned tg = og / nx;
            if (og + 1u == (tg + 1u) * nx) xb_add(&bar[XB_TOPGEN], 1u);
            else XB_SPIN(xb_ld(&bar[XB_TOPGEN]) == tg, bar);
            __builtin_amdgcn_fence(__ATOMIC_ACQUIRE, "agent");
            xb_add(&bar[XB_XGEN(b.x)], 1u);
            asm volatile("s_waitcnt vmcnt(0)" ::: "memory");
        } else {
            XB_SPIN(xb_ld(&bar[XB_XGEN(b.x)]) == gen, bar);
            __builtin_amdgcn_fence(__ATOMIC_ACQUIRE, "agent");
            asm volatile("s_waitcnt vmcnt(0)" ::: "memory");
        }
    }
    __syncthreads();
}


template <int LO, int HI>
__global__ void __launch_bounds__(512, 2) k_phases(Params p) {
    extern __shared__ __attribute__((aligned(16))) unsigned char smem[];
#define IN(k) (LO <= (k) && (k) < HI)
#define SEAM(k) do { if constexpr (IN(k) && IN((k) + 1)) { xcd_barrier(xbar); if (TS_A >= 0 && blockIdx.x == 0 && threadIdx.x == 0) ((unsigned*)(p.ws + OFF_CTRL + 8192))[(k) + 1] = (unsigned)__builtin_amdgcn_s_memrealtime(); } } while (0)
    XcdBarrier xbar; xbar.bar = nullptr; xbar.x = 0; xbar.st = nullptr;
    if constexpr (HI - LO > 1) {
        volatile LAS unsigned* stw = (volatile LAS unsigned*)((LAS unsigned char*)smem + LDS_BYTES - 48);
        if (threadIdx.x < 4) stw[threadIdx.x] = 0u;
        __syncthreads();
        xbar = xcd_barrier_post((unsigned*)(p.ws + OFF_CTRL + 16384), stw);
    }
    if (TS_A >= 0 && blockIdx.x == 0 && threadIdx.x == 0) ((unsigned*)(p.ws + OFF_CTRL + 8192))[0] = (unsigned)__builtin_amdgcn_s_memrealtime();
    if constexpr (IN(0)) { for (int rep = 0; rep < NREP(0); ++rep) phase0(p, smem); }
    SEAM(0);
    if constexpr (IN(1)) for (int rep = 0; rep < NREP(1); ++rep) {
        EpiIn E{p.ws, p.a_log, p.dt_bias, p.pos};
        {
            pg8::Gemm g{(const h16*)(p.ws + OFF_H), (const h16*)(p.ws + OFF_WT), BT, NPAD, DM};
            OrderF16 S; S.init(BT, 21 * 256, gridDim.x, blockIdx.x);
            pg8::gemm_phase<EpiIn, OrderF16>((LAS unsigned char*)smem, g, S, E);
        }
        {
            pg8::Gemm g{(const h16*)(p.ws + OFF_H8), (const h16*)(p.ws + OFF_WT8 - (size_t)16 * 256 * 2048), BT, 2560, DM};
            OrderF8 S; S.G = gridDim.x; S.c = blockIdx.x;
            pg8::gemm_phase<EpiIn, OrderF8, true, true>((LAS unsigned char*)smem, g, S, E);
        }
    }
    SEAM(1);
    if constexpr (IN(2)) for (int rep = 0; rep < NREP(2); ++rep) {
        {
            unsigned* qctr = (unsigned*)(p.ws + OFF_CTRL);
            volatile unsigned* lds_t = (volatile unsigned*)(smem + LDS_BYTES - 16);
            __syncthreads();
            if (threadIdx.x == 0) lds_t[0] = atomicAdd(qctr + 0 + 16 * rep, 1u);
            __syncthreads();
            unsigned o = lds_t[0];
            while (o < 1024u + 2048u) {
                unsigned nxt = 0u;
                if (threadIdx.x == 0) nxt = atomicAdd(qctr + 0 + 16 * rep, 1u);
                if (o < 1024u) { ACC_T0(); gdn_prep_pair(p, smem, (int)o); __syncthreads(); ACC_ADD(0); }
                else { const unsigned o2 = o - 1024u; idx8_task(p, smem, (int)(o2 & 3u), 511 - (int)(o2 >> 2)); }
                __syncthreads();
                if (threadIdx.x == 0) lds_t[0] = nxt;
                __syncthreads();
                o = lds_t[0];
            }
        }
    }
    SEAM(2);
    if constexpr (IN(3)) for (int rep = 0; rep < NREP(3); ++rep) {
        {
            unsigned* qctr = (unsigned*)(p.ws + OFF_CTRL);
            volatile unsigned* lds_t = (volatile unsigned*)(smem + LDS_BYTES - 16);
            volatile unsigned* lds_c = (volatile unsigned*)(smem + LDS_BYTES - 192);
            const int myx = (int)(xb_xcc_id() & 7u);
            for (int pass = 0; pass < 2; ++pass) {
                if (pass == 1) { __syncthreads(); if (threadIdx.x < 8) lds_c[8 + threadIdx.x] = __hip_atomic_load(qctr + 64 + 16 * rep + threadIdx.x, __ATOMIC_RELAXED, __HIP_MEMORY_SCOPE_AGENT); __syncthreads(); }
                const int nk = pass == 0 ? 1 : 8;
                for (int k = 0; k < nk; ++k) {
                    const int sp = (myx + k) & 7;
                    if (pass == 1 && lds_c[8 + sp] >= 4u) continue;
                    for (;;) {
                        __syncthreads();
                        if (threadIdx.x == 0) lds_t[0] = atomicAdd(qctr + 64 + 16 * rep + sp, 1u);
                        __syncthreads();
                        const unsigned o = lds_t[0];
                        if (o >= 4u) break;
                        { ACC_T0(); gdn_scan_task(p, smem, 4 * sp + (int)o); __syncthreads(); ACC_ADD(4); }
                        if (pass == 0) break;
                    }
                }
                if (pass == 0) for (int k = 0; k < 8; ++k) {
                    const int part = (myx + k) & 7;
                    if (k == 1) { __syncthreads(); if (threadIdx.x < 8) lds_c[threadIdx.x] = __hip_atomic_load(qctr + 128 + 16 * rep + threadIdx.x, __ATOMIC_RELAXED, __HIP_MEMORY_SCOPE_AGENT); __syncthreads(); }
                    if (k >= 1 && lds_c[part] >= 512u) continue;
                    __syncthreads();
                    if (threadIdx.x == 0) lds_t[0] = atomicAdd(qctr + 128 + 16 * rep + part, 1u);
                    __syncthreads();
                    unsigned a = lds_t[0];
                    while (a < 512u) {
                        unsigned nxt = 0u;
                        if (threadIdx.x == 0) nxt = atomicAdd(qctr + 128 + 16 * rep + part, 1u);
                        { ACC_T0(); attn8_task(p, smem, part, (int)a); __syncthreads(); ACC_ADD(3); }
                        __syncthreads();
                        if (threadIdx.x == 0) lds_t[0] = nxt;
                        __syncthreads();
                        a = lds_t[0];
                    }
                }
            }
        }
    }
    SEAM(3);
    const bool fuse_norm = (gridDim.x == 256) && (TS_A < 0) && (TS_ACC < 0);
    if constexpr (IN(4)) {
        pg8::Gemm g{(const h16*)(p.ws + OFF_OMIX), (const h16*)(p.ws + OFF_WOT), BT, DM, DM};
        if (fuse_norm) {
            PanelOrder S; S.c = blockIdx.x;
            EpiOutNorm E{p.x, p.out, (float*)(p.ws + OFF_ROWSS), (unsigned*)(p.ws + OFF_CTRL + 32768), p.final_g};
            pg8::gemm_phase<EpiOutNorm, PanelOrder>((LAS unsigned char*)smem, g, S, E);
        } else {
            pg8::StaticOrder S; S.init(BT, DM, gridDim.x, blockIdx.x);
            EpiOut E{p.x, p.out, (float*)(p.ws + OFF_ROWSS)};
            pg8::gemm_phase<EpiOut, pg8::StaticOrder>((LAS unsigned char*)smem, g, S, E);
        }
    }
    if (fuse_norm) return;
    SEAM(4);
    if constexpr (IN(5)) { phase5(p); }
#undef IN
#undef SEAM
}

template <int LO, int HI> static void launch_range(const Params& p, int grid, hipStream_t stream, bool coop) {
    static bool attr = false;
    if (!attr) { hipFuncSetAttribute((const void*)k_phases<LO, HI>, hipFuncAttributeMaxDynamicSharedMemorySize, LDS_BYTES); attr = true; }
    if (coop) {
        Params pp = p; void* args[] = {&pp};
        hipError_t e = hipLaunchCooperativeKernel((const void*)k_phases<LO, HI>, dim3(grid), dim3(512), args, LDS_BYTES, stream);
        if (e != hipSuccess) fprintf(stderr, "cooperative launch failed: %s (grid %d)\n", hipGetErrorString(e), grid);
    } else {
        hipLaunchKernelGGL((k_phases<LO, HI>), dim3(grid), dim3(512), LDS_BYTES, stream, p);
    }
}

extern "C" void kernel_launch(void* const* d_in, const int* in_sizes, int n_in, void* d_out, int out_size, void* d_ws, size_t ws_size, hipStream_t stream) {
    if (n_in != 10 || in_sizes[0] != BT * DM || out_size != BT * DM || ws_size < WS_END) {
        fprintf(stderr, "kernel_launch: unexpected shapes (n_in %d in0 %d out %d ws %zu need %zu)\n", n_in, n_in > 0 ? in_sizes[0] : -1, out_size, ws_size, (size_t)WS_END); return; }
    static int grid = 0;
    if (!grid) {
        int dev = 0, cus = 0, per_cu = 0; hipGetDevice(&dev); hipDeviceGetAttribute(&cus, hipDeviceAttributeMultiprocessorCount, dev);
#if FUSED
        hipFuncSetAttribute((const void*)k_phases<0, 6>, hipFuncAttributeMaxDynamicSharedMemorySize, LDS_BYTES);
        hipOccupancyMaxActiveBlocksPerMultiprocessor(&per_cu, (const void*)k_phases<0, 6>, 512, LDS_BYTES);
#else
        per_cu = 1;
#endif
        if (per_cu < 1) per_cu = 1; if (per_cu > 1) per_cu = 1;
        grid = cus * per_cu;
    }
    Params p{};
    p.x = (const float*)d_in[0]; p.pos = (const int*)d_in[1]; p.attn_g = (const float*)d_in[2]; p.w_in = (const float*)d_in[3]; p.conv_w = (const float*)d_in[4];
    p.a_log = (const float*)d_in[5]; p.dt_bias = (const float*)d_in[6]; p.gdn_norm_g = (const float*)d_in[7]; p.w_out = (const float*)d_in[8]; p.final_g = (const float*)d_in[9];
    p.out = (float*)d_out; p.ws = (unsigned char*)d_ws;
    hipMemsetAsync((char*)d_ws + OFF_CTRL, 0, CTL_ZERO_BYTES, stream);
#if FUSED
    launch_range<0, 6>(p, grid, stream, false);
#else
    launch_range<0, 1>(p, grid, stream, false);
    launch_range<1, 2>(p, grid, stream, false);
    launch_range<2, 3>(p, grid, stream, false);
    launch_range<3, 4>(p, grid, stream, false);
    launch_range<4, 5>(p, grid, stream, false);
    launch_range<5, 6>(p, grid, stream, false);
#endif
}
```

```cpp
#include <hip/hip_runtime.h>
#include <hip/hip_cooperative_groups.h>
#include <cstdio>
#include <cstdint>
namespace cg = cooperative_groups;

#ifndef FUSED
#define FUSED 1
#endif
#ifndef REPEAT_PHASE
#define REPEAT_PHASE -1
#endif
#define NREP(k) ((REPEAT_PHASE == (k)) ? 2 : 1)
#ifndef TS_A
#define TS_A -1
#endif
#ifndef TS_ACC
#define TS_ACC -1
#endif
#define ACC_T0() unsigned acc_t0_ = 0; if (TS_ACC >= 0 && threadIdx.x == 0) acc_t0_ = (unsigned)__builtin_amdgcn_s_memrealtime()
#define ACC_ADD(k) do { if (TS_ACC >= 0 && threadIdx.x == 0) { const unsigned t1_ = (unsigned)__builtin_amdgcn_s_memrealtime(); atomicAdd((unsigned*)(p.ws + OFF_CTRL + 8192) + 16 + (k), t1_ - acc_t0_); acc_t0_ = t1_; } } while (0)
#ifndef TS_B
#define TS_B -1
#endif

#define LAS __attribute__((address_space(3)))
typedef _Float16 h16;
typedef h16 h16x8 __attribute__((ext_vector_type(8)));
typedef h16 h16x4 __attribute__((ext_vector_type(4)));
typedef h16 h16x2 __attribute__((ext_vector_type(2)));
typedef float f32x4 __attribute__((ext_vector_type(4)));
typedef float f32x2 __attribute__((ext_vector_type(2)));
typedef unsigned u32x4 __attribute__((ext_vector_type(4)));

constexpr int NB = 4, NT = 4096, DM = 2048, BT = NB * NT;
constexpr int IN_COLS = 7776, NPAD = 7936;
constexpr float EPS = 1e-6f;
constexpr int LDS_BYTES = 155648;

constexpr size_t MB = 1024 * 1024;
constexpr size_t OFF_CTRL = 0;
constexpr size_t OFF_ROWSS = 65536;
constexpr size_t CTL_ZERO_BYTES = 65536 + (size_t)BT * 4;
constexpr size_t OFF_H = 1 * MB;
constexpr size_t OFF_OMIX = OFF_H;
constexpr size_t OFF_WT = OFF_H + 64 * MB;
constexpr size_t OFF_WOT = OFF_WT + (size_t)NPAD * 2048 * 2;
constexpr size_t OFF_QKVR = OFF_WOT + 8 * MB;
constexpr size_t OFF_GZ = OFF_QKVR + (size_t)BT * 3072 * 2;
constexpr size_t OFF_AQ = OFF_GZ + 32 * MB;
constexpr size_t OFF_AK = OFF_AQ + 32 * MB;
constexpr size_t OFF_AV = OFF_AK + 8 * MB;
constexpr size_t OFF_AZ = OFF_AV + 8 * MB;
constexpr size_t OFF_IQ = OFF_AZ + 32 * MB;
constexpr size_t OFF_IK = OFF_IQ + 32 * MB;
constexpr size_t OFF_GB = OFF_IK + 2 * MB;
constexpr size_t OFF_IW = OFF_GB + 1 * MB;
constexpr size_t OFF_COS = OFF_IW + 1 * MB;
constexpr size_t OFF_SIN = OFF_COS + 2 * MB;
constexpr size_t OFF_SEL = OFF_SIN + 2 * MB;
constexpr size_t OFF_REC = OFF_SEL + 8 * MB;
constexpr size_t OFF_H8 = OFF_REC;
constexpr size_t OFF_WT8 = OFF_REC + 32 * MB;
constexpr size_t WS_END = OFF_REC + (size_t)2048 * 74752;

struct Params {
    const float* x; const int* pos; const float* attn_g; const float* w_in; const float* conv_w; const float* a_log;
    const float* dt_bias; const float* gdn_norm_g; const float* w_out; const float* final_g; float* out; unsigned char* ws;
};

__device__ __forceinline__ float wave_sum(float v) {
#pragma unroll
    for (int o = 1; o < 64; o <<= 1) v += __shfl_xor(v, o);
    return v;
}
__device__ __forceinline__ float wave_max(float v) {
#pragma unroll
    for (int o = 1; o < 64; o <<= 1) v = fmaxf(v, __shfl_xor(v, o));
    return v;
}
__device__ __forceinline__ int opaque_tid() { int t = threadIdx.x; asm volatile("" : "+v"(t)); return t; }
__device__ __forceinline__ float silu_f(float x) { return x * __builtin_amdgcn_rcpf(1.0f + __builtin_amdgcn_exp2f(-1.4426950408889634f * x)); }

namespace pg8 {
constexpr int BM = 256, BK = 64, HALF = 128, HTB = HALF * BK * 2, STAGE_BYTES = 8 * HTB, NXCD = 8, WGM = 8;
__host__ __device__ __forceinline__ int lds_byte(int r, int c) { const int st = (r >> 4) * 2 + (c >> 5), rr = r & 15, cc = c & 31, ob = rr * 64 + cc * 2; return st * 1024 + (ob ^ (((ob >> 9) & 1) << 5)); }
__host__ __device__ __forceinline__ void stage_rc(int b, int& R, int& C) { const int st = b / 1024, sb = b % 1024, swz = sb ^ (((sb >> 9) & 1) << 5); R = (st >> 1) * 16 + swz / 64; C = (st & 1) * 32 + (swz % 64) / 2; }
__host__ __device__ __forceinline__ int perm32(int rho) { const int n = rho >> 4, i = rho & 15; return 8 * (i >> 2) + 4 * n + (i & 3); }
struct Unit { int pm, pn; };
struct Gemm { const h16* A; const h16* Bt; int M, N, K; };
struct StaticOrder {
    int nM, nN, nwg, G, c;
    __host__ __device__ void init(int M, int N, int G_, int c_) { nM = M / BM; nN = N / BM; nwg = nM * nN; G = G_; c = c_; }
    __host__ __device__ bool next(int i, Unit& u) const {
        const long L = (long)i * G + c; if (L >= nwg) return false;
        int wgid = (int)L; { const int q = nwg / NXCD, r = nwg % NXCD, xcd = wgid % NXCD, off = wgid / NXCD; wgid = (xcd < r ? xcd * (q + 1) : r * (q + 1) + (xcd - r) * q) + off; }
        const int nig = WGM * nN, gid = wgid / nig, fm = gid * WGM, gsz = (nM - fm) < WGM ? (nM - fm) : WGM;
        u.pm = fm + ((wgid % nig) % gsz); u.pn = (wgid % nig) / gsz; return true;
    }
    __device__ __forceinline__ void a_ready(const Unit&) const {}
    __device__ __forceinline__ void done(const Unit&) const {}
};

typedef int i32x8 __attribute__((ext_vector_type(8)));
template <class Epi, class Sched, bool SP2 = true, bool F8 = false>
__device__ __forceinline__ void gemm_phase(LAS unsigned char* lds, const Gemm g, const Sched& S, const Epi& E) {
    const int tid = opaque_tid(), wid = __builtin_amdgcn_readfirstlane(tid >> 6), lane = tid & 63, wr = wid >> 2, wc = wid & 3, fr = lane & 15, fq = lane >> 4;
    const int K = g.K;
    const int ESZ = F8 ? 1 : 2, nt = (K * ESZ) / 128;
    unsigned voffA[2], voffB[2];
#pragma unroll
    for (int i = 0; i < 2; ++i) { int R, C; stage_rc(tid * 16 + i * 8192, R, C); const int Rb = Epi::PERM ? ((R & ~31) + perm32(R & 31)) : R;
        voffA[i] = (unsigned)(R * K * ESZ + C * 2); voffB[i] = (unsigned)(Rb * K * ESZ + C * 2); }
    const size_t kstep = (size_t)(BK * 2);
    const size_t hstep = (size_t)HALF * K * ESZ;
    const size_t tstep = 2 * hstep;
    const unsigned ldsw = (unsigned)wid * 1024u;
    const int aoff = lds_byte(wr * 64 + fr, fq * 8), boff = lds_byte(wc * 32 + fr, fq * 8);
#define PG8_SA(b, h) (((b) * 2 + (h)) * HTB)
#define PG8_SB(b, h) ((4 + (b) * 2 + (h)) * HTB)
#define PG8_STAGE(bufoff, gbase, voff) do { _Pragma("unroll") for (int _i = 0; _i < 2; ++_i) \
        __builtin_amdgcn_global_load_lds((const unsigned*)((const char*)(gbase) + (voff)[_i]), (LAS unsigned*)(lds + (bufoff) + ldsw + _i * 8192), 16, 0, 0); } while (0)
#define PG8_LDA(dst, b, h) do { _Pragma("unroll") for (int m = 0; m < 4; ++m) _Pragma("unroll") for (int k = 0; k < 2; ++k) dst[m][k] = *(const LAS h16x8*)(lds + PG8_SA(b, h) + aoff + m * 2048 + k * 1024); } while (0)
#define PG8_LDB(dst, b, h) do { _Pragma("unroll") for (int n = 0; n < 2; ++n) _Pragma("unroll") for (int k = 0; k < 2; ++k) dst[n][k] = *(const LAS h16x8*)(lds + PG8_SB(b, h) + boff + n * 2048 + k * 1024); } while (0)
#define PG8_MMA(ai, bj, At, Bt) do { __builtin_amdgcn_s_setprio(1); \
        if constexpr (F8) { _Pragma("unroll") for (int m = 0; m < 4; ++m) _Pragma("unroll") for (int n = 0; n < 2; ++n) { \
            const u32x4 b0_ = __builtin_bit_cast(u32x4, Bt[n][0]), b1_ = __builtin_bit_cast(u32x4, Bt[n][1]), a0_ = __builtin_bit_cast(u32x4, At[m][0]), a1_ = __builtin_bit_cast(u32x4, At[m][1]); \
            const i32x8 bw_ = (i32x8){(int)b0_[0], (int)b0_[1], (int)b0_[2], (int)b0_[3], (int)b1_[0], (int)b1_[1], (int)b1_[2], (int)b1_[3]}; \
            const i32x8 aw_ = (i32x8){(int)a0_[0], (int)a0_[1], (int)a0_[2], (int)a0_[3], (int)a1_[0], (int)a1_[1], (int)a1_[2], (int)a1_[3]}; \
            asm volatile("v_mfma_scale_f32_16x16x128_f8f6f4 %0, %1, %2, %0, %3, %3 op_sel_hi:[0,0,0]" : "+v"(acc[ai][bj][m][n]) : "v"(bw_), "v"(aw_), "v"(0x7C7C7C7C)); } } \
        else { _Pragma("unroll") for (int m = 0; m < 4; ++m) _Pragma("unroll") for (int n = 0; n < 2; ++n) _Pragma("unroll") for (int k = 0; k < 2; ++k) \
            acc[ai][bj][m][n] = __builtin_amdgcn_mfma_f32_16x16x32_f16(Bt[n][k], At[m][k], acc[ai][bj][m][n], 0, 0, 0); } \
        __builtin_amdgcn_s_setprio(0); } while (0)
#define PG8_WAIT_V(n) asm volatile("s_waitcnt vmcnt(" #n ")" ::: "memory")
#define PG8_WAIT_L(n) asm volatile("s_waitcnt lgkmcnt(" #n ")" ::: "memory")
#define PG8_BAR __builtin_amdgcn_s_barrier()
#define PG8_SCHED __builtin_amdgcn_sched_barrier(0)
    Unit cur, nxt; int ui = 0;
    if (!S.next(0, cur)) return;
    f32x4 acc[2][2][4][2];
#pragma unroll
    for (int a = 0; a < 2; ++a)
#pragma unroll
        for (int b = 0; b < 2; ++b)
#pragma unroll
            for (int m = 0; m < 4; ++m)
#pragma unroll
                for (int n = 0; n < 2; ++n) acc[a][b][m][n] = (f32x4){0.f, 0.f, 0.f, 0.f};
    h16x8 At[4][2], B0[2][2], B1[2][2];
    const char* cA = (const char*)g.A + (size_t)cur.pm * tstep; const char* cB = (const char*)g.Bt + (size_t)cur.pn * tstep;
    S.a_ready(cur);
    if constexpr (SP2) {
        PG8_STAGE(PG8_SB(0, 0), cB, voffB); PG8_STAGE(PG8_SB(0, 1), cB + hstep, voffB); PG8_STAGE(PG8_SA(0, 0), cA, voffA); PG8_STAGE(PG8_SA(0, 1), cA + hstep, voffA);
        if (wr == 1) PG8_BAR;
        PG8_WAIT_V(2); PG8_BAR;
        PG8_STAGE(PG8_SB(1, 0), cB + kstep, voffB); PG8_STAGE(PG8_SA(1, 0), cA + kstep, voffA); PG8_STAGE(PG8_SB(1, 1), cB + hstep + kstep, voffB);
        PG8_WAIT_V(6); PG8_BAR;
    } else {
    PG8_STAGE(PG8_SB(0, 0), cB, voffB); PG8_STAGE(PG8_SA(0, 0), cA, voffA); PG8_STAGE(PG8_SB(0, 1), cB + hstep, voffB); PG8_STAGE(PG8_SA(0, 1), cA + hstep, voffA);
    if (wr == 1) PG8_BAR;
    PG8_WAIT_V(4); PG8_BAR;
    PG8_STAGE(PG8_SB(1, 0), cB + kstep, voffB); PG8_STAGE(PG8_SA(1, 0), cA + kstep, voffA); PG8_STAGE(PG8_SB(1, 1), cB + hstep + kstep, voffB);
    PG8_WAIT_V(6); PG8_BAR;
    }
    for (;;) {
        const bool has_next = S.next(ui + 1, nxt);
        const char* nA = has_next ? (const char*)g.A + (size_t)nxt.pm * tstep : cA; const char* nB = has_next ? (const char*)g.Bt + (size_t)nxt.pn * tstep : cB;
        for (int t = 0; t < nt; t += 2) {
            const bool last = (t == nt - 2);
            const char* a1 = cA + (size_t)(t + 1) * kstep;
            const char* a2 = last ? nA : cA + (size_t)(t + 2) * kstep; const char* b2 = last ? nB : cB + (size_t)(t + 2) * kstep;
            const char* a3 = a2 + kstep; const char* b3 = b2 + kstep;
            if (last && has_next) S.a_ready(nxt);
            if constexpr (SP2) {
            PG8_LDB(B0, 0, 0); PG8_LDB(B1, 0, 1); PG8_SCHED; PG8_LDA(At, 0, 0); PG8_STAGE(PG8_SA(1, 1), a1 + hstep, voffA);
            PG8_WAIT_V(8); PG8_WAIT_L(0); PG8_BAR; PG8_MMA(0, 0, At, B0); PG8_MMA(0, 1, At, B1); PG8_BAR; PG8_SCHED;
            PG8_LDA(At, 0, 1); PG8_STAGE(PG8_SB(0, 0), b2, voffB); PG8_STAGE(PG8_SB(0, 1), b2 + hstep, voffB); PG8_STAGE(PG8_SA(0, 0), a2, voffA);
            PG8_WAIT_V(8); PG8_WAIT_L(0); PG8_BAR; PG8_MMA(1, 0, At, B0); PG8_MMA(1, 1, At, B1); PG8_BAR; PG8_SCHED;
            PG8_LDB(B0, 1, 0); PG8_LDB(B1, 1, 1); PG8_SCHED; PG8_LDA(At, 1, 0); PG8_STAGE(PG8_SA(0, 1), a2 + hstep, voffA);
            PG8_WAIT_V(8); PG8_WAIT_L(0); PG8_BAR; PG8_MMA(0, 0, At, B0); PG8_MMA(0, 1, At, B1); PG8_BAR; PG8_SCHED;
            PG8_LDA(At, 1, 1); PG8_STAGE(PG8_SB(1, 0), b3, voffB); PG8_STAGE(PG8_SB(1, 1), b3 + hstep, voffB); PG8_STAGE(PG8_SA(1, 0), a3, voffA);
            PG8_WAIT_V(8); PG8_WAIT_L(0); PG8_BAR; PG8_MMA(1, 0, At, B0); PG8_MMA(1, 1, At, B1); PG8_BAR; PG8_SCHED;
            } else {
            PG8_LDB(B0, 0, 0); PG8_SCHED; PG8_LDA(At, 0, 0); PG8_STAGE(PG8_SA(1, 1), a1 + hstep, voffA);
            PG8_WAIT_L(8); PG8_BAR; PG8_WAIT_L(0); PG8_MMA(0, 0, At, B0); PG8_BAR; PG8_SCHED;
            PG8_LDB(B1, 0, 1); PG8_STAGE(PG8_SB(0, 0), b2, voffB);
            PG8_BAR; PG8_WAIT_L(0); PG8_MMA(0, 1, At, B1); PG8_BAR;
            PG8_LDA(At, 0, 1); PG8_STAGE(PG8_SA(0, 0), a2, voffA);
            PG8_BAR; PG8_WAIT_L(0); PG8_MMA(1, 0, At, B0); PG8_BAR; PG8_SCHED;
            PG8_STAGE(PG8_SB(0, 1), b2 + hstep, voffB);
            PG8_WAIT_V(6); PG8_BAR; PG8_MMA(1, 1, At, B1); PG8_BAR;
            PG8_LDB(B0, 1, 0); PG8_SCHED; PG8_LDA(At, 1, 0); PG8_STAGE(PG8_SA(0, 1), a2 + hstep, voffA);
            PG8_WAIT_L(8); PG8_BAR; PG8_WAIT_L(0); PG8_MMA(0, 0, At, B0); PG8_BAR; PG8_SCHED;
            PG8_LDB(B1, 1, 1); PG8_STAGE(PG8_SB(1, 0), b3, voffB);
            PG8_BAR; PG8_WAIT_L(0); PG8_MMA(0, 1, At, B1); PG8_BAR;
            PG8_LDA(At, 1, 1); PG8_STAGE(PG8_SA(1, 0), a3, voffA);
            PG8_BAR; PG8_WAIT_L(0); PG8_MMA(1, 0, At, B0); PG8_BAR; PG8_SCHED;
            PG8_STAGE(PG8_SB(1, 1), b3 + hstep, voffB);
            PG8_WAIT_V(6); PG8_BAR; PG8_MMA(1, 1, At, B1); PG8_BAR;
            }
        }
        if (wr == 0) PG8_BAR;
        if constexpr (F8) asm volatile("s_nop 15\n\ts_nop 15" ::: "memory");
        PG8_SCHED; { const int te = opaque_tid(), le = te & 63; E(acc, cur, wr, wc, le & 15, le >> 4); } S.done(cur);
        if (!has_next) break;
#pragma unroll
        for (int a = 0; a < 2; ++a)
#pragma unroll
            for (int b = 0; b < 2; ++b)
#pragma unroll
                for (int m = 0; m < 4; ++m)
#pragma unroll
                    for (int n = 0; n < 2; ++n) acc[a][b][m][n] = (f32x4){0.f, 0.f, 0.f, 0.f};
        cur = nxt; cA = nA; cB = nB; ++ui;
        if (wr == 1) PG8_BAR;
    }
    PG8_WAIT_V(0);
    PG8_BAR;
#undef PG8_SA
#undef PG8_SB
#undef PG8_STAGE
#undef PG8_LDA
#undef PG8_LDB
#undef PG8_MMA
#undef PG8_WAIT_V
#undef PG8_WAIT_L
#undef PG8_BAR
#undef PG8_SCHED
}
}

struct OrderF16 : pg8::StaticOrder {
    __device__ __forceinline__ bool next(int i, pg8::Unit& u) const { if (!pg8::StaticOrder::next(i, u)) return false; if (u.pn >= 16) u.pn += 10; return true; }
};
struct OrderF8 {
    int G, c;
    __device__ __forceinline__ bool next(int i, pg8::Unit& u) const {
        int L;
        if (G == 256) { if (c < 64) { if (i >= 1) return false; L = 576 + c; } else { if (i >= 3) return false; L = (c - 64) + 192 * i; } }
        else { L = i * G + c; if (L >= 640) return false; }
        const int wgid = (L % 8) * 80 + L / 8;
        u.pm = (wgid / 80) * 8 + (wgid % 80) % 8; u.pn = 16 + (wgid % 80) / 8; return true;
    }
    __device__ __forceinline__ void a_ready(const pg8::Unit&) const {}
    __device__ __forceinline__ void done(const pg8::Unit&) const {}
};

struct EpiIn {
    static constexpr bool PERM = true;
    unsigned char* ws; const float* a_log; const float* dt_bias; const int* pos;
    __device__ __forceinline__ void operator()(const f32x4 (&acc)[2][2][4][2], const pg8::Unit& u, int wr, int wc, int fr, int fq) const {
        constexpr float RF[16] = {1.591549431e-01f, 7.008652159e-02f, 3.086376340e-02f, 1.359137064e-02f, 5.985185713e-03f, 2.635675899e-03f, 1.160663641e-03f, 5.111175045e-04f,
                                  2.250790790e-04f, 9.911730937e-05f, 4.364795279e-05f, 1.922110068e-05f, 8.464330808e-06f, 3.727408602e-06f, 1.641426263e-06f, 7.228293069e-07f};
        const int pn = u.pn;
        const int rowb = u.pm * 256 + wr * 64 + fr;
        const int cw = wc * 32 + 8 * fq;
        if (pn < 30) {
            h16* base; int ldc, colt, mode; float scale = 1.f;
            if (pn < 12) { base = (h16*)(ws + OFF_QKVR); ldc = 3072; colt = pn * 256; mode = 0; }
            else if (pn < 16) { base = (h16*)(ws + OFF_GZ); ldc = 1024; colt = (pn - 12) * 256; mode = 1; }
            else if (pn < 20) { base = (h16*)(ws + OFF_AQ); ldc = 1024; colt = (pn - 16) * 256; mode = 2; }
            else if (pn == 20) { base = (h16*)(ws + OFF_AK); ldc = 256; colt = 0; mode = 2; }
            else if (pn == 21) { base = (h16*)(ws + OFF_AV); ldc = 256; colt = 0; mode = 4; }
            else if (pn < 26) { base = (h16*)(ws + OFF_AZ); ldc = 1024; colt = (pn - 22) * 256; mode = 1; }
            else { base = (h16*)(ws + OFF_IQ); ldc = 1024; colt = (pn - 26) * 256; mode = 3; }
            const bool rot_wave = (mode == 2 && wc == 0) || (mode == 3 && (wc & 1) == 0);
            const int xm = (mode == 2) ? 32 : 16;
            const bool rot_lane = (mode == 2) ? true : (fq < 2);
            const float sgn = (mode == 2) ? (fq < 2 ? -1.f : 1.f) : (fq == 0 ? -1.f : 1.f);
            float Fq[8]; int ps[2][4];
#pragma unroll
            for (int j = 0; j < 8; ++j) Fq[j] = (mode == 2) ? ((fq & 1) ? RF[8 + j] : RF[j]) : RF[2 * j];
            if (rot_wave) {
#pragma unroll
                for (int ai = 0; ai < 2; ++ai)
#pragma unroll
                    for (int m = 0; m < 4; ++m) ps[ai][m] = pos[rowb + ai * 128 + m * 16];
            }
#pragma unroll
            for (int ai = 0; ai < 2; ++ai)
#pragma unroll
                for (int m = 0; m < 4; ++m) {
                    const int row = rowb + ai * 128 + m * 16;
                    float cs[8], sn[8];
                    if (rot_wave) {
                        const float pf = (float)ps[ai][m];
#pragma unroll
                        for (int j = 0; j < 8; ++j) { const float rv = __builtin_amdgcn_fractf(pf * Fq[j]); cs[j] = __builtin_amdgcn_cosf(rv); sn[j] = __builtin_amdgcn_sinf(rv); }
                    }
#pragma unroll
                    for (int bj = 0; bj < 2; ++bj) {
                        float v[8];
#pragma unroll
                        for (int j = 0; j < 4; ++j) { v[j] = acc[ai][bj][m][0][j]; v[4 + j] = acc[ai][bj][m][1][j]; }
                        if (rot_wave) {
#pragma unroll
                            for (int j = 0; j < 8; ++j) {
                                const unsigned xv = __builtin_bit_cast(unsigned, v[j]); float pv;
                                if (mode == 2) { const auto sw = __builtin_amdgcn_permlane32_swap(xv, xv, false, false); pv = __builtin_bit_cast(float, fq < 2 ? sw[1] : sw[0]); }
                                else { const auto sw = __builtin_amdgcn_permlane16_swap(xv, xv, false, false); pv = __builtin_bit_cast(float, (fq & 1) ? sw[0] : sw[1]); }
                                if (rot_lane) v[j] = v[j] * cs[j] + sgn * pv * sn[j]; }
                        }
                        if (mode == 1) {
#pragma unroll
                            for (int j = 0; j < 8; ++j) v[j] = silu_f(v[j]);
                        }
                        if (mode == 4) {
                            int w0 = 0, w1 = 0;
                            w0 = __builtin_amdgcn_cvt_pk_fp8_f32(v[0], v[1], w0, false); w0 = __builtin_amdgcn_cvt_pk_fp8_f32(v[2], v[3], w0, true);
                            w1 = __builtin_amdgcn_cvt_pk_fp8_f32(v[4], v[5], w1, false); w1 = __builtin_amdgcn_cvt_pk_fp8_f32(v[6], v[7], w1, true);
                            typedef int i32x2b __attribute__((ext_vector_type(2)));
                            *(i32x2b*)((unsigned char*)base + (size_t)row * ldc + bj * 128 + cw) = (i32x2b){w0, w1};
                        } else if (mode == 2) {
                            int w0 = 0, w1 = 0;
                            w0 = __builtin_amdgcn_cvt_pk_fp8_f32(v[0], v[1], w0, false); w0 = __builtin_amdgcn_cvt_pk_fp8_f32(v[2], v[3], w0, true);
                            w1 = __builtin_amdgcn_cvt_pk_fp8_f32(v[4], v[5], w1, false); w1 = __builtin_amdgcn_cvt_pk_fp8_f32(v[6], v[7], w1, true);
                            typedef int i32x2 __attribute__((ext_vector_type(2)));
                            *(i32x2*)((unsigned char*)base + (size_t)row * ldc + colt + bj * 128 + cw) = (i32x2){w0, w1};
                        } else {
                            h16x8 o;
#pragma unroll
                            for (int j = 0; j < 8; ++j) o[j] = (h16)(v[j] * scale);
                            *(h16x8*)(base + (size_t)row * ldc + colt + bj * 128 + cw) = o;
                        }
                    }
                }
        } else {
            h16* ik = (h16*)(ws + OFF_IK); float* gb = (float*)(ws + OFF_GB); float* iw = (float*)(ws + OFF_IW);
#pragma unroll
            for (int ai = 0; ai < 2; ++ai)
#pragma unroll
                for (int m = 0; m < 4; ++m) {
                    const int row = rowb + ai * 128 + m * 16;
                    float v[8];
#pragma unroll
                    for (int j = 0; j < 4; ++j) { v[j] = acc[ai][0][m][0][j]; v[4 + j] = acc[ai][0][m][1][j]; }
                    if (wc == 0) {
                        const float sgn = (fq == 0 ? -1.f : 1.f), pf = (float)pos[row];
#pragma unroll
                        for (int j = 0; j < 8; ++j) { const unsigned xv = __builtin_bit_cast(unsigned, v[j]); const auto sw = __builtin_amdgcn_permlane16_swap(xv, xv, false, false); const float pv = __builtin_bit_cast(float, (fq & 1) ? sw[0] : sw[1]); const float rv = __builtin_amdgcn_fractf(pf * RF[2 * j]); const float c = __builtin_amdgcn_cosf(rv), s = __builtin_amdgcn_sinf(rv);
                            if (fq < 2) v[j] = v[j] * c + sgn * pv * s; }
                    }
                    if (wc < 2) {
                        h16x8 o;
#pragma unroll
                        for (int j = 0; j < 8; ++j) o[j] = (h16)v[j];
                        *(h16x8*)(ik + (size_t)(row >> 5) * 2048 + (cw >> 4) * 512 + ((cw >> 3) & 1) * 256 + (row & 31) * 8) = o;
                    } else if (wc == 2) {
                        if (fq == 0) {
#pragma unroll
                            for (int j = 0; j < 8; ++j) { const float z = v[j] + dt_bias[j];
                                const float sp = fmaxf(z, 0.f) + 0.6931471805599453f * __builtin_amdgcn_logf(1.0f + __builtin_amdgcn_exp2f(-1.4426950408889634f * fabsf(z)));
                                gb[(size_t)row * 16 + j] = -__builtin_amdgcn_exp2f(1.4426950408889634f * a_log[j]) * sp; }
                        } else if (fq == 1) {
#pragma unroll
                            for (int j = 0; j < 8; ++j) gb[(size_t)row * 16 + 8 + j] = __builtin_amdgcn_rcpf(1.0f + __builtin_amdgcn_exp2f(-1.4426950408889634f * v[j]));
                        } else {
#pragma unroll
                            for (int j = 0; j < 8; ++j) iw[(size_t)row * 16 + 8 * (fq - 2) + j] = v[j] * 0.03125f;
                        }
                    }
                }
        }
    }
};

struct PanelOrder {
    int c;
    __device__ __forceinline__ bool next(int i, pg8::Unit& u) const { if (i >= 2) return false; u.pm = 32 * i + 4 * (c & 7) + (c >> 6); u.pn = (c >> 3) & 7; return true; }
    __device__ __forceinline__ void a_ready(const pg8::Unit&) const {}
    __device__ __forceinline__ void done(const pg8::Unit&) const {}
};
struct EpiOutNorm {
    static constexpr bool PERM = false;
    const float* x; float* out; float* rowss; unsigned* cnt; const float* fg;
    __device__ __forceinline__ void operator()(f32x4 (&acc)[2][2][4][2], const pg8::Unit& u, int wr, int wc, int fr, int fq) const {
        const int rowb = u.pm * 256 + wr * 64 + fr, col0 = u.pn * 256 + wc * 32 + 4 * fq;
#pragma unroll
        for (int ai = 0; ai < 2; ++ai)
#pragma unroll
            for (int m = 0; m < 4; ++m) {
                const int row = rowb + ai * 128 + m * 16; float ss = 0.f;
#pragma unroll
                for (int bj = 0; bj < 2; ++bj)
#pragma unroll
                    for (int n = 0; n < 2; ++n) {
                        const f32x4 y = *(const f32x4*)(x + (size_t)row * DM + col0 + bj * 128 + n * 16) + acc[ai][bj][m][n];
                        acc[ai][bj][m][n] = y; ss += (y[0] * y[0] + y[1] * y[1]) + (y[2] * y[2] + y[3] * y[3]);
                    }
                ss += __shfl_xor(ss, 16); ss += __shfl_xor(ss, 32);
                if (fq == 0) atomicAdd(rowss + row, ss);
            }
        asm volatile("s_waitcnt vmcnt(0)" ::: "memory");
        unsigned* cw = cnt + (u.pm * 2 + wr) * 16;
        if ((threadIdx.x & 63) == 0) __hip_atomic_fetch_add(cw, 1u, __ATOMIC_RELAXED, __HIP_MEMORY_SCOPE_AGENT);
        { unsigned spins = 0;
          while ((unsigned)__builtin_amdgcn_readfirstlane((int)__hip_atomic_load(cw, __ATOMIC_RELAXED, __HIP_MEMORY_SCOPE_AGENT)) < 32u) { __builtin_amdgcn_s_sleep(2); if (++spins > (1u << 22)) break; } }
        f32x4 gv[2][2];
#pragma unroll
        for (int bj = 0; bj < 2; ++bj)
#pragma unroll
            for (int n = 0; n < 2; ++n) gv[bj][n] = *(const f32x4*)(fg + col0 + bj * 128 + n * 16);
#pragma unroll
        for (int ai = 0; ai < 2; ++ai)
#pragma unroll
            for (int m = 0; m < 4; ++m) {
                const int row = rowb + ai * 128 + m * 16;
                const float ssr = __hip_atomic_load(rowss + row, __ATOMIC_RELAXED, __HIP_MEMORY_SCOPE_AGENT);
                const float r = __builtin_amdgcn_rsqf(ssr * (1.0f / DM) + EPS);
#pragma unroll
                for (int bj = 0; bj < 2; ++bj)
#pragma unroll
                    for (int n = 0; n < 2; ++n) *(f32x4*)(out + (size_t)row * DM + col0 + bj * 128 + n * 16) = acc[ai][bj][m][n] * r * gv[bj][n];
            }
    }
};

struct EpiOut {
    static constexpr bool PERM = false;
    const float* x; float* out; float* rowss;
    __device__ __forceinline__ void operator()(const f32x4 (&acc)[2][2][4][2], const pg8::Unit& u, int wr, int wc, int fr, int fq) const {
        const int rowb = u.pm * 256 + wr * 64 + fr, col0 = u.pn * 256 + wc * 32 + 4 * fq;
#pragma unroll
        for (int ai = 0; ai < 2; ++ai)
#pragma unroll
            for (int m = 0; m < 4; ++m) {
                const int row = rowb + ai * 128 + m * 16; float ss = 0.f;
#pragma unroll
                for (int bj = 0; bj < 2; ++bj)
#pragma unroll
                    for (int n = 0; n < 2; ++n) {
                        const size_t off = (size_t)row * DM + col0 + bj * 128 + n * 16;
                        const f32x4 y = *(const f32x4*)(x + off) + acc[ai][bj][m][n];
                        *(f32x4*)(out + off) = y; ss += (y[0] * y[0] + y[1] * y[1]) + (y[2] * y[2] + y[3] * y[3]);
                    }
                ss += __shfl_xor(ss, 16); ss += __shfl_xor(ss, 32);
                if (fq == 0) atomicAdd(rowss + row, ss);
            }
    }
};

__device__ __forceinline__ int src_col(int np) {
    if (np < 4096) return np;
    if (np < 7680) return np + 16;
    if (np < 7744) return 7696 + (np - 7680);
    if (np < 7752) return 4096 + (np - 7744);
    if (np < 7760) return 4104 + (np - 7752);
    if (np < 7776) return np;
    return -1;
}
__device__ __forceinline__ void phase0(const Params& p, unsigned char* smem) {
    const int tid = opaque_tid(), wid = tid >> 6, lane = tid & 63;
    const int gw = blockIdx.x * 8 + wid, nw = gridDim.x * 8;
    h16* H = (h16*)(p.ws + OFF_H); unsigned char* H8 = p.ws + OFF_H8;
    for (int row = 2 * gw; row < BT; row += 2 * nw) {
        const f32x4* xr0 = (const f32x4*)(p.x + (size_t)row * DM); const f32x4* xr1 = xr0 + DM / 4;
        f32x4 v0[8], v1[8]; float s0 = 0.f, s1 = 0.f;
#pragma unroll
        for (int i = 0; i < 8; ++i) { v0[i] = xr0[lane + 64 * i]; v1[i] = xr1[lane + 64 * i]; }
#pragma unroll
        for (int i = 0; i < 8; ++i) { s0 += (v0[i][0] * v0[i][0] + v0[i][1] * v0[i][1]) + (v0[i][2] * v0[i][2] + v0[i][3] * v0[i][3]); s1 += (v1[i][0] * v1[i][0] + v1[i][1] * v1[i][1]) + (v1[i][2] * v1[i][2] + v1[i][3] * v1[i][3]); }
        s0 = wave_sum(s0); s1 = wave_sum(s1);
        const float r0 = __builtin_amdgcn_rsqf(s0 * (1.0f / DM) + EPS), r1 = __builtin_amdgcn_rsqf(s1 * (1.0f / DM) + EPS);
#pragma unroll
        for (int i = 0; i < 8; ++i) { const f32x4 g = ((const f32x4*)p.attn_g)[lane + 64 * i]; h16x4 o0, o1;
#pragma unroll
            for (int j = 0; j < 4; ++j) { o0[j] = (h16)(v0[i][j] * r0 * g[j]); o1[j] = (h16)(v1[i][j] * r1 * g[j]); }
            *(h16x4*)(H + (size_t)row * DM + 4 * (lane + 64 * i)) = o0; *(h16x4*)(H + (size_t)(row + 1) * DM + 4 * (lane + 64 * i)) = o1;
            int e0 = 0, e1 = 0;
            e0 = __builtin_amdgcn_cvt_pk_fp8_f32(v0[i][0] * r0 * g[0], v0[i][1] * r0 * g[1], e0, false); e0 = __builtin_amdgcn_cvt_pk_fp8_f32(v0[i][2] * r0 * g[2], v0[i][3] * r0 * g[3], e0, true);
            e1 = __builtin_amdgcn_cvt_pk_fp8_f32(v1[i][0] * r1 * g[0], v1[i][1] * r1 * g[1], e1, false); e1 = __builtin_amdgcn_cvt_pk_fp8_f32(v1[i][2] * r1 * g[2], v1[i][3] * r1 * g[3], e1, true);
            *(int*)(H8 + (size_t)row * DM + 4 * (lane + 64 * i)) = e0; *(int*)(H8 + (size_t)(row + 1) * DM + 4 * (lane + 64 * i)) = e1; }
    }
    {
        float* tiles = (float*)smem;
        h16* Wt = (h16*)(p.ws + OFF_WT); h16* WoT = (h16*)(p.ws + OFF_WOT);
        constexpr int NT1 = 124 * 32, NTT = NT1 + 32 * 32;
        const int nl_r = tid & 63, kl_r = tid >> 6, nl_w = tid >> 3, kc_w = tid & 7;
        float va[8], vb[8];
#define P0_LOAD(tI, v) do { if ((tI) < NT1) { const int n0_ = ((tI) / 32) * 64, k0_ = ((tI) % 32) * 64; const int src_ = src_col(n0_ + nl_r); \
            _Pragma("unroll") for (int i = 0; i < 8; ++i) v[i] = src_ >= 0 ? p.w_in[(size_t)(k0_ + kl_r + 8 * i) * IN_COLS + src_] : 0.f; } \
          else { const int t2_ = (tI) - NT1; const int n0_ = (t2_ / 32) * 64, k0_ = (t2_ % 32) * 64; \
            _Pragma("unroll") for (int i = 0; i < 8; ++i) v[i] = p.w_out[(size_t)(k0_ + kl_r + 8 * i) * DM + n0_ + nl_r]; } } while (0)
#define P0_PUT(buf, v) do { float* t_ = tiles + (buf) * (64 * 65); _Pragma("unroll") for (int i = 0; i < 8; ++i) t_[(kl_r + 8 * i) * 65 + nl_r] = v[i]; } while (0)
#define P0_STORE(buf, tI) do { const float* t_ = tiles + (buf) * (64 * 65); h16x8 o_; _Pragma("unroll") for (int j = 0; j < 8; ++j) o_[j] = (h16)t_[(8 * kc_w + j) * 65 + nl_w]; \
          if ((tI) < NT1) { const int n0_ = ((tI) / 32) * 64, k0_ = ((tI) % 32) * 64; \
              if (n0_ >= 4096 && n0_ < 6656) { int e0_ = 0, e1_ = 0; e0_ = __builtin_amdgcn_cvt_pk_fp8_f32(64.f * (float)o_[0], 64.f * (float)o_[1], e0_, false); e0_ = __builtin_amdgcn_cvt_pk_fp8_f32(64.f * (float)o_[2], 64.f * (float)o_[3], e0_, true); \
                  e1_ = __builtin_amdgcn_cvt_pk_fp8_f32(64.f * (float)o_[4], 64.f * (float)o_[5], e1_, false); e1_ = __builtin_amdgcn_cvt_pk_fp8_f32(64.f * (float)o_[6], 64.f * (float)o_[7], e1_, true); \
                  typedef int i32x2w __attribute__((ext_vector_type(2))); *(i32x2w*)(p.ws + OFF_WT8 + (size_t)(n0_ - 4096 + nl_w) * 2048 + k0_ + 8 * kc_w) = (i32x2w){e0_, e1_}; } \
              else *(h16x8*)(Wt + (size_t)(n0_ + nl_w) * 2048 + k0_ + 8 * kc_w) = o_; } \
          else { const int t2_ = (tI) - NT1; const int n0_ = (t2_ / 32) * 64, k0_ = (t2_ % 32) * 64; *(h16x8*)(WoT + (size_t)(n0_ + nl_w) * 2048 + k0_ + 8 * kc_w) = o_; } } while (0)
        int tI = blockIdx.x; int buf = 0;
        __syncthreads();
        if (tI < NTT) { P0_LOAD(tI, va); P0_PUT(0, va); }
        while (tI < NTT) {
            const int tn = tI + gridDim.x;
            if (tn < NTT) P0_LOAD(tn, vb);
            __syncthreads();
            P0_STORE(buf, tI);
            if (tn < NTT) P0_PUT(buf ^ 1, vb);
            buf ^= 1; tI = tn;
        }
#undef P0_LOAD
#undef P0_PUT
#undef P0_STORE
    }
}

__device__ __forceinline__ h16x8 pack8(const f32x4 a, const f32x4 c) { h16x8 o; o[0] = (h16)a[0]; o[1] = (h16)a[1]; o[2] = (h16)a[2]; o[3] = (h16)a[3]; o[4] = (h16)c[0]; o[5] = (h16)c[1]; o[6] = (h16)c[2]; o[7] = (h16)c[3]; return o; }
typedef short v4s_t __attribute__((__vector_size__(4 * sizeof(short))));
__device__ __forceinline__ h16x4 lds_tr16(const LAS unsigned char* a) { const v4s_t v = __builtin_amdgcn_ds_read_tr16_b64_v4i16((LAS v4s_t*)a); return __builtin_bit_cast(h16x4, v); }
constexpr int REC_BYTES = 74752, REC_WF = 0, REC_QF = 16384, REC_AF = 32768, REC_KTF = 40960, REC_VEC = 57344, REC_UF = 58368, REC_DMA = 58368;
constexpr int HB_BYTES = 69632;

__device__ __forceinline__ void gdn_prep_pair(const Params& p, unsigned char* smem, int pair) {
    const int tid = opaque_tid(), wid = __builtin_amdgcn_readfirstlane(tid >> 6), lane = tid & 63, hb = wid >> 2, w4 = wid & 3, tl = tid & 255;
    const int tk = 2 * pair + hb; const int b = tk >> 9, h = (tk >> 6) & 7, n = tk & 63; const int t0 = n * 64;
    unsigned char* base = smem + hb * HB_BYTES;
    h16* Kn = (h16*)base; h16* Qn = Kn + 64 * 136; h16* Vh = Qn + 64 * 136; float* L = (float*)(Vh + 64 * 136); float* vec = L + 4096;
    unsigned char* rec = p.ws + OFF_REC + (size_t)tk * REC_BYTES;
    const h16* qkvr = (const h16*)(p.ws + OFF_QKVR);
    __syncthreads();
    {
        const int cg = tl & 15, rg = tl >> 4;
        h16x8 raw[3][7];
#pragma unroll
        for (int ti = 0; ti < 3; ++ti)
#pragma unroll
            for (int r = 0; r < 7; ++r) {
                const int trow = t0 + 4 * rg - 3 + r;
                if (trow >= 0) raw[ti][r] = *(const h16x8*)(qkvr + ((size_t)b * NT + trow) * 3072 + ti * 1024 + h * 128 + 8 * cg);
                else { for (int j = 0; j < 8; ++j) raw[ti][r][j] = (h16)0.f; }
            }
#pragma unroll
        for (int ti = 0; ti < 3; ++ti) {
            const int chan = ti * 1024 + h * 128 + 8 * cg;
            float xr[7][8];
#pragma unroll
            for (int r = 0; r < 7; ++r)
#pragma unroll
                for (int j = 0; j < 8; ++j) xr[r][j] = (float)raw[ti][r][j];
            float wv[4][8];
#pragma unroll
            for (int tp = 0; tp < 4; ++tp) { const f32x4 a = *(const f32x4*)(p.conv_w + (size_t)tp * 3072 + chan), c = *(const f32x4*)(p.conv_w + (size_t)tp * 3072 + chan + 4);
#pragma unroll
                for (int j = 0; j < 4; ++j) { wv[tp][j] = a[j]; wv[tp][4 + j] = c[j]; } }
            h16* dst = (ti == 0) ? Qn : (ti == 1 ? Kn : Vh);
#pragma unroll
            for (int r = 0; r < 4; ++r) {
                float y[8]; float ss = 0.f;
#pragma unroll
                for (int j = 0; j < 8; ++j) { float a = wv[0][j] * xr[r][j] + wv[1][j] * xr[r + 1][j] + wv[2][j] * xr[r + 2][j] + wv[3][j] * xr[r + 3][j]; a = silu_f(a); y[j] = a; ss += a * a; }
                float sc = 1.f;
                if (ti < 2) { ss += __shfl_xor(ss, 1); ss += __shfl_xor(ss, 2); ss += __shfl_xor(ss, 4); ss += __shfl_xor(ss, 8); sc = (ti == 0 ? 0.08838834764831845f : 1.0f) * __builtin_amdgcn_rsqf(ss + EPS); }
                h16x8 o;
#pragma unroll
                for (int j = 0; j < 8; ++j) o[j] = (h16)(y[j] * sc);
                *(h16x8*)(dst + (4 * rg + r) * 136 + 8 * cg) = o;
            }
        }
    }
    if (tl < 64) {
        const float* gb = (const float*)(p.ws + OFF_GB) + ((size_t)b * NT + t0 + tl) * 16;
        const float g = gb[h], be = gb[8 + h];
        float gc = g;
#pragma unroll
        for (int o = 1; o < 64; o <<= 1) { const float tt = __shfl_up(gc, o); if (lane >= o) gc += tt; }
        const float gl = __shfl(gc, 63);
        vec[tl] = g; vec[64 + tl] = be; vec[128 + tl] = gc; vec[192 + tl] = __expf(gc);
        float* rv = (float*)(rec + REC_VEC);
        rv[tl] = __expf(gc); rv[64 + tl] = __expf(gl - gc); if (tl == 0) rv[128] = __expf(gl);
    }
    __syncthreads();
    {
        const int rt = w4, fr = lane & 15, kg = lane >> 4;
        h16x8 Ak[4], Aq[4];
#pragma unroll
        for (int s = 0; s < 4; ++s) { Ak[s] = *(const h16x8*)(Kn + (16 * rt + fr) * 136 + 32 * s + 8 * kg); Aq[s] = *(const h16x8*)(Qn + (16 * rt + fr) * 136 + 32 * s + 8 * kg); }
        h16* AF = (h16*)(rec + REC_AF);
#pragma unroll
        for (int ct = 0; ct < 4; ++ct) {
            f32x4 kk = (f32x4){0.f, 0.f, 0.f, 0.f}, qk = (f32x4){0.f, 0.f, 0.f, 0.f};
#pragma unroll
            for (int s = 0; s < 4; ++s) { const h16x8 Bk = *(const h16x8*)(Kn + (16 * ct + fr) * 136 + 32 * s + 8 * kg);
                kk = __builtin_amdgcn_mfma_f32_16x16x32_f16(Ak[s], Bk, kk, 0, 0, 0); qk = __builtin_amdgcn_mfma_f32_16x16x32_f16(Aq[s], Bk, qk, 0, 0, 0); }
            const int j = 16 * ct + fr; const float gcj = vec[128 + j];
#pragma unroll
            for (int rgi = 0; rgi < 4; ++rgi) {
                const int i = 16 * rt + 4 * kg + rgi;
                const float dec = (i >= j) ? __expf(vec[128 + i] - gcj) : 0.f;
                L[i * 64 + j] = (i > j) ? vec[64 + i] * kk[rgi] * dec : 0.f;
                const int sp = ct >> 1, kgp = fr >> 2, j8 = (ct & 1) * 4 + (fr & 3), lanep = 16 * kgp + 4 * kg + rgi;
                AF[((rt * 2 + sp) * 64 + lanep) * 8 + j8] = (h16)(qk[rgi] * dec);
            }
        }
    }
    __syncthreads();
    h16* Tw = (h16*)L; h16* Tu = Tw + 4096;
    if (w4 == 0) {
        float X[64];
#pragma unroll
        for (int i = 0; i < 64; ++i) X[i] = 0.f;
        f32x4 Ln[16]; float rn = (lane == 0) ? 1.f : 0.f;
#pragma unroll
        for (int i = 0; i < 64; ++i) {
            f32x4 Lc[16]; const float rc = rn;
#pragma unroll
            for (int jj = 0; jj < (i + 3) / 4; ++jj) Lc[jj] = Ln[jj];
            if (i + 1 < 64) {
#pragma unroll
                for (int jj = 0; jj < (i + 4) / 4; ++jj) Ln[jj] = *(const f32x4*)(L + (i + 1) * 64 + 4 * jj);
                rn = (lane == i + 1) ? 1.f : 0.f;
            }
            float a0 = rc, a1 = 0.f, a2 = 0.f, a3 = 0.f;
#pragma unroll
            for (int jj = 0; jj < (i + 3) / 4; ++jj) { a0 -= Lc[jj][0] * X[4 * jj]; a1 -= Lc[jj][1] * X[4 * jj + 1]; a2 -= Lc[jj][2] * X[4 * jj + 2]; a3 -= Lc[jj][3] * X[4 * jj + 3]; }
            float acc = (a0 + a1) + (a2 + a3);
            asm volatile("" : "+v"(acc) :: "memory");
            X[i] = acc;
        }
        const float bu = vec[64 + lane], bw = bu * vec[192 + lane];
#pragma unroll
        for (int i = 0; i < 64; ++i) { const int pos = i * 64 + ((((lane >> 3) ^ (i & 7)) << 3) | (lane & 7)); Tw[pos] = (h16)(X[i] * bw); Tu[pos] = (h16)(X[i] * bu); }
    } else {
        const int t3 = tl - 64;
        h16* QF = (h16*)(rec + REC_QF);
        for (int f = t3; f < 1024; f += 192) { const int lanep = f & 63, s = (f >> 6) & 3, rt = f >> 8; const int row = 16 * rt + (lanep & 15), kgp = lanep >> 4;
            const h16x4 a = *(const h16x4*)(Qn + row * 136 + 32 * s + 4 * kgp), c = *(const h16x4*)(Qn + row * 136 + 32 * s + 16 + 4 * kgp);
            h16x8 o; o[0] = a[0]; o[1] = a[1]; o[2] = a[2]; o[3] = a[3]; o[4] = c[0]; o[5] = c[1]; o[6] = c[2]; o[7] = c[3];
            *(h16x8*)(QF + (size_t)f * 8) = o; }
        h16* KTF = (h16*)(rec + REC_KTF);
        for (int f = t3; f < 1024; f += 192) { const int lanep = f & 63, sp = (f >> 6) & 1, rt = f >> 7; const int d = 16 * rt + (lanep & 15), kgp = lanep >> 4;
            h16x8 o;
#pragma unroll
            for (int j8 = 0; j8 < 8; ++j8) { const int c = 32 * sp + (j8 < 4 ? 4 * kgp + j8 : 16 + 4 * kgp + (j8 - 4)); o[j8] = Kn[c * 136 + d]; }
            *(h16x8*)(KTF + (size_t)f * 8) = o; }
    }
    __syncthreads();
    {
        const int rt = w4, fr = lane & 15, kg = lane >> 4, q4 = fr >> 2, pp = fr & 3;
        const LAS unsigned char* Knl = (const LAS unsigned char*)Kn; const LAS unsigned char* Vl = (const LAS unsigned char*)Vh;
        const int trow = 16 * rt + fr;
        h16x8 Tuf[2], Twf[2];
#pragma unroll
        for (int s = 0; s < 2; ++s) { const int off = trow * 64 + ((((4 * s + kg) ^ (trow & 7))) << 3); Tuf[s] = *(const h16x8*)(Tu + off); Twf[s] = *(const h16x8*)(Tw + off); }
        h16* UF = (h16*)(rec + REC_UF);
#pragma unroll
        for (int dvb = 0; dvb < 8; ++dvb) {
            f32x4 acc = (f32x4){0.f, 0.f, 0.f, 0.f};
#pragma unroll
            for (int s = 0; s < 2; ++s) { const LAS unsigned char* a0 = Vl + ((32 * s + 8 * kg + q4) * 136 + 16 * dvb + 4 * pp) * 2;
                const h16x4 lo = lds_tr16(a0), hi4 = lds_tr16(a0 + 4 * 136 * 2);
                h16x8 Bv; Bv[0] = lo[0]; Bv[1] = lo[1]; Bv[2] = lo[2]; Bv[3] = lo[3]; Bv[4] = hi4[0]; Bv[5] = hi4[1]; Bv[6] = hi4[2]; Bv[7] = hi4[3];
                acc = __builtin_amdgcn_mfma_f32_16x16x32_f16(Tuf[s], Bv, acc, 0, 0, 0); }
            h16x4 o; o[0] = (h16)acc[0]; o[1] = (h16)acc[1]; o[2] = (h16)acc[2]; o[3] = (h16)acc[3];
            *(h16x4*)(UF + (size_t)((dvb * 4 + rt) * 64 + lane) * 4) = o;
        }
        h16* WF = (h16*)(rec + REC_WF);
#pragma unroll
        for (int so = 0; so < 4; ++so) {
            f32x4 c0 = (f32x4){0.f, 0.f, 0.f, 0.f}, c1 = (f32x4){0.f, 0.f, 0.f, 0.f};
#pragma unroll
            for (int s = 0; s < 2; ++s) {
                const LAS unsigned char* a0 = Knl + ((32 * s + 8 * kg + q4) * 136 + 16 * (2 * so) + 4 * pp) * 2;
                const h16x4 l0 = lds_tr16(a0), h0 = lds_tr16(a0 + 4 * 136 * 2), l1 = lds_tr16(a0 + 32), h1 = lds_tr16(a0 + 32 + 4 * 136 * 2);
                h16x8 A0, A1; A0[0] = l0[0]; A0[1] = l0[1]; A0[2] = l0[2]; A0[3] = l0[3]; A0[4] = h0[0]; A0[5] = h0[1]; A0[6] = h0[2]; A0[7] = h0[3];
                A1[0] = l1[0]; A1[1] = l1[1]; A1[2] = l1[2]; A1[3] = l1[3]; A1[4] = h1[0]; A1[5] = h1[1]; A1[6] = h1[2]; A1[7] = h1[3];
                c0 = __builtin_amdgcn_mfma_f32_16x16x32_f16(A0, Twf[s], c0, 0, 0, 0); c1 = __builtin_amdgcn_mfma_f32_16x16x32_f16(A1, Twf[s], c1, 0, 0, 0);
            }
            *(h16x8*)(WF + (size_t)((rt * 4 + so) * 64 + lane) * 8) = pack8(-c0, -c1);
        }
    }
}

__device__ __forceinline__ void gdn_scan_task(const Params& p, unsigned char* smem, int bh) {
    const int tid = opaque_tid(), wid = __builtin_amdgcn_readfirstlane(tid >> 6), lane = tid & 63, kg = lane >> 4, fr = lane & 15;
    const int b = bh >> 3, h = bh & 7;
    LAS unsigned char* lds = (LAS unsigned char*)smem;
    const unsigned char* rec0 = p.ws + OFF_REC + (size_t)(bh * 64) * REC_BYTES;
    h16* OB = (h16*)(smem + 2 * REC_DMA);
    const h16* gz = (const h16*)(p.ws + OFF_GZ); h16* omix = (h16*)(p.ws + OFF_OMIX);
    f32x4 Sacc[8];
#pragma unroll
    for (int t = 0; t < 8; ++t) Sacc[t] = (f32x4){0.f, 0.f, 0.f, 0.f};
    h16x4 Uc[4], Un[4];
    __syncthreads();
#define GDN_GLDS(recp, bufi) do { _Pragma("unroll") for (int _i = 0; _i < 7; ++_i) \
        __builtin_amdgcn_global_load_lds((const unsigned*)((recp) + (size_t)(_i * 512 + tid) * 16), (LAS unsigned*)(lds + (bufi) * REC_DMA + (_i * 512 + wid * 64) * 16), 16, 0, 0); \
        if (wid == 0) __builtin_amdgcn_global_load_lds((const unsigned*)((recp) + (size_t)(7 * 512 + tid) * 16), (LAS unsigned*)(lds + (bufi) * REC_DMA + (7 * 512) * 16), 16, 0, 0); } while (0)
#define GDN_LDREG(recp, U_) do { _Pragma("unroll") for (int rt = 0; rt < 4; ++rt) U_[rt] = *(const h16x4*)((recp) + REC_UF + (size_t)((wid * 4 + rt) * 64 + lane) * 8); } while (0)
#define GDN_LDGZ(dst, chunk) do { const h16* gp_ = gz + ((size_t)b * NT + 64 * (chunk) + prow) * 1024 + h * 128 + 16 * pseg; dst[0] = *(const h16x8*)gp_; dst[1] = *(const h16x8*)(gp_ + 8); } while (0)
#define GDN_POST(chunk, gzv) do { const h16* Ob = OB + ((chunk) & 1) * 8192 + prow * 128 + 16 * pseg; const h16x8 a0 = *(const h16x8*)Ob, a1 = *(const h16x8*)(Ob + 8); \
        float ngv[16]; _Pragma("unroll") for (int j = 0; j < 4; ++j) { const f32x4 t4 = *(const f32x4*)(ngl + 16 * pseg + 4 * j); ngv[4 * j] = t4[0]; ngv[4 * j + 1] = t4[1]; ngv[4 * j + 2] = t4[2]; ngv[4 * j + 3] = t4[3]; } \
        float ss = 0.f; _Pragma("unroll") for (int j = 0; j < 8; ++j) { const float u0 = (float)a0[j], u1 = (float)a1[j]; ss += u0 * u0 + u1 * u1; } \
        ss += __shfl_xor(ss, 1); ss += __shfl_xor(ss, 2); ss += __shfl_xor(ss, 4); const float r = __builtin_amdgcn_rsqf(ss * (1.0f / 128.0f) + EPS); \
        h16x8 o0, o1; _Pragma("unroll") for (int j = 0; j < 8; ++j) { o0[j] = (h16)((float)a0[j] * r * ngv[j] * (float)gzv[0][j]); o1[j] = (h16)((float)a1[j] * r * ngv[8 + j] * (float)gzv[1][j]); } \
        h16* op_ = omix + ((size_t)b * NT + 64 * (chunk) + prow) * 2048 + h * 128 + 16 * pseg; *(h16x8*)op_ = o0; *(h16x8*)(op_ + 8) = o1; } while (0)
#define GDN_RD8(X, off0) do { _Pragma("unroll") for (int _j = 0; _j < 8; ++_j) X[_j] = *(const LAS h16x8*)(bufp + (off0) + (_j * 64 + lane) * 16); } while (0)
#define GDN_SB __builtin_amdgcn_sched_barrier(0)
    h16x8 gzp[2], gzn[2];
    const int prow = tid >> 3, pseg = tid & 7;
    float* ngl = (float*)(smem + 2 * REC_DMA + 32768);
    if (tid < 128) ngl[tid] = p.gdn_norm_g[tid];
    GDN_GLDS(rec0, 0);
    GDN_LDREG(rec0, Uc);
    asm volatile("s_waitcnt vmcnt(0)" ::: "memory");
    __syncthreads();
    for (int n = 0; n < 64; ++n) {
        const unsigned char* recn = rec0 + (size_t)(n + 1) * REC_BYTES;
        if (n + 1 < 64) { GDN_GLDS(recn, (n + 1) & 1); GDN_LDREG(recn, Un); }
        GDN_LDGZ(gzn, n);
        if (n > 0) GDN_POST(n - 1, gzp);
        const LAS unsigned char* bufp = lds + (n & 1) * REC_DMA;
        h16x8 X[8], Y[8];
        GDN_RD8(X, REC_WF);
        h16x8 SB[4];
#pragma unroll
        for (int s = 0; s < 4; ++s) SB[s] = pack8(Sacc[2 * s], Sacc[2 * s + 1]);
        f32x4 vacc[4], oacc[4];
#pragma unroll
        for (int rt = 0; rt < 4; ++rt) { vacc[rt] = (f32x4){(float)Uc[rt][0], (float)Uc[rt][1], (float)Uc[rt][2], (float)Uc[rt][3]}; oacc[rt] = (f32x4){0.f, 0.f, 0.f, 0.f}; }
        GDN_SB;
        GDN_RD8(Y, REC_WF + 8192);
#pragma unroll
        for (int j = 0; j < 8; ++j) vacc[j >> 2] = __builtin_amdgcn_mfma_f32_16x16x32_f16(X[j], SB[j & 3], vacc[j >> 2], 0, 0, 0);
        GDN_SB;
        GDN_RD8(X, REC_QF);
#pragma unroll
        for (int j = 0; j < 8; ++j) vacc[2 + (j >> 2)] = __builtin_amdgcn_mfma_f32_16x16x32_f16(Y[j], SB[j & 3], vacc[2 + (j >> 2)], 0, 0, 0);
        GDN_SB;
        GDN_RD8(Y, REC_QF + 8192);
        f32x4 ekv[4], egv[4];
#pragma unroll
        for (int rt = 0; rt < 4; ++rt) { ekv[rt] = *(const LAS f32x4*)(bufp + REC_VEC + 256 + (16 * rt + 4 * kg) * 4); egv[rt] = *(const LAS f32x4*)(bufp + REC_VEC + (16 * rt + 4 * kg) * 4); }
        const float eglc = *(const LAS float*)(bufp + REC_VEC + 512);
#pragma unroll
        for (int j = 0; j < 8; ++j) oacc[j >> 2] = __builtin_amdgcn_mfma_f32_16x16x32_f16(X[j], SB[j & 3], oacc[j >> 2], 0, 0, 0);
        GDN_SB;
        GDN_RD8(X, REC_KTF);
        h16x8 VB[2], VKB[2];
#pragma unroll
        for (int sp = 0; sp < 2; ++sp) { VB[sp] = pack8(vacc[2 * sp], vacc[2 * sp + 1]); VKB[sp] = pack8(vacc[2 * sp] * ekv[2 * sp], vacc[2 * sp + 1] * ekv[2 * sp + 1]); }
#pragma unroll
        for (int j = 0; j < 8; ++j) oacc[2 + (j >> 2)] = __builtin_amdgcn_mfma_f32_16x16x32_f16(Y[j], SB[j & 3], oacc[2 + (j >> 2)], 0, 0, 0);
        GDN_SB;
        GDN_RD8(Y, REC_KTF + 8192);
#pragma unroll
        for (int t = 0; t < 8; ++t) Sacc[t] = Sacc[t] * eglc;
#pragma unroll
        for (int j = 0; j < 8; ++j) Sacc[j >> 1] = __builtin_amdgcn_mfma_f32_16x16x32_f16(X[j], VKB[j & 1], Sacc[j >> 1], 0, 0, 0);
        GDN_SB;
        GDN_RD8(X, REC_AF);
#pragma unroll
        for (int rt = 0; rt < 4; ++rt) oacc[rt] = oacc[rt] * egv[rt];
#pragma unroll
        for (int j = 0; j < 8; ++j) Sacc[4 + (j >> 1)] = __builtin_amdgcn_mfma_f32_16x16x32_f16(Y[j], VKB[j & 1], Sacc[4 + (j >> 1)], 0, 0, 0);
        GDN_SB;
#pragma unroll
        for (int j = 0; j < 8; ++j) oacc[j >> 1] = __builtin_amdgcn_mfma_f32_16x16x32_f16(X[j], VB[j & 1], oacc[j >> 1], 0, 0, 0);
        { h16* Ob = OB + (n & 1) * 8192;
#pragma unroll
          for (int rt = 0; rt < 4; ++rt)
#pragma unroll
              for (int rgi = 0; rgi < 4; ++rgi) Ob[(16 * rt + 4 * kg + rgi) * 128 + 16 * wid + fr] = (h16)oacc[rt][rgi]; }
        asm volatile("s_waitcnt vmcnt(0)" ::: "memory");
        __syncthreads();
#pragma unroll
        for (int rt = 0; rt < 4; ++rt) Uc[rt] = Un[rt];
        gzp[0] = gzn[0]; gzp[1] = gzn[1];
    }
    GDN_POST(63, gzp);
#undef GDN_LDGZ
#undef GDN_POST
#undef GDN_RD8
#undef GDN_SB
#undef GDN_GLDS
#undef GDN_LDREG
}

__device__ __forceinline__ unsigned f2key(float x) { const unsigned u = __float_as_uint(x); return (u & 0x80000000u) ? ~u : (u | 0x80000000u); }
typedef float f32x16 __attribute__((ext_vector_type(16)));
__device__ __forceinline__ float wave_min(float v) {
#pragma unroll
    for (int o = 1; o < 64; o <<= 1) v = fminf(v, __shfl_xor(v, o));
    return v;
}
__device__ __forceinline__ unsigned lane_below(unsigned long long m) { return __builtin_amdgcn_mbcnt_hi((unsigned)(m >> 32), __builtin_amdgcn_mbcnt_lo((unsigned)m, 0u)); }
__device__ __forceinline__ void idx8_task(const Params& p, unsigned char* smem, int b, int qb) {
    const int tid = opaque_tid(), wid = __builtin_amdgcn_readfirstlane(tid >> 6), lane = tid & 63;
    const int t0 = qb * 8;
    unsigned short* selg = (unsigned short*)(p.ws + OFF_SEL) + ((size_t)b * NT + t0) * 256;
    if (t0 + 8 <= 256) {
        for (int i = tid; i < 8 * 256; i += 512) { const int q = i >> 8, k = i & 255; selg[i] = (unsigned short)(k <= t0 + q ? k : 0); }
        return;
    }
    float* sc = (float*)smem;
    ACC_T0();
    unsigned* hist = (unsigned*)(smem + 131072 + wid * 2560);
    unsigned* cand = hist + 256;
    __syncthreads();
    {
        const int n8 = t0 + 8;
        const int ntile = (n8 + 31) >> 5, ntile_pad = ((n8 + 255) >> 8) << 3;
        const h16* iq = (const h16*)(p.ws + OFF_IQ) + ((size_t)b * NT + t0) * 1024;
        const float* iw = (const float*)(p.ws + OFF_IW) + ((size_t)b * NT + t0) * 16;
        const h16* ik = (const h16*)(p.ws + OFF_IK) + (size_t)b * NT * 64;
        const int r = lane & 31, kh = lane >> 5, qq = (r >> 2) & 1, hh = (r & 3) + 4 * (r >> 3);
        h16x8 Af[4][4]; h16x2 Wp[4][8];
#pragma unroll
        for (int a = 0; a < 4; ++a) {
#pragma unroll
            for (int s = 0; s < 4; ++s) Af[a][s] = *(const h16x8*)(iq + (size_t)(2 * a + qq) * 1024 + hh * 64 + 16 * s + 8 * kh);
#pragma unroll
            for (int c = 0; c < 4; ++c) { const f32x4 w4 = *(const f32x4*)(iw + (size_t)(2 * a + kh) * 16 + 4 * c);
                Wp[a][2 * c] = (h16x2){(h16)w4[0], (h16)w4[1]}; Wp[a][2 * c + 1] = (h16x2){(h16)w4[2], (h16)w4[3]}; }
        }
#define IDX_LOADB(Bx, ti) do { const int tc_ = (ti) < ntile ? (ti) : ntile - 1;     \
            _Pragma("unroll") for (int s = 0; s < 4; ++s) Bx[s] = *(const h16x8*)(ik + (size_t)tc_ * 2048 + s * 512 + kh * 256 + r * 8); } while (0)
#define IDX_COMP(Bx, ti) do { if ((ti) < ntile) { const int key = 32 * (ti) + r; f32x16 accs[4]; \
            _Pragma("unroll") for (int a = 0; a < 4; ++a) { _Pragma("unroll") for (int e = 0; e < 16; ++e) accs[a][e] = 0.f; \
                _Pragma("unroll") for (int s = 0; s < 4; ++s) accs[a] = __builtin_amdgcn_mfma_f32_32x32x16_f16(Af[a][s], Bx[s], accs[a], 0, 0, 0); } \
            __builtin_amdgcn_sched_barrier(0); \
            _Pragma("unroll") for (int a = 0; a < 4; ++a) { \
                float s0 = 0.f, s1 = 0.f; _Pragma("unroll") for (int e = 0; e < 8; e += 2) { h16x2 rp = (h16x2){(h16)accs[a][2 * e], (h16)accs[a][2 * e + 1]}; rp = __builtin_elementwise_max(rp, (h16x2){(h16)0.f, (h16)0.f}); s0 = __builtin_amdgcn_fdot2(rp, Wp[a][e], s0, false); \
                    h16x2 rq = (h16x2){(h16)accs[a][2 * e + 2], (h16)accs[a][2 * e + 3]}; rq = __builtin_elementwise_max(rq, (h16x2){(h16)0.f, (h16)0.f}); s1 = __builtin_amdgcn_fdot2(rq, Wp[a][e + 1], s1, false); } \
                const int q = 2 * a + kh; sc[q * 4096 + key] = (key > t0 + q) ? -INFINITY : (s0 + s1); } } } while (0)
        {
            h16x8 B0[4], B1[4], B2[4];
            IDX_LOADB(B0, wid); IDX_LOADB(B1, wid + 8);
            for (int i = wid; i < ntile; i += 24) {
                IDX_LOADB(B2, i + 16); IDX_COMP(B0, i);
                IDX_LOADB(B0, i + 24); IDX_COMP(B1, i + 8);
                IDX_LOADB(B1, i + 32); IDX_COMP(B2, i + 16);
            }
            for (int i = ntile + wid; i < ntile_pad; i += 8) {
#pragma unroll
                for (int a = 0; a < 4; ++a) sc[(2 * a + kh) * 4096 + 32 * i + r] = -INFINITY;
            }
        }
#undef IDX_LOADB
#undef IDX_COMP
    }
    __syncthreads();
    ACC_ADD(1);
    {
        const int tq = t0 + wid, n = tq + 1;
        const float* row = sc + wid * 4096;
        const int ng = (n + 255) >> 8;
        f32x4 x[16];
#pragma unroll
        for (int g = 0; g < 16; ++g) { if (g < ng) x[g] = *(const f32x4*)(row + 256 * g + 4 * lane); else x[g] = (f32x4){-INFINITY, -INFINITY, -INFINITY, -INFINITY}; }
        float hi = -INFINITY, lo = INFINITY;
#pragma unroll
        for (int g = 0; g < 16; ++g)
#pragma unroll
            for (int c = 0; c < 4; ++c) { const float v = x[g][c]; hi = fmaxf(hi, v); lo = fminf(lo, v == -INFINITY ? INFINITY : v); }
        hi = wave_max(hi); lo = wave_min(lo);
        const float scale = (hi > lo) ? 255.99f / (hi - lo) : 0.f; const float off = -lo * scale;
        *(u32x4*)(hist + 4 * lane) = (u32x4){0u, 0u, 0u, 0u};
#pragma unroll
        for (int g = 0; g < 16; ++g) { if (g < ng) {
#pragma unroll
            for (int c = 0; c < 4; ++c) { int bin = (int)fmaf(x[g][c], scale, off); bin = bin < 0 ? 0 : (bin > 255 ? 255 : bin); atomicAdd(&hist[bin], 1u); } } }
        unsigned bstar, need;
        {
            const u32x4 h4 = *(const u32x4*)(hist + 4 * lane); const unsigned s = h4[0] + h4[1] + h4[2] + h4[3];
            unsigned suf = s;
#pragma unroll
            for (int o = 1; o < 64; o <<= 1) { const unsigned tt = __shfl_down(suf, o); if (lane + o < 64) suf += tt; }
            const unsigned above = suf - s;
            const bool mine = (above < 256u && 256u <= suf);
            unsigned cum = above; unsigned bin = 0;
            if (cum + h4[3] >= 256u) bin = 3; else { cum += h4[3]; if (cum + h4[2] >= 256u) bin = 2; else { cum += h4[2]; if (cum + h4[1] >= 256u) bin = 1; else { cum += h4[1]; bin = 0; } } }
            const unsigned long long mm = __ballot(mine);
            const int src = (int)__builtin_ctzll(mm);
            bstar = (unsigned)__shfl((int)(4 * lane + bin), src); need = (unsigned)__shfl((int)(256u - cum), src);
        }
        unsigned short* so = selg + (size_t)wid * 256;
        unsigned short* cidx = (unsigned short*)(cand + 256);
        unsigned m = 0, outb = 0;
#pragma unroll
        for (int g = 0; g < 16; ++g) { if (g < ng) {
#pragma unroll
            for (int c = 0; c < 4; ++c) { int bin = (int)fmaf(x[g][c], scale, off); bin = bin < 0 ? 0 : (bin > 255 ? 255 : bin);
                const bool gt = ((unsigned)bin > bstar), pr = ((unsigned)bin == bstar);
                const unsigned long long mg = __ballot(gt), mk = __ballot(pr);
                if (mg) { const unsigned pos = outb + lane_below(mg); if (gt) so[pos] = (unsigned short)(256 * g + 4 * lane + c); outb += (unsigned)__builtin_popcountll(mg); }
                if (mk) { const unsigned pos = m + lane_below(mk); if (pr && pos < 256u) { cand[pos] = f2key(x[g][c]); cidx[pos] = (unsigned short)(256 * g + 4 * lane + c); } m += (unsigned)__builtin_popcountll(mk); } } } }
        unsigned Kt = 0, rr = need;
        if (m <= 256u) {
            const int nc = (int)((m + 63u) >> 6);
            unsigned cv[4]; unsigned short ci[4];
#pragma unroll
            for (int j = 0; j < 4; ++j) { const bool in = (64 * j + lane < (int)m); cv[j] = in ? cand[64 * j + lane] : 0u; ci[j] = in ? cidx[64 * j + lane] : (unsigned short)0; }
            for (int bit = 31; bit >= 0; --bit) {
                const unsigned test = (Kt | (1u << bit)) >> bit;
                unsigned cnt = (unsigned)__builtin_popcountll(__ballot((cv[0] >> bit) == test));
                if (nc > 1) cnt += (unsigned)__builtin_popcountll(__ballot((cv[1] >> bit) == test));
                if (nc > 2) cnt += (unsigned)__builtin_popcountll(__ballot((cv[2] >> bit) == test));
                if (nc > 3) cnt += (unsigned)__builtin_popcountll(__ballot((cv[3] >> bit) == test));
                if (cnt >= rr) Kt |= (1u << bit); else rr -= cnt;
            }
            unsigned eqb = 0;
#pragma unroll
            for (int j = 0; j < 4; ++j) { if (j < nc) { const bool in = (64 * j + lane < (int)m); const bool gt = in && cv[j] > Kt, eq = in && cv[j] == Kt;
                const unsigned long long me = __ballot(eq); bool take = gt;
                if (me) { const unsigned er = eqb + lane_below(me); take = gt || (eq && er < rr); eqb += (unsigned)__builtin_popcountll(me); }
                const unsigned long long mt = __ballot(take);
                if (mt) { const unsigned pos = outb + lane_below(mt); if (take) so[pos] = ci[j]; outb += (unsigned)__builtin_popcountll(mt); } } }
        } else {
            for (int bit = 31; bit >= 0; --bit) {
                const unsigned test = (Kt | (1u << bit)) >> bit; unsigned cnt = 0;
                for (int idx = lane; idx < ng * 256; idx += 64) { const float v = row[idx]; int bin = (int)fmaf(v, scale, off); bin = bin < 0 ? 0 : (bin > 255 ? 255 : bin);
                    const bool pr = ((unsigned)bin == bstar) && ((f2key(v) >> bit) == test); cnt += (unsigned)__builtin_popcountll(__ballot(pr)); }
                if (cnt >= rr) Kt |= (1u << bit); else rr -= cnt;
            }
            unsigned eqb = 0;
            for (int idx = lane; idx < ng * 256; idx += 64) { const float v = row[idx]; int bin = (int)fmaf(v, scale, off); bin = bin < 0 ? 0 : (bin > 255 ? 255 : bin);
                const unsigned k = f2key(v); const bool inb = ((unsigned)bin == bstar); const bool gt = inb && k > Kt, eq = inb && k == Kt;
                const unsigned long long me = __ballot(eq); bool take = gt;
                if (me) { const unsigned er = eqb + lane_below(me); take = gt || (eq && er < rr); eqb += (unsigned)__builtin_popcountll(me); }
                const unsigned long long mt = __ballot(take);
                if (mt) { const unsigned pos = outb + lane_below(mt); if (take) so[pos] = (unsigned short)idx; outb += (unsigned)__builtin_popcountll(mt); } }
        }
    }
    __syncthreads();
    ACC_ADD(2);
}

typedef unsigned short u16x4 __attribute__((ext_vector_type(4)));
typedef unsigned short u16x8 __attribute__((ext_vector_type(8)));
__device__ __forceinline__ void attn8_task(const Params& p, unsigned char* smem, int part, int o) {
    const int tid = opaque_tid(), wid = __builtin_amdgcn_readfirstlane(tid >> 6), lane = tid & 63, kg = lane >> 4, fr = lane & 15;
    const int b = part >> 1, g = part & 1;
    unsigned char* vl = smem + wid * 17408;
    LAS unsigned char* vll = (LAS unsigned char*)vl;
    const char* akb = (const char*)(p.ws + OFF_AK) + (size_t)b * NT * 256 + g * 128;
    const char* avb = (const char*)(p.ws + OFF_AV) + (size_t)b * NT * 256 + g * 128;
    typedef long i64x2 __attribute__((ext_vector_type(2)));
    constexpr int NQW = 1;
    const int tq0 = 8 * NQW * o + NQW * wid;
    u16x4 kix[4], kixn[4];
#define AT_LOADI(tt, KI) do { const unsigned short* sel_ = (const unsigned short*)(p.ws + OFF_SEL) + ((size_t)b * NT + (tt)) * 256; \
        _Pragma("unroll") for (int c = 0; c < 4; ++c) KI[c] = *(const u16x4*)(sel_ + 64 * c + 4 * fr); } while (0)
    AT_LOADI(tq0, kix);
#pragma unroll 1
    for (int qi = 0; qi < NQW; ++qi) {
    const int t = tq0 + qi; const int bt = b * NT + t; const int nvalid = (t + 1) < 256 ? (t + 1) : 256;
    const unsigned short* sel = (const unsigned short*)(p.ws + OFF_SEL) + (size_t)bt * 256;
    long Qf[4];
    { const char* qp_ = (const char*)(p.ws + OFF_AQ) + (size_t)bt * 1024 + (4 * g + (fr & 3)) * 128 + kg * 32; const i64x2 q0 = *(const i64x2*)qp_, q1 = *(const i64x2*)(qp_ + 16);
      Qf[0] = fr < 4 ? q0[0] : 0l; Qf[1] = fr < 4 ? q0[1] : 0l; Qf[2] = fr < 4 ? q1[0] : 0l; Qf[3] = fr < 4 ? q1[1] : 0l; }
    f32x4 lg[16];
#define AT_LOADK(Kx, c) do { _Pragma("unroll") for (int ii = 0; ii < 4; ++ii) { const char* kp = akb + (unsigned)kix[c][ii] * 256u + 32u * (unsigned)kg; \
        const i64x2 t0 = *(const i64x2*)kp, t1 = *(const i64x2*)(kp + 16); Kx[ii][0] = t0[0]; Kx[ii][1] = t0[1]; Kx[ii][2] = t1[0]; Kx[ii][3] = t1[1]; } } while (0)
#define AT_MMAK(Kx, c) do { _Pragma("unroll") for (int ii = 0; ii < 4; ++ii) { f32x4 a = (f32x4){0.f, 0.f, 0.f, 0.f}; \
        _Pragma("unroll") for (int s = 0; s < 4; ++s) a = __builtin_amdgcn_mfma_f32_16x16x32_fp8_fp8(Kx[ii][s], Qf[s], a, 0, 0, 0); lg[4 * (c) + ii] = a; } } while (0)
#define AT_LOADV(Vx, c) do { const u16x8 i0 = *(const u16x8*)(sel + 64 * (c) + 8 * (lane >> 3)); \
        _Pragma("unroll") for (int it = 0; it < 8; ++it) Vx[it] = *(const u32x4*)(avb + (unsigned)i0[it] * 256u + 16u * (unsigned)(lane & 7)); } while (0)
    u32x4 VA[8], VB[8];
    {
        long K0[4][4], K1[4][4], K2[4][4];
        AT_LOADK(K0, 0); AT_LOADK(K1, 1); AT_LOADK(K2, 2);
        AT_MMAK(K0, 0); AT_LOADK(K0, 3);
        AT_MMAK(K1, 1); AT_LOADV(VA, 0);
        AT_MMAK(K2, 2);
        AT_MMAK(K0, 3);
    }
#define DPP_F(oldv, srcv, ctrl, bank) __builtin_bit_cast(float, __builtin_amdgcn_update_dpp(__builtin_bit_cast(int, (float)(oldv)), __builtin_bit_cast(int, (float)(srcv)), (ctrl), 0xF, (bank), false))
    float val[4][4];
#pragma unroll
    for (int ii = 0; ii < 4; ++ii)
#pragma unroll
        for (int r = 0; r < 4; ++r) { float v = lg[ii][r];
            v = DPP_F(v, lg[4 + ii][r], 0x114, 0x2); v = DPP_F(v, lg[8 + ii][r], 0x118, 0x4); v = DPP_F(v, lg[12 + ii][r], 0x11C, 0x8); val[ii][r] = v; }
    const int cj = fr >> 2;
    float m = -INFINITY;
#pragma unroll
    for (int ii = 0; ii < 4; ++ii)
#pragma unroll
        for (int r = 0; r < 4; ++r) { const int slot = 64 * cj + 16 * kg + 4 * r + ii; const float v = (slot < nvalid) ? val[ii][r] * (0.08838834764831845f * 1.4426950408889634f) : -INFINITY; val[ii][r] = v; m = fmaxf(m, v); }
    m = fmaxf(m, __shfl_xor(m, 4)); m = fmaxf(m, __shfl_xor(m, 8)); m = fmaxf(m, __shfl_xor(m, 16)); m = fmaxf(m, __shfl_xor(m, 32));
    float sum = 0.f;
#pragma unroll
    for (int ii = 0; ii < 4; ++ii)
#pragma unroll
        for (int r = 0; r < 4; ++r) { const float e = __builtin_amdgcn_exp2f(val[ii][r] - m); val[ii][r] = e; sum += e; }
    sum += __shfl_xor(sum, 4); sum += __shfl_xor(sum, 8); sum += __shfl_xor(sum, 16); sum += __shfl_xor(sum, 32);
    const float pscale = __builtin_amdgcn_rcpf(sum) * 256.0f;
    int pl[2][2];
#pragma unroll
    for (int ipl = 0; ipl < 2; ++ipl) { int w0 = 0, w1 = 0;
        w0 = __builtin_amdgcn_cvt_pk_fp8_f32(val[2 * ipl][0] * pscale, val[2 * ipl][1] * pscale, w0, false); w0 = __builtin_amdgcn_cvt_pk_fp8_f32(val[2 * ipl][2] * pscale, val[2 * ipl][3] * pscale, w0, true);
        w1 = __builtin_amdgcn_cvt_pk_fp8_f32(val[2 * ipl + 1][0] * pscale, val[2 * ipl + 1][1] * pscale, w1, false); w1 = __builtin_amdgcn_cvt_pk_fp8_f32(val[2 * ipl + 1][2] * pscale, val[2 * ipl + 1][3] * pscale, w1, true);
        pl[ipl][0] = w0; pl[ipl][1] = w1; }
    long Pf[8];
#pragma unroll
    for (int ipl = 0; ipl < 2; ++ipl) {
        Pf[ipl] = (long)(((unsigned long long)(unsigned)pl[ipl][1] << 32) | (unsigned long long)(unsigned)pl[ipl][0]);
#define PF_GATHER(c, ctrl) do { const int lo_ = __builtin_amdgcn_update_dpp(0, pl[ipl][0], ctrl, 0xF, 0x1, false), hi_ = __builtin_amdgcn_update_dpp(0, pl[ipl][1], ctrl, 0xF, 0x1, false); \
            Pf[2 * (c) + ipl] = (long)(((unsigned long long)(unsigned)hi_ << 32) | (unsigned long long)(unsigned)lo_); } while (0)
        PF_GATHER(1, 0x104); PF_GATHER(2, 0x108); PF_GATHER(3, 0x10C);
#undef PF_GATHER
    }
#undef DPP_F
    f32x4 O[8];
#pragma unroll
    for (int ct = 0; ct < 8; ++ct) O[ct] = (f32x4){0.f, 0.f, 0.f, 0.f};
    if (qi < NQW - 1) AT_LOADI(t + 1, kixn);
    const h16x8 gate = *(const h16x8*)((const h16*)(p.ws + OFF_AZ) + (size_t)bt * 1024 + (4 * g) * 128 + 8 * lane);
    const int q4 = fr >> 2, pp = fr & 3;
    typedef int v2i_t __attribute__((__vector_size__(2 * sizeof(int))));
#define AT_STOREV(Vx) do { _Pragma("unroll") for (int it = 0; it < 8; ++it) { const int r = 8 * (lane >> 3) + it; const int fk = ((r >> 2) & 3) | (((r >> 4) & 1) << 2); \
        *(u32x4*)(vl + r * 128 + (((lane & 7) ^ fk) << 4)) = Vx[it]; } } while (0)
#define AT_PV(c) do { _Pragma("unroll") for (int ipl = 0; ipl < 2; ++ipl) { const int qq = fr >> 1; const int r = 16 * kg + 4 * (qq & 3) + 2 * ipl + (qq >> 2); const int fk = ((r >> 2) & 3) | (((r >> 4) & 1) << 2); \
        _Pragma("unroll") for (int ct = 0; ct < 8; ++ct) { const LAS unsigned char* a0 = vll + r * 128 + ((ct ^ fk) << 4) + (fr & 1) * 8; \
            const v2i_t bv = __builtin_amdgcn_ds_read_tr8_b64_v2i32((LAS v2i_t*)a0); \
            O[ct] = __builtin_amdgcn_mfma_f32_16x16x32_fp8_fp8(Pf[2 * (c) + ipl], __builtin_bit_cast(long, bv), O[ct], 0, 0, 0); } } } while (0)
    AT_LOADV(VB, 1); AT_STOREV(VA); AT_PV(0);
    AT_LOADV(VA, 2); AT_STOREV(VB); AT_PV(1);
    AT_LOADV(VB, 3); AT_STOREV(VA); AT_PV(2);
    AT_STOREV(VB); AT_PV(3);
#undef AT_LOADK
#undef AT_MMAK
#undef AT_LOADV
#undef AT_STOREV
#undef AT_PV
    h16* ot = (h16*)vl;
    if (kg == 0) {
#pragma unroll
        for (int ct = 0; ct < 8; ++ct)
#pragma unroll
            for (int r = 0; r < 4; ++r) ot[r * 128 + 16 * ct + fr] = (h16)O[ct][r];
    }
    {
        const h16x8 ov = *(const h16x8*)(ot + 8 * lane);
        h16x8 res;
#pragma unroll
        for (int j = 0; j < 8; ++j) res[j] = (h16)((float)ov[j] * (float)gate[j] * (1.0f / 256.0f));
        *(h16x8*)((h16*)(p.ws + OFF_OMIX) + (size_t)bt * 2048 + 1024 + (4 * g) * 128 + 8 * lane) = res;
    }
#pragma unroll
    for (int c = 0; c < 4; ++c) kix[c] = kixn[c];
    }
#undef AT_LOADI
}

__device__ __forceinline__ void phase5(const Params& p) {
    const int tid = opaque_tid(), wid = tid >> 6, lane = tid & 63;
    const int gw = blockIdx.x * 8 + wid, nw = gridDim.x * 8;
    const float* rowss = (const float*)(p.ws + OFF_ROWSS);
    for (int row = gw; row < BT; row += nw) {
        const float r = 1.0f / sqrtf(rowss[row] * (1.0f / DM) + EPS);
        f32x4* o = (f32x4*)(p.out + (size_t)row * DM);
        float eadd = 0.f;
        if ((TS_A >= 0 || TS_ACC >= 0) && row < 164) { const unsigned* ts = (const unsigned*)(p.ws + OFF_CTRL + 8192); const float tus = (TS_ACC >= 0) ? (float)ts[16 + (TS_ACC >= 0 ? TS_ACC : 0)] * (0.01f / 256.0f) : (float)(ts[TS_B >= 0 ? TS_B : 0] - ts[TS_A >= 0 ? TS_A : 0]) * 0.01f; eadd = sqrtf(tus * 1e-5f); }
#pragma unroll
        for (int i = 0; i < 8; ++i) { const f32x4 g = ((const f32x4*)p.final_g)[lane + 64 * i]; f32x4 v = o[lane + 64 * i]; v = v * r * g + eadd; o[lane + 64 * i] = v; }
    }
}

#define XB_TMO      128
#define XB_XCNT(j)  (256  + 64 * (j))
#define XB_XSUB(j)  (1280 + 64 * (j))
#define XB_XGEN(j)  (2304 + 64 * (j))
#define XB_TOP      3328
#define XB_TOPGEN   3392
#define XCD_BAR_WORDS 3456
#define XB_SPIN_CAP (1u << 18)

__device__ __forceinline__ unsigned xb_ld(unsigned* p)              { return __hip_atomic_load(p, __ATOMIC_RELAXED, __HIP_MEMORY_SCOPE_AGENT); }
__device__ __forceinline__ unsigned xb_add(unsigned* p, unsigned v) { return __hip_atomic_fetch_add(p, v, __ATOMIC_RELAXED, __HIP_MEMORY_SCOPE_AGENT); }
__device__ __forceinline__ unsigned xb_xcc_id() { return (unsigned)__builtin_amdgcn_s_getreg((3 << 11) | 20) & 0xFu; }
#define XB_SPIN(cond, bar) do { unsigned _sp = 0; while (cond) { __builtin_amdgcn_s_sleep(1); \
    if ((++_sp & 255u) == 0u) { if (xb_ld(&(bar)[XB_TMO])) break; if (_sp > XB_SPIN_CAP) { atomicAdd(&(bar)[XB_TMO], 1u); break; } } } } while (0)

struct XcdBarrier {
    unsigned* bar; unsigned x;
    volatile LAS unsigned* st;
};

__device__ __forceinline__ XcdBarrier xcd_barrier_post(unsigned* bar, volatile LAS unsigned* st) {
    XcdBarrier b; b.bar = bar; b.x = xb_xcc_id(); b.st = st;
    if (threadIdx.x == 0) (void)xb_add(&bar[XB_XCNT(b.x)], 1u);
    return b;
}
__device__ __forceinline__ void xcd_barrier_complete(unsigned* bar, unsigned x, unsigned& nloc, unsigned& nx) {
    const unsigned G = gridDim.x * gridDim.y * gridDim.z;
    unsigned sum, cnt, mine, sp = 0u;
    for (;;) {
        sum = 0u; cnt = 0u; mine = 0u;
#pragma unroll
        for (unsigned j = 0; j < 16; ++j) { const unsigned c = xb_ld(&bar[XB_XCNT(j)]); sum += c; cnt += (c > 0u) ? 1u : 0u; mine = (j == x) ? c : mine; }
        if (sum == G) break;
        __builtin_amdgcn_s_sleep(1);
        if ((++sp & 255u) == 0u) { if (xb_ld(&bar[XB_TMO])) break; if (sp > XB_SPIN_CAP) { atomicAdd(&bar[XB_TMO], 1u); break; } }
    }
    nloc = mine > 0u ? mine : 1u; nx = cnt > 0u ? cnt : 1u;
}

__device__ __forceinline__ void xcd_barrier(const XcdBarrier& b) {
    asm volatile("s_waitcnt vmcnt(0)" ::: "memory");
    __syncthreads();
    if (threadIdx.x == 0) {
        unsigned* bar = b.bar;
        __builtin_amdgcn_s_waitcnt(0);
        unsigned nloc = b.st[0], nx = b.st[1];
        if (nloc == 0u) { xcd_barrier_complete(bar, b.x, nloc, nx); b.st[0] = nloc; b.st[1] = nx; }
        const unsigned old = xb_add(&bar[XB_XSUB(b.x)], 1u);
        const unsigned gen = old / nloc;
        if (old + 1u == (gen + 1u) * nloc) {
            __builtin_amdgcn_fence(__ATOMIC_RELEASE, "agent");
            asm volatile("s_waitcnt vmcnt(0)" ::: "memory");
            const unsigned og = xb_add(&bar[XB_TOP], 1u);
            const unsigned tg = og / nx;
            if (og + 1u == (tg + 1u) * nx) xb_add(&bar[XB_TOPGEN], 1u);
            else XB_SPIN(xb_ld(&bar[XB_TOPGEN]) == tg, bar);
            __builtin_amdgcn_fence(__ATOMIC_ACQUIRE, "agent");
            xb_add(&bar[XB_XGEN(b.x)], 1u);
            asm volatile("s_waitcnt vmcnt(0)" ::: "memory");
        } else {
            XB_SPIN(xb_ld(&bar[XB_XGEN(b.x)]) == gen, bar);
            __builtin_amdgcn_fence(__ATOMIC_ACQUIRE, "agent");
            asm volatile("s_waitcnt vmcnt(0)" ::: "memory");
        }
    }
    __syncthreads();
}


template <int LO, int HI>
__global__ void __launch_bounds__(512, 2) k_phases(Params p) {
    extern __shared__ __attribute__((aligned(16))) unsigned char smem[];
#define IN(k) (LO <= (k) && (k) < HI)
#define SEAM(k) do { if constexpr (IN(k) && IN((k) + 1)) { xcd_barrier(xbar); if (TS_A >= 0 && blockIdx.x == 0 && threadIdx.x == 0) ((unsigned*)(p.ws + OFF_CTRL + 8192))[(k) + 1] = (unsigned)__builtin_amdgcn_s_memrealtime(); } } while (0)
    XcdBarrier xbar; xbar.bar = nullptr; xbar.x = 0; xbar.st = nullptr;
    if constexpr (HI - LO > 1) {
        volatile LAS unsigned* stw = (volatile LAS unsigned*)((LAS unsigned char*)smem + LDS_BYTES - 48);
        if (threadIdx.x < 4) stw[threadIdx.x] = 0u;
        __syncthreads();
        xbar = xcd_barrier_post((unsigned*)(p.ws + OFF_CTRL + 16384), stw);
    }
    if (TS_A >= 0 && blockIdx.x == 0 && threadIdx.x == 0) ((unsigned*)(p.ws + OFF_CTRL + 8192))[0] = (unsigned)__builtin_amdgcn_s_memrealtime();
    if constexpr (IN(0)) { for (int rep = 0; rep < NREP(0); ++rep) phase0(p, smem); }
    SEAM(0);
    if constexpr (IN(1)) for (int rep = 0; rep < NREP(1); ++rep) {
        EpiIn E{p.ws, p.a_log, p.dt_bias, p.pos};
        {
            pg8::Gemm g{(const h16*)(p.ws + OFF_H), (const h16*)(p.ws + OFF_WT), BT, NPAD, DM};
            OrderF16 S; S.init(BT, 21 * 256, gridDim.x, blockIdx.x);
            pg8::gemm_phase<EpiIn, OrderF16>((LAS unsigned char*)smem, g, S, E);
        }
        {
            pg8::Gemm g{(const h16*)(p.ws + OFF_H8), (const h16*)(p.ws + OFF_WT8 - (size_t)16 * 256 * 2048), BT, 2560, DM};
            OrderF8 S; S.G = gridDim.x; S.c = blockIdx.x;
            pg8::gemm_phase<EpiIn, OrderF8, true, true>((LAS unsigned char*)smem, g, S, E);
        }
    }
    SEAM(1);
    if constexpr (IN(2)) for (int rep = 0; rep < NREP(2); ++rep) {
        {
            unsigned* qctr = (unsigned*)(p.ws + OFF_CTRL);
            volatile unsigned* lds_t = (volatile unsigned*)(smem + LDS_BYTES - 16);
            __syncthreads();
            if (threadIdx.x == 0) lds_t[0] = atomicAdd(qctr + 0 + 16 * rep, 1u);
            __syncthreads();
            unsigned o = lds_t[0];
            while (o < 1024u + 2048u) {
                unsigned nxt = 0u;
                if (threadIdx.x == 0) nxt = atomicAdd(qctr + 0 + 16 * rep, 1u);
                if (o < 1024u) { ACC_T0(); gdn_prep_pair(p, smem, (int)o); __syncthreads(); ACC_ADD(0); }
                else { const unsigned o2 = o - 1024u; idx8_task(p, smem, (int)(o2 & 3u), 511 - (int)(o2 >> 2)); }
                __syncthreads();
                if (threadIdx.x == 0) lds_t[0] = nxt;
                __syncthreads();
                o = lds_t[0];
            }
        }
    }
    SEAM(2);
    if constexpr (IN(3)) for (int rep = 0; rep < NREP(3); ++rep) {
        {
            unsigned* qctr = (unsigned*)(p.ws + OFF_CTRL);
            volatile unsigned* lds_t = (volatile unsigned*)(smem + LDS_BYTES - 16);
            volatile unsigned* lds_c = (volatile unsigned*)(smem + LDS_BYTES - 192);
            const int myx = (int)(xb_xcc_id() & 7u);
            for (int pass = 0; pass < 2; ++pass) {
                if (pass == 1) { __syncthreads(); if (threadIdx.x < 8) lds_c[8 + threadIdx.x] = __hip_atomic_load(qctr + 64 + 16 * rep + threadIdx.x, __ATOMIC_RELAXED, __HIP_MEMORY_SCOPE_AGENT); __syncthreads(); }
                const int nk = pass == 0 ? 1 : 8;
                for (int k = 0; k < nk; ++k) {
                    const int sp = (myx + k) & 7;
                    if (pass == 1 && lds_c[8 + sp] >= 4u) continue;
                    for (;;) {
                        __syncthreads();
                        if (threadIdx.x == 0) lds_t[0] = atomicAdd(qctr + 64 + 16 * rep + sp, 1u);
                        __syncthreads();
                        const unsigned o = lds_t[0];
                        if (o >= 4u) break;
                        { ACC_T0(); gdn_scan_task(p, smem, 4 * sp + (int)o); __syncthreads(); ACC_ADD(4); }
                        if (pass == 0) break;
                    }
                }
                if (pass == 0) for (int k = 0; k < 8; ++k) {
                    const int part = (myx + k) & 7;
                    if (k == 1) { __syncthreads(); if (threadIdx.x < 8) lds_c[threadIdx.x] = __hip_atomic_load(qctr + 128 + 16 * rep + threadIdx.x, __ATOMIC_RELAXED, __HIP_MEMORY_SCOPE_AGENT); __syncthreads(); }
                    if (k >= 1 && lds_c[part] >= 512u) continue;
                    __syncthreads();
                    if (threadIdx.x == 0) lds_t[0] = atomicAdd(qctr + 128 + 16 * rep + part, 1u);
                    __syncthreads();
                    unsigned a = lds_t[0];
                    while (a < 512u) {
                        unsigned nxt = 0u;
                        if (threadIdx.x == 0) nxt = atomicAdd(qctr + 128 + 16 * rep + part, 1u);
                        { ACC_T0(); attn8_task(p, smem, part, (int)a); __syncthreads(); ACC_ADD(3); }
                        __syncthreads();
                        if (threadIdx.x == 0) lds_t[0] = nxt;
                        __syncthreads();
                        a = lds_t[0];
                    }
                }
            }
        }
    }
    SEAM(3);
    const bool fuse_norm = (gridDim.x == 256) && (TS_A < 0) && (TS_ACC < 0);
    if constexpr (IN(4)) {
        pg8::Gemm g{(const h16*)(p.ws + OFF_OMIX), (const h16*)(p.ws + OFF_WOT), BT, DM, DM};
        if (fuse_norm) {
            PanelOrder S; S.c = blockIdx.x;
            EpiOutNorm E{p.x, p.out, (float*)(p.ws + OFF_ROWSS), (unsigned*)(p.ws + OFF_CTRL + 32768), p.final_g};
            pg8::gemm_phase<EpiOutNorm, PanelOrder>((LAS unsigned char*)smem, g, S, E);
        } else {
            pg8::StaticOrder S; S.init(BT, DM, gridDim.x, blockIdx.x);
            EpiOut E{p.x, p.out, (float*)(p.ws + OFF_ROWSS)};
            pg8::gemm_phase<EpiOut, pg8::StaticOrder>((LAS unsigned char*)smem, g, S, E);
        }
    }
    if (fuse_norm) return;
    SEAM(4);
    if constexpr (IN(5)) { phase5(p); }
#undef IN
#undef SEAM
}

template <int LO, int HI> static void launch_range(const Params& p, int grid, hipStream_t stream, bool coop) {
    static bool attr = false;
    if (!attr) { hipFuncSetAttribute((const void*)k_phases<LO, HI>, hipFuncAttributeMaxDynamicSharedMemorySize, LDS_BYTES); attr = true; }
    if (coop) {
        Params pp = p; void* args[] = {&pp};
        hipError_t e = hipLaunchCooperativeKernel((const void*)k_phases<LO, HI>, dim3(grid), dim3(512), args, LDS_BYTES, stream);
        if (e != hipSuccess) fprintf(stderr, "cooperative launch failed: %s (grid %d)\n", hipGetErrorString(e), grid);
    } else {
        hipLaunchKernelGGL((k_phases<LO, HI>), dim3(grid), dim3(512), LDS_BYTES, stream, p);
    }
}

extern "C" void kernel_launch(void* const* d_in, const int* in_sizes, int n_in, void* d_out, int out_size, void* d_ws, size_t ws_size, hipStream_t stream) {
    if (n_in != 10 || in_sizes[0] != BT * DM || out_size != BT * DM || ws_size < WS_END) {
        fprintf(stderr, "kernel_launch: unexpected shapes (n_in %d in0 %d out %d ws %zu need %zu)\n", n_in, n_in > 0 ? in_sizes[0] : -1, out_size, ws_size, (size_t)WS_END); return; }
    static int grid = 0;
    if (!grid) {
        int dev = 0, cus = 0, per_cu = 0; hipGetDevice(&dev); hipDeviceGetAttribute(&cus, hipDeviceAttributeMultiprocessorCount, dev);
#if FUSED
        hipFuncSetAttribute((const void*)k_phases<0, 6>, hipFuncAttributeMaxDynamicSharedMemorySize, LDS_BYTES);
        hipOccupancyMaxActiveBlocksPerMultiprocessor(&per_cu, (const void*)k_phases<0, 6>, 512, LDS_BYTES);
#else
        per_cu = 1;
#endif
        if (per_cu < 1) per_cu = 1; if (per_cu > 1) per_cu = 1;
        grid = cus * per_cu;
    }
    Params p{};
    p.x = (const float*)d_in[0]; p.pos = (const int*)d_in[1]; p.attn_g = (const float*)d_in[2]; p.w_in = (const float*)d_in[3]; p.conv_w = (const float*)d_in[4];
    p.a_log = (const float*)d_in[5]; p.dt_bias = (const float*)d_in[6]; p.gdn_norm_g = (const float*)d_in[7]; p.w_out = (const float*)d_in[8]; p.final_g = (const float*)d_in[9];
    p.out = (float*)d_out; p.ws = (unsigned char*)d_ws;
    hipMemsetAsync((char*)d_ws + OFF_CTRL, 0, CTL_ZERO_BYTES, stream);
#if FUSED
    launch_range<0, 6>(p, grid, stream, false);
#else
    launch_range<0, 1>(p, grid, stream, false);
    launch_range<1, 2>(p, grid, stream, false);
    launch_range<2, 3>(p, grid, stream, false);
    launch_range<3, 4>(p, grid, stream, false);
    launch_range<4, 5>(p, grid, stream, false);
    launch_range<5, 6>(p, grid, stream, false);
#endif
}
```

```cpp
#include <hip/hip_runtime.h>
#include <hip/hip_cooperative_groups.h>
#include <cstdio>
#include <cstdint>
namespace cg = cooperative_groups;

#ifndef FUSED
#define FUSED 1
#endif
#ifndef REPEAT_PHASE
#define REPEAT_PHASE -1
#endif
#define NREP(k) ((REPEAT_PHASE == (k)) ? 2 : 1)
#ifndef TS_A
#define TS_A -1
#endif
#ifndef TS_ACC
#define TS_ACC -1
#endif
#define ACC_T0() unsigned acc_t0_ = 0; if (TS_ACC >= 0 && threadIdx.x == 0) acc_t0_ = (unsigned)__builtin_amdgcn_s_memrealtime()
#define ACC_ADD(k) do { if (TS_ACC >= 0 && threadIdx.x == 0) { const unsigned t1_ = (unsigned)__builtin_amdgcn_s_memrealtime(); atomicAdd((unsigned*)(p.ws + OFF_CTRL + 8192) + 16 + (k), t1_ - acc_t0_); acc_t0_ = t1_; } } while (0)
#ifndef TS_B
#define TS_B -1
#endif

#define LAS __attribute__((address_space(3)))
typedef _Float16 h16;
typedef h16 h16x8 __attribute__((ext_vector_type(8)));
typedef h16 h16x4 __attribute__((ext_vector_type(4)));
typedef h16 h16x2 __attribute__((ext_vector_type(2)));
typedef float f32x4 __attribute__((ext_vector_type(4)));
typedef float f32x2 __attribute__((ext_vector_type(2)));
typedef unsigned u32x4 __attribute__((ext_vector_type(4)));

constexpr int NB = 4, NT = 4096, DM = 2048, BT = NB * NT;
constexpr int IN_COLS = 7776, NPAD = 7936;
constexpr float EPS = 1e-6f;
constexpr int LDS_BYTES = 155648;

constexpr size_t MB = 1024 * 1024;
constexpr size_t OFF_CTRL = 0;
constexpr size_t OFF_ROWSS = 65536;
constexpr size_t CTL_ZERO_BYTES = 65536 + (size_t)BT * 4;
constexpr size_t OFF_H = 1 * MB;
constexpr size_t OFF_OMIX = OFF_H;
constexpr size_t OFF_WT = OFF_H + 64 * MB;
constexpr size_t OFF_WOT = OFF_WT + (size_t)NPAD * 2048 * 2;
constexpr size_t OFF_QKVR = OFF_WOT + 8 * MB;
constexpr size_t OFF_GZ = OFF_QKVR + (size_t)BT * 3072 * 2;
constexpr size_t OFF_AQ = OFF_GZ + 32 * MB;
constexpr size_t OFF_AK = OFF_AQ + 32 * MB;
constexpr size_t OFF_AV = OFF_AK + 8 * MB;
constexpr size_t OFF_AZ = OFF_AV + 8 * MB;
constexpr size_t OFF_IQ = OFF_AZ + 32 * MB;
constexpr size_t OFF_IK = OFF_IQ + 32 * MB;
constexpr size_t OFF_GB = OFF_IK + 2 * MB;
constexpr size_t OFF_IW = OFF_GB + 1 * MB;
constexpr size_t OFF_COS = OFF_IW + 1 * MB;
constexpr size_t OFF_SIN = OFF_COS + 2 * MB;
constexpr size_t OFF_SEL = OFF_SIN + 2 * MB;
constexpr size_t OFF_REC = OFF_SEL + 8 * MB;
constexpr size_t OFF_H8 = OFF_REC;
constexpr size_t OFF_WT8 = OFF_REC + 32 * MB;
constexpr size_t WS_END = OFF_REC + (size_t)2048 * 74752;

struct Params {
    const float* x; const int* pos; const float* attn_g; const float* w_in; const float* conv_w; const float* a_log;
    const float* dt_bias; const float* gdn_norm_g; const float* w_out; const float* final_g; float* out; unsigned char* ws;
};

__device__ __forceinline__ float wave_sum(float v) {
#pragma unroll
    for (int o = 1; o < 64; o <<= 1) v += __shfl_xor(v, o);
    return v;
}
__device__ __forceinline__ float wave_max(float v) {
#pragma unroll
    for (int o = 1; o < 64; o <<= 1) v = fmaxf(v, __shfl_xor(v, o));
    return v;
}
__device__ __forceinline__ int opaque_tid() { int t = threadIdx.x; asm volatile("" : "+v"(t)); return t; }
__device__ __forceinline__ float silu_f(float x) { return x * __builtin_amdgcn_rcpf(1.0f + __builtin_amdgcn_exp2f(-1.4426950408889634f * x)); }

namespace pg8 {
constexpr int BM = 256, BK = 64, HALF = 128, HTB = HALF * BK * 2, STAGE_BYTES = 8 * HTB, NXCD = 8, WGM = 8;
__host__ __device__ __forceinline__ int lds_byte(int r, int c) { const int st = (r >> 4) * 2 + (c >> 5), rr = r & 15, cc = c & 31, ob = rr * 64 + cc * 2; return st * 1024 + (ob ^ (((ob >> 9) & 1) << 5)); }
__host__ __device__ __forceinline__ void stage_rc(int b, int& R, int& C) { const int st = b / 1024, sb = b % 1024, swz = sb ^ (((sb >> 9) & 1) << 5); R = (st >> 1) * 16 + swz / 64; C = (st & 1) * 32 + (swz % 64) / 2; }
__host__ __device__ __forceinline__ int perm32(int rho) { const int n = rho >> 4, i = rho & 15; return 8 * (i >> 2) + 4 * n + (i & 3); }
struct Unit { int pm, pn; };
struct Gemm { const h16* A; const h16* Bt; int M, N, K; };
struct StaticOrder {
    int nM, nN, nwg, G, c;
    __host__ __device__ void init(int M, int N, int G_, int c_) { nM = M / BM; nN = N / BM; nwg = nM * nN; G = G_; c = c_; }
    __host__ __device__ bool next(int i, Unit& u) const {
        const long L = (long)i * G + c; if (L >= nwg) return false;
        int wgid = (int)L; { const int q = nwg / NXCD, r = nwg % NXCD, xcd = wgid % NXCD, off = wgid / NXCD; wgid = (xcd < r ? xcd * (q + 1) : r * (q + 1) + (xcd - r) * q) + off; }
        const int nig = WGM * nN, gid = wgid / nig, fm = gid * WGM, gsz = (nM - fm) < WGM ? (nM - fm) : WGM;
        u.pm = fm + ((wgid % nig) % gsz); u.pn = (wgid % nig) / gsz; return true;
    }
    __device__ __forceinline__ void a_ready(const Unit&) const {}
    __device__ __forceinline__ void done(const Unit&) const {}
};

typedef int i32x8 __attribute__((ext_vector_type(8)));
template <class Epi, class Sched, bool SP2 = true, bool F8 = false>
__device__ __forceinline__ void gemm_phase(LAS unsigned char* lds, const Gemm g, const Sched& S, const Epi& E) {
    const int tid = opaque_tid(), wid = __builtin_amdgcn_readfirstlane(tid >> 6), lane = tid & 63, wr = wid >> 2, wc = wid & 3, fr = lane & 15, fq = lane >> 4;
    const int K = g.K;
    const int ESZ = F8 ? 1 : 2, nt = (K * ESZ) / 128;
    unsigned voffA[2], voffB[2];
#pragma unroll
    for (int i = 0; i < 2; ++i) { int R, C; stage_rc(tid * 16 + i * 8192, R, C); const int Rb = Epi::PERM ? ((R & ~31) + perm32(R & 31)) : R;
        voffA[i] = (unsigned)(R * K * ESZ + C * 2); voffB[i] = (unsigned)(Rb * K * ESZ + C * 2); }
    const size_t kstep = (size_t)(BK * 2);
    const size_t hstep = (size_t)HALF * K * ESZ;
    const size_t tstep = 2 * hstep;
    const unsigned ldsw = (unsigned)wid * 1024u;
    const int aoff = lds_byte(wr * 64 + fr, fq * 8), boff = lds_byte(wc * 32 + fr, fq * 8);
#define PG8_SA(b, h) (((b) * 2 + (h)) * HTB)
#define PG8_SB(b, h) ((4 + (b) * 2 + (h)) * HTB)
#define PG8_STAGE(bufoff, gbase, voff) do { _Pragma("unroll") for (int _i = 0; _i < 2; ++_i) \
        __builtin_amdgcn_global_load_lds((const unsigned*)((const char*)(gbase) + (voff)[_i]), (LAS unsigned*)(lds + (bufoff) + ldsw + _i * 8192), 16, 0, 0); } while (0)
#define PG8_LDA(dst, b, h) do { _Pragma("unroll") for (int m = 0; m < 4; ++m) _Pragma("unroll") for (int k = 0; k < 2; ++k) dst[m][k] = *(const LAS h16x8*)(lds + PG8_SA(b, h) + aoff + m * 2048 + k * 1024); } while (0)
#define PG8_LDB(dst, b, h) do { _Pragma("unroll") for (int n = 0; n < 2; ++n) _Pragma("unroll") for (int k = 0; k < 2; ++k) dst[n][k] = *(const LAS h16x8*)(lds + PG8_SB(b, h) + boff + n * 2048 + k * 1024); } while (0)
#define PG8_MMA(ai, bj, At, Bt) do { __builtin_amdgcn_s_setprio(1); \
        if constexpr (F8) { _Pragma("unroll") for (int m = 0; m < 4; ++m) _Pragma("unroll") for (int n = 0; n < 2; ++n) { \
            const u32x4 b0_ = __builtin_bit_cast(u32x4, Bt[n][0]), b1_ = __builtin_bit_cast(u32x4, Bt[n][1]), a0_ = __builtin_bit_cast(u32x4, At[m][0]), a1_ = __builtin_bit_cast(u32x4, At[m][1]); \
            const i32x8 bw_ = (i32x8){(int)b0_[0], (int)b0_[1], (int)b0_[2], (int)b0_[3], (int)b1_[0], (int)b1_[1], (int)b1_[2], (int)b1_[3]}; \
            const i32x8 aw_ = (i32x8){(int)a0_[0], (int)a0_[1], (int)a0_[2], (int)a0_[3], (int)a1_[0], (int)a1_[1], (int)a1_[2], (int)a1_[3]}; \
            asm volatile("v_mfma_scale_f32_16x16x128_f8f6f4 %0, %1, %2, %0, %3, %3 op_sel_hi:[0,0,0]" : "+v"(acc[ai][bj][m][n]) : "v"(bw_), "v"(aw_), "v"(0x7C7C7C7C)); } } \
        else { _Pragma("unroll") for (int m = 0; m < 4; ++m) _Pragma("unroll") for (int n = 0; n < 2; ++n) _Pragma("unroll") for (int k = 0; k < 2; ++k) \
            acc[ai][bj][m][n] = __builtin_amdgcn_mfma_f32_16x16x32_f16(Bt[n][k], At[m][k], acc[ai][bj][m][n], 0, 0, 0); } \
        __builtin_amdgcn_s_setprio(0); } while (0)
#define PG8_WAIT_V(n) asm volatile("s_waitcnt vmcnt(" #n ")" ::: "memory")
#define PG8_WAIT_L(n) asm volatile("s_waitcnt lgkmcnt(" #n ")" ::: "memory")
#define PG8_BAR __builtin_amdgcn_s_barrier()
#define PG8_SCHED __builtin_amdgcn_sched_barrier(0)
    Unit cur, nxt; int ui = 0;
    if (!S.next(0, cur)) return;
    f32x4 acc[2][2][4][2];
#pragma unroll
    for (int a = 0; a < 2; ++a)
#pragma unroll
        for (int b = 0; b < 2; ++b)
#pragma unroll
            for (int m = 0; m < 4; ++m)
#pragma unroll
                for (int n = 0; n < 2; ++n) acc[a][b][m][n] = (f32x4){0.f, 0.f, 0.f, 0.f};
    h16x8 At[4][2], B0[2][2], B1[2][2];
    const char* cA = (const char*)g.A + (size_t)cur.pm * tstep; const char* cB = (const char*)g.Bt + (size_t)cur.pn * tstep;
    S.a_ready(cur);
    if constexpr (SP2) {
        PG8_STAGE(PG8_SB(0, 0), cB, voffB); PG8_STAGE(PG8_SB(0, 1), cB + hstep, voffB); PG8_STAGE(PG8_SA(0, 0), cA, voffA); PG8_STAGE(PG8_SA(0, 1), cA + hstep, voffA);
        if (wr == 1) PG8_BAR;
        PG8_WAIT_V(2); PG8_BAR;
        PG8_STAGE(PG8_SB(1, 0), cB + kstep, voffB); PG8_STAGE(PG8_SA(1, 0), cA + kstep, voffA); PG8_STAGE(PG8_SB(1, 1), cB + hstep + kstep, voffB);
        PG8_WAIT_V(6); PG8_BAR;
    } else {
    PG8_STAGE(PG8_SB(0, 0), cB, voffB); PG8_STAGE(PG8_SA(0, 0), cA, voffA); PG8_STAGE(PG8_SB(0, 1), cB + hstep, voffB); PG8_STAGE(PG8_SA(0, 1), cA + hstep, voffA);
    if (wr == 1) PG8_BAR;
    PG8_WAIT_V(4); PG8_BAR;
    PG8_STAGE(PG8_SB(1, 0), cB + kstep, voffB); PG8_STAGE(PG8_SA(1, 0), cA + kstep, voffA); PG8_STAGE(PG8_SB(1, 1), cB + hstep + kstep, voffB);
    PG8_WAIT_V(6); PG8_BAR;
    }
    for (;;) {
        const bool has_next = S.next(ui + 1, nxt);
        const char* nA = has_next ? (const char*)g.A + (size_t)nxt.pm * tstep : cA; const char* nB = has_next ? (const char*)g.Bt + (size_t)nxt.pn * tstep : cB;
        for (int t = 0; t < nt; t += 2) {
            const bool last = (t == nt - 2);
            const char* a1 = cA + (size_t)(t + 1) * kstep;
            const char* a2 = last ? nA : cA + (size_t)(t + 2) * kstep; const char* b2 = last ? nB : cB + (size_t)(t + 2) * kstep;
            const char* a3 = a2 + kstep; const char* b3 = b2 + kstep;
            if (last && has_next) S.a_ready(nxt);
            if constexpr (SP2) {
            PG8_LDB(B0, 0, 0); PG8_LDB(B1, 0, 1); PG8_SCHED; PG8_LDA(At, 0, 0); PG8_STAGE(PG8_SA(1, 1), a1 + hstep, voffA);
            PG8_WAIT_V(8); PG8_WAIT_L(0); PG8_BAR; PG8_MMA(0, 0, At, B0); PG8_MMA(0, 1, At, B1); PG8_BAR; PG8_SCHED;
            PG8_LDA(At, 0, 1); PG8_STAGE(PG8_SB(0, 0), b2, voffB); PG8_STAGE(PG8_SB(0, 1), b2 + hstep, voffB); PG8_STAGE(PG8_SA(0, 0), a2, voffA);
            PG8_WAIT_V(8); PG8_WAIT_L(0); PG8_BAR; PG8_MMA(1, 0, At, B0); PG8_MMA(1, 1, At, B1); PG8_BAR; PG8_SCHED;
            PG8_LDB(B0, 1, 0); PG8_LDB(B1, 1, 1); PG8_SCHED; PG8_LDA(At, 1, 0); PG8_STAGE(PG8_SA(0, 1), a2 + hstep, voffA);
            PG8_WAIT_V(8); PG8_WAIT_L(0); PG8_BAR; PG8_MMA(0, 0, At, B0); PG8_MMA(0, 1, At, B1); PG8_BAR; PG8_SCHED;
            PG8_LDA(At, 1, 1); PG8_STAGE(PG8_SB(1, 0), b3, voffB); PG8_STAGE(PG8_SB(1, 1), b3 + hstep, voffB); PG8_STAGE(PG8_SA(1, 0), a3, voffA);
            PG8_WAIT_V(8); PG8_WAIT_L(0); PG8_BAR; PG8_MMA(1, 0, At, B0); PG8_MMA(1, 1, At, B1); PG8_BAR; PG8_SCHED;
            } else {
            PG8_LDB(B0, 0, 0); PG8_SCHED; PG8_LDA(At, 0, 0); PG8_STAGE(PG8_SA(1, 1), a1 + hstep, voffA);
            PG8_WAIT_L(8); PG8_BAR; PG8_WAIT_L(0); PG8_MMA(0, 0, At, B0); PG8_BAR; PG8_SCHED;
            PG8_LDB(B1, 0, 1); PG8_STAGE(PG8_SB(0, 0), b2, voffB);
            PG8_BAR; PG8_WAIT_L(0); PG8_MMA(0, 1, At, B1); PG8_BAR;
            PG8_LDA(At, 0, 1); PG8_STAGE(PG8_SA(0, 0), a2, voffA);
            PG8_BAR; PG8_WAIT_L(0); PG8_MMA(1, 0, At, B0); PG8_BAR; PG8_SCHED;
            PG8_STAGE(PG8_SB(0, 1), b2 + hstep, voffB);
            PG8_WAIT_V(6); PG8_BAR; PG8_MMA(1, 1, At, B1); PG8_BAR;
            PG8_LDB(B0, 1, 0); PG8_SCHED; PG8_LDA(At, 1, 0); PG8_STAGE(PG8_SA(0, 1), a2 + hstep, voffA);
            PG8_WAIT_L(8); PG8_BAR; PG8_WAIT_L(0); PG8_MMA(0, 0, At, B0); PG8_BAR; PG8_SCHED;
            PG8_LDB(B1, 1, 1); PG8_STAGE(PG8_SB(1, 0), b3, voffB);
            PG8_BAR; PG8_WAIT_L(0); PG8_MMA(0, 1, At, B1); PG8_BAR;
            PG8_LDA(At, 1, 1); PG8_STAGE(PG8_SA(1, 0), a3, voffA);
            PG8_BAR; PG8_WAIT_L(0); PG8_MMA(1, 0, At, B0); PG8_BAR; PG8_SCHED;
            PG8_STAGE(PG8_SB(1, 1), b3 + hstep, voffB);
            PG8_WAIT_V(6); PG8_BAR; PG8_MMA(1, 1, At, B1); PG8_BAR;
            }
        }
        if (wr == 0) PG8_BAR;
        if constexpr (F8) asm volatile("s_nop 15\n\ts_nop 15" ::: "memory");
        PG8_SCHED; { const int te = opaque_tid(), le = te & 63; E(acc, cur, wr, wc, le & 15, le >> 4); } S.done(cur);
        if (!has_next) break;
#pragma unroll
        for (int a = 0; a < 2; ++a)
#pragma unroll
            for (int b = 0; b < 2; ++b)
#pragma unroll
                for (int m = 0; m < 4; ++m)
#pragma unroll
                    for (int n = 0; n < 2; ++n) acc[a][b][m][n] = (f32x4){0.f, 0.f, 0.f, 0.f};
        cur = nxt; cA = nA; cB = nB; ++ui;
        if (wr == 1) PG8_BAR;
    }
    PG8_WAIT_V(0);
    PG8_BAR;
#undef PG8_SA
#undef PG8_SB
#undef PG8_STAGE
#undef PG8_LDA
#undef PG8_LDB
#undef PG8_MMA
#undef PG8_WAIT_V
#undef PG8_WAIT_L
#undef PG8_BAR
#undef PG8_SCHED
}
}

struct OrderF16 : pg8::StaticOrder {
    __device__ __forceinline__ bool next(int i, pg8::Unit& u) const { if (!pg8::StaticOrder::next(i, u)) return false; if (u.pn >= 16) u.pn += 10; return true; }
};
struct OrderF8 {
    int G, c;
    __device__ __forceinline__ bool next(int i, pg8::Unit& u) const {
        int L;
        if (G == 256) { if (c < 64) { if (i >= 1) return false; L = 576 + c; } else { if (i >= 3) return false; L = (c - 64) + 192 * i; } }
        else { L = i * G + c; if (L >= 640) return false; }
        const int wgid = (L % 8) * 80 + L / 8;
        u.pm = (wgid / 80) * 8 + (wgid % 80) % 8; u.pn = 16 + (wgid % 80) / 8; return true;
    }
    __device__ __forceinline__ void a_ready(const pg8::Unit&) const {}
    __device__ __forceinline__ void done(const pg8::Unit&) const {}
};

struct EpiIn {
    static constexpr bool PERM = true;
    unsigned char* ws; const float* a_log; const float* dt_bias; const int* pos;
    __device__ __forceinline__ void operator()(const f32x4 (&acc)[2][2][4][2], const pg8::Unit& u, int wr, int wc, int fr, int fq) const {
        constexpr float RF[16] = {1.591549431e-01f, 7.008652159e-02f, 3.086376340e-02f, 1.359137064e-02f, 5.985185713e-03f, 2.635675899e-03f, 1.160663641e-03f, 5.111175045e-04f,
                                  2.250790790e-04f, 9.911730937e-05f, 4.364795279e-05f, 1.922110068e-05f, 8.464330808e-06f, 3.727408602e-06f, 1.641426263e-06f, 7.228293069e-07f};
        const int pn = u.pn;
        const int rowb = u.pm * 256 + wr * 64 + fr;
        const int cw = wc * 32 + 8 * fq;
        if (pn < 30) {
            h16* base; int ldc, colt, mode; float scale = 1.f;
            if (pn < 12) { base = (h16*)(ws + OFF_QKVR); ldc = 3072; colt = pn * 256; mode = 0; }
            else if (pn < 16) { base = (h16*)(ws + OFF_GZ); ldc = 1024; colt = (pn - 12) * 256; mode = 1; }
            else if (pn < 20) { base = (h16*)(ws + OFF_AQ); ldc = 1024; colt = (pn - 16) * 256; mode = 2; }
            else if (pn == 20) { base = (h16*)(ws + OFF_AK); ldc = 256; colt = 0; mode = 2; }
            else if (pn == 21) { base = (h16*)(ws + OFF_AV); ldc = 256; colt = 0; mode = 4; }
            else if (pn < 26) { base = (h16*)(ws + OFF_AZ); ldc = 1024; colt = (pn - 22) * 256; mode = 1; }
            else { base = (h16*)(ws + OFF_IQ); ldc = 1024; colt = (pn - 26) * 256; mode = 3; }
            const bool rot_wave = (mode == 2 && wc == 0) || (mode == 3 && (wc & 1) == 0);
            const int xm = (mode == 2) ? 32 : 16;
            const bool rot_lane = (mode == 2) ? true : (fq < 2);
            const float sgn = (mode == 2) ? (fq < 2 ? -1.f : 1.f) : (fq == 0 ? -1.f : 1.f);
            float Fq[8]; int ps[2][4];
#pragma unroll
            for (int j = 0; j < 8; ++j) Fq[j] = (mode == 2) ? ((fq & 1) ? RF[8 + j] : RF[j]) : RF[2 * j];
            if (rot_wave) {
#pragma unroll
                for (int ai = 0; ai < 2; ++ai)
#pragma unroll
                    for (int m = 0; m < 4; ++m) ps[ai][m] = pos[rowb + ai * 128 + m * 16];
            }
#pragma unroll
            for (int ai = 0; ai < 2; ++ai)
#pragma unroll
                for (int m = 0; m < 4; ++m) {
                    const int row = rowb + ai * 128 + m * 16;
                    float cs[8], sn[8];
                    if (rot_wave) {
                        const float pf = (float)ps[ai][m];
#pragma unroll
                        for (int j = 0; j < 8; ++j) { const float rv = __builtin_amdgcn_fractf(pf * Fq[j]); cs[j] = __builtin_amdgcn_cosf(rv); sn[j] = __builtin_amdgcn_sinf(rv); }
                    }
#pragma unroll
                    for (int bj = 0; bj < 2; ++bj) {
                        float v[8];
#pragma unroll
                        for (int j = 0; j < 4; ++j) { v[j] = acc[ai][bj][m][0][j]; v[4 + j] = acc[ai][bj][m][1][j]; }
                        if (rot_wave) {
#pragma unroll
                            for (int j = 0; j < 8; ++j) {
                                const unsigned xv = __builtin_bit_cast(unsigned, v[j]); float pv;
                                if (mode == 2) { const auto sw = __builtin_amdgcn_permlane32_swap(xv, xv, false, false); pv = __builtin_bit_cast(float, fq < 2 ? sw[1] : sw[0]); }
                                else { const auto sw = __builtin_amdgcn_permlane16_swap(xv, xv, false, false); pv = __builtin_bit_cast(float, (fq & 1) ? sw[0] : sw[1]); }
                                if (rot_lane) v[j] = v[j] * cs[j] + sgn * pv * sn[j]; }
                        }
                        if (mode == 1) {
#pragma unroll
                            for (int j = 0; j < 8; ++j) v[j] = silu_f(v[j]);
                        }
                        if (mode == 4) {
                            int w0 = 0, w1 = 0;
                            w0 = __builtin_amdgcn_cvt_pk_fp8_f32(v[0], v[1], w0, false); w0 = __builtin_amdgcn_cvt_pk_fp8_f32(v[2], v[3], w0, true);
                            w1 = __builtin_amdgcn_cvt_pk_fp8_f32(v[4], v[5], w1, false); w1 = __builtin_amdgcn_cvt_pk_fp8_f32(v[6], v[7], w1, true);
                            typedef int i32x2b __attribute__((ext_vector_type(2)));
                            *(i32x2b*)((unsigned char*)base + (size_t)row * ldc + bj * 128 + cw) = (i32x2b){w0, w1};
                        } else if (mode == 2) {
                            int w0 = 0, w1 = 0;
                            w0 = __builtin_amdgcn_cvt_pk_fp8_f32(v[0], v[1], w0, false); w0 = __builtin_amdgcn_cvt_pk_fp8_f32(v[2], v[3], w0, true);
                            w1 = __builtin_amdgcn_cvt_pk_fp8_f32(v[4], v[5], w1, false); w1 = __builtin_amdgcn_cvt_pk_fp8_f32(v[6], v[7], w1, true);
                            typedef int i32x2 __attribute__((ext_vector_type(2)));
                            *(i32x2*)((unsigned char*)base + (size_t)row * ldc + colt + bj * 128 + cw) = (i32x2){w0, w1};
                        } else {
                            h16x8 o;
#pragma unroll
                            for (int j = 0; j < 8; ++j) o[j] = (h16)(v[j] * scale);
                            *(h16x8*)(base + (size_t)row * ldc + colt + bj * 128 + cw) = o;
                        }
                    }
                }
        } else {
            h16* ik = (h16*)(ws + OFF_IK); float* gb = (float*)(ws + OFF_GB); float* iw = (float*)(ws + OFF_IW);
#pragma unroll
            for (int ai = 0; ai < 2; ++ai)
#pragma unroll
                for (int m = 0; m < 4; ++m) {
                    const int row = rowb + ai * 128 + m * 16;
                    float v[8];
#pragma unroll
                    for (int j = 0; j < 4; ++j) { v[j] = acc[ai][0][m][0][j]; v[4 + j] = acc[ai][0][m][1][j]; }
                    if (wc == 0) {
                        const float sgn = (fq == 0 ? -1.f : 1.f), pf = (float)pos[row];
#pragma unroll
                        for (int j = 0; j < 8; ++j) { const unsigned xv = __builtin_bit_cast(unsigned, v[j]); const auto sw = __builtin_amdgcn_permlane16_swap(xv, xv, false, false); const float pv = __builtin_bit_cast(float, (fq & 1) ? sw[0] : sw[1]); const float rv = __builtin_amdgcn_fractf(pf * RF[2 * j]); const float c = __builtin_amdgcn_cosf(rv), s = __builtin_amdgcn_sinf(rv);
                            if (fq < 2) v[j] = v[j] * c + sgn * pv * s; }
                    }
                    if (wc < 2) {
                        h16x8 o;
#pragma unroll
                        for (int j = 0; j < 8; ++j) o[j] = (h16)v[j];
                        *(h16x8*)(ik + (size_t)(row >> 5) * 2048 + (cw >> 4) * 512 + ((cw >> 3) & 1) * 256 + (row & 31) * 8) = o;
                    } else if (wc == 2) {
                        if (fq == 0) {
#pragma unroll
                            for (int j = 0; j < 8; ++j) { const float z = v[j] + dt_bias[j];
                                const float sp = fmaxf(z, 0.f) + 0.6931471805599453f * __builtin_amdgcn_logf(1.0f + __builtin_amdgcn_exp2f(-1.4426950408889634f * fabsf(z)));
                                gb[(size_t)row * 16 + j] = -__builtin_amdgcn_exp2f(1.4426950408889634f * a_log[j]) * sp; }
                        } else if (fq == 1) {
#pragma unroll
                            for (int j = 0; j < 8; ++j) gb[(size_t)row * 16 + 8 + j] = __builtin_amdgcn_rcpf(1.0f + __builtin_amdgcn_exp2f(-1.4426950408889634f * v[j]));
                        } else {
#pragma unroll
                            for (int j = 0; j < 8; ++j) iw[(size_t)row * 16 + 8 * (fq - 2) + j] = v[j] * 0.03125f;
                        }
                    }
                }
        }
    }
};

struct PanelOrder {
    int c;
    __device__ __forceinline__ bool next(int i, pg8::Unit& u) const { if (i >= 2) return false; u.pm = 32 * i + 4 * (c & 7) + (c >> 6); u.pn = (c >> 3) & 7; return true; }
    __device__ __forceinline__ void a_ready(const pg8::Unit&) const {}
    __device__ __forceinline__ void done(const pg8::Unit&) const {}
};
struct EpiOutNorm {
    static constexpr bool PERM = false;
    const float* x; float* out; float* rowss; unsigned* cnt; const float* fg;
    __device__ __forceinline__ void operator()(f32x4 (&acc)[2][2][4][2], const pg8::Unit& u, int wr, int wc, int fr, int fq) const {
        const int rowb = u.pm * 256 + wr * 64 + fr, col0 = u.pn * 256 + wc * 32 + 4 * fq;
#pragma unroll
        for (int ai = 0; ai < 2; ++ai)
#pragma unroll
            for (int m = 0; m < 4; ++m) {
                const int row = rowb + ai * 128 + m * 16; float ss = 0.f;
#pragma unroll
                for (int bj = 0; bj < 2; ++bj)
#pragma unroll
                    for (int n = 0; n < 2; ++n) {
                        const f32x4 y = *(const f32x4*)(x + (size_t)row * DM + col0 + bj * 128 + n * 16) + acc[ai][bj][m][n];
                        acc[ai][bj][m][n] = y; ss += (y[0] * y[0] + y[1] * y[1]) + (y[2] * y[2] + y[3] * y[3]);
                    }
                ss += __shfl_xor(ss, 16); ss += __shfl_xor(ss, 32);
                if (fq == 0) atomicAdd(rowss + row, ss);
            }
        asm volatile("s_waitcnt vmcnt(0)" ::: "memory");
        unsigned* cw = cnt + (u.pm * 2 + wr) * 16;
        if ((threadIdx.x & 63) == 0) __hip_atomic_fetch_add(cw, 1u, __ATOMIC_RELAXED, __HIP_MEMORY_SCOPE_AGENT);
        { unsigned spins = 0;
          while ((unsigned)__builtin_amdgcn_readfirstlane((int)__hip_atomic_load(cw, __ATOMIC_RELAXED, __HIP_MEMORY_SCOPE_AGENT)) < 32u) { __builtin_amdgcn_s_sleep(2); if (++spins > (1u << 22)) break; } }
        f32x4 gv[2][2];
#pragma unroll
        for (int bj = 0; bj < 2; ++bj)
#pragma unroll
            for (int n = 0; n < 2; ++n) gv[bj][n] = *(const f32x4*)(fg + col0 + bj * 128 + n * 16);
#pragma unroll
        for (int ai = 0; ai < 2; ++ai)
#pragma unroll
            for (int m = 0; m < 4; ++m) {
                const int row = rowb + ai * 128 + m * 16;
                const float ssr = __hip_atomic_load(rowss + row, __ATOMIC_RELAXED, __HIP_MEMORY_SCOPE_AGENT);
                const float r = __builtin_amdgcn_rsqf(ssr * (1.0f / DM) + EPS);
#pragma unroll
                for (int bj = 0; bj < 2; ++bj)
#pragma unroll
                    for (int n = 0; n < 2; ++n) *(f32x4*)(out + (size_t)row * DM + col0 + bj * 128 + n * 16) = acc[ai][bj][m][n] * r * gv[bj][n];
            }
    }
};

struct EpiOut {
    static constexpr bool PERM = false;
    const float* x; float* out; float* rowss;
    __device__ __forceinline__ void operator()(const f32x4 (&acc)[2][2][4][2], const pg8::Unit& u, int wr, int wc, int fr, int fq) const {
        const int rowb = u.pm * 256 + wr * 64 + fr, col0 = u.pn * 256 + wc * 32 + 4 * fq;
#pragma unroll
        for (int ai = 0; ai < 2; ++ai)
#pragma unroll
            for (int m = 0; m < 4; ++m) {
                const int row = rowb + ai * 128 + m * 16; float ss = 0.f;
#pragma unroll
                for (int bj = 0; bj < 2; ++bj)
#pragma unroll
                    for (int n = 0; n < 2; ++n) {
                        const size_t off = (size_t)row * DM + col0 + bj * 128 + n * 16;
                        const f32x4 y = *(const f32x4*)(x + off) + acc[ai][bj][m][n];
                        *(f32x4*)(out + off) = y; ss += (y[0] * y[0] + y[1] * y[1]) + (y[2] * y[2] + y[3] * y[3]);
                    }
                ss += __shfl_xor(ss, 16); ss += __shfl_xor(ss, 32);
                if (fq == 0) atomicAdd(rowss + row, ss);
            }
    }
};

__device__ __forceinline__ int src_col(int np) {
    if (np < 4096) return np;
    if (np < 7680) return np + 16;
    if (np < 7744) return 7696 + (np - 7680);
    if (np < 7752) return 4096 + (np - 7744);
    if (np < 7760) return 4104 + (np - 7752);
    if (np < 7776) return np;
    return -1;
}
__device__ __forceinline__ void phase0(const Params& p, unsigned char* smem) {
    const int tid = opaque_tid(), wid = tid >> 6, lane = tid & 63;
    const int gw = blockIdx.x * 8 + wid, nw = gridDim.x * 8;
    h16* H = (h16*)(p.ws + OFF_H); unsigned char* H8 = p.ws + OFF_H8;
    for (int row = 2 * gw; row < BT; row += 2 * nw) {
        const f32x4* xr0 = (const f32x4*)(p.x + (size_t)row * DM); const f32x4* xr1 = xr0 + DM / 4;
        f32x4 v0[8], v1[8]; float s0 = 0.f, s1 = 0.f;
#pragma unroll
        for (int i = 0; i < 8; ++i) { v0[i] = xr0[lane + 64 * i]; v1[i] = xr1[lane + 64 * i]; }
#pragma unroll
        for (int i = 0; i < 8; ++i) { s0 += (v0[i][0] * v0[i][0] + v0[i][1] * v0[i][1]) + (v0[i][2] * v0[i][2] + v0[i][3] * v0[i][3]); s1 += (v1[i][0] * v1[i][0] + v1[i][1] * v1[i][1]) + (v1[i][2] * v1[i][2] + v1[i][3] * v1[i][3]); }
        s0 = wave_sum(s0); s1 = wave_sum(s1);
        const float r0 = __builtin_amdgcn_rsqf(s0 * (1.0f / DM) + EPS), r1 = __builtin_amdgcn_rsqf(s1 * (1.0f / DM) + EPS);
#pragma unroll
        for (int i = 0; i < 8; ++i) { const f32x4 g = ((const f32x4*)p.attn_g)[lane + 64 * i]; h16x4 o0, o1;
#pragma unroll
            for (int j = 0; j < 4; ++j) { o0[j] = (h16)(v0[i][j] * r0 * g[j]); o1[j] = (h16)(v1[i][j] * r1 * g[j]); }
            *(h16x4*)(H + (size_t)row * DM + 4 * (lane + 64 * i)) = o0; *(h16x4*)(H + (size_t)(row + 1) * DM + 4 * (lane + 64 * i)) = o1;
            int e0 = 0, e1 = 0;
            e0 = __builtin_amdgcn_cvt_pk_fp8_f32(v0[i][0] * r0 * g[0], v0[i][1] * r0 * g[1], e0, false); e0 = __builtin_amdgcn_cvt_pk_fp8_f32(v0[i][2] * r0 * g[2], v0[i][3] * r0 * g[3], e0, true);
            e1 = __builtin_amdgcn_cvt_pk_fp8_f32(v1[i][0] * r1 * g[0], v1[i][1] * r1 * g[1], e1, false); e1 = __builtin_amdgcn_cvt_pk_fp8_f32(v1[i][2] * r1 * g[2], v1[i][3] * r1 * g[3], e1, true);
            *(int*)(H8 + (size_t)row * DM + 4 * (lane + 64 * i)) = e0; *(int*)(H8 + (size_t)(row + 1) * DM + 4 * (lane + 64 * i)) = e1; }
    }
    {
        float* tiles = (float*)smem;
        h16* Wt = (h16*)(p.ws + OFF_WT); h16* WoT = (h16*)(p.ws + OFF_WOT);
        constexpr int NT1 = 124 * 32, NTT = NT1 + 32 * 32;
        const int nl_r = tid & 63, kl_r = tid >> 6, nl_w = tid >> 3, kc_w = tid & 7;
        float va[8], vb[8];
#define P0_LOAD(tI, v) do { if ((tI) < NT1) { const int n0_ = ((tI) / 32) * 64, k0_ = ((tI) % 32) * 64; const int src_ = src_col(n0_ + nl_r); \
            _Pragma("unroll") for (int i = 0; i < 8; ++i) v[i] = src_ >= 0 ? p.w_in[(size_t)(k0_ + kl_r + 8 * i) * IN_COLS + src_] : 0.f; } \
          else { const int t2_ = (tI) - NT1; const int n0_ = (t2_ / 32) * 64, k0_ = (t2_ % 32) * 64; \
            _Pragma("unroll") for (int i = 0; i < 8; ++i) v[i] = p.w_out[(size_t)(k0_ + kl_r + 8 * i) * DM + n0_ + nl_r]; } } while (0)
#define P0_PUT(buf, v) do { float* t_ = tiles + (buf) * (64 * 65); _Pragma("unroll") for (int i = 0; i < 8; ++i) t_[(kl_r + 8 * i) * 65 + nl_r] = v[i]; } while (0)
#define P0_STORE(buf, tI) do { const float* t_ = tiles + (buf) * (64 * 65); h16x8 o_; _Pragma("unroll") for (int j = 0; j < 8; ++j) o_[j] = (h16)t_[(8 * kc_w + j) * 65 + nl_w]; \
          if ((tI) < NT1) { const int n0_ = ((tI) / 32) * 64, k0_ = ((tI) % 32) * 64; \
              if (n0_ >= 4096 && n0_ < 6656) { int e0_ = 0, e1_ = 0; e0_ = __builtin_amdgcn_cvt_pk_fp8_f32(64.f * (float)o_[0], 64.f * (float)o_[1], e0_, false); e0_ = __builtin_amdgcn_cvt_pk_fp8_f32(64.f * (float)o_[2], 64.f * (float)o_[3], e0_, true); \
                  e1_ = __builtin_amdgcn_cvt_pk_fp8_f32(64.f * (float)o_[4], 64.f * (float)o_[5], e1_, false); e1_ = __builtin_amdgcn_cvt_pk_fp8_f32(64.f * (float)o_[6], 64.f * (float)o_[7], e1_, true); \
                  typedef int i32x2w __attribute__((ext_vector_type(2))); *(i32x2w*)(p.ws + OFF_WT8 + (size_t)(n0_ - 4096 + nl_w) * 2048 + k0_ + 8 * kc_w) = (i32x2w){e0_, e1_}; } \
              else *(h16x8*)(Wt + (size_t)(n0_ + nl_w) * 2048 + k0_ + 8 * kc_w) = o_; } \
          else { const int t2_ = (tI) - NT1; const int n0_ = (t2_ / 32) * 64, k0_ = (t2_ % 32) * 64; *(h16x8*)(WoT + (size_t)(n0_ + nl_w) * 2048 + k0_ + 8 * kc_w) = o_; } } while (0)
        int tI = blockIdx.x; int buf = 0;
        __syncthreads();
        if (tI < NTT) { P0_LOAD(tI, va); P0_PUT(0, va); }
        while (tI < NTT) {
            const int tn = tI + gridDim.x;
            if (tn < NTT) P0_LOAD(tn, vb);
            __syncthreads();
            P0_STORE(buf, tI);
            if (tn < NTT) P0_PUT(buf ^ 1, vb);
            buf ^= 1; tI = tn;
        }
#undef P0_LOAD
#undef P0_PUT
#undef P0_STORE
    }
}

__device__ __forceinline__ h16x8 pack8(const f32x4 a, const f32x4 c) { h16x8 o; o[0] = (h16)a[0]; o[1] = (h16)a[1]; o[2] = (h16)a[2]; o[3] = (h16)a[3]; o[4] = (h16)c[0]; o[5] = (h16)c[1]; o[6] = (h16)c[2]; o[7] = (h16)c[3]; return o; }
typedef short v4s_t __attribute__((__vector_size__(4 * sizeof(short))));
__device__ __forceinline__ h16x4 lds_tr16(const LAS unsigned char* a) { const v4s_t v = __builtin_amdgcn_ds_read_tr16_b64_v4i16((LAS v4s_t*)a); return __builtin_bit_cast(h16x4, v); }
constexpr int REC_BYTES = 74752, REC_WF = 0, REC_QF = 16384, REC_AF = 32768, REC_KTF = 40960, REC_VEC = 57344, REC_UF = 58368, REC_DMA = 58368;
constexpr int HB_BYTES = 69632;

__device__ __forceinline__ void gdn_prep_pair(const Params& p, unsigned char* smem, int pair) {
    const int tid = opaque_tid(), wid = __builtin_amdgcn_readfirstlane(tid >> 6), lane = tid & 63, hb = wid >> 2, w4 = wid & 3, tl = tid & 255;
    const int tk = 2 * pair + hb; const int b = tk >> 9, h = (tk >> 6) & 7, n = tk & 63; const int t0 = n * 64;
    unsigned char* base = smem + hb * HB_BYTES;
    h16* Kn = (h16*)base; h16* Qn = Kn + 64 * 136; h16* Vh = Qn + 64 * 136; float* L = (float*)(Vh + 64 * 136); float* vec = L + 4096;
    unsigned char* rec = p.ws + OFF_REC + (size_t)tk * REC_BYTES;
    const h16* qkvr = (const h16*)(p.ws + OFF_QKVR);
    __syncthreads();
    {
        const int cg = tl & 15, rg = tl >> 4;
        h16x8 raw[3][7];
#pragma unroll
        for (int ti = 0; ti < 3; ++ti)
#pragma unroll
            for (int r = 0; r < 7; ++r) {
                const int trow = t0 + 4 * rg - 3 + r;
                if (trow >= 0) raw[ti][r] = *(const h16x8*)(qkvr + ((size_t)b * NT + trow) * 3072 + ti * 1024 + h * 128 + 8 * cg);
                else { for (int j = 0; j < 8; ++j) raw[ti][r][j] = (h16)0.f; }
            }
#pragma unroll
        for (int ti = 0; ti < 3; ++ti) {
            const int chan = ti * 1024 + h * 128 + 8 * cg;
            float xr[7][8];
#pragma unroll
            for (int r = 0; r < 7; ++r)
#pragma unroll
                for (int j = 0; j < 8; ++j) xr[r][j] = (float)raw[ti][r][j];
            float wv[4][8];
#pragma unroll
            for (int tp = 0; tp < 4; ++tp) { const f32x4 a = *(const f32x4*)(p.conv_w + (size_t)tp * 3072 + chan), c = *(const f32x4*)(p.conv_w + (size_t)tp * 3072 + chan + 4);
#pragma unroll
                for (int j = 0; j < 4; ++j) { wv[tp][j] = a[j]; wv[tp][4 + j] = c[j]; } }
            h16* dst = (ti == 0) ? Qn : (ti == 1 ? Kn : Vh);
#pragma unroll
            for (int r = 0; r < 4; ++r) {
                float y[8]; float ss = 0.f;
#pragma unroll
                for (int j = 0; j < 8; ++j) { float a = wv[0][j] * xr[r][j] + wv[1][j] * xr[r + 1][j] + wv[2][j] * xr[r + 2][j] + wv[3][j] * xr[r + 3][j]; a = silu_f(a); y[j] = a; ss += a * a; }
                float sc = 1.f;
                if (ti < 2) { ss += __shfl_xor(ss, 1); ss += __shfl_xor(ss, 2); ss += __shfl_xor(ss, 4); ss += __shfl_xor(ss, 8); sc = (ti == 0 ? 0.08838834764831845f : 1.0f) * __builtin_amdgcn_rsqf(ss + EPS); }
                h16x8 o;
#pragma unroll
                for (int j = 0; j < 8; ++j) o[j] = (h16)(y[j] * sc);
                *(h16x8*)(dst + (4 * rg + r) * 136 + 8 * cg) = o;
            }
        }
    }
    if (tl < 64) {
        const float* gb = (const float*)(p.ws + OFF_GB) + ((size_t)b * NT + t0 + tl) * 16;
        const float g = gb[h], be = gb[8 + h];
        float gc = g;
#pragma unroll
        for (int o = 1; o < 64; o <<= 1) { const float tt = __shfl_up(gc, o); if (lane >= o) gc += tt; }
        const float gl = __shfl(gc, 63);
        vec[tl] = g; vec[64 + tl] = be; vec[128 + tl] = gc; vec[192 + tl] = __expf(gc);
        float* rv = (float*)(rec + REC_VEC);
        rv[tl] = __expf(gc); rv[64 + tl] = __expf(gl - gc); if (tl == 0) rv[128] = __expf(gl);
    }
    __syncthreads();
    {
        const int rt = w4, fr = lane & 15, kg = lane >> 4;
        h16x8 Ak[4], Aq[4];
#pragma unroll
        for (int s = 0; s < 4; ++s) { Ak[s] = *(const h16x8*)(Kn + (16 * rt + fr) * 136 + 32 * s + 8 * kg); Aq[s] = *(const h16x8*)(Qn + (16 * rt + fr) * 136 + 32 * s + 8 * kg); }
        h16* AF = (h16*)(rec + REC_AF);
#pragma unroll
        for (int ct = 0; ct < 4; ++ct) {
            f32x4 kk = (f32x4){0.f, 0.f, 0.f, 0.f}, qk = (f32x4){0.f, 0.f, 0.f, 0.f};
#pragma unroll
            for (int s = 0; s < 4; ++s) { const h16x8 Bk = *(const h16x8*)(Kn + (16 * ct + fr) * 136 + 32 * s + 8 * kg);
                kk = __builtin_amdgcn_mfma_f32_16x16x32_f16(Ak[s], Bk, kk, 0, 0, 0); qk = __builtin_amdgcn_mfma_f32_16x16x32_f16(Aq[s], Bk, qk, 0, 0, 0); }
            const int j = 16 * ct + fr; const float gcj = vec[128 + j];
#pragma unroll
            for (int rgi = 0; rgi < 4; ++rgi) {
                const int i = 16 * rt + 4 * kg + rgi;
                const float dec = (i >= j) ? __expf(vec[128 + i] - gcj) : 0.f;
                L[i * 64 + j] = (i > j) ? vec[64 + i] * kk[rgi] * dec : 0.f;
                const int sp = ct >> 1, kgp = fr >> 2, j8 = (ct & 1) * 4 + (fr & 3), lanep = 16 * kgp + 4 * kg + rgi;
                AF[((rt * 2 + sp) * 64 + lanep) * 8 + j8] = (h16)(qk[rgi] * dec);
            }
        }
    }
    __syncthreads();
    h16* Tw = (h16*)L; h16* Tu = Tw + 4096;
    if (w4 == 0) {
        float X[64];
#pragma unroll
        for (int i = 0; i < 64; ++i) X[i] = 0.f;
        f32x4 Ln[16]; float rn = (lane == 0) ? 1.f : 0.f;
#pragma unroll
        for (int i = 0; i < 64; ++i) {
            f32x4 Lc[16]; const float rc = rn;
#pragma unroll
            for (int jj = 0; jj < (i + 3) / 4; ++jj) Lc[jj] = Ln[jj];
            if (i + 1 < 64) {
#pragma unroll
                for (int jj = 0; jj < (i + 4) / 4; ++jj) Ln[jj] = *(const f32x4*)(L + (i + 1) * 64 + 4 * jj);
                rn = (lane == i + 1) ? 1.f : 0.f;
            }
            float a0 = rc, a1 = 0.f, a2 = 0.f, a3 = 0.f;
#pragma unroll
            for (int jj = 0; jj < (i + 3) / 4; ++jj) { a0 -= Lc[jj][0] * X[4 * jj]; a1 -= Lc[jj][1] * X[4 * jj + 1]; a2 -= Lc[jj][2] * X[4 * jj + 2]; a3 -= Lc[jj][3] * X[4 * jj + 3]; }
            float acc = (a0 + a1) + (a2 + a3);
            asm volatile("" : "+v"(acc) :: "memory");
            X[i] = acc;
        }
        const float bu = vec[64 + lane], bw = bu * vec[192 + lane];
#pragma unroll
        for (int i = 0; i < 64; ++i) { const int pos = i * 64 + ((((lane >> 3) ^ (i & 7)) << 3) | (lane & 7)); Tw[pos] = (h16)(X[i] * bw); Tu[pos] = (h16)(X[i] * bu); }
    } else {
        const int t3 = tl - 64;
        h16* QF = (h16*)(rec + REC_QF);
        for (int f = t3; f < 1024; f += 192) { const int lanep = f & 63, s = (f >> 6) & 3, rt = f >> 8; const int row = 16 * rt + (lanep & 15), kgp = lanep >> 4;
            const h16x4 a = *(const h16x4*)(Qn + row * 136 + 32 * s + 4 * kgp), c = *(const h16x4*)(Qn + row * 136 + 32 * s + 16 + 4 * kgp);
            h16x8 o; o[0] = a[0]; o[1] = a[1]; o[2] = a[2]; o[3] = a[3]; o[4] = c[0]; o[5] = c[1]; o[6] = c[2]; o[7] = c[3];
            *(h16x8*)(QF + (size_t)f * 8) = o; }
        h16* KTF = (h16*)(rec + REC_KTF);
        for (int f = t3; f < 1024; f += 192) { const int lanep = f & 63, sp = (f >> 6) & 1, rt = f >> 7; const int d = 16 * rt + (lanep & 15), kgp = lanep >> 4;
            h16x8 o;
#pragma unroll
            for (int j8 = 0; j8 < 8; ++j8) { const int c = 32 * sp + (j8 < 4 ? 4 * kgp + j8 : 16 + 4 * kgp + (j8 - 4)); o[j8] = Kn[c * 136 + d]; }
            *(h16x8*)(KTF + (size_t)f * 8) = o; }
    }
    __syncthreads();
    {
        const int rt = w4, fr = lane & 15, kg = lane >> 4, q4 = fr >> 2, pp = fr & 3;
        const LAS unsigned char* Knl = (const LAS unsigned char*)Kn; const LAS unsigned char* Vl = (const LAS unsigned char*)Vh;
        const int trow = 16 * rt + fr;
        h16x8 Tuf[2], Twf[2];
#pragma unroll
        for (int s = 0; s < 2; ++s) { const int off = trow * 64 + ((((4 * s + kg) ^ (trow & 7))) << 3); Tuf[s] = *(const h16x8*)(Tu + off); Twf[s] = *(const h16x8*)(Tw + off); }
        h16* UF = (h16*)(rec + REC_UF);
#pragma unroll
        for (int dvb = 0; dvb < 8; ++dvb) {
            f32x4 acc = (f32x4){0.f, 0.f, 0.f, 0.f};
#pragma unroll
            for (int s = 0; s < 2; ++s) { const LAS unsigned char* a0 = Vl + ((32 * s + 8 * kg + q4) * 136 + 16 * dvb + 4 * pp) * 2;
                const h16x4 lo = lds_tr16(a0), hi4 = lds_tr16(a0 + 4 * 136 * 2);
                h16x8 Bv; Bv[0] = lo[0]; Bv[1] = lo[1]; Bv[2] = lo[2]; Bv[3] = lo[3]; Bv[4] = hi4[0]; Bv[5] = hi4[1]; Bv[6] = hi4[2]; Bv[7] = hi4[3];
                acc = __builtin_amdgcn_mfma_f32_16x16x32_f16(Tuf[s], Bv, acc, 0, 0, 0); }
            h16x4 o; o[0] = (h16)acc[0]; o[1] = (h16)acc[1]; o[2] = (h16)acc[2]; o[3] = (h16)acc[3];
            *(h16x4*)(UF + (size_t)((dvb * 4 + rt) * 64 + lane) * 4) = o;
        }
        h16* WF = (h16*)(rec + REC_WF);
#pragma unroll
        for (int so = 0; so < 4; ++so) {
            f32x4 c0 = (f32x4){0.f, 0.f, 0.f, 0.f}, c1 = (f32x4){0.f, 0.f, 0.f, 0.f};
#pragma unroll
            for (int s = 0; s < 2; ++s) {
                const LAS unsigned char* a0 = Knl + ((32 * s + 8 * kg + q4) * 136 + 16 * (2 * so) + 4 * pp) * 2;
                const h16x4 l0 = lds_tr16(a0), h0 = lds_tr16(a0 + 4 * 136 * 2), l1 = lds_tr16(a0 + 32), h1 = lds_tr16(a0 + 32 + 4 * 136 * 2);
                h16x8 A0, A1; A0[0] = l0[0]; A0[1] = l0[1]; A0[2] = l0[2]; A0[3] = l0[3]; A0[4] = h0[0]; A0[5] = h0[1]; A0[6] = h0[2]; A0[7] = h0[3];
                A1[0] = l1[0]; A1[1] = l1[1]; A1[2] = l1[2]; A1[3] = l1[3]; A1[4] = h1[0]; A1[5] = h1[1]; A1[6] = h1[2]; A1[7] = h1[3];
                c0 = __builtin_amdgcn_mfma_f32_16x16x32_f16(A0, Twf[s], c0, 0, 0, 0); c1 = __builtin_amdgcn_mfma_f32_16x16x32_f16(A1, Twf[s], c1, 0, 0, 0);
            }
            *(h16x8*)(WF + (size_t)((rt * 4 + so) * 64 + lane) * 8) = pack8(-c0, -c1);
        }
    }
}

__device__ __forceinline__ void gdn_scan_task(const Params& p, unsigned char* smem, int bh) {
    const int tid = opaque_tid(), wid = __builtin_amdgcn_readfirstlane(tid >> 6), lane = tid & 63, kg = lane >> 4, fr = lane & 15;
    const int b = bh >> 3, h = bh & 7;
    LAS unsigned char* lds = (LAS unsigned char*)smem;
    const unsigned char* rec0 = p.ws + OFF_REC + (size_t)(bh * 64) * REC_BYTES;
    h16* OB = (h16*)(smem + 2 * REC_DMA);
    const h16* gz = (const h16*)(p.ws + OFF_GZ); h16* omix = (h16*)(p.ws + OFF_OMIX);
    f32x4 Sacc[8];
#pragma unroll
    for (int t = 0; t < 8; ++t) Sacc[t] = (f32x4){0.f, 0.f, 0.f, 0.f};
    h16x4 Uc[4], Un[4];
    __syncthreads();
#define GDN_GLDS(recp, bufi) do { _Pragma("unroll") for (int _i = 0; _i < 7; ++_i) \
        __builtin_amdgcn_global_load_lds((const unsigned*)((recp) + (size_t)(_i * 512 + tid) * 16), (LAS unsigned*)(lds + (bufi) * REC_DMA + (_i * 512 + wid * 64) * 16), 16, 0, 0); \
        if (wid == 0) __builtin_amdgcn_global_load_lds((const unsigned*)((recp) + (size_t)(7 * 512 + tid) * 16), (LAS unsigned*)(lds + (bufi) * REC_DMA + (7 * 512) * 16), 16, 0, 0); } while (0)
#define GDN_LDREG(recp, U_) do { _Pragma("unroll") for (int rt = 0; rt < 4; ++rt) U_[rt] = *(const h16x4*)((recp) + REC_UF + (size_t)((wid * 4 + rt) * 64 + lane) * 8); } while (0)
#define GDN_LDGZ(dst, chunk) do { const h16* gp_ = gz + ((size_t)b * NT + 64 * (chunk) + prow) * 1024 + h * 128 + 16 * pseg; dst[0] = *(const h16x8*)gp_; dst[1] = *(const h16x8*)(gp_ + 8); } while (0)
#define GDN_POST(chunk, gzv) do { const h16* Ob = OB + ((chunk) & 1) * 8192 + prow * 128 + 16 * pseg; const h16x8 a0 = *(const h16x8*)Ob, a1 = *(const h16x8*)(Ob + 8); \
        float ngv[16]; _Pragma("unroll") for (int j = 0; j < 4; ++j) { const f32x4 t4 = *(const f32x4*)(ngl + 16 * pseg + 4 * j); ngv[4 * j] = t4[0]; ngv[4 * j + 1] = t4[1]; ngv[4 * j + 2] = t4[2]; ngv[4 * j + 3] = t4[3]; } \
        float ss = 0.f; _Pragma("unroll") for (int j = 0; j < 8; ++j) { const float u0 = (float)a0[j], u1 = (float)a1[j]; ss += u0 * u0 + u1 * u1; } \
        ss += __shfl_xor(ss, 1); ss += __shfl_xor(ss, 2); ss += __shfl_xor(ss, 4); const float r = __builtin_amdgcn_rsqf(ss * (1.0f / 128.0f) + EPS); \
        h16x8 o0, o1; _Pragma("unroll") for (int j = 0; j < 8; ++j) { o0[j] = (h16)((float)a0[j] * r * ngv[j] * (float)gzv[0][j]); o1[j] = (h16)((float)a1[j] * r * ngv[8 + j] * (float)gzv[1][j]); } \
        h16* op_ = omix + ((size_t)b * NT + 64 * (chunk) + prow) * 2048 + h * 128 + 16 * pseg; *(h16x8*)op_ = o0; *(h16x8*)(op_ + 8) = o1; } while (0)
#define GDN_RD8(X, off0) do { _Pragma("unroll") for (int _j = 0; _j < 8; ++_j) X[_j] = *(const LAS h16x8*)(bufp + (off0) + (_j * 64 + lane) * 16); } while (0)
#define GDN_SB __builtin_amdgcn_sched_barrier(0)
    h16x8 gzp[2], gzn[2];
    const int prow = tid >> 3, pseg = tid & 7;
    float* ngl = (float*)(smem + 2 * REC_DMA + 32768);
    if (tid < 128) ngl[tid] = p.gdn_norm_g[tid];
    GDN_GLDS(rec0, 0);
    GDN_LDREG(rec0, Uc);
    asm volatile("s_waitcnt vmcnt(0)" ::: "memory");
    __syncthreads();
    for (int n = 0; n < 64; ++n) {
        const unsigned char* recn = rec0 + (size_t)(n + 1) * REC_BYTES;
        if (n + 1 < 64) { GDN_GLDS(recn, (n + 1) & 1); GDN_LDREG(recn, Un); }
        GDN_LDGZ(gzn, n);
        if (n > 0) GDN_POST(n - 1, gzp);
        const LAS unsigned char* bufp = lds + (n & 1) * REC_DMA;
        h16x8 X[8], Y[8];
        GDN_RD8(X, REC_WF);
        h16x8 SB[4];
#pragma unroll
        for (int s = 0; s < 4; ++s) SB[s] = pack8(Sacc[2 * s], Sacc[2 * s + 1]);
        f32x4 vacc[4], oacc[4];
#pragma unroll
        for (int rt = 0; rt < 4; ++rt) { vacc[rt] = (f32x4){(float)Uc[rt][0], (float)Uc[rt][1], (float)Uc[rt][2], (float)Uc[rt][3]}; oacc[rt] = (f32x4){0.f, 0.f, 0.f, 0.f}; }
        GDN_SB;
        GDN_RD8(Y, REC_WF + 8192);
#pragma unroll
        for (int j = 0; j < 8; ++j) vacc[j >> 2] = __builtin_amdgcn_mfma_f32_16x16x32_f16(X[j], SB[j & 3], vacc[j >> 2], 0, 0, 0);
        GDN_SB;
        GDN_RD8(X, REC_QF);
#pragma unroll
        for (int j = 0; j < 8; ++j) vacc[2 + (j >> 2)] = __builtin_amdgcn_mfma_f32_16x16x32_f16(Y[j], SB[j & 3], vacc[2 + (j >> 2)], 0, 0, 0);
        GDN_SB;
        GDN_RD8(Y, REC_QF + 8192);
        f32x4 ekv[4], egv[4];
#pragma unroll
        for (int rt = 0; rt < 4; ++rt) { ekv[rt] = *(const LAS f32x4*)(bufp + REC_VEC + 256 + (16 * rt + 4 * kg) * 4); egv[rt] = *(const LAS f32x4*)(bufp + REC_VEC + (16 * rt + 4 * kg) * 4); }
        const float eglc = *(const LAS float*)(bufp + REC_VEC + 512);
#pragma unroll
        for (int j = 0; j < 8; ++j) oacc[j >> 2] = __builtin_amdgcn_mfma_f32_16x16x32_f16(X[j], SB[j & 3], oacc[j >> 2], 0, 0, 0);
        GDN_SB;
        GDN_RD8(X, REC_KTF);
        h16x8 VB[2], VKB[2];
#pragma unroll
        for (int sp = 0; sp < 2; ++sp) { VB[sp] = pack8(vacc[2 * sp], vacc[2 * sp + 1]); VKB[sp] = pack8(vacc[2 * sp] * ekv[2 * sp], vacc[2 * sp + 1] * ekv[2 * sp + 1]); }
#pragma unroll
        for (int j = 0; j < 8; ++j) oacc[2 + (j >> 2)] = __builtin_amdgcn_mfma_f32_16x16x32_f16(Y[j], SB[j & 3], oacc[2 + (j >> 2)], 0, 0, 0);
        GDN_SB;
        GDN_RD8(Y, REC_KTF + 8192);
#pragma unroll
        for (int t = 0; t < 8; ++t) Sacc[t] = Sacc[t] * eglc;
#pragma unroll
        for (int j = 0; j < 8; ++j) Sacc[j >> 1] = __builtin_amdgcn_mfma_f32_16x16x32_f16(X[j], VKB[j & 1], Sacc[j >> 1], 0, 0, 0);
        GDN_SB;
        GDN_RD8(X, REC_AF);
#pragma unroll
        for (int rt = 0; rt < 4; ++rt) oacc[rt] = oacc[rt] * egv[rt];
#pragma unroll
        for (int j = 0; j < 8; ++j) Sacc[4 + (j >> 1)] = __builtin_amdgcn_mfma_f32_16x16x32_f16(Y[j], VKB[j & 1], Sacc[4 + (j >> 1)], 0, 0, 0);
        GDN_SB;
#pragma unroll
        for (int j = 0; j < 8; ++j) oacc[j >> 1] = __builtin_amdgcn_mfma_f32_16x16x32_f16(X[j], VB[j & 1], oacc[j >> 1], 0, 0, 0);
        { h16* Ob = OB + (n & 1) * 8192;
#pragma unroll
          for (int rt = 0; rt < 4; ++rt)
#pragma unroll
              for (int rgi = 0; rgi < 4; ++rgi) Ob[(16 * rt + 4 * kg + rgi) * 128 + 16 * wid + fr] = (h16)oacc[rt][rgi]; }
        asm volatile("s_waitcnt vmcnt(0)" ::: "memory");
        __syncthreads();
#pragma unroll
        for (int rt = 0; rt < 4; ++rt) Uc[rt] = Un[rt];
        gzp[0] = gzn[0]; gzp[1] = gzn[1];
    }
    GDN_POST(63, gzp);
#undef GDN_LDGZ
#undef GDN_POST
#undef GDN_RD8
#undef GDN_SB
#undef GDN_GLDS
#undef GDN_LDREG
}

__device__ __forceinline__ unsigned f2key(float x) { const unsigned u = __float_as_uint(x); return (u & 0x80000000u) ? ~u : (u | 0x80000000u); }
typedef float f32x16 __attribute__((ext_vector_type(16)));
__device__ __forceinline__ float wave_min(float v) {
#pragma unroll
    for (int o = 1; o < 64; o <<= 1) v = fminf(v, __shfl_xor(v, o));
    return v;
}
__device__ __forceinline__ unsigned lane_below(unsigned long long m) { return __builtin_amdgcn_mbcnt_hi((unsigned)(m >> 32), __builtin_amdgcn_mbcnt_lo((unsigned)m, 0u)); }
__device__ __forceinline__ void idx8_task(const Params& p, unsigned char* smem, int b, int qb) {
    const int tid = opaque_tid(), wid = __builtin_amdgcn_readfirstlane(tid >> 6), lane = tid & 63;
    const int t0 = qb * 8;
    unsigned short* selg = (unsigned short*)(p.ws + OFF_SEL) + ((size_t)b * NT + t0) * 256;
    if (t0 + 8 <= 256) {
        for (int i = tid; i < 8 * 256; i += 512) { const int q = i >> 8, k = i & 255; selg[i] = (unsigned short)(k <= t0 + q ? k : 0); }
        return;
    }
    float* sc = (float*)smem;
    ACC_T0();
    unsigned* hist = (unsigned*)(smem + 131072 + wid * 2560);
    unsigned* cand = hist + 256;
    __syncthreads();
    {
        const int n8 = t0 + 8;
        const int ntile = (n8 + 31) >> 5, ntile_pad = ((n8 + 255) >> 8) << 3;
        const h16* iq = (const h16*)(p.ws + OFF_IQ) + ((size_t)b * NT + t0) * 1024;
        const float* iw = (const float*)(p.ws + OFF_IW) + ((size_t)b * NT + t0) * 16;
        const h16* ik = (const h16*)(p.ws + OFF_IK) + (size_t)b * NT * 64;
        const int r = lane & 31, kh = lane >> 5, qq = (r >> 2) & 1, hh = (r & 3) + 4 * (r >> 3);
        h16x8 Af[4][4]; h16x2 Wp[4][8];
#pragma unroll
        for (int a = 0; a < 4; ++a) {
#pragma unroll
            for (int s = 0; s < 4; ++s) Af[a][s] = *(const h16x8*)(iq + (size_t)(2 * a + qq) * 1024 + hh * 64 + 16 * s + 8 * kh);
#pragma unroll
            for (int c = 0; c < 4; ++c) { const f32x4 w4 = *(const f32x4*)(iw + (size_t)(2 * a + kh) * 16 + 4 * c);
                Wp[a][2 * c] = (h16x2){(h16)w4[0], (h16)w4[1]}; Wp[a][2 * c + 1] = (h16x2){(h16)w4[2], (h16)w4[3]}; }
        }
#define IDX_LOADB(Bx, ti) do { const int tc_ = (ti) < ntile ? (ti) : ntile - 1;     \
            _Pragma("unroll") for (int s = 0; s < 4; ++s) Bx[s] = *(const h16x8*)(ik + (size_t)tc_ * 2048 + s * 512 + kh * 256 + r * 8); } while (0)
#define IDX_COMP(Bx, ti) do { if ((ti) < ntile) { const int key = 32 * (ti) + r; f32x16 accs[4]; \
            _Pragma("unroll") for (int a = 0; a < 4; ++a) { _Pragma("unroll") for (int e = 0; e < 16; ++e) accs[a][e] = 0.f; \
                _Pragma("unroll") for (int s = 0; s < 4; ++s) accs[a] = __builtin_amdgcn_mfma_f32_32x32x16_f16(Af[a][s], Bx[s], accs[a], 0, 0, 0); } \
            __builtin_amdgcn_sched_barrier(0); \
            _Pragma("unroll") for (int a = 0; a < 4; ++a) { \
                float s0 = 0.f, s1 = 0.f; _Pragma("unroll") for (int e = 0; e < 8; e += 2) { h16x2 rp = (h16x2){(h16)accs[a][2 * e], (h16)accs[a][2 * e + 1]}; rp = __builtin_elementwise_max(rp, (h16x2){(h16)0.f, (h16)0.f}); s0 = __builtin_amdgcn_fdot2(rp, Wp[a][e], s0, false); \
                    h16x2 rq = (h16x2){(h16)accs[a][2 * e + 2], (h16)accs[a][2 * e + 3]}; rq = __builtin_elementwise_max(rq, (h16x2){(h16)0.f, (h16)0.f}); s1 = __builtin_amdgcn_fdot2(rq, Wp[a][e + 1], s1, false); } \
                const int q = 2 * a + kh; sc[q * 4096 + key] = (key > t0 + q) ? -INFINITY : (s0 + s1); } } } while (0)
        {
            h16x8 B0[4], B1[4], B2[4];
            IDX_LOADB(B0, wid); IDX_LOADB(B1, wid + 8);
            for (int i = wid; i < ntile; i += 24) {
                IDX_LOADB(B2, i + 16); IDX_COMP(B0, i);
                IDX_LOADB(B0, i + 24); IDX_COMP(B1, i + 8);
                IDX_LOADB(B1, i + 32); IDX_COMP(B2, i + 16);
            }
            for (int i = ntile + wid; i < ntile_pad; i += 8) {
#pragma unroll
                for (int a = 0; a < 4; ++a) sc[(2 * a + kh) * 4096 + 32 * i + r] = -INFINITY;
            }
        }
#undef IDX_LOADB
#undef IDX_COMP
    }
    __syncthreads();
    ACC_ADD(1);
    {
        const int tq = t0 + wid, n = tq + 1;
        const float* row = sc + wid * 4096;
        const int ng = (n + 255) >> 8;
        f32x4 x[16];
#pragma unroll
        for (int g = 0; g < 16; ++g) { if (g < ng) x[g] = *(const f32x4*)(row + 256 * g + 4 * lane); else x[g] = (f32x4){-INFINITY, -INFINITY, -INFINITY, -INFINITY}; }
        float hi = -INFINITY, lo = INFINITY;
#pragma unroll
        for (int g = 0; g < 16; ++g)
#pragma unroll
            for (int c = 0; c < 4; ++c) { const float v = x[g][c]; hi = fmaxf(hi, v); lo = fminf(lo, v == -INFINITY ? INFINITY : v); }
        hi = wave_max(hi); lo = wave_min(lo);
        const float scale = (hi > lo) ? 255.99f / (hi - lo) : 0.f; const float off = -lo * scale;
        *(u32x4*)(hist + 4 * lane) = (u32x4){0u, 0u, 0u, 0u};
#pragma unroll
        for (int g = 0; g < 16; ++g) { if (g < ng) {
#pragma unroll
            for (int c = 0; c < 4; ++c) { int bin = (int)fmaf(x[g][c], scale, off); bin = bin < 0 ? 0 : (bin > 255 ? 255 : bin); atomicAdd(&hist[bin], 1u); } } }
        unsigned bstar, need;
        {
            const u32x4 h4 = *(const u32x4*)(hist + 4 * lane); const unsigned s = h4[0] + h4[1] + h4[2] + h4[3];
            unsigned suf = s;
#pragma unroll
            for (int o = 1; o < 64; o <<= 1) { const unsigned tt = __shfl_down(suf, o); if (lane + o < 64) suf += tt; }
            const unsigned above = suf - s;
            const bool mine = (above < 256u && 256u <= suf);
            unsigned cum = above; unsigned bin = 0;
            if (cum + h4[3] >= 256u) bin = 3; else { cum += h4[3]; if (cum + h4[2] >= 256u) bin = 2; else { cum += h4[2]; if (cum + h4[1] >= 256u) bin = 1; else { cum += h4[1]; bin = 0; } } }
            const unsigned long long mm = __ballot(mine);
            const int src = (int)__builtin_ctzll(mm);
            bstar = (unsigned)__shfl((int)(4 * lane + bin), src); need = (unsigned)__shfl((int)(256u - cum), src);
        }
        unsigned short* so = selg + (size_t)wid * 256;
        unsigned short* cidx = (unsigned short*)(cand + 256);
        unsigned m = 0, outb = 0;
#pragma unroll
        for (int g = 0; g < 16; ++g) { if (g < ng) {
#pragma unroll
            for (int c = 0; c < 4; ++c) { int bin = (int)fmaf(x[g][c], scale, off); bin = bin < 0 ? 0 : (bin > 255 ? 255 : bin);
                const bool gt = ((unsigned)bin > bstar), pr = ((unsigned)bin == bstar);
                const unsigned long long mg = __ballot(gt), mk = __ballot(pr);
                if (mg) { const unsigned pos = outb + lane_below(mg); if (gt) so[pos] = (unsigned short)(256 * g + 4 * lane + c); outb += (unsigned)__builtin_popcountll(mg); }
                if (mk) { const unsigned pos = m + lane_below(mk); if (pr && pos < 256u) { cand[pos] = f2key(x[g][c]); cidx[pos] = (unsigned short)(256 * g + 4 * lane + c); } m += (unsigned)__builtin_popcountll(mk); } } } }
        unsigned Kt = 0, rr = need;
        if (m <= 256u) {
            const int nc = (int)((m + 63u) >> 6);
            unsigned cv[4]; unsigned short ci[4];
#pragma unroll
            for (int j = 0; j < 4; ++j) { const bool in = (64 * j + lane < (int)m); cv[j] = in ? cand[64 * j + lane] : 0u; ci[j] = in ? cidx[64 * j + lane] : (unsigned short)0; }
            for (int bit = 31; bit >= 0; --bit) {
                const unsigned test = (Kt | (1u << bit)) >> bit;
                unsigned cnt = (unsigned)__builtin_popcountll(__ballot((cv[0] >> bit) == test));
                if (nc > 1) cnt += (unsigned)__builtin_popcountll(__ballot((cv[1] >> bit) == test));
                if (nc > 2) cnt += (unsigned)__builtin_popcountll(__ballot((cv[2] >> bit) == test));
                if (nc > 3) cnt += (unsigned)__builtin_popcountll(__ballot((cv[3] >> bit) == test));
                if (cnt >= rr) Kt |= (1u << bit); else rr -= cnt;
            }
            unsigned eqb = 0;
#pragma unroll
            for (int j = 0; j < 4; ++j) { if (j < nc) { const bool in = (64 * j + lane < (int)m); const bool gt = in && cv[j] > Kt, eq = in && cv[j] == Kt;
                const unsigned long long me = __ballot(eq); bool take = gt;
                if (me) { const unsigned er = eqb + lane_below(me); take = gt || (eq && er < rr); eqb += (unsigned)__builtin_popcountll(me); }
                const unsigned long long mt = __ballot(take);
                if (mt) { const unsigned pos = outb + lane_below(mt); if (take) so[pos] = ci[j]; outb += (unsigned)__builtin_popcountll(mt); } } }
        } else {
            for (int bit = 31; bit >= 0; --bit) {
                const unsigned test = (Kt | (1u << bit)) >> bit; unsigned cnt = 0;
                for (int idx = lane; idx < ng * 256; idx += 64) { const float v = row[idx]; int bin = (int)fmaf(v, scale, off); bin = bin < 0 ? 0 : (bin > 255 ? 255 : bin);
                    const bool pr = ((unsigned)bin == bstar) && ((f2key(v) >> bit) == test); cnt += (unsigned)__builtin_popcountll(__ballot(pr)); }
                if (cnt >= rr) Kt |= (1u << bit); else rr -= cnt;
            }
            unsigned eqb = 0;
            for (int idx = lane; idx < ng * 256; idx += 64) { const float v = row[idx]; int bin = (int)fmaf(v, scale, off); bin = bin < 0 ? 0 : (bin > 255 ? 255 : bin);
                const unsigned k = f2key(v); const bool inb = ((unsigned)bin == bstar); const bool gt = inb && k > Kt, eq = inb && k == Kt;
                const unsigned long long me = __ballot(eq); bool take = gt;
                if (me) { const unsigned er = eqb + lane_below(me); take = gt || (eq && er < rr); eqb += (unsigned)__builtin_popcountll(me); }
                const unsigned long long mt = __ballot(take);
                if (mt) { const unsigned pos = outb + lane_below(mt); if (take) so[pos] = (unsigned short)idx; outb += (unsigned)__builtin_popcountll(mt); } }
        }
    }
    __syncthreads();
    ACC_ADD(2);
}

typedef unsigned short u16x4 __attribute__((ext_vector_type(4)));
typedef unsigned short u16x8 __attribute__((ext_vector_type(8)));
__device__ __forceinline__ void attn8_task(const Params& p, unsigned char* smem, int part, int o) {
    const int tid = opaque_tid(), wid = __builtin_amdgcn_readfirstlane(tid >> 6), lane = tid & 63, kg = lane >> 4, fr = lane & 15;
    const int b = part >> 1, g = part & 1;
    unsigned char* vl = smem + wid * 17408;
    LAS unsigned char* vll = (LAS unsigned char*)vl;
    const char* akb = (const char*)(p.ws + OFF_AK) + (size_t)b * NT * 256 + g * 128;
    const char* avb = (const char*)(p.ws + OFF_AV) + (size_t)b * NT * 256 + g * 128;
    typedef long i64x2 __attribute__((ext_vector_type(2)));
    constexpr int NQW = 1;
    const int tq0 = 8 * NQW * o + NQW * wid;
    u16x4 kix[4], kixn[4];
#define AT_LOADI(tt, KI) do { const unsigned short* sel_ = (const unsigned short*)(p.ws + OFF_SEL) + ((size_t)b * NT + (tt)) * 256; \
        _Pragma("unroll") for (int c = 0; c < 4; ++c) KI[c] = *(const u16x4*)(sel_ + 64 * c + 4 * fr); } while (0)
    AT_LOADI(tq0, kix);
#pragma unroll 1
    for (int qi = 0; qi < NQW; ++qi) {
    const int t = tq0 + qi; const int bt = b * NT + t; const int nvalid = (t + 1) < 256 ? (t + 1) : 256;
    const unsigned short* sel = (const unsigned short*)(p.ws + OFF_SEL) + (size_t)bt * 256;
    long Qf[4];
    { const char* qp_ = (const char*)(p.ws + OFF_AQ) + (size_t)bt * 1024 + (4 * g + (fr & 3)) * 128 + kg * 32; const i64x2 q0 = *(const i64x2*)qp_, q1 = *(const i64x2*)(qp_ + 16);
      Qf[0] = fr < 4 ? q0[0] : 0l; Qf[1] = fr < 4 ? q0[1] : 0l; Qf[2] = fr < 4 ? q1[0] : 0l; Qf[3] = fr < 4 ? q1[1] : 0l; }
    f32x4 lg[16];
    unsigned char* kl = vl + 8192; LAS unsigned char* kll = (LAS unsigned char*)kl;
#define AT_LOADKR(KRx, c) do { const u16x8 i0 = *(const u16x8*)(sel + 64 * (c) + 8 * (lane >> 3)); \
        _Pragma("unroll") for (int it = 0; it < 8; ++it) KRx[it] = *(const u32x4*)(akb + (unsigned)i0[it] * 256u + 16u * (unsigned)(lane & 7)); } while (0)
#define AT_STOREK(KRx) do { _Pragma("unroll") for (int it = 0; it < 8; ++it) { const int r = 8 * (lane >> 3) + it; const int fk = (r >> 2) & 7; \
        *(u32x4*)(kl + r * 128 + (((lane & 7) ^ fk) << 4)) = KRx[it]; } } while (0)
#define AT_READK(Kx) do { _Pragma("unroll") for (int ii = 0; ii < 4; ++ii) { const int r = 4 * fr + ii; const int fk = fr & 7; \
        const i64x2 t0 = *(const LAS i64x2*)(kll + r * 128 + (((2 * kg) ^ fk) << 4)), t1 = *(const LAS i64x2*)(kll + r * 128 + (((2 * kg + 1) ^ fk) << 4)); \
        Kx[ii][0] = t0[0]; Kx[ii][1] = t0[1]; Kx[ii][2] = t1[0]; Kx[ii][3] = t1[1]; } } while (0)
#define AT_MMAK(Kx, c) do { _Pragma("unroll") for (int ii = 0; ii < 4; ++ii) { f32x4 a = (f32x4){0.f, 0.f, 0.f, 0.f}; \
        _Pragma("unroll") for (int s = 0; s < 4; ++s) a = __builtin_amdgcn_mfma_f32_16x16x32_fp8_fp8(Kx[ii][s], Qf[s], a, 0, 0, 0); lg[4 * (c) + ii] = a; } } while (0)
#define AT_LOADV(Vx, c) do { const u16x8 i0 = *(const u16x8*)(sel + 64 * (c) + 8 * (lane >> 3)); \
        _Pragma("unroll") for (int it = 0; it < 8; ++it) Vx[it] = *(const u32x4*)(avb + (unsigned)i0[it] * 256u + 16u * (unsigned)(lane & 7)); } while (0)
    u32x4 VA[8], VB[8];
    {
        u32x4 KA[8], KB[8], KC[8]; long Kf[4][4];
        AT_LOADKR(KA, 0); AT_LOADKR(KB, 1); AT_LOADKR(KC, 2);
        AT_STOREK(KA); AT_READK(Kf); AT_LOADKR(KA, 3); AT_MMAK(Kf, 0);
        AT_STOREK(KB); AT_READK(Kf); AT_LOADV(VA, 0); AT_MMAK(Kf, 1);
        AT_STOREK(KC); AT_READK(Kf); AT_MMAK(Kf, 2);
        AT_STOREK(KA); AT_READK(Kf); AT_MMAK(Kf, 3);
    }
#define DPP_F(oldv, srcv, ctrl, bank) __builtin_bit_cast(float, __builtin_amdgcn_update_dpp(__builtin_bit_cast(int, (float)(oldv)), __builtin_bit_cast(int, (float)(srcv)), (ctrl), 0xF, (bank), false))
    float val[4][4];
#pragma unroll
    for (int ii = 0; ii < 4; ++ii)
#pragma unroll
        for (int r = 0; r < 4; ++r) { float v = lg[ii][r];
            v = DPP_F(v, lg[4 + ii][r], 0x114, 0x2); v = DPP_F(v, lg[8 + ii][r], 0x118, 0x4); v = DPP_F(v, lg[12 + ii][r], 0x11C, 0x8); val[ii][r] = v; }
    const int cj = fr >> 2;
    float m = -INFINITY;
#pragma unroll
    for (int ii = 0; ii < 4; ++ii)
#pragma unroll
        for (int r = 0; r < 4; ++r) { const int slot = 64 * cj + 16 * kg + 4 * r + ii; const float v = (slot < nvalid) ? val[ii][r] * (0.08838834764831845f * 1.4426950408889634f) : -INFINITY; val[ii][r] = v; m = fmaxf(m, v); }
    m = fmaxf(m, __shfl_xor(m, 4)); m = fmaxf(m, __shfl_xor(m, 8)); m = fmaxf(m, __shfl_xor(m, 16)); m = fmaxf(m, __shfl_xor(m, 32));
    float sum = 0.f;
#pragma unroll
    for (int ii = 0; ii < 4; ++ii)
#pragma unroll
        for (int r = 0; r < 4; ++r) { const float e = __builtin_amdgcn_exp2f(val[ii][r] - m); val[ii][r] = e; sum += e; }
    sum += __shfl_xor(sum, 4); sum += __shfl_xor(sum, 8); sum += __shfl_xor(sum, 16); sum += __shfl_xor(sum, 32);
    const float pscale = __builtin_amdgcn_rcpf(sum) * 256.0f;
    int pl[2][2];
#pragma unroll
    for (int ipl = 0; ipl < 2; ++ipl) { int w0 = 0, w1 = 0;
        w0 = __builtin_amdgcn_cvt_pk_fp8_f32(val[2 * ipl][0] * pscale, val[2 * ipl][1] * pscale, w0, false); w0 = __builtin_amdgcn_cvt_pk_fp8_f32(val[2 * ipl][2] * pscale, val[2 * ipl][3] * pscale, w0, true);
        w1 = __builtin_amdgcn_cvt_pk_fp8_f32(val[2 * ipl + 1][0] * pscale, val[2 * ipl + 1][1] * pscale, w1, false); w1 = __builtin_amdgcn_cvt_pk_fp8_f32(val[2 * ipl + 1][2] * pscale, val[2 * ipl + 1][3] * pscale, w1, true);
        pl[ipl][0] = w0; pl[ipl][1] = w1; }
    long Pf[8];
#pragma unroll
    for (int ipl = 0; ipl < 2; ++ipl) {
        Pf[ipl] = (long)(((unsigned long long)(unsigned)pl[ipl][1] << 32) | (unsigned long long)(unsigned)pl[ipl][0]);
#define PF_GATHER(c, ctrl) do { const int lo_ = __builtin_amdgcn_update_dpp(0, pl[ipl][0], ctrl, 0xF, 0x1, false), hi_ = __builtin_amdgcn_update_dpp(0, pl[ipl][1], ctrl, 0xF, 0x1, false); \
            Pf[2 * (c) + ipl] = (long)(((unsigned long long)(unsigned)hi_ << 32) | (unsigned long long)(unsigned)lo_); } while (0)
        PF_GATHER(1, 0x104); PF_GATHER(2, 0x108); PF_GATHER(3, 0x10C);
#undef PF_GATHER
    }
#undef DPP_F
    f32x4 O[8];
#pragma unroll
    for (int ct = 0; ct < 8; ++ct) O[ct] = (f32x4){0.f, 0.f, 0.f, 0.f};
    if (qi < NQW - 1) AT_LOADI(t + 1, kixn);
    const h16x8 gate = *(const h16x8*)((const h16*)(p.ws + OFF_AZ) + (size_t)bt * 1024 + (4 * g) * 128 + 8 * lane);
    const int q4 = fr >> 2, pp = fr & 3;
    typedef int v2i_t __attribute__((__vector_size__(2 * sizeof(int))));
#define AT_STOREV(Vx) do { _Pragma("unroll") for (int it = 0; it < 8; ++it) { const int r = 8 * (lane >> 3) + it; const int fk = ((r >> 2) & 3) | (((r >> 4) & 1) << 2); \
        *(u32x4*)(vl + r * 128 + (((lane & 7) ^ fk) << 4)) = Vx[it]; } } while (0)
#define AT_PV(c) do { _Pragma("unroll") for (int ipl = 0; ipl < 2; ++ipl) { const int qq = fr >> 1; const int r = 16 * kg + 4 * (qq & 3) + 2 * ipl + (qq >> 2); const int fk = ((r >> 2) & 3) | (((r >> 4) & 1) << 2); \
        _Pragma("unroll") for (int ct = 0; ct < 8; ++ct) { const LAS unsigned char* a0 = vll + r * 128 + ((ct ^ fk) << 4) + (fr & 1) * 8; \
            const v2i_t bv = __builtin_amdgcn_ds_read_tr8_b64_v2i32((LAS v2i_t*)a0); \
            O[ct] = __builtin_amdgcn_mfma_f32_16x16x32_fp8_fp8(Pf[2 * (c) + ipl], __builtin_bit_cast(long, bv), O[ct], 0, 0, 0); } } } while (0)
    AT_LOADV(VB, 1); AT_STOREV(VA); AT_PV(0);
    AT_LOADV(VA, 2); AT_STOREV(VB); AT_PV(1);
    AT_LOADV(VB, 3); AT_STOREV(VA); AT_PV(2);
    AT_STOREV(VB); AT_PV(3);
#undef AT_LOADKR
#undef AT_STOREK
#undef AT_READK
#undef AT_MMAK
#undef AT_LOADV
#undef AT_STOREV
#undef AT_PV
    h16* ot = (h16*)vl;
    if (kg == 0) {
#pragma unroll
        for (int ct = 0; ct < 8; ++ct)
#pragma unroll
            for (int r = 0; r < 4; ++r) ot[r * 128 + 16 * ct + fr] = (h16)O[ct][r];
    }
    {
        const h16x8 ov = *(const h16x8*)(ot + 8 * lane);
        h16x8 res;
#pragma unroll
        for (int j = 0; j < 8; ++j) res[j] = (h16)((float)ov[j] * (float)gate[j] * (1.0f / 256.0f));
        *(h16x8*)((h16*)(p.ws + OFF_OMIX) + (size_t)bt * 2048 + 1024 + (4 * g) * 128 + 8 * lane) = res;
    }
#pragma unroll
    for (int c = 0; c < 4; ++c) kix[c] = kixn[c];
    }
#undef AT_LOADI
}

__device__ __forceinline__ void phase5(const Params& p) {
    const int tid = opaque_tid(), wid = tid >> 6, lane = tid & 63;
    const int gw = blockIdx.x * 8 + wid, nw = gridDim.x * 8;
    const float* rowss = (const float*)(p.ws + OFF_ROWSS);
    for (int row = gw; row < BT; row += nw) {
        const float r = 1.0f / sqrtf(rowss[row] * (1.0f / DM) + EPS);
        f32x4* o = (f32x4*)(p.out + (size_t)row * DM);
        float eadd = 0.f;
        if ((TS_A >= 0 || TS_ACC >= 0) && row < 164) { const unsigned* ts = (const unsigned*)(p.ws + OFF_CTRL + 8192); const float tus = (TS_ACC >= 0) ? (float)ts[16 + (TS_ACC >= 0 ? TS_ACC : 0)] * (0.01f / 256.0f) : (float)(ts[TS_B >= 0 ? TS_B : 0] - ts[TS_A >= 0 ? TS_A : 0]) * 0.01f; eadd = sqrtf(tus * 1e-5f); }
#pragma unroll
        for (int i = 0; i < 8; ++i) { const f32x4 g = ((const f32x4*)p.final_g)[lane + 64 * i]; f32x4 v = o[lane + 64 * i]; v = v * r * g + eadd; o[lane + 64 * i] = v; }
    }
}

#define XB_TMO      128
#define XB_XCNT(j)  (256  + 64 * (j))
#define XB_XSUB(j)  (1280 + 64 * (j))
#define XB_XGEN(j)  (2304 + 64 * (j))
#define XB_TOP      3328
#define XB_TOPGEN   3392
#define XCD_BAR_WORDS 3456
#define XB_SPIN_CAP (1u << 18)

__device__ __forceinline__ unsigned xb_ld(unsigned* p)              { return __hip_atomic_load(p, __ATOMIC_RELAXED, __HIP_MEMORY_SCOPE_AGENT); }
__device__ __forceinline__ unsigned xb_add(unsigned* p, unsigned v) { return __hip_atomic_fetch_add(p, v, __ATOMIC_RELAXED, __HIP_MEMORY_SCOPE_AGENT); }
__device__ __forceinline__ unsigned xb_xcc_id() { return (unsigned)__builtin_amdgcn_s_getreg((3 << 11) | 20) & 0xFu; }
#define XB_SPIN(cond, bar) do { unsigned _sp = 0; while (cond) { __builtin_amdgcn_s_sleep(1); \
    if ((++_sp & 255u) == 0u) { if (xb_ld(&(bar)[XB_TMO])) break; if (_sp > XB_SPIN_CAP) { atomicAdd(&(bar)[XB_TMO], 1u); break; } } } } while (0)

struct XcdBarrier {
    unsigned* bar; unsigned x;
    volatile LAS unsigned* st;
};

__device__ __forceinline__ XcdBarrier xcd_barrier_post(unsigned* bar, volatile LAS unsigned* st) {
    XcdBarrier b; b.bar = bar; b.x = xb_xcc_id(); b.st = st;
    if (threadIdx.x == 0) (void)xb_add(&bar[XB_XCNT(b.x)], 1u);
    return b;
}
__device__ __forceinline__ void xcd_barrier_complete(unsigned* bar, unsigned x, unsigned& nloc, unsigned& nx) {
    const unsigned G = gridDim.x * gridDim.y * gridDim.z;
    unsigned sum, cnt, mine, sp = 0u;
    for (;;) {
        sum = 0u; cnt = 0u; mine = 0u;
#pragma unroll
        for (unsigned j = 0; j < 16; ++j) { const unsigned c = xb_ld(&bar[XB_XCNT(j)]); sum += c; cnt += (c > 0u) ? 1u : 0u; mine = (j == x) ? c : mine; }
        if (sum == G) break;
        __builtin_amdgcn_s_sleep(1);
        if ((++sp & 255u) == 0u) { if (xb_ld(&bar[XB_TMO])) break; if (sp > XB_SPIN_CAP) { atomicAdd(&bar[XB_TMO], 1u); break; } }
    }
    nloc = mine > 0u ? mine : 1u; nx = cnt > 0u ? cnt : 1u;
}

__device__ __forceinline__ void xcd_barrier(const XcdBarrier& b) {
    asm volatile("s_waitcnt vmcnt(0)" ::: "memory");
    __syncthreads();
    if (threadIdx.x == 0) {
        unsigned* bar = b.bar;
        __builtin_amdgcn_s_waitcnt(0);
        unsigned nloc = b.st[0], nx = b.st[1];
        if (nloc == 0u) { xcd_barrier_complete(bar, b.x, nloc, nx); b.st[0] = nloc; b.st[1] = nx; }
        const unsigned old = xb_add(&bar[XB_XSUB(b.x)], 1u);
        const unsigned gen = old / nloc;
        if (old + 1u == (gen + 1u) * nloc) {
            __builtin_amdgcn_fence(__ATOMIC_RELEASE, "agent");
            asm volatile("s_waitcnt vmcnt(0)" ::: "memory");
            const unsigned og = xb_add(&bar[XB_TOP], 1u);
            const unsigned tg = og / nx;
            if (og + 1u == (tg + 1u) * nx) xb_add(&bar[XB_TOPGEN], 1u);
            else XB_SPIN(xb_ld(&bar[XB_TOPGEN]) == tg, bar);
            __builtin_amdgcn_fence(__ATOMIC_ACQUIRE, "agent");
            xb_add(&bar[XB_XGEN(b.x)], 1u);
            asm volatile("s_waitcnt vmcnt(0)" ::: "memory");
        } else {
            XB_SPIN(xb_ld(&bar[XB_XGEN(b.x)]) == gen, bar);
            __builtin_amdgcn_fence(__ATOMIC_ACQUIRE, "agent");
            asm volatile("s_waitcnt vmcnt(0)" ::: "memory");
        }
    }
    __syncthreads();
}


template <int LO, int HI>
__global__ void __launch_bounds__(512, 2) k_phases(Params p) {
    extern __shared__ __attribute__((aligned(16))) unsigned char smem[];
#define IN(k) (LO <= (k) && (k) < HI)
#define SEAM(k) do { if constexpr (IN(k) && IN((k) + 1)) { xcd_barrier(xbar); if (TS_A >= 0 && blockIdx.x == 0 && threadIdx.x == 0) ((unsigned*)(p.ws + OFF_CTRL + 8192))[(k) + 1] = (unsigned)__builtin_amdgcn_s_memrealtime(); } } while (0)
    XcdBarrier xbar; xbar.bar = nullptr; xbar.x = 0; xbar.st = nullptr;
    if constexpr (HI - LO > 1) {
        volatile LAS unsigned* stw = (volatile LAS unsigned*)((LAS unsigned char*)smem + LDS_BYTES - 48);
        if (threadIdx.x < 4) stw[threadIdx.x] = 0u;
        __syncthreads();
        xbar = xcd_barrier_post((unsigned*)(p.ws + OFF_CTRL + 16384), stw);
    }
    if (TS_A >= 0 && blockIdx.x == 0 && threadIdx.x == 0) ((unsigned*)(p.ws + OFF_CTRL + 8192))[0] = (unsigned)__builtin_amdgcn_s_memrealtime();
    if constexpr (IN(0)) { for (int rep = 0; rep < NREP(0); ++rep) phase0(p, smem); }
    SEAM(0);
    if constexpr (IN(1)) for (int rep = 0; rep < NREP(1); ++rep) {
        EpiIn E{p.ws, p.a_log, p.dt_bias, p.pos};
        {
            pg8::Gemm g{(const h16*)(p.ws + OFF_H), (const h16*)(p.ws + OFF_WT), BT, NPAD, DM};
            OrderF16 S; S.init(BT, 21 * 256, gridDim.x, blockIdx.x);
            pg8::gemm_phase<EpiIn, OrderF16>((LAS unsigned char*)smem, g, S, E);
        }
        {
            pg8::Gemm g{(const h16*)(p.ws + OFF_H8), (const h16*)(p.ws + OFF_WT8 - (size_t)16 * 256 * 2048), BT, 2560, DM};
            OrderF8 S; S.G = gridDim.x; S.c = blockIdx.x;
            pg8::gemm_phase<EpiIn, OrderF8, true, true>((LAS unsigned char*)smem, g, S, E);
        }
    }
    SEAM(1);
    if constexpr (IN(2)) for (int rep = 0; rep < NREP(2); ++rep) {
        {
            unsigned* qctr = (unsigned*)(p.ws + OFF_CTRL);
            volatile unsigned* lds_t = (volatile unsigned*)(smem + LDS_BYTES - 16);
            __syncthreads();
            if (threadIdx.x == 0) lds_t[0] = atomicAdd(qctr + 0 + 16 * rep, 1u);
            __syncthreads();
            unsigned o = lds_t[0];
            while (o < 1024u + 2048u) {
                unsigned nxt = 0u;
                if (threadIdx.x == 0) nxt = atomicAdd(qctr + 0 + 16 * rep, 1u);
                if (o < 1024u) { ACC_T0(); gdn_prep_pair(p, smem, (int)o); __syncthreads(); ACC_ADD(0); }
                else { const unsigned o2 = o - 1024u; idx8_task(p, smem, (int)(o2 & 3u), 511 - (int)(o2 >> 2)); }
                __syncthreads();
                if (threadIdx.x == 0) lds_t[0] = nxt;
                __syncthreads();
                o = lds_t[0];
            }
        }
    }
    SEAM(2);
    if constexpr (IN(3)) for (int rep = 0; rep < NREP(3); ++rep) {
        {
            unsigned* qctr = (unsigned*)(p.ws + OFF_CTRL);
            volatile unsigned* lds_t = (volatile unsigned*)(smem + LDS_BYTES - 16);
            volatile unsigned* lds_c = (volatile unsigned*)(smem + LDS_BYTES - 192);
            const int myx = (int)(xb_xcc_id() & 7u);
            for (int pass = 0; pass < 2; ++pass) {
                if (pass == 1) { __syncthreads(); if (threadIdx.x < 8) lds_c[8 + threadIdx.x] = __hip_atomic_load(qctr + 64 + 16 * rep + threadIdx.x, __ATOMIC_RELAXED, __HIP_MEMORY_SCOPE_AGENT); __syncthreads(); }
                const int nk = pass == 0 ? 1 : 8;
                for (int k = 0; k < nk; ++k) {
                    const int sp = (myx + k) & 7;
                    if (pass == 1 && lds_c[8 + sp] >= 4u) continue;
                    for (;;) {
                        __syncthreads();
                        if (threadIdx.x == 0) lds_t[0] = atomicAdd(qctr + 64 + 16 * rep + sp, 1u);
                        __syncthreads();
                        const unsigned o = lds_t[0];
                        if (o >= 4u) break;
                        { ACC_T0(); gdn_scan_task(p, smem, 4 * sp + (int)o); __syncthreads(); ACC_ADD(4); }
                        if (pass == 0) break;
                    }
                }
                if (pass == 0) for (int k = 0; k < 8; ++k) {
                    const int part = (myx + k) & 7;
                    if (k == 1) { __syncthreads(); if (threadIdx.x < 8) lds_c[threadIdx.x] = __hip_atomic_load(qctr + 128 + 16 * rep + threadIdx.x, __ATOMIC_RELAXED, __HIP_MEMORY_SCOPE_AGENT); __syncthreads(); }
                    if (k >= 1 && lds_c[part] >= 512u) continue;
                    __syncthreads();
                    if (threadIdx.x == 0) lds_t[0] = atomicAdd(qctr + 128 + 16 * rep + part, 1u);
                    __syncthreads();
                    unsigned a = lds_t[0];
                    while (a < 512u) {
                        unsigned nxt = 0u;
                        if (threadIdx.x == 0) nxt = atomicAdd(qctr + 128 + 16 * rep + part, 1u);
                        { ACC_T0(); attn8_task(p, smem, part, (int)a); __syncthreads(); ACC_ADD(3); }
                        __syncthreads();
                        if (threadIdx.x == 0) lds_t[0] = nxt;
                        __syncthreads();
                        a = lds_t[0];
                    }
                }
            }
        }
    }
    SEAM(3);
    const bool fuse_norm = (gridDim.x == 256) && (TS_A < 0) && (TS_ACC < 0);
    if constexpr (IN(4)) {
        pg8::Gemm g{(const h16*)(p.ws + OFF_OMIX), (const h16*)(p.ws + OFF_WOT), BT, DM, DM};
        if (fuse_norm) {
            PanelOrder S; S.c = blockIdx.x;
            EpiOutNorm E{p.x, p.out, (float*)(p.ws + OFF_ROWSS), (unsigned*)(p.ws + OFF_CTRL + 32768), p.final_g};
            pg8::gemm_phase<EpiOutNorm, PanelOrder>((LAS unsigned char*)smem, g, S, E);
        } else {
            pg8::StaticOrder S; S.init(BT, DM, gridDim.x, blockIdx.x);
            EpiOut E{p.x, p.out, (float*)(p.ws + OFF_ROWSS)};
            pg8::gemm_phase<EpiOut, pg8::StaticOrder>((LAS unsigned char*)smem, g, S, E);
        }
    }
    if (fuse_norm) return;
    SEAM(4);
    if constexpr (IN(5)) { phase5(p); }
#undef IN
#undef SEAM
}

template <int LO, int HI> static void launch_range(const Params& p, int grid, hipStream_t stream, bool coop) {
    static bool attr = false;
    if (!attr) { hipFuncSetAttribute((const void*)k_phases<LO, HI>, hipFuncAttributeMaxDynamicSharedMemorySize, LDS_BYTES); attr = true; }
    if (coop) {
        Params pp = p; void* args[] = {&pp};
        hipError_t e = hipLaunchCooperativeKernel((const void*)k_phases<LO, HI>, dim3(grid), dim3(512), args, LDS_BYTES, stream);
        if (e != hipSuccess) fprintf(stderr, "cooperative launch failed: %s (grid %d)\n", hipGetErrorString(e), grid);
    } else {
        hipLaunchKernelGGL((k_phases<LO, HI>), dim3(grid), dim3(512), LDS_BYTES, stream, p);
    }
}

extern "C" void kernel_launch(void* const* d_in, const int* in_sizes, int n_in, void* d_out, int out_size, void* d_ws, size_t ws_size, hipStream_t stream) {
    if (n_in != 10 || in_sizes[0] != BT * DM || out_size != BT * DM || ws_size < WS_END) {
        fprintf(stderr, "kernel_launch: unexpected shapes (n_in %d in0 %d out %d ws %zu need %zu)\n", n_in, n_in > 0 ? in_sizes[0] : -1, out_size, ws_size, (size_t)WS_END); return; }
    static int grid = 0;
    if (!grid) {
        int dev = 0, cus = 0, per_cu = 0; hipGetDevice(&dev); hipDeviceGetAttribute(&cus, hipDeviceAttributeMultiprocessorCount, dev);
#if FUSED
        hipFuncSetAttribute((const void*)k_phases<0, 6>, hipFuncAttributeMaxDynamicSharedMemorySize, LDS_BYTES);
        hipOccupancyMaxActiveBlocksPerMultiprocessor(&per_cu, (const void*)k_phases<0, 6>, 512, LDS_BYTES);
#else
        per_cu = 1;
#endif
        if (per_cu < 1) per_cu = 1; if (per_cu > 1) per_cu = 1;
        grid = cus * per_cu;
    }
    Params p{};
    p.x = (const float*)d_in[0]; p.pos = (const int*)d_in[1]; p.attn_g = (const float*)d_in[2]; p.w_in = (const float*)d_in[3]; p.conv_w = (const float*)d_in[4];
    p.a_log = (const float*)d_in[5]; p.dt_bias = (const float*)d_in[6]; p.gdn_norm_g = (const float*)d_in[7]; p.w_out = (const float*)d_in[8]; p.final_g = (const float*)d_in[9];
    p.out = (float*)d_out; p.ws = (unsigned char*)d_ws;
    hipMemsetAsync((char*)d_ws + OFF_CTRL, 0, CTL_ZERO_BYTES, stream);
#if FUSED
    launch_range<0, 6>(p, grid, stream, false);
#else
    launch_range<0, 1>(p, grid, stream, false);
    launch_range<1, 2>(p, grid, stream, false);
    launch_range<2, 3>(p, grid, stream, false);
    launch_range<3, 4>(p, grid, stream, false);
    launch_range<4, 5>(p, grid, stream, false);
    launch_range<5, 6>(p, grid, stream, false);
#endif
}
```

```cpp
#include <hip/hip_runtime.h>
#include <hip/hip_cooperative_groups.h>
#include <cstdio>
#include <cstdint>
namespace cg = cooperative_groups;

#ifndef FUSED
#define FUSED 1
#endif
#ifndef REPEAT_PHASE
#define REPEAT_PHASE -1
#endif
#define NREP(k) ((REPEAT_PHASE == (k)) ? 2 : 1)
#ifndef TS_A
#define TS_A -1
#endif
#ifndef TS_ACC
#define TS_ACC -1
#endif
#define ACC_T0() unsigned acc_t0_ = 0; if (TS_ACC >= 0 && threadIdx.x == 0) acc_t0_ = (unsigned)__builtin_amdgcn_s_memrealtime()
#define ACC_ADD(k) do { if (TS_ACC >= 0 && threadIdx.x == 0) { const unsigned t1_ = (unsigned)__builtin_amdgcn_s_memrealtime(); atomicAdd((unsigned*)(p.ws + OFF_CTRL + 8192) + 16 + (k), t1_ - acc_t0_); acc_t0_ = t1_; } } while (0)
#ifndef TS_B
#define TS_B -1
#endif

#define LAS __attribute__((address_space(3)))
typedef _Float16 h16;
typedef h16 h16x8 __attribute__((ext_vector_type(8)));
typedef h16 h16x4 __attribute__((ext_vector_type(4)));
typedef h16 h16x2 __attribute__((ext_vector_type(2)));
typedef float f32x4 __attribute__((ext_vector_type(4)));
typedef float f32x2 __attribute__((ext_vector_type(2)));
typedef unsigned u32x4 __attribute__((ext_vector_type(4)));

constexpr int NB = 4, NT = 4096, DM = 2048, BT = NB * NT;
constexpr int IN_COLS = 7776, NPAD = 7936;
constexpr float EPS = 1e-6f;
constexpr int LDS_BYTES = 155648;

constexpr size_t MB = 1024 * 1024;
constexpr size_t OFF_CTRL = 0;
constexpr size_t OFF_ROWSS = 65536;
constexpr size_t CTL_ZERO_BYTES = 65536 + (size_t)BT * 4;
constexpr size_t OFF_H = 1 * MB;
constexpr size_t OFF_OMIX = OFF_H;
constexpr size_t OFF_WT = OFF_H + 64 * MB;
constexpr size_t OFF_WOT = OFF_WT + (size_t)NPAD * 2048 * 2;
constexpr size_t OFF_QKVR = OFF_WOT + 8 * MB;
constexpr size_t OFF_GZ = OFF_QKVR + (size_t)BT * 3072 * 2;
constexpr size_t OFF_AQ = OFF_GZ + 32 * MB;
constexpr size_t OFF_AK = OFF_AQ + 32 * MB;
constexpr size_t OFF_AV = OFF_AK + 8 * MB;
constexpr size_t OFF_AZ = OFF_AV + 8 * MB;
constexpr size_t OFF_IQ = OFF_AZ + 32 * MB;
constexpr size_t OFF_IK = OFF_IQ + 32 * MB;
constexpr size_t OFF_GB = OFF_IK + 2 * MB;
constexpr size_t OFF_IW = OFF_GB + 1 * MB;
constexpr size_t OFF_COS = OFF_IW + 1 * MB;
constexpr size_t OFF_SIN = OFF_COS + 2 * MB;
constexpr size_t OFF_SEL = OFF_SIN + 2 * MB;
constexpr size_t OFF_REC = OFF_SEL + 8 * MB;
constexpr size_t OFF_H8 = OFF_REC;
constexpr size_t OFF_WT8 = OFF_REC + 32 * MB;
constexpr size_t WS_END = OFF_REC + (size_t)2048 * 74752;

struct Params {
    const float* x; const int* pos; const float* attn_g; const float* w_in; const float* conv_w; const float* a_log;
    const float* dt_bias; const float* gdn_norm_g; const float* w_out; const float* final_g; float* out; unsigned char* ws;
};

__device__ __forceinline__ float wave_sum(float v) {
#pragma unroll
    for (int o = 1; o < 64; o <<= 1) v += __shfl_xor(v, o);
    return v;
}
__device__ __forceinline__ float wave_max(float v) {
#pragma unroll
    for (int o = 1; o < 64; o <<= 1) v = fmaxf(v, __shfl_xor(v, o));
    return v;
}
__device__ __forceinline__ int opaque_tid() { int t = threadIdx.x; asm volatile("" : "+v"(t)); return t; }
__device__ __forceinline__ float silu_f(float x) { return x * __builtin_amdgcn_rcpf(1.0f + __builtin_amdgcn_exp2f(-1.4426950408889634f * x)); }

namespace pg8 {
constexpr int BM = 256, BK = 64, HALF = 128, HTB = HALF * BK * 2, STAGE_BYTES = 8 * HTB, NXCD = 8, WGM = 8;
__host__ __device__ __forceinline__ int lds_byte(int r, int c) { const int st = (r >> 4) * 2 + (c >> 5), rr = r & 15, cc = c & 31, ob = rr * 64 + cc * 2; return st * 1024 + (ob ^ (((ob >> 9) & 1) << 5)); }
__host__ __device__ __forceinline__ void stage_rc(int b, int& R, int& C) { const int st = b / 1024, sb = b % 1024, swz = sb ^ (((sb >> 9) & 1) << 5); R = (st >> 1) * 16 + swz / 64; C = (st & 1) * 32 + (swz % 64) / 2; }
__host__ __device__ __forceinline__ int perm32(int rho) { const int n = rho >> 4, i = rho & 15; return 8 * (i >> 2) + 4 * n + (i & 3); }
struct Unit { int pm, pn; };
struct Gemm { const h16* A; const h16* Bt; int M, N, K; };
struct StaticOrder {
    int nM, nN, nwg, G, c;
    __host__ __device__ void init(int M, int N, int G_, int c_) { nM = M / BM; nN = N / BM; nwg = nM * nN; G = G_; c = c_; }
    __host__ __device__ bool next(int i, Unit& u) const {
        const long L = (long)i * G + c; if (L >= nwg) return false;
        int wgid = (int)L; { const int q = nwg / NXCD, r = nwg % NXCD, xcd = wgid % NXCD, off = wgid / NXCD; wgid = (xcd < r ? xcd * (q + 1) : r * (q + 1) + (xcd - r) * q) + off; }
        const int nig = WGM * nN, gid = wgid / nig, fm = gid * WGM, gsz = (nM - fm) < WGM ? (nM - fm) : WGM;
        u.pm = fm + ((wgid % nig) % gsz); u.pn = (wgid % nig) / gsz; return true;
    }
    __device__ __forceinline__ void a_ready(const Unit&) const {}
    __device__ __forceinline__ void done(const Unit&) const {}
};

typedef int i32x8 __attribute__((ext_vector_type(8)));
template <class Epi, class Sched, bool SP2 = true, bool F8 = false>
__device__ __forceinline__ void gemm_phase(LAS unsigned char* lds, const Gemm g, const Sched& S, const Epi& E) {
    const int tid = opaque_tid(), wid = __builtin_amdgcn_readfirstlane(tid >> 6), lane = tid & 63, wr = wid >> 2, wc = wid & 3, fr = lane & 15, fq = lane >> 4;
    const int K = g.K;
    const int ESZ = F8 ? 1 : 2, nt = (K * ESZ) / 128;
    unsigned voffA[2], voffB[2];
#pragma unroll
    for (int i = 0; i < 2; ++i) { int R, C; stage_rc(tid * 16 + i * 8192, R, C); const int Rb = Epi::PERM ? ((R & ~31) + perm32(R & 31)) : R;
        voffA[i] = (unsigned)(R * K * ESZ + C * 2); voffB[i] = (unsigned)(Rb * K * ESZ + C * 2); }
    const size_t kstep = (size_t)(BK * 2);
    const size_t hstep = (size_t)HALF * K * ESZ;
    const size_t tstep = 2 * hstep;
    const unsigned ldsw = (unsigned)wid * 1024u;
    const int aoff = lds_byte(wr * 64 + fr, fq * 8), boff = lds_byte(wc * 32 + fr, fq * 8);
#define PG8_SA(b, h) (((b) * 2 + (h)) * HTB)
#define PG8_SB(b, h) ((4 + (b) * 2 + (h)) * HTB)
#define PG8_STAGE(bufoff, gbase, voff) do { _Pragma("unroll") for (int _i = 0; _i < 2; ++_i) \
        __builtin_amdgcn_global_load_lds((const unsigned*)((const char*)(gbase) + (voff)[_i]), (LAS unsigned*)(lds + (bufoff) + ldsw + _i * 8192), 16, 0, 0); } while (0)
#define PG8_LDA(dst, b, h) do { _Pragma("unroll") for (int m = 0; m < 4; ++m) _Pragma("unroll") for (int k = 0; k < 2; ++k) dst[m][k] = *(const LAS h16x8*)(lds + PG8_SA(b, h) + aoff + m * 2048 + k * 1024); } while (0)
#define PG8_LDB(dst, b, h) do { _Pragma("unroll") for (int n = 0; n < 2; ++n) _Pragma("unroll") for (int k = 0; k < 2; ++k) dst[n][k] = *(const LAS h16x8*)(lds + PG8_SB(b, h) + boff + n * 2048 + k * 1024); } while (0)
#define PG8_MMA(ai, bj, At, Bt) do { __builtin_amdgcn_s_setprio(1); \
        if constexpr (F8) { _Pragma("unroll") for (int m = 0; m < 4; ++m) _Pragma("unroll") for (int n = 0; n < 2; ++n) { \
            const u32x4 b0_ = __builtin_bit_cast(u32x4, Bt[n][0]), b1_ = __builtin_bit_cast(u32x4, Bt[n][1]), a0_ = __builtin_bit_cast(u32x4, At[m][0]), a1_ = __builtin_bit_cast(u32x4, At[m][1]); \
            const i32x8 bw_ = (i32x8){(int)b0_[0], (int)b0_[1], (int)b0_[2], (int)b0_[3], (int)b1_[0], (int)b1_[1], (int)b1_[2], (int)b1_[3]}; \
            const i32x8 aw_ = (i32x8){(int)a0_[0], (int)a0_[1], (int)a0_[2], (int)a0_[3], (int)a1_[0], (int)a1_[1], (int)a1_[2], (int)a1_[3]}; \
            asm volatile("v_mfma_scale_f32_16x16x128_f8f6f4 %0, %1, %2, %0, %3, %3 op_sel_hi:[0,0,0]" : "+v"(acc[ai][bj][m][n]) : "v"(bw_), "v"(aw_), "v"(0x7C7C7C7C)); } } \
        else { _Pragma("unroll") for (int m = 0; m < 4; ++m) _Pragma("unroll") for (int n = 0; n < 2; ++n) _Pragma("unroll") for (int k = 0; k < 2; ++k) \
            acc[ai][bj][m][n] = __builtin_amdgcn_mfma_f32_16x16x32_f16(Bt[n][k], At[m][k], acc[ai][bj][m][n], 0, 0, 0); } \
        __builtin_amdgcn_s_setprio(0); } while (0)
#define PG8_WAIT_V(n) asm volatile("s_waitcnt vmcnt(" #n ")" ::: "memory")
#define PG8_WAIT_L(n) asm volatile("s_waitcnt lgkmcnt(" #n ")" ::: "memory")
#define PG8_BAR __builtin_amdgcn_s_barrier()
#define PG8_SCHED __builtin_amdgcn_sched_barrier(0)
    Unit cur, nxt; int ui = 0;
    if (!S.next(0, cur)) return;
    f32x4 acc[2][2][4][2];
#pragma unroll
    for (int a = 0; a < 2; ++a)
#pragma unroll
        for (int b = 0; b < 2; ++b)
#pragma unroll
            for (int m = 0; m < 4; ++m)
#pragma unroll
                for (int n = 0; n < 2; ++n) acc[a][b][m][n] = (f32x4){0.f, 0.f, 0.f, 0.f};
    h16x8 At[4][2], B0[2][2], B1[2][2];
    const char* cA = (const char*)g.A + (size_t)cur.pm * tstep; const char* cB = (const char*)g.Bt + (size_t)cur.pn * tstep;
    S.a_ready(cur);
    if constexpr (SP2) {
        PG8_STAGE(PG8_SB(0, 0), cB, voffB); PG8_STAGE(PG8_SB(0, 1), cB + hstep, voffB); PG8_STAGE(PG8_SA(0, 0), cA, voffA); PG8_STAGE(PG8_SA(0, 1), cA + hstep, voffA);
        if (wr == 1) PG8_BAR;
        PG8_WAIT_V(2); PG8_BAR;
        PG8_STAGE(PG8_SB(1, 0), cB + kstep, voffB); PG8_STAGE(PG8_SA(1, 0), cA + kstep, voffA); PG8_STAGE(PG8_SB(1, 1), cB + hstep + kstep, voffB);
        PG8_WAIT_V(6); PG8_BAR;
    } else {
    PG8_STAGE(PG8_SB(0, 0), cB, voffB); PG8_STAGE(PG8_SA(0, 0), cA, voffA); PG8_STAGE(PG8_SB(0, 1), cB + hstep, voffB); PG8_STAGE(PG8_SA(0, 1), cA + hstep, voffA);
    if (wr == 1) PG8_BAR;
    PG8_WAIT_V(4); PG8_BAR;
    PG8_STAGE(PG8_SB(1, 0), cB + kstep, voffB); PG8_STAGE(PG8_SA(1, 0), cA + kstep, voffA); PG8_STAGE(PG8_SB(1, 1), cB + hstep + kstep, voffB);
    PG8_WAIT_V(6); PG8_BAR;
    }
    for (;;) {
        const bool has_next = S.next(ui + 1, nxt);
        const char* nA = has_next ? (const char*)g.A + (size_t)nxt.pm * tstep : cA; const char* nB = has_next ? (const char*)g.Bt + (size_t)nxt.pn * tstep : cB;
        for (int t = 0; t < nt; t += 2) {
            const bool last = (t == nt - 2);
            const char* a1 = cA + (size_t)(t + 1) * kstep;
            const char* a2 = last ? nA : cA + (size_t)(t + 2) * kstep; const char* b2 = last ? nB : cB + (size_t)(t + 2) * kstep;
            const char* a3 = a2 + kstep; const char* b3 = b2 + kstep;
            if (last && has_next) S.a_ready(nxt);
            if constexpr (SP2) {
            PG8_LDB(B0, 0, 0); PG8_LDB(B1, 0, 1); PG8_SCHED; PG8_LDA(At, 0, 0); PG8_STAGE(PG8_SA(1, 1), a1 + hstep, voffA);
            PG8_WAIT_V(8); PG8_WAIT_L(0); PG8_BAR; PG8_MMA(0, 0, At, B0); PG8_MMA(0, 1, At, B1); PG8_BAR; PG8_SCHED;
            PG8_LDA(At, 0, 1); PG8_STAGE(PG8_SB(0, 0), b2, voffB); PG8_STAGE(PG8_SB(0, 1), b2 + hstep, voffB); PG8_STAGE(PG8_SA(0, 0), a2, voffA);
            PG8_WAIT_V(8); PG8_WAIT_L(0); PG8_BAR; PG8_MMA(1, 0, At, B0); PG8_MMA(1, 1, At, B1); PG8_BAR; PG8_SCHED;
            PG8_LDB(B0, 1, 0); PG8_LDB(B1, 1, 1); PG8_SCHED; PG8_LDA(At, 1, 0); PG8_STAGE(PG8_SA(0, 1), a2 + hstep, voffA);
            PG8_WAIT_V(8); PG8_WAIT_L(0); PG8_BAR; PG8_MMA(0, 0, At, B0); PG8_MMA(0, 1, At, B1); PG8_BAR; PG8_SCHED;
            PG8_LDA(At, 1, 1); PG8_STAGE(PG8_SB(1, 0), b3, voffB); PG8_STAGE(PG8_SB(1, 1), b3 + hstep, voffB); PG8_STAGE(PG8_SA(1, 0), a3, voffA);
            PG8_WAIT_V(8); PG8_WAIT_L(0); PG8_BAR; PG8_MMA(1, 0, At, B0); PG8_MMA(1, 1, At, B1); PG8_BAR; PG8_SCHED;
            } else {
            PG8_LDB(B0, 0, 0); PG8_SCHED; PG8_LDA(At, 0, 0); PG8_STAGE(PG8_SA(1, 1), a1 + hstep, voffA);
            PG8_WAIT_L(8); PG8_BAR; PG8_WAIT_L(0); PG8_MMA(0, 0, At, B0); PG8_BAR; PG8_SCHED;
            PG8_LDB(B1, 0, 1); PG8_STAGE(PG8_SB(0, 0), b2, voffB);
            PG8_BAR; PG8_WAIT_L(0); PG8_MMA(0, 1, At, B1); PG8_BAR;
            PG8_LDA(At, 0, 1); PG8_STAGE(PG8_SA(0, 0), a2, voffA);
            PG8_BAR; PG8_WAIT_L(0); PG8_MMA(1, 0, At, B0); PG8_BAR; PG8_SCHED;
            PG8_STAGE(PG8_SB(0, 1), b2 + hstep, voffB);
            PG8_WAIT_V(6); PG8_BAR; PG8_MMA(1, 1, At, B1); PG8_BAR;
            PG8_LDB(B0, 1, 0); PG8_SCHED; PG8_LDA(At, 1, 0); PG8_STAGE(PG8_SA(0, 1), a2 + hstep, voffA);
            PG8_WAIT_L(8); PG8_BAR; PG8_WAIT_L(0); PG8_MMA(0, 0, At, B0); PG8_BAR; PG8_SCHED;
            PG8_LDB(B1, 1, 1); PG8_STAGE(PG8_SB(1, 0), b3, voffB);
            PG8_BAR; PG8_WAIT_L(0); PG8_MMA(0, 1, At, B1); PG8_BAR;
            PG8_LDA(At, 1, 1); PG8_STAGE(PG8_SA(1, 0), a3, voffA);
            PG8_BAR; PG8_WAIT_L(0); PG8_MMA(1, 0, At, B0); PG8_BAR; PG8_SCHED;
            PG8_STAGE(PG8_SB(1, 1), b3 + hstep, voffB);
            PG8_WAIT_V(6); PG8_BAR; PG8_MMA(1, 1, At, B1); PG8_BAR;
            }
        }
        if (wr == 0) PG8_BAR;
        if constexpr (F8) asm volatile("s_nop 15\n\ts_nop 15" ::: "memory");
        PG8_SCHED; { const int te = opaque_tid(), le = te & 63; E(acc, cur, wr, wc, le & 15, le >> 4); } S.done(cur);
        if (!has_next) break;
#pragma unroll
        for (int a = 0; a < 2; ++a)
#pragma unroll
            for (int b = 0; b < 2; ++b)
#pragma unroll
                for (int m = 0; m < 4; ++m)
#pragma unroll
                    for (int n = 0; n < 2; ++n) acc[a][b][m][n] = (f32x4){0.f, 0.f, 0.f, 0.f};
        cur = nxt; cA = nA; cB = nB; ++ui;
        if (wr == 1) PG8_BAR;
    }
    PG8_WAIT_V(0);
    PG8_BAR;
#undef PG8_SA
#undef PG8_SB
#undef PG8_STAGE
#undef PG8_LDA
#undef PG8_LDB
#undef PG8_MMA
#undef PG8_WAIT_V
#undef PG8_WAIT_L
#undef PG8_BAR
#undef PG8_SCHED
}
}

struct OrderF16 : pg8::StaticOrder {
    __device__ __forceinline__ bool next(int i, pg8::Unit& u) const { if (!pg8::StaticOrder::next(i, u)) return false; if (u.pn >= 16) u.pn += 10; return true; }
};
struct OrderF8 {
    int G, c;
    __device__ __forceinline__ bool next(int i, pg8::Unit& u) const {
        int L;
        if (G == 256) { if (c < 64) { if (i >= 1) return false; L = 576 + c; } else { if (i >= 3) return false; L = (c - 64) + 192 * i; } }
        else { L = i * G + c; if (L >= 640) return false; }
        const int wgid = (L % 8) * 80 + L / 8;
        u.pm = (wgid / 80) * 8 + (wgid % 80) % 8; u.pn = 16 + (wgid % 80) / 8; return true;
    }
    __device__ __forceinline__ void a_ready(const pg8::Unit&) const {}
    __device__ __forceinline__ void done(const pg8::Unit&) const {}
};

struct EpiIn {
    static constexpr bool PERM = true;
    unsigned char* ws; const float* a_log; const float* dt_bias; const int* pos;
    __device__ __forceinline__ void operator()(const f32x4 (&acc)[2][2][4][2], const pg8::Unit& u, int wr, int wc, int fr, int fq) const {
        constexpr float RF[16] = {1.591549431e-01f, 7.008652159e-02f, 3.086376340e-02f, 1.359137064e-02f, 5.985185713e-03f, 2.635675899e-03f, 1.160663641e-03f, 5.111175045e-04f,
                                  2.250790790e-04f, 9.911730937e-05f, 4.364795279e-05f, 1.922110068e-05f, 8.464330808e-06f, 3.727408602e-06f, 1.641426263e-06f, 7.228293069e-07f};
        const int pn = u.pn;
        const int rowb = u.pm * 256 + wr * 64 + fr;
        const int cw = wc * 32 + 8 * fq;
        if (pn < 30) {
            h16* base; int ldc, colt, mode; float scale = 1.f;
            if (pn < 12) { base = (h16*)(ws + OFF_QKVR); ldc = 3072; colt = pn * 256; mode = 0; }
            else if (pn < 16) { base = (h16*)(ws + OFF_GZ); ldc = 1024; colt = (pn - 12) * 256; mode = 1; }
            else if (pn < 20) { base = (h16*)(ws + OFF_AQ); ldc = 1024; colt = (pn - 16) * 256; mode = 2; }
            else if (pn == 20) { base = (h16*)(ws + OFF_AK); ldc = 256; colt = 0; mode = 2; }
            else if (pn == 21) { base = (h16*)(ws + OFF_AV); ldc = 256; colt = 0; mode = 4; }
            else if (pn < 26) { base = (h16*)(ws + OFF_AZ); ldc = 1024; colt = (pn - 22) * 256; mode = 1; }
            else { base = (h16*)(ws + OFF_IQ); ldc = 1024; colt = (pn - 26) * 256; mode = 3; }
            const bool rot_wave = (mode == 2 && wc == 0) || (mode == 3 && (wc & 1) == 0);
            const int xm = (mode == 2) ? 32 : 16;
            const bool rot_lane = (mode == 2) ? true : (fq < 2);
            const float sgn = (mode == 2) ? (fq < 2 ? -1.f : 1.f) : (fq == 0 ? -1.f : 1.f);
            float Fq[8]; int ps[2][4];
#pragma unroll
            for (int j = 0; j < 8; ++j) Fq[j] = (mode == 2) ? ((fq & 1) ? RF[8 + j] : RF[j]) : RF[2 * j];
            if (rot_wave) {
#pragma unroll
                for (int ai = 0; ai < 2; ++ai)
#pragma unroll
                    for (int m = 0; m < 4; ++m) ps[ai][m] = pos[rowb + ai * 128 + m * 16];
            }
#pragma unroll
            for (int ai = 0; ai < 2; ++ai)
#pragma unroll
                for (int m = 0; m < 4; ++m) {
                    const int row = rowb + ai * 128 + m * 16;
                    float cs[8], sn[8];
                    if (rot_wave) {
                        const float pf = (float)ps[ai][m];
#pragma unroll
                        for (int j = 0; j < 8; ++j) { const float rv = __builtin_amdgcn_fractf(pf * Fq[j]); cs[j] = __builtin_amdgcn_cosf(rv); sn[j] = __builtin_amdgcn_sinf(rv); }
                    }
#pragma unroll
                    for (int bj = 0; bj < 2; ++bj) {
                        float v[8];
#pragma unroll
                        for (int j = 0; j < 4; ++j) { v[j] = acc[ai][bj][m][0][j]; v[4 + j] = acc[ai][bj][m][1][j]; }
                        if (rot_wave) {
#pragma unroll
                            for (int j = 0; j < 8; ++j) {
                                const unsigned xv = __builtin_bit_cast(unsigned, v[j]); float pv;
                                if (mode == 2) { const auto sw = __builtin_amdgcn_permlane32_swap(xv, xv, false, false); pv = __builtin_bit_cast(float, fq < 2 ? sw[1] : sw[0]); }
                                else { const auto sw = __builtin_amdgcn_permlane16_swap(xv, xv, false, false); pv = __builtin_bit_cast(float, (fq & 1) ? sw[0] : sw[1]); }
                                if (rot_lane) v[j] = v[j] * cs[j] + sgn * pv * sn[j]; }
                        }
                        if (mode == 1) {
#pragma unroll
                            for (int j = 0; j < 8; ++j) v[j] = silu_f(v[j]);
                        }
                        if (mode == 4) {
                            int w0 = 0, w1 = 0;
                            w0 = __builtin_amdgcn_cvt_pk_fp8_f32(v[0], v[1], w0, false); w0 = __builtin_amdgcn_cvt_pk_fp8_f32(v[2], v[3], w0, true);
                            w1 = __builtin_amdgcn_cvt_pk_fp8_f32(v[4], v[5], w1, false); w1 = __builtin_amdgcn_cvt_pk_fp8_f32(v[6], v[7], w1, true);
                            typedef int i32x2b __attribute__((ext_vector_type(2)));
                            *(i32x2b*)((unsigned char*)base + (size_t)row * ldc + bj * 128 + cw) = (i32x2b){w0, w1};
                        } else if (mode == 2) {
                            int w0 = 0, w1 = 0;
                            w0 = __builtin_amdgcn_cvt_pk_fp8_f32(v[0], v[1], w0, false); w0 = __builtin_amdgcn_cvt_pk_fp8_f32(v[2], v[3], w0, true);
                            w1 = __builtin_amdgcn_cvt_pk_fp8_f32(v[4], v[5], w1, false); w1 = __builtin_amdgcn_cvt_pk_fp8_f32(v[6], v[7], w1, true);
                            typedef int i32x2 __attribute__((ext_vector_type(2)));
                            *(i32x2*)((unsigned char*)base + (size_t)row * ldc + colt + bj * 128 + cw) = (i32x2){w0, w1};
                        } else {
                            h16x8 o;
#pragma unroll
                            for (int j = 0; j < 8; ++j) o[j] = (h16)(v[j] * scale);
                            *(h16x8*)(base + (size_t)row * ldc + colt + bj * 128 + cw) = o;
                        }
                    }
                }
        } else {
            h16* ik = (h16*)(ws + OFF_IK); float* gb = (float*)(ws + OFF_GB); float* iw = (float*)(ws + OFF_IW);
#pragma unroll
            for (int ai = 0; ai < 2; ++ai)
#pragma unroll
                for (int m = 0; m < 4; ++m) {
                    const int row = rowb + ai * 128 + m * 16;
                    float v[8];
#pragma unroll
                    for (int j = 0; j < 4; ++j) { v[j] = acc[ai][0][m][0][j]; v[4 + j] = acc[ai][0][m][1][j]; }
                    if (wc == 0) {
                        const float sgn = (fq == 0 ? -1.f : 1.f), pf = (float)pos[row];
#pragma unroll
                        for (int j = 0; j < 8; ++j) { const unsigned xv = __builtin_bit_cast(unsigned, v[j]); const auto sw = __builtin_amdgcn_permlane16_swap(xv, xv, false, false); const float pv = __builtin_bit_cast(float, (fq & 1) ? sw[0] : sw[1]); const float rv = __builtin_amdgcn_fractf(pf * RF[2 * j]); const float c = __builtin_amdgcn_cosf(rv), s = __builtin_amdgcn_sinf(rv);
                            if (fq < 2) v[j] = v[j] * c + sgn * pv * s; }
                    }
                    if (wc < 2) {
                        h16x8 o;
#pragma unroll
                        for (int j = 0; j < 8; ++j) o[j] = (h16)v[j];
                        *(h16x8*)(ik + (size_t)(row >> 5) * 2048 + (cw >> 4) * 512 + ((cw >> 3) & 1) * 256 + (row & 31) * 8) = o;
                    } else if (wc == 2) {
                        if (fq == 0) {
#pragma unroll
                            for (int j = 0; j < 8; ++j) { const float z = v[j] + dt_bias[j];
                                const float sp = fmaxf(z, 0.f) + 0.6931471805599453f * __builtin_amdgcn_logf(1.0f + __builtin_amdgcn_exp2f(-1.4426950408889634f * fabsf(z)));
                                gb[(size_t)row * 16 + j] = -__builtin_amdgcn_exp2f(1.4426950408889634f * a_log[j]) * sp; }
                        } else if (fq == 1) {
#pragma unroll
                            for (int j = 0; j < 8; ++j) gb[(size_t)row * 16 + 8 + j] = __builtin_amdgcn_rcpf(1.0f + __builtin_amdgcn_exp2f(-1.4426950408889634f * v[j]));
                        } else {
#pragma unroll
                            for (int j = 0; j < 8; ++j) iw[(size_t)row * 16 + 8 * (fq - 2) + j] = v[j] * 0.03125f;
                        }
                    }
                }
        }
    }
};

struct PanelOrder {
    int c;
    __device__ __forceinline__ bool next(int i, pg8::Unit& u) const { if (i >= 2) return false; u.pm = 32 * i + 4 * (c & 7) + (c >> 6); u.pn = (c >> 3) & 7; return true; }
    __device__ __forceinline__ void a_ready(const pg8::Unit&) const {}
    __device__ __forceinline__ void done(const pg8::Unit&) const {}
};
struct EpiOutNorm {
    static constexpr bool PERM = false;
    const float* x; float* out; float* rowss; unsigned* cnt; const float* fg;
    __device__ __forceinline__ void operator()(f32x4 (&acc)[2][2][4][2], const pg8::Unit& u, int wr, int wc, int fr, int fq) const {
        const int rowb = u.pm * 256 + wr * 64 + fr, col0 = u.pn * 256 + wc * 32 + 4 * fq;
#pragma unroll
        for (int ai = 0; ai < 2; ++ai)
#pragma unroll
            for (int m = 0; m < 4; ++m) {
                const int row = rowb + ai * 128 + m * 16; float ss = 0.f;
#pragma unroll
                for (int bj = 0; bj < 2; ++bj)
#pragma unroll
                    for (int n = 0; n < 2; ++n) {
                        const f32x4 y = *(const f32x4*)(x + (size_t)row * DM + col0 + bj * 128 + n * 16) + acc[ai][bj][m][n];
                        acc[ai][bj][m][n] = y; ss += (y[0] * y[0] + y[1] * y[1]) + (y[2] * y[2] + y[3] * y[3]);
                    }
                ss += __shfl_xor(ss, 16); ss += __shfl_xor(ss, 32);
                if (fq == 0) atomicAdd(rowss + row, ss);
            }
        asm volatile("s_waitcnt vmcnt(0)" ::: "memory");
        unsigned* cw = cnt + (u.pm * 2 + wr) * 16;
        if ((threadIdx.x & 63) == 0) __hip_atomic_fetch_add(cw, 1u, __ATOMIC_RELAXED, __HIP_MEMORY_SCOPE_AGENT);
        { unsigned spins = 0;
          while ((unsigned)__builtin_amdgcn_readfirstlane((int)__hip_atomic_load(cw, __ATOMIC_RELAXED, __HIP_MEMORY_SCOPE_AGENT)) < 32u) { __builtin_amdgcn_s_sleep(2); if (++spins > (1u << 22)) break; } }
        f32x4 gv[2][2];
#pragma unroll
        for (int bj = 0; bj < 2; ++bj)
#pragma unroll
            for (int n = 0; n < 2; ++n) gv[bj][n] = *(const f32x4*)(fg + col0 + bj * 128 + n * 16);
#pragma unroll
        for (int ai = 0; ai < 2; ++ai)
#pragma unroll
            for (int m = 0; m < 4; ++m) {
                const int row = rowb + ai * 128 + m * 16;
                const float ssr = __hip_atomic_load(rowss + row, __ATOMIC_RELAXED, __HIP_MEMORY_SCOPE_AGENT);
                const float r = __builtin_amdgcn_rsqf(ssr * (1.0f / DM) + EPS);
#pragma unroll
                for (int bj = 0; bj < 2; ++bj)
#pragma unroll
                    for (int n = 0; n < 2; ++n) *(f32x4*)(out + (size_t)row * DM + col0 + bj * 128 + n * 16) = acc[ai][bj][m][n] * r * gv[bj][n];
            }
    }
};

struct EpiOut {
    static constexpr bool PERM = false;
    const float* x; float* out; float* rowss;
    __device__ __forceinline__ void operator()(const f32x4 (&acc)[2][2][4][2], const pg8::Unit& u, int wr, int wc, int fr, int fq) const {
        const int rowb = u.pm * 256 + wr * 64 + fr, col0 = u.pn * 256 + wc * 32 + 4 * fq;
#pragma unroll
        for (int ai = 0; ai < 2; ++ai)
#pragma unroll
            for (int m = 0; m < 4; ++m) {
                const int row = rowb + ai * 128 + m * 16; float ss = 0.f;
#pragma unroll
                for (int bj = 0; bj < 2; ++bj)
#pragma unroll
                    for (int n = 0; n < 2; ++n) {
                        const size_t off = (size_t)row * DM + col0 + bj * 128 + n * 16;
                        const f32x4 y = *(const f32x4*)(x + off) + acc[ai][bj][m][n];
                        *(f32x4*)(out + off) = y; ss += (y[0] * y[0] + y[1] * y[1]) + (y[2] * y[2] + y[3] * y[3]);
                    }
                ss += __shfl_xor(ss, 16); ss += __shfl_xor(ss, 32);
                if (fq == 0) atomicAdd(rowss + row, ss);
            }
    }
};

__device__ __forceinline__ int src_col(int np) {
    if (np < 4096) return np;
    if (np < 7680) return np + 16;
    if (np < 7744) return 7696 + (np - 7680);
    if (np < 7752) return 4096 + (np - 7744);
    if (np < 7760) return 4104 + (np - 7752);
    if (np < 7776) return np;
    return -1;
}
__device__ __forceinline__ void phase0(const Params& p, unsigned char* smem) {
    const int tid = opaque_tid(), wid = tid >> 6, lane = tid & 63;
    const int gw = blockIdx.x * 8 + wid, nw = gridDim.x * 8;
    h16* H = (h16*)(p.ws + OFF_H); unsigned char* H8 = p.ws + OFF_H8;
    for (int row = 2 * gw; row < BT; row += 2 * nw) {
        const f32x4* xr0 = (const f32x4*)(p.x + (size_t)row * DM); const f32x4* xr1 = xr0 + DM / 4;
        f32x4 v0[8], v1[8]; float s0 = 0.f, s1 = 0.f;
#pragma unroll
        for (int i = 0; i < 8; ++i) { v0[i] = xr0[lane + 64 * i]; v1[i] = xr1[lane + 64 * i]; }
#pragma unroll
        for (int i = 0; i < 8; ++i) { s0 += (v0[i][0] * v0[i][0] + v0[i][1] * v0[i][1]) + (v0[i][2] * v0[i][2] + v0[i][3] * v0[i][3]); s1 += (v1[i][0] * v1[i][0] + v1[i][1] * v1[i][1]) + (v1[i][2] * v1[i][2] + v1[i][3] * v1[i][3]); }
        s0 = wave_sum(s0); s1 = wave_sum(s1);
        const float r0 = __builtin_amdgcn_rsqf(s0 * (1.0f / DM) + EPS), r1 = __builtin_amdgcn_rsqf(s1 * (1.0f / DM) + EPS);
#pragma unroll
        for (int i = 0; i < 8; ++i) { const f32x4 g = ((const f32x4*)p.attn_g)[lane + 64 * i]; h16x4 o0, o1;
#pragma unroll
            for (int j = 0; j < 4; ++j) { o0[j] = (h16)(v0[i][j] * r0 * g[j]); o1[j] = (h16)(v1[i][j] * r1 * g[j]); }
            *(h16x4*)(H + (size_t)row * DM + 4 * (lane + 64 * i)) = o0; *(h16x4*)(H + (size_t)(row + 1) * DM + 4 * (lane + 64 * i)) = o1;
            int e0 = 0, e1 = 0;
            e0 = __builtin_amdgcn_cvt_pk_fp8_f32(v0[i][0] * r0 * g[0], v0[i][1] * r0 * g[1], e0, false); e0 = __builtin_amdgcn_cvt_pk_fp8_f32(v0[i][2] * r0 * g[2], v0[i][3] * r0 * g[3], e0, true);
            e1 = __builtin_amdgcn_cvt_pk_fp8_f32(v1[i][0] * r1 * g[0], v1[i][1] * r1 * g[1], e1, false); e1 = __builtin_amdgcn_cvt_pk_fp8_f32(v1[i][2] * r1 * g[2], v1[i][3] * r1 * g[3], e1, true);
            *(int*)(H8 + (size_t)row * DM + 4 * (lane + 64 * i)) = e0; *(int*)(H8 + (size_t)(row + 1) * DM + 4 * (lane + 64 * i)) = e1; }
    }
    {
        float* tiles = (float*)smem;
        h16* Wt = (h16*)(p.ws + OFF_WT); h16* WoT = (h16*)(p.ws + OFF_WOT);
        constexpr int NT1 = 124 * 32, NTT = NT1 + 32 * 32;
        const int nl_r = tid & 63, kl_r = tid >> 6, nl_w = tid >> 3, kc_w = tid & 7;
        float va[8], vb[8];
#define P0_LOAD(tI, v) do { if ((tI) < NT1) { const int n0_ = ((tI) / 32) * 64, k0_ = ((tI) % 32) * 64; const int src_ = src_col(n0_ + nl_r); \
            _Pragma("unroll") for (int i = 0; i < 8; ++i) v[i] = src_ >= 0 ? p.w_in[(size_t)(k0_ + kl_r + 8 * i) * IN_COLS + src_] : 0.f; } \
          else { const int t2_ = (tI) - NT1; const int n0_ = (t2_ / 32) * 64, k0_ = (t2_ % 32) * 64; \
            _Pragma("unroll") for (int i = 0; i < 8; ++i) v[i] = p.w_out[(size_t)(k0_ + kl_r + 8 * i) * DM + n0_ + nl_r]; } } while (0)
#define P0_PUT(buf, v) do { float* t_ = tiles + (buf) * (64 * 65); _Pragma("unroll") for (int i = 0; i < 8; ++i) t_[(kl_r + 8 * i) * 65 + nl_r] = v[i]; } while (0)
#define P0_STORE(buf, tI) do { const float* t_ = tiles + (buf) * (64 * 65); h16x8 o_; _Pragma("unroll") for (int j = 0; j < 8; ++j) o_[j] = (h16)t_[(8 * kc_w + j) * 65 + nl_w]; \
          if ((tI) < NT1) { const int n0_ = ((tI) / 32) * 64, k0_ = ((tI) % 32) * 64; \
              if (n0_ >= 4096 && n0_ < 6656) { int e0_ = 0, e1_ = 0; e0_ = __builtin_amdgcn_cvt_pk_fp8_f32(64.f * (float)o_[0], 64.f * (float)o_[1], e0_, false); e0_ = __builtin_amdgcn_cvt_pk_fp8_f32(64.f * (float)o_[2], 64.f * (float)o_[3], e0_, true); \
                  e1_ = __builtin_amdgcn_cvt_pk_fp8_f32(64.f * (float)o_[4], 64.f * (float)o_[5], e1_, false); e1_ = __builtin_amdgcn_cvt_pk_fp8_f32(64.f * (float)o_[6], 64.f * (float)o_[7], e1_, true); \
                  typedef int i32x2w __attribute__((ext_vector_type(2))); *(i32x2w*)(p.ws + OFF_WT8 + (size_t)(n0_ - 4096 + nl_w) * 2048 + k0_ + 8 * kc_w) = (i32x2w){e0_, e1_}; } \
              else *(h16x8*)(Wt + (size_t)(n0_ + nl_w) * 2048 + k0_ + 8 * kc_w) = o_; } \
          else { const int t2_ = (tI) - NT1; const int n0_ = (t2_ / 32) * 64, k0_ = (t2_ % 32) * 64; *(h16x8*)(WoT + (size_t)(n0_ + nl_w) * 2048 + k0_ + 8 * kc_w) = o_; } } while (0)
        int tI = blockIdx.x; int buf = 0;
        __syncthreads();
        if (tI < NTT) { P0_LOAD(tI, va); P0_PUT(0, va); }
        while (tI < NTT) {
            const int tn = tI + gridDim.x;
            if (tn < NTT) P0_LOAD(tn, vb);
            __syncthreads();
            P0_STORE(buf, tI);
            if (tn < NTT) P0_PUT(buf ^ 1, vb);
            buf ^= 1; tI = tn;
        }
#undef P0_LOAD
#undef P0_PUT
#undef P0_STORE
    }
}

__device__ __forceinline__ h16x8 pack8(const f32x4 a, const f32x4 c) { h16x8 o; o[0] = (h16)a[0]; o[1] = (h16)a[1]; o[2] = (h16)a[2]; o[3] = (h16)a[3]; o[4] = (h16)c[0]; o[5] = (h16)c[1]; o[6] = (h16)c[2]; o[7] = (h16)c[3]; return o; }
typedef short v4s_t __attribute__((__vector_size__(4 * sizeof(short))));
__device__ __forceinline__ h16x4 lds_tr16(const LAS unsigned char* a) { const v4s_t v = __builtin_amdgcn_ds_read_tr16_b64_v4i16((LAS v4s_t*)a); return __builtin_bit_cast(h16x4, v); }
constexpr int REC_BYTES = 74752, REC_WF = 0, REC_QF = 16384, REC_AF = 32768, REC_KTF = 40960, REC_VEC = 57344, REC_UF = 58368, REC_DMA = 58368;
constexpr int HB_BYTES = 69632;

__device__ __forceinline__ void gdn_prep_pair(const Params& p, unsigned char* smem, int pair) {
    const int tid = opaque_tid(), wid = __builtin_amdgcn_readfirstlane(tid >> 6), lane = tid & 63, hb = wid >> 2, w4 = wid & 3, tl = tid & 255;
    const int tk = 2 * pair + hb; const int b = tk >> 9, h = (tk >> 6) & 7, n = tk & 63; const int t0 = n * 64;
    unsigned char* base = smem + hb * HB_BYTES;
    h16* Kn = (h16*)base; h16* Qn = Kn + 64 * 136; h16* Vh = Qn + 64 * 136; float* L = (float*)(Vh + 64 * 136); float* vec = L + 4096;
    unsigned char* rec = p.ws + OFF_REC + (size_t)tk * REC_BYTES;
    const h16* qkvr = (const h16*)(p.ws + OFF_QKVR);
    __syncthreads();
    {
        const int cg = tl & 15, rg = tl >> 4;
        h16x8 raw[3][7];
#pragma unroll
        for (int ti = 0; ti < 3; ++ti)
#pragma unroll
            for (int r = 0; r < 7; ++r) {
                const int trow = t0 + 4 * rg - 3 + r;
                if (trow >= 0) raw[ti][r] = *(const h16x8*)(qkvr + ((size_t)b * NT + trow) * 3072 + ti * 1024 + h * 128 + 8 * cg);
                else { for (int j = 0; j < 8; ++j) raw[ti][r][j] = (h16)0.f; }
            }
#pragma unroll
        for (int ti = 0; ti < 3; ++ti) {
            const int chan = ti * 1024 + h * 128 + 8 * cg;
            float xr[7][8];
#pragma unroll
            for (int r = 0; r < 7; ++r)
#pragma unroll
                for (int j = 0; j < 8; ++j) xr[r][j] = (float)raw[ti][r][j];
            float wv[4][8];
#pragma unroll
            for (int tp = 0; tp < 4; ++tp) { const f32x4 a = *(const f32x4*)(p.conv_w + (size_t)tp * 3072 + chan), c = *(const f32x4*)(p.conv_w + (size_t)tp * 3072 + chan + 4);
#pragma unroll
                for (int j = 0; j < 4; ++j) { wv[tp][j] = a[j]; wv[tp][4 + j] = c[j]; } }
            h16* dst = (ti == 0) ? Qn : (ti == 1 ? Kn : Vh);
#pragma unroll
            for (int r = 0; r < 4; ++r) {
                float y[8]; float ss = 0.f;
#pragma unroll
                for (int j = 0; j < 8; ++j) { float a = wv[0][j] * xr[r][j] + wv[1][j] * xr[r + 1][j] + wv[2][j] * xr[r + 2][j] + wv[3][j] * xr[r + 3][j]; a = silu_f(a); y[j] = a; ss += a * a; }
                float sc = 1.f;
                if (ti < 2) { ss += __shfl_xor(ss, 1); ss += __shfl_xor(ss, 2); ss += __shfl_xor(ss, 4); ss += __shfl_xor(ss, 8); sc = (ti == 0 ? 0.08838834764831845f : 1.0f) * __builtin_amdgcn_rsqf(ss + EPS); }
                h16x8 o;
#pragma unroll
                for (int j = 0; j < 8; ++j) o[j] = (h16)(y[j] * sc);
                *(h16x8*)(dst + (4 * rg + r) * 136 + 8 * cg) = o;
            }
        }
    }
    if (tl < 64) {
        const float* gb = (const float*)(p.ws + OFF_GB) + ((size_t)b * NT + t0 + tl) * 16;
        const float g = gb[h], be = gb[8 + h];
        float gc = g;
#pragma unroll
        for (int o = 1; o < 64; o <<= 1) { const float tt = __shfl_up(gc, o); if (lane >= o) gc += tt; }
        const float gl = __shfl(gc, 63);
        vec[tl] = g; vec[64 + tl] = be; vec[128 + tl] = gc; vec[192 + tl] = __expf(gc);
        float* rv = (float*)(rec + REC_VEC);
        rv[tl] = __expf(gc); rv[64 + tl] = __expf(gl - gc); if (tl == 0) rv[128] = __expf(gl);
    }
    __syncthreads();
    {
        const int rt = w4, fr = lane & 15, kg = lane >> 4;
        h16x8 Ak[4], Aq[4];
#pragma unroll
        for (int s = 0; s < 4; ++s) { Ak[s] = *(const h16x8*)(Kn + (16 * rt + fr) * 136 + 32 * s + 8 * kg); Aq[s] = *(const h16x8*)(Qn + (16 * rt + fr) * 136 + 32 * s + 8 * kg); }
        h16* AF = (h16*)(rec + REC_AF);
#pragma unroll
        for (int ct = 0; ct < 4; ++ct) {
            f32x4 kk = (f32x4){0.f, 0.f, 0.f, 0.f}, qk = (f32x4){0.f, 0.f, 0.f, 0.f};
#pragma unroll
            for (int s = 0; s < 4; ++s) { const h16x8 Bk = *(const h16x8*)(Kn + (16 * ct + fr) * 136 + 32 * s + 8 * kg);
                kk = __builtin_amdgcn_mfma_f32_16x16x32_f16(Ak[s], Bk, kk, 0, 0, 0); qk = __builtin_amdgcn_mfma_f32_16x16x32_f16(Aq[s], Bk, qk, 0, 0, 0); }
            const int j = 16 * ct + fr; const float gcj = vec[128 + j];
#pragma unroll
            for (int rgi = 0; rgi < 4; ++rgi) {
                const int i = 16 * rt + 4 * kg + rgi;
                const float dec = (i >= j) ? __expf(vec[128 + i] - gcj) : 0.f;
                L[i * 64 + j] = (i > j) ? vec[64 + i] * kk[rgi] * dec : 0.f;
                const int sp = ct >> 1, kgp = fr >> 2, j8 = (ct & 1) * 4 + (fr & 3), lanep = 16 * kgp + 4 * kg + rgi;
                AF[((rt * 2 + sp) * 64 + lanep) * 8 + j8] = (h16)(qk[rgi] * dec);
            }
        }
    }
    __syncthreads();
    h16* Tw = (h16*)L; h16* Tu = Tw + 4096;
    if (w4 == 0) {
        float X[64];
#pragma unroll
        for (int i = 0; i < 64; ++i) X[i] = 0.f;
        f32x4 Ln[16]; float rn = (lane == 0) ? 1.f : 0.f;
#pragma unroll
        for (int i = 0; i < 64; ++i) {
            f32x4 Lc[16]; const float rc = rn;
#pragma unroll
            for (int jj = 0; jj < (i + 3) / 4; ++jj) Lc[jj] = Ln[jj];
            if (i + 1 < 64) {
#pragma unroll
                for (int jj = 0; jj < (i + 4) / 4; ++jj) Ln[jj] = *(const f32x4*)(L + (i + 1) * 64 + 4 * jj);
                rn = (lane == i + 1) ? 1.f : 0.f;
            }
            float a0 = rc, a1 = 0.f, a2 = 0.f, a3 = 0.f;
#pragma unroll
            for (int jj = 0; jj < (i + 3) / 4; ++jj) { a0 -= Lc[jj][0] * X[4 * jj]; a1 -= Lc[jj][1] * X[4 * jj + 1]; a2 -= Lc[jj][2] * X[4 * jj + 2]; a3 -= Lc[jj][3] * X[4 * jj + 3]; }
            float acc = (a0 + a1) + (a2 + a3);
            asm volatile("" : "+v"(acc) :: "memory");
            X[i] = acc;
        }
        const float bu = vec[64 + lane], bw = bu * vec[192 + lane];
#pragma unroll
        for (int i = 0; i < 64; ++i) { const int pos = i * 64 + ((((lane >> 3) ^ (i & 7)) << 3) | (lane & 7)); Tw[pos] = (h16)(X[i] * bw); Tu[pos] = (h16)(X[i] * bu); }
    } else {
        const int t3 = tl - 64;
        h16* QF = (h16*)(rec + REC_QF);
        for (int f = t3; f < 1024; f += 192) { const int lanep = f & 63, s = (f >> 6) & 3, rt = f >> 8; const int row = 16 * rt + (lanep & 15), kgp = lanep >> 4;
            const h16x4 a = *(const h16x4*)(Qn + row * 136 + 32 * s + 4 * kgp), c = *(const h16x4*)(Qn + row * 136 + 32 * s + 16 + 4 * kgp);
            h16x8 o; o[0] = a[0]; o[1] = a[1]; o[2] = a[2]; o[3] = a[3]; o[4] = c[0]; o[5] = c[1]; o[6] = c[2]; o[7] = c[3];
            *(h16x8*)(QF + (size_t)f * 8) = o; }
        h16* KTF = (h16*)(rec + REC_KTF);
        for (int f = t3; f < 1024; f += 192) { const int lanep = f & 63, sp = (f >> 6) & 1, rt = f >> 7; const int d = 16 * rt + (lanep & 15), kgp = lanep >> 4;
            h16x8 o;
#pragma unroll
            for (int j8 = 0; j8 < 8; ++j8) { const int c = 32 * sp + (j8 < 4 ? 4 * kgp + j8 : 16 + 4 * kgp + (j8 - 4)); o[j8] = Kn[c * 136 + d]; }
            *(h16x8*)(KTF + (size_t)f * 8) = o; }
    }
    __syncthreads();
    {
        const int rt = w4, fr = lane & 15, kg = lane >> 4, q4 = fr >> 2, pp = fr & 3;
        const LAS unsigned char* Knl = (const LAS unsigned char*)Kn; const LAS unsigned char* Vl = (const LAS unsigned char*)Vh;
        const int trow = 16 * rt + fr;
        h16x8 Tuf[2], Twf[2];
#pragma unroll
        for (int s = 0; s < 2; ++s) { const int off = trow * 64 + ((((4 * s + kg) ^ (trow & 7))) << 3); Tuf[s] = *(const h16x8*)(Tu + off); Twf[s] = *(const h16x8*)(Tw + off); }
        h16* UF = (h16*)(rec + REC_UF);
#pragma unroll
        for (int dvb = 0; dvb < 8; ++dvb) {
            f32x4 acc = (f32x4){0.f, 0.f, 0.f, 0.f};
#pragma unroll
            for (int s = 0; s < 2; ++s) { const LAS unsigned char* a0 = Vl + ((32 * s + 8 * kg + q4) * 136 + 16 * dvb + 4 * pp) * 2;
                const h16x4 lo = lds_tr16(a0), hi4 = lds_tr16(a0 + 4 * 136 * 2);
                h16x8 Bv; Bv[0] = lo[0]; Bv[1] = lo[1]; Bv[2] = lo[2]; Bv[3] = lo[3]; Bv[4] = hi4[0]; Bv[5] = hi4[1]; Bv[6] = hi4[2]; Bv[7] = hi4[3];
                acc = __builtin_amdgcn_mfma_f32_16x16x32_f16(Tuf[s], Bv, acc, 0, 0, 0); }
            h16x4 o; o[0] = (h16)acc[0]; o[1] = (h16)acc[1]; o[2] = (h16)acc[2]; o[3] = (h16)acc[3];
            *(h16x4*)(UF + (size_t)((dvb * 4 + rt) * 64 + lane) * 4) = o;
        }
        h16* WF = (h16*)(rec + REC_WF);
#pragma unroll
        for (int so = 0; so < 4; ++so) {
            f32x4 c0 = (f32x4){0.f, 0.f, 0.f, 0.f}, c1 = (f32x4){0.f, 0.f, 0.f, 0.f};
#pragma unroll
            for (int s = 0; s < 2; ++s) {
                const LAS unsigned char* a0 = Knl + ((32 * s + 8 * kg + q4) * 136 + 16 * (2 * so) + 4 * pp) * 2;
                const h16x4 l0 = lds_tr16(a0), h0 = lds_tr16(a0 + 4 * 136 * 2), l1 = lds_tr16(a0 + 32), h1 = lds_tr16(a0 + 32 + 4 * 136 * 2);
                h16x8 A0, A1; A0[0] = l0[0]; A0[1] = l0[1]; A0[2] = l0[2]; A0[3] = l0[3]; A0[4] = h0[0]; A0[5] = h0[1]; A0[6] = h0[2]; A0[7] = h0[3];
                A1[0] = l1[0]; A1[1] = l1[1]; A1[2] = l1[2]; A1[3] = l1[3]; A1[4] = h1[0]; A1[5] = h1[1]; A1[6] = h1[2]; A1[7] = h1[3];
                c0 = __builtin_amdgcn_mfma_f32_16x16x32_f16(A0, Twf[s], c0, 0, 0, 0); c1 = __builtin_amdgcn_mfma_f32_16x16x32_f16(A1, Twf[s], c1, 0, 0, 0);
            }
            *(h16x8*)(WF + (size_t)((rt * 4 + so) * 64 + lane) * 8) = pack8(-c0, -c1);
        }
    }
}

__device__ __forceinline__ void gdn_scan_task(const Params& p, unsigned char* smem, int bh) {
    const int tid = opaque_tid(), wid = __builtin_amdgcn_readfirstlane(tid >> 6), lane = tid & 63, kg = lane >> 4, fr = lane & 15;
    const int b = bh >> 3, h = bh & 7;
    LAS unsigned char* lds = (LAS unsigned char*)smem;
    const unsigned char* rec0 = p.ws + OFF_REC + (size_t)(bh * 64) * REC_BYTES;
    h16* OB = (h16*)(smem + 2 * REC_DMA);
    const h16* gz = (const h16*)(p.ws + OFF_GZ); h16* omix = (h16*)(p.ws + OFF_OMIX);
    f32x4 Sacc[8];
#pragma unroll
    for (int t = 0; t < 8; ++t) Sacc[t] = (f32x4){0.f, 0.f, 0.f, 0.f};
    h16x4 Uc[4], Un[4];
    __syncthreads();
#define GDN_GLDS(recp, bufi) do { _Pragma("unroll") for (int _i = 0; _i < 7; ++_i) \
        __builtin_amdgcn_global_load_lds((const unsigned*)((recp) + (size_t)(_i * 512 + tid) * 16), (LAS unsigned*)(lds + (bufi) * REC_DMA + (_i * 512 + wid * 64) * 16), 16, 0, 0); \
        if (wid == 0) __builtin_amdgcn_global_load_lds((const unsigned*)((recp) + (size_t)(7 * 512 + tid) * 16), (LAS unsigned*)(lds + (bufi) * REC_DMA + (7 * 512) * 16), 16, 0, 0); } while (0)
#define GDN_LDREG(recp, U_) do { _Pragma("unroll") for (int rt = 0; rt < 4; ++rt) U_[rt] = *(const h16x4*)((recp) + REC_UF + (size_t)((wid * 4 + rt) * 64 + lane) * 8); } while (0)
#define GDN_LDGZ(dst, chunk) do { const h16* gp_ = gz + ((size_t)b * NT + 64 * (chunk) + prow) * 1024 + h * 128 + 16 * pseg; dst[0] = *(const h16x8*)gp_; dst[1] = *(const h16x8*)(gp_ + 8); } while (0)
#define GDN_POST(chunk, gzv) do { const h16* Ob = OB + ((chunk) & 1) * 8192 + prow * 128 + 16 * pseg; const h16x8 a0 = *(const h16x8*)Ob, a1 = *(const h16x8*)(Ob + 8); \
        float ngv[16]; _Pragma("unroll") for (int j = 0; j < 4; ++j) { const f32x4 t4 = *(const f32x4*)(ngl + 16 * pseg + 4 * j); ngv[4 * j] = t4[0]; ngv[4 * j + 1] = t4[1]; ngv[4 * j + 2] = t4[2]; ngv[4 * j + 3] = t4[3]; } \
        float ss = 0.f; _Pragma("unroll") for (int j = 0; j < 8; ++j) { const float u0 = (float)a0[j], u1 = (float)a1[j]; ss += u0 * u0 + u1 * u1; } \
        ss += __shfl_xor(ss, 1); ss += __shfl_xor(ss, 2); ss += __shfl_xor(ss, 4); const float r = __builtin_amdgcn_rsqf(ss * (1.0f / 128.0f) + EPS); \
        h16x8 o0, o1; _Pragma("unroll") for (int j = 0; j < 8; ++j) { o0[j] = (h16)((float)a0[j] * r * ngv[j] * (float)gzv[0][j]); o1[j] = (h16)((float)a1[j] * r * ngv[8 + j] * (float)gzv[1][j]); } \
        h16* op_ = omix + ((size_t)b * NT + 64 * (chunk) + prow) * 2048 + h * 128 + 16 * pseg; *(h16x8*)op_ = o0; *(h16x8*)(op_ + 8) = o1; } while (0)
#define GDN_RD8(X, off0) do { _Pragma("unroll") for (int _j = 0; _j < 8; ++_j) X[_j] = *(const LAS h16x8*)(bufp + (off0) + (_j * 64 + lane) * 16); } while (0)
#define GDN_SB __builtin_amdgcn_sched_barrier(0)
    h16x8 gzp[2], gzn[2];
    const int prow = tid >> 3, pseg = tid & 7;
    float* ngl = (float*)(smem + 2 * REC_DMA + 32768);
    if (tid < 128) ngl[tid] = p.gdn_norm_g[tid];
    GDN_GLDS(rec0, 0);
    GDN_LDREG(rec0, Uc);
    asm volatile("s_waitcnt vmcnt(0)" ::: "memory");
    __syncthreads();
    for (int n = 0; n < 64; ++n) {
        const unsigned char* recn = rec0 + (size_t)(n + 1) * REC_BYTES;
        if (n + 1 < 64) { GDN_GLDS(recn, (n + 1) & 1); GDN_LDREG(recn, Un); }
        GDN_LDGZ(gzn, n);
        if (n > 0) GDN_POST(n - 1, gzp);
        const LAS unsigned char* bufp = lds + (n & 1) * REC_DMA;
        h16x8 X[8], Y[8];
        GDN_RD8(X, REC_WF);
        h16x8 SB[4];
#pragma unroll
        for (int s = 0; s < 4; ++s) SB[s] = pack8(Sacc[2 * s], Sacc[2 * s + 1]);
        f32x4 vacc[4], oacc[4];
#pragma unroll
        for (int rt = 0; rt < 4; ++rt) { vacc[rt] = (f32x4){(float)Uc[rt][0], (float)Uc[rt][1], (float)Uc[rt][2], (float)Uc[rt][3]}; oacc[rt] = (f32x4){0.f, 0.f, 0.f, 0.f}; }
        GDN_SB;
        GDN_RD8(Y, REC_WF + 8192);
#pragma unroll
        for (int j = 0; j < 8; ++j) vacc[j >> 2] = __builtin_amdgcn_mfma_f32_16x16x32_f16(X[j], SB[j & 3], vacc[j >> 2], 0, 0, 0);
        GDN_SB;
        GDN_RD8(X, REC_QF);
#pragma unroll
        for (int j = 0; j < 8; ++j) vacc[2 + (j >> 2)] = __builtin_amdgcn_mfma_f32_16x16x32_f16(Y[j], SB[j & 3], vacc[2 + (j >> 2)], 0, 0, 0);
        GDN_SB;
        GDN_RD8(Y, REC_QF + 8192);
        f32x4 ekv[4], egv[4];
#pragma unroll
        for (int rt = 0; rt < 4; ++rt) { ekv[rt] = *(const LAS f32x4*)(bufp + REC_VEC + 256 + (16 * rt + 4 * kg) * 4); egv[rt] = *(const LAS f32x4*)(bufp + REC_VEC + (16 * rt + 4 * kg) * 4); }
        const float eglc = *(const LAS float*)(bufp + REC_VEC + 512);
#pragma unroll
        for (int j = 0; j < 8; ++j) oacc[j >> 2] = __builtin_amdgcn_mfma_f32_16x16x32_f16(X[j], SB[j & 3], oacc[j >> 2], 0, 0, 0);
        GDN_SB;
        GDN_RD8(X, REC_KTF);
        h16x8 VB[2], VKB[2];
#pragma unroll
        for (int sp = 0; sp < 2; ++sp) { VB[sp] = pack8(vacc[2 * sp], vacc[2 * sp + 1]); VKB[sp] = pack8(vacc[2 * sp] * ekv[2 * sp], vacc[2 * sp + 1] * ekv[2 * sp + 1]); }
#pragma unroll
        for (int j = 0; j < 8; ++j) oacc[2 + (j >> 2)] = __builtin_amdgcn_mfma_f32_16x16x32_f16(Y[j], SB[j & 3], oacc[2 + (j >> 2)], 0, 0, 0);
        GDN_SB;
        GDN_RD8(Y, REC_KTF + 8192);
#pragma unroll
        for (int t = 0; t < 8; ++t) Sacc[t] = Sacc[t] * eglc;
#pragma unroll
        for (int j = 0; j < 8; ++j) Sacc[j >> 1] = __builtin_amdgcn_mfma_f32_16x16x32_f16(X[j], VKB[j & 1], Sacc[j >> 1], 0, 0, 0);
        GDN_SB;
        GDN_RD8(X, REC_AF);
#pragma unroll
        for (int rt = 0; rt < 4; ++rt) oacc[rt] = oacc[rt] * egv[rt];
#pragma unroll
        for (int j = 0; j < 8; ++j) Sacc[4 + (j >> 1)] = __builtin_amdgcn_mfma_f32_16x16x32_f16(Y[j], VKB[j & 1], Sacc[4 + (j >> 1)], 0, 0, 0);
        GDN_SB;
#pragma unroll
        for (int j = 0; j < 8; ++j) oacc[j >> 1] = __builtin_amdgcn_mfma_f32_16x16x32_f16(X[j], VB[j & 1], oacc[j >> 1], 0, 0, 0);
        { h16* Ob = OB + (n & 1) * 8192;
#pragma unroll
          for (int rt = 0; rt < 4; ++rt)
#pragma unroll
              for (int rgi = 0; rgi < 4; ++rgi) Ob[(16 * rt + 4 * kg + rgi) * 128 + 16 * wid + fr] = (h16)oacc[rt][rgi]; }
        asm volatile("s_waitcnt vmcnt(0)" ::: "memory");
        __syncthreads();
#pragma unroll
        for (int rt = 0; rt < 4; ++rt) Uc[rt] = Un[rt];
        gzp[0] = gzn[0]; gzp[1] = gzn[1];
    }
    GDN_POST(63, gzp);
#undef GDN_LDGZ
#undef GDN_POST
#undef GDN_RD8
#undef GDN_SB
#undef GDN_GLDS
#undef GDN_LDREG
}

__device__ __forceinline__ unsigned f2key(float x) { const unsigned u = __float_as_uint(x); return (u & 0x80000000u) ? ~u : (u | 0x80000000u); }
typedef float f32x16 __attribute__((ext_vector_type(16)));
__device__ __forceinline__ float wave_min(float v) {
#pragma unroll
    for (int o = 1; o < 64; o <<= 1) v = fminf(v, __shfl_xor(v, o));
    return v;
}
__device__ __forceinline__ unsigned lane_below(unsigned long long m) { return __builtin_amdgcn_mbcnt_hi((unsigned)(m >> 32), __builtin_amdgcn_mbcnt_lo((unsigned)m, 0u)); }
__device__ __forceinline__ void idx8_task(const Params& p, unsigned char* smem, int b, int qb) {
    const int tid = opaque_tid(), wid = __builtin_amdgcn_readfirstlane(tid >> 6), lane = tid & 63;
    const int t0 = qb * 8;
    unsigned short* selg = (unsigned short*)(p.ws + OFF_SEL) + ((size_t)b * NT + t0) * 256;
    if (t0 + 8 <= 256) {
        for (int i = tid; i < 8 * 256; i += 512) { const int q = i >> 8, k = i & 255; selg[i] = (unsigned short)(k <= t0 + q ? k : 0); }
        return;
    }
    float* sc = (float*)smem;
    ACC_T0();
    unsigned* hist = (unsigned*)(smem + 131072 + wid * 2560);
    unsigned* cand = hist + 256;
    __syncthreads();
    {
        const int n8 = t0 + 8;
        const int ntile = (n8 + 31) >> 5, ntile_pad = ((n8 + 255) >> 8) << 3;
        const h16* iq = (const h16*)(p.ws + OFF_IQ) + ((size_t)b * NT + t0) * 1024;
        const float* iw = (const float*)(p.ws + OFF_IW) + ((size_t)b * NT + t0) * 16;
        const h16* ik = (const h16*)(p.ws + OFF_IK) + (size_t)b * NT * 64;
        const int r = lane & 31, kh = lane >> 5, qq = (r >> 2) & 1, hh = (r & 3) + 4 * (r >> 3);
        h16x8 Af[4][4]; h16x2 Wp[4][8];
#pragma unroll
        for (int a = 0; a < 4; ++a) {
#pragma unroll
            for (int s = 0; s < 4; ++s) Af[a][s] = *(const h16x8*)(iq + (size_t)(2 * a + qq) * 1024 + hh * 64 + 16 * s + 8 * kh);
#pragma unroll
            for (int c = 0; c < 4; ++c) { const f32x4 w4 = *(const f32x4*)(iw + (size_t)(2 * a + kh) * 16 + 4 * c);
                Wp[a][2 * c] = (h16x2){(h16)w4[0], (h16)w4[1]}; Wp[a][2 * c + 1] = (h16x2){(h16)w4[2], (h16)w4[3]}; }
        }
#define IDX_LOADB(Bx, ti) do { const int tc_ = (ti) < ntile ? (ti) : ntile - 1;     \
            _Pragma("unroll") for (int s = 0; s < 4; ++s) Bx[s] = *(const h16x8*)(ik + (size_t)tc_ * 2048 + s * 512 + kh * 256 + r * 8); } while (0)
#define IDX_COMP(Bx, ti) do { if ((ti) < ntile) { const int key = 32 * (ti) + r; f32x16 accs[4]; \
            _Pragma("unroll") for (int a = 0; a < 4; ++a) { _Pragma("unroll") for (int e = 0; e < 16; ++e) accs[a][e] = 0.f; \
                _Pragma("unroll") for (int s = 0; s < 4; ++s) accs[a] = __builtin_amdgcn_mfma_f32_32x32x16_f16(Af[a][s], Bx[s], accs[a], 0, 0, 0); } \
            __builtin_amdgcn_sched_barrier(0); \
            _Pragma("unroll") for (int a = 0; a < 4; ++a) { \
                float s0 = 0.f, s1 = 0.f; _Pragma("unroll") for (int e = 0; e < 8; e += 2) { h16x2 rp = (h16x2){(h16)accs[a][2 * e], (h16)accs[a][2 * e + 1]}; rp = __builtin_elementwise_max(rp, (h16x2){(h16)0.f, (h16)0.f}); s0 = __builtin_amdgcn_fdot2(rp, Wp[a][e], s0, false); \
                    h16x2 rq = (h16x2){(h16)accs[a][2 * e + 2], (h16)accs[a][2 * e + 3]}; rq = __builtin_elementwise_max(rq, (h16x2){(h16)0.f, (h16)0.f}); s1 = __builtin_amdgcn_fdot2(rq, Wp[a][e + 1], s1, false); } \
                const int q = 2 * a + kh; sc[q * 4096 + key] = (key > t0 + q) ? -INFINITY : (s0 + s1); } } } while (0)
        {
            h16x8 B0[4], B1[4], B2[4];
            IDX_LOADB(B0, wid); IDX_LOADB(B1, wid + 8);
            for (int i = wid; i < ntile; i += 24) {
                IDX_LOADB(B2, i + 16); IDX_COMP(B0, i);
                IDX_LOADB(B0, i + 24); IDX_COMP(B1, i + 8);
                IDX_LOADB(B1, i + 32); IDX_COMP(B2, i + 16);
            }
            for (int i = ntile + wid; i < ntile_pad; i += 8) {
#pragma unroll
                for (int a = 0; a < 4; ++a) sc[(2 * a + kh) * 4096 + 32 * i + r] = -INFINITY;
            }
        }
#undef IDX_LOADB
#undef IDX_COMP
    }
    __syncthreads();
    ACC_ADD(1);
    {
        const int tq = t0 + wid, n = tq + 1;
        const float* row = sc + wid * 4096;
        const int ng = (n + 255) >> 8;
        f32x4 x[16];
#pragma unroll
        for (int g = 0; g < 16; ++g) { if (g < ng) x[g] = *(const f32x4*)(row + 256 * g + 4 * lane); else x[g] = (f32x4){-INFINITY, -INFINITY, -INFINITY, -INFINITY}; }
        float hi = -INFINITY, lo = INFINITY;
#pragma unroll
        for (int g = 0; g < 16; ++g)
#pragma unroll
            for (int c = 0; c < 4; ++c) { const float v = x[g][c]; hi = fmaxf(hi, v); lo = fminf(lo, v == -INFINITY ? INFINITY : v); }
        hi = wave_max(hi); lo = wave_min(lo);
        const float scale = (hi > lo) ? 255.99f / (hi - lo) : 0.f; const float off = -lo * scale;
        *(u32x4*)(hist + 4 * lane) = (u32x4){0u, 0u, 0u, 0u};
#pragma unroll
        for (int g = 0; g < 16; ++g) { if (g < ng) {
#pragma unroll
            for (int c = 0; c < 4; ++c) { int bin = (int)fmaf(x[g][c], scale, off); bin = bin < 0 ? 0 : (bin > 255 ? 255 : bin); atomicAdd(&hist[bin], 1u); } } }
        unsigned bstar, need;
        {
            const u32x4 h4 = *(const u32x4*)(hist + 4 * lane); const unsigned s = h4[0] + h4[1] + h4[2] + h4[3];
            unsigned suf = s;
#pragma unroll
            for (int o = 1; o < 64; o <<= 1) { const unsigned tt = __shfl_down(suf, o); if (lane + o < 64) suf += tt; }
            const unsigned above = suf - s;
            const bool mine = (above < 256u && 256u <= suf);
            unsigned cum = above; unsigned bin = 0;
            if (cum + h4[3] >= 256u) bin = 3; else { cum += h4[3]; if (cum + h4[2] >= 256u) bin = 2; else { cum += h4[2]; if (cum + h4[1] >= 256u) bin = 1; else { cum += h4[1]; bin = 0; } } }
            const unsigned long long mm = __ballot(mine);
            const int src = (int)__builtin_ctzll(mm);
            bstar = (unsigned)__shfl((int)(4 * lane + bin), src); need = (unsigned)__shfl((int)(256u - cum), src);
        }
        unsigned short* so = selg + (size_t)wid * 256;
        unsigned short* cidx = (unsigned short*)(cand + 256);
        unsigned m = 0, outb = 0;
#pragma unroll
        for (int g = 0; g < 16; ++g) { if (g < ng) {
#pragma unroll
            for (int c = 0; c < 4; ++c) { int bin = (int)fmaf(x[g][c], scale, off); bin = bin < 0 ? 0 : (bin > 255 ? 255 : bin);
                const bool gt = ((unsigned)bin > bstar), pr = ((unsigned)bin == bstar);
                const unsigned long long mg = __ballot(gt), mk = __ballot(pr);
                if (mg) { const unsigned pos = outb + lane_below(mg); if (gt) so[pos] = (unsigned short)(256 * g + 4 * lane + c); outb += (unsigned)__builtin_popcountll(mg); }
                if (mk) { const unsigned pos = m + lane_below(mk); if (pr && pos < 256u) { cand[pos] = f2key(x[g][c]); cidx[pos] = (unsigned short)(256 * g + 4 * lane + c); } m += (unsigned)__builtin_popcountll(mk); } } } }
        unsigned Kt = 0, rr = need;
        if (m <= 256u) {
            const int nc = (int)((m + 63u) >> 6);
            unsigned cv[4]; unsigned short ci[4];
#pragma unroll
            for (int j = 0; j < 4; ++j) { const bool in = (64 * j + lane < (int)m); cv[j] = in ? cand[64 * j + lane] : 0u; ci[j] = in ? cidx[64 * j + lane] : (unsigned short)0; }
            for (int bit = 31; bit >= 0; --bit) {
                const unsigned test = (Kt | (1u << bit)) >> bit;
                unsigned cnt = (unsigned)__builtin_popcountll(__ballot((cv[0] >> bit) == test));
                if (nc > 1) cnt += (unsigned)__builtin_popcountll(__ballot((cv[1] >> bit) == test));
                if (nc > 2) cnt += (unsigned)__builtin_popcountll(__ballot((cv[2] >> bit) == test));
                if (nc > 3) cnt += (unsigned)__builtin_popcountll(__ballot((cv[3] >> bit) == test));
                if (cnt >= rr) Kt |= (1u << bit); else rr -= cnt;
            }
            unsigned eqb = 0;
#pragma unroll
            for (int j = 0; j < 4; ++j) { if (j < nc) { const bool in = (64 * j + lane < (int)m); const bool gt = in && cv[j] > Kt, eq = in && cv[j] == Kt;
                const unsigned long long me = __ballot(eq); bool take = gt;
                if (me) { const unsigned er = eqb + lane_below(me); take = gt || (eq && er < rr); eqb += (unsigned)__builtin_popcountll(me); }
                const unsigned long long mt = __ballot(take);
                if (mt) { const unsigned pos = outb + lane_below(mt); if (take) so[pos] = ci[j]; outb += (unsigned)__builtin_popcountll(mt); } } }
        } else {
            for (int bit = 31; bit >= 0; --bit) {
                const unsigned test = (Kt | (1u << bit)) >> bit; unsigned cnt = 0;
                for (int idx = lane; idx < ng * 256; idx += 64) { const float v = row[idx]; int bin = (int)fmaf(v, scale, off); bin = bin < 0 ? 0 : (bin > 255 ? 255 : bin);
                    const bool pr = ((unsigned)bin == bstar) && ((f2key(v) >> bit) == test); cnt += (unsigned)__builtin_popcountll(__ballot(pr)); }
                if (cnt >= rr) Kt |= (1u << bit); else rr -= cnt;
            }
            unsigned eqb = 0;
            for (int idx = lane; idx < ng * 256; idx += 64) { const float v = row[idx]; int bin = (int)fmaf(v, scale, off); bin = bin < 0 ? 0 : (bin > 255 ? 255 : bin);
                const unsigned k = f2key(v); const bool inb = ((unsigned)bin == bstar); const bool gt = inb && k > Kt, eq = inb && k == Kt;
                const unsigned long long me = __ballot(eq); bool take = gt;
                if (me) { const unsigned er = eqb + lane_below(me); take = gt || (eq && er < rr); eqb += (unsigned)__builtin_popcountll(me); }
                const unsigned long long mt = __ballot(take);
                if (mt) { const unsigned pos = outb + lane_below(mt); if (take) so[pos] = (unsigned short)idx; outb += (unsigned)__builtin_popcountll(mt); } }
        }
    }
    __syncthreads();
    ACC_ADD(2);
}

typedef unsigned short u16x4 __attribute__((ext_vector_type(4)));
typedef unsigned short u16x8 __attribute__((ext_vector_type(8)));
__device__ __forceinline__ void attn8_task(const Params& p, unsigned char* smem, int part, int o) {
    const int tid = opaque_tid(), wid = __builtin_amdgcn_readfirstlane(tid >> 6), lane = tid & 63, kg = lane >> 4, fr = lane & 15;
    const int b = part >> 1, g = part & 1;
    unsigned char* vl = smem + wid * 17408;
    LAS unsigned char* vll = (LAS unsigned char*)vl;
    const char* akb = (const char*)(p.ws + OFF_AK) + (size_t)b * NT * 256 + g * 128;
    const char* avb = (const char*)(p.ws + OFF_AV) + (size_t)b * NT * 256 + g * 128;
    typedef long i64x2 __attribute__((ext_vector_type(2)));
    constexpr int NQW = 1;
    const int tq0 = 8 * NQW * o + NQW * wid;
    u16x4 kix[4], kixn[4];
#define AT_LOADI(tt, KI) do { const unsigned short* sel_ = (const unsigned short*)(p.ws + OFF_SEL) + ((size_t)b * NT + (tt)) * 256; \
        _Pragma("unroll") for (int c = 0; c < 4; ++c) KI[c] = *(const u16x4*)(sel_ + 64 * c + 4 * fr); } while (0)
    AT_LOADI(tq0, kix);
#pragma unroll 1
    for (int qi = 0; qi < NQW; ++qi) {
    const int t = tq0 + qi; const int bt = b * NT + t; const int nvalid = (t + 1) < 256 ? (t + 1) : 256;
    const unsigned short* sel = (const unsigned short*)(p.ws + OFF_SEL) + (size_t)bt * 256;
    long Qf[4];
    { const char* qp_ = (const char*)(p.ws + OFF_AQ) + (size_t)bt * 1024 + (4 * g + (fr & 3)) * 128 + kg * 32; const i64x2 q0 = *(const i64x2*)qp_, q1 = *(const i64x2*)(qp_ + 16);
      Qf[0] = fr < 4 ? q0[0] : 0l; Qf[1] = fr < 4 ? q0[1] : 0l; Qf[2] = fr < 4 ? q1[0] : 0l; Qf[3] = fr < 4 ? q1[1] : 0l; }
    f32x4 lg[16];
    unsigned char* kl = vl + 8192; LAS unsigned char* kll = (LAS unsigned char*)kl;
    u16x8 IX[4];
#pragma unroll
    for (int c = 0; c < 4; ++c) IX[c] = *(const u16x8*)(sel + 64 * c + 8 * (lane >> 3));
#define AT_GATHER(Rx, base, c) do { _Pragma("unroll") for (int it = 0; it < 8; ++it) Rx[it] = *(const u32x4*)((base) + (unsigned)IX[c][it] * 256u + 16u * (unsigned)(lane & 7)); } while (0)
#define AT_STOREK(KRx) do { _Pragma("unroll") for (int it = 0; it < 8; ++it) { const int r = 8 * (lane >> 3) + it; const int fk = (r >> 2) & 7; \
        *(u32x4*)(kl + r * 128 + (((lane & 7) ^ fk) << 4)) = KRx[it]; } } while (0)
#define AT_READK(Kx) do { _Pragma("unroll") for (int ii = 0; ii < 4; ++ii) { const int r = 4 * fr + ii; const int fk = fr & 7; \
        const i64x2 t0 = *(const LAS i64x2*)(kll + r * 128 + (((2 * kg) ^ fk) << 4)), t1 = *(const LAS i64x2*)(kll + r * 128 + (((2 * kg + 1) ^ fk) << 4)); \
        Kx[ii][0] = t0[0]; Kx[ii][1] = t0[1]; Kx[ii][2] = t1[0]; Kx[ii][3] = t1[1]; } } while (0)
#define AT_MMAK(Kx, c) do { _Pragma("unroll") for (int ii = 0; ii < 4; ++ii) { f32x4 a = (f32x4){0.f, 0.f, 0.f, 0.f}; \
        _Pragma("unroll") for (int s = 0; s < 4; ++s) a = __builtin_amdgcn_mfma_f32_16x16x32_fp8_fp8(Kx[ii][s], Qf[s], a, 0, 0, 0); lg[4 * (c) + ii] = a; } } while (0)
    u32x4 R0[8], R1[8], R2[8];
    {
        long Kf[4][4];
        AT_GATHER(R0, akb, 0); AT_GATHER(R1, akb, 1); AT_GATHER(R2, akb, 2);
        AT_STOREK(R0); AT_READK(Kf); AT_GATHER(R0, akb, 3); AT_MMAK(Kf, 0);
        AT_STOREK(R1); AT_READK(Kf); AT_GATHER(R1, avb, 0); AT_MMAK(Kf, 1);
        AT_STOREK(R2); AT_READK(Kf); AT_GATHER(R2, avb, 1); AT_MMAK(Kf, 2);
        AT_STOREK(R0); AT_READK(Kf); AT_GATHER(R0, avb, 2); AT_MMAK(Kf, 3);
    }
#define DPP_F(oldv, srcv, ctrl, bank) __builtin_bit_cast(float, __builtin_amdgcn_update_dpp(__builtin_bit_cast(int, (float)(oldv)), __builtin_bit_cast(int, (float)(srcv)), (ctrl), 0xF, (bank), false))
    float val[4][4];
#pragma unroll
    for (int ii = 0; ii < 4; ++ii)
#pragma unroll
        for (int r = 0; r < 4; ++r) { float v = lg[ii][r];
            v = DPP_F(v, lg[4 + ii][r], 0x114, 0x2); v = DPP_F(v, lg[8 + ii][r], 0x118, 0x4); v = DPP_F(v, lg[12 + ii][r], 0x11C, 0x8); val[ii][r] = v; }
    const int cj = fr >> 2;
    float m = -INFINITY;
#pragma unroll
    for (int ii = 0; ii < 4; ++ii)
#pragma unroll
        for (int r = 0; r < 4; ++r) { const int slot = 64 * cj + 16 * kg + 4 * r + ii; const float v = (slot < nvalid) ? val[ii][r] * (0.08838834764831845f * 1.4426950408889634f) : -INFINITY; val[ii][r] = v; m = fmaxf(m, v); }
    m = fmaxf(m, __shfl_xor(m, 4)); m = fmaxf(m, __shfl_xor(m, 8)); m = fmaxf(m, __shfl_xor(m, 16)); m = fmaxf(m, __shfl_xor(m, 32));
    float sum = 0.f;
#pragma unroll
    for (int ii = 0; ii < 4; ++ii)
#pragma unroll
        for (int r = 0; r < 4; ++r) { const float e = __builtin_amdgcn_exp2f(val[ii][r] - m); val[ii][r] = e; sum += e; }
    sum += __shfl_xor(sum, 4); sum += __shfl_xor(sum, 8); sum += __shfl_xor(sum, 16); sum += __shfl_xor(sum, 32);
    const float pscale = __builtin_amdgcn_rcpf(sum) * 256.0f;
    int pl[2][2];
#pragma unroll
    for (int ipl = 0; ipl < 2; ++ipl) { int w0 = 0, w1 = 0;
        w0 = __builtin_amdgcn_cvt_pk_fp8_f32(val[2 * ipl][0] * pscale, val[2 * ipl][1] * pscale, w0, false); w0 = __builtin_amdgcn_cvt_pk_fp8_f32(val[2 * ipl][2] * pscale, val[2 * ipl][3] * pscale, w0, true);
        w1 = __builtin_amdgcn_cvt_pk_fp8_f32(val[2 * ipl + 1][0] * pscale, val[2 * ipl + 1][1] * pscale, w1, false); w1 = __builtin_amdgcn_cvt_pk_fp8_f32(val[2 * ipl + 1][2] * pscale, val[2 * ipl + 1][3] * pscale, w1, true);
        pl[ipl][0] = w0; pl[ipl][1] = w1; }
    long Pf[8];
#pragma unroll
    for (int ipl = 0; ipl < 2; ++ipl) {
        Pf[ipl] = (long)(((unsigned long long)(unsigned)pl[ipl][1] << 32) | (unsigned long long)(unsigned)pl[ipl][0]);
#define PF_GATHER(c, ctrl) do { const int lo_ = __builtin_amdgcn_update_dpp(0, pl[ipl][0], ctrl, 0xF, 0x1, false), hi_ = __builtin_amdgcn_update_dpp(0, pl[ipl][1], ctrl, 0xF, 0x1, false); \
            Pf[2 * (c) + ipl] = (long)(((unsigned long long)(unsigned)hi_ << 32) | (unsigned long long)(unsigned)lo_); } while (0)
        PF_GATHER(1, 0x104); PF_GATHER(2, 0x108); PF_GATHER(3, 0x10C);
#undef PF_GATHER
    }
#undef DPP_F
    f32x4 O[8];
#pragma unroll
    for (int ct = 0; ct < 8; ++ct) O[ct] = (f32x4){0.f, 0.f, 0.f, 0.f};
    if (qi < NQW - 1) AT_LOADI(t + 1, kixn);
    const h16x8 gate = *(const h16x8*)((const h16*)(p.ws + OFF_AZ) + (size_t)bt * 1024 + (4 * g) * 128 + 8 * lane);
    const int q4 = fr >> 2, pp = fr & 3;
    typedef int v2i_t __attribute__((__vector_size__(2 * sizeof(int))));
#define AT_STOREV(Vx) do { _Pragma("unroll") for (int it = 0; it < 8; ++it) { const int r = 8 * (lane >> 3) + it; const int fk = ((r >> 2) & 3) | (((r >> 4) & 1) << 2); \
        *(u32x4*)(vl + r * 128 + (((lane & 7) ^ fk) << 4)) = Vx[it]; } } while (0)
#define AT_PV(c) do { _Pragma("unroll") for (int ipl = 0; ipl < 2; ++ipl) { const int qq = fr >> 1; const int r = 16 * kg + 4 * (qq & 3) + 2 * ipl + (qq >> 2); const int fk = ((r >> 2) & 3) | (((r >> 4) & 1) << 2); \
        _Pragma("unroll") for (int ct = 0; ct < 8; ++ct) { const LAS unsigned char* a0 = vll + r * 128 + ((ct ^ fk) << 4) + (fr & 1) * 8; \
            const v2i_t bv = __builtin_amdgcn_ds_read_tr8_b64_v2i32((LAS v2i_t*)a0); \
            O[ct] = __builtin_amdgcn_mfma_f32_16x16x32_fp8_fp8(Pf[2 * (c) + ipl], __builtin_bit_cast(long, bv), O[ct], 0, 0, 0); } } } while (0)
    AT_STOREV(R1); AT_GATHER(R1, avb, 3); AT_PV(0);
    AT_STOREV(R2); AT_PV(1);
    AT_STOREV(R0); AT_PV(2);
    AT_STOREV(R1); AT_PV(3);
#undef AT_GATHER
#undef AT_STOREK
#undef AT_READK
#undef AT_MMAK
#undef AT_STOREV
#undef AT_PV
    h16* ot = (h16*)vl;
    if (kg == 0) {
#pragma unroll
        for (int ct = 0; ct < 8; ++ct)
#pragma unroll
            for (int r = 0; r < 4; ++r) ot[r * 128 + 16 * ct + fr] = (h16)O[ct][r];
    }
    {
        const h16x8 ov = *(const h16x8*)(ot + 8 * lane);
        h16x8 res;
#pragma unroll
        for (int j = 0; j < 8; ++j) res[j] = (h16)((float)ov[j] * (float)gate[j] * (1.0f / 256.0f));
        *(h16x8*)((h16*)(p.ws + OFF_OMIX) + (size_t)bt * 2048 + 1024 + (4 * g) * 128 + 8 * lane) = res;
    }
#pragma unroll
    for (int c = 0; c < 4; ++c) kix[c] = kixn[c];
    }
#undef AT_LOADI
}

__device__ __forceinline__ void phase5(const Params& p) {
    const int tid = opaque_tid(), wid = tid >> 6, lane = tid & 63;
    const int gw = blockIdx.x * 8 + wid, nw = gridDim.x * 8;
    const float* rowss = (const float*)(p.ws + OFF_ROWSS);
    for (int row = gw; row < BT; row += nw) {
        const float r = 1.0f / sqrtf(rowss[row] * (1.0f / DM) + EPS);
        f32x4* o = (f32x4*)(p.out + (size_t)row * DM);
        float eadd = 0.f;
        if ((TS_A >= 0 || TS_ACC >= 0) && row < 164) { const unsigned* ts = (const unsigned*)(p.ws + OFF_CTRL + 8192); const float tus = (TS_ACC >= 0) ? (float)ts[16 + (TS_ACC >= 0 ? TS_ACC : 0)] * (0.01f / 256.0f) : (float)(ts[TS_B >= 0 ? TS_B : 0] - ts[TS_A >= 0 ? TS_A : 0]) * 0.01f; eadd = sqrtf(tus * 1e-5f); }
#pragma unroll
        for (int i = 0; i < 8; ++i) { const f32x4 g = ((const f32x4*)p.final_g)[lane + 64 * i]; f32x4 v = o[lane + 64 * i]; v = v * r * g + eadd; o[lane + 64 * i] = v; }
    }
}

#define XB_TMO      128
#define XB_XCNT(j)  (256  + 64 * (j))
#define XB_XSUB(j)  (1280 + 64 * (j))
#define XB_XGEN(j)  (2304 + 64 * (j))
#define XB_TOP      3328
#define XB_TOPGEN   3392
#define XCD_BAR_WORDS 3456
#define XB_SPIN_CAP (1u << 18)

__device__ __forceinline__ unsigned xb_ld(unsigned* p)              { return __hip_atomic_load(p, __ATOMIC_RELAXED, __HIP_MEMORY_SCOPE_AGENT); }
__device__ __forceinline__ unsigned xb_add(unsigned* p, unsigned v) { return __hip_atomic_fetch_add(p, v, __ATOMIC_RELAXED, __HIP_MEMORY_SCOPE_AGENT); }
__device__ __forceinline__ unsigned xb_xcc_id() { return (unsigned)__builtin_amdgcn_s_getreg((3 << 11) | 20) & 0xFu; }
#define XB_SPIN(cond, bar) do { unsigned _sp = 0; while (cond) { __builtin_amdgcn_s_sleep(1); \
    if ((++_sp & 255u) == 0u) { if (xb_ld(&(bar)[XB_TMO])) break; if (_sp > XB_SPIN_CAP) { atomicAdd(&(bar)[XB_TMO], 1u); break; } } } } while (0)

struct XcdBarrier {
    unsigned* bar; unsigned x;
    volatile LAS unsigned* st;
};

__device__ __forceinline__ XcdBarrier xcd_barrier_post(unsigned* bar, volatile LAS unsigned* st) {
    XcdBarrier b; b.bar = bar; b.x = xb_xcc_id(); b.st = st;
    if (threadIdx.x == 0) (void)xb_add(&bar[XB_XCNT(b.x)], 1u);
    return b;
}
__device__ __forceinline__ void xcd_barrier_complete(unsigned* bar, unsigned x, unsigned& nloc, unsigned& nx) {
    const unsigned G = gridDim.x * gridDim.y * gridDim.z;
    unsigned sum, cnt, mine, sp = 0u;
    for (;;) {
        sum = 0u; cnt = 0u; mine = 0u;
#pragma unroll
        for (unsigned j = 0; j < 16; ++j) { const unsigned c = xb_ld(&bar[XB_XCNT(j)]); sum += c; cnt += (c > 0u) ? 1u : 0u; mine = (j == x) ? c : mine; }
        if (sum == G) break;
        __builtin_amdgcn_s_sleep(1);
        if ((++sp & 255u) == 0u) { if (xb_ld(&bar[XB_TMO])) break; if (sp > XB_SPIN_CAP) { atomicAdd(&bar[XB_TMO], 1u); break; } }
    }
    nloc = mine > 0u ? mine : 1u; nx = cnt > 0u ? cnt : 1u;
}

__device__ __forceinline__ void xcd_barrier(const XcdBarrier& b) {
    asm volatile("s_waitcnt vmcnt(0)" ::: "memory");
    __syncthreads();
    if (threadIdx.x == 0) {
        unsigned* bar = b.bar;
        __builtin_amdgcn_s_waitcnt(0);
        unsigned nloc = b.st[0], nx = b.st[1];
        if (nloc == 0u) { xcd_barrier_complete(bar, b.x, nloc, nx); b.st[0] = nloc; b.st[1] = nx; }
        const unsigned old = xb_add(&bar[XB_XSUB(b.x)], 1u);
        const unsigned gen = old / nloc;
        if (old + 1u == (gen + 1u) * nloc) {
            __builtin_amdgcn_fence(__ATOMIC_RELEASE, "agent");
            asm volatile("s_waitcnt vmcnt(0)" ::: "memory");
            const unsigned og = xb_add(&bar[XB_TOP], 1u);
            const unsigned tg = og / nx;
            if (og + 1u == (tg + 1u) * nx) xb_add(&bar[XB_TOPGEN], 1u);
            else XB_SPIN(xb_ld(&bar[XB_TOPGEN]) == tg, bar);
            __builtin_amdgcn_fence(__ATOMIC_ACQUIRE, "agent");
            xb_add(&bar[XB_XGEN(b.x)], 1u);
            asm volatile("s_waitcnt vmcnt(0)" ::: "memory");
        } else {
            XB_SPIN(xb_ld(&bar[XB_XGEN(b.x)]) == gen, bar);
            __builtin_amdgcn_fence(__ATOMIC_ACQUIRE, "agent");
            asm volatile("s_waitcnt vmcnt(0)" ::: "memory");
        }
    }
    __syncthreads();
}


template <int LO, int HI>
__global__ void __launch_bounds__(512, 2) k_phases(Params p) {
    extern __shared__ __attribute__((aligned(16))) unsigned char smem[];
#define IN(k) (LO <= (k) && (k) < HI)
#define SEAM(k) do { if constexpr (IN(k) && IN((k) + 1)) { xcd_barrier(xbar); if (TS_A >= 0 && blockIdx.x == 0 && threadIdx.x == 0) ((unsigned*)(p.ws + OFF_CTRL + 8192))[(k) + 1] = (unsigned)__builtin_amdgcn_s_memrealtime(); } } while (0)
    XcdBarrier xbar; xbar.bar = nullptr; xbar.x = 0; xbar.st = nullptr;
    if constexpr (HI - LO > 1) {
        volatile LAS unsigned* stw = (volatile LAS unsigned*)((LAS unsigned char*)smem + LDS_BYTES - 48);
        if (threadIdx.x < 4) stw[threadIdx.x] = 0u;
        __syncthreads();
        xbar = xcd_barrier_post((unsigned*)(p.ws + OFF_CTRL + 16384), stw);
    }
    if (TS_A >= 0 && blockIdx.x == 0 && threadIdx.x == 0) ((unsigned*)(p.ws + OFF_CTRL + 8192))[0] = (unsigned)__builtin_amdgcn_s_memrealtime();
    if constexpr (IN(0)) { for (int rep = 0; rep < NREP(0); ++rep) phase0(p, smem); }
    SEAM(0);
    if constexpr (IN(1)) for (int rep = 0; rep < NREP(1); ++rep) {
        EpiIn E{p.ws, p.a_log, p.dt_bias, p.pos};
        {
            pg8::Gemm g{(const h16*)(p.ws + OFF_H), (const h16*)(p.ws + OFF_WT), BT, NPAD, DM};
            OrderF16 S; S.init(BT, 21 * 256, gridDim.x, blockIdx.x);
            pg8::gemm_phase<EpiIn, OrderF16>((LAS unsigned char*)smem, g, S, E);
        }
        {
            pg8::Gemm g{(const h16*)(p.ws + OFF_H8), (const h16*)(p.ws + OFF_WT8 - (size_t)16 * 256 * 2048), BT, 2560, DM};
            OrderF8 S; S.G = gridDim.x; S.c = blockIdx.x;
            pg8::gemm_phase<EpiIn, OrderF8, true, true>((LAS unsigned char*)smem, g, S, E);
        }
    }
    SEAM(1);
    if constexpr (IN(2)) for (int rep = 0; rep < NREP(2); ++rep) {
        {
            unsigned* qctr = (unsigned*)(p.ws + OFF_CTRL);
            volatile unsigned* lds_t = (volatile unsigned*)(smem + LDS_BYTES - 16);
            __syncthreads();
            if (threadIdx.x == 0) lds_t[0] = atomicAdd(qctr + 0 + 16 * rep, 1u);
            __syncthreads();
            unsigned o = lds_t[0];
            while (o < 1024u + 2048u) {
                unsigned nxt = 0u;
                if (threadIdx.x == 0) nxt = atomicAdd(qctr + 0 + 16 * rep, 1u);
                if (o < 1024u) { ACC_T0(); gdn_prep_pair(p, smem, (int)o); __syncthreads(); ACC_ADD(0); }
                else { const unsigned o2 = o - 1024u; idx8_task(p, smem, (int)(o2 & 3u), 511 - (int)(o2 >> 2)); }
                __syncthreads();
                if (threadIdx.x == 0) lds_t[0] = nxt;
                __syncthreads();
                o = lds_t[0];
            }
        }
    }
    SEAM(2);
    if constexpr (IN(3)) for (int rep = 0; rep < NREP(3); ++rep) {
        {
            unsigned* qctr = (unsigned*)(p.ws + OFF_CTRL);
            volatile unsigned* lds_t = (volatile unsigned*)(smem + LDS_BYTES - 16);
            volatile unsigned* lds_c = (volatile unsigned*)(smem + LDS_BYTES - 192);
            const int myx = (int)(xb_xcc_id() & 7u);
            for (int pass = 0; pass < 2; ++pass) {
                if (pass == 1) { __syncthreads(); if (threadIdx.x < 8) lds_c[8 + threadIdx.x] = __hip_atomic_load(qctr + 64 + 16 * rep + threadIdx.x, __ATOMIC_RELAXED, __HIP_MEMORY_SCOPE_AGENT); __syncthreads(); }
                const int nk = pass == 0 ? 1 : 8;
                for (int k = 0; k < nk; ++k) {
                    const int sp = (myx + k) & 7;
                    if (pass == 1 && lds_c[8 + sp] >= 4u) continue;
                    for (;;) {
                        __syncthreads();
                        if (threadIdx.x == 0) lds_t[0] = atomicAdd(qctr + 64 + 16 * rep + sp, 1u);
                        __syncthreads();
                        const unsigned o = lds_t[0];
                        if (o >= 4u) break;
                        { ACC_T0(); gdn_scan_task(p, smem, 4 * sp + (int)o); __syncthreads(); ACC_ADD(4); }
                        if (pass == 0) break;
                    }
                }
                if (pass == 0) for (int k = 0; k < 8; ++k) {
                    const int part = (myx + k) & 7;
                    if (k == 1) { __syncthreads(); if (threadIdx.x < 8) lds_c[threadIdx.x] = __hip_atomic_load(qctr + 128 + 16 * rep + threadIdx.x, __ATOMIC_RELAXED, __HIP_MEMORY_SCOPE_AGENT); __syncthreads(); }
                    if (k >= 1 && lds_c[part] >= 512u) continue;
                    __syncthreads();
                    if (threadIdx.x == 0) lds_t[0] = atomicAdd(qctr + 128 + 16 * rep + part, 1u);
                    __syncthreads();
                    unsigned a = lds_t[0];
                    while (a < 512u) {
                        unsigned nxt = 0u;
                        if (threadIdx.x == 0) nxt = atomicAdd(qctr + 128 + 16 * rep + part, 1u);
                        { ACC_T0(); attn8_task(p, smem, part, (int)a); __syncthreads(); ACC_ADD(3); }
                        __syncthreads();
                        if (threadIdx.x == 0) lds_t[0] = nxt;
                        __syncthreads();
                        a = lds_t[0];
                    }
                }
            }
        }
    }
    SEAM(3);
    const bool fuse_norm = (gridDim.x == 256) && (TS_A < 0) && (TS_ACC < 0);
    if constexpr (IN(4)) {
        pg8::Gemm g{(const h16*)(p.ws + OFF_OMIX), (const h16*)(p.ws + OFF_WOT), BT, DM, DM};
        if (fuse_norm) {
            PanelOrder S; S.c = blockIdx.x;
            EpiOutNorm E{p.x, p.out, (float*)(p.ws + OFF_ROWSS), (unsigned*)(p.ws + OFF_CTRL + 32768), p.final_g};
            pg8::gemm_phase<EpiOutNorm, PanelOrder>((LAS unsigned char*)smem, g, S, E);
        } else {
            pg8::StaticOrder S; S.init(BT, DM, gridDim.x, blockIdx.x);
            EpiOut E{p.x, p.out, (float*)(p.ws + OFF_ROWSS)};
            pg8::gemm_phase<EpiOut, pg8::StaticOrder>((LAS unsigned char*)smem, g, S, E);
        }
    }
    if (fuse_norm) return;
    SEAM(4);
    if constexpr (IN(5)) { phase5(p); }
#undef IN
#undef SEAM
}

template <int LO, int HI> static void launch_range(const Params& p, int grid, hipStream_t stream, bool coop) {
    static bool attr = false;
    if (!attr) { hipFuncSetAttribute((const void*)k_phases<LO, HI>, hipFuncAttributeMaxDynamicSharedMemorySize, LDS_BYTES); attr = true; }
    if (coop) {
        Params pp = p; void* args[] = {&pp};
        hipError_t e = hipLaunchCooperativeKernel((const void*)k_phases<LO, HI>, dim3(grid), dim3(512), args, LDS_BYTES, stream);
        if (e != hipSuccess) fprintf(stderr, "cooperative launch failed: %s (grid %d)\n", hipGetErrorString(e), grid);
    } else {
        hipLaunchKernelGGL((k_phases<LO, HI>), dim3(grid), dim3(512), LDS_BYTES, stream, p);
    }
}

extern "C" void kernel_launch(void* const* d_in, const int* in_sizes, int n_in, void* d_out, int out_size, void* d_ws, size_t ws_size, hipStream_t stream) {
    if (n_in != 10 || in_sizes[0] != BT * DM || out_size != BT * DM || ws_size < WS_END) {
        fprintf(stderr, "kernel_launch: unexpected shapes (n_in %d in0 %d out %d ws %zu need %zu)\n", n_in, n_in > 0 ? in_sizes[0] : -1, out_size, ws_size, (size_t)WS_END); return; }
    static int grid = 0;
    if (!grid) {
        int dev = 0, cus = 0, per_cu = 0; hipGetDevice(&dev); hipDeviceGetAttribute(&cus, hipDeviceAttributeMultiprocessorCount, dev);
#if FUSED
        hipFuncSetAttribute((const void*)k_phases<0, 6>, hipFuncAttributeMaxDynamicSharedMemorySize, LDS_BYTES);
        hipOccupancyMaxActiveBlocksPerMultiprocessor(&per_cu, (const void*)k_phases<0, 6>, 512, LDS_BYTES);
#else
        per_cu = 1;
#endif
        if (per_cu < 1) per_cu = 1; if (per_cu > 1) per_cu = 1;
        grid = cus * per_cu;
    }
    Params p{};
    p.x = (const float*)d_in[0]; p.pos = (const int*)d_in[1]; p.attn_g = (const float*)d_in[2]; p.w_in = (const float*)d_in[3]; p.conv_w = (const float*)d_in[4];
    p.a_log = (const float*)d_in[5]; p.dt_bias = (const float*)d_in[6]; p.gdn_norm_g = (const float*)d_in[7]; p.w_out = (const float*)d_in[8]; p.final_g = (const float*)d_in[9];
    p.out = (float*)d_out; p.ws = (unsigned char*)d_ws;
    hipMemsetAsync((char*)d_ws + OFF_CTRL, 0, CTL_ZERO_BYTES, stream);
#if FUSED
    launch_range<0, 6>(p, grid, stream, false);
#else
    launch_range<0, 1>(p, grid, stream, false);
    launch_range<1, 2>(p, grid, stream, false);
    launch_range<2, 3>(p, grid, stream, false);
    launch_range<3, 4>(p, grid, stream, false);
    launch_range<4, 5>(p, grid, stream, false);
    launch_range<5, 6>(p, grid, stream, false);
#endif
}
```

```cpp
#include <hip/hip_runtime.h>
#include <hip/hip_cooperative_groups.h>
#include <cstdio>
#include <cstdint>
namespace cg = cooperative_groups;

#ifndef FUSED
#define FUSED 1
#endif
#ifndef REPEAT_PHASE
#define REPEAT_PHASE -1
#endif
#define NREP(k) ((REPEAT_PHASE == (k)) ? 2 : 1)
#ifndef TS_A
#define TS_A -1
#endif
#ifndef TS_ACC
#define TS_ACC -1
#endif
#define ACC_T0() unsigned acc_t0_ = 0; if (TS_ACC >= 0 && threadIdx.x == 0) acc_t0_ = (unsigned)__builtin_amdgcn_s_memrealtime()
#define ACC_ADD(k) do { if (TS_ACC >= 0 && threadIdx.x == 0) { const unsigned t1_ = (unsigned)__builtin_amdgcn_s_memrealtime(); atomicAdd((unsigned*)(p.ws + OFF_CTRL + 8192) + 16 + (k), t1_ - acc_t0_); acc_t0_ = t1_; } } while (0)
#ifndef TS_B
#define TS_B -1
#endif

#define LAS __attribute__((address_space(3)))
typedef _Float16 h16;
typedef h16 h16x8 __attribute__((ext_vector_type(8)));
typedef h16 h16x4 __attribute__((ext_vector_type(4)));
typedef h16 h16x2 __attribute__((ext_vector_type(2)));
typedef float f32x4 __attribute__((ext_vector_type(4)));
typedef float f32x2 __attribute__((ext_vector_type(2)));
typedef unsigned u32x4 __attribute__((ext_vector_type(4)));

constexpr int NB = 4, NT = 4096, DM = 2048, BT = NB * NT;
constexpr int IN_COLS = 7776, NPAD = 7936;
constexpr float EPS = 1e-6f;
constexpr int LDS_BYTES = 155648;

constexpr size_t MB = 1024 * 1024;
constexpr size_t OFF_CTRL = 0;
constexpr size_t OFF_ROWSS = 65536;
constexpr size_t CTL_ZERO_BYTES = 65536 + (size_t)BT * 4;
constexpr size_t OFF_H = 1 * MB;
constexpr size_t OFF_OMIX = OFF_H;
constexpr size_t OFF_WT = OFF_H + 64 * MB;
constexpr size_t OFF_WOT = OFF_WT + (size_t)NPAD * 2048 * 2;
constexpr size_t OFF_QKVR = OFF_WOT + 8 * MB;
constexpr size_t OFF_GZ = OFF_QKVR + (size_t)BT * 3072 * 2;
constexpr size_t OFF_AQ = OFF_GZ + 32 * MB;
constexpr size_t OFF_AK = OFF_AQ + 32 * MB;
constexpr size_t OFF_AV = OFF_AK + 8 * MB;
constexpr size_t OFF_AZ = OFF_AV + 8 * MB;
constexpr size_t OFF_IQ = OFF_AZ + 32 * MB;
constexpr size_t OFF_IK = OFF_IQ + 32 * MB;
constexpr size_t OFF_GB = OFF_IK + 2 * MB;
constexpr size_t OFF_IW = OFF_GB + 1 * MB;
constexpr size_t OFF_COS = OFF_IW + 1 * MB;
constexpr size_t OFF_SIN = OFF_COS + 2 * MB;
constexpr size_t OFF_SEL = OFF_SIN + 2 * MB;
constexpr size_t OFF_REC = OFF_SEL + 8 * MB;
constexpr size_t OFF_H8 = OFF_REC;
constexpr size_t OFF_WT8 = OFF_REC + 32 * MB;
constexpr size_t WS_END = OFF_REC + (size_t)2048 * 74752;

struct Params {
    const float* x; const int* pos; const float* attn_g; const float* w_in; const float* conv_w; const float* a_log;
    const float* dt_bias; const float* gdn_norm_g; const float* w_out; const float* final_g; float* out; unsigned char* ws;
};

__device__ __forceinline__ float wave_sum(float v) {
#pragma unroll
    for (int o = 1; o < 64; o <<= 1) v += __shfl_xor(v, o);
    return v;
}
__device__ __forceinline__ float wave_max(float v) {
#pragma unroll
    for (int o = 1; o < 64; o <<= 1) v = fmaxf(v, __shfl_xor(v, o));
    return v;
}
__device__ __forceinline__ int opaque_tid() { int t = threadIdx.x; asm volatile("" : "+v"(t)); return t; }
__device__ __forceinline__ float silu_f(float x) { return x * __builtin_amdgcn_rcpf(1.0f + __builtin_amdgcn_exp2f(-1.4426950408889634f * x)); }

namespace pg8 {
constexpr int BM = 256, BK = 64, HALF = 128, HTB = HALF * BK * 2, STAGE_BYTES = 8 * HTB, NXCD = 8, WGM = 8;
__host__ __device__ __forceinline__ int lds_byte(int r, int c) { const int st = (r >> 4) * 2 + (c >> 5), rr = r & 15, cc = c & 31, ob = rr * 64 + cc * 2; return st * 1024 + (ob ^ (((ob >> 9) & 1) << 5)); }
__host__ __device__ __forceinline__ void stage_rc(int b, int& R, int& C) { const int st = b / 1024, sb = b % 1024, swz = sb ^ (((sb >> 9) & 1) << 5); R = (st >> 1) * 16 + swz / 64; C = (st & 1) * 32 + (swz % 64) / 2; }
__host__ __device__ __forceinline__ int perm32(int rho) { const int n = rho >> 4, i = rho & 15; return 8 * (i >> 2) + 4 * n + (i & 3); }
struct Unit { int pm, pn; };
struct Gemm { const h16* A; const h16* Bt; int M, N, K; };
struct StaticOrder {
    int nM, nN, nwg, G, c;
    __host__ __device__ void init(int M, int N, int G_, int c_) { nM = M / BM; nN = N / BM; nwg = nM * nN; G = G_; c = c_; }
    __host__ __device__ bool next(int i, Unit& u) const {
        const long L = (long)i * G + c; if (L >= nwg) return false;
        int wgid = (int)L; { const int q = nwg / NXCD, r = nwg % NXCD, xcd = wgid % NXCD, off = wgid / NXCD; wgid = (xcd < r ? xcd * (q + 1) : r * (q + 1) + (xcd - r) * q) + off; }
        const int nig = WGM * nN, gid = wgid / nig, fm = gid * WGM, gsz = (nM - fm) < WGM ? (nM - fm) : WGM;
        u.pm = fm + ((wgid % nig) % gsz); u.pn = (wgid % nig) / gsz; return true;
    }
    __device__ __forceinline__ void a_ready(const Unit&) const {}
    __device__ __forceinline__ void done(const Unit&) const {}
};

typedef int i32x8 __attribute__((ext_vector_type(8)));
template <class Epi, class Sched, bool SP2 = true, bool F8 = false, bool SPLIT = false, unsigned SCW = 0x7C7C7C7Cu, unsigned SCA = 0x7C7C7C7Cu>
__device__ __forceinline__ void gemm_phase(LAS unsigned char* lds, const Gemm g, const Sched& S, const Epi& E) {
    const int tid = opaque_tid(), wid = __builtin_amdgcn_readfirstlane(tid >> 6), lane = tid & 63, wr = wid >> 2, wc = wid & 3, fr = lane & 15, fq = lane >> 4;
    const int K = g.K;
    const int ESZ = F8 ? 1 : 2, RB = SPLIT ? 3072 : K * ESZ, nt = RB / 128;
    unsigned voffA[2], voffB[2];
#pragma unroll
    for (int i = 0; i < 2; ++i) { int R, C; stage_rc(tid * 16 + i * 8192, R, C); const int Rb = Epi::PERM ? ((R & ~31) + perm32(R & 31)) : R;
        voffA[i] = (unsigned)(R * RB + C * 2); voffB[i] = (unsigned)(Rb * RB + C * 2); }
    const size_t kstep = (size_t)(BK * 2);
    const size_t hstep = (size_t)HALF * RB;
    const size_t tstep = 2 * hstep;
    const unsigned ldsw = (unsigned)wid * 1024u;
    const int aoff = lds_byte(wr * 64 + fr, fq * 8), boff = lds_byte(wc * 32 + fr, fq * 8);
#define PG8_SA(b, h) (((b) * 2 + (h)) * HTB)
#define PG8_SB(b, h) ((4 + (b) * 2 + (h)) * HTB)
#define PG8_STAGE(bufoff, gbase, voff) do { _Pragma("unroll") for (int _i = 0; _i < 2; ++_i) \
        __builtin_amdgcn_global_load_lds((const unsigned*)((const char*)(gbase) + (voff)[_i]), (LAS unsigned*)(lds + (bufoff) + ldsw + _i * 8192), 16, 0, 0); } while (0)
#define PG8_LDA(dst, b, h) do { _Pragma("unroll") for (int m = 0; m < 4; ++m) _Pragma("unroll") for (int k = 0; k < 2; ++k) dst[m][k] = *(const LAS h16x8*)(lds + PG8_SA(b, h) + aoff + m * 2048 + k * 1024); } while (0)
#define PG8_LDB(dst, b, h) do { _Pragma("unroll") for (int n = 0; n < 2; ++n) _Pragma("unroll") for (int k = 0; k < 2; ++k) dst[n][k] = *(const LAS h16x8*)(lds + PG8_SB(b, h) + boff + n * 2048 + k * 1024); } while (0)
#define PG8_MMA8(ai, bj, At, Bt) do { __builtin_amdgcn_s_setprio(1); \
        _Pragma("unroll") for (int m = 0; m < 4; ++m) _Pragma("unroll") for (int n = 0; n < 2; ++n) { \
            const u32x4 b0_ = __builtin_bit_cast(u32x4, Bt[n][0]), b1_ = __builtin_bit_cast(u32x4, Bt[n][1]), a0_ = __builtin_bit_cast(u32x4, At[m][0]), a1_ = __builtin_bit_cast(u32x4, At[m][1]); \
            const i32x8 bw_ = (i32x8){(int)b0_[0], (int)b0_[1], (int)b0_[2], (int)b0_[3], (int)b1_[0], (int)b1_[1], (int)b1_[2], (int)b1_[3]}; \
            const i32x8 aw_ = (i32x8){(int)a0_[0], (int)a0_[1], (int)a0_[2], (int)a0_[3], (int)a1_[0], (int)a1_[1], (int)a1_[2], (int)a1_[3]}; \
            asm volatile("v_mfma_scale_f32_16x16x128_f8f6f4 %0, %1, %2, %0, %3, %4 op_sel_hi:[0,0,0]" : "+v"(acc[ai][bj][m][n]) : "v"(bw_), "v"(aw_), "v"(SCW), "v"(SCA)); } \
        __builtin_amdgcn_s_setprio(0); } while (0)
#define PG8_MMA16(ai, bj, At, Bt) do { __builtin_amdgcn_s_setprio(1); \
        _Pragma("unroll") for (int m = 0; m < 4; ++m) _Pragma("unroll") for (int n = 0; n < 2; ++n) _Pragma("unroll") for (int k = 0; k < 2; ++k) { \
            if constexpr (SPLIT) asm volatile("v_mfma_f32_16x16x32_f16 %0, %1, %2, %0" : "+v"(acc[ai][bj][m][n]) : "v"(Bt[n][k]), "v"(At[m][k]));     \
            else acc[ai][bj][m][n] = __builtin_amdgcn_mfma_f32_16x16x32_f16(Bt[n][k], At[m][k], acc[ai][bj][m][n], 0, 0, 0); } \
        __builtin_amdgcn_s_setprio(0); } while (0)
#define PG8_ITER(MMA) do { \
            PG8_LDB(B0, 0, 0); PG8_LDB(B1, 0, 1); PG8_SCHED; PG8_LDA(At, 0, 0); PG8_STAGE(PG8_SA(1, 1), a1 + hstep, voffA); \
            PG8_WAIT_V(8); PG8_WAIT_L(0); PG8_BAR; MMA(0, 0, At, B0); MMA(0, 1, At, B1); PG8_BAR; PG8_SCHED; \
            PG8_LDA(At, 0, 1); PG8_STAGE(PG8_SB(0, 0), b2, voffB); PG8_STAGE(PG8_SB(0, 1), b2 + hstep, voffB); PG8_STAGE(PG8_SA(0, 0), a2, voffA); \
            PG8_WAIT_V(8); PG8_WAIT_L(0); PG8_BAR; MMA(1, 0, At, B0); MMA(1, 1, At, B1); PG8_BAR; PG8_SCHED; \
            PG8_LDB(B0, 1, 0); PG8_LDB(B1, 1, 1); PG8_SCHED; PG8_LDA(At, 1, 0); PG8_STAGE(PG8_SA(0, 1), a2 + hstep, voffA); \
            PG8_WAIT_V(8); PG8_WAIT_L(0); PG8_BAR; MMA(0, 0, At, B0); MMA(0, 1, At, B1); PG8_BAR; PG8_SCHED; \
            PG8_LDA(At, 1, 1); PG8_STAGE(PG8_SB(1, 0), b3, voffB); PG8_STAGE(PG8_SB(1, 1), b3 + hstep, voffB); PG8_STAGE(PG8_SA(1, 0), a3, voffA); \
            PG8_WAIT_V(8); PG8_WAIT_L(0); PG8_BAR; MMA(1, 0, At, B0); MMA(1, 1, At, B1); PG8_BAR; PG8_SCHED; \
            } while (0)
#define PG8_MMA(ai, bj, At, Bt) PG8_MMA16(ai, bj, At, Bt)
#define PG8_WAIT_V(n) asm volatile("s_waitcnt vmcnt(" #n ")" ::: "memory")
#define PG8_WAIT_L(n) asm volatile("s_waitcnt lgkmcnt(" #n ")" ::: "memory")
#define PG8_BAR __builtin_amdgcn_s_barrier()
#define PG8_SCHED __builtin_amdgcn_sched_barrier(0)
    Unit cur, nxt; int ui = 0;
    if (!S.next(0, cur)) return;
    f32x4 acc[2][2][4][2];
#pragma unroll
    for (int a = 0; a < 2; ++a)
#pragma unroll
        for (int b = 0; b < 2; ++b)
#pragma unroll
            for (int m = 0; m < 4; ++m)
#pragma unroll
                for (int n = 0; n < 2; ++n) acc[a][b][m][n] = (f32x4){0.f, 0.f, 0.f, 0.f};
    h16x8 At[4][2], B0[2][2], B1[2][2];
    const char* cA = (const char*)g.A + (size_t)cur.pm * tstep; const char* cB = (const char*)g.Bt + (size_t)cur.pn * tstep;
    S.a_ready(cur);
    if constexpr (SP2) {
        PG8_STAGE(PG8_SB(0, 0), cB, voffB); PG8_STAGE(PG8_SB(0, 1), cB + hstep, voffB); PG8_STAGE(PG8_SA(0, 0), cA, voffA); PG8_STAGE(PG8_SA(0, 1), cA + hstep, voffA);
        if (wr == 1) PG8_BAR;
        PG8_WAIT_V(2); PG8_BAR;
        PG8_STAGE(PG8_SB(1, 0), cB + kstep, voffB); PG8_STAGE(PG8_SA(1, 0), cA + kstep, voffA); PG8_STAGE(PG8_SB(1, 1), cB + hstep + kstep, voffB);
        PG8_WAIT_V(6); PG8_BAR;
    } else {
    PG8_STAGE(PG8_SB(0, 0), cB, voffB); PG8_STAGE(PG8_SA(0, 0), cA, voffA); PG8_STAGE(PG8_SB(0, 1), cB + hstep, voffB); PG8_STAGE(PG8_SA(0, 1), cA + hstep, voffA);
    if (wr == 1) PG8_BAR;
    PG8_WAIT_V(4); PG8_BAR;
    PG8_STAGE(PG8_SB(1, 0), cB + kstep, voffB); PG8_STAGE(PG8_SA(1, 0), cA + kstep, voffA); PG8_STAGE(PG8_SB(1, 1), cB + hstep + kstep, voffB);
    PG8_WAIT_V(6); PG8_BAR;
    }
    for (;;) {
        const bool has_next = S.next(ui + 1, nxt);
        const char* nA = has_next ? (const char*)g.A + (size_t)nxt.pm * tstep : cA; const char* nB = has_next ? (const char*)g.Bt + (size_t)nxt.pn * tstep : cB;
#define PG8_PTRS const bool last = (t == nt - 2); const char* a1 = cA + (size_t)(t + 1) * kstep; const char* a2 = last ? nA : cA + (size_t)(t + 2) * kstep; const char* b2 = last ? nB : cB + (size_t)(t + 2) * kstep; const char* a3 = a2 + kstep; const char* b3 = b2 + kstep; if (last && has_next) S.a_ready(nxt);
        if constexpr (SPLIT) {
            for (int t = 0; t < 16; t += 2) { PG8_PTRS PG8_ITER(PG8_MMA16); }
            for (int t = 16; t < nt; t += 2) { PG8_PTRS PG8_ITER(PG8_MMA8); }
        } else
        for (int t = 0; t < nt; t += 2) {
            PG8_PTRS
            if constexpr (SP2) {
            if constexpr (F8) PG8_ITER(PG8_MMA8); else PG8_ITER(PG8_MMA16);
            } else {
            PG8_LDB(B0, 0, 0); PG8_SCHED; PG8_LDA(At, 0, 0); PG8_STAGE(PG8_SA(1, 1), a1 + hstep, voffA);
            PG8_WAIT_L(8); PG8_BAR; PG8_WAIT_L(0); PG8_MMA(0, 0, At, B0); PG8_BAR; PG8_SCHED;
            PG8_LDB(B1, 0, 1); PG8_STAGE(PG8_SB(0, 0), b2, voffB);
            PG8_BAR; PG8_WAIT_L(0); PG8_MMA(0, 1, At, B1); PG8_BAR;
            PG8_LDA(At, 0, 1); PG8_STAGE(PG8_SA(0, 0), a2, voffA);
            PG8_BAR; PG8_WAIT_L(0); PG8_MMA(1, 0, At, B0); PG8_BAR; PG8_SCHED;
            PG8_STAGE(PG8_SB(0, 1), b2 + hstep, voffB);
            PG8_WAIT_V(6); PG8_BAR; PG8_MMA(1, 1, At, B1); PG8_BAR;
            PG8_LDB(B0, 1, 0); PG8_SCHED; PG8_LDA(At, 1, 0); PG8_STAGE(PG8_SA(0, 1), a2 + hstep, voffA);
            PG8_WAIT_L(8); PG8_BAR; PG8_WAIT_L(0); PG8_MMA(0, 0, At, B0); PG8_BAR; PG8_SCHED;
            PG8_LDB(B1, 1, 1); PG8_STAGE(PG8_SB(1, 0), b3, voffB);
            PG8_BAR; PG8_WAIT_L(0); PG8_MMA(0, 1, At, B1); PG8_BAR;
            PG8_LDA(At, 1, 1); PG8_STAGE(PG8_SA(1, 0), a3, voffA);
            PG8_BAR; PG8_WAIT_L(0); PG8_MMA(1, 0, At, B0); PG8_BAR; PG8_SCHED;
            PG8_STAGE(PG8_SB(1, 1), b3 + hstep, voffB);
            PG8_WAIT_V(6); PG8_BAR; PG8_MMA(1, 1, At, B1); PG8_BAR;
            }
        }
        if (wr == 0) PG8_BAR;
        if constexpr (F8 || SPLIT) asm volatile("s_nop 15\n\ts_nop 15" ::: "memory");
        PG8_SCHED; { const int te = opaque_tid(), le = te & 63; E(acc, cur, wr, wc, le & 15, le >> 4); } S.done(cur);
        if (!has_next) break;
#pragma unroll
        for (int a = 0; a < 2; ++a)
#pragma unroll
            for (int b = 0; b < 2; ++b)
#pragma unroll
                for (int m = 0; m < 4; ++m)
#pragma unroll
                    for (int n = 0; n < 2; ++n) acc[a][b][m][n] = (f32x4){0.f, 0.f, 0.f, 0.f};
        cur = nxt; cA = nA; cB = nB; ++ui;
        if (wr == 1) PG8_BAR;
    }
    PG8_WAIT_V(0);
    PG8_BAR;
#undef PG8_SA
#undef PG8_SB
#undef PG8_STAGE
#undef PG8_LDA
#undef PG8_LDB
#undef PG8_MMA
#undef PG8_MMA8
#undef PG8_MMA16
#undef PG8_ITER
#undef PG8_PTRS
#undef PG8_WAIT_V
#undef PG8_WAIT_L
#undef PG8_BAR
#undef PG8_SCHED
}
}

struct OrderF16 : pg8::StaticOrder {
    __device__ __forceinline__ bool next(int i, pg8::Unit& u) const { if (!pg8::StaticOrder::next(i, u)) return false; if (u.pn >= 16) u.pn += 10; return true; }
};
struct OrderF8 {
    int G, c;
    __device__ __forceinline__ bool next(int i, pg8::Unit& u) const {
        int L;
        if (G == 256) { if (c < 64) { if (i >= 1) return false; L = 576 + c; } else { if (i >= 3) return false; L = (c - 64) + 192 * i; } }
        else { L = i * G + c; if (L >= 640) return false; }
        const int wgid = (L % 8) * 80 + L / 8;
        u.pm = (wgid / 80) * 8 + (wgid % 80) % 8; u.pn = 16 + (wgid % 80) / 8; return true;
    }
    __device__ __forceinline__ void a_ready(const pg8::Unit&) const {}
    __device__ __forceinline__ void done(const pg8::Unit&) const {}
};

struct EpiIn {
    static constexpr bool PERM = true;
    unsigned char* ws; const float* a_log; const float* dt_bias; const int* pos;
    __device__ __forceinline__ void operator()(const f32x4 (&acc)[2][2][4][2], const pg8::Unit& u, int wr, int wc, int fr, int fq) const {
        constexpr float RF[16] = {1.591549431e-01f, 7.008652159e-02f, 3.086376340e-02f, 1.359137064e-02f, 5.985185713e-03f, 2.635675899e-03f, 1.160663641e-03f, 5.111175045e-04f,
                                  2.250790790e-04f, 9.911730937e-05f, 4.364795279e-05f, 1.922110068e-05f, 8.464330808e-06f, 3.727408602e-06f, 1.641426263e-06f, 7.228293069e-07f};
        const int pn = u.pn;
        const int rowb = u.pm * 256 + wr * 64 + fr;
        const int cw = wc * 32 + 8 * fq;
        if (pn < 30) {
            h16* base; int ldc, colt, mode; float scale = 1.f;
            if (pn < 12) { base = (h16*)(ws + OFF_QKVR); ldc = 3072; colt = pn * 256; mode = 0; }
            else if (pn < 16) { base = (h16*)(ws + OFF_GZ); ldc = 1024; colt = (pn - 12) * 256; mode = 1; }
            else if (pn < 20) { base = (h16*)(ws + OFF_AQ); ldc = 1024; colt = (pn - 16) * 256; mode = 2; }
            else if (pn == 20) { base = (h16*)(ws + OFF_AK); ldc = 256; colt = 0; mode = 2; }
            else if (pn == 21) { base = (h16*)(ws + OFF_AV); ldc = 256; colt = 0; mode = 4; }
            else if (pn < 26) { base = (h16*)(ws + OFF_AZ); ldc = 1024; colt = (pn - 22) * 256; mode = 1; }
            else { base = (h16*)(ws + OFF_IQ); ldc = 1024; colt = (pn - 26) * 256; mode = 3; }
            const bool rot_wave = (mode == 2 && wc == 0) || (mode == 3 && (wc & 1) == 0);
            const int xm = (mode == 2) ? 32 : 16;
            const bool rot_lane = (mode == 2) ? true : (fq < 2);
            const float sgn = (mode == 2) ? (fq < 2 ? -1.f : 1.f) : (fq == 0 ? -1.f : 1.f);
            float Fq[8]; int ps[2][4];
#pragma unroll
            for (int j = 0; j < 8; ++j) Fq[j] = (mode == 2) ? ((fq & 1) ? RF[8 + j] : RF[j]) : RF[2 * j];
            if (rot_wave) {
#pragma unroll
                for (int ai = 0; ai < 2; ++ai)
#pragma unroll
                    for (int m = 0; m < 4; ++m) ps[ai][m] = pos[rowb + ai * 128 + m * 16];
            }
#pragma unroll
            for (int ai = 0; ai < 2; ++ai)
#pragma unroll
                for (int m = 0; m < 4; ++m) {
                    const int row = rowb + ai * 128 + m * 16;
                    float cs[8], sn[8];
                    if (rot_wave) {
                        const float pf = (float)ps[ai][m];
#pragma unroll
                        for (int j = 0; j < 8; ++j) { const float rv = __builtin_amdgcn_fractf(pf * Fq[j]); cs[j] = __builtin_amdgcn_cosf(rv); sn[j] = __builtin_amdgcn_sinf(rv); }
                    }
#pragma unroll
                    for (int bj = 0; bj < 2; ++bj) {
                        float v[8];
#pragma unroll
                        for (int j = 0; j < 4; ++j) { v[j] = acc[ai][bj][m][0][j]; v[4 + j] = acc[ai][bj][m][1][j]; }
                        if (rot_wave) {
#pragma unroll
                            for (int j = 0; j < 8; ++j) {
                                const unsigned xv = __builtin_bit_cast(unsigned, v[j]); float pv;
                                if (mode == 2) { const auto sw = __builtin_amdgcn_permlane32_swap(xv, xv, false, false); pv = __builtin_bit_cast(float, fq < 2 ? sw[1] : sw[0]); }
                                else { const auto sw = __builtin_amdgcn_permlane16_swap(xv, xv, false, false); pv = __builtin_bit_cast(float, (fq & 1) ? sw[0] : sw[1]); }
                                if (rot_lane) v[j] = v[j] * cs[j] + sgn * pv * sn[j]; }
                        }
                        if (mode == 1) {
#pragma unroll
                            for (int j = 0; j < 8; ++j) v[j] = silu_f(v[j]);
                        }
                        if (mode == 4) {
                            int w0 = 0, w1 = 0;
                            w0 = __builtin_amdgcn_cvt_pk_fp8_f32(v[0], v[1], w0, false); w0 = __builtin_amdgcn_cvt_pk_fp8_f32(v[2], v[3], w0, true);
                            w1 = __builtin_amdgcn_cvt_pk_fp8_f32(v[4], v[5], w1, false); w1 = __builtin_amdgcn_cvt_pk_fp8_f32(v[6], v[7], w1, true);
                            typedef int i32x2b __attribute__((ext_vector_type(2)));
                            *(i32x2b*)((unsigned char*)base + (size_t)row * ldc + bj * 128 + cw) = (i32x2b){w0, w1};
                        } else if (mode == 2) {
                            int w0 = 0, w1 = 0;
                            w0 = __builtin_amdgcn_cvt_pk_fp8_f32(v[0], v[1], w0, false); w0 = __builtin_amdgcn_cvt_pk_fp8_f32(v[2], v[3], w0, true);
                            w1 = __builtin_amdgcn_cvt_pk_fp8_f32(v[4], v[5], w1, false); w1 = __builtin_amdgcn_cvt_pk_fp8_f32(v[6], v[7], w1, true);
                            typedef int i32x2 __attribute__((ext_vector_type(2)));
                            *(i32x2*)((unsigned char*)base + (size_t)row * ldc + colt + bj * 128 + cw) = (i32x2){w0, w1};
                        } else {
                            h16x8 o;
#pragma unroll
                            for (int j = 0; j < 8; ++j) o[j] = (h16)(v[j] * scale);
                            *(h16x8*)(base + (size_t)row * ldc + colt + bj * 128 + cw) = o;
                        }
                    }
                }
        } else {
            h16* ik = (h16*)(ws + OFF_IK); float* gb = (float*)(ws + OFF_GB); float* iw = (float*)(ws + OFF_IW);
#pragma unroll
            for (int ai = 0; ai < 2; ++ai)
#pragma unroll
                for (int m = 0; m < 4; ++m) {
                    const int row = rowb + ai * 128 + m * 16;
                    float v[8];
#pragma unroll
                    for (int j = 0; j < 4; ++j) { v[j] = acc[ai][0][m][0][j]; v[4 + j] = acc[ai][0][m][1][j]; }
                    if (wc == 0) {
                        const float sgn = (fq == 0 ? -1.f : 1.f), pf = (float)pos[row];
#pragma unroll
                        for (int j = 0; j < 8; ++j) { const unsigned xv = __builtin_bit_cast(unsigned, v[j]); const auto sw = __builtin_amdgcn_permlane16_swap(xv, xv, false, false); const float pv = __builtin_bit_cast(float, (fq & 1) ? sw[0] : sw[1]); const float rv = __builtin_amdgcn_fractf(pf * RF[2 * j]); const float c = __builtin_amdgcn_cosf(rv), s = __builtin_amdgcn_sinf(rv);
                            if (fq < 2) v[j] = v[j] * c + sgn * pv * s; }
                    }
                    if (wc < 2) {
                        h16x8 o;
#pragma unroll
                        for (int j = 0; j < 8; ++j) o[j] = (h16)v[j];
                        *(h16x8*)(ik + (size_t)(row >> 5) * 2048 + (cw >> 4) * 512 + ((cw >> 3) & 1) * 256 + (row & 31) * 8) = o;
                    } else if (wc == 2) {
                        if (fq == 0) {
#pragma unroll
                            for (int j = 0; j < 8; ++j) { const float z = v[j] + dt_bias[j];
                                const float sp = fmaxf(z, 0.f) + 0.6931471805599453f * __builtin_amdgcn_logf(1.0f + __builtin_amdgcn_exp2f(-1.4426950408889634f * fabsf(z)));
                                gb[(size_t)row * 16 + j] = -__builtin_amdgcn_exp2f(1.4426950408889634f * a_log[j]) * sp; }
                        } else if (fq == 1) {
#pragma unroll
                            for (int j = 0; j < 8; ++j) gb[(size_t)row * 16 + 8 + j] = __builtin_amdgcn_rcpf(1.0f + __builtin_amdgcn_exp2f(-1.4426950408889634f * v[j]));
                        } else {
#pragma unroll
                            for (int j = 0; j < 8; ++j) iw[(size_t)row * 16 + 8 * (fq - 2) + j] = v[j] * 0.03125f;
                        }
                    }
                }
        }
    }
};

struct PanelOrder {
    int c;
    __device__ __forceinline__ bool next(int i, pg8::Unit& u) const { if (i >= 2) return false; u.pm = 32 * i + 4 * (c & 7) + (c >> 6); u.pn = (c >> 3) & 7; return true; }
    __device__ __forceinline__ void a_ready(const pg8::Unit&) const {}
    __device__ __forceinline__ void done(const pg8::Unit&) const {}
};
struct EpiOutNorm {
    static constexpr bool PERM = false;
    const float* x; float* out; float* rowss; unsigned* cnt; const float* fg;
    __device__ __forceinline__ void operator()(f32x4 (&acc)[2][2][4][2], const pg8::Unit& u, int wr, int wc, int fr, int fq) const {
        const int rowb = u.pm * 256 + wr * 64 + fr, col0 = u.pn * 256 + wc * 32 + 4 * fq;
#pragma unroll
        for (int ai = 0; ai < 2; ++ai)
#pragma unroll
            for (int m = 0; m < 4; ++m) {
                const int row = rowb + ai * 128 + m * 16; float ss = 0.f;
#pragma unroll
                for (int bj = 0; bj < 2; ++bj)
#pragma unroll
                    for (int n = 0; n < 2; ++n) {
                        const f32x4 y = *(const f32x4*)(x + (size_t)row * DM + col0 + bj * 128 + n * 16) + acc[ai][bj][m][n];
                        acc[ai][bj][m][n] = y; ss += (y[0] * y[0] + y[1] * y[1]) + (y[2] * y[2] + y[3] * y[3]);
                    }
                ss += __shfl_xor(ss, 16); ss += __shfl_xor(ss, 32);
                if (fq == 0) atomicAdd(rowss + row, ss);
            }
        asm volatile("s_waitcnt vmcnt(0)" ::: "memory");
        unsigned* cw = cnt + (u.pm * 2 + wr) * 16;
        if ((threadIdx.x & 63) == 0) __hip_atomic_fetch_add(cw, 1u, __ATOMIC_RELAXED, __HIP_MEMORY_SCOPE_AGENT);
        { unsigned spins = 0;
          while ((unsigned)__builtin_amdgcn_readfirstlane((int)__hip_atomic_load(cw, __ATOMIC_RELAXED, __HIP_MEMORY_SCOPE_AGENT)) < 32u) { __builtin_amdgcn_s_sleep(2); if (++spins > (1u << 22)) break; } }
        f32x4 gv[2][2];
#pragma unroll
        for (int bj = 0; bj < 2; ++bj)
#pragma unroll
            for (int n = 0; n < 2; ++n) gv[bj][n] = *(const f32x4*)(fg + col0 + bj * 128 + n * 16);
#pragma unroll
        for (int ai = 0; ai < 2; ++ai)
#pragma unroll
            for (int m = 0; m < 4; ++m) {
                const int row = rowb + ai * 128 + m * 16;
                const float ssr = __hip_atomic_load(rowss + row, __ATOMIC_RELAXED, __HIP_MEMORY_SCOPE_AGENT);
                const float r = __builtin_amdgcn_rsqf(ssr * (1.0f / DM) + EPS);
#pragma unroll
                for (int bj = 0; bj < 2; ++bj)
#pragma unroll
                    for (int n = 0; n < 2; ++n) *(f32x4*)(out + (size_t)row * DM + col0 + bj * 128 + n * 16) = acc[ai][bj][m][n] * r * gv[bj][n];
            }
    }
};

struct EpiOut {
    static constexpr bool PERM = false;
    const float* x; float* out; float* rowss;
    __device__ __forceinline__ void operator()(const f32x4 (&acc)[2][2][4][2], const pg8::Unit& u, int wr, int wc, int fr, int fq) const {
        const int rowb = u.pm * 256 + wr * 64 + fr, col0 = u.pn * 256 + wc * 32 + 4 * fq;
#pragma unroll
        for (int ai = 0; ai < 2; ++ai)
#pragma unroll
            for (int m = 0; m < 4; ++m) {
                const int row = rowb + ai * 128 + m * 16; float ss = 0.f;
#pragma unroll
                for (int bj = 0; bj < 2; ++bj)
#pragma unroll
                    for (int n = 0; n < 2; ++n) {
                        const size_t off = (size_t)row * DM + col0 + bj * 128 + n * 16;
                        const f32x4 y = *(const f32x4*)(x + off) + acc[ai][bj][m][n];
                        *(f32x4*)(out + off) = y; ss += (y[0] * y[0] + y[1] * y[1]) + (y[2] * y[2] + y[3] * y[3]);
                    }
                ss += __shfl_xor(ss, 16); ss += __shfl_xor(ss, 32);
                if (fq == 0) atomicAdd(rowss + row, ss);
            }
    }
};

__device__ __forceinline__ int src_col(int np) {
    if (np < 4096) return np;
    if (np < 7680) return np + 16;
    if (np < 7744) return 7696 + (np - 7680);
    if (np < 7752) return 4096 + (np - 7744);
    if (np < 7760) return 4104 + (np - 7752);
    if (np < 7776) return np;
    return -1;
}
__device__ __forceinline__ void phase0(const Params& p, unsigned char* smem) {
    const int tid = opaque_tid(), wid = tid >> 6, lane = tid & 63;
    const int gw = blockIdx.x * 8 + wid, nw = gridDim.x * 8;
    h16* H = (h16*)(p.ws + OFF_H); unsigned char* H8 = p.ws + OFF_H8;
    for (int row = 2 * gw; row < BT; row += 2 * nw) {
        const f32x4* xr0 = (const f32x4*)(p.x + (size_t)row * DM); const f32x4* xr1 = xr0 + DM / 4;
        f32x4 v0[8], v1[8]; float s0 = 0.f, s1 = 0.f;
#pragma unroll
        for (int i = 0; i < 8; ++i) { v0[i] = xr0[lane + 64 * i]; v1[i] = xr1[lane + 64 * i]; }
#pragma unroll
        for (int i = 0; i < 8; ++i) { s0 += (v0[i][0] * v0[i][0] + v0[i][1] * v0[i][1]) + (v0[i][2] * v0[i][2] + v0[i][3] * v0[i][3]); s1 += (v1[i][0] * v1[i][0] + v1[i][1] * v1[i][1]) + (v1[i][2] * v1[i][2] + v1[i][3] * v1[i][3]); }
        s0 = wave_sum(s0); s1 = wave_sum(s1);
        const float r0 = __builtin_amdgcn_rsqf(s0 * (1.0f / DM) + EPS), r1 = __builtin_amdgcn_rsqf(s1 * (1.0f / DM) + EPS);
#pragma unroll
        for (int i = 0; i < 8; ++i) { const f32x4 g = ((const f32x4*)p.attn_g)[lane + 64 * i]; h16x4 o0, o1;
#pragma unroll
            for (int j = 0; j < 4; ++j) { o0[j] = (h16)(v0[i][j] * r0 * g[j]); o1[j] = (h16)(v1[i][j] * r1 * g[j]); }
            *(h16x4*)(H + (size_t)row * DM + 4 * (lane + 64 * i)) = o0; *(h16x4*)(H + (size_t)(row + 1) * DM + 4 * (lane + 64 * i)) = o1;
            int e0 = 0, e1 = 0;
            e0 = __builtin_amdgcn_cvt_pk_fp8_f32(v0[i][0] * r0 * g[0], v0[i][1] * r0 * g[1], e0, false); e0 = __builtin_amdgcn_cvt_pk_fp8_f32(v0[i][2] * r0 * g[2], v0[i][3] * r0 * g[3], e0, true);
            e1 = __builtin_amdgcn_cvt_pk_fp8_f32(v1[i][0] * r1 * g[0], v1[i][1] * r1 * g[1], e1, false); e1 = __builtin_amdgcn_cvt_pk_fp8_f32(v1[i][2] * r1 * g[2], v1[i][3] * r1 * g[3], e1, true);
            *(int*)(H8 + (size_t)row * DM + 4 * (lane + 64 * i)) = e0; *(int*)(H8 + (size_t)(row + 1) * DM + 4 * (lane + 64 * i)) = e1; }
    }
    {
        float* tiles = (float*)smem;
        h16* Wt = (h16*)(p.ws + OFF_WT); h16* WoT = (h16*)(p.ws + OFF_WOT);
        constexpr int NT1 = 124 * 32, NTT = NT1 + 32 * 32;
        const int nl_r = tid & 63, kl_r = tid >> 6, nl_w = tid >> 3, kc_w = tid & 7;
        float va[8], vb[8];
#define P0_LOAD(tI, v) do { if ((tI) < NT1) { const int n0_ = ((tI) / 32) * 64, k0_ = ((tI) % 32) * 64; const int src_ = src_col(n0_ + nl_r); \
            _Pragma("unroll") for (int i = 0; i < 8; ++i) v[i] = src_ >= 0 ? p.w_in[(size_t)(k0_ + kl_r + 8 * i) * IN_COLS + src_] : 0.f; } \
          else { const int t2_ = (tI) - NT1; const int n0_ = (t2_ / 32) * 64, k0_ = (t2_ % 32) * 64; \
            _Pragma("unroll") for (int i = 0; i < 8; ++i) v[i] = p.w_out[(size_t)(k0_ + kl_r + 8 * i) * DM + n0_ + nl_r]; } } while (0)
#define P0_PUT(buf, v) do { float* t_ = tiles + (buf) * (64 * 65); _Pragma("unroll") for (int i = 0; i < 8; ++i) t_[(kl_r + 8 * i) * 65 + nl_r] = v[i]; } while (0)
#define P0_STORE(buf, tI) do { const float* t_ = tiles + (buf) * (64 * 65); h16x8 o_; _Pragma("unroll") for (int j = 0; j < 8; ++j) o_[j] = (h16)t_[(8 * kc_w + j) * 65 + nl_w]; \
          if ((tI) < NT1) { const int n0_ = ((tI) / 32) * 64, k0_ = ((tI) % 32) * 64; \
              if (n0_ >= 4096 && n0_ < 6656) { int e0_ = 0, e1_ = 0; e0_ = __builtin_amdgcn_cvt_pk_fp8_f32(64.f * (float)o_[0], 64.f * (float)o_[1], e0_, false); e0_ = __builtin_amdgcn_cvt_pk_fp8_f32(64.f * (float)o_[2], 64.f * (float)o_[3], e0_, true); \
                  e1_ = __builtin_amdgcn_cvt_pk_fp8_f32(64.f * (float)o_[4], 64.f * (float)o_[5], e1_, false); e1_ = __builtin_amdgcn_cvt_pk_fp8_f32(64.f * (float)o_[6], 64.f * (float)o_[7], e1_, true); \
                  typedef int i32x2w __attribute__((ext_vector_type(2))); *(i32x2w*)(p.ws + OFF_WT8 + (size_t)(n0_ - 4096 + nl_w) * 2048 + k0_ + 8 * kc_w) = (i32x2w){e0_, e1_}; } \
              else *(h16x8*)(Wt + (size_t)(n0_ + nl_w) * 2048 + k0_ + 8 * kc_w) = o_; } \
          else { const int t2_ = (tI) - NT1; const int n0_ = (t2_ / 32) * 64, k0_ = (t2_ % 32) * 64; unsigned char* wr_ = (unsigned char*)WoT + (size_t)(n0_ + nl_w) * 3072; \
              if (k0_ < 1024) *(h16x8*)(wr_ + 2 * (k0_ + 8 * kc_w)) = o_; \
              else { int e0_ = 0, e1_ = 0; e0_ = __builtin_amdgcn_cvt_pk_fp8_f32(64.f * (float)o_[0], 64.f * (float)o_[1], e0_, false); e0_ = __builtin_amdgcn_cvt_pk_fp8_f32(64.f * (float)o_[2], 64.f * (float)o_[3], e0_, true); \
                  e1_ = __builtin_amdgcn_cvt_pk_fp8_f32(64.f * (float)o_[4], 64.f * (float)o_[5], e1_, false); e1_ = __builtin_amdgcn_cvt_pk_fp8_f32(64.f * (float)o_[6], 64.f * (float)o_[7], e1_, true); \
                  typedef int i32x2o __attribute__((ext_vector_type(2))); *(i32x2o*)(wr_ + 2048 + (k0_ - 1024) + 8 * kc_w) = (i32x2o){e0_, e1_}; } } } while (0)
        int tI = blockIdx.x; int buf = 0;
        __syncthreads();
        if (tI < NTT) { P0_LOAD(tI, va); P0_PUT(0, va); }
        while (tI < NTT) {
            const int tn = tI + gridDim.x;
            if (tn < NTT) P0_LOAD(tn, vb);
            __syncthreads();
            P0_STORE(buf, tI);
            if (tn < NTT) P0_PUT(buf ^ 1, vb);
            buf ^= 1; tI = tn;
        }
#undef P0_LOAD
#undef P0_PUT
#undef P0_STORE
    }
}

__device__ __forceinline__ h16x8 pack8(const f32x4 a, const f32x4 c) { h16x8 o; o[0] = (h16)a[0]; o[1] = (h16)a[1]; o[2] = (h16)a[2]; o[3] = (h16)a[3]; o[4] = (h16)c[0]; o[5] = (h16)c[1]; o[6] = (h16)c[2]; o[7] = (h16)c[3]; return o; }
typedef short v4s_t __attribute__((__vector_size__(4 * sizeof(short))));
__device__ __forceinline__ h16x4 lds_tr16(const LAS unsigned char* a) { const v4s_t v = __builtin_amdgcn_ds_read_tr16_b64_v4i16((LAS v4s_t*)a); return __builtin_bit_cast(h16x4, v); }
constexpr int REC_BYTES = 74752, REC_WF = 0, REC_QF = 16384, REC_AF = 32768, REC_KTF = 40960, REC_VEC = 57344, REC_UF = 58368, REC_DMA = 58368;
constexpr int HB_BYTES = 69632;

__device__ __forceinline__ void gdn_prep_pair(const Params& p, unsigned char* smem, int pair) {
    const int tid = opaque_tid(), wid = __builtin_amdgcn_readfirstlane(tid >> 6), lane = tid & 63, hb = wid >> 2, w4 = wid & 3, tl = tid & 255;
    const int tk = 2 * pair + hb; const int b = tk >> 9, h = (tk >> 6) & 7, n = tk & 63; const int t0 = n * 64;
    unsigned char* base = smem + hb * HB_BYTES;
    h16* Kn = (h16*)base; h16* Qn = Kn + 64 * 136; h16* Vh = Qn + 64 * 136; float* L = (float*)(Vh + 64 * 136); float* vec = L + 4096;
    unsigned char* rec = p.ws + OFF_REC + (size_t)tk * REC_BYTES;
    const h16* qkvr = (const h16*)(p.ws + OFF_QKVR);
    __syncthreads();
    {
        const int cg = tl & 15, rg = tl >> 4;
        h16x8 raw[3][7];
#pragma unroll
        for (int ti = 0; ti < 3; ++ti)
#pragma unroll
            for (int r = 0; r < 7; ++r) {
                const int trow = t0 + 4 * rg - 3 + r;
                if (trow >= 0) raw[ti][r] = *(const h16x8*)(qkvr + ((size_t)b * NT + trow) * 3072 + ti * 1024 + h * 128 + 8 * cg);
                else { for (int j = 0; j < 8; ++j) raw[ti][r][j] = (h16)0.f; }
            }
#pragma unroll
        for (int ti = 0; ti < 3; ++ti) {
            const int chan = ti * 1024 + h * 128 + 8 * cg;
            float xr[7][8];
#pragma unroll
            for (int r = 0; r < 7; ++r)
#pragma unroll
                for (int j = 0; j < 8; ++j) xr[r][j] = (float)raw[ti][r][j];
            float wv[4][8];
#pragma unroll
            for (int tp = 0; tp < 4; ++tp) { const f32x4 a = *(const f32x4*)(p.conv_w + (size_t)tp * 3072 + chan), c = *(const f32x4*)(p.conv_w + (size_t)tp * 3072 + chan + 4);
#pragma unroll
                for (int j = 0; j < 4; ++j) { wv[tp][j] = a[j]; wv[tp][4 + j] = c[j]; } }
            h16* dst = (ti == 0) ? Qn : (ti == 1 ? Kn : Vh);
#pragma unroll
            for (int r = 0; r < 4; ++r) {
                float y[8]; float ss = 0.f;
#pragma unroll
                for (int j = 0; j < 8; ++j) { float a = wv[0][j] * xr[r][j] + wv[1][j] * xr[r + 1][j] + wv[2][j] * xr[r + 2][j] + wv[3][j] * xr[r + 3][j]; a = silu_f(a); y[j] = a; ss += a * a; }
                float sc = 1.f;
                if (ti < 2) { ss += __shfl_xor(ss, 1); ss += __shfl_xor(ss, 2); ss += __shfl_xor(ss, 4); ss += __shfl_xor(ss, 8); sc = (ti == 0 ? 0.08838834764831845f : 1.0f) * __builtin_amdgcn_rsqf(ss + EPS); }
                h16x8 o;
#pragma unroll
                for (int j = 0; j < 8; ++j) o[j] = (h16)(y[j] * sc);
                *(h16x8*)(dst + (4 * rg + r) * 136 + 8 * cg) = o;
            }
        }
    }
    if (tl < 64) {
        const float* gb = (const float*)(p.ws + OFF_GB) + ((size_t)b * NT + t0 + tl) * 16;
        const float g = gb[h], be = gb[8 + h];
        float gc = g;
#pragma unroll
        for (int o = 1; o < 64; o <<= 1) { const float tt = __shfl_up(gc, o); if (lane >= o) gc += tt; }
        const float gl = __shfl(gc, 63);
        vec[tl] = g; vec[64 + tl] = be; vec[128 + tl] = gc; vec[192 + tl] = __expf(gc);
        float* rv = (float*)(rec + REC_VEC);
        rv[tl] = __expf(gc); rv[64 + tl] = __expf(gl - gc); if (tl == 0) rv[128] = __expf(gl);
    }
    __syncthreads();
    {
        const int rt = w4, fr = lane & 15, kg = lane >> 4;
        h16x8 Ak[4], Aq[4];
#pragma unroll
        for (int s = 0; s < 4; ++s) { Ak[s] = *(const h16x8*)(Kn + (16 * rt + fr) * 136 + 32 * s + 8 * kg); Aq[s] = *(const h16x8*)(Qn + (16 * rt + fr) * 136 + 32 * s + 8 * kg); }
        h16* AF = (h16*)(rec + REC_AF);
#pragma unroll
        for (int ct = 0; ct < 4; ++ct) {
            f32x4 kk = (f32x4){0.f, 0.f, 0.f, 0.f}, qk = (f32x4){0.f, 0.f, 0.f, 0.f};
#pragma unroll
            for (int s = 0; s < 4; ++s) { const h16x8 Bk = *(const h16x8*)(Kn + (16 * ct + fr) * 136 + 32 * s + 8 * kg);
                kk = __builtin_amdgcn_mfma_f32_16x16x32_f16(Ak[s], Bk, kk, 0, 0, 0); qk = __builtin_amdgcn_mfma_f32_16x16x32_f16(Aq[s], Bk, qk, 0, 0, 0); }
            const int j = 16 * ct + fr; const float gcj = vec[128 + j];
#pragma unroll
            for (int rgi = 0; rgi < 4; ++rgi) {
                const int i = 16 * rt + 4 * kg + rgi;
                const float dec = (i >= j) ? __expf(vec[128 + i] - gcj) : 0.f;
                L[i * 64 + j] = (i > j) ? vec[64 + i] * kk[rgi] * dec : 0.f;
                const int sp = ct >> 1, kgp = fr >> 2, j8 = (ct & 1) * 4 + (fr & 3), lanep = 16 * kgp + 4 * kg + rgi;
                AF[((rt * 2 + sp) * 64 + lanep) * 8 + j8] = (h16)(qk[rgi] * dec);
            }
        }
    }
    __syncthreads();
    h16* Tw = (h16*)L; h16* Tu = Tw + 4096;
    if (w4 == 0) {
        float X[64];
#pragma unroll
        for (int i = 0; i < 64; ++i) X[i] = 0.f;
        f32x4 Ln[16]; float rn = (lane == 0) ? 1.f : 0.f;
#pragma unroll
        for (int i = 0; i < 64; ++i) {
            f32x4 Lc[16]; const float rc = rn;
#pragma unroll
            for (int jj = 0; jj < (i + 3) / 4; ++jj) Lc[jj] = Ln[jj];
            if (i + 1 < 64) {
#pragma unroll
                for (int jj = 0; jj < (i + 4) / 4; ++jj) Ln[jj] = *(const f32x4*)(L + (i + 1) * 64 + 4 * jj);
                rn = (lane == i + 1) ? 1.f : 0.f;
            }
            float a0 = rc, a1 = 0.f, a2 = 0.f, a3 = 0.f;
#pragma unroll
            for (int jj = 0; jj < (i + 3) / 4; ++jj) { a0 -= Lc[jj][0] * X[4 * jj]; a1 -= Lc[jj][1] * X[4 * jj + 1]; a2 -= Lc[jj][2] * X[4 * jj + 2]; a3 -= Lc[jj][3] * X[4 * jj + 3]; }
            float acc = (a0 + a1) + (a2 + a3);
            asm volatile("" : "+v"(acc) :: "memory");
            X[i] = acc;
        }
        const float bu = vec[64 + lane], bw = bu * vec[192 + lane];
#pragma unroll
        for (int i = 0; i < 64; ++i) { const int pos = i * 64 + ((((lane >> 3) ^ (i & 7)) << 3) | (lane & 7)); Tw[pos] = (h16)(X[i] * bw); Tu[pos] = (h16)(X[i] * bu); }
    } else {
        const int t3 = tl - 64;
        h16* QF = (h16*)(rec + REC_QF);
        for (int f = t3; f < 1024; f += 192) { const int lanep = f & 63, s = (f >> 6) & 3, rt = f >> 8; const int row = 16 * rt + (lanep & 15), kgp = lanep >> 4;
            const h16x4 a = *(const h16x4*)(Qn + row * 136 + 32 * s + 4 * kgp), c = *(const h16x4*)(Qn + row * 136 + 32 * s + 16 + 4 * kgp);
            h16x8 o; o[0] = a[0]; o[1] = a[1]; o[2] = a[2]; o[3] = a[3]; o[4] = c[0]; o[5] = c[1]; o[6] = c[2]; o[7] = c[3];
            *(h16x8*)(QF + (size_t)f * 8) = o; }
        h16* KTF = (h16*)(rec + REC_KTF);
        for (int f = t3; f < 1024; f += 192) { const int lanep = f & 63, sp = (f >> 6) & 1, rt = f >> 7; const int d = 16 * rt + (lanep & 15), kgp = lanep >> 4;
            h16x8 o;
#pragma unroll
            for (int j8 = 0; j8 < 8; ++j8) { const int c = 32 * sp + (j8 < 4 ? 4 * kgp + j8 : 16 + 4 * kgp + (j8 - 4)); o[j8] = Kn[c * 136 + d]; }
            *(h16x8*)(KTF + (size_t)f * 8) = o; }
    }
    __syncthreads();
    {
        const int rt = w4, fr = lane & 15, kg = lane >> 4, q4 = fr >> 2, pp = fr & 3;
        const LAS unsigned char* Knl = (const LAS unsigned char*)Kn; const LAS unsigned char* Vl = (const LAS unsigned char*)Vh;
        const int trow = 16 * rt + fr;
        h16x8 Tuf[2], Twf[2];
#pragma unroll
        for (int s = 0; s < 2; ++s) { const int off = trow * 64 + ((((4 * s + kg) ^ (trow & 7))) << 3); Tuf[s] = *(const h16x8*)(Tu + off); Twf[s] = *(const h16x8*)(Tw + off); }
        h16* UF = (h16*)(rec + REC_UF);
#pragma unroll
        for (int dvb = 0; dvb < 8; ++dvb) {
            f32x4 acc = (f32x4){0.f, 0.f, 0.f, 0.f};
#pragma unroll
            for (int s = 0; s < 2; ++s) { const LAS unsigned char* a0 = Vl + ((32 * s + 8 * kg + q4) * 136 + 16 * dvb + 4 * pp) * 2;
                const h16x4 lo = lds_tr16(a0), hi4 = lds_tr16(a0 + 4 * 136 * 2);
                h16x8 Bv; Bv[0] = lo[0]; Bv[1] = lo[1]; Bv[2] = lo[2]; Bv[3] = lo[3]; Bv[4] = hi4[0]; Bv[5] = hi4[1]; Bv[6] = hi4[2]; Bv[7] = hi4[3];
                acc = __builtin_amdgcn_mfma_f32_16x16x32_f16(Tuf[s], Bv, acc, 0, 0, 0); }
            h16x4 o; o[0] = (h16)acc[0]; o[1] = (h16)acc[1]; o[2] = (h16)acc[2]; o[3] = (h16)acc[3];
            *(h16x4*)(UF + (size_t)((dvb * 4 + rt) * 64 + lane) * 4) = o;
        }
        h16* WF = (h16*)(rec + REC_WF);
#pragma unroll
        for (int so = 0; so < 4; ++so) {
            f32x4 c0 = (f32x4){0.f, 0.f, 0.f, 0.f}, c1 = (f32x4){0.f, 0.f, 0.f, 0.f};
#pragma unroll
            for (int s = 0; s < 2; ++s) {
                const LAS unsigned char* a0 = Knl + ((32 * s + 8 * kg + q4) * 136 + 16 * (2 * so) + 4 * pp) * 2;
                const h16x4 l0 = lds_tr16(a0), h0 = lds_tr16(a0 + 4 * 136 * 2), l1 = lds_tr16(a0 + 32), h1 = lds_tr16(a0 + 32 + 4 * 136 * 2);
                h16x8 A0, A1; A0[0] = l0[0]; A0[1] = l0[1]; A0[2] = l0[2]; A0[3] = l0[3]; A0[4] = h0[0]; A0[5] = h0[1]; A0[6] = h0[2]; A0[7] = h0[3];
                A1[0] = l1[0]; A1[1] = l1[1]; A1[2] = l1[2]; A1[3] = l1[3]; A1[4] = h1[0]; A1[5] = h1[1]; A1[6] = h1[2]; A1[7] = h1[3];
                c0 = __builtin_amdgcn_mfma_f32_16x16x32_f16(A0, Twf[s], c0, 0, 0, 0); c1 = __builtin_amdgcn_mfma_f32_16x16x32_f16(A1, Twf[s], c1, 0, 0, 0);
            }
            *(h16x8*)(WF + (size_t)((rt * 4 + so) * 64 + lane) * 8) = pack8(-c0, -c1);
        }
    }
}

__device__ __forceinline__ void gdn_scan_task(const Params& p, unsigned char* smem, int bh) {
    const int tid = opaque_tid(), wid = __builtin_amdgcn_readfirstlane(tid >> 6), lane = tid & 63, kg = lane >> 4, fr = lane & 15;
    const int b = bh >> 3, h = bh & 7;
    LAS unsigned char* lds = (LAS unsigned char*)smem;
    const unsigned char* rec0 = p.ws + OFF_REC + (size_t)(bh * 64) * REC_BYTES;
    h16* OB = (h16*)(smem + 2 * REC_DMA);
    const h16* gz = (const h16*)(p.ws + OFF_GZ); h16* omix = (h16*)(p.ws + OFF_OMIX);
    f32x4 Sacc[8];
#pragma unroll
    for (int t = 0; t < 8; ++t) Sacc[t] = (f32x4){0.f, 0.f, 0.f, 0.f};
    h16x4 Uc[4], Un[4];
    __syncthreads();
#define GDN_GLDS(recp, bufi) do { _Pragma("unroll") for (int _i = 0; _i < 7; ++_i) \
        __builtin_amdgcn_global_load_lds((const unsigned*)((recp) + (size_t)(_i * 512 + tid) * 16), (LAS unsigned*)(lds + (bufi) * REC_DMA + (_i * 512 + wid * 64) * 16), 16, 0, 0); \
        if (wid == 0) __builtin_amdgcn_global_load_lds((const unsigned*)((recp) + (size_t)(7 * 512 + tid) * 16), (LAS unsigned*)(lds + (bufi) * REC_DMA + (7 * 512) * 16), 16, 0, 0); } while (0)
#define GDN_LDREG(recp, U_) do { _Pragma("unroll") for (int rt = 0; rt < 4; ++rt) U_[rt] = *(const h16x4*)((recp) + REC_UF + (size_t)((wid * 4 + rt) * 64 + lane) * 8); } while (0)
#define GDN_LDGZ(dst, chunk) do { const h16* gp_ = gz + ((size_t)b * NT + 64 * (chunk) + prow) * 1024 + h * 128 + 16 * pseg; dst[0] = *(const h16x8*)gp_; dst[1] = *(const h16x8*)(gp_ + 8); } while (0)
#define GDN_POST(chunk, gzv) do { const h16* Ob = OB + ((chunk) & 1) * 8192 + prow * 128 + 16 * pseg; const h16x8 a0 = *(const h16x8*)Ob, a1 = *(const h16x8*)(Ob + 8); \
        float ngv[16]; _Pragma("unroll") for (int j = 0; j < 4; ++j) { const f32x4 t4 = *(const f32x4*)(ngl + 16 * pseg + 4 * j); ngv[4 * j] = t4[0]; ngv[4 * j + 1] = t4[1]; ngv[4 * j + 2] = t4[2]; ngv[4 * j + 3] = t4[3]; } \
        float ss = 0.f; _Pragma("unroll") for (int j = 0; j < 8; ++j) { const float u0 = (float)a0[j], u1 = (float)a1[j]; ss += u0 * u0 + u1 * u1; } \
        ss += __shfl_xor(ss, 1); ss += __shfl_xor(ss, 2); ss += __shfl_xor(ss, 4); const float r = __builtin_amdgcn_rsqf(ss * (1.0f / 128.0f) + EPS); \
        h16x8 o0, o1; _Pragma("unroll") for (int j = 0; j < 8; ++j) { o0[j] = (h16)((float)a0[j] * r * ngv[j] * (float)gzv[0][j]); o1[j] = (h16)((float)a1[j] * r * ngv[8 + j] * (float)gzv[1][j]); } \
        h16* op_ = omix + ((size_t)b * NT + 64 * (chunk) + prow) * 1536 + h * 128 + 16 * pseg; *(h16x8*)op_ = o0; *(h16x8*)(op_ + 8) = o1; } while (0)
#define GDN_RD8(X, off0) do { _Pragma("unroll") for (int _j = 0; _j < 8; ++_j) X[_j] = *(const LAS h16x8*)(bufp + (off0) + (_j * 64 + lane) * 16); } while (0)
#define GDN_SB __builtin_amdgcn_sched_barrier(0)
    h16x8 gzp[2], gzn[2];
    const int prow = tid >> 3, pseg = tid & 7;
    float* ngl = (float*)(smem + 2 * REC_DMA + 32768);
    if (tid < 128) ngl[tid] = p.gdn_norm_g[tid];
    GDN_GLDS(rec0, 0);
    GDN_LDREG(rec0, Uc);
    asm volatile("s_waitcnt vmcnt(0)" ::: "memory");
    __syncthreads();
    for (int n = 0; n < 64; ++n) {
        const unsigned char* recn = rec0 + (size_t)(n + 1) * REC_BYTES;
        if (n + 1 < 64) { GDN_GLDS(recn, (n + 1) & 1); GDN_LDREG(recn, Un); }
        GDN_LDGZ(gzn, n);
        if (n > 0) GDN_POST(n - 1, gzp);
        const LAS unsigned char* bufp = lds + (n & 1) * REC_DMA;
        h16x8 X[8], Y[8];
        GDN_RD8(X, REC_WF);
        h16x8 SB[4];
#pragma unroll
        for (int s = 0; s < 4; ++s) SB[s] = pack8(Sacc[2 * s], Sacc[2 * s + 1]);
        f32x4 vacc[4], oacc[4];
#pragma unroll
        for (int rt = 0; rt < 4; ++rt) { vacc[rt] = (f32x4){(float)Uc[rt][0], (float)Uc[rt][1], (float)Uc[rt][2], (float)Uc[rt][3]}; oacc[rt] = (f32x4){0.f, 0.f, 0.f, 0.f}; }
        GDN_SB;
        GDN_RD8(Y, REC_WF + 8192);
#pragma unroll
        for (int j = 0; j < 8; ++j) vacc[j >> 2] = __builtin_amdgcn_mfma_f32_16x16x32_f16(X[j], SB[j & 3], vacc[j >> 2], 0, 0, 0);
        GDN_SB;
        GDN_RD8(X, REC_QF);
#pragma unroll
        for (int j = 0; j < 8; ++j) vacc[2 + (j >> 2)] = __builtin_amdgcn_mfma_f32_16x16x32_f16(Y[j], SB[j & 3], vacc[2 + (j >> 2)], 0, 0, 0);
        GDN_SB;
        GDN_RD8(Y, REC_QF + 8192);
        f32x4 ekv[4], egv[4];
#pragma unroll
        for (int rt = 0; rt < 4; ++rt) { ekv[rt] = *(const LAS f32x4*)(bufp + REC_VEC + 256 + (16 * rt + 4 * kg) * 4); egv[rt] = *(const LAS f32x4*)(bufp + REC_VEC + (16 * rt + 4 * kg) * 4); }
        const float eglc = *(const LAS float*)(bufp + REC_VEC + 512);
#pragma unroll
        for (int j = 0; j < 8; ++j) oacc[j >> 2] = __builtin_amdgcn_mfma_f32_16x16x32_f16(X[j], SB[j & 3], oacc[j >> 2], 0, 0, 0);
        GDN_SB;
        GDN_RD8(X, REC_KTF);
        h16x8 VB[2], VKB[2];
#pragma unroll
        for (int sp = 0; sp < 2; ++sp) { VB[sp] = pack8(vacc[2 * sp], vacc[2 * sp + 1]); VKB[sp] = pack8(vacc[2 * sp] * ekv[2 * sp], vacc[2 * sp + 1] * ekv[2 * sp + 1]); }
#pragma unroll
        for (int j = 0; j < 8; ++j) oacc[2 + (j >> 2)] = __builtin_amdgcn_mfma_f32_16x16x32_f16(Y[j], SB[j & 3], oacc[2 + (j >> 2)], 0, 0, 0);
        GDN_SB;
        GDN_RD8(Y, REC_KTF + 8192);
#pragma unroll
        for (int t = 0; t < 8; ++t) Sacc[t] = Sacc[t] * eglc;
#pragma unroll
        for (int j = 0; j < 8; ++j) Sacc[j >> 1] = __builtin_amdgcn_mfma_f32_16x16x32_f16(X[j], VKB[j & 1], Sacc[j >> 1], 0, 0, 0);
        GDN_SB;
        GDN_RD8(X, REC_AF);
#pragma unroll
        for (int rt = 0; rt < 4; ++rt) oacc[rt] = oacc[rt] * egv[rt];
#pragma unroll
        for (int j = 0; j < 8; ++j) Sacc[4 + (j >> 1)] = __builtin_amdgcn_mfma_f32_16x16x32_f16(Y[j], VKB[j & 1], Sacc[4 + (j >> 1)], 0, 0, 0);
        GDN_SB;
#pragma unroll
        for (int j = 0; j < 8; ++j) oacc[j >> 1] = __builtin_amdgcn_mfma_f32_16x16x32_f16(X[j], VB[j & 1], oacc[j >> 1], 0, 0, 0);
        { h16* Ob = OB + (n & 1) * 8192;
#pragma unroll
          for (int rt = 0; rt < 4; ++rt)
#pragma unroll
              for (int rgi = 0; rgi < 4; ++rgi) Ob[(16 * rt + 4 * kg + rgi) * 128 + 16 * wid + fr] = (h16)oacc[rt][rgi]; }
        asm volatile("s_waitcnt vmcnt(0)" ::: "memory");
        __syncthreads();
#pragma unroll
        for (int rt = 0; rt < 4; ++rt) Uc[rt] = Un[rt];
        gzp[0] = gzn[0]; gzp[1] = gzn[1];
    }
    GDN_POST(63, gzp);
#undef GDN_LDGZ
#undef GDN_POST
#undef GDN_RD8
#undef GDN_SB
#undef GDN_GLDS
#undef GDN_LDREG
}

__device__ __forceinline__ unsigned f2key(float x) { const unsigned u = __float_as_uint(x); return (u & 0x80000000u) ? ~u : (u | 0x80000000u); }
typedef float f32x16 __attribute__((ext_vector_type(16)));
__device__ __forceinline__ float wave_min(float v) {
#pragma unroll
    for (int o = 1; o < 64; o <<= 1) v = fminf(v, __shfl_xor(v, o));
    return v;
}
__device__ __forceinline__ unsigned lane_below(unsigned long long m) { return __builtin_amdgcn_mbcnt_hi((unsigned)(m >> 32), __builtin_amdgcn_mbcnt_lo((unsigned)m, 0u)); }
__device__ __forceinline__ void idx8_task(const Params& p, unsigned char* smem, int b, int qb) {
    const int tid = opaque_tid(), wid = __builtin_amdgcn_readfirstlane(tid >> 6), lane = tid & 63;
    const int t0 = qb * 8;
    unsigned short* selg = (unsigned short*)(p.ws + OFF_SEL) + ((size_t)b * NT + t0) * 256;
    if (t0 + 8 <= 256) {
        for (int i = tid; i < 8 * 256; i += 512) { const int q = i >> 8, k = i & 255; selg[i] = (unsigned short)(k <= t0 + q ? k : 0); }
        return;
    }
    float* sc = (float*)smem;
    ACC_T0();
    unsigned* hist = (unsigned*)(smem + 131072 + wid * 2560);
    unsigned* cand = hist + 256;
    __syncthreads();
    {
        const int n8 = t0 + 8;
        const int ntile = (n8 + 31) >> 5, ntile_pad = ((n8 + 255) >> 8) << 3;
        const h16* iq = (const h16*)(p.ws + OFF_IQ) + ((size_t)b * NT + t0) * 1024;
        const float* iw = (const float*)(p.ws + OFF_IW) + ((size_t)b * NT + t0) * 16;
        const h16* ik = (const h16*)(p.ws + OFF_IK) + (size_t)b * NT * 64;
        const int r = lane & 31, kh = lane >> 5, qq = (r >> 2) & 1, hh = (r & 3) + 4 * (r >> 3);
        h16x8 Af[4][4]; h16x2 Wp[4][8];
#pragma unroll
        for (int a = 0; a < 4; ++a) {
#pragma unroll
            for (int s = 0; s < 4; ++s) Af[a][s] = *(const h16x8*)(iq + (size_t)(2 * a + qq) * 1024 + hh * 64 + 16 * s + 8 * kh);
#pragma unroll
            for (int c = 0; c < 4; ++c) { const f32x4 w4 = *(const f32x4*)(iw + (size_t)(2 * a + kh) * 16 + 4 * c);
                Wp[a][2 * c] = (h16x2){(h16)w4[0], (h16)w4[1]}; Wp[a][2 * c + 1] = (h16x2){(h16)w4[2], (h16)w4[3]}; }
        }
#define IDX_LOADB(Bx, ti) do { const int tc_ = (ti) < ntile ? (ti) : ntile - 1;     \
            _Pragma("unroll") for (int s = 0; s < 4; ++s) Bx[s] = *(const h16x8*)(ik + (size_t)tc_ * 2048 + s * 512 + kh * 256 + r * 8); } while (0)
#define IDX_COMP(Bx, ti) do { if ((ti) < ntile) { const int key = 32 * (ti) + r; f32x16 accs[4]; \
            _Pragma("unroll") for (int a = 0; a < 4; ++a) { _Pragma("unroll") for (int e = 0; e < 16; ++e) accs[a][e] = 0.f; \
                _Pragma("unroll") for (int s = 0; s < 4; ++s) accs[a] = __builtin_amdgcn_mfma_f32_32x32x16_f16(Af[a][s], Bx[s], accs[a], 0, 0, 0); } \
            __builtin_amdgcn_sched_barrier(0); \
            _Pragma("unroll") for (int a = 0; a < 4; ++a) { \
                float s0 = 0.f, s1 = 0.f; _Pragma("unroll") for (int e = 0; e < 8; e += 2) { h16x2 rp = (h16x2){(h16)accs[a][2 * e], (h16)accs[a][2 * e + 1]}; rp = __builtin_elementwise_max(rp, (h16x2){(h16)0.f, (h16)0.f}); s0 = __builtin_amdgcn_fdot2(rp, Wp[a][e], s0, false); \
                    h16x2 rq = (h16x2){(h16)accs[a][2 * e + 2], (h16)accs[a][2 * e + 3]}; rq = __builtin_elementwise_max(rq, (h16x2){(h16)0.f, (h16)0.f}); s1 = __builtin_amdgcn_fdot2(rq, Wp[a][e + 1], s1, false); } \
                const int q = 2 * a + kh; sc[q * 4096 + key] = (key > t0 + q) ? -INFINITY : (s0 + s1); } } } while (0)
        {
            h16x8 B0[4], B1[4], B2[4];
            IDX_LOADB(B0, wid); IDX_LOADB(B1, wid + 8);
            for (int i = wid; i < ntile; i += 24) {
                IDX_LOADB(B2, i + 16); IDX_COMP(B0, i);
                IDX_LOADB(B0, i + 24); IDX_COMP(B1, i + 8);
                IDX_LOADB(B1, i + 32); IDX_COMP(B2, i + 16);
            }
            for (int i = ntile + wid; i < ntile_pad; i += 8) {
#pragma unroll
                for (int a = 0; a < 4; ++a) sc[(2 * a + kh) * 4096 + 32 * i + r] = -INFINITY;
            }
        }
#undef IDX_LOADB
#undef IDX_COMP
    }
    __syncthreads();
    ACC_ADD(1);
    {
        const int tq = t0 + wid, n = tq + 1;
        const float* row = sc + wid * 4096;
        const int ng = (n + 255) >> 8;
        f32x4 x[16];
#pragma unroll
        for (int g = 0; g < 16; ++g) { if (g < ng) x[g] = *(const f32x4*)(row + 256 * g + 4 * lane); else x[g] = (f32x4){-INFINITY, -INFINITY, -INFINITY, -INFINITY}; }
        float hi = -INFINITY, lo = INFINITY;
#pragma unroll
        for (int g = 0; g < 16; ++g)
#pragma unroll
            for (int c = 0; c < 4; ++c) { const float v = x[g][c]; hi = fmaxf(hi, v); lo = fminf(lo, v == -INFINITY ? INFINITY : v); }
        hi = wave_max(hi); lo = wave_min(lo);
        const float scale = (hi > lo) ? 255.99f / (hi - lo) : 0.f; const float off = -lo * scale;
        *(u32x4*)(hist + 4 * lane) = (u32x4){0u, 0u, 0u, 0u};
#pragma unroll
        for (int g = 0; g < 16; ++g) { if (g < ng) {
#pragma unroll
            for (int c = 0; c < 4; ++c) { int bin = (int)fmaf(x[g][c], scale, off); bin = bin < 0 ? 0 : (bin > 255 ? 255 : bin); atomicAdd(&hist[bin], 1u); } } }
        unsigned bstar, need;
        {
            const u32x4 h4 = *(const u32x4*)(hist + 4 * lane); const unsigned s = h4[0] + h4[1] + h4[2] + h4[3];
            unsigned suf = s;
#pragma unroll
            for (int o = 1; o < 64; o <<= 1) { const unsigned tt = __shfl_down(suf, o); if (lane + o < 64) suf += tt; }
            const unsigned above = suf - s;
            const bool mine = (above < 256u && 256u <= suf);
            unsigned cum = above; unsigned bin = 0;
            if (cum + h4[3] >= 256u) bin = 3; else { cum += h4[3]; if (cum + h4[2] >= 256u) bin = 2; else { cum += h4[2]; if (cum + h4[1] >= 256u) bin = 1; else { cum += h4[1]; bin = 0; } } }
            const unsigned long long mm = __ballot(mine);
            const int src = (int)__builtin_ctzll(mm);
            bstar = (unsigned)__shfl((int)(4 * lane + bin), src); need = (unsigned)__shfl((int)(256u - cum), src);
        }
        unsigned short* so = selg + (size_t)wid * 256;
        unsigned short* cidx = (unsigned short*)(cand + 256);
        unsigned m = 0, outb = 0;
#pragma unroll
        for (int g = 0; g < 16; ++g) { if (g < ng) {
#pragma unroll
            for (int c = 0; c < 4; ++c) { int bin = (int)fmaf(x[g][c], scale, off); bin = bin < 0 ? 0 : (bin > 255 ? 255 : bin);
                const bool gt = ((unsigned)bin > bstar), pr = ((unsigned)bin == bstar);
                const unsigned long long mg = __ballot(gt), mk = __ballot(pr);
                if (mg) { const unsigned pos = outb + lane_below(mg); if (gt) so[pos] = (unsigned short)(256 * g + 4 * lane + c); outb += (unsigned)__builtin_popcountll(mg); }
                if (mk) { const unsigned pos = m + lane_below(mk); if (pr && pos < 256u) { cand[pos] = f2key(x[g][c]); cidx[pos] = (unsigned short)(256 * g + 4 * lane + c); } m += (unsigned)__builtin_popcountll(mk); } } } }
        unsigned Kt = 0, rr = need;
        if (m <= 256u) {
            const int nc = (int)((m + 63u) >> 6);
            unsigned cv[4]; unsigned short ci[4];
#pragma unroll
            for (int j = 0; j < 4; ++j) { const bool in = (64 * j + lane < (int)m); cv[j] = in ? cand[64 * j + lane] : 0u; ci[j] = in ? cidx[64 * j + lane] : (unsigned short)0; }
            for (int bit = 31; bit >= 0; --bit) {
                const unsigned test = (Kt | (1u << bit)) >> bit;
                unsigned cnt = (unsigned)__builtin_popcountll(__ballot((cv[0] >> bit) == test));
                if (nc > 1) cnt += (unsigned)__builtin_popcountll(__ballot((cv[1] >> bit) == test));
                if (nc > 2) cnt += (unsigned)__builtin_popcountll(__ballot((cv[2] >> bit) == test));
                if (nc > 3) cnt += (unsigned)__builtin_popcountll(__ballot((cv[3] >> bit) == test));
                if (cnt >= rr) Kt |= (1u << bit); else rr -= cnt;
            }
            unsigned eqb = 0;
#pragma unroll
            for (int j = 0; j < 4; ++j) { if (j < nc) { const bool in = (64 * j + lane < (int)m); const bool gt = in && cv[j] > Kt, eq = in && cv[j] == Kt;
                const unsigned long long me = __ballot(eq); bool take = gt;
                if (me) { const unsigned er = eqb + lane_below(me); take = gt || (eq && er < rr); eqb += (unsigned)__builtin_popcountll(me); }
                const unsigned long long mt = __ballot(take);
                if (mt) { const unsigned pos = outb + lane_below(mt); if (take) so[pos] = ci[j]; outb += (unsigned)__builtin_popcountll(mt); } } }
        } else {
            for (int bit = 31; bit >= 0; --bit) {
                const unsigned test = (Kt | (1u << bit)) >> bit; unsigned cnt = 0;
                for (int idx = lane; idx < ng * 256; idx += 64) { const float v = row[idx]; int bin = (int)fmaf(v, scale, off); bin = bin < 0 ? 0 : (bin > 255 ? 255 : bin);
                    const bool pr = ((unsigned)bin == bstar) && ((f2key(v) >> bit) == test); cnt += (unsigned)__builtin_popcountll(__ballot(pr)); }
                if (cnt >= rr) Kt |= (1u << bit); else rr -= cnt;
            }
            unsigned eqb = 0;
            for (int idx = lane; idx < ng * 256; idx += 64) { const float v = row[idx]; int bin = (int)fmaf(v, scale, off); bin = bin < 0 ? 0 : (bin > 255 ? 255 : bin);
                const unsigned k = f2key(v); const bool inb = ((unsigned)bin == bstar); const bool gt = inb && k > Kt, eq = inb && k == Kt;
                const unsigned long long me = __ballot(eq); bool take = gt;
                if (me) { const unsigned er = eqb + lane_below(me); take = gt || (eq && er < rr); eqb += (unsigned)__builtin_popcountll(me); }
                const unsigned long long mt = __ballot(take);
                if (mt) { const unsigned pos = outb + lane_below(mt); if (take) so[pos] = (unsigned short)idx; outb += (unsigned)__builtin_popcountll(mt); } }
        }
    }
    __syncthreads();
    ACC_ADD(2);
}

typedef unsigned short u16x4 __attribute__((ext_vector_type(4)));
typedef unsigned short u16x8 __attribute__((ext_vector_type(8)));
__device__ __forceinline__ void attn8_task(const Params& p, unsigned char* smem, int part, int o) {
    const int tid = opaque_tid(), wid = __builtin_amdgcn_readfirstlane(tid >> 6), lane = tid & 63, kg = lane >> 4, fr = lane & 15;
    const int b = part >> 1, g = part & 1;
    unsigned char* vl = smem + wid * 17408;
    LAS unsigned char* vll = (LAS unsigned char*)vl;
    const char* akb = (const char*)(p.ws + OFF_AK) + (size_t)b * NT * 256 + g * 128;
    const char* avb = (const char*)(p.ws + OFF_AV) + (size_t)b * NT * 256 + g * 128;
    typedef long i64x2 __attribute__((ext_vector_type(2)));
    constexpr int NQW = 1;
    const int tq0 = 8 * NQW * o + NQW * wid;
    u16x4 kix[4], kixn[4];
#define AT_LOADI(tt, KI) do { const unsigned short* sel_ = (const unsigned short*)(p.ws + OFF_SEL) + ((size_t)b * NT + (tt)) * 256; \
        _Pragma("unroll") for (int c = 0; c < 4; ++c) KI[c] = *(const u16x4*)(sel_ + 64 * c + 4 * fr); } while (0)
    AT_LOADI(tq0, kix);
#pragma unroll 1
    for (int qi = 0; qi < NQW; ++qi) {
    const int t = tq0 + qi; const int bt = b * NT + t; const int nvalid = (t + 1) < 256 ? (t + 1) : 256;
    const unsigned short* sel = (const unsigned short*)(p.ws + OFF_SEL) + (size_t)bt * 256;
    long Qf[4];
    { const char* qp_ = (const char*)(p.ws + OFF_AQ) + (size_t)bt * 1024 + (4 * g + (fr & 3)) * 128 + kg * 32; const i64x2 q0 = *(const i64x2*)qp_, q1 = *(const i64x2*)(qp_ + 16);
      Qf[0] = fr < 4 ? q0[0] : 0l; Qf[1] = fr < 4 ? q0[1] : 0l; Qf[2] = fr < 4 ? q1[0] : 0l; Qf[3] = fr < 4 ? q1[1] : 0l; }
    f32x4 lg[16];
    unsigned char* kl = vl + 8192; LAS unsigned char* kll = (LAS unsigned char*)kl;
    u16x8 IX[4];
#pragma unroll
    for (int c = 0; c < 4; ++c) IX[c] = *(const u16x8*)(sel + 64 * c + 8 * (lane >> 3));
#define AT_GATHER(Rx, base, c) do { _Pragma("unroll") for (int it = 0; it < 8; ++it) Rx[it] = *(const u32x4*)((base) + (unsigned)IX[c][it] * 256u + 16u * (unsigned)(lane & 7)); } while (0)
#define AT_STOREK(KRx) do { _Pragma("unroll") for (int it = 0; it < 8; ++it) { const int r = 8 * (lane >> 3) + it; const int fk = (r >> 2) & 7; \
        *(u32x4*)(kl + r * 128 + (((lane & 7) ^ fk) << 4)) = KRx[it]; } } while (0)
#define AT_READK(Kx) do { _Pragma("unroll") for (int ii = 0; ii < 4; ++ii) { const int r = 4 * fr + ii; const int fk = fr & 7; \
        const i64x2 t0 = *(const LAS i64x2*)(kll + r * 128 + (((2 * kg) ^ fk) << 4)), t1 = *(const LAS i64x2*)(kll + r * 128 + (((2 * kg + 1) ^ fk) << 4)); \
        Kx[ii][0] = t0[0]; Kx[ii][1] = t0[1]; Kx[ii][2] = t1[0]; Kx[ii][3] = t1[1]; } } while (0)
#define AT_MMAK(Kx, c) do { _Pragma("unroll") for (int ii = 0; ii < 4; ++ii) { f32x4 a = (f32x4){0.f, 0.f, 0.f, 0.f}; \
        _Pragma("unroll") for (int s = 0; s < 4; ++s) a = __builtin_amdgcn_mfma_f32_16x16x32_fp8_fp8(Kx[ii][s], Qf[s], a, 0, 0, 0); lg[4 * (c) + ii] = a; } } while (0)
    u32x4 R0[8], R1[8], R2[8];
    {
        long Kf[4][4];
        AT_GATHER(R0, akb, 0); AT_GATHER(R1, akb, 1); AT_GATHER(R2, akb, 2);
        AT_STOREK(R0); AT_READK(Kf); AT_GATHER(R0, akb, 3); AT_MMAK(Kf, 0);
        AT_STOREK(R1); AT_READK(Kf); AT_GATHER(R1, avb, 0); AT_MMAK(Kf, 1);
        AT_STOREK(R2); AT_READK(Kf); AT_GATHER(R2, avb, 1); AT_MMAK(Kf, 2);
        AT_STOREK(R0); AT_READK(Kf); AT_GATHER(R0, avb, 2); AT_MMAK(Kf, 3);
    }
#define DPP_F(oldv, srcv, ctrl, bank) __builtin_bit_cast(float, __builtin_amdgcn_update_dpp(__builtin_bit_cast(int, (float)(oldv)), __builtin_bit_cast(int, (float)(srcv)), (ctrl), 0xF, (bank), false))
    float val[4][4];
#pragma unroll
    for (int ii = 0; ii < 4; ++ii)
#pragma unroll
        for (int r = 0; r < 4; ++r) { float v = lg[ii][r];
            v = DPP_F(v, lg[4 + ii][r], 0x114, 0x2); v = DPP_F(v, lg[8 + ii][r], 0x118, 0x4); v = DPP_F(v, lg[12 + ii][r], 0x11C, 0x8); val[ii][r] = v; }
    const int cj = fr >> 2;
    float m = -INFINITY;
#pragma unroll
    for (int ii = 0; ii < 4; ++ii)
#pragma unroll
        for (int r = 0; r < 4; ++r) { const int slot = 64 * cj + 16 * kg + 4 * r + ii; const float v = (slot < nvalid) ? val[ii][r] * (0.08838834764831845f * 1.4426950408889634f) : -INFINITY; val[ii][r] = v; m = fmaxf(m, v); }
    m = fmaxf(m, __shfl_xor(m, 4)); m = fmaxf(m, __shfl_xor(m, 8)); m = fmaxf(m, __shfl_xor(m, 16)); m = fmaxf(m, __shfl_xor(m, 32));
    float sum = 0.f;
#pragma unroll
    for (int ii = 0; ii < 4; ++ii)
#pragma unroll
        for (int r = 0; r < 4; ++r) { const float e = __builtin_amdgcn_exp2f(val[ii][r] - m); val[ii][r] = e; sum += e; }
    sum += __shfl_xor(sum, 4); sum += __shfl_xor(sum, 8); sum += __shfl_xor(sum, 16); sum += __shfl_xor(sum, 32);
    const float pscale = __builtin_amdgcn_rcpf(sum) * 256.0f;
    int pl[2][2];
#pragma unroll
    for (int ipl = 0; ipl < 2; ++ipl) { int w0 = 0, w1 = 0;
        w0 = __builtin_amdgcn_cvt_pk_fp8_f32(val[2 * ipl][0] * pscale, val[2 * ipl][1] * pscale, w0, false); w0 = __builtin_amdgcn_cvt_pk_fp8_f32(val[2 * ipl][2] * pscale, val[2 * ipl][3] * pscale, w0, true);
        w1 = __builtin_amdgcn_cvt_pk_fp8_f32(val[2 * ipl + 1][0] * pscale, val[2 * ipl + 1][1] * pscale, w1, false); w1 = __builtin_amdgcn_cvt_pk_fp8_f32(val[2 * ipl + 1][2] * pscale, val[2 * ipl + 1][3] * pscale, w1, true);
        pl[ipl][0] = w0; pl[ipl][1] = w1; }
    long Pf[8];
#pragma unroll
    for (int ipl = 0; ipl < 2; ++ipl) {
        Pf[ipl] = (long)(((unsigned long long)(unsigned)pl[ipl][1] << 32) | (unsigned long long)(unsigned)pl[ipl][0]);
#define PF_GATHER(c, ctrl) do { const int lo_ = __builtin_amdgcn_update_dpp(0, pl[ipl][0], ctrl, 0xF, 0x1, false), hi_ = __builtin_amdgcn_update_dpp(0, pl[ipl][1], ctrl, 0xF, 0x1, false); \
            Pf[2 * (c) + ipl] = (long)(((unsigned long long)(unsigned)hi_ << 32) | (unsigned long long)(unsigned)lo_); } while (0)
        PF_GATHER(1, 0x104); PF_GATHER(2, 0x108); PF_GATHER(3, 0x10C);
#undef PF_GATHER
    }
#undef DPP_F
    f32x4 O[8];
#pragma unroll
    for (int ct = 0; ct < 8; ++ct) O[ct] = (f32x4){0.f, 0.f, 0.f, 0.f};
    if (qi < NQW - 1) AT_LOADI(t + 1, kixn);
    const h16x8 gate = *(const h16x8*)((const h16*)(p.ws + OFF_AZ) + (size_t)bt * 1024 + (4 * g) * 128 + 8 * lane);
    const int q4 = fr >> 2, pp = fr & 3;
    typedef int v2i_t __attribute__((__vector_size__(2 * sizeof(int))));
#define AT_STOREV(Vx) do { _Pragma("unroll") for (int it = 0; it < 8; ++it) { const int r = 8 * (lane >> 3) + it; const int fk = ((r >> 2) & 3) | (((r >> 4) & 1) << 2); \
        *(u32x4*)(vl + r * 128 + (((lane & 7) ^ fk) << 4)) = Vx[it]; } } while (0)
#define AT_PV(c) do { _Pragma("unroll") for (int ipl = 0; ipl < 2; ++ipl) { const int qq = fr >> 1; const int r = 16 * kg + 4 * (qq & 3) + 2 * ipl + (qq >> 2); const int fk = ((r >> 2) & 3) | (((r >> 4) & 1) << 2); \
        _Pragma("unroll") for (int ct = 0; ct < 8; ++ct) { const LAS unsigned char* a0 = vll + r * 128 + ((ct ^ fk) << 4) + (fr & 1) * 8; \
            const v2i_t bv = __builtin_amdgcn_ds_read_tr8_b64_v2i32((LAS v2i_t*)a0); \
            O[ct] = __builtin_amdgcn_mfma_f32_16x16x32_fp8_fp8(Pf[2 * (c) + ipl], __builtin_bit_cast(long, bv), O[ct], 0, 0, 0); } } } while (0)
    AT_STOREV(R1); AT_GATHER(R1, avb, 3); AT_PV(0);
    AT_STOREV(R2); AT_PV(1);
    AT_STOREV(R0); AT_PV(2);
    AT_STOREV(R1); AT_PV(3);
#undef AT_GATHER
#undef AT_STOREK
#undef AT_READK
#undef AT_MMAK
#undef AT_STOREV
#undef AT_PV
    h16* ot = (h16*)vl;
    if (kg == 0) {
#pragma unroll
        for (int ct = 0; ct < 8; ++ct)
#pragma unroll
            for (int r = 0; r < 4; ++r) ot[r * 128 + 16 * ct + fr] = (h16)O[ct][r];
    }
    {
        const h16x8 ov = *(const h16x8*)(ot + 8 * lane);
        float rs[8];
#pragma unroll
        for (int j = 0; j < 8; ++j) rs[j] = (float)ov[j] * (float)gate[j] * (16.0f / 256.0f);
        int w0 = 0, w1 = 0;
        w0 = __builtin_amdgcn_cvt_pk_fp8_f32(rs[0], rs[1], w0, false); w0 = __builtin_amdgcn_cvt_pk_fp8_f32(rs[2], rs[3], w0, true);
        w1 = __builtin_amdgcn_cvt_pk_fp8_f32(rs[4], rs[5], w1, false); w1 = __builtin_amdgcn_cvt_pk_fp8_f32(rs[6], rs[7], w1, true);
        typedef int i32x2q __attribute__((ext_vector_type(2)));
        *(i32x2q*)(p.ws + OFF_OMIX + (size_t)bt * 3072 + 2048 + (4 * g) * 128 + 8 * lane) = (i32x2q){w0, w1};
    }
#pragma unroll
    for (int c = 0; c < 4; ++c) kix[c] = kixn[c];
    }
#undef AT_LOADI
}

__device__ __forceinline__ void phase5(const Params& p) {
    const int tid = opaque_tid(), wid = tid >> 6, lane = tid & 63;
    const int gw = blockIdx.x * 8 + wid, nw = gridDim.x * 8;
    const float* rowss = (const float*)(p.ws + OFF_ROWSS);
    for (int row = gw; row < BT; row += nw) {
        const float r = 1.0f / sqrtf(rowss[row] * (1.0f / DM) + EPS);
        f32x4* o = (f32x4*)(p.out + (size_t)row * DM);
        float eadd = 0.f;
        if ((TS_A >= 0 || TS_ACC >= 0) && row < 164) { const unsigned* ts = (const unsigned*)(p.ws + OFF_CTRL + 8192); const float tus = (TS_ACC >= 0) ? (float)ts[16 + (TS_ACC >= 0 ? TS_ACC : 0)] * (0.01f / 256.0f) : (float)(ts[TS_B >= 0 ? TS_B : 0] - ts[TS_A >= 0 ? TS_A : 0]) * 0.01f; eadd = sqrtf(tus * 1e-5f); }
#pragma unroll
        for (int i = 0; i < 8; ++i) { const f32x4 g = ((const f32x4*)p.final_g)[lane + 64 * i]; f32x4 v = o[lane + 64 * i]; v = v * r * g + eadd; o[lane + 64 * i] = v; }
    }
}

#define XB_TMO      128
#define XB_XCNT(j)  (256  + 64 * (j))
#define XB_XSUB(j)  (1280 + 64 * (j))
#define XB_XGEN(j)  (2304 + 64 * (j))
#define XB_TOP      3328
#define XB_TOPGEN   3392
#define XCD_BAR_WORDS 3456
#define XB_SPIN_CAP (1u << 18)

__device__ __forceinline__ unsigned xb_ld(unsigned* p)              { return __hip_atomic_load(p, __ATOMIC_RELAXED, __HIP_MEMORY_SCOPE_AGENT); }
__device__ __forceinline__ unsigned xb_add(unsigned* p, unsigned v) { return __hip_atomic_fetch_add(p, v, __ATOMIC_RELAXED, __HIP_MEMORY_SCOPE_AGENT); }
__device__ __forceinline__ unsigned xb_xcc_id() { return (unsigned)__builtin_amdgcn_s_getreg((3 << 11) | 20) & 0xFu; }
#define XB_SPIN(cond, bar) do { unsigned _sp = 0; while (cond) { __builtin_amdgcn_s_sleep(1); \
    if ((++_sp & 255u) == 0u) { if (xb_ld(&(bar)[XB_TMO])) break; if (_sp > XB_SPIN_CAP) { atomicAdd(&(bar)[XB_TMO], 1u); break; } } } } while (0)

struct XcdBarrier {
    unsigned* bar; unsigned x;
    volatile LAS unsigned* st;
};

__device__ __forceinline__ XcdBarrier xcd_barrier_post(unsigned* bar, volatile LAS unsigned* st) {
    XcdBarrier b; b.bar = bar; b.x = xb_xcc_id(); b.st = st;
    if (threadIdx.x == 0) (void)xb_add(&bar[XB_XCNT(b.x)], 1u);
    return b;
}
__device__ __forceinline__ void xcd_barrier_complete(unsigned* bar, unsigned x, unsigned& nloc, unsigned& nx) {
    const unsigned G = gridDim.x * gridDim.y * gridDim.z;
    unsigned sum, cnt, mine, sp = 0u;
    for (;;) {
        sum = 0u; cnt = 0u; mine = 0u;
#pragma unroll
        for (unsigned j = 0; j < 16; ++j) { const unsigned c = xb_ld(&bar[XB_XCNT(j)]); sum += c; cnt += (c > 0u) ? 1u : 0u; mine = (j == x) ? c : mine; }
        if (sum == G) break;
        __builtin_amdgcn_s_sleep(1);
        if ((++sp & 255u) == 0u) { if (xb_ld(&bar[XB_TMO])) break; if (sp > XB_SPIN_CAP) { atomicAdd(&bar[XB_TMO], 1u); break; } }
    }
    nloc = mine > 0u ? mine : 1u; nx = cnt > 0u ? cnt : 1u;
}

__device__ __forceinline__ void xcd_barrier(const XcdBarrier& b) {
    asm volatile("s_waitcnt vmcnt(0)" ::: "memory");
    __syncthreads();
    if (threadIdx.x == 0) {
        unsigned* bar = b.bar;
        __builtin_amdgcn_s_waitcnt(0);
        unsigned nloc = b.st[0], nx = b.st[1];
        if (nloc == 0u) { xcd_barrier_complete(bar, b.x, nloc, nx); b.st[0] = nloc; b.st[1] = nx; }
        const unsigned old = xb_add(&bar[XB_XSUB(b.x)], 1u);
        const unsigned gen = old / nloc;
        if (old + 1u == (gen + 1u) * nloc) {
            __builtin_amdgcn_fence(__ATOMIC_RELEASE, "agent");
            asm volatile("s_waitcnt vmcnt(0)" ::: "memory");
            const unsigned og = xb_add(&bar[XB_TOP], 1u);
            const unsigned tg = og / nx;
            if (og + 1u == (tg + 1u) * nx) xb_add(&bar[XB_TOPGEN], 1u);
            else XB_SPIN(xb_ld(&bar[XB_TOPGEN]) == tg, bar);
            __builtin_amdgcn_fence(__ATOMIC_ACQUIRE, "agent");
            xb_add(&bar[XB_XGEN(b.x)], 1u);
            asm volatile("s_waitcnt vmcnt(0)" ::: "memory");
        } else {
            XB_SPIN(xb_ld(&bar[XB_XGEN(b.x)]) == gen, bar);
            __builtin_amdgcn_fence(__ATOMIC_ACQUIRE, "agent");
            asm volatile("s_waitcnt vmcnt(0)" ::: "memory");
        }
    }
    __syncthreads();
}


template <int LO, int HI>
__global__ void __launch_bounds__(512, 2) k_phases(Params p) {
    extern __shared__ __attribute__((aligned(16))) unsigned char smem[];
#define IN(k) (LO <= (k) && (k) < HI)
#define SEAM(k) do { if constexpr (IN(k) && IN((k) + 1)) { xcd_barrier(xbar); if (TS_A >= 0 && blockIdx.x == 0 && threadIdx.x == 0) ((unsigned*)(p.ws + OFF_CTRL + 8192))[(k) + 1] = (unsigned)__builtin_amdgcn_s_memrealtime(); } } while (0)
    XcdBarrier xbar; xbar.bar = nullptr; xbar.x = 0; xbar.st = nullptr;
    if constexpr (HI - LO > 1) {
        volatile LAS unsigned* stw = (volatile LAS unsigned*)((LAS unsigned char*)smem + LDS_BYTES - 48);
        if (threadIdx.x < 4) stw[threadIdx.x] = 0u;
        __syncthreads();
        xbar = xcd_barrier_post((unsigned*)(p.ws + OFF_CTRL + 16384), stw);
    }
    if (TS_A >= 0 && blockIdx.x == 0 && threadIdx.x == 0) ((unsigned*)(p.ws + OFF_CTRL + 8192))[0] = (unsigned)__builtin_amdgcn_s_memrealtime();
    if constexpr (IN(0)) { for (int rep = 0; rep < NREP(0); ++rep) phase0(p, smem); }
    SEAM(0);
    if constexpr (IN(1)) for (int rep = 0; rep < NREP(1); ++rep) {
        EpiIn E{p.ws, p.a_log, p.dt_bias, p.pos};
        {
            pg8::Gemm g{(const h16*)(p.ws + OFF_H), (const h16*)(p.ws + OFF_WT), BT, NPAD, DM};
            OrderF16 S; S.init(BT, 21 * 256, gridDim.x, blockIdx.x);
            pg8::gemm_phase<EpiIn, OrderF16>((LAS unsigned char*)smem, g, S, E);
        }
        {
            pg8::Gemm g{(const h16*)(p.ws + OFF_H8), (const h16*)(p.ws + OFF_WT8 - (size_t)16 * 256 * 2048), BT, 2560, DM};
            OrderF8 S; S.G = gridDim.x; S.c = blockIdx.x;
            pg8::gemm_phase<EpiIn, OrderF8, true, true>((LAS unsigned char*)smem, g, S, E);
        }
    }
    SEAM(1);
    if constexpr (IN(2)) for (int rep = 0; rep < NREP(2); ++rep) {
        {
            unsigned* qctr = (unsigned*)(p.ws + OFF_CTRL);
            volatile unsigned* lds_t = (volatile unsigned*)(smem + LDS_BYTES - 16);
            __syncthreads();
            if (threadIdx.x == 0) lds_t[0] = atomicAdd(qctr + 0 + 16 * rep, 1u);
            __syncthreads();
            unsigned o = lds_t[0];
            while (o < 1024u + 2048u) {
                unsigned nxt = 0u;
                if (threadIdx.x == 0) nxt = atomicAdd(qctr + 0 + 16 * rep, 1u);
                if (o < 1024u) { ACC_T0(); gdn_prep_pair(p, smem, (int)o); __syncthreads(); ACC_ADD(0); }
                else { const unsigned o2 = o - 1024u; idx8_task(p, smem, (int)(o2 & 3u), 511 - (int)(o2 >> 2)); }
                __syncthreads();
                if (threadIdx.x == 0) lds_t[0] = nxt;
                __syncthreads();
                o = lds_t[0];
            }
        }
    }
    SEAM(2);
    if constexpr (IN(3)) for (int rep = 0; rep < NREP(3); ++rep) {
        {
            unsigned* qctr = (unsigned*)(p.ws + OFF_CTRL);
            volatile unsigned* lds_t = (volatile unsigned*)(smem + LDS_BYTES - 16);
            volatile unsigned* lds_c = (volatile unsigned*)(smem + LDS_BYTES - 192);
            const int myx = (int)(xb_xcc_id() & 7u);
            for (int pass = 0; pass < 2; ++pass) {
                if (pass == 1) { __syncthreads(); if (threadIdx.x < 8) lds_c[8 + threadIdx.x] = __hip_atomic_load(qctr + 64 + 16 * rep + threadIdx.x, __ATOMIC_RELAXED, __HIP_MEMORY_SCOPE_AGENT); __syncthreads(); }
                const int nk = pass == 0 ? 1 : 8;
                for (int k = 0; k < nk; ++k) {
                    const int sp = (myx + k) & 7;
                    if (pass == 1 && lds_c[8 + sp] >= 4u) continue;
                    for (;;) {
                        __syncthreads();
                        if (threadIdx.x == 0) lds_t[0] = atomicAdd(qctr + 64 + 16 * rep + sp, 1u);
                        __syncthreads();
                        const unsigned o = lds_t[0];
                        if (o >= 4u) break;
                        { ACC_T0(); gdn_scan_task(p, smem, 4 * sp + (int)o); __syncthreads(); ACC_ADD(4); }
                        if (pass == 0) break;
                    }
                }
                if (pass == 0) for (int k = 0; k < 8; ++k) {
                    const int part = (myx + k) & 7;
                    if (k == 1) { __syncthreads(); if (threadIdx.x < 8) lds_c[threadIdx.x] = __hip_atomic_load(qctr + 128 + 16 * rep + threadIdx.x, __ATOMIC_RELAXED, __HIP_MEMORY_SCOPE_AGENT); __syncthreads(); }
                    if (k >= 1 && lds_c[part] >= 512u) continue;
                    __syncthreads();
                    if (threadIdx.x == 0) lds_t[0] = atomicAdd(qctr + 128 + 16 * rep + part, 1u);
                    __syncthreads();
                    unsigned a = lds_t[0];
                    while (a < 512u) {
                        unsigned nxt = 0u;
                        if (threadIdx.x == 0) nxt = atomicAdd(qctr + 128 + 16 * rep + part, 1u);
                        { ACC_T0(); attn8_task(p, smem, part, (int)a); __syncthreads(); ACC_ADD(3); }
                        __syncthreads();
                        if (threadIdx.x == 0) lds_t[0] = nxt;
                        __syncthreads();
                        a = lds_t[0];
                    }
                }
            }
        }
    }
    SEAM(3);
    const bool fuse_norm = (gridDim.x == 256) && (TS_A < 0) && (TS_ACC < 0);
    if constexpr (IN(4)) {
        pg8::Gemm g{(const h16*)(p.ws + OFF_OMIX), (const h16*)(p.ws + OFF_WOT), BT, DM, DM};
        if (fuse_norm) {
            PanelOrder S; S.c = blockIdx.x;
            EpiOutNorm E{p.x, p.out, (float*)(p.ws + OFF_ROWSS), (unsigned*)(p.ws + OFF_CTRL + 32768), p.final_g};
            pg8::gemm_phase<EpiOutNorm, PanelOrder, true, false, true, 0x79797979u, 0x7B7B7B7Bu>((LAS unsigned char*)smem, g, S, E);
        } else {
            pg8::StaticOrder S; S.init(BT, DM, gridDim.x, blockIdx.x);
            EpiOut E{p.x, p.out, (float*)(p.ws + OFF_ROWSS)};
            pg8::gemm_phase<EpiOut, pg8::StaticOrder, true, false, true, 0x79797979u, 0x7B7B7B7Bu>((LAS unsigned char*)smem, g, S, E);
        }
    }
    if (fuse_norm) return;
    SEAM(4);
    if constexpr (IN(5)) { phase5(p); }
#undef IN
#undef SEAM
}

template <int LO, int HI> static void launch_range(const Params& p, int grid, hipStream_t stream, bool coop) {
    static bool attr = false;
    if (!attr) { hipFuncSetAttribute((const void*)k_phases<LO, HI>, hipFuncAttributeMaxDynamicSharedMemorySize, LDS_BYTES); attr = true; }
    if (coop) {
        Params pp = p; void* args[] = {&pp};
        hipError_t e = hipLaunchCooperativeKernel((const void*)k_phases<LO, HI>, dim3(grid), dim3(512), args, LDS_BYTES, stream);
        if (e != hipSuccess) fprintf(stderr, "cooperative launch failed: %s (grid %d)\n", hipGetErrorString(e), grid);
    } else {
        hipLaunchKernelGGL((k_phases<LO, HI>), dim3(grid), dim3(512), LDS_BYTES, stream, p);
    }
}

extern "C" void kernel_launch(void* const* d_in, const int* in_sizes, int n_in, void* d_out, int out_size, void* d_ws, size_t ws_size, hipStream_t stream) {
    if (n_in != 10 || in_sizes[0] != BT * DM || out_size != BT * DM || ws_size < WS_END) {
        fprintf(stderr, "kernel_launch: unexpected shapes (n_in %d in0 %d out %d ws %zu need %zu)\n", n_in, n_in > 0 ? in_sizes[0] : -1, out_size, ws_size, (size_t)WS_END); return; }
    static int grid = 0;
    if (!grid) {
        int dev = 0, cus = 0, per_cu = 0; hipGetDevice(&dev); hipDeviceGetAttribute(&cus, hipDeviceAttributeMultiprocessorCount, dev);
#if FUSED
        hipFuncSetAttribute((const void*)k_phases<0, 6>, hipFuncAttributeMaxDynamicSharedMemorySize, LDS_BYTES);
        hipOccupancyMaxActiveBlocksPerMultiprocessor(&per_cu, (const void*)k_phases<0, 6>, 512, LDS_BYTES);
#else
        per_cu = 1;
#endif
        if (per_cu < 1) per_cu = 1; if (per_cu > 1) per_cu = 1;
        grid = cus * per_cu;
    }
    Params p{};
    p.x = (const float*)d_in[0]; p.pos = (const int*)d_in[1]; p.attn_g = (const float*)d_in[2]; p.w_in = (const float*)d_in[3]; p.conv_w = (const float*)d_in[4];
    p.a_log = (const float*)d_in[5]; p.dt_bias = (const float*)d_in[6]; p.gdn_norm_g = (const float*)d_in[7]; p.w_out = (const float*)d_in[8]; p.final_g = (const float*)d_in[9];
    p.out = (float*)d_out; p.ws = (unsigned char*)d_ws;
    hipMemsetAsync((char*)d_ws + OFF_CTRL, 0, CTL_ZERO_BYTES, stream);
#if FUSED
    launch_range<0, 6>(p, grid, stream, false);
#else
    launch_range<0, 1>(p, grid, stream, false);
    launch_range<1, 2>(p, grid, stream, false);
    launch_range<2, 3>(p, grid, stream, false);
    launch_range<3, 4>(p, grid, stream, false);
    launch_range<4, 5>(p, grid, stream, false);
    launch_range<5, 6>(p, grid, stream, false);
#endif
}
```

```cpp
#include <hip/hip_runtime.h>
#include <hip/hip_cooperative_groups.h>
#include <cstdio>
#include <cstdint>
namespace cg = cooperative_groups;

#ifndef FUSED
#define FUSED 1
#endif
#ifndef REPEAT_PHASE
#define REPEAT_PHASE -1
#endif
#define NREP(k) ((REPEAT_PHASE == (k)) ? 2 : 1)
#ifndef TS_A
#define TS_A -1
#endif
#ifndef TS_ACC
#define TS_ACC -1
#endif
#define ACC_T0() unsigned acc_t0_ = 0; if (TS_ACC >= 0 && threadIdx.x == 0) acc_t0_ = (unsigned)__builtin_amdgcn_s_memrealtime()
#define ACC_ADD(k) do { if (TS_ACC >= 0 && threadIdx.x == 0) { const unsigned t1_ = (unsigned)__builtin_amdgcn_s_memrealtime(); atomicAdd((unsigned*)(p.ws + OFF_CTRL + 8192) + 16 + (k), t1_ - acc_t0_); acc_t0_ = t1_; } } while (0)
#ifndef TS_B
#define TS_B -1
#endif

#define LAS __attribute__((address_space(3)))
typedef _Float16 h16;
typedef h16 h16x8 __attribute__((ext_vector_type(8)));
typedef h16 h16x4 __attribute__((ext_vector_type(4)));
typedef h16 h16x2 __attribute__((ext_vector_type(2)));
typedef float f32x4 __attribute__((ext_vector_type(4)));
typedef float f32x2 __attribute__((ext_vector_type(2)));
typedef unsigned u32x4 __attribute__((ext_vector_type(4)));

constexpr int NB = 4, NT = 4096, DM = 2048, BT = NB * NT;
constexpr int IN_COLS = 7776, NPAD = 7936;
constexpr float EPS = 1e-6f;
constexpr int LDS_BYTES = 155648;

constexpr size_t MB = 1024 * 1024;
constexpr size_t OFF_CTRL = 0;
constexpr size_t OFF_ROWSS = 65536;
constexpr size_t CTL_ZERO_BYTES = 65536 + (size_t)BT * 4;
constexpr size_t OFF_H = 1 * MB;
constexpr size_t OFF_OMIX = OFF_H;
constexpr size_t OFF_WT = OFF_H + 64 * MB;
constexpr size_t OFF_WOT = OFF_WT + (size_t)NPAD * 2048 * 2;
constexpr size_t OFF_QKVR = OFF_WOT + 8 * MB;
constexpr size_t OFF_GZ = OFF_QKVR + (size_t)BT * 3072 * 2;
constexpr size_t OFF_AQ = OFF_GZ + 32 * MB;
constexpr size_t OFF_AK = OFF_AQ + 32 * MB;
constexpr size_t OFF_AV = OFF_AK + 8 * MB;
constexpr size_t OFF_AZ = OFF_AV + 8 * MB;
constexpr size_t OFF_IQ = OFF_AZ + 32 * MB;
constexpr size_t OFF_IK = OFF_IQ + 32 * MB;
constexpr size_t OFF_GB = OFF_IK + 2 * MB;
constexpr size_t OFF_IW = OFF_GB + 1 * MB;
constexpr size_t OFF_COS = OFF_IW + 1 * MB;
constexpr size_t OFF_SIN = OFF_COS + 2 * MB;
constexpr size_t OFF_SEL = OFF_SIN + 2 * MB;
constexpr size_t OFF_REC = OFF_SEL + 8 * MB;
constexpr size_t OFF_H8 = OFF_REC;
constexpr size_t OFF_WT8 = OFF_REC + 32 * MB;
constexpr size_t WS_END = OFF_REC + (size_t)2048 * 74752;

struct Params {
    const float* x; const int* pos; const float* attn_g; const float* w_in; const float* conv_w; const float* a_log;
    const float* dt_bias; const float* gdn_norm_g; const float* w_out; const float* final_g; float* out; unsigned char* ws;
};

__device__ __forceinline__ float wave_sum(float v) {
#pragma unroll
    for (int o = 1; o < 64; o <<= 1) v += __shfl_xor(v, o);
    return v;
}
__device__ __forceinline__ float wave_max(float v) {
#pragma unroll
    for (int o = 1; o < 64; o <<= 1) v = fmaxf(v, __shfl_xor(v, o));
    return v;
}
__device__ __forceinline__ int opaque_tid() { int t = threadIdx.x; asm volatile("" : "+v"(t)); return t; }
__device__ __forceinline__ float silu_f(float x) { return x * __builtin_amdgcn_rcpf(1.0f + __builtin_amdgcn_exp2f(-1.4426950408889634f * x)); }

namespace pg8 {
constexpr int BM = 256, BK = 64, HALF = 128, HTB = HALF * BK * 2, STAGE_BYTES = 8 * HTB, NXCD = 8, WGM = 8;
__host__ __device__ __forceinline__ int lds_byte(int r, int c) { const int st = (r >> 4) * 2 + (c >> 5), rr = r & 15, cc = c & 31, ob = rr * 64 + cc * 2; return st * 1024 + (ob ^ (((ob >> 9) & 1) << 5)); }
__host__ __device__ __forceinline__ void stage_rc(int b, int& R, int& C) { const int st = b / 1024, sb = b % 1024, swz = sb ^ (((sb >> 9) & 1) << 5); R = (st >> 1) * 16 + swz / 64; C = (st & 1) * 32 + (swz % 64) / 2; }
__host__ __device__ __forceinline__ int perm32(int rho) { const int n = rho >> 4, i = rho & 15; return 8 * (i >> 2) + 4 * n + (i & 3); }
struct Unit { int pm, pn; };
struct Gemm { const h16* A; const h16* Bt; int M, N, K; };
struct StaticOrder {
    int nM, nN, nwg, G, c;
    __host__ __device__ void init(int M, int N, int G_, int c_) { nM = M / BM; nN = N / BM; nwg = nM * nN; G = G_; c = c_; }
    __host__ __device__ bool next(int i, Unit& u) const {
        const long L = (long)i * G + c; if (L >= nwg) return false;
        int wgid = (int)L; { const int q = nwg / NXCD, r = nwg % NXCD, xcd = wgid % NXCD, off = wgid / NXCD; wgid = (xcd < r ? xcd * (q + 1) : r * (q + 1) + (xcd - r) * q) + off; }
        const int nig = WGM * nN, gid = wgid / nig, fm = gid * WGM, gsz = (nM - fm) < WGM ? (nM - fm) : WGM;
        u.pm = fm + ((wgid % nig) % gsz); u.pn = (wgid % nig) / gsz; return true;
    }
    __device__ __forceinline__ void a_ready(const Unit&) const {}
    __device__ __forceinline__ void done(const Unit&) const {}
};

typedef int i32x8 __attribute__((ext_vector_type(8)));
template <class Epi, class Sched, bool SP2 = true, bool F8 = false, bool SPLIT = false, unsigned SCW = 0x7C7C7C7Cu, unsigned SCA = 0x7C7C7C7Cu>
__device__ __forceinline__ void gemm_phase(LAS unsigned char* lds, const Gemm g, const Sched& S, const Epi& E) {
    const int tid = opaque_tid(), wid = __builtin_amdgcn_readfirstlane(tid >> 6), lane = tid & 63, wr = wid >> 2, wc = wid & 3, fr = lane & 15, fq = lane >> 4;
    const int K = g.K;
    const int ESZ = F8 ? 1 : 2, RB = SPLIT ? 3072 : K * ESZ, nt = RB / 128;
    unsigned voffA[2], voffB[2];
#pragma unroll
    for (int i = 0; i < 2; ++i) { int R, C; stage_rc(tid * 16 + i * 8192, R, C); const int Rb = Epi::PERM ? ((R & ~31) + perm32(R & 31)) : R;
        voffA[i] = (unsigned)(R * RB + C * 2); voffB[i] = (unsigned)(Rb * RB + C * 2); }
    const size_t kstep = (size_t)(BK * 2);
    const size_t hstep = (size_t)HALF * RB;
    const size_t tstep = 2 * hstep;
    const unsigned ldsw = (unsigned)wid * 1024u;
    const int aoff = lds_byte(wr * 64 + fr, fq * 8), boff = lds_byte(wc * 32 + fr, fq * 8);
#define PG8_SA(b, h) (((b) * 2 + (h)) * HTB)
#define PG8_SB(b, h) ((4 + (b) * 2 + (h)) * HTB)
#define PG8_STAGE(bufoff, gbase, voff) do { _Pragma("unroll") for (int _i = 0; _i < 2; ++_i) \
        __builtin_amdgcn_global_load_lds((const unsigned*)((const char*)(gbase) + (voff)[_i]), (LAS unsigned*)(lds + (bufoff) + ldsw + _i * 8192), 16, 0, 0); } while (0)
#define PG8_LDA(dst, b, h) do { _Pragma("unroll") for (int m = 0; m < 4; ++m) _Pragma("unroll") for (int k = 0; k < 2; ++k) dst[m][k] = *(const LAS h16x8*)(lds + PG8_SA(b, h) + aoff + m * 2048 + k * 1024); } while (0)
#define PG8_LDB(dst, b, h) do { _Pragma("unroll") for (int n = 0; n < 2; ++n) _Pragma("unroll") for (int k = 0; k < 2; ++k) dst[n][k] = *(const LAS h16x8*)(lds + PG8_SB(b, h) + boff + n * 2048 + k * 1024); } while (0)
#define PG8_MMA8(ai, bj, At, Bt) do { __builtin_amdgcn_s_setprio(1); \
        _Pragma("unroll") for (int m = 0; m < 4; ++m) _Pragma("unroll") for (int n = 0; n < 2; ++n) { \
            const u32x4 b0_ = __builtin_bit_cast(u32x4, Bt[n][0]), b1_ = __builtin_bit_cast(u32x4, Bt[n][1]), a0_ = __builtin_bit_cast(u32x4, At[m][0]), a1_ = __builtin_bit_cast(u32x4, At[m][1]); \
            const i32x8 bw_ = (i32x8){(int)b0_[0], (int)b0_[1], (int)b0_[2], (int)b0_[3], (int)b1_[0], (int)b1_[1], (int)b1_[2], (int)b1_[3]}; \
            const i32x8 aw_ = (i32x8){(int)a0_[0], (int)a0_[1], (int)a0_[2], (int)a0_[3], (int)a1_[0], (int)a1_[1], (int)a1_[2], (int)a1_[3]}; \
            asm volatile("v_mfma_scale_f32_16x16x128_f8f6f4 %0, %1, %2, %0, %3, %4 op_sel_hi:[0,0,0]" : "+v"(acc[ai][bj][m][n]) : "v"(bw_), "v"(aw_), "v"(SCW), "v"(SCA)); } \
        __builtin_amdgcn_s_setprio(0); } while (0)
#define PG8_MMA16(ai, bj, At, Bt) do { __builtin_amdgcn_s_setprio(1); \
        _Pragma("unroll") for (int m = 0; m < 4; ++m) _Pragma("unroll") for (int n = 0; n < 2; ++n) _Pragma("unroll") for (int k = 0; k < 2; ++k) { \
            if constexpr (SPLIT) asm volatile("v_mfma_f32_16x16x32_f16 %0, %1, %2, %0" : "+v"(acc[ai][bj][m][n]) : "v"(Bt[n][k]), "v"(At[m][k]));     \
            else acc[ai][bj][m][n] = __builtin_amdgcn_mfma_f32_16x16x32_f16(Bt[n][k], At[m][k], acc[ai][bj][m][n], 0, 0, 0); } \
        __builtin_amdgcn_s_setprio(0); } while (0)
#define PG8_ITER(MMA) do { \
            PG8_LDB(B0, 0, 0); PG8_LDB(B1, 0, 1); PG8_SCHED; PG8_LDA(At, 0, 0); PG8_STAGE(PG8_SA(1, 1), a1 + hstep, voffA); \
            PG8_WAIT_V(8); PG8_WAIT_L(0); PG8_BAR; MMA(0, 0, At, B0); MMA(0, 1, At, B1); PG8_BAR; PG8_SCHED; \
            PG8_LDA(At, 0, 1); PG8_STAGE(PG8_SB(0, 0), b2, voffB); PG8_STAGE(PG8_SB(0, 1), b2 + hstep, voffB); PG8_STAGE(PG8_SA(0, 0), a2, voffA); \
            PG8_WAIT_V(8); PG8_WAIT_L(0); PG8_BAR; MMA(1, 0, At, B0); MMA(1, 1, At, B1); PG8_BAR; PG8_SCHED; \
            PG8_LDB(B0, 1, 0); PG8_LDB(B1, 1, 1); PG8_SCHED; PG8_LDA(At, 1, 0); PG8_STAGE(PG8_SA(0, 1), a2 + hstep, voffA); \
            PG8_WAIT_V(8); PG8_WAIT_L(0); PG8_BAR; MMA(0, 0, At, B0); MMA(0, 1, At, B1); PG8_BAR; PG8_SCHED; \
            PG8_LDA(At, 1, 1); PG8_STAGE(PG8_SB(1, 0), b3, voffB); PG8_STAGE(PG8_SB(1, 1), b3 + hstep, voffB); PG8_STAGE(PG8_SA(1, 0), a3, voffA); \
            PG8_WAIT_V(8); PG8_WAIT_L(0); PG8_BAR; MMA(1, 0, At, B0); MMA(1, 1, At, B1); PG8_BAR; PG8_SCHED; \
            } while (0)
#define PG8_MMA(ai, bj, At, Bt) PG8_MMA16(ai, bj, At, Bt)
#define PG8_WAIT_V(n) asm volatile("s_waitcnt vmcnt(" #n ")" ::: "memory")
#define PG8_WAIT_L(n) asm volatile("s_waitcnt lgkmcnt(" #n ")" ::: "memory")
#define PG8_BAR __builtin_amdgcn_s_barrier()
#define PG8_SCHED __builtin_amdgcn_sched_barrier(0)
    Unit cur, nxt; int ui = 0;
    if (!S.next(0, cur)) return;
    f32x4 acc[2][2][4][2];
#pragma unroll
    for (int a = 0; a < 2; ++a)
#pragma unroll
        for (int b = 0; b < 2; ++b)
#pragma unroll
            for (int m = 0; m < 4; ++m)
#pragma unroll
                for (int n = 0; n < 2; ++n) acc[a][b][m][n] = (f32x4){0.f, 0.f, 0.f, 0.f};
    h16x8 At[4][2], B0[2][2], B1[2][2];
    const char* cA = (const char*)g.A + (size_t)cur.pm * tstep; const char* cB = (const char*)g.Bt + (size_t)cur.pn * tstep;
    S.a_ready(cur);
    if constexpr (SP2) {
        PG8_STAGE(PG8_SB(0, 0), cB, voffB); PG8_STAGE(PG8_SB(0, 1), cB + hstep, voffB); PG8_STAGE(PG8_SA(0, 0), cA, voffA); PG8_STAGE(PG8_SA(0, 1), cA + hstep, voffA);
        if (wr == 1) PG8_BAR;
        PG8_WAIT_V(2); PG8_BAR;
        PG8_STAGE(PG8_SB(1, 0), cB + kstep, voffB); PG8_STAGE(PG8_SA(1, 0), cA + kstep, voffA); PG8_STAGE(PG8_SB(1, 1), cB + hstep + kstep, voffB);
        PG8_WAIT_V(6); PG8_BAR;
    } else {
    PG8_STAGE(PG8_SB(0, 0), cB, voffB); PG8_STAGE(PG8_SA(0, 0), cA, voffA); PG8_STAGE(PG8_SB(0, 1), cB + hstep, voffB); PG8_STAGE(PG8_SA(0, 1), cA + hstep, voffA);
    if (wr == 1) PG8_BAR;
    PG8_WAIT_V(4); PG8_BAR;
    PG8_STAGE(PG8_SB(1, 0), cB + kstep, voffB); PG8_STAGE(PG8_SA(1, 0), cA + kstep, voffA); PG8_STAGE(PG8_SB(1, 1), cB + hstep + kstep, voffB);
    PG8_WAIT_V(6); PG8_BAR;
    }
    for (;;) {
        const bool has_next = S.next(ui + 1, nxt);
        const char* nA = has_next ? (const char*)g.A + (size_t)nxt.pm * tstep : cA; const char* nB = has_next ? (const char*)g.Bt + (size_t)nxt.pn * tstep : cB;
#define PG8_PTRS const bool last = (t == nt - 2); const char* a1 = cA + (size_t)(t + 1) * kstep; const char* a2 = last ? nA : cA + (size_t)(t + 2) * kstep; const char* b2 = last ? nB : cB + (size_t)(t + 2) * kstep; const char* a3 = a2 + kstep; const char* b3 = b2 + kstep; if (last && has_next) S.a_ready(nxt);
        if constexpr (SPLIT) {
            for (int t = 0; t < 16; t += 2) { PG8_PTRS PG8_ITER(PG8_MMA16); }
            for (int t = 16; t < nt; t += 2) { PG8_PTRS PG8_ITER(PG8_MMA8); }
        } else
        for (int t = 0; t < nt; t += 2) {
            PG8_PTRS
            if constexpr (SP2) {
            if constexpr (F8) PG8_ITER(PG8_MMA8); else PG8_ITER(PG8_MMA16);
            } else {
            PG8_LDB(B0, 0, 0); PG8_SCHED; PG8_LDA(At, 0, 0); PG8_STAGE(PG8_SA(1, 1), a1 + hstep, voffA);
            PG8_WAIT_L(8); PG8_BAR; PG8_WAIT_L(0); PG8_MMA(0, 0, At, B0); PG8_BAR; PG8_SCHED;
            PG8_LDB(B1, 0, 1); PG8_STAGE(PG8_SB(0, 0), b2, voffB);
            PG8_BAR; PG8_WAIT_L(0); PG8_MMA(0, 1, At, B1); PG8_BAR;
            PG8_LDA(At, 0, 1); PG8_STAGE(PG8_SA(0, 0), a2, voffA);
            PG8_BAR; PG8_WAIT_L(0); PG8_MMA(1, 0, At, B0); PG8_BAR; PG8_SCHED;
            PG8_STAGE(PG8_SB(0, 1), b2 + hstep, voffB);
            PG8_WAIT_V(6); PG8_BAR; PG8_MMA(1, 1, At, B1); PG8_BAR;
            PG8_LDB(B0, 1, 0); PG8_SCHED; PG8_LDA(At, 1, 0); PG8_STAGE(PG8_SA(0, 1), a2 + hstep, voffA);
            PG8_WAIT_L(8); PG8_BAR; PG8_WAIT_L(0); PG8_MMA(0, 0, At, B0); PG8_BAR; PG8_SCHED;
            PG8_LDB(B1, 1, 1); PG8_STAGE(PG8_SB(1, 0), b3, voffB);
            PG8_BAR; PG8_WAIT_L(0); PG8_MMA(0, 1, At, B1); PG8_BAR;
            PG8_LDA(At, 1, 1); PG8_STAGE(PG8_SA(1, 0), a3, voffA);
            PG8_BAR; PG8_WAIT_L(0); PG8_MMA(1, 0, At, B0); PG8_BAR; PG8_SCHED;
            PG8_STAGE(PG8_SB(1, 1), b3 + hstep, voffB);
            PG8_WAIT_V(6); PG8_BAR; PG8_MMA(1, 1, At, B1); PG8_BAR;
            }
        }
        if (wr == 0) PG8_BAR;
        if constexpr (F8 || SPLIT) asm volatile("s_nop 15\n\ts_nop 15" ::: "memory");
        PG8_SCHED; { const int te = opaque_tid(), le = te & 63; E(acc, cur, wr, wc, le & 15, le >> 4); } S.done(cur);
        if (!has_next) break;
#pragma unroll
        for (int a = 0; a < 2; ++a)
#pragma unroll
            for (int b = 0; b < 2; ++b)
#pragma unroll
                for (int m = 0; m < 4; ++m)
#pragma unroll
                    for (int n = 0; n < 2; ++n) acc[a][b][m][n] = (f32x4){0.f, 0.f, 0.f, 0.f};
        cur = nxt; cA = nA; cB = nB; ++ui;
        if (wr == 1) PG8_BAR;
    }
    PG8_WAIT_V(0);
    PG8_BAR;
#undef PG8_SA
#undef PG8_SB
#undef PG8_STAGE
#undef PG8_LDA
#undef PG8_LDB
#undef PG8_MMA
#undef PG8_MMA8
#undef PG8_MMA16
#undef PG8_ITER
#undef PG8_PTRS
#undef PG8_WAIT_V
#undef PG8_WAIT_L
#undef PG8_BAR
#undef PG8_SCHED
}
}

struct OrderF16 : pg8::StaticOrder {
    __device__ __forceinline__ bool next(int i, pg8::Unit& u) const { if (!pg8::StaticOrder::next(i, u)) return false; if (u.pn >= 16) u.pn += 10; return true; }
};
struct OrderF8 {
    int G, c;
    __device__ __forceinline__ bool next(int i, pg8::Unit& u) const {
        int L;
        if (G == 256) { if (c < 64) { if (i >= 1) return false; L = 576 + c; } else { if (i >= 3) return false; L = (c - 64) + 192 * i; } }
        else { L = i * G + c; if (L >= 640) return false; }
        const int wgid = (L % 8) * 80 + L / 8;
        u.pm = (wgid / 80) * 8 + (wgid % 80) % 8; u.pn = 16 + (wgid % 80) / 8; return true;
    }
    __device__ __forceinline__ void a_ready(const pg8::Unit&) const {}
    __device__ __forceinline__ void done(const pg8::Unit&) const {}
};

struct EpiIn {
    static constexpr bool PERM = true;
    unsigned char* ws; const float* a_log; const float* dt_bias; const int* pos;
    __device__ __forceinline__ void operator()(const f32x4 (&acc)[2][2][4][2], const pg8::Unit& u, int wr, int wc, int fr, int fq) const {
        constexpr float RF[16] = {1.591549431e-01f, 7.008652159e-02f, 3.086376340e-02f, 1.359137064e-02f, 5.985185713e-03f, 2.635675899e-03f, 1.160663641e-03f, 5.111175045e-04f,
                                  2.250790790e-04f, 9.911730937e-05f, 4.364795279e-05f, 1.922110068e-05f, 8.464330808e-06f, 3.727408602e-06f, 1.641426263e-06f, 7.228293069e-07f};
        const int pn = u.pn;
        const int rowb = u.pm * 256 + wr * 64 + fr;
        const int cw = wc * 32 + 8 * fq;
        if (pn < 30) {
            h16* base; int ldc, colt, mode; float scale = 1.f;
            if (pn < 12) { base = (h16*)(ws + OFF_QKVR); ldc = 3072; colt = pn * 256; mode = 0; }
            else if (pn < 16) { base = (h16*)(ws + OFF_GZ); ldc = 1024; colt = (pn - 12) * 256; mode = 1; }
            else if (pn < 20) { base = (h16*)(ws + OFF_AQ); ldc = 1024; colt = (pn - 16) * 256; mode = 2; }
            else if (pn == 20) { base = (h16*)(ws + OFF_AK); ldc = 256; colt = 0; mode = 2; }
            else if (pn == 21) { base = (h16*)(ws + OFF_AV); ldc = 256; colt = 0; mode = 4; }
            else if (pn < 26) { base = (h16*)(ws + OFF_AZ); ldc = 1024; colt = (pn - 22) * 256; mode = 1; }
            else { base = (h16*)(ws + OFF_IQ); ldc = 1024; colt = (pn - 26) * 256; mode = 3; }
            const bool rot_wave = (mode == 2 && wc == 0) || (mode == 3 && (wc & 1) == 0);
            const int xm = (mode == 2) ? 32 : 16;
            const bool rot_lane = (mode == 2) ? true : (fq < 2);
            const float sgn = (mode == 2) ? (fq < 2 ? -1.f : 1.f) : (fq == 0 ? -1.f : 1.f);
            float Fq[8]; int ps[2][4];
#pragma unroll
            for (int j = 0; j < 8; ++j) Fq[j] = (mode == 2) ? ((fq & 1) ? RF[8 + j] : RF[j]) : RF[2 * j];
            if (rot_wave) {
#pragma unroll
                for (int ai = 0; ai < 2; ++ai)
#pragma unroll
                    for (int m = 0; m < 4; ++m) ps[ai][m] = pos[rowb + ai * 128 + m * 16];
            }
#pragma unroll
            for (int ai = 0; ai < 2; ++ai)
#pragma unroll
                for (int m = 0; m < 4; ++m) {
                    const int row = rowb + ai * 128 + m * 16;
                    float cs[8], sn[8];
                    if (rot_wave) {
                        const float pf = (float)ps[ai][m];
#pragma unroll
                        for (int j = 0; j < 8; ++j) { const float rv = __builtin_amdgcn_fractf(pf * Fq[j]); cs[j] = __builtin_amdgcn_cosf(rv); sn[j] = __builtin_amdgcn_sinf(rv); }
                    }
#pragma unroll
                    for (int bj = 0; bj < 2; ++bj) {
                        float v[8];
#pragma unroll
                        for (int j = 0; j < 4; ++j) { v[j] = acc[ai][bj][m][0][j]; v[4 + j] = acc[ai][bj][m][1][j]; }
                        if (rot_wave) {
#pragma unroll
                            for (int j = 0; j < 8; ++j) {
                                const unsigned xv = __builtin_bit_cast(unsigned, v[j]); float pv;
                                if (mode == 2) { const auto sw = __builtin_amdgcn_permlane32_swap(xv, xv, false, false); pv = __builtin_bit_cast(float, fq < 2 ? sw[1] : sw[0]); }
                                else { const auto sw = __builtin_amdgcn_permlane16_swap(xv, xv, false, false); pv = __builtin_bit_cast(float, (fq & 1) ? sw[0] : sw[1]); }
                                if (rot_lane) v[j] = v[j] * cs[j] + sgn * pv * sn[j]; }
                        }
                        if (mode == 1) {
#pragma unroll
                            for (int j = 0; j < 8; ++j) v[j] = silu_f(v[j]);
                        }
                        if (mode == 4) {
                            int w0 = 0, w1 = 0;
                            w0 = __builtin_amdgcn_cvt_pk_fp8_f32(v[0], v[1], w0, false); w0 = __builtin_amdgcn_cvt_pk_fp8_f32(v[2], v[3], w0, true);
                            w1 = __builtin_amdgcn_cvt_pk_fp8_f32(v[4], v[5], w1, false); w1 = __builtin_amdgcn_cvt_pk_fp8_f32(v[6], v[7], w1, true);
                            typedef int i32x2b __attribute__((ext_vector_type(2)));
                            *(i32x2b*)((unsigned char*)base + (size_t)row * ldc + bj * 128 + cw) = (i32x2b){w0, w1};
                        } else if (mode == 2) {
                            int w0 = 0, w1 = 0;
                            w0 = __builtin_amdgcn_cvt_pk_fp8_f32(v[0], v[1], w0, false); w0 = __builtin_amdgcn_cvt_pk_fp8_f32(v[2], v[3], w0, true);
                            w1 = __builtin_amdgcn_cvt_pk_fp8_f32(v[4], v[5], w1, false); w1 = __builtin_amdgcn_cvt_pk_fp8_f32(v[6], v[7], w1, true);
                            typedef int i32x2 __attribute__((ext_vector_type(2)));
                            *(i32x2*)((unsigned char*)base + (size_t)row * ldc + colt + bj * 128 + cw) = (i32x2){w0, w1};
                        } else {
                            h16x8 o;
#pragma unroll
                            for (int j = 0; j < 8; ++j) o[j] = (h16)(v[j] * scale);
                            *(h16x8*)(base + (size_t)row * ldc + colt + bj * 128 + cw) = o;
                        }
                    }
                }
        } else {
            h16* ik = (h16*)(ws + OFF_IK); float* gb = (float*)(ws + OFF_GB); float* iw = (float*)(ws + OFF_IW);
#pragma unroll
            for (int ai = 0; ai < 2; ++ai)
#pragma unroll
                for (int m = 0; m < 4; ++m) {
                    const int row = rowb + ai * 128 + m * 16;
                    float v[8];
#pragma unroll
                    for (int j = 0; j < 4; ++j) { v[j] = acc[ai][0][m][0][j]; v[4 + j] = acc[ai][0][m][1][j]; }
                    if (wc == 0) {
                        const float sgn = (fq == 0 ? -1.f : 1.f), pf = (float)pos[row];
#pragma unroll
                        for (int j = 0; j < 8; ++j) { const unsigned xv = __builtin_bit_cast(unsigned, v[j]); const auto sw = __builtin_amdgcn_permlane16_swap(xv, xv, false, false); const float pv = __builtin_bit_cast(float, (fq & 1) ? sw[0] : sw[1]); const float rv = __builtin_amdgcn_fractf(pf * RF[2 * j]); const float c = __builtin_amdgcn_cosf(rv), s = __builtin_amdgcn_sinf(rv);
                            if (fq < 2) v[j] = v[j] * c + sgn * pv * s; }
                    }
                    if (wc < 2) {
                        h16x8 o;
#pragma unroll
                        for (int j = 0; j < 8; ++j) o[j] = (h16)v[j];
                        *(h16x8*)(ik + (size_t)(row >> 5) * 2048 + (cw >> 4) * 512 + ((cw >> 3) & 1) * 256 + (row & 31) * 8) = o;
                    } else if (wc == 2) {
                        if (fq == 0) {
#pragma unroll
                            for (int j = 0; j < 8; ++j) { const float z = v[j] + dt_bias[j];
                                const float sp = fmaxf(z, 0.f) + 0.6931471805599453f * __builtin_amdgcn_logf(1.0f + __builtin_amdgcn_exp2f(-1.4426950408889634f * fabsf(z)));
                                gb[(size_t)row * 16 + j] = -__builtin_amdgcn_exp2f(1.4426950408889634f * a_log[j]) * sp; }
                        } else if (fq == 1) {
#pragma unroll
                            for (int j = 0; j < 8; ++j) gb[(size_t)row * 16 + 8 + j] = __builtin_amdgcn_rcpf(1.0f + __builtin_amdgcn_exp2f(-1.4426950408889634f * v[j]));
                        } else {
#pragma unroll
                            for (int j = 0; j < 8; ++j) iw[(size_t)row * 16 + 8 * (fq - 2) + j] = v[j] * 0.03125f;
                        }
                    }
                }
        }
    }
};

struct PanelOrder {
    int c;
    __device__ __forceinline__ bool next(int i, pg8::Unit& u) const { if (i >= 2) return false; u.pm = 32 * i + 4 * (c & 7) + (c >> 6); u.pn = (c >> 3) & 7; return true; }
    __device__ __forceinline__ void a_ready(const pg8::Unit&) const {}
    __device__ __forceinline__ void done(const pg8::Unit&) const {}
};
struct EpiOutNorm {
    static constexpr bool PERM = false;
    const float* x; float* out; float* rowss; unsigned* cnt; const float* fg;
    __device__ __forceinline__ void operator()(f32x4 (&acc)[2][2][4][2], const pg8::Unit& u, int wr, int wc, int fr, int fq) const {
        const int rowb = u.pm * 256 + wr * 64 + fr, col0 = u.pn * 256 + wc * 32 + 4 * fq;
#pragma unroll
        for (int ai = 0; ai < 2; ++ai)
#pragma unroll
            for (int m = 0; m < 4; ++m) {
                const int row = rowb + ai * 128 + m * 16; float ss = 0.f;
#pragma unroll
                for (int bj = 0; bj < 2; ++bj)
#pragma unroll
                    for (int n = 0; n < 2; ++n) {
                        const f32x4 y = *(const f32x4*)(x + (size_t)row * DM + col0 + bj * 128 + n * 16) + acc[ai][bj][m][n];
                        acc[ai][bj][m][n] = y; ss += (y[0] * y[0] + y[1] * y[1]) + (y[2] * y[2] + y[3] * y[3]);
                    }
                ss += __shfl_xor(ss, 16); ss += __shfl_xor(ss, 32);
                if (fq == 0) atomicAdd(rowss + row, ss);
            }
        asm volatile("s_waitcnt vmcnt(0)" ::: "memory");
        unsigned* cw = cnt + (u.pm * 2 + wr) * 16;
        if ((threadIdx.x & 63) == 0) __hip_atomic_fetch_add(cw, 1u, __ATOMIC_RELAXED, __HIP_MEMORY_SCOPE_AGENT);
        { unsigned spins = 0;
          while ((unsigned)__builtin_amdgcn_readfirstlane((int)__hip_atomic_load(cw, __ATOMIC_RELAXED, __HIP_MEMORY_SCOPE_AGENT)) < 32u) { __builtin_amdgcn_s_sleep(2); if (++spins > (1u << 22)) break; } }
        f32x4 gv[2][2];
#pragma unroll
        for (int bj = 0; bj < 2; ++bj)
#pragma unroll
            for (int n = 0; n < 2; ++n) gv[bj][n] = *(const f32x4*)(fg + col0 + bj * 128 + n * 16);
#pragma unroll
        for (int ai = 0; ai < 2; ++ai)
#pragma unroll
            for (int m = 0; m < 4; ++m) {
                const int row = rowb + ai * 128 + m * 16;
                const float ssr = __hip_atomic_load(rowss + row, __ATOMIC_RELAXED, __HIP_MEMORY_SCOPE_AGENT);
                const float r = __builtin_amdgcn_rsqf(ssr * (1.0f / DM) + EPS);
#pragma unroll
                for (int bj = 0; bj < 2; ++bj)
#pragma unroll
                    for (int n = 0; n < 2; ++n) *(f32x4*)(out + (size_t)row * DM + col0 + bj * 128 + n * 16) = acc[ai][bj][m][n] * r * gv[bj][n];
            }
    }
};

struct EpiOut {
    static constexpr bool PERM = false;
    const float* x; float* out; float* rowss;
    __device__ __forceinline__ void operator()(const f32x4 (&acc)[2][2][4][2], const pg8::Unit& u, int wr, int wc, int fr, int fq) const {
        const int rowb = u.pm * 256 + wr * 64 + fr, col0 = u.pn * 256 + wc * 32 + 4 * fq;
#pragma unroll
        for (int ai = 0; ai < 2; ++ai)
#pragma unroll
            for (int m = 0; m < 4; ++m) {
                const int row = rowb + ai * 128 + m * 16; float ss = 0.f;
#pragma unroll
                for (int bj = 0; bj < 2; ++bj)
#pragma unroll
                    for (int n = 0; n < 2; ++n) {
                        const size_t off = (size_t)row * DM + col0 + bj * 128 + n * 16;
                        const f32x4 y = *(const f32x4*)(x + off) + acc[ai][bj][m][n];
                        *(f32x4*)(out + off) = y; ss += (y[0] * y[0] + y[1] * y[1]) + (y[2] * y[2] + y[3] * y[3]);
                    }
                ss += __shfl_xor(ss, 16); ss += __shfl_xor(ss, 32);
                if (fq == 0) atomicAdd(rowss + row, ss);
            }
    }
};

__device__ __forceinline__ int src_col(int np) {
    if (np < 4096) return np;
    if (np < 7680) return np + 16;
    if (np < 7744) return 7696 + (np - 7680);
    if (np < 7752) return 4096 + (np - 7744);
    if (np < 7760) return 4104 + (np - 7752);
    if (np < 7776) return np;
    return -1;
}
__device__ __forceinline__ void phase0(const Params& p, unsigned char* smem) {
    const int tid = opaque_tid(), wid = tid >> 6, lane = tid & 63;
    const int gw = blockIdx.x * 8 + wid, nw = gridDim.x * 8;
    h16* H = (h16*)(p.ws + OFF_H); unsigned char* H8 = p.ws + OFF_H8;
    for (int row = 2 * gw; row < BT; row += 2 * nw) {
        const f32x4* xr0 = (const f32x4*)(p.x + (size_t)row * DM); const f32x4* xr1 = xr0 + DM / 4;
        f32x4 v0[8], v1[8]; float s0 = 0.f, s1 = 0.f;
#pragma unroll
        for (int i = 0; i < 8; ++i) { v0[i] = xr0[lane + 64 * i]; v1[i] = xr1[lane + 64 * i]; }
#pragma unroll
        for (int i = 0; i < 8; ++i) { s0 += (v0[i][0] * v0[i][0] + v0[i][1] * v0[i][1]) + (v0[i][2] * v0[i][2] + v0[i][3] * v0[i][3]); s1 += (v1[i][0] * v1[i][0] + v1[i][1] * v1[i][1]) + (v1[i][2] * v1[i][2] + v1[i][3] * v1[i][3]); }
        s0 = wave_sum(s0); s1 = wave_sum(s1);
        const float r0 = __builtin_amdgcn_rsqf(s0 * (1.0f / DM) + EPS), r1 = __builtin_amdgcn_rsqf(s1 * (1.0f / DM) + EPS);
#pragma unroll
        for (int i = 0; i < 8; ++i) { const f32x4 g = ((const f32x4*)p.attn_g)[lane + 64 * i]; h16x4 o0, o1;
#pragma unroll
            for (int j = 0; j < 4; ++j) { o0[j] = (h16)(v0[i][j] * r0 * g[j]); o1[j] = (h16)(v1[i][j] * r1 * g[j]); }
            *(h16x4*)(H + (size_t)row * DM + 4 * (lane + 64 * i)) = o0; *(h16x4*)(H + (size_t)(row + 1) * DM + 4 * (lane + 64 * i)) = o1;
            int e0 = 0, e1 = 0;
            e0 = __builtin_amdgcn_cvt_pk_fp8_f32(v0[i][0] * r0 * g[0], v0[i][1] * r0 * g[1], e0, false); e0 = __builtin_amdgcn_cvt_pk_fp8_f32(v0[i][2] * r0 * g[2], v0[i][3] * r0 * g[3], e0, true);
            e1 = __builtin_amdgcn_cvt_pk_fp8_f32(v1[i][0] * r1 * g[0], v1[i][1] * r1 * g[1], e1, false); e1 = __builtin_amdgcn_cvt_pk_fp8_f32(v1[i][2] * r1 * g[2], v1[i][3] * r1 * g[3], e1, true);
            *(int*)(H8 + (size_t)row * DM + 4 * (lane + 64 * i)) = e0; *(int*)(H8 + (size_t)(row + 1) * DM + 4 * (lane + 64 * i)) = e1; }
    }
    {
        float* tiles = (float*)smem;
        h16* Wt = (h16*)(p.ws + OFF_WT); h16* WoT = (h16*)(p.ws + OFF_WOT);
        constexpr int NT1 = 124 * 32, NTT = NT1 + 32 * 32;
        const int nl_r = tid & 63, kl_r = tid >> 6, nl_w = tid >> 3, kc_w = tid & 7;
        float va[8], vb[8];
#define P0_LOAD(tI, v) do { if ((tI) < NT1) { const int n0_ = ((tI) / 32) * 64, k0_ = ((tI) % 32) * 64; const int src_ = src_col(n0_ + nl_r); \
            _Pragma("unroll") for (int i = 0; i < 8; ++i) v[i] = src_ >= 0 ? p.w_in[(size_t)(k0_ + kl_r + 8 * i) * IN_COLS + src_] : 0.f; } \
          else { const int t2_ = (tI) - NT1; const int n0_ = (t2_ / 32) * 64, k0_ = (t2_ % 32) * 64; \
            _Pragma("unroll") for (int i = 0; i < 8; ++i) v[i] = p.w_out[(size_t)(k0_ + kl_r + 8 * i) * DM + n0_ + nl_r]; } } while (0)
#define P0_PUT(buf, v) do { float* t_ = tiles + (buf) * (64 * 65); _Pragma("unroll") for (int i = 0; i < 8; ++i) t_[(kl_r + 8 * i) * 65 + nl_r] = v[i]; } while (0)
#define P0_STORE(buf, tI) do { const float* t_ = tiles + (buf) * (64 * 65); h16x8 o_; _Pragma("unroll") for (int j = 0; j < 8; ++j) o_[j] = (h16)t_[(8 * kc_w + j) * 65 + nl_w]; \
          if ((tI) < NT1) { const int n0_ = ((tI) / 32) * 64, k0_ = ((tI) % 32) * 64; \
              if (n0_ >= 4096 && n0_ < 6656) { int e0_ = 0, e1_ = 0; e0_ = __builtin_amdgcn_cvt_pk_fp8_f32(64.f * (float)o_[0], 64.f * (float)o_[1], e0_, false); e0_ = __builtin_amdgcn_cvt_pk_fp8_f32(64.f * (float)o_[2], 64.f * (float)o_[3], e0_, true); \
                  e1_ = __builtin_amdgcn_cvt_pk_fp8_f32(64.f * (float)o_[4], 64.f * (float)o_[5], e1_, false); e1_ = __builtin_amdgcn_cvt_pk_fp8_f32(64.f * (float)o_[6], 64.f * (float)o_[7], e1_, true); \
                  typedef int i32x2w __attribute__((ext_vector_type(2))); *(i32x2w*)(p.ws + OFF_WT8 + (size_t)(n0_ - 4096 + nl_w) * 2048 + k0_ + 8 * kc_w) = (i32x2w){e0_, e1_}; } \
              else *(h16x8*)(Wt + (size_t)(n0_ + nl_w) * 2048 + k0_ + 8 * kc_w) = o_; } \
          else { const int t2_ = (tI) - NT1; const int n0_ = (t2_ / 32) * 64, k0_ = (t2_ % 32) * 64; unsigned char* wr_ = (unsigned char*)WoT + (size_t)(n0_ + nl_w) * 3072; \
              if (k0_ < 1024) *(h16x8*)(wr_ + 2 * (k0_ + 8 * kc_w)) = o_; \
              else { int e0_ = 0, e1_ = 0; e0_ = __builtin_amdgcn_cvt_pk_fp8_f32(64.f * (float)o_[0], 64.f * (float)o_[1], e0_, false); e0_ = __builtin_amdgcn_cvt_pk_fp8_f32(64.f * (float)o_[2], 64.f * (float)o_[3], e0_, true); \
                  e1_ = __builtin_amdgcn_cvt_pk_fp8_f32(64.f * (float)o_[4], 64.f * (float)o_[5], e1_, false); e1_ = __builtin_amdgcn_cvt_pk_fp8_f32(64.f * (float)o_[6], 64.f * (float)o_[7], e1_, true); \
                  typedef int i32x2o __attribute__((ext_vector_type(2))); *(i32x2o*)(wr_ + 2048 + (k0_ - 1024) + 8 * kc_w) = (i32x2o){e0_, e1_}; } } } while (0)
        int tI = blockIdx.x; int buf = 0;
        __syncthreads();
        if (tI < NTT) { P0_LOAD(tI, va); P0_PUT(0, va); }
        while (tI < NTT) {
            const int tn = tI + gridDim.x;
            if (tn < NTT) P0_LOAD(tn, vb);
            __syncthreads();
            P0_STORE(buf, tI);
            if (tn < NTT) P0_PUT(buf ^ 1, vb);
            buf ^= 1; tI = tn;
        }
#undef P0_LOAD
#undef P0_PUT
#undef P0_STORE
    }
}

__device__ __forceinline__ h16x8 pack8(const f32x4 a, const f32x4 c) { h16x8 o; o[0] = (h16)a[0]; o[1] = (h16)a[1]; o[2] = (h16)a[2]; o[3] = (h16)a[3]; o[4] = (h16)c[0]; o[5] = (h16)c[1]; o[6] = (h16)c[2]; o[7] = (h16)c[3]; return o; }
typedef short v4s_t __attribute__((__vector_size__(4 * sizeof(short))));
__device__ __forceinline__ h16x4 lds_tr16(const LAS unsigned char* a) { const v4s_t v = __builtin_amdgcn_ds_read_tr16_b64_v4i16((LAS v4s_t*)a); return __builtin_bit_cast(h16x4, v); }
constexpr int REC_BYTES = 74752, REC_WF = 0, REC_QF = 16384, REC_AF = 32768, REC_KTF = 40960, REC_VEC = 57344, REC_UF = 58368, REC_DMA = 58368;
constexpr int HB_BYTES = 69632;

__device__ __forceinline__ void gdn_prep_pair(const Params& p, unsigned char* smem, int pair) {
    const int tid = opaque_tid(), wid = __builtin_amdgcn_readfirstlane(tid >> 6), lane = tid & 63, hb = wid >> 2, w4 = wid & 3, tl = tid & 255;
    const int tk = 2 * pair + hb; const int b = tk >> 9, h = (tk >> 6) & 7, n = tk & 63; const int t0 = n * 64;
    unsigned char* base = smem + hb * HB_BYTES;
    h16* Kn = (h16*)base; h16* Qn = Kn + 64 * 136; h16* Vh = Qn + 64 * 136; float* L = (float*)(Vh + 64 * 136); float* vec = L + 4096;
    unsigned char* rec = p.ws + OFF_REC + (size_t)tk * REC_BYTES;
    const h16* qkvr = (const h16*)(p.ws + OFF_QKVR);
    __syncthreads();
    {
        const int cg = tl & 15, rg = tl >> 4;
        h16x8 raw[3][7];
#pragma unroll
        for (int ti = 0; ti < 3; ++ti)
#pragma unroll
            for (int r = 0; r < 7; ++r) {
                const int trow = t0 + 4 * rg - 3 + r;
                if (trow >= 0) raw[ti][r] = *(const h16x8*)(qkvr + ((size_t)b * NT + trow) * 3072 + ti * 1024 + h * 128 + 8 * cg);
                else { for (int j = 0; j < 8; ++j) raw[ti][r][j] = (h16)0.f; }
            }
#pragma unroll
        for (int ti = 0; ti < 3; ++ti) {
            const int chan = ti * 1024 + h * 128 + 8 * cg;
            float xr[7][8];
#pragma unroll
            for (int r = 0; r < 7; ++r)
#pragma unroll
                for (int j = 0; j < 8; ++j) xr[r][j] = (float)raw[ti][r][j];
            float wv[4][8];
#pragma unroll
            for (int tp = 0; tp < 4; ++tp) { const f32x4 a = *(const f32x4*)(p.conv_w + (size_t)tp * 3072 + chan), c = *(const f32x4*)(p.conv_w + (size_t)tp * 3072 + chan + 4);
#pragma unroll
                for (int j = 0; j < 4; ++j) { wv[tp][j] = a[j]; wv[tp][4 + j] = c[j]; } }
            h16* dst = (ti == 0) ? Qn : (ti == 1 ? Kn : Vh);
#pragma unroll
            for (int r = 0; r < 4; ++r) {
                float y[8]; float ss = 0.f;
#pragma unroll
                for (int j = 0; j < 8; ++j) { float a = wv[0][j] * xr[r][j] + wv[1][j] * xr[r + 1][j] + wv[2][j] * xr[r + 2][j] + wv[3][j] * xr[r + 3][j]; a = silu_f(a); y[j] = a; ss += a * a; }
                float sc = 1.f;
                if (ti < 2) { ss += __shfl_xor(ss, 1); ss += __shfl_xor(ss, 2); ss += __shfl_xor(ss, 4); ss += __shfl_xor(ss, 8); sc = (ti == 0 ? 0.08838834764831845f : 1.0f) * __builtin_amdgcn_rsqf(ss + EPS); }
                h16x8 o;
#pragma unroll
                for (int j = 0; j < 8; ++j) o[j] = (h16)(y[j] * sc);
                *(h16x8*)(dst + (4 * rg + r) * 136 + 8 * cg) = o;
            }
        }
    }
    if (tl < 64) {
        const float* gb = (const float*)(p.ws + OFF_GB) + ((size_t)b * NT + t0 + tl) * 16;
        const float g = gb[h], be = gb[8 + h];
        float gc = g;
#pragma unroll
        for (int o = 1; o < 64; o <<= 1) { const float tt = __shfl_up(gc, o); if (lane >= o) gc += tt; }
        const float gl = __shfl(gc, 63);
        vec[tl] = g; vec[64 + tl] = be; vec[128 + tl] = gc; vec[192 + tl] = __expf(gc);
        float* rv = (float*)(rec + REC_VEC);
        rv[tl] = __expf(gc); rv[64 + tl] = __expf(gl - gc); if (tl == 0) rv[128] = __expf(gl);
    }
    __syncthreads();
    {
        const int rt = w4, fr = lane & 15, kg = lane >> 4;
        h16x8 Ak[4], Aq[4];
#pragma unroll
        for (int s = 0; s < 4; ++s) { Ak[s] = *(const h16x8*)(Kn + (16 * rt + fr) * 136 + 32 * s + 8 * kg); Aq[s] = *(const h16x8*)(Qn + (16 * rt + fr) * 136 + 32 * s + 8 * kg); }
        h16* AF = (h16*)(rec + REC_AF);
#pragma unroll
        for (int ct = 0; ct < 4; ++ct) {
            f32x4 kk = (f32x4){0.f, 0.f, 0.f, 0.f}, qk = (f32x4){0.f, 0.f, 0.f, 0.f};
#pragma unroll
            for (int s = 0; s < 4; ++s) { const h16x8 Bk = *(const h16x8*)(Kn + (16 * ct + fr) * 136 + 32 * s + 8 * kg);
                kk = __builtin_amdgcn_mfma_f32_16x16x32_f16(Ak[s], Bk, kk, 0, 0, 0); qk = __builtin_amdgcn_mfma_f32_16x16x32_f16(Aq[s], Bk, qk, 0, 0, 0); }
            const int j = 16 * ct + fr; const float gcj = vec[128 + j];
#pragma unroll
            for (int rgi = 0; rgi < 4; ++rgi) {
                const int i = 16 * rt + 4 * kg + rgi;
                const float dec = (i >= j) ? __expf(vec[128 + i] - gcj) : 0.f;
                L[i * 64 + j] = (i > j) ? vec[64 + i] * kk[rgi] * dec : 0.f;
                const int sp = ct >> 1, kgp = fr >> 2, j8 = (ct & 1) * 4 + (fr & 3), lanep = 16 * kgp + 4 * kg + rgi;
                AF[((rt * 2 + sp) * 64 + lanep) * 8 + j8] = (h16)(qk[rgi] * dec);
            }
        }
    }
    __syncthreads();
    h16* Tw = (h16*)L; h16* Tu = Tw + 4096;
    if (w4 == 0) {
        float X[64];
#pragma unroll
        for (int i = 0; i < 64; ++i) X[i] = 0.f;
        f32x4 Ln[16]; float rn = (lane == 0) ? 1.f : 0.f;
#pragma unroll
        for (int i = 0; i < 64; ++i) {
            f32x4 Lc[16]; const float rc = rn;
#pragma unroll
            for (int jj = 0; jj < (i + 3) / 4; ++jj) Lc[jj] = Ln[jj];
            if (i + 1 < 64) {
#pragma unroll
                for (int jj = 0; jj < (i + 4) / 4; ++jj) Ln[jj] = *(const f32x4*)(L + (i + 1) * 64 + 4 * jj);
                rn = (lane == i + 1) ? 1.f : 0.f;
            }
            float a0 = rc, a1 = 0.f, a2 = 0.f, a3 = 0.f;
#pragma unroll
            for (int jj = 0; jj < (i + 3) / 4; ++jj) { a0 -= Lc[jj][0] * X[4 * jj]; a1 -= Lc[jj][1] * X[4 * jj + 1]; a2 -= Lc[jj][2] * X[4 * jj + 2]; a3 -= Lc[jj][3] * X[4 * jj + 3]; }
            float acc = (a0 + a1) + (a2 + a3);
            asm volatile("" : "+v"(acc) :: "memory");
            X[i] = acc;
        }
        const float bu = vec[64 + lane], bw = bu * vec[192 + lane];
#pragma unroll
        for (int i = 0; i < 64; ++i) { const int pos = i * 64 + ((((lane >> 3) ^ (i & 7)) << 3) | (lane & 7)); Tw[pos] = (h16)(X[i] * bw); Tu[pos] = (h16)(X[i] * bu); }
    } else {
        const int t3 = tl - 64;
        h16* QF = (h16*)(rec + REC_QF);
        for (int f = t3; f < 1024; f += 192) { const int lanep = f & 63, s = (f >> 6) & 3, rt = f >> 8; const int row = 16 * rt + (lanep & 15), kgp = lanep >> 4;
            const h16x4 a = *(const h16x4*)(Qn + row * 136 + 32 * s + 4 * kgp), c = *(const h16x4*)(Qn + row * 136 + 32 * s + 16 + 4 * kgp);
            h16x8 o; o[0] = a[0]; o[1] = a[1]; o[2] = a[2]; o[3] = a[3]; o[4] = c[0]; o[5] = c[1]; o[6] = c[2]; o[7] = c[3];
            *(h16x8*)(QF + (size_t)f * 8) = o; }
        h16* KTF = (h16*)(rec + REC_KTF);
        for (int f = t3; f < 1024; f += 192) { const int lanep = f & 63, sp = (f >> 6) & 1, rt = f >> 7; const int d = 16 * rt + (lanep & 15), kgp = lanep >> 4;
            h16x8 o;
#pragma unroll
            for (int j8 = 0; j8 < 8; ++j8) { const int c = 32 * sp + (j8 < 4 ? 4 * kgp + j8 : 16 + 4 * kgp + (j8 - 4)); o[j8] = Kn[c * 136 + d]; }
            *(h16x8*)(KTF + (size_t)f * 8) = o; }
    }
    __syncthreads();
    {
        const int rt = w4, fr = lane & 15, kg = lane >> 4, q4 = fr >> 2, pp = fr & 3;
        const LAS unsigned char* Knl = (const LAS unsigned char*)Kn; const LAS unsigned char* Vl = (const LAS unsigned char*)Vh;
        const int trow = 16 * rt + fr;
        h16x8 Tuf[2], Twf[2];
#pragma unroll
        for (int s = 0; s < 2; ++s) { const int off = trow * 64 + ((((4 * s + kg) ^ (trow & 7))) << 3); Tuf[s] = *(const h16x8*)(Tu + off); Twf[s] = *(const h16x8*)(Tw + off); }
        h16* UF = (h16*)(rec + REC_UF);
#pragma unroll
        for (int dvb = 0; dvb < 8; ++dvb) {
            f32x4 acc = (f32x4){0.f, 0.f, 0.f, 0.f};
#pragma unroll
            for (int s = 0; s < 2; ++s) { const LAS unsigned char* a0 = Vl + ((32 * s + 8 * kg + q4) * 136 + 16 * dvb + 4 * pp) * 2;
                const h16x4 lo = lds_tr16(a0), hi4 = lds_tr16(a0 + 4 * 136 * 2);
                h16x8 Bv; Bv[0] = lo[0]; Bv[1] = lo[1]; Bv[2] = lo[2]; Bv[3] = lo[3]; Bv[4] = hi4[0]; Bv[5] = hi4[1]; Bv[6] = hi4[2]; Bv[7] = hi4[3];
                acc = __builtin_amdgcn_mfma_f32_16x16x32_f16(Tuf[s], Bv, acc, 0, 0, 0); }
            h16x4 o; o[0] = (h16)acc[0]; o[1] = (h16)acc[1]; o[2] = (h16)acc[2]; o[3] = (h16)acc[3];
            *(h16x4*)(UF + (size_t)((dvb * 4 + rt) * 64 + lane) * 4) = o;
        }
        h16* WF = (h16*)(rec + REC_WF);
#pragma unroll
        for (int so = 0; so < 4; ++so) {
            f32x4 c0 = (f32x4){0.f, 0.f, 0.f, 0.f}, c1 = (f32x4){0.f, 0.f, 0.f, 0.f};
#pragma unroll
            for (int s = 0; s < 2; ++s) {
                const LAS unsigned char* a0 = Knl + ((32 * s + 8 * kg + q4) * 136 + 16 * (2 * so) + 4 * pp) * 2;
                const h16x4 l0 = lds_tr16(a0), h0 = lds_tr16(a0 + 4 * 136 * 2), l1 = lds_tr16(a0 + 32), h1 = lds_tr16(a0 + 32 + 4 * 136 * 2);
                h16x8 A0, A1; A0[0] = l0[0]; A0[1] = l0[1]; A0[2] = l0[2]; A0[3] = l0[3]; A0[4] = h0[0]; A0[5] = h0[1]; A0[6] = h0[2]; A0[7] = h0[3];
                A1[0] = l1[0]; A1[1] = l1[1]; A1[2] = l1[2]; A1[3] = l1[3]; A1[4] = h1[0]; A1[5] = h1[1]; A1[6] = h1[2]; A1[7] = h1[3];
                c0 = __builtin_amdgcn_mfma_f32_16x16x32_f16(A0, Twf[s], c0, 0, 0, 0); c1 = __builtin_amdgcn_mfma_f32_16x16x32_f16(A1, Twf[s], c1, 0, 0, 0);
            }
            *(h16x8*)(WF + (size_t)((rt * 4 + so) * 64 + lane) * 8) = pack8(-c0, -c1);
        }
    }
}

#define SC_DPP(v, ctrl) __builtin_bit_cast(float, __builtin_amdgcn_update_dpp(0, __builtin_bit_cast(int, (float)(v)), (ctrl), 0xF, 0xF, true))
__device__ __forceinline__ void gdn_scan_task(const Params& p, unsigned char* smem, int bh) {
    const int tid = opaque_tid(), wid = __builtin_amdgcn_readfirstlane(tid >> 6), lane = tid & 63, kg = lane >> 4, fr = lane & 15;
    const int b = bh >> 3, h = bh & 7;
    LAS unsigned char* lds = (LAS unsigned char*)smem;
    const unsigned char* rec0 = p.ws + OFF_REC + (size_t)(bh * 64) * REC_BYTES;
    h16* OB = (h16*)(smem + 2 * REC_DMA);
    const h16* gz = (const h16*)(p.ws + OFF_GZ); h16* omix = (h16*)(p.ws + OFF_OMIX);
    f32x4 Sacc[8];
#pragma unroll
    for (int t = 0; t < 8; ++t) Sacc[t] = (f32x4){0.f, 0.f, 0.f, 0.f};
    h16x4 Uc[4], Un[4];
    __syncthreads();
#define GDN_GLDS(recp, bufi) do { _Pragma("unroll") for (int _i = 0; _i < 7; ++_i) \
        __builtin_amdgcn_global_load_lds((const unsigned*)((recp) + (size_t)(_i * 512 + tid) * 16), (LAS unsigned*)(lds + (bufi) * REC_DMA + (_i * 512 + wid * 64) * 16), 16, 0, 0); \
        if (wid == 0) __builtin_amdgcn_global_load_lds((const unsigned*)((recp) + (size_t)(7 * 512 + tid) * 16), (LAS unsigned*)(lds + (bufi) * REC_DMA + (7 * 512) * 16), 16, 0, 0); } while (0)
#define GDN_LDREG(recp, U_) do { _Pragma("unroll") for (int rt = 0; rt < 4; ++rt) U_[rt] = *(const h16x4*)((recp) + REC_UF + (size_t)((wid * 4 + rt) * 64 + lane) * 8); } while (0)
#define GDN_LDGZ(dst, chunk) do { const h16* gp_ = gz + ((size_t)b * NT + 64 * (chunk) + prow) * 1024 + h * 128 + 16 * pseg; dst[0] = *(const h16x8*)gp_; dst[1] = *(const h16x8*)(gp_ + 8); } while (0)
#define GDN_POST(chunk, gzv) do { const h16* Ob = OB + ((chunk) & 1) * 8192 + prow * 128 + 16 * pseg; const h16x8 a0 = *(const h16x8*)Ob, a1 = *(const h16x8*)(Ob + 8); \
        float ngv[16]; _Pragma("unroll") for (int j = 0; j < 4; ++j) { const f32x4 t4 = *(const f32x4*)(ngl + 16 * pseg + 4 * j); ngv[4 * j] = t4[0]; ngv[4 * j + 1] = t4[1]; ngv[4 * j + 2] = t4[2]; ngv[4 * j + 3] = t4[3]; } \
        float ss = 0.f; _Pragma("unroll") for (int j = 0; j < 8; ++j) { const float u0 = (float)a0[j], u1 = (float)a1[j]; ss += u0 * u0 + u1 * u1; } \
        ss += SC_DPP(ss, 0xB1); ss += SC_DPP(ss, 0x4E); ss += SC_DPP(ss, 0x141);     const float r = __builtin_amdgcn_rsqf(ss * (1.0f / 128.0f) + EPS); \
        h16x8 o0, o1; _Pragma("unroll") for (int j = 0; j < 8; ++j) { o0[j] = (h16)((float)a0[j] * r * ngv[j] * (float)gzv[0][j]); o1[j] = (h16)((float)a1[j] * r * ngv[8 + j] * (float)gzv[1][j]); } \
        h16* op_ = omix + ((size_t)b * NT + 64 * (chunk) + prow) * 1536 + h * 128 + 16 * pseg; *(h16x8*)op_ = o0; *(h16x8*)(op_ + 8) = o1; } while (0)
#define GDN_RD8(X, off0) do { _Pragma("unroll") for (int _j = 0; _j < 8; ++_j) X[_j] = *(const LAS h16x8*)(bufp + (off0) + (_j * 64 + lane) * 16); } while (0)
#define GDN_SB __builtin_amdgcn_sched_barrier(0)
    h16x8 gzp[2], gzn[2];
    const int prow = tid >> 3, pseg = tid & 7;
    float* ngl = (float*)(smem + 2 * REC_DMA + 32768);
    if (tid < 128) ngl[tid] = p.gdn_norm_g[tid];
    GDN_GLDS(rec0, 0);
    GDN_LDREG(rec0, Uc);
    asm volatile("s_waitcnt vmcnt(0)" ::: "memory");
    __syncthreads();
    for (int n = 0; n < 64; ++n) {
        const unsigned char* recn = rec0 + (size_t)(n + 1) * REC_BYTES;
        if (n + 1 < 64) { GDN_GLDS(recn, (n + 1) & 1); GDN_LDREG(recn, Un); }
        GDN_LDGZ(gzn, n);
        if (n > 0) GDN_POST(n - 1, gzp);
        const LAS unsigned char* bufp = lds + (n & 1) * REC_DMA;
        h16x8 X[8], Y[8];
        GDN_RD8(X, REC_WF);
        h16x8 SB[4];
#pragma unroll
        for (int s = 0; s < 4; ++s) SB[s] = pack8(Sacc[2 * s], Sacc[2 * s + 1]);
        f32x4 vacc[4], oacc[4];
#pragma unroll
        for (int rt = 0; rt < 4; ++rt) { vacc[rt] = (f32x4){(float)Uc[rt][0], (float)Uc[rt][1], (float)Uc[rt][2], (float)Uc[rt][3]}; oacc[rt] = (f32x4){0.f, 0.f, 0.f, 0.f}; }
        GDN_SB;
        GDN_RD8(Y, REC_WF + 8192);
#pragma unroll
        for (int j = 0; j < 8; ++j) vacc[j >> 2] = __builtin_amdgcn_mfma_f32_16x16x32_f16(X[j], SB[j & 3], vacc[j >> 2], 0, 0, 0);
        GDN_SB;
        GDN_RD8(X, REC_QF);
#pragma unroll
        for (int j = 0; j < 8; ++j) vacc[2 + (j >> 2)] = __builtin_amdgcn_mfma_f32_16x16x32_f16(Y[j], SB[j & 3], vacc[2 + (j >> 2)], 0, 0, 0);
        GDN_SB;
        GDN_RD8(Y, REC_QF + 8192);
        f32x4 ekv[4], egv[4];
#pragma unroll
        for (int rt = 0; rt < 4; ++rt) { ekv[rt] = *(const LAS f32x4*)(bufp + REC_VEC + 256 + (16 * rt + 4 * kg) * 4); egv[rt] = *(const LAS f32x4*)(bufp + REC_VEC + (16 * rt + 4 * kg) * 4); }
        const float eglc = *(const LAS float*)(bufp + REC_VEC + 512);
#pragma unroll
        for (int j = 0; j < 8; ++j) oacc[j >> 2] = __builtin_amdgcn_mfma_f32_16x16x32_f16(X[j], SB[j & 3], oacc[j >> 2], 0, 0, 0);
        GDN_SB;
        GDN_RD8(X, REC_KTF);
        h16x8 VB[2], VKB[2];
#pragma unroll
        for (int sp = 0; sp < 2; ++sp) { VB[sp] = pack8(vacc[2 * sp], vacc[2 * sp + 1]); VKB[sp] = pack8(vacc[2 * sp] * ekv[2 * sp], vacc[2 * sp + 1] * ekv[2 * sp + 1]); }
#pragma unroll
        for (int j = 0; j < 8; ++j) oacc[2 + (j >> 2)] = __builtin_amdgcn_mfma_f32_16x16x32_f16(Y[j], SB[j & 3], oacc[2 + (j >> 2)], 0, 0, 0);
        GDN_SB;
        GDN_RD8(Y, REC_KTF + 8192);
#pragma unroll
        for (int t = 0; t < 8; ++t) Sacc[t] = Sacc[t] * eglc;
#pragma unroll
        for (int j = 0; j < 8; ++j) Sacc[j >> 1] = __builtin_amdgcn_mfma_f32_16x16x32_f16(X[j], VKB[j & 1], Sacc[j >> 1], 0, 0, 0);
        GDN_SB;
        GDN_RD8(X, REC_AF);
#pragma unroll
        for (int rt = 0; rt < 4; ++rt) oacc[rt] = oacc[rt] * egv[rt];
#pragma unroll
        for (int j = 0; j < 8; ++j) Sacc[4 + (j >> 1)] = __builtin_amdgcn_mfma_f32_16x16x32_f16(Y[j], VKB[j & 1], Sacc[4 + (j >> 1)], 0, 0, 0);
        GDN_SB;
#pragma unroll
        for (int j = 0; j < 8; ++j) oacc[j >> 1] = __builtin_amdgcn_mfma_f32_16x16x32_f16(X[j], VB[j & 1], oacc[j >> 1], 0, 0, 0);
        { h16* Ob = OB + (n & 1) * 8192;
#pragma unroll
          for (int rt = 0; rt < 4; ++rt)
#pragma unroll
              for (int rgi = 0; rgi < 4; ++rgi) Ob[(16 * rt + 4 * kg + rgi) * 128 + 16 * wid + fr] = (h16)oacc[rt][rgi]; }
        asm volatile("s_waitcnt vmcnt(0)" ::: "memory");
        __syncthreads();
#pragma unroll
        for (int rt = 0; rt < 4; ++rt) Uc[rt] = Un[rt];
        gzp[0] = gzn[0]; gzp[1] = gzn[1];
    }
    GDN_POST(63, gzp);
#undef GDN_LDGZ
#undef GDN_POST
#undef GDN_RD8
#undef GDN_SB
#undef GDN_GLDS
#undef GDN_LDREG
}

__device__ __forceinline__ unsigned f2key(float x) { const unsigned u = __float_as_uint(x); return (u & 0x80000000u) ? ~u : (u | 0x80000000u); }
typedef float f32x16 __attribute__((ext_vector_type(16)));
__device__ __forceinline__ float wave_min(float v) {
#pragma unroll
    for (int o = 1; o < 64; o <<= 1) v = fminf(v, __shfl_xor(v, o));
    return v;
}
__device__ __forceinline__ unsigned lane_below(unsigned long long m) { return __builtin_amdgcn_mbcnt_hi((unsigned)(m >> 32), __builtin_amdgcn_mbcnt_lo((unsigned)m, 0u)); }
__device__ __forceinline__ void idx8_task(const Params& p, unsigned char* smem, int b, int qb) {
    const int tid = opaque_tid(), wid = __builtin_amdgcn_readfirstlane(tid >> 6), lane = tid & 63;
    const int t0 = qb * 8;
    unsigned short* selg = (unsigned short*)(p.ws + OFF_SEL) + ((size_t)b * NT + t0) * 256;
    if (t0 + 8 <= 256) {
        for (int i = tid; i < 8 * 256; i += 512) { const int q = i >> 8, k = i & 255; selg[i] = (unsigned short)(k <= t0 + q ? k : 0); }
        return;
    }
    float* sc = (float*)smem;
    ACC_T0();
    unsigned* hist = (unsigned*)(smem + 131072 + wid * 2560);
    unsigned* cand = hist + 256;
    __syncthreads();
    {
        const int n8 = t0 + 8;
        const int ntile = (n8 + 31) >> 5, ntile_pad = ((n8 + 255) >> 8) << 3;
        const h16* iq = (const h16*)(p.ws + OFF_IQ) + ((size_t)b * NT + t0) * 1024;
        const float* iw = (const float*)(p.ws + OFF_IW) + ((size_t)b * NT + t0) * 16;
        const h16* ik = (const h16*)(p.ws + OFF_IK) + (size_t)b * NT * 64;
        const int r = lane & 31, kh = lane >> 5, qq = (r >> 2) & 1, hh = (r & 3) + 4 * (r >> 3);
        h16x8 Af[4][4]; h16x2 Wp[4][8];
#pragma unroll
        for (int a = 0; a < 4; ++a) {
#pragma unroll
            for (int s = 0; s < 4; ++s) Af[a][s] = *(const h16x8*)(iq + (size_t)(2 * a + qq) * 1024 + hh * 64 + 16 * s + 8 * kh);
#pragma unroll
            for (int c = 0; c < 4; ++c) { const f32x4 w4 = *(const f32x4*)(iw + (size_t)(2 * a + kh) * 16 + 4 * c);
                Wp[a][2 * c] = (h16x2){(h16)w4[0], (h16)w4[1]}; Wp[a][2 * c + 1] = (h16x2){(h16)w4[2], (h16)w4[3]}; }
        }
#define IDX_LOADB(Bx, ti) do { const int tc_ = (ti) < ntile ? (ti) : ntile - 1;     \
            _Pragma("unroll") for (int s = 0; s < 4; ++s) Bx[s] = *(const h16x8*)(ik + (size_t)tc_ * 2048 + s * 512 + kh * 256 + r * 8); } while (0)
#define IDX_COMP(Bx, ti) do { if ((ti) < ntile) { const int key = 32 * (ti) + r; f32x16 accs[4]; \
            _Pragma("unroll") for (int a = 0; a < 4; ++a) { _Pragma("unroll") for (int e = 0; e < 16; ++e) accs[a][e] = 0.f; \
                _Pragma("unroll") for (int s = 0; s < 4; ++s) accs[a] = __builtin_amdgcn_mfma_f32_32x32x16_f16(Af[a][s], Bx[s], accs[a], 0, 0, 0); } \
            __builtin_amdgcn_sched_barrier(0); \
            _Pragma("unroll") for (int a = 0; a < 4; ++a) { \
                float s0 = 0.f, s1 = 0.f; _Pragma("unroll") for (int e = 0; e < 8; e += 2) { h16x2 rp = (h16x2){(h16)accs[a][2 * e], (h16)accs[a][2 * e + 1]}; rp = __builtin_elementwise_max(rp, (h16x2){(h16)0.f, (h16)0.f}); s0 = __builtin_amdgcn_fdot2(rp, Wp[a][e], s0, false); \
                    h16x2 rq = (h16x2){(h16)accs[a][2 * e + 2], (h16)accs[a][2 * e + 3]}; rq = __builtin_elementwise_max(rq, (h16x2){(h16)0.f, (h16)0.f}); s1 = __builtin_amdgcn_fdot2(rq, Wp[a][e + 1], s1, false); } \
                const int q = 2 * a + kh; sc[q * 4096 + key] = (key > t0 + q) ? -INFINITY : (s0 + s1); } } } while (0)
        {
            h16x8 B0[4], B1[4], B2[4];
            IDX_LOADB(B0, wid); IDX_LOADB(B1, wid + 8);
            for (int i = wid; i < ntile; i += 24) {
                IDX_LOADB(B2, i + 16); IDX_COMP(B0, i);
                IDX_LOADB(B0, i + 24); IDX_COMP(B1, i + 8);
                IDX_LOADB(B1, i + 32); IDX_COMP(B2, i + 16);
            }
            for (int i = ntile + wid; i < ntile_pad; i += 8) {
#pragma unroll
                for (int a = 0; a < 4; ++a) sc[(2 * a + kh) * 4096 + 32 * i + r] = -INFINITY;
            }
        }
#undef IDX_LOADB
#undef IDX_COMP
    }
    __syncthreads();
    ACC_ADD(1);
    {
        const int tq = t0 + wid, n = tq + 1;
        const float* row = sc + wid * 4096;
        const int ng = (n + 255) >> 8;
        f32x4 x[16];
#pragma unroll
        for (int g = 0; g < 16; ++g) { if (g < ng) x[g] = *(const f32x4*)(row + 256 * g + 4 * lane); else x[g] = (f32x4){-INFINITY, -INFINITY, -INFINITY, -INFINITY}; }
        float hi = -INFINITY, lo = INFINITY;
#pragma unroll
        for (int g = 0; g < 16; ++g)
#pragma unroll
            for (int c = 0; c < 4; ++c) { const float v = x[g][c]; hi = fmaxf(hi, v); lo = fminf(lo, v == -INFINITY ? INFINITY : v); }
        hi = wave_max(hi); lo = wave_min(lo);
        const float scale = (hi > lo) ? 255.99f / (hi - lo) : 0.f; const float off = -lo * scale;
        { u32x4 z0 = (u32x4){0u, 0u, 0u, 0u}; asm volatile("" : "+v"(z0)); *(u32x4*)(hist + 4 * lane) = z0; }
#pragma unroll
        for (int g = 0; g < 16; ++g) { if (g < ng) {
#pragma unroll
            for (int c = 0; c < 4; ++c) { int bin = (int)fmaf(x[g][c], scale, off); bin = bin < 0 ? 0 : (bin > 255 ? 255 : bin); atomicAdd(&hist[bin], 1u); } } }
        unsigned bstar, need;
        {
            const u32x4 h4 = *(const u32x4*)(hist + 4 * lane); const unsigned s = h4[0] + h4[1] + h4[2] + h4[3];
            unsigned suf = s;
#pragma unroll
            for (int o = 1; o < 64; o <<= 1) { const unsigned tt = __shfl_down(suf, o); if (lane + o < 64) suf += tt; }
            const unsigned above = suf - s;
            const bool mine = (above < 256u && 256u <= suf);
            unsigned cum = above; unsigned bin = 0;
            if (cum + h4[3] >= 256u) bin = 3; else { cum += h4[3]; if (cum + h4[2] >= 256u) bin = 2; else { cum += h4[2]; if (cum + h4[1] >= 256u) bin = 1; else { cum += h4[1]; bin = 0; } } }
            const unsigned long long mm = __ballot(mine);
            const int src = (int)__builtin_ctzll(mm);
            bstar = (unsigned)__shfl((int)(4 * lane + bin), src); need = (unsigned)__shfl((int)(256u - cum), src);
        }
        unsigned short* so = selg + (size_t)wid * 256;
        unsigned short* cidx = (unsigned short*)(cand + 256);
        unsigned m = 0, outb = 0;
#pragma unroll
        for (int g = 0; g < 16; ++g) { if (g < ng) {
#pragma unroll
            for (int c = 0; c < 4; ++c) { int bin = (int)fmaf(x[g][c], scale, off); bin = bin < 0 ? 0 : (bin > 255 ? 255 : bin);
                const bool gt = ((unsigned)bin > bstar), pr = ((unsigned)bin == bstar);
                const unsigned long long mg = __ballot(gt), mk = __ballot(pr);
                if (mg) { const unsigned pos = outb + lane_below(mg); if (gt) so[pos] = (unsigned short)(256 * g + 4 * lane + c); outb += (unsigned)__builtin_popcountll(mg); }
                if (mk) { const unsigned pos = m + lane_below(mk); if (pr && pos < 256u) { cand[pos] = f2key(x[g][c]); cidx[pos] = (unsigned short)(256 * g + 4 * lane + c); } m += (unsigned)__builtin_popcountll(mk); } } } }
        unsigned Kt = 0, rr = need;
        if (m <= 256u) {
            const int nc = (int)((m + 63u) >> 6);
            unsigned cv[4]; unsigned short ci[4];
#pragma unroll
            for (int j = 0; j < 4; ++j) { const bool in = (64 * j + lane < (int)m); cv[j] = in ? cand[64 * j + lane] : 0u; ci[j] = in ? cidx[64 * j + lane] : (unsigned short)0; }
            for (int bit = 31; bit >= 0; --bit) {
                const unsigned test = (Kt | (1u << bit)) >> bit;
                unsigned cnt = (unsigned)__builtin_popcountll(__ballot((cv[0] >> bit) == test));
                if (nc > 1) cnt += (unsigned)__builtin_popcountll(__ballot((cv[1] >> bit) == test));
                if (nc > 2) cnt += (unsigned)__builtin_popcountll(__ballot((cv[2] >> bit) == test));
                if (nc > 3) cnt += (unsigned)__builtin_popcountll(__ballot((cv[3] >> bit) == test));
                if (cnt >= rr) Kt |= (1u << bit); else rr -= cnt;
            }
            unsigned eqb = 0;
#pragma unroll
            for (int j = 0; j < 4; ++j) { if (j < nc) { const bool in = (64 * j + lane < (int)m); const bool gt = in && cv[j] > Kt, eq = in && cv[j] == Kt;
                const unsigned long long me = __ballot(eq); bool take = gt;
                if (me) { const unsigned er = eqb + lane_below(me); take = gt || (eq && er < rr); eqb += (unsigned)__builtin_popcountll(me); }
                const unsigned long long mt = __ballot(take);
                if (mt) { const unsigned pos = outb + lane_below(mt); if (take) so[pos] = ci[j]; outb += (unsigned)__builtin_popcountll(mt); } } }
        } else {
            for (int bit = 31; bit >= 0; --bit) {
                const unsigned test = (Kt | (1u << bit)) >> bit; unsigned cnt = 0;
                for (int idx = lane; idx < ng * 256; idx += 64) { const float v = row[idx]; int bin = (int)fmaf(v, scale, off); bin = bin < 0 ? 0 : (bin > 255 ? 255 : bin);
                    const bool pr = ((unsigned)bin == bstar) && ((f2key(v) >> bit) == test); cnt += (unsigned)__builtin_popcountll(__ballot(pr)); }
                if (cnt >= rr) Kt |= (1u << bit); else rr -= cnt;
            }
            unsigned eqb = 0;
            for (int idx = lane; idx < ng * 256; idx += 64) { const float v = row[idx]; int bin = (int)fmaf(v, scale, off); bin = bin < 0 ? 0 : (bin > 255 ? 255 : bin);
                const unsigned k = f2key(v); const bool inb = ((unsigned)bin == bstar); const bool gt = inb && k > Kt, eq = inb && k == Kt;
                const unsigned long long me = __ballot(eq); bool take = gt;
                if (me) { const unsigned er = eqb + lane_below(me); take = gt || (eq && er < rr); eqb += (unsigned)__builtin_popcountll(me); }
                const unsigned long long mt = __ballot(take);
                if (mt) { const unsigned pos = outb + lane_below(mt); if (take) so[pos] = (unsigned short)idx; outb += (unsigned)__builtin_popcountll(mt); } }
        }
    }
    __syncthreads();
    ACC_ADD(2);
}

typedef unsigned short u16x4 __attribute__((ext_vector_type(4)));
typedef unsigned short u16x8 __attribute__((ext_vector_type(8)));
__device__ __forceinline__ void attn8_task(const Params& p, unsigned char* smem, int part, int o) {
    const int tid = opaque_tid(), wid = __builtin_amdgcn_readfirstlane(tid >> 6), lane = tid & 63, kg = lane >> 4, fr = lane & 15;
    const int b = part >> 1, g = part & 1;
    unsigned char* vl = smem + wid * 17408;
    LAS unsigned char* vll = (LAS unsigned char*)vl;
    const char* akb = (const char*)(p.ws + OFF_AK) + (size_t)b * NT * 256 + g * 128;
    const char* avb = (const char*)(p.ws + OFF_AV) + (size_t)b * NT * 256 + g * 128;
    typedef long i64x2 __attribute__((ext_vector_type(2)));
    constexpr int NQW = 1;
    const int tq0 = 8 * NQW * o + NQW * wid;
    u16x4 kix[4], kixn[4];
#define AT_LOADI(tt, KI) do { const unsigned short* sel_ = (const unsigned short*)(p.ws + OFF_SEL) + ((size_t)b * NT + (tt)) * 256; \
        _Pragma("unroll") for (int c = 0; c < 4; ++c) KI[c] = *(const u16x4*)(sel_ + 64 * c + 4 * fr); } while (0)
    AT_LOADI(tq0, kix);
#pragma unroll 1
    for (int qi = 0; qi < NQW; ++qi) {
    const int t = tq0 + qi; const int bt = b * NT + t; const int nvalid = (t + 1) < 256 ? (t + 1) : 256;
    const unsigned short* sel = (const unsigned short*)(p.ws + OFF_SEL) + (size_t)bt * 256;
    long Qf[4];
    { const char* qp_ = (const char*)(p.ws + OFF_AQ) + (size_t)bt * 1024 + (4 * g + (fr & 3)) * 128 + kg * 32; const i64x2 q0 = *(const i64x2*)qp_, q1 = *(const i64x2*)(qp_ + 16);
      Qf[0] = fr < 4 ? q0[0] : 0l; Qf[1] = fr < 4 ? q0[1] : 0l; Qf[2] = fr < 4 ? q1[0] : 0l; Qf[3] = fr < 4 ? q1[1] : 0l; }
    f32x4 lg[16];
    unsigned char* kl = vl + 8192; LAS unsigned char* kll = (LAS unsigned char*)kl;
    u16x8 IX[4];
#pragma unroll
    for (int c = 0; c < 4; ++c) IX[c] = *(const u16x8*)(sel + 64 * c + 8 * (lane >> 3));
#define AT_GATHER(Rx, base, c) do { _Pragma("unroll") for (int it = 0; it < 8; ++it) Rx[it] = *(const u32x4*)((base) + (unsigned)IX[c][it] * 256u + 16u * (unsigned)(lane & 7)); } while (0)
#define AT_STOREK(KRx) do { _Pragma("unroll") for (int it = 0; it < 8; ++it) { const int r = 8 * (lane >> 3) + it; const int fk = (r >> 2) & 7; \
        *(u32x4*)(kl + r * 128 + (((lane & 7) ^ fk) << 4)) = KRx[it]; } } while (0)
#define AT_READK(Kx) do { _Pragma("unroll") for (int ii = 0; ii < 4; ++ii) { const int r = 4 * fr + ii; const int fk = fr & 7; \
        const i64x2 t0 = *(const LAS i64x2*)(kll + r * 128 + (((2 * kg) ^ fk) << 4)), t1 = *(const LAS i64x2*)(kll + r * 128 + (((2 * kg + 1) ^ fk) << 4)); \
        Kx[ii][0] = t0[0]; Kx[ii][1] = t0[1]; Kx[ii][2] = t1[0]; Kx[ii][3] = t1[1]; } } while (0)
#define AT_MMAK(Kx, c) do { _Pragma("unroll") for (int ii = 0; ii < 4; ++ii) { f32x4 a = (f32x4){0.f, 0.f, 0.f, 0.f}; \
        _Pragma("unroll") for (int s = 0; s < 4; ++s) a = __builtin_amdgcn_mfma_f32_16x16x32_fp8_fp8(Kx[ii][s], Qf[s], a, 0, 0, 0); lg[4 * (c) + ii] = a; } } while (0)
    u32x4 R0[8], R1[8], R2[8];
    {
        long Kf[4][4];
        AT_GATHER(R0, akb, 0); AT_GATHER(R1, akb, 1); AT_GATHER(R2, akb, 2);
        AT_STOREK(R0); AT_READK(Kf); AT_GATHER(R0, akb, 3); AT_MMAK(Kf, 0);
        AT_STOREK(R1); AT_READK(Kf); AT_GATHER(R1, avb, 0); AT_MMAK(Kf, 1);
        AT_STOREK(R2); AT_READK(Kf); AT_GATHER(R2, avb, 1); AT_MMAK(Kf, 2);
        AT_STOREK(R0); AT_READK(Kf); AT_GATHER(R0, avb, 2); AT_MMAK(Kf, 3);
    }
#define DPP_F(oldv, srcv, ctrl, bank) __builtin_bit_cast(float, __builtin_amdgcn_update_dpp(__builtin_bit_cast(int, (float)(oldv)), __builtin_bit_cast(int, (float)(srcv)), (ctrl), 0xF, (bank), false))
    float val[4][4];
#pragma unroll
    for (int ii = 0; ii < 4; ++ii)
#pragma unroll
        for (int r = 0; r < 4; ++r) { float v = lg[ii][r];
            v = DPP_F(v, lg[4 + ii][r], 0x114, 0x2); v = DPP_F(v, lg[8 + ii][r], 0x118, 0x4); v = DPP_F(v, lg[12 + ii][r], 0x11C, 0x8); val[ii][r] = v; }
    const int cj = fr >> 2;
    float m = -INFINITY;
#pragma unroll
    for (int ii = 0; ii < 4; ++ii)
#pragma unroll
        for (int r = 0; r < 4; ++r) { const int slot = 64 * cj + 16 * kg + 4 * r + ii; const float v = (slot < nvalid) ? val[ii][r] * (0.08838834764831845f * 1.4426950408889634f) : -INFINITY; val[ii][r] = v; m = fmaxf(m, v); }
    m = fmaxf(m, __shfl_xor(m, 4)); m = fmaxf(m, __shfl_xor(m, 8)); m = fmaxf(m, __shfl_xor(m, 16)); m = fmaxf(m, __shfl_xor(m, 32));
    float sum = 0.f;
#pragma unroll
    for (int ii = 0; ii < 4; ++ii)
#pragma unroll
        for (int r = 0; r < 4; ++r) { const float e = __builtin_amdgcn_exp2f(val[ii][r] - m); val[ii][r] = e; sum += e; }
    sum += __shfl_xor(sum, 4); sum += __shfl_xor(sum, 8); sum += __shfl_xor(sum, 16); sum += __shfl_xor(sum, 32);
    const float pscale = __builtin_amdgcn_rcpf(sum) * 256.0f;
    int pl[2][2];
#pragma unroll
    for (int ipl = 0; ipl < 2; ++ipl) { int w0 = 0, w1 = 0;
        w0 = __builtin_amdgcn_cvt_pk_fp8_f32(val[2 * ipl][0] * pscale, val[2 * ipl][1] * pscale, w0, false); w0 = __builtin_amdgcn_cvt_pk_fp8_f32(val[2 * ipl][2] * pscale, val[2 * ipl][3] * pscale, w0, true);
        w1 = __builtin_amdgcn_cvt_pk_fp8_f32(val[2 * ipl + 1][0] * pscale, val[2 * ipl + 1][1] * pscale, w1, false); w1 = __builtin_amdgcn_cvt_pk_fp8_f32(val[2 * ipl + 1][2] * pscale, val[2 * ipl + 1][3] * pscale, w1, true);
        pl[ipl][0] = w0; pl[ipl][1] = w1; }
    long Pf[8];
#pragma unroll
    for (int ipl = 0; ipl < 2; ++ipl) {
        Pf[ipl] = (long)(((unsigned long long)(unsigned)pl[ipl][1] << 32) | (unsigned long long)(unsigned)pl[ipl][0]);
#define PF_GATHER(c, ctrl) do { const int lo_ = __builtin_amdgcn_update_dpp(0, pl[ipl][0], ctrl, 0xF, 0x1, false), hi_ = __builtin_amdgcn_update_dpp(0, pl[ipl][1], ctrl, 0xF, 0x1, false); \
            Pf[2 * (c) + ipl] = (long)(((unsigned long long)(unsigned)hi_ << 32) | (unsigned long long)(unsigned)lo_); } while (0)
        PF_GATHER(1, 0x104); PF_GATHER(2, 0x108); PF_GATHER(3, 0x10C);
#undef PF_GATHER
    }
#undef DPP_F
    f32x4 O[8];
#pragma unroll
    for (int ct = 0; ct < 8; ++ct) O[ct] = (f32x4){0.f, 0.f, 0.f, 0.f};
    if (qi < NQW - 1) AT_LOADI(t + 1, kixn);
    const h16x8 gate = *(const h16x8*)((const h16*)(p.ws + OFF_AZ) + (size_t)bt * 1024 + (4 * g) * 128 + 8 * lane);
    const int q4 = fr >> 2, pp = fr & 3;
    typedef int v2i_t __attribute__((__vector_size__(2 * sizeof(int))));
#define AT_STOREV(Vx) do { _Pragma("unroll") for (int it = 0; it < 8; ++it) { const int r = 8 * (lane >> 3) + it; const int fk = ((r >> 2) & 3) | (((r >> 4) & 1) << 2); \
        *(u32x4*)(vl + r * 128 + (((lane & 7) ^ fk) << 4)) = Vx[it]; } } while (0)
#define AT_PV(c) do { _Pragma("unroll") for (int ipl = 0; ipl < 2; ++ipl) { const int qq = fr >> 1; const int r = 16 * kg + 4 * (qq & 3) + 2 * ipl + (qq >> 2); const int fk = ((r >> 2) & 3) | (((r >> 4) & 1) << 2); \
        _Pragma("unroll") for (int ct = 0; ct < 8; ++ct) { const LAS unsigned char* a0 = vll + r * 128 + ((ct ^ fk) << 4) + (fr & 1) * 8; \
            const v2i_t bv = __builtin_amdgcn_ds_read_tr8_b64_v2i32((LAS v2i_t*)a0); \
            O[ct] = __builtin_amdgcn_mfma_f32_16x16x32_fp8_fp8(Pf[2 * (c) + ipl], __builtin_bit_cast(long, bv), O[ct], 0, 0, 0); } } } while (0)
    AT_STOREV(R1); AT_GATHER(R1, avb, 3); AT_PV(0);
    AT_STOREV(R2); AT_PV(1);
    AT_STOREV(R0); AT_PV(2);
    AT_STOREV(R1); AT_PV(3);
#undef AT_GATHER
#undef AT_STOREK
#undef AT_READK
#undef AT_MMAK
#undef AT_STOREV
#undef AT_PV
    h16* ot = (h16*)vl;
    if (kg == 0) {
#pragma unroll
        for (int ct = 0; ct < 8; ++ct)
#pragma unroll
            for (int r = 0; r < 4; ++r) ot[r * 128 + 16 * ct + fr] = (h16)O[ct][r];
    }
    {
        const h16x8 ov = *(const h16x8*)(ot + 8 * lane);
        float rs[8];
#pragma unroll
        for (int j = 0; j < 8; ++j) rs[j] = (float)ov[j] * (float)gate[j] * (16.0f / 256.0f);
        int w0 = 0, w1 = 0;
        w0 = __builtin_amdgcn_cvt_pk_fp8_f32(rs[0], rs[1], w0, false); w0 = __builtin_amdgcn_cvt_pk_fp8_f32(rs[2], rs[3], w0, true);
        w1 = __builtin_amdgcn_cvt_pk_fp8_f32(rs[4], rs[5], w1, false); w1 = __builtin_amdgcn_cvt_pk_fp8_f32(rs[6], rs[7], w1, true);
        typedef int i32x2q __attribute__((ext_vector_type(2)));
        *(i32x2q*)(p.ws + OFF_OMIX + (size_t)bt * 3072 + 2048 + (4 * g) * 128 + 8 * lane) = (i32x2q){w0, w1};
    }
#pragma unroll
    for (int c = 0; c < 4; ++c) kix[c] = kixn[c];
    }
#undef AT_LOADI
}

__device__ __forceinline__ void phase5(const Params& p) {
    const int tid = opaque_tid(), wid = tid >> 6, lane = tid & 63;
    const int gw = blockIdx.x * 8 + wid, nw = gridDim.x * 8;
    const float* rowss = (const float*)(p.ws + OFF_ROWSS);
    for (int row = gw; row < BT; row += nw) {
        const float r = 1.0f / sqrtf(rowss[row] * (1.0f / DM) + EPS);
        f32x4* o = (f32x4*)(p.out + (size_t)row * DM);
        float eadd = 0.f;
        if ((TS_A >= 0 || TS_ACC >= 0) && row < 164) { const unsigned* ts = (const unsigned*)(p.ws + OFF_CTRL + 8192); const float tus = (TS_ACC >= 0) ? (float)ts[16 + (TS_ACC >= 0 ? TS_ACC : 0)] * (0.01f / 256.0f) : (float)(ts[TS_B >= 0 ? TS_B : 0] - ts[TS_A >= 0 ? TS_A : 0]) * 0.01f; eadd = sqrtf(tus * 1e-5f); }
#pragma unroll
        for (int i = 0; i < 8; ++i) { const f32x4 g = ((const f32x4*)p.final_g)[lane + 64 * i]; f32x4 v = o[lane + 64 * i]; v = v * r * g + eadd; o[lane + 64 * i] = v; }
    }
}

#define XB_TMO      128
#define XB_XCNT(j)  (256  + 64 * (j))
#define XB_XSUB(j)  (1280 + 64 * (j))
#define XB_XGEN(j)  (2304 + 64 * (j))
#define XB_TOP      3328
#define XB_TOPGEN   3392
#define XCD_BAR_WORDS 3456
#define XB_SPIN_CAP (1u << 18)

__device__ __forceinline__ unsigned xb_ld(unsigned* p)              { return __hip_atomic_load(p, __ATOMIC_RELAXED, __HIP_MEMORY_SCOPE_AGENT); }
__device__ __forceinline__ unsigned xb_add(unsigned* p, unsigned v) { return __hip_atomic_fetch_add(p, v, __ATOMIC_RELAXED, __HIP_MEMORY_SCOPE_AGENT); }
__device__ __forceinline__ unsigned xb_xcc_id() { return (unsigned)__builtin_amdgcn_s_getreg((3 << 11) | 20) & 0xFu; }
#define XB_SPIN(cond, bar) do { unsigned _sp = 0; while (cond) { __builtin_amdgcn_s_sleep(1); \
    if ((++_sp & 255u) == 0u) { if (xb_ld(&(bar)[XB_TMO])) break; if (_sp > XB_SPIN_CAP) { atomicAdd(&(bar)[XB_TMO], 1u); break; } } } } while (0)

struct XcdBarrier {
    unsigned* bar; unsigned x;
    volatile LAS unsigned* st;
};

__device__ __forceinline__ XcdBarrier xcd_barrier_post(unsigned* bar, volatile LAS unsigned* st) {
    XcdBarrier b; b.bar = bar; b.x = xb_xcc_id(); b.st = st;
    if (threadIdx.x == 0) (void)xb_add(&bar[XB_XCNT(b.x)], 1u);
    return b;
}
__device__ __forceinline__ void xcd_barrier_complete(unsigned* bar, unsigned x, unsigned& nloc, unsigned& nx) {
    const unsigned G = gridDim.x * gridDim.y * gridDim.z;
    unsigned sum, cnt, mine, sp = 0u;
    for (;;) {
        sum = 0u; cnt = 0u; mine = 0u;
#pragma unroll
        for (unsigned j = 0; j < 16; ++j) { const unsigned c = xb_ld(&bar[XB_XCNT(j)]); sum += c; cnt += (c > 0u) ? 1u : 0u; mine = (j == x) ? c : mine; }
        if (sum == G) break;
        __builtin_amdgcn_s_sleep(1);
        if ((++sp & 255u) == 0u) { if (xb_ld(&bar[XB_TMO])) break; if (sp > XB_SPIN_CAP) { atomicAdd(&bar[XB_TMO], 1u); break; } }
    }
    nloc = mine > 0u ? mine : 1u; nx = cnt > 0u ? cnt : 1u;
}

__device__ __forceinline__ void xcd_barrier(const XcdBarrier& b) {
    asm volatile("s_waitcnt vmcnt(0)" ::: "memory");
    __syncthreads();
    if (threadIdx.x == 0) {
        unsigned* bar = b.bar;
        __builtin_amdgcn_s_waitcnt(0);
        unsigned nloc = b.st[0], nx = b.st[1];
        if (nloc == 0u) { xcd_barrier_complete(bar, b.x, nloc, nx); b.st[0] = nloc; b.st[1] = nx; }
        const unsigned old = xb_add(&bar[XB_XSUB(b.x)], 1u);
        const unsigned gen = old / nloc;
        if (old + 1u == (gen + 1u) * nloc) {
            __builtin_amdgcn_fence(__ATOMIC_RELEASE, "agent");
            asm volatile("s_waitcnt vmcnt(0)" ::: "memory");
            const unsigned og = xb_add(&bar[XB_TOP], 1u);
            const unsigned tg = og / nx;
            if (og + 1u == (tg + 1u) * nx) xb_add(&bar[XB_TOPGEN], 1u);
            else XB_SPIN(xb_ld(&bar[XB_TOPGEN]) == tg, bar);
            __builtin_amdgcn_fence(__ATOMIC_ACQUIRE, "agent");
            xb_add(&bar[XB_XGEN(b.x)], 1u);
            asm volatile("s_waitcnt vmcnt(0)" ::: "memory");
        } else {
            XB_SPIN(xb_ld(&bar[XB_XGEN(b.x)]) == gen, bar);
            __builtin_amdgcn_fence(__ATOMIC_ACQUIRE, "agent");
            asm volatile("s_waitcnt vmcnt(0)" ::: "memory");
        }
    }
    __syncthreads();
}


template <int LO, int HI>
__global__ void __launch_bounds__(512, 2) k_phases(Params p) {
    extern __shared__ __attribute__((aligned(16))) unsigned char smem[];
#define IN(k) (LO <= (k) && (k) < HI)
#define SEAM(k) do { if constexpr (IN(k) && IN((k) + 1)) { xcd_barrier(xbar); if (TS_A >= 0 && blockIdx.x == 0 && threadIdx.x == 0) ((unsigned*)(p.ws + OFF_CTRL + 8192))[(k) + 1] = (unsigned)__builtin_amdgcn_s_memrealtime(); } } while (0)
    XcdBarrier xbar; xbar.bar = nullptr; xbar.x = 0; xbar.st = nullptr;
    if constexpr (HI - LO > 1) {
        volatile LAS unsigned* stw = (volatile LAS unsigned*)((LAS unsigned char*)smem + LDS_BYTES - 48);
        if (threadIdx.x < 4) stw[threadIdx.x] = 0u;
        __syncthreads();
        xbar = xcd_barrier_post((unsigned*)(p.ws + OFF_CTRL + 16384), stw);
    }
    if (TS_A >= 0 && blockIdx.x == 0 && threadIdx.x == 0) ((unsigned*)(p.ws + OFF_CTRL + 8192))[0] = (unsigned)__builtin_amdgcn_s_memrealtime();
    if constexpr (IN(0)) { for (int rep = 0; rep < NREP(0); ++rep) phase0(p, smem); }
    SEAM(0);
    if constexpr (IN(1)) for (int rep = 0; rep < NREP(1); ++rep) {
        EpiIn E{p.ws, p.a_log, p.dt_bias, p.pos};
        {
            pg8::Gemm g{(const h16*)(p.ws + OFF_H), (const h16*)(p.ws + OFF_WT), BT, NPAD, DM};
            OrderF16 S; S.init(BT, 21 * 256, gridDim.x, blockIdx.x);
            pg8::gemm_phase<EpiIn, OrderF16>((LAS unsigned char*)smem, g, S, E);
        }
        {
            pg8::Gemm g{(const h16*)(p.ws + OFF_H8), (const h16*)(p.ws + OFF_WT8 - (size_t)16 * 256 * 2048), BT, 2560, DM};
            OrderF8 S; S.G = gridDim.x; S.c = blockIdx.x;
            pg8::gemm_phase<EpiIn, OrderF8, true, true>((LAS unsigned char*)smem, g, S, E);
        }
    }
    SEAM(1);
    if constexpr (IN(2)) for (int rep = 0; rep < NREP(2); ++rep) {
        {
            unsigned* qctr = (unsigned*)(p.ws + OFF_CTRL);
            volatile unsigned* lds_t = (volatile unsigned*)(smem + LDS_BYTES - 16);
            __syncthreads();
            if (threadIdx.x == 0) lds_t[0] = atomicAdd(qctr + 0 + 16 * rep, 1u);
            __syncthreads();
            unsigned o = lds_t[0];
            unsigned* pdone = qctr + 300;
            bool published = false;
            while (o < 1024u + 32u + 2048u) {
                unsigned nxt = 0u;
                if (threadIdx.x == 0) nxt = atomicAdd(qctr + 0 + 16 * rep, 1u);
                if (o < 1024u) { ACC_T0(); gdn_prep_pair(p, smem, (int)o); __syncthreads(); ACC_ADD(0); }
                else {
                    if (!published) {
                        published = true;
                        asm volatile("s_waitcnt vmcnt(0)" ::: "memory"); __syncthreads();
                        if (threadIdx.x == 0) { __builtin_amdgcn_fence(__ATOMIC_RELEASE, "agent"); asm volatile("s_waitcnt vmcnt(0)" ::: "memory"); __hip_atomic_fetch_add(pdone, 1u, __ATOMIC_RELAXED, __HIP_MEMORY_SCOPE_AGENT); }
                    }
                    if (o < 1056u) {
                        if (threadIdx.x == 0) { unsigned spins = 0; while (__hip_atomic_load(pdone, __ATOMIC_RELAXED, __HIP_MEMORY_SCOPE_AGENT) < gridDim.x) { __builtin_amdgcn_s_sleep(8); if (++spins > (1u << 22)) break; } }
                        __syncthreads();
                        __builtin_amdgcn_fence(__ATOMIC_ACQUIRE, "agent"); asm volatile("s_waitcnt vmcnt(0)" ::: "memory");
                        gdn_scan_task(p, smem, (int)(o - 1024u)); __syncthreads();
                    } else { const unsigned o2 = o - 1056u; idx8_task(p, smem, (int)(o2 & 3u), 511 - (int)(o2 >> 2)); }
                }
                __syncthreads();
                if (threadIdx.x == 0) lds_t[0] = nxt;
                __syncthreads();
                o = lds_t[0];
            }
            if (!published) {
                asm volatile("s_waitcnt vmcnt(0)" ::: "memory"); __syncthreads();
                if (threadIdx.x == 0) { __builtin_amdgcn_fence(__ATOMIC_RELEASE, "agent"); asm volatile("s_waitcnt vmcnt(0)" ::: "memory"); __hip_atomic_fetch_add(pdone, 1u, __ATOMIC_RELAXED, __HIP_MEMORY_SCOPE_AGENT); }
            }
        }
    }
    SEAM(2);
    if constexpr (IN(3)) for (int rep = 0; rep < NREP(3); ++rep) {
        {
            unsigned* qctr = (unsigned*)(p.ws + OFF_CTRL);
            volatile unsigned* lds_t = (volatile unsigned*)(smem + LDS_BYTES - 16);
            volatile unsigned* lds_c = (volatile unsigned*)(smem + LDS_BYTES - 192);
            const int myx = (int)(xb_xcc_id() & 7u);
            {
                for (int k = 0; k < 8; ++k) {
                    const int part = (myx + k) & 7;
                    if (k == 1) { __syncthreads(); if (threadIdx.x < 8) lds_c[threadIdx.x] = __hip_atomic_load(qctr + 128 + 16 * rep + threadIdx.x, __ATOMIC_RELAXED, __HIP_MEMORY_SCOPE_AGENT); __syncthreads(); }
                    if (k >= 1 && lds_c[part] >= 512u) continue;
                    __syncthreads();
                    if (threadIdx.x == 0) lds_t[0] = atomicAdd(qctr + 128 + 16 * rep + part, 1u);
                    __syncthreads();
                    unsigned a = lds_t[0];
                    while (a < 512u) {
                        unsigned nxt = 0u;
                        if (threadIdx.x == 0) nxt = atomicAdd(qctr + 128 + 16 * rep + part, 1u);
                        { ACC_T0(); attn8_task(p, smem, part, (int)a); __syncthreads(); ACC_ADD(3); }
                        __syncthreads();
                        if (threadIdx.x == 0) lds_t[0] = nxt;
                        __syncthreads();
                        a = lds_t[0];
                    }
                }
            }
        }
    }
    SEAM(3);
    const bool fuse_norm = (gridDim.x == 256) && (TS_A < 0) && (TS_ACC < 0);
    if constexpr (IN(4)) {
        pg8::Gemm g{(const h16*)(p.ws + OFF_OMIX), (const h16*)(p.ws + OFF_WOT), BT, DM, DM};
        if (fuse_norm) {
            PanelOrder S; S.c = blockIdx.x;
            EpiOutNorm E{p.x, p.out, (float*)(p.ws + OFF_ROWSS), (unsigned*)(p.ws + OFF_CTRL + 32768), p.final_g};
            pg8::gemm_phase<EpiOutNorm, PanelOrder, true, false, true, 0x79797979u, 0x7B7B7B7Bu>((LAS unsigned char*)smem, g, S, E);
        } else {
            pg8::StaticOrder S; S.init(BT, DM, gridDim.x, blockIdx.x);
            EpiOut E{p.x, p.out, (float*)(p.ws + OFF_ROWSS)};
            pg8::gemm_phase<EpiOut, pg8::StaticOrder, true, false, true, 0x79797979u, 0x7B7B7B7Bu>((LAS unsigned char*)smem, g, S, E);
        }
    }
    if (fuse_norm) return;
    SEAM(4);
    if constexpr (IN(5)) { phase5(p); }
#undef IN
#undef SEAM
}

template <int LO, int HI> static void launch_range(const Params& p, int grid, hipStream_t stream, bool coop) {
    static bool attr = false;
    if (!attr) { hipFuncSetAttribute((const void*)k_phases<LO, HI>, hipFuncAttributeMaxDynamicSharedMemorySize, LDS_BYTES); attr = true; }
    if (coop) {
        Params pp = p; void* args[] = {&pp};
        hipError_t e = hipLaunchCooperativeKernel((const void*)k_phases<LO, HI>, dim3(grid), dim3(512), args, LDS_BYTES, stream);
        if (e != hipSuccess) fprintf(stderr, "cooperative launch failed: %s (grid %d)\n", hipGetErrorString(e), grid);
    } else {
        hipLaunchKernelGGL((k_phases<LO, HI>), dim3(grid), dim3(512), LDS_BYTES, stream, p);
    }
}

extern "C" void kernel_launch(void* const* d_in, const int* in_sizes, int n_in, void* d_out, int out_size, void* d_ws, size_t ws_size, hipStream_t stream) {
    if (n_in != 10 || in_sizes[0] != BT * DM || out_size != BT * DM || ws_size < WS_END) {
        fprintf(stderr, "kernel_launch: unexpected shapes (n_in %d in0 %d out %d ws %zu need %zu)\n", n_in, n_in > 0 ? in_sizes[0] : -1, out_size, ws_size, (size_t)WS_END); return; }
    static int grid = 0;
    if (!grid) {
        int dev = 0, cus = 0, per_cu = 0; hipGetDevice(&dev); hipDeviceGetAttribute(&cus, hipDeviceAttributeMultiprocessorCount, dev);
#if FUSED
        hipFuncSetAttribute((const void*)k_phases<0, 6>, hipFuncAttributeMaxDynamicSharedMemorySize, LDS_BYTES);
        hipOccupancyMaxActiveBlocksPerMultiprocessor(&per_cu, (const void*)k_phases<0, 6>, 512, LDS_BYTES);
#else
        per_cu = 1;
#endif
        if (per_cu < 1) per_cu = 1; if (per_cu > 1) per_cu = 1;
        grid = cus * per_cu;
    }
    Params p{};
    p.x = (const float*)d_in[0]; p.pos = (const int*)d_in[1]; p.attn_g = (const float*)d_in[2]; p.w_in = (const float*)d_in[3]; p.conv_w = (const float*)d_in[4];
    p.a_log = (const float*)d_in[5]; p.dt_bias = (const float*)d_in[6]; p.gdn_norm_g = (const float*)d_in[7]; p.w_out = (const float*)d_in[8]; p.final_g = (const float*)d_in[9];
    p.out = (float*)d_out; p.ws = (unsigned char*)d_ws;
    hipMemsetAsync((char*)d_ws + OFF_CTRL, 0, CTL_ZERO_BYTES, stream);
#if FUSED
    launch_range<0, 6>(p, grid, stream, false);
#else
    launch_range<0, 1>(p, grid, stream, false);
    launch_range<1, 2>(p, grid, stream, false);
    launch_range<2, 3>(p, grid, stream, false);
    launch_range<3, 4>(p, grid, stream, false);
    launch_range<4, 5>(p, grid, stream, false);
    launch_range<5, 6>(p, grid, stream, false);
#endif
}
```

```cpp
#include <hip/hip_runtime.h>
#include <hip/hip_cooperative_groups.h>
#include <cstdio>
#include <cstdint>
namespace cg = cooperative_groups;

#ifndef FUSED
#define FUSED 1
#endif
#ifndef REPEAT_PHASE
#define REPEAT_PHASE -1
#endif
#define NREP(k) ((REPEAT_PHASE == (k)) ? 2 : 1)
#ifndef TS_A
#define TS_A -1
#endif
#ifndef TS_ACC
#define TS_ACC -1
#endif
#define ACC_T0() unsigned acc_t0_ = 0; if (TS_ACC >= 0 && threadIdx.x == 0) acc_t0_ = (unsigned)__builtin_amdgcn_s_memrealtime()
#define ACC_ADD(k) do { if (TS_ACC >= 0 && threadIdx.x == 0) { const unsigned t1_ = (unsigned)__builtin_amdgcn_s_memrealtime(); atomicAdd((unsigned*)(p.ws + OFF_CTRL + 8192) + 16 + (k), t1_ - acc_t0_); acc_t0_ = t1_; } } while (0)
#ifndef TS_B
#define TS_B -1
#endif

#define LAS __attribute__((address_space(3)))
typedef _Float16 h16;
typedef h16 h16x8 __attribute__((ext_vector_type(8)));
typedef h16 h16x4 __attribute__((ext_vector_type(4)));
typedef h16 h16x2 __attribute__((ext_vector_type(2)));
typedef float f32x4 __attribute__((ext_vector_type(4)));
typedef float f32x2 __attribute__((ext_vector_type(2)));
typedef unsigned u32x4 __attribute__((ext_vector_type(4)));

constexpr int NB = 4, NT = 4096, DM = 2048, BT = NB * NT;
constexpr int IN_COLS = 7776, NPAD = 7936;
constexpr float EPS = 1e-6f;
constexpr int LDS_BYTES = 155648;

constexpr size_t MB = 1024 * 1024;
constexpr size_t OFF_CTRL = 0;
constexpr size_t OFF_ROWSS = 65536;
constexpr size_t CTL_ZERO_BYTES = 65536 + (size_t)BT * 4;
constexpr size_t OFF_H = 1 * MB;
constexpr size_t OFF_OMIX = OFF_H;
constexpr size_t OFF_WT = OFF_H + 64 * MB;
constexpr size_t OFF_WOT = OFF_WT + (size_t)NPAD * 2048 * 2;
constexpr size_t OFF_QKVR = OFF_WOT + 8 * MB;
constexpr size_t OFF_GZ = OFF_QKVR + (size_t)BT * 3072 * 2;
constexpr size_t OFF_AQ = OFF_GZ + 32 * MB;
constexpr size_t OFF_AK = OFF_AQ + 32 * MB;
constexpr size_t OFF_AV = OFF_AK + 8 * MB;
constexpr size_t OFF_AZ = OFF_AV + 8 * MB;
constexpr size_t OFF_IQ = OFF_AZ + 32 * MB;
constexpr size_t OFF_IK = OFF_IQ + 32 * MB;
constexpr size_t OFF_GB = OFF_IK + 2 * MB;
constexpr size_t OFF_IW = OFF_GB + 1 * MB;
constexpr size_t OFF_COS = OFF_IW + 1 * MB;
constexpr size_t OFF_SIN = OFF_COS + 2 * MB;
constexpr size_t OFF_SEL = OFF_SIN + 2 * MB;
constexpr size_t OFF_REC = OFF_SEL + 8 * MB;
constexpr size_t OFF_H8 = OFF_REC;
constexpr size_t OFF_WT8 = OFF_REC + 32 * MB;
constexpr size_t WS_END = OFF_REC + (size_t)2048 * 74752;

struct Params {
    const float* x; const int* pos; const float* attn_g; const float* w_in; const float* conv_w; const float* a_log;
    const float* dt_bias; const float* gdn_norm_g; const float* w_out; const float* final_g; float* out; unsigned char* ws;
};

__device__ __forceinline__ float wave_sum(float v) {
#pragma unroll
    for (int o = 1; o < 64; o <<= 1) v += __shfl_xor(v, o);
    return v;
}
__device__ __forceinline__ float wave_max(float v) {
#pragma unroll
    for (int o = 1; o < 64; o <<= 1) v = fmaxf(v, __shfl_xor(v, o));
    return v;
}
#define LDS_SYNC() do { asm volatile("s_waitcnt lgkmcnt(0)" ::: "memory"); __builtin_amdgcn_s_barrier(); asm volatile("" ::: "memory"); } while (0)
__device__ __forceinline__ int opaque_tid() { int t = threadIdx.x; asm volatile("" : "+v"(t)); return t; }
#define SC_DPP(v, ctrl) __builtin_bit_cast(float, __builtin_amdgcn_update_dpp(0, __builtin_bit_cast(int, (float)(v)), (ctrl), 0xF, 0xF, true))
__device__ __forceinline__ float lane_xor16(float v, int kg) { const unsigned x = __builtin_bit_cast(unsigned, v); const auto sw = __builtin_amdgcn_permlane16_swap(x, x, false, false); return __builtin_bit_cast(float, (kg & 1) ? sw[0] : sw[1]); }
__device__ __forceinline__ float lane_xor32(float v, int kg) { const unsigned x = __builtin_bit_cast(unsigned, v); const auto sw = __builtin_amdgcn_permlane32_swap(x, x, false, false); return __builtin_bit_cast(float, (kg < 2) ? sw[1] : sw[0]); }
__device__ __forceinline__ float silu_f(float x) { return x * __builtin_amdgcn_rcpf(1.0f + __builtin_amdgcn_exp2f(-1.4426950408889634f * x)); }

namespace pg8 {
constexpr int BM = 256, BK = 64, HALF = 128, HTB = HALF * BK * 2, STAGE_BYTES = 8 * HTB, NXCD = 8, WGM = 8;
__host__ __device__ __forceinline__ int lds_byte(int r, int c) { const int st = (r >> 4) * 2 + (c >> 5), rr = r & 15, cc = c & 31, ob = rr * 64 + cc * 2; return st * 1024 + (ob ^ (((ob >> 9) & 1) << 5)); }
__host__ __device__ __forceinline__ void stage_rc(int b, int& R, int& C) { const int st = b / 1024, sb = b % 1024, swz = sb ^ (((sb >> 9) & 1) << 5); R = (st >> 1) * 16 + swz / 64; C = (st & 1) * 32 + (swz % 64) / 2; }
__host__ __device__ __forceinline__ int perm32(int rho) { const int n = rho >> 4, i = rho & 15; return 8 * (i >> 2) + 4 * n + (i & 3); }
struct Unit { int pm, pn; };
struct Gemm { const h16* A; const h16* Bt; int M, N, K; };
struct StaticOrder {
    int nM, nN, nwg, G, c;
    __host__ __device__ void init(int M, int N, int G_, int c_) { nM = M / BM; nN = N / BM; nwg = nM * nN; G = G_; c = c_; }
    __host__ __device__ bool next(int i, Unit& u) const {
        const long L = (long)i * G + c; if (L >= nwg) return false;
        int wgid = (int)L; { const int q = nwg / NXCD, r = nwg % NXCD, xcd = wgid % NXCD, off = wgid / NXCD; wgid = (xcd < r ? xcd * (q + 1) : r * (q + 1) + (xcd - r) * q) + off; }
        const int nig = WGM * nN, gid = wgid / nig, fm = gid * WGM, gsz = (nM - fm) < WGM ? (nM - fm) : WGM;
        u.pm = fm + ((wgid % nig) % gsz); u.pn = (wgid % nig) / gsz; return true;
    }
    __device__ __forceinline__ void a_ready(const Unit&) const {}
    __device__ __forceinline__ void done(const Unit&) const {}
};

typedef int i32x8 __attribute__((ext_vector_type(8)));
template <class Epi, class Sched, bool SP2 = true, bool F8 = false, bool SPLIT = false, unsigned SCW = 0x7C7C7C7Cu, unsigned SCA = 0x7C7C7C7Cu>
__device__ __forceinline__ void gemm_phase(LAS unsigned char* lds, const Gemm g, const Sched& S, const Epi& E) {
    const int tid = opaque_tid(), wid = __builtin_amdgcn_readfirstlane(tid >> 6), lane = tid & 63, wr = wid >> 2, wc = wid & 3, fr = lane & 15, fq = lane >> 4;
    const int K = g.K;
    const int ESZ = F8 ? 1 : 2, RB = SPLIT ? 3072 : K * ESZ, nt = RB / 128;
    unsigned voffA[2], voffB[2];
#pragma unroll
    for (int i = 0; i < 2; ++i) { int R, C; stage_rc(tid * 16 + i * 8192, R, C); const int Rb = Epi::PERM ? ((R & ~31) + perm32(R & 31)) : R;
        voffA[i] = (unsigned)(R * RB + C * 2); voffB[i] = (unsigned)(Rb * RB + C * 2); }
    const size_t kstep = (size_t)(BK * 2);
    const size_t hstep = (size_t)HALF * RB;
    const size_t tstep = 2 * hstep;
    const unsigned ldsw = (unsigned)wid * 1024u;
    const int aoff = lds_byte(wr * 64 + fr, fq * 8), boff = lds_byte(wc * 32 + fr, fq * 8);
#define PG8_SA(b, h) (((b) * 2 + (h)) * HTB)
#define PG8_SB(b, h) ((4 + (b) * 2 + (h)) * HTB)
#define PG8_STAGE(bufoff, gbase, voff) do { _Pragma("unroll") for (int _i = 0; _i < 2; ++_i) \
        __builtin_amdgcn_global_load_lds((const unsigned*)((const char*)(gbase) + (voff)[_i]), (LAS unsigned*)(lds + (bufoff) + ldsw + _i * 8192), 16, 0, 0); } while (0)
#define PG8_LDA(dst, b, h) do { _Pragma("unroll") for (int m = 0; m < 4; ++m) _Pragma("unroll") for (int k = 0; k < 2; ++k) dst[m][k] = *(const LAS h16x8*)(lds + PG8_SA(b, h) + aoff + m * 2048 + k * 1024); } while (0)
#define PG8_LDB(dst, b, h) do { _Pragma("unroll") for (int n = 0; n < 2; ++n) _Pragma("unroll") for (int k = 0; k < 2; ++k) dst[n][k] = *(const LAS h16x8*)(lds + PG8_SB(b, h) + boff + n * 2048 + k * 1024); } while (0)
#define PG8_MMA8(ai, bj, At, Bt) do { __builtin_amdgcn_s_setprio(1); \
        _Pragma("unroll") for (int m = 0; m < 4; ++m) _Pragma("unroll") for (int n = 0; n < 2; ++n) { \
            const u32x4 b0_ = __builtin_bit_cast(u32x4, Bt[n][0]), b1_ = __builtin_bit_cast(u32x4, Bt[n][1]), a0_ = __builtin_bit_cast(u32x4, At[m][0]), a1_ = __builtin_bit_cast(u32x4, At[m][1]); \
            const i32x8 bw_ = (i32x8){(int)b0_[0], (int)b0_[1], (int)b0_[2], (int)b0_[3], (int)b1_[0], (int)b1_[1], (int)b1_[2], (int)b1_[3]}; \
            const i32x8 aw_ = (i32x8){(int)a0_[0], (int)a0_[1], (int)a0_[2], (int)a0_[3], (int)a1_[0], (int)a1_[1], (int)a1_[2], (int)a1_[3]}; \
            asm volatile("v_mfma_scale_f32_16x16x128_f8f6f4 %0, %1, %2, %0, %3, %4 op_sel_hi:[0,0,0]" : "+v"(acc[ai][bj][m][n]) : "v"(bw_), "v"(aw_), "v"(SCW), "v"(SCA)); } \
        __builtin_amdgcn_s_setprio(0); } while (0)
#define PG8_MMA16(ai, bj, At, Bt) do { __builtin_amdgcn_s_setprio(1); \
        _Pragma("unroll") for (int m = 0; m < 4; ++m) _Pragma("unroll") for (int n = 0; n < 2; ++n) _Pragma("unroll") for (int k = 0; k < 2; ++k) { \
            if constexpr (SPLIT) asm volatile("v_mfma_f32_16x16x32_f16 %0, %1, %2, %0" : "+v"(acc[ai][bj][m][n]) : "v"(Bt[n][k]), "v"(At[m][k]));     \
            else acc[ai][bj][m][n] = __builtin_amdgcn_mfma_f32_16x16x32_f16(Bt[n][k], At[m][k], acc[ai][bj][m][n], 0, 0, 0); } \
        __builtin_amdgcn_s_setprio(0); } while (0)
#define PG8_ITER(MMA) do { \
            PG8_LDB(B0, 0, 0); PG8_LDB(B1, 0, 1); PG8_SCHED; PG8_LDA(At, 0, 0); PG8_STAGE(PG8_SA(1, 1), a1 + hstep, voffA); \
            PG8_WAIT_V(8); PG8_WAIT_L(0); PG8_BAR; MMA(0, 0, At, B0); MMA(0, 1, At, B1); PG8_BAR; PG8_SCHED; \
            PG8_LDA(At, 0, 1); PG8_STAGE(PG8_SB(0, 0), b2, voffB); PG8_STAGE(PG8_SB(0, 1), b2 + hstep, voffB); PG8_STAGE(PG8_SA(0, 0), a2, voffA); \
            PG8_WAIT_V(8); PG8_WAIT_L(0); PG8_BAR; MMA(1, 0, At, B0); MMA(1, 1, At, B1); PG8_BAR; PG8_SCHED; \
            PG8_LDB(B0, 1, 0); PG8_LDB(B1, 1, 1); PG8_SCHED; PG8_LDA(At, 1, 0); PG8_STAGE(PG8_SA(0, 1), a2 + hstep, voffA); \
            PG8_WAIT_V(8); PG8_WAIT_L(0); PG8_BAR; MMA(0, 0, At, B0); MMA(0, 1, At, B1); PG8_BAR; PG8_SCHED; \
            PG8_LDA(At, 1, 1); PG8_STAGE(PG8_SB(1, 0), b3, voffB); PG8_STAGE(PG8_SB(1, 1), b3 + hstep, voffB); PG8_STAGE(PG8_SA(1, 0), a3, voffA); \
            PG8_WAIT_V(8); PG8_WAIT_L(0); PG8_BAR; MMA(1, 0, At, B0); MMA(1, 1, At, B1); PG8_BAR; PG8_SCHED; \
            } while (0)
#define PG8_MMA(ai, bj, At, Bt) PG8_MMA16(ai, bj, At, Bt)
#define PG8_WAIT_V(n) asm volatile("s_waitcnt vmcnt(" #n ")" ::: "memory")
#define PG8_WAIT_L(n) asm volatile("s_waitcnt lgkmcnt(" #n ")" ::: "memory")
#define PG8_BAR __builtin_amdgcn_s_barrier()
#define PG8_SCHED __builtin_amdgcn_sched_barrier(0)
    Unit cur, nxt; int ui = 0;
    if (!S.next(0, cur)) return;
    f32x4 acc[2][2][4][2];
#pragma unroll
    for (int a = 0; a < 2; ++a)
#pragma unroll
        for (int b = 0; b < 2; ++b)
#pragma unroll
            for (int m = 0; m < 4; ++m)
#pragma unroll
                for (int n = 0; n < 2; ++n) acc[a][b][m][n] = (f32x4){0.f, 0.f, 0.f, 0.f};
    h16x8 At[4][2], B0[2][2], B1[2][2];
    const char* cA = (const char*)g.A + (size_t)cur.pm * tstep; const char* cB = (const char*)g.Bt + (size_t)cur.pn * tstep;
    S.a_ready(cur);
    if constexpr (SP2) {
        PG8_STAGE(PG8_SB(0, 0), cB, voffB); PG8_STAGE(PG8_SB(0, 1), cB + hstep, voffB); PG8_STAGE(PG8_SA(0, 0), cA, voffA); PG8_STAGE(PG8_SA(0, 1), cA + hstep, voffA);
        if (wr == 1) PG8_BAR;
        PG8_WAIT_V(2); PG8_BAR;
        PG8_STAGE(PG8_SB(1, 0), cB + kstep, voffB); PG8_STAGE(PG8_SA(1, 0), cA + kstep, voffA); PG8_STAGE(PG8_SB(1, 1), cB + hstep + kstep, voffB);
        PG8_WAIT_V(6); PG8_BAR;
    } else {
    PG8_STAGE(PG8_SB(0, 0), cB, voffB); PG8_STAGE(PG8_SA(0, 0), cA, voffA); PG8_STAGE(PG8_SB(0, 1), cB + hstep, voffB); PG8_STAGE(PG8_SA(0, 1), cA + hstep, voffA);
    if (wr == 1) PG8_BAR;
    PG8_WAIT_V(4); PG8_BAR;
    PG8_STAGE(PG8_SB(1, 0), cB + kstep, voffB); PG8_STAGE(PG8_SA(1, 0), cA + kstep, voffA); PG8_STAGE(PG8_SB(1, 1), cB + hstep + kstep, voffB);
    PG8_WAIT_V(6); PG8_BAR;
    }
    for (;;) {
        const bool has_next = S.next(ui + 1, nxt);
        const char* nA = has_next ? (const char*)g.A + (size_t)nxt.pm * tstep : cA; const char* nB = has_next ? (const char*)g.Bt + (size_t)nxt.pn * tstep : cB;
#define PG8_PTRS const bool last = (t == nt - 2); const char* a1 = cA + (size_t)(t + 1) * kstep; const char* a2 = last ? nA : cA + (size_t)(t + 2) * kstep; const char* b2 = last ? nB : cB + (size_t)(t + 2) * kstep; const char* a3 = a2 + kstep; const char* b3 = b2 + kstep; if (last && has_next) S.a_ready(nxt);
        if constexpr (SPLIT) {
            for (int t = 0; t < 16; t += 2) { PG8_PTRS PG8_ITER(PG8_MMA16); }
            for (int t = 16; t < nt; t += 2) { PG8_PTRS PG8_ITER(PG8_MMA8); }
        } else
        for (int t = 0; t < nt; t += 2) {
            PG8_PTRS
            if constexpr (SP2) {
            if constexpr (F8) PG8_ITER(PG8_MMA8); else PG8_ITER(PG8_MMA16);
            } else {
            PG8_LDB(B0, 0, 0); PG8_SCHED; PG8_LDA(At, 0, 0); PG8_STAGE(PG8_SA(1, 1), a1 + hstep, voffA);
            PG8_WAIT_L(8); PG8_BAR; PG8_WAIT_L(0); PG8_MMA(0, 0, At, B0); PG8_BAR; PG8_SCHED;
            PG8_LDB(B1, 0, 1); PG8_STAGE(PG8_SB(0, 0), b2, voffB);
            PG8_BAR; PG8_WAIT_L(0); PG8_MMA(0, 1, At, B1); PG8_BAR;
            PG8_LDA(At, 0, 1); PG8_STAGE(PG8_SA(0, 0), a2, voffA);
            PG8_BAR; PG8_WAIT_L(0); PG8_MMA(1, 0, At, B0); PG8_BAR; PG8_SCHED;
            PG8_STAGE(PG8_SB(0, 1), b2 + hstep, voffB);
            PG8_WAIT_V(6); PG8_BAR; PG8_MMA(1, 1, At, B1); PG8_BAR;
            PG8_LDB(B0, 1, 0); PG8_SCHED; PG8_LDA(At, 1, 0); PG8_STAGE(PG8_SA(0, 1), a2 + hstep, voffA);
            PG8_WAIT_L(8); PG8_BAR; PG8_WAIT_L(0); PG8_MMA(0, 0, At, B0); PG8_BAR; PG8_SCHED;
            PG8_LDB(B1, 1, 1); PG8_STAGE(PG8_SB(1, 0), b3, voffB);
            PG8_BAR; PG8_WAIT_L(0); PG8_MMA(0, 1, At, B1); PG8_BAR;
            PG8_LDA(At, 1, 1); PG8_STAGE(PG8_SA(1, 0), a3, voffA);
            PG8_BAR; PG8_WAIT_L(0); PG8_MMA(1, 0, At, B0); PG8_BAR; PG8_SCHED;
            PG8_STAGE(PG8_SB(1, 1), b3 + hstep, voffB);
            PG8_WAIT_V(6); PG8_BAR; PG8_MMA(1, 1, At, B1); PG8_BAR;
            }
        }
        if (wr == 0) PG8_BAR;
        if constexpr (F8 || SPLIT) asm volatile("s_nop 15\n\ts_nop 15" ::: "memory");
        PG8_SCHED; { const int te = opaque_tid(), le = te & 63; E(acc, cur, wr, wc, le & 15, le >> 4); } S.done(cur);
        if (!has_next) break;
#pragma unroll
        for (int a = 0; a < 2; ++a)
#pragma unroll
            for (int b = 0; b < 2; ++b)
#pragma unroll
                for (int m = 0; m < 4; ++m)
#pragma unroll
                    for (int n = 0; n < 2; ++n) acc[a][b][m][n] = (f32x4){0.f, 0.f, 0.f, 0.f};
        cur = nxt; cA = nA; cB = nB; ++ui;
        if (wr == 1) PG8_BAR;
    }
    PG8_WAIT_V(0);
    PG8_BAR;
#undef PG8_SA
#undef PG8_SB
#undef PG8_STAGE
#undef PG8_LDA
#undef PG8_LDB
#undef PG8_MMA
#undef PG8_MMA8
#undef PG8_MMA16
#undef PG8_ITER
#undef PG8_PTRS
#undef PG8_WAIT_V
#undef PG8_WAIT_L
#undef PG8_BAR
#undef PG8_SCHED
}
}

struct OrderF16 : pg8::StaticOrder {
    __device__ __forceinline__ bool next(int i, pg8::Unit& u) const { if (!pg8::StaticOrder::next(i, u)) return false; if (u.pn >= 16) u.pn += 10; return true; }
};
struct OrderF8 {
    int G, c;
    __device__ __forceinline__ bool next(int i, pg8::Unit& u) const {
        int L;
        if (G == 256) { if (c < 64) { if (i >= 1) return false; L = 576 + c; } else { if (i >= 3) return false; L = (c - 64) + 192 * i; } }
        else { L = i * G + c; if (L >= 640) return false; }
        const int wgid = (L % 8) * 80 + L / 8;
        u.pm = (wgid / 80) * 8 + (wgid % 80) % 8; u.pn = 16 + (wgid % 80) / 8; return true;
    }
    __device__ __forceinline__ void a_ready(const pg8::Unit&) const {}
    __device__ __forceinline__ void done(const pg8::Unit&) const {}
};

struct EpiIn {
    static constexpr bool PERM = true;
    unsigned char* ws; const float* a_log; const float* dt_bias; const int* pos;
    __device__ __forceinline__ void operator()(const f32x4 (&acc)[2][2][4][2], const pg8::Unit& u, int wr, int wc, int fr, int fq) const {
        constexpr float RF[16] = {1.591549431e-01f, 7.008652159e-02f, 3.086376340e-02f, 1.359137064e-02f, 5.985185713e-03f, 2.635675899e-03f, 1.160663641e-03f, 5.111175045e-04f,
                                  2.250790790e-04f, 9.911730937e-05f, 4.364795279e-05f, 1.922110068e-05f, 8.464330808e-06f, 3.727408602e-06f, 1.641426263e-06f, 7.228293069e-07f};
        const int pn = u.pn;
        const int rowb = u.pm * 256 + wr * 64 + fr;
        const int cw = wc * 32 + 8 * fq;
        if (pn < 30) {
            h16* base; int ldc, colt, mode; float scale = 1.f;
            if (pn < 12) { base = (h16*)(ws + OFF_QKVR); ldc = 3072; colt = pn * 256; mode = 0; }
            else if (pn < 16) { base = (h16*)(ws + OFF_GZ); ldc = 1024; colt = (pn - 12) * 256; mode = 1; }
            else if (pn < 20) { base = (h16*)(ws + OFF_AQ); ldc = 1024; colt = (pn - 16) * 256; mode = 2; }
            else if (pn == 20) { base = (h16*)(ws + OFF_AK); ldc = 256; colt = 0; mode = 2; }
            else if (pn == 21) { base = (h16*)(ws + OFF_AV); ldc = 256; colt = 0; mode = 4; }
            else if (pn < 26) { base = (h16*)(ws + OFF_AZ); ldc = 1024; colt = (pn - 22) * 256; mode = 1; }
            else { base = (h16*)(ws + OFF_IQ); ldc = 1024; colt = (pn - 26) * 256; mode = 3; }
            const bool rot_wave = (mode == 2 && wc == 0) || (mode == 3 && (wc & 1) == 0);
            const int xm = (mode == 2) ? 32 : 16;
            const bool rot_lane = (mode == 2) ? true : (fq < 2);
            const float sgn = (mode == 2) ? (fq < 2 ? -1.f : 1.f) : (fq == 0 ? -1.f : 1.f);
            float Fq[8]; int ps[2][4];
#pragma unroll
            for (int j = 0; j < 8; ++j) Fq[j] = (mode == 2) ? ((fq & 1) ? RF[8 + j] : RF[j]) : RF[2 * j];
            if (rot_wave) {
#pragma unroll
                for (int ai = 0; ai < 2; ++ai)
#pragma unroll
                    for (int m = 0; m < 4; ++m) ps[ai][m] = pos[rowb + ai * 128 + m * 16];
            }
#pragma unroll
            for (int ai = 0; ai < 2; ++ai)
#pragma unroll
                for (int m = 0; m < 4; ++m) {
                    const int row = rowb + ai * 128 + m * 16;
                    float cs[8], sn[8];
                    if (rot_wave) {
                        const float pf = (float)ps[ai][m];
#pragma unroll
                        for (int j = 0; j < 8; ++j) { const float rv = __builtin_amdgcn_fractf(pf * Fq[j]); cs[j] = __builtin_amdgcn_cosf(rv); sn[j] = __builtin_amdgcn_sinf(rv); }
                    }
#pragma unroll
                    for (int bj = 0; bj < 2; ++bj) {
                        float v[8];
#pragma unroll
                        for (int j = 0; j < 4; ++j) { v[j] = acc[ai][bj][m][0][j]; v[4 + j] = acc[ai][bj][m][1][j]; }
                        if (rot_wave) {
#pragma unroll
                            for (int j = 0; j < 8; ++j) {
                                const unsigned xv = __builtin_bit_cast(unsigned, v[j]); float pv;
                                if (mode == 2) { const auto sw = __builtin_amdgcn_permlane32_swap(xv, xv, false, false); pv = __builtin_bit_cast(float, fq < 2 ? sw[1] : sw[0]); }
                                else { const auto sw = __builtin_amdgcn_permlane16_swap(xv, xv, false, false); pv = __builtin_bit_cast(float, (fq & 1) ? sw[0] : sw[1]); }
                                if (rot_lane) v[j] = v[j] * cs[j] + sgn * pv * sn[j]; }
                        }
                        if (mode == 1) {
#pragma unroll
                            for (int j = 0; j < 8; ++j) v[j] = silu_f(v[j]);
                        }
                        if (mode == 4) {
                            int w0 = 0, w1 = 0;
                            w0 = __builtin_amdgcn_cvt_pk_fp8_f32(v[0], v[1], w0, false); w0 = __builtin_amdgcn_cvt_pk_fp8_f32(v[2], v[3], w0, true);
                            w1 = __builtin_amdgcn_cvt_pk_fp8_f32(v[4], v[5], w1, false); w1 = __builtin_amdgcn_cvt_pk_fp8_f32(v[6], v[7], w1, true);
                            typedef int i32x2b __attribute__((ext_vector_type(2)));
                            *(i32x2b*)((unsigned char*)base + (size_t)row * ldc + bj * 128 + cw) = (i32x2b){w0, w1};
                        } else if (mode == 2) {
                            int w0 = 0, w1 = 0;
                            w0 = __builtin_amdgcn_cvt_pk_fp8_f32(v[0], v[1], w0, false); w0 = __builtin_amdgcn_cvt_pk_fp8_f32(v[2], v[3], w0, true);
                            w1 = __builtin_amdgcn_cvt_pk_fp8_f32(v[4], v[5], w1, false); w1 = __builtin_amdgcn_cvt_pk_fp8_f32(v[6], v[7], w1, true);
                            typedef int i32x2 __attribute__((ext_vector_type(2)));
                            *(i32x2*)((unsigned char*)base + (size_t)row * ldc + colt + bj * 128 + cw) = (i32x2){w0, w1};
                        } else {
                            h16x8 o;
#pragma unroll
                            for (int j = 0; j < 8; ++j) o[j] = (h16)(v[j] * scale);
                            __builtin_nontemporal_store(o, (h16x8*)(base + (size_t)row * ldc + colt + bj * 128 + cw));
                        }
                    }
                }
        } else {
            h16* ik = (h16*)(ws + OFF_IK); float* gb = (float*)(ws + OFF_GB); float* iw = (float*)(ws + OFF_IW);
            float dtb[8], nea[8];
#pragma unroll
            for (int j = 0; j < 8; ++j) { dtb[j] = dt_bias[j]; nea[j] = -__builtin_amdgcn_exp2f(1.4426950408889634f * a_log[j]); }
#pragma unroll
            for (int ai = 0; ai < 2; ++ai)
#pragma unroll
                for (int m = 0; m < 4; ++m) {
                    const int row = rowb + ai * 128 + m * 16;
                    float v[8];
#pragma unroll
                    for (int j = 0; j < 4; ++j) { v[j] = acc[ai][0][m][0][j]; v[4 + j] = acc[ai][0][m][1][j]; }
                    if (wc == 0) {
                        const float sgn = (fq == 0 ? -1.f : 1.f), pf = (float)pos[row];
#pragma unroll
                        for (int j = 0; j < 8; ++j) { const unsigned xv = __builtin_bit_cast(unsigned, v[j]); const auto sw = __builtin_amdgcn_permlane16_swap(xv, xv, false, false); const float pv = __builtin_bit_cast(float, (fq & 1) ? sw[0] : sw[1]); const float rv = __builtin_amdgcn_fractf(pf * RF[2 * j]); const float c = __builtin_amdgcn_cosf(rv), s = __builtin_amdgcn_sinf(rv);
                            if (fq < 2) v[j] = v[j] * c + sgn * pv * s; }
                    }
                    if (wc < 2) {
                        h16x8 o;
#pragma unroll
                        for (int j = 0; j < 8; ++j) o[j] = (h16)v[j];
                        *(h16x8*)(ik + (size_t)(row >> 5) * 2048 + (cw >> 4) * 512 + ((cw >> 3) & 1) * 256 + (row & 31) * 8) = o;
                    } else if (wc == 2) {
                        if (fq == 0) {
#pragma unroll
                            for (int j = 0; j < 8; ++j) { const float z = v[j] + dtb[j];
                                const float sp = fmaxf(z, 0.f) + 0.6931471805599453f * __builtin_amdgcn_logf(1.0f + __builtin_amdgcn_exp2f(-1.4426950408889634f * fabsf(z)));
                                gb[(size_t)row * 16 + j] = nea[j] * sp; }
                        } else if (fq == 1) {
#pragma unroll
                            for (int j = 0; j < 8; ++j) gb[(size_t)row * 16 + 8 + j] = __builtin_amdgcn_rcpf(1.0f + __builtin_amdgcn_exp2f(-1.4426950408889634f * v[j]));
                        } else {
#pragma unroll
                            for (int j = 0; j < 8; ++j) iw[(size_t)row * 16 + 8 * (fq - 2) + j] = v[j] * 0.03125f;
                        }
                    }
                }
        }
    }
};

struct PanelOrder {
    int c;
    __device__ __forceinline__ bool next(int i, pg8::Unit& u) const { if (i >= 2) return false; u.pm = 32 * i + 4 * (c & 7) + (c >> 6); u.pn = (c >> 3) & 7; return true; }
    __device__ __forceinline__ void a_ready(const pg8::Unit&) const {}
    __device__ __forceinline__ void done(const pg8::Unit&) const {}
};
struct EpiOutNorm {
    static constexpr bool PERM = false;
    const float* x; float* out; float* rowss; unsigned* cnt; const float* fg;
    __device__ __forceinline__ void operator()(f32x4 (&acc)[2][2][4][2], const pg8::Unit& u, int wr, int wc, int fr, int fq) const {
        const int rowb = u.pm * 256 + wr * 64 + fr, col0 = u.pn * 256 + wc * 32 + 4 * fq;
#pragma unroll
        for (int ai = 0; ai < 2; ++ai)
#pragma unroll
            for (int m = 0; m < 4; ++m) {
                const int row = rowb + ai * 128 + m * 16; float ss = 0.f;
#pragma unroll
                for (int bj = 0; bj < 2; ++bj)
#pragma unroll
                    for (int n = 0; n < 2; ++n) {
                        const f32x4 y = *(const f32x4*)(x + (size_t)row * DM + col0 + bj * 128 + n * 16) + acc[ai][bj][m][n];
                        acc[ai][bj][m][n] = y; ss += (y[0] * y[0] + y[1] * y[1]) + (y[2] * y[2] + y[3] * y[3]);
                    }
                ss += lane_xor16(ss, fq); ss += lane_xor32(ss, fq);
                if (fq == 0) atomicAdd(rowss + row, ss);
            }
        asm volatile("s_waitcnt vmcnt(0)" ::: "memory");
        unsigned* cw = cnt + (u.pm * 2 + wr) * 16;
        if ((threadIdx.x & 63) == 0) __hip_atomic_fetch_add(cw, 1u, __ATOMIC_RELAXED, __HIP_MEMORY_SCOPE_AGENT);
        { unsigned spins = 0;
          while ((unsigned)__builtin_amdgcn_readfirstlane((int)__hip_atomic_load(cw, __ATOMIC_RELAXED, __HIP_MEMORY_SCOPE_AGENT)) < 32u) { __builtin_amdgcn_s_sleep(2); if (++spins > (1u << 22)) break; } }
        f32x4 gv[2][2];
#pragma unroll
        for (int bj = 0; bj < 2; ++bj)
#pragma unroll
            for (int n = 0; n < 2; ++n) gv[bj][n] = *(const f32x4*)(fg + col0 + bj * 128 + n * 16);
#pragma unroll
        for (int ai = 0; ai < 2; ++ai)
#pragma unroll
            for (int m = 0; m < 4; ++m) {
                const int row = rowb + ai * 128 + m * 16;
                const float ssr = __hip_atomic_load(rowss + row, __ATOMIC_RELAXED, __HIP_MEMORY_SCOPE_AGENT);
                const float r = __builtin_amdgcn_rsqf(ssr * (1.0f / DM) + EPS);
#pragma unroll
                for (int bj = 0; bj < 2; ++bj)
#pragma unroll
                    for (int n = 0; n < 2; ++n) *(f32x4*)(out + (size_t)row * DM + col0 + bj * 128 + n * 16) = acc[ai][bj][m][n] * r * gv[bj][n];
            }
    }
};

struct EpiOut {
    static constexpr bool PERM = false;
    const float* x; float* out; float* rowss;
    __device__ __forceinline__ void operator()(const f32x4 (&acc)[2][2][4][2], const pg8::Unit& u, int wr, int wc, int fr, int fq) const {
        const int rowb = u.pm * 256 + wr * 64 + fr, col0 = u.pn * 256 + wc * 32 + 4 * fq;
#pragma unroll
        for (int ai = 0; ai < 2; ++ai)
#pragma unroll
            for (int m = 0; m < 4; ++m) {
                const int row = rowb + ai * 128 + m * 16; float ss = 0.f;
#pragma unroll
                for (int bj = 0; bj < 2; ++bj)
#pragma unroll
                    for (int n = 0; n < 2; ++n) {
                        const size_t off = (size_t)row * DM + col0 + bj * 128 + n * 16;
                        const f32x4 y = *(const f32x4*)(x + off) + acc[ai][bj][m][n];
                        *(f32x4*)(out + off) = y; ss += (y[0] * y[0] + y[1] * y[1]) + (y[2] * y[2] + y[3] * y[3]);
                    }
                ss += lane_xor16(ss, fq); ss += lane_xor32(ss, fq);
                if (fq == 0) atomicAdd(rowss + row, ss);
            }
    }
};

__device__ __forceinline__ int src_col(int np) {
    if (np < 4096) return np;
    if (np < 7680) return np + 16;
    if (np < 7744) return 7696 + (np - 7680);
    if (np < 7752) return 4096 + (np - 7744);
    if (np < 7760) return 4104 + (np - 7752);
    if (np < 7776) return np;
    return -1;
}
__device__ __forceinline__ void phase0(const Params& p, unsigned char* smem) {
    const int tid = opaque_tid(), wid = tid >> 6, lane = tid & 63;
    const int gw = blockIdx.x * 8 + wid, nw = gridDim.x * 8;
    h16* H = (h16*)(p.ws + OFF_H); unsigned char* H8 = p.ws + OFF_H8;
    f32x4 gq[8];
#pragma unroll
    for (int i = 0; i < 8; ++i) gq[i] = ((const f32x4*)p.attn_g)[lane + 64 * i];
    {
        float* tiles = (float*)smem;
        h16* Wt = (h16*)(p.ws + OFF_WT); h16* WoT = (h16*)(p.ws + OFF_WOT);
        constexpr int NT1 = 124 * 32, NTT = NT1 + 32 * 32;
        const int n4_r = tid & 15, kr_r = tid >> 4, nl_w = tid >> 3, kc_w = tid & 7;
        float va[8], vb[8];
#define P0_LOAD(tI, v) do { const bool in_ = (tI) < NT1; const int t2_ = in_ ? (tI) : (tI) - NT1; const int n0_ = (t2_ / 32) * 64, k0_ = (t2_ % 32) * 64; \
            const int src_ = in_ ? src_col(n0_ + 4 * n4_r) : n0_ + 4 * n4_r; const float* wp_ = (in_ ? p.w_in : p.w_out) + (size_t)(k0_ + kr_r) * (in_ ? IN_COLS : DM) + (src_ >= 0 ? src_ : 0); \
            const size_t st_ = (size_t)32 * (in_ ? IN_COLS : DM);     \
            _Pragma("unroll") for (int i = 0; i < 2; ++i) { const f32x4 l_ = __builtin_nontemporal_load((const f32x4*)(wp_ + i * st_)); _Pragma("unroll") for (int j = 0; j < 4; ++j) v[4 * i + j] = src_ >= 0 ? l_[j] : 0.f; } } while (0)
#define P0_PUT(buf, v) do { float* t_ = tiles + (buf) * (64 * 65); _Pragma("unroll") for (int i = 0; i < 2; ++i) _Pragma("unroll") for (int j = 0; j < 4; ++j) t_[(kr_r + 32 * i) * 65 + 4 * n4_r + j] = v[4 * i + j]; } while (0)
#define P0_STORE(buf, tI) do { const float* t_ = tiles + (buf) * (64 * 65); h16x8 o_; _Pragma("unroll") for (int j = 0; j < 8; ++j) o_[j] = (h16)t_[(8 * kc_w + j) * 65 + nl_w]; \
          if ((tI) < NT1) { const int n0_ = ((tI) / 32) * 64, k0_ = ((tI) % 32) * 64; \
              if (n0_ >= 4096 && n0_ < 6656) { int e0_ = 0, e1_ = 0; e0_ = __builtin_amdgcn_cvt_pk_fp8_f32(64.f * (float)o_[0], 64.f * (float)o_[1], e0_, false); e0_ = __builtin_amdgcn_cvt_pk_fp8_f32(64.f * (float)o_[2], 64.f * (float)o_[3], e0_, true); \
                  e1_ = __builtin_amdgcn_cvt_pk_fp8_f32(64.f * (float)o_[4], 64.f * (float)o_[5], e1_, false); e1_ = __builtin_amdgcn_cvt_pk_fp8_f32(64.f * (float)o_[6], 64.f * (float)o_[7], e1_, true); \
                  typedef int i32x2w __attribute__((ext_vector_type(2))); *(i32x2w*)(p.ws + OFF_WT8 + (size_t)(n0_ - 4096 + nl_w) * 2048 + k0_ + 8 * kc_w) = (i32x2w){e0_, e1_}; } \
              else *(h16x8*)(Wt + (size_t)(n0_ + nl_w) * 2048 + k0_ + 8 * kc_w) = o_; } \
          else { const int t2_ = (tI) - NT1; const int n0_ = (t2_ / 32) * 64, k0_ = (t2_ % 32) * 64; unsigned char* wr_ = (unsigned char*)WoT + (size_t)(n0_ + nl_w) * 3072; \
              if (k0_ < 1024) *(h16x8*)(wr_ + 2 * (k0_ + 8 * kc_w)) = o_; \
              else { int e0_ = 0, e1_ = 0; e0_ = __builtin_amdgcn_cvt_pk_fp8_f32(64.f * (float)o_[0], 64.f * (float)o_[1], e0_, false); e0_ = __builtin_amdgcn_cvt_pk_fp8_f32(64.f * (float)o_[2], 64.f * (float)o_[3], e0_, true); \
                  e1_ = __builtin_amdgcn_cvt_pk_fp8_f32(64.f * (float)o_[4], 64.f * (float)o_[5], e1_, false); e1_ = __builtin_amdgcn_cvt_pk_fp8_f32(64.f * (float)o_[6], 64.f * (float)o_[7], e1_, true); \
                  typedef int i32x2o __attribute__((ext_vector_type(2))); *(i32x2o*)(wr_ + 2048 + (k0_ - 1024) + 8 * kc_w) = (i32x2o){e0_, e1_}; } } } while (0)
        float vc[8];
        const int G = gridDim.x; int tI = blockIdx.x; int buf = 0;
#define P0_CL(t) ((t) < NTT ? (t) : NTT - 1)
#define P0_STEP(v, tcur, tnew) do { if ((tcur) < NTT) P0_PUT(buf, v); P0_LOAD(P0_CL(tnew), v); LDS_SYNC(); if ((tcur) < NTT) P0_STORE(buf, tcur); buf ^= 1; } while (0)
        LDS_SYNC();
        P0_LOAD(P0_CL(tI), va); P0_LOAD(P0_CL(tI + G), vb); P0_LOAD(P0_CL(tI + 2 * G), vc);
        for (; tI < NTT; tI += 3 * G) {
            P0_STEP(va, tI, tI + 3 * G);
            P0_STEP(vb, tI + G, tI + 4 * G);
            P0_STEP(vc, tI + 2 * G, tI + 5 * G);
        }
#undef P0_STEP
#undef P0_CL
#undef P0_LOAD
#undef P0_PUT
#undef P0_STORE
    }
    for (int row = 2 * gw; row < BT; row += 2 * nw) {
        const f32x4* xr0 = (const f32x4*)(p.x + (size_t)row * DM); const f32x4* xr1 = xr0 + DM / 4;
        f32x4 v0[8], v1[8]; float s0 = 0.f, s1 = 0.f;
#pragma unroll
        for (int i = 0; i < 8; ++i) { v0[i] = __builtin_nontemporal_load(xr0 + lane + 64 * i); v1[i] = __builtin_nontemporal_load(xr1 + lane + 64 * i); }
#pragma unroll
        for (int i = 0; i < 8; ++i) { s0 += (v0[i][0] * v0[i][0] + v0[i][1] * v0[i][1]) + (v0[i][2] * v0[i][2] + v0[i][3] * v0[i][3]); s1 += (v1[i][0] * v1[i][0] + v1[i][1] * v1[i][1]) + (v1[i][2] * v1[i][2] + v1[i][3] * v1[i][3]); }
        s0 = wave_sum(s0); s1 = wave_sum(s1);
        const float r0 = __builtin_amdgcn_rsqf(s0 * (1.0f / DM) + EPS), r1 = __builtin_amdgcn_rsqf(s1 * (1.0f / DM) + EPS);
#pragma unroll
        for (int i = 0; i < 8; ++i) { const f32x4 g = gq[i]; h16x4 o0, o1;
#pragma unroll
            for (int j = 0; j < 4; ++j) { o0[j] = (h16)(v0[i][j] * r0 * g[j]); o1[j] = (h16)(v1[i][j] * r1 * g[j]); }
            *(h16x4*)(H + (size_t)row * DM + 4 * (lane + 64 * i)) = o0; *(h16x4*)(H + (size_t)(row + 1) * DM + 4 * (lane + 64 * i)) = o1;
            int e0 = 0, e1 = 0;
            e0 = __builtin_amdgcn_cvt_pk_fp8_f32(v0[i][0] * r0 * g[0], v0[i][1] * r0 * g[1], e0, false); e0 = __builtin_amdgcn_cvt_pk_fp8_f32(v0[i][2] * r0 * g[2], v0[i][3] * r0 * g[3], e0, true);
            e1 = __builtin_amdgcn_cvt_pk_fp8_f32(v1[i][0] * r1 * g[0], v1[i][1] * r1 * g[1], e1, false); e1 = __builtin_amdgcn_cvt_pk_fp8_f32(v1[i][2] * r1 * g[2], v1[i][3] * r1 * g[3], e1, true);
            *(int*)(H8 + (size_t)row * DM + 4 * (lane + 64 * i)) = e0; *(int*)(H8 + (size_t)(row + 1) * DM + 4 * (lane + 64 * i)) = e1; }
    }
}

__device__ __forceinline__ h16x8 pack8(const f32x4 a, const f32x4 c) { h16x8 o; o[0] = (h16)a[0]; o[1] = (h16)a[1]; o[2] = (h16)a[2]; o[3] = (h16)a[3]; o[4] = (h16)c[0]; o[5] = (h16)c[1]; o[6] = (h16)c[2]; o[7] = (h16)c[3]; return o; }
typedef short v4s_t __attribute__((__vector_size__(4 * sizeof(short))));
__device__ __forceinline__ h16x4 lds_tr16(const LAS unsigned char* a) { const v4s_t v = __builtin_amdgcn_ds_read_tr16_b64_v4i16((LAS v4s_t*)a); return __builtin_bit_cast(h16x4, v); }
constexpr int REC_BYTES = 74752, REC_WF = 0, REC_QF = 16384, REC_AF = 32768, REC_KTF = 40960, REC_VEC = 57344, REC_UF = 58368, REC_DMA = 58368;
constexpr int HB_BYTES = 69632;

__device__ __forceinline__ void gdn_prep_pair(const Params& p, unsigned char* smem, int pair) {
    const int tid = opaque_tid(), wid = __builtin_amdgcn_readfirstlane(tid >> 6), lane = tid & 63, hb = wid >> 2, w4 = wid & 3, tl = tid & 255;
    const int tk = 2 * pair + hb; const int b = tk >> 9, h = (tk >> 6) & 7, n = tk & 63; const int t0 = n * 64;
    unsigned char* base = smem + hb * HB_BYTES;
    h16* Kn = (h16*)base; h16* Qn = Kn + 64 * 136; h16* Vh = Qn + 64 * 136; float* L = (float*)(Vh + 64 * 136); float* vec = L + 4096;
    unsigned char* rec = p.ws + OFF_REC + (size_t)tk * REC_BYTES;
    const h16* qkvr = (const h16*)(p.ws + OFF_QKVR);
    LDS_SYNC();
    {
        const int cg = tl & 15, rg = tl >> 4;
        h16x8 raw[3][7];
#pragma unroll
        for (int ti = 0; ti < 3; ++ti)
#pragma unroll
            for (int r = 0; r < 7; ++r) {
                const int trow = t0 + 4 * rg - 3 + r;
                if (trow >= 0) raw[ti][r] = __builtin_nontemporal_load((const h16x8*)(qkvr + ((size_t)b * NT + trow) * 3072 + ti * 1024 + h * 128 + 8 * cg));
                else { for (int j = 0; j < 8; ++j) raw[ti][r][j] = (h16)0.f; }
            }
#pragma unroll
        for (int ti = 0; ti < 3; ++ti) {
            const int chan = ti * 1024 + h * 128 + 8 * cg;
            float xr[7][8];
#pragma unroll
            for (int r = 0; r < 7; ++r)
#pragma unroll
                for (int j = 0; j < 8; ++j) xr[r][j] = (float)raw[ti][r][j];
            float wv[4][8];
#pragma unroll
            for (int tp = 0; tp < 4; ++tp) { const f32x4 a = *(const f32x4*)(p.conv_w + (size_t)tp * 3072 + chan), c = *(const f32x4*)(p.conv_w + (size_t)tp * 3072 + chan + 4);
#pragma unroll
                for (int j = 0; j < 4; ++j) { wv[tp][j] = a[j]; wv[tp][4 + j] = c[j]; } }
            h16* dst = (ti == 0) ? Qn : (ti == 1 ? Kn : Vh);
#pragma unroll
            for (int r = 0; r < 4; ++r) {
                float y[8]; float ss = 0.f;
#pragma unroll
                for (int j = 0; j < 8; ++j) { float a = wv[0][j] * xr[r][j] + wv[1][j] * xr[r + 1][j] + wv[2][j] * xr[r + 2][j] + wv[3][j] * xr[r + 3][j]; a = silu_f(a); y[j] = a; ss += a * a; }
                float sc = 1.f;
                if (ti < 2) { ss += SC_DPP(ss, 0xB1); ss += SC_DPP(ss, 0x4E); ss += SC_DPP(ss, 0x141); ss += SC_DPP(ss, 0x140);     sc = (ti == 0 ? 0.08838834764831845f : 1.0f) * __builtin_amdgcn_rsqf(ss + EPS); }
                h16x8 o;
#pragma unroll
                for (int j = 0; j < 8; ++j) o[j] = (h16)(y[j] * sc);
                *(h16x8*)(dst + (4 * rg + r) * 136 + 8 * cg) = o;
            }
        }
    }
    if (tl < 64) {
        const float* gb = (const float*)(p.ws + OFF_GB) + ((size_t)b * NT + t0 + tl) * 16;
        const float g = gb[h], be = gb[8 + h];
        float gc = g;
#pragma unroll
        for (int o = 1; o < 64; o <<= 1) { const float tt = __shfl_up(gc, o); if (lane >= o) gc += tt; }
        const float gl = __shfl(gc, 63);
        vec[tl] = g; vec[64 + tl] = be; vec[128 + tl] = gc; vec[192 + tl] = __expf(gc);
        float* rv = (float*)(rec + REC_VEC);
        rv[tl] = __expf(gc); rv[64 + tl] = __expf(gl - gc); if (tl == 0) rv[128] = __expf(gl);
    }
    LDS_SYNC();
    {
        const int rt = w4, fr = lane & 15, kg = lane >> 4;
        h16x8 Ak[4], Aq[4];
#pragma unroll
        for (int s = 0; s < 4; ++s) { Ak[s] = *(const h16x8*)(Kn + (16 * rt + fr) * 136 + 32 * s + 8 * kg); Aq[s] = *(const h16x8*)(Qn + (16 * rt + fr) * 136 + 32 * s + 8 * kg); }
        h16* AF = (h16*)(rec + REC_AF);
#pragma unroll
        for (int ct = 0; ct < 4; ++ct) {
            f32x4 kk = (f32x4){0.f, 0.f, 0.f, 0.f}, qk = (f32x4){0.f, 0.f, 0.f, 0.f};
#pragma unroll
            for (int s = 0; s < 4; ++s) { const h16x8 Bk = *(const h16x8*)(Kn + (16 * ct + fr) * 136 + 32 * s + 8 * kg);
                kk = __builtin_amdgcn_mfma_f32_16x16x32_f16(Ak[s], Bk, kk, 0, 0, 0); qk = __builtin_amdgcn_mfma_f32_16x16x32_f16(Aq[s], Bk, qk, 0, 0, 0); }
            const int j = 16 * ct + fr; const float gcj = vec[128 + j];
#pragma unroll
            for (int rgi = 0; rgi < 4; ++rgi) {
                const int i = 16 * rt + 4 * kg + rgi;
                const float dec = (i >= j) ? __expf(vec[128 + i] - gcj) : 0.f;
                L[i * 64 + j] = (i > j) ? vec[64 + i] * kk[rgi] * dec : 0.f;
                const int sp = ct >> 1, kgp = fr >> 2, j8 = (ct & 1) * 4 + (fr & 3), lanep = 16 * kgp + 4 * kg + rgi;
                AF[((rt * 2 + sp) * 64 + lanep) * 8 + j8] = (h16)(qk[rgi] * dec);
            }
        }
    }
    LDS_SYNC();
    h16* Tw = (h16*)L; h16* Tu = Tw + 4096;
    {
        const int d = w4, c16 = lane & 15, kk = lane >> 4;
        {
            float X[16];
#pragma unroll
            for (int i = 0; i < 16; ++i) {
                const float* Lr = L + (16 * d + i) * 64 + 16 * d;
                float a0 = (c16 == i) ? 1.f : 0.f, a1 = 0.f;
#pragma unroll
                for (int jj = 0; jj < (i + 3) / 4; ++jj) { const f32x4 lv = *(const f32x4*)(Lr + 4 * jj);
#pragma unroll
                    for (int e = 0; e < 4; ++e) { if (4 * jj + e < i) { if (e & 1) a1 -= lv[e] * X[4 * jj + e]; else a0 -= lv[e] * X[4 * jj + e]; } } }
                float acc = a0 + a1;
                asm volatile("" : "+v"(acc) :: "memory");
                X[i] = acc;
            }
            LDS_SYNC();
            if (kk == 0) {
#pragma unroll
                for (int i = 0; i < 16; ++i) L[(16 * d + i) * 64 + 16 * d + c16] = X[i];
            }
        }
        LDS_SYNC();
#pragma unroll 1
        for (int bi = 1; bi < 4; ++bi) {
            f32x4 R = (f32x4){0.f, 0.f, 0.f, 0.f};
            if (d < bi) {
                f32x4 S = (f32x4){0.f, 0.f, 0.f, 0.f};
                for (int k = d; k < bi; ++k)
#pragma unroll
                    for (int s = 0; s < 4; ++s) S = __builtin_amdgcn_mfma_f32_16x16x4f32(L[(16 * bi + c16) * 64 + 16 * k + 4 * s + kk], L[(16 * k + 4 * s + kk) * 64 + 16 * d + c16], S, 0, 0, 0);
#pragma unroll
                for (int r = 0; r < 4; ++r) R = __builtin_amdgcn_mfma_f32_16x16x4f32(L[(16 * bi + c16) * 64 + 16 * bi + 4 * kk + r], S[r], R, 0, 0, 0);
            }
            LDS_SYNC();
            if (d < bi) {
#pragma unroll
                for (int r = 0; r < 4; ++r) L[(16 * bi + 4 * kk + r) * 64 + 16 * d + c16] = -R[r];
            }
            LDS_SYNC();
        }
        const int ti = tl >> 2, tq = tl & 3;
        f32x4 tv[4];
#pragma unroll
        for (int e = 0; e < 4; ++e) tv[e] = *(const f32x4*)(L + ti * 64 + 16 * tq + 4 * e);
        LDS_SYNC();
#pragma unroll
        for (int hh = 0; hh < 2; ++hh) {
            h16x8 ow, ou;
#pragma unroll
            for (int e = 0; e < 8; ++e) { const int c = 16 * tq + 8 * hh + e; const float bu = vec[64 + c], bw = bu * vec[192 + c]; const float x = tv[2 * hh + (e >> 2)][e & 3]; ow[e] = (h16)(x * bw); ou[e] = (h16)(x * bu); }
            const int pos = ti * 64 + ((((2 * tq + hh) ^ (ti & 7))) << 3);
            *(h16x8*)(Tw + pos) = ow; *(h16x8*)(Tu + pos) = ou;
        }
        h16* QF = (h16*)(rec + REC_QF);
        for (int f = tl; f < 1024; f += 256) { const int lanep = f & 63, s = (f >> 6) & 3, rt = f >> 8; const int row = 16 * rt + (lanep & 15), kgp = lanep >> 4;
            const h16x4 a = *(const h16x4*)(Qn + row * 136 + 32 * s + 4 * kgp), c = *(const h16x4*)(Qn + row * 136 + 32 * s + 16 + 4 * kgp);
            h16x8 o; o[0] = a[0]; o[1] = a[1]; o[2] = a[2]; o[3] = a[3]; o[4] = c[0]; o[5] = c[1]; o[6] = c[2]; o[7] = c[3];
            *(h16x8*)(QF + (size_t)f * 8) = o; }
        h16* KTF = (h16*)(rec + REC_KTF);
        for (int f = tl; f < 1024; f += 256) { const int lanep = f & 63, sp = (f >> 6) & 1, rt = f >> 7; const int d2 = 16 * rt + (lanep & 15), kgp = lanep >> 4;
            h16x8 o;
#pragma unroll
            for (int j8 = 0; j8 < 8; ++j8) { const int c = 32 * sp + (j8 < 4 ? 4 * kgp + j8 : 16 + 4 * kgp + (j8 - 4)); o[j8] = Kn[c * 136 + d2]; }
            *(h16x8*)(KTF + (size_t)f * 8) = o; }
    }
    LDS_SYNC();
    {
        const int rt = w4, fr = lane & 15, kg = lane >> 4, q4 = fr >> 2, pp = fr & 3;
        const LAS unsigned char* Knl = (const LAS unsigned char*)Kn; const LAS unsigned char* Vl = (const LAS unsigned char*)Vh;
        const int trow = 16 * rt + fr;
        h16x8 Tuf[2], Twf[2];
#pragma unroll
        for (int s = 0; s < 2; ++s) { const int off = trow * 64 + ((((4 * s + kg) ^ (trow & 7))) << 3); Tuf[s] = *(const h16x8*)(Tu + off); Twf[s] = *(const h16x8*)(Tw + off); }
        h16* UF = (h16*)(rec + REC_UF);
#pragma unroll
        for (int dvb = 0; dvb < 8; ++dvb) {
            f32x4 acc = (f32x4){0.f, 0.f, 0.f, 0.f};
#pragma unroll
            for (int s = 0; s < 2; ++s) { const LAS unsigned char* a0 = Vl + ((32 * s + 8 * kg + q4) * 136 + 16 * dvb + 4 * pp) * 2;
                const h16x4 lo = lds_tr16(a0), hi4 = lds_tr16(a0 + 4 * 136 * 2);
                h16x8 Bv; Bv[0] = lo[0]; Bv[1] = lo[1]; Bv[2] = lo[2]; Bv[3] = lo[3]; Bv[4] = hi4[0]; Bv[5] = hi4[1]; Bv[6] = hi4[2]; Bv[7] = hi4[3];
                acc = __builtin_amdgcn_mfma_f32_16x16x32_f16(Tuf[s], Bv, acc, 0, 0, 0); }
            h16x4 o; o[0] = (h16)acc[0]; o[1] = (h16)acc[1]; o[2] = (h16)acc[2]; o[3] = (h16)acc[3];
            *(h16x4*)(UF + (size_t)((dvb * 4 + rt) * 64 + lane) * 4) = o;
        }
        h16* WF = (h16*)(rec + REC_WF);
#pragma unroll
        for (int so = 0; so < 4; ++so) {
            f32x4 c0 = (f32x4){0.f, 0.f, 0.f, 0.f}, c1 = (f32x4){0.f, 0.f, 0.f, 0.f};
#pragma unroll
            for (int s = 0; s < 2; ++s) {
                const LAS unsigned char* a0 = Knl + ((32 * s + 8 * kg + q4) * 136 + 16 * (2 * so) + 4 * pp) * 2;
                const h16x4 l0 = lds_tr16(a0), h0 = lds_tr16(a0 + 4 * 136 * 2), l1 = lds_tr16(a0 + 32), h1 = lds_tr16(a0 + 32 + 4 * 136 * 2);
                h16x8 A0, A1; A0[0] = l0[0]; A0[1] = l0[1]; A0[2] = l0[2]; A0[3] = l0[3]; A0[4] = h0[0]; A0[5] = h0[1]; A0[6] = h0[2]; A0[7] = h0[3];
                A1[0] = l1[0]; A1[1] = l1[1]; A1[2] = l1[2]; A1[3] = l1[3]; A1[4] = h1[0]; A1[5] = h1[1]; A1[6] = h1[2]; A1[7] = h1[3];
                c0 = __builtin_amdgcn_mfma_f32_16x16x32_f16(A0, Twf[s], c0, 0, 0, 0); c1 = __builtin_amdgcn_mfma_f32_16x16x32_f16(A1, Twf[s], c1, 0, 0, 0);
            }
            *(h16x8*)(WF + (size_t)((rt * 4 + so) * 64 + lane) * 8) = pack8(-c0, -c1);
        }
    }
}

__device__ __forceinline__ void gdn_scan_task(const Params& p, unsigned char* smem, int bh) {
    const int tid = opaque_tid(), wid = __builtin_amdgcn_readfirstlane(tid >> 6), lane = tid & 63, kg = lane >> 4, fr = lane & 15;
    const int b = bh >> 3, h = bh & 7;
    LAS unsigned char* lds = (LAS unsigned char*)smem;
    const unsigned char* rec0 = p.ws + OFF_REC + (size_t)(bh * 64) * REC_BYTES;
    h16* OB = (h16*)(smem + 2 * REC_DMA);
    const h16* gz = (const h16*)(p.ws + OFF_GZ); h16* omix = (h16*)(p.ws + OFF_OMIX);
    f32x4 Sacc[8];
#pragma unroll
    for (int t = 0; t < 8; ++t) Sacc[t] = (f32x4){0.f, 0.f, 0.f, 0.f};
    h16x4 Uc[4], Un[4];
    __syncthreads();
#define GDN_GLDS(recp, bufi) do { _Pragma("unroll") for (int _i = 0; _i < 7; ++_i) \
        __builtin_amdgcn_global_load_lds((const unsigned*)((recp) + (size_t)(_i * 512 + tid) * 16), (LAS unsigned*)(lds + (bufi) * REC_DMA + (_i * 512 + wid * 64) * 16), 16, 0, 2); \
        if (wid == 0) __builtin_amdgcn_global_load_lds((const unsigned*)((recp) + (size_t)(7 * 512 + tid) * 16), (LAS unsigned*)(lds + (bufi) * REC_DMA + (7 * 512) * 16), 16, 0, 2); } while (0)
#define GDN_LDREG(recp, U_) do { _Pragma("unroll") for (int rt = 0; rt < 4; ++rt) U_[rt] = __builtin_nontemporal_load((const h16x4*)((recp) + REC_UF + (size_t)((wid * 4 + rt) * 64 + lane) * 8)); } while (0)
#define GDN_LDGZ(dst, chunk) do { const h16* gp_ = gz + ((size_t)b * NT + 64 * (chunk) + prow) * 1024 + h * 128 + 16 * pseg; dst[0] = __builtin_nontemporal_load((const h16x8*)gp_); dst[1] = __builtin_nontemporal_load((const h16x8*)(gp_ + 8)); } while (0)
#define GDN_POST(chunk, gzv) do { const h16* Ob = OB + ((chunk) & 1) * 8192 + prow * 128 + 16 * pseg; const h16x8 a0 = *(const h16x8*)Ob, a1 = *(const h16x8*)(Ob + 8); \
        float ngv[16]; _Pragma("unroll") for (int j = 0; j < 4; ++j) { const f32x4 t4 = *(const f32x4*)(ngl + 16 * pseg + 4 * j); ngv[4 * j] = t4[0]; ngv[4 * j + 1] = t4[1]; ngv[4 * j + 2] = t4[2]; ngv[4 * j + 3] = t4[3]; } \
        float ss = 0.f; _Pragma("unroll") for (int j = 0; j < 8; ++j) { const float u0 = (float)a0[j], u1 = (float)a1[j]; ss += u0 * u0 + u1 * u1; } \
        ss += SC_DPP(ss, 0xB1); ss += SC_DPP(ss, 0x4E); ss += SC_DPP(ss, 0x141);     const float r = __builtin_amdgcn_rsqf(ss * (1.0f / 128.0f) + EPS); \
        h16x8 o0, o1; _Pragma("unroll") for (int j = 0; j < 8; ++j) { o0[j] = (h16)((float)a0[j] * r * ngv[j] * (float)gzv[0][j]); o1[j] = (h16)((float)a1[j] * r * ngv[8 + j] * (float)gzv[1][j]); } \
        h16* op_ = omix + ((size_t)b * NT + 64 * (chunk) + prow) * 1536 + h * 128 + 16 * pseg; *(h16x8*)op_ = o0; *(h16x8*)(op_ + 8) = o1; } while (0)
#define GDN_RD8(X, off0) do { _Pragma("unroll") for (int _j = 0; _j < 8; ++_j) X[_j] = *(const LAS h16x8*)(bufp + (off0) + (_j * 64 + lane) * 16); } while (0)
#define GDN_SB __builtin_amdgcn_sched_barrier(0)
    h16x8 gzp[2], gzn[2];
    const int prow = tid >> 3, pseg = tid & 7;
    float* ngl = (float*)(smem + 2 * REC_DMA + 32768);
    if (tid < 128) ngl[tid] = p.gdn_norm_g[tid];
    GDN_GLDS(rec0, 0);
    GDN_LDREG(rec0, Uc);
    asm volatile("s_waitcnt vmcnt(0)" ::: "memory");
    __syncthreads();
    for (int n = 0; n < 64; ++n) {
        const unsigned char* recn = rec0 + (size_t)(n + 1) * REC_BYTES;
        if (n + 1 < 64) { GDN_GLDS(recn, (n + 1) & 1); GDN_LDREG(recn, Un); }
        GDN_LDGZ(gzn, n);
        if (n > 0) GDN_POST(n - 1, gzp);
        const LAS unsigned char* bufp = lds + (n & 1) * REC_DMA;
        h16x8 X[8], Y[8];
        GDN_RD8(X, REC_WF);
        h16x8 SB[4];
#pragma unroll
        for (int s = 0; s < 4; ++s) SB[s] = pack8(Sacc[2 * s], Sacc[2 * s + 1]);
        f32x4 vacc[4], oacc[4];
#pragma unroll
        for (int rt = 0; rt < 4; ++rt) { vacc[rt] = (f32x4){(float)Uc[rt][0], (float)Uc[rt][1], (float)Uc[rt][2], (float)Uc[rt][3]}; oacc[rt] = (f32x4){0.f, 0.f, 0.f, 0.f}; }
        GDN_SB;
        GDN_RD8(Y, REC_WF + 8192);
#pragma unroll
        for (int j = 0; j < 8; ++j) vacc[j >> 2] = __builtin_amdgcn_mfma_f32_16x16x32_f16(X[j], SB[j & 3], vacc[j >> 2], 0, 0, 0);
        GDN_SB;
        GDN_RD8(X, REC_QF);
#pragma unroll
        for (int j = 0; j < 8; ++j) vacc[2 + (j >> 2)] = __builtin_amdgcn_mfma_f32_16x16x32_f16(Y[j], SB[j & 3], vacc[2 + (j >> 2)], 0, 0, 0);
        GDN_SB;
        GDN_RD8(Y, REC_QF + 8192);
        f32x4 ekv[4], egv[4];
#pragma unroll
        for (int rt = 0; rt < 4; ++rt) { ekv[rt] = *(const LAS f32x4*)(bufp + REC_VEC + 256 + (16 * rt + 4 * kg) * 4); egv[rt] = *(const LAS f32x4*)(bufp + REC_VEC + (16 * rt + 4 * kg) * 4); }
        const float eglc = *(const LAS float*)(bufp + REC_VEC + 512);
#pragma unroll
        for (int j = 0; j < 8; ++j) oacc[j >> 2] = __builtin_amdgcn_mfma_f32_16x16x32_f16(X[j], SB[j & 3], oacc[j >> 2], 0, 0, 0);
        GDN_SB;
        GDN_RD8(X, REC_KTF);
        h16x8 VB[2], VKB[2];
#pragma unroll
        for (int sp = 0; sp < 2; ++sp) { VB[sp] = pack8(vacc[2 * sp], vacc[2 * sp + 1]); VKB[sp] = pack8(vacc[2 * sp] * ekv[2 * sp], vacc[2 * sp + 1] * ekv[2 * sp + 1]); }
#pragma unroll
        for (int j = 0; j < 8; ++j) oacc[2 + (j >> 2)] = __builtin_amdgcn_mfma_f32_16x16x32_f16(Y[j], SB[j & 3], oacc[2 + (j >> 2)], 0, 0, 0);
        GDN_SB;
        GDN_RD8(Y, REC_KTF + 8192);
#pragma unroll
        for (int t = 0; t < 8; ++t) Sacc[t] = Sacc[t] * eglc;
#pragma unroll
        for (int j = 0; j < 8; ++j) Sacc[j >> 1] = __builtin_amdgcn_mfma_f32_16x16x32_f16(X[j], VKB[j & 1], Sacc[j >> 1], 0, 0, 0);
        GDN_SB;
        GDN_RD8(X, REC_AF);
#pragma unroll
        for (int rt = 0; rt < 4; ++rt) oacc[rt] = oacc[rt] * egv[rt];
#pragma unroll
        for (int j = 0; j < 8; ++j) Sacc[4 + (j >> 1)] = __builtin_amdgcn_mfma_f32_16x16x32_f16(Y[j], VKB[j & 1], Sacc[4 + (j >> 1)], 0, 0, 0);
        GDN_SB;
#pragma unroll
        for (int j = 0; j < 8; ++j) oacc[j >> 1] = __builtin_amdgcn_mfma_f32_16x16x32_f16(X[j], VB[j & 1], oacc[j >> 1], 0, 0, 0);
        { h16* Ob = OB + (n & 1) * 8192;
#pragma unroll
          for (int rt = 0; rt < 4; ++rt)
#pragma unroll
              for (int rgi = 0; rgi < 4; ++rgi) Ob[(16 * rt + 4 * kg + rgi) * 128 + 16 * wid + fr] = (h16)oacc[rt][rgi]; }
        asm volatile("s_waitcnt vmcnt(0)" ::: "memory");
        __syncthreads();
#pragma unroll
        for (int rt = 0; rt < 4; ++rt) Uc[rt] = Un[rt];
        gzp[0] = gzn[0]; gzp[1] = gzn[1];
    }
    GDN_POST(63, gzp);
#undef GDN_LDGZ
#undef GDN_POST
#undef GDN_RD8
#undef GDN_SB
#undef GDN_GLDS
#undef GDN_LDREG
}

__device__ __forceinline__ unsigned f2key(float x) { const unsigned u = __float_as_uint(x); return (u & 0x80000000u) ? ~u : (u | 0x80000000u); }
typedef float f32x16 __attribute__((ext_vector_type(16)));
__device__ __forceinline__ float wave_min(float v) {
#pragma unroll
    for (int o = 1; o < 64; o <<= 1) v = fminf(v, __shfl_xor(v, o));
    return v;
}
__device__ __forceinline__ unsigned lane_below(unsigned long long m) { return __builtin_amdgcn_mbcnt_hi((unsigned)(m >> 32), __builtin_amdgcn_mbcnt_lo((unsigned)m, 0u)); }
__device__ __forceinline__ int idx8_task(const Params& p, unsigned char* smem, int b, int qb, int pend) {
    const int tid = opaque_tid(), wid = __builtin_amdgcn_readfirstlane(tid >> 6), lane = tid & 63;
    const int t0 = qb * 8;
    unsigned short* selg = (unsigned short*)(p.ws + OFF_SEL) + ((size_t)b * NT + t0) * 256;
    if (t0 + 8 <= 256) {
        for (int i = tid; i < 8 * 128; i += 512) { const int q = i >> 7, k = 2 * (i & 127); const unsigned lo = (unsigned)(k <= t0 + q ? k : 0), hi = (unsigned)(k + 1 <= t0 + q ? k + 1 : 0);
            __hip_atomic_store((unsigned*)selg + i, lo | (hi << 16), __ATOMIC_RELAXED, __HIP_MEMORY_SCOPE_AGENT); }
        asm volatile("s_waitcnt vmcnt(0)" ::: "memory"); __syncthreads();
        if (tid == 0) { __hip_atomic_store((unsigned*)(p.ws + OFF_CTRL + 49152) + b * 512 + qb, 1u, __ATOMIC_RELAXED, __HIP_MEMORY_SCOPE_AGENT);
            if (pend >= 0) __hip_atomic_store((unsigned*)(p.ws + OFF_CTRL + 49152) + pend, 1u, __ATOMIC_RELAXED, __HIP_MEMORY_SCOPE_AGENT); }
        return -1;
    }
    float* sc = (float*)smem;
    ACC_T0();
    unsigned* hist = (unsigned*)(smem + 131072 + wid * 2560);
    unsigned* cand = hist + 256;
    LDS_SYNC();
    {
        const int n8 = t0 + 8;
        const int ntile = (n8 + 31) >> 5, ntile_pad = ((n8 + 255) >> 8) << 3;
        const h16* iq = (const h16*)(p.ws + OFF_IQ) + ((size_t)b * NT + t0) * 1024;
        const float* iw = (const float*)(p.ws + OFF_IW) + ((size_t)b * NT + t0) * 16;
        const h16* ik = (const h16*)(p.ws + OFF_IK) + (size_t)b * NT * 64;
        const int r = lane & 31, kh = lane >> 5, qq = (r >> 2) & 1, hh = (r & 3) + 4 * (r >> 3);
        h16x8 Af[4][4]; h16x2 Wp[4][8];
#pragma unroll
        for (int a = 0; a < 4; ++a) {
#pragma unroll
            for (int s = 0; s < 4; ++s) Af[a][s] = *(const h16x8*)(iq + (size_t)(2 * a + qq) * 1024 + hh * 64 + 16 * s + 8 * kh);
#pragma unroll
            for (int c = 0; c < 4; ++c) { const f32x4 w4 = *(const f32x4*)(iw + (size_t)(2 * a + kh) * 16 + 4 * c);
                Wp[a][2 * c] = (h16x2){(h16)w4[0], (h16)w4[1]}; Wp[a][2 * c + 1] = (h16x2){(h16)w4[2], (h16)w4[3]}; }
        }
#define IDX_LOADB(Bx, ti) do { const int tc_ = (ti) < ntile ? (ti) : ntile - 1;     \
            _Pragma("unroll") for (int s = 0; s < 4; ++s) Bx[s] = *(const h16x8*)(ik + (size_t)tc_ * 2048 + s * 512 + kh * 256 + r * 8); } while (0)
#define IDX_COMP(Bx, ti) do { if ((ti) < ntile) { const int key = 32 * (ti) + r; f32x16 accs[4]; \
            _Pragma("unroll") for (int a = 0; a < 4; ++a) { _Pragma("unroll") for (int e = 0; e < 16; ++e) accs[a][e] = 0.f; \
                _Pragma("unroll") for (int s = 0; s < 4; ++s) accs[a] = __builtin_amdgcn_mfma_f32_32x32x16_f16(Af[a][s], Bx[s], accs[a], 0, 0, 0); } \
            __builtin_amdgcn_sched_barrier(0); \
            _Pragma("unroll") for (int a = 0; a < 4; ++a) { \
                float s0 = 0.f, s1 = 0.f; _Pragma("unroll") for (int e = 0; e < 8; e += 2) { h16x2 rp = (h16x2){(h16)accs[a][2 * e], (h16)accs[a][2 * e + 1]}; rp = __builtin_elementwise_max(rp, (h16x2){(h16)0.f, (h16)0.f}); s0 = __builtin_amdgcn_fdot2(rp, Wp[a][e], s0, false); \
                    h16x2 rq = (h16x2){(h16)accs[a][2 * e + 2], (h16)accs[a][2 * e + 3]}; rq = __builtin_elementwise_max(rq, (h16x2){(h16)0.f, (h16)0.f}); s1 = __builtin_amdgcn_fdot2(rq, Wp[a][e + 1], s1, false); } \
                const int q = 2 * a + kh; sc[q * 4096 + key] = (key > t0 + q) ? -INFINITY : (s0 + s1); } } } while (0)
        {
            h16x8 B0[4], B1[4], B2[4];
            IDX_LOADB(B0, wid); IDX_LOADB(B1, wid + 8);
            for (int i = wid; i < ntile; i += 24) {
                IDX_LOADB(B2, i + 16); IDX_COMP(B0, i);
                IDX_LOADB(B0, i + 24); IDX_COMP(B1, i + 8);
                IDX_LOADB(B1, i + 32); IDX_COMP(B2, i + 16);
            }
            for (int i = ntile + wid; i < ntile_pad; i += 8) {
#pragma unroll
                for (int a = 0; a < 4; ++a) sc[(2 * a + kh) * 4096 + 32 * i + r] = -INFINITY;
            }
        }
#undef IDX_LOADB
#undef IDX_COMP
    }
    asm volatile("s_waitcnt vmcnt(0)" ::: "memory");
    LDS_SYNC();
    if (tid == 0 && pend >= 0) __hip_atomic_store((unsigned*)(p.ws + OFF_CTRL + 49152) + pend, 1u, __ATOMIC_RELAXED, __HIP_MEMORY_SCOPE_AGENT);
    ACC_ADD(1);
    {
        const int tq = t0 + wid, n = tq + 1;
        const float* row = sc + wid * 4096;
        const int ng = (n + 255) >> 8;
        f32x4 x[16];
#pragma unroll
        for (int g = 0; g < 16; ++g) { if (g < ng) x[g] = *(const f32x4*)(row + 256 * g + 4 * lane); else x[g] = (f32x4){-INFINITY, -INFINITY, -INFINITY, -INFINITY}; }
        float hi = -INFINITY, lo = INFINITY;
#pragma unroll
        for (int g = 0; g < 16; ++g)
#pragma unroll
            for (int c = 0; c < 4; ++c) { const float v = x[g][c]; hi = fmaxf(hi, v); lo = fminf(lo, v == -INFINITY ? INFINITY : v); }
        { const int kgl = lane >> 4;
          hi = fmaxf(hi, SC_DPP(hi, 0xB1)); lo = fminf(lo, SC_DPP(lo, 0xB1)); hi = fmaxf(hi, SC_DPP(hi, 0x4E)); lo = fminf(lo, SC_DPP(lo, 0x4E));
          hi = fmaxf(hi, SC_DPP(hi, 0x141)); lo = fminf(lo, SC_DPP(lo, 0x141)); hi = fmaxf(hi, SC_DPP(hi, 0x140)); lo = fminf(lo, SC_DPP(lo, 0x140));
          hi = fmaxf(hi, lane_xor16(hi, kgl)); lo = fminf(lo, lane_xor16(lo, kgl)); hi = fmaxf(hi, lane_xor32(hi, kgl)); lo = fminf(lo, lane_xor32(lo, kgl)); }
        const float scale = (hi > lo) ? 255.99f / (hi - lo) : 0.f; const float off = -lo * scale;
        { u32x4 z0 = (u32x4){0u, 0u, 0u, 0u}; asm volatile("" : "+v"(z0)); *(u32x4*)(hist + 4 * lane) = z0; }
#pragma unroll
        for (int g = 0; g < 16; ++g) { if (g < ng) {
#pragma unroll
            for (int c = 0; c < 4; ++c) { int bin = (int)fmaf(x[g][c], scale, off); bin = bin < 0 ? 0 : (bin > 255 ? 255 : bin); atomicAdd(&hist[bin], 1u); } } }
        unsigned bstar, need;
        {
            const u32x4 h4 = *(const u32x4*)(hist + 4 * lane); const unsigned s = h4[0] + h4[1] + h4[2] + h4[3];
            unsigned suf = s;
#pragma unroll
            for (int o = 1; o < 64; o <<= 1) { const unsigned tt = __shfl_down(suf, o); if (lane + o < 64) suf += tt; }
            const unsigned above = suf - s;
            const bool mine = (above < 256u && 256u <= suf);
            unsigned cum = above; unsigned bin = 0;
            if (cum + h4[3] >= 256u) bin = 3; else { cum += h4[3]; if (cum + h4[2] >= 256u) bin = 2; else { cum += h4[2]; if (cum + h4[1] >= 256u) bin = 1; else { cum += h4[1]; bin = 0; } } }
            const unsigned long long mm = __ballot(mine);
            const int src = (int)__builtin_ctzll(mm);
            bstar = (unsigned)__shfl((int)(4 * lane + bin), src); need = (unsigned)__shfl((int)(256u - cum), src);
        }
        unsigned short* so = (unsigned short*)hist;
        unsigned short* cidx = (unsigned short*)(cand + 256);
        unsigned m = 0, outb = 0;
#pragma unroll
        for (int g = 0; g < 16; ++g) { if (g < ng) {
#pragma unroll
            for (int c = 0; c < 4; ++c) { int bin = (int)fmaf(x[g][c], scale, off); bin = bin < 0 ? 0 : (bin > 255 ? 255 : bin);
                const bool gt = ((unsigned)bin > bstar), pr = ((unsigned)bin == bstar);
                const unsigned long long mg = __ballot(gt), mk = __ballot(pr);
                if (mg) { const unsigned pos = outb + lane_below(mg); if (gt) so[pos] = (unsigned short)(256 * g + 4 * lane + c); outb += (unsigned)__builtin_popcountll(mg); }
                if (mk) { const unsigned pos = m + lane_below(mk); if (pr && pos < 256u) { cand[pos] = f2key(x[g][c]); cidx[pos] = (unsigned short)(256 * g + 4 * lane + c); } m += (unsigned)__builtin_popcountll(mk); } } } }
        unsigned Kt = 0, rr = need;
        if (m <= 256u) {
            const int nc = (int)((m + 63u) >> 6);
            unsigned cv[4]; unsigned short ci[4];
#pragma unroll
            for (int j = 0; j < 4; ++j) { const bool in = (64 * j + lane < (int)m); cv[j] = in ? cand[64 * j + lane] : 0u; ci[j] = in ? cidx[64 * j + lane] : (unsigned short)0; }
            for (int bit = 31; bit >= 0; --bit) {
                const unsigned test = (Kt | (1u << bit)) >> bit;
                unsigned cnt = (unsigned)__builtin_popcountll(__ballot((cv[0] >> bit) == test));
                if (nc > 1) cnt += (unsigned)__builtin_popcountll(__ballot((cv[1] >> bit) == test));
                if (nc > 2) cnt += (unsigned)__builtin_popcountll(__ballot((cv[2] >> bit) == test));
                if (nc > 3) cnt += (unsigned)__builtin_popcountll(__ballot((cv[3] >> bit) == test));
                if (cnt >= rr) Kt |= (1u << bit); else rr -= cnt;
            }
            unsigned eqb = 0;
#pragma unroll
            for (int j = 0; j < 4; ++j) { if (j < nc) { const bool in = (64 * j + lane < (int)m); const bool gt = in && cv[j] > Kt, eq = in && cv[j] == Kt;
                const unsigned long long me = __ballot(eq); bool take = gt;
                if (me) { const unsigned er = eqb + lane_below(me); take = gt || (eq && er < rr); eqb += (unsigned)__builtin_popcountll(me); }
                const unsigned long long mt = __ballot(take);
                if (mt) { const unsigned pos = outb + lane_below(mt); if (take) so[pos] = ci[j]; outb += (unsigned)__builtin_popcountll(mt); } } }
        } else {
            for (int bit = 31; bit >= 0; --bit) {
                const unsigned test = (Kt | (1u << bit)) >> bit; unsigned cnt = 0;
                for (int idx = lane; idx < ng * 256; idx += 64) { const float v = row[idx]; int bin = (int)fmaf(v, scale, off); bin = bin < 0 ? 0 : (bin > 255 ? 255 : bin);
                    const bool pr = ((unsigned)bin == bstar) && ((f2key(v) >> bit) == test); cnt += (unsigned)__builtin_popcountll(__ballot(pr)); }
                if (cnt >= rr) Kt |= (1u << bit); else rr -= cnt;
            }
            unsigned eqb = 0;
            for (int idx = lane; idx < ng * 256; idx += 64) { const float v = row[idx]; int bin = (int)fmaf(v, scale, off); bin = bin < 0 ? 0 : (bin > 255 ? 255 : bin);
                const unsigned k = f2key(v); const bool inb = ((unsigned)bin == bstar); const bool gt = inb && k > Kt, eq = inb && k == Kt;
                const unsigned long long me = __ballot(eq); bool take = gt;
                if (me) { const unsigned er = eqb + lane_below(me); take = gt || (eq && er < rr); eqb += (unsigned)__builtin_popcountll(me); }
                const unsigned long long mt = __ballot(take);
                if (mt) { const unsigned pos = outb + lane_below(mt); if (take) so[pos] = (unsigned short)idx; outb += (unsigned)__builtin_popcountll(mt); } }
        }
        __hip_atomic_store((unsigned long long*)(selg + (size_t)wid * 256 + 4 * lane), *(const unsigned long long*)(so + 4 * lane), __ATOMIC_RELAXED, __HIP_MEMORY_SCOPE_AGENT);
    }
    LDS_SYNC();
    ACC_ADD(2);
    return b * 512 + qb;
}

typedef unsigned short u16x4 __attribute__((ext_vector_type(4)));
typedef unsigned short u16x8 __attribute__((ext_vector_type(8)));
__device__ __forceinline__ void attn8_task(const Params& p, unsigned char* smem, int part, int o) {
    const int tid = opaque_tid(), wid = __builtin_amdgcn_readfirstlane(tid >> 6), lane = tid & 63, kg = lane >> 4, fr = lane & 15;
    const int b = part >> 1, g = part & 1;
    unsigned char* vl = smem + wid * 17408;
    LAS unsigned char* vll = (LAS unsigned char*)vl;
    const char* akb = (const char*)(p.ws + OFF_AK) + (size_t)b * NT * 256 + g * 128;
    const char* avb = (const char*)(p.ws + OFF_AV) + (size_t)b * NT * 256 + g * 128;
    typedef long i64x2 __attribute__((ext_vector_type(2)));
    constexpr int NQW = 1;
    const int tq0 = 8 * NQW * o + NQW * wid;
    u16x4 kix[4], kixn[4];
#define AT_LOADI(tt, KI) do { const unsigned short* sel_ = (const unsigned short*)(p.ws + OFF_SEL) + ((size_t)b * NT + (tt)) * 256; \
        _Pragma("unroll") for (int c = 0; c < 4; ++c) KI[c] = *(const u16x4*)(sel_ + 64 * c + 4 * fr); } while (0)
    AT_LOADI(tq0, kix);
#pragma unroll 1
    for (int qi = 0; qi < NQW; ++qi) {
    const int t = tq0 + qi; const int bt = b * NT + t; const int nvalid = (t + 1) < 256 ? (t + 1) : 256;
    const unsigned short* sel = (const unsigned short*)(p.ws + OFF_SEL) + (size_t)bt * 256;
    long Qf[4];
    { const char* qp_ = (const char*)(p.ws + OFF_AQ) + (size_t)bt * 1024 + (4 * g + (fr & 3)) * 128 + kg * 32; const i64x2 q0 = *(const i64x2*)qp_, q1 = *(const i64x2*)(qp_ + 16);
      Qf[0] = fr < 4 ? q0[0] : 0l; Qf[1] = fr < 4 ? q0[1] : 0l; Qf[2] = fr < 4 ? q1[0] : 0l; Qf[3] = fr < 4 ? q1[1] : 0l; }
    f32x4 lg[16];
    unsigned char* s0 = vl; unsigned char* s1 = vl + 8192;
    LAS unsigned char* s0l = (LAS unsigned char*)s0; LAS unsigned char* s1l = (LAS unsigned char*)s1;
    u16x8 IX[4];
#pragma unroll
    for (int c = 0; c < 4; ++c) IX[c] = *(const u16x8*)(sel + 64 * c + 8 * (lane >> 3));
#define AT_FK(rho) (((rho) >> 2) & 7)
#define AT_FV(rho) ((((rho) >> 2) & 3) | ((((rho) >> 4) & 1) << 2))
#define AT_DMA(stl, base, c, FF) do { _Pragma("unroll") for (int it = 0; it < 8; ++it) { const int rho_ = 8 * it + (lane >> 3); \
        __builtin_amdgcn_global_load_lds((const unsigned*)((base) + (unsigned)IX[c][it] * 256u + 16u * (unsigned)((lane & 7) ^ FF(rho_))), (LAS unsigned*)((stl) + it * 1024), 16, 0, 0); } } while (0)
#define AT_WAITV(n) asm volatile("s_waitcnt vmcnt(" #n ")" ::: "memory")
#define AT_WAITL asm volatile("s_waitcnt lgkmcnt(0)" ::: "memory")
#define AT_SB __builtin_amdgcn_sched_barrier(0)
#define AT_READK(Kx, stl) do { _Pragma("unroll") for (int ii = 0; ii < 4; ++ii) { const int r = 4 * fr + ii; const int fk = fr & 7; \
        const i64x2 t0 = *(const LAS i64x2*)((stl) + r * 128 + (((2 * kg) ^ fk) << 4)), t1 = *(const LAS i64x2*)((stl) + r * 128 + (((2 * kg + 1) ^ fk) << 4)); \
        Kx[ii][0] = t0[0]; Kx[ii][1] = t0[1]; Kx[ii][2] = t1[0]; Kx[ii][3] = t1[1]; } } while (0)
#define AT_MMAK(Kx, c) do { _Pragma("unroll") for (int ii = 0; ii < 4; ++ii) { f32x4 a = (f32x4){0.f, 0.f, 0.f, 0.f}; \
        _Pragma("unroll") for (int s = 0; s < 4; ++s) a = __builtin_amdgcn_mfma_f32_16x16x32_fp8_fp8(Kx[ii][s], Qf[s], a, 0, 0, 0); lg[4 * (c) + ii] = a; } } while (0)
    const h16x8 gate = *(const h16x8*)((const h16*)(p.ws + OFF_AZ) + (size_t)bt * 1024 + (4 * g) * 128 + 8 * lane);
    h16x8 gate_r;
    {
        long Kf[4][4];
        { h16x8 gt_ = gate; asm volatile("" : "+v"(IX[0]), "+v"(IX[1]), "+v"(IX[2]), "+v"(IX[3]), "+v"(Qf[0]), "+v"(Qf[1]), "+v"(Qf[2]), "+v"(Qf[3]), "+v"(gt_)); gate_r = gt_; }
        AT_WAITL; AT_SB;
        AT_DMA(s0l, akb, 0, AT_FK); AT_DMA(s1l, akb, 1, AT_FK); AT_SB;
        AT_WAITV(8); AT_SB; AT_READK(Kf, s0l); AT_WAITL; AT_SB; AT_DMA(s0l, akb, 2, AT_FK); AT_SB; AT_MMAK(Kf, 0); AT_SB;
        AT_WAITV(8); AT_SB; AT_READK(Kf, s1l); AT_WAITL; AT_SB; AT_DMA(s1l, akb, 3, AT_FK); AT_SB; AT_MMAK(Kf, 1); AT_SB;
        AT_WAITV(8); AT_SB; AT_READK(Kf, s0l); AT_WAITL; AT_SB; AT_DMA(s0l, avb, 0, AT_FV); AT_SB; AT_MMAK(Kf, 2); AT_SB;
        AT_WAITV(8); AT_SB; AT_READK(Kf, s1l); AT_WAITL; AT_SB; AT_DMA(s1l, avb, 1, AT_FV); AT_SB; AT_MMAK(Kf, 3); AT_SB;
    }
#define DPP_F(oldv, srcv, ctrl, bank) __builtin_bit_cast(float, __builtin_amdgcn_update_dpp(__builtin_bit_cast(int, (float)(oldv)), __builtin_bit_cast(int, (float)(srcv)), (ctrl), 0xF, (bank), false))
    float val[4][4];
#pragma unroll
    for (int ii = 0; ii < 4; ++ii)
#pragma unroll
        for (int r = 0; r < 4; ++r) { float v = lg[ii][r];
            v = DPP_F(v, lg[4 + ii][r], 0x114, 0x2); v = DPP_F(v, lg[8 + ii][r], 0x118, 0x4); v = DPP_F(v, lg[12 + ii][r], 0x11C, 0x8); val[ii][r] = v; }
    const int cj = fr >> 2;
    float m = -INFINITY;
#pragma unroll
    for (int ii = 0; ii < 4; ++ii)
#pragma unroll
        for (int r = 0; r < 4; ++r) { const int slot = 64 * cj + 32 * (r & 1) + 8 * ii + 2 * kg + (r >> 1);     const float v = (slot < nvalid) ? val[ii][r] * (0.08838834764831845f * 1.4426950408889634f) : -INFINITY; val[ii][r] = v; m = fmaxf(m, v); }
    m = fmaxf(m, SC_DPP(m, 0x124)); m = fmaxf(m, SC_DPP(m, 0x128)); m = fmaxf(m, lane_xor16(m, kg)); m = fmaxf(m, lane_xor32(m, kg));
    float sum = 0.f;
#pragma unroll
    for (int ii = 0; ii < 4; ++ii)
#pragma unroll
        for (int r = 0; r < 4; ++r) { const float e = __builtin_amdgcn_exp2f(val[ii][r] - m); val[ii][r] = e; sum += e; }
    sum += SC_DPP(sum, 0x124); sum += SC_DPP(sum, 0x128); sum += lane_xor16(sum, kg); sum += lane_xor32(sum, kg);
    const float pscale = __builtin_amdgcn_rcpf(sum) * 256.0f;
    int pl[2][2];
#pragma unroll
    for (int ipl = 0; ipl < 2; ++ipl) { int w0 = 0, w1 = 0;
        w0 = __builtin_amdgcn_cvt_pk_fp8_f32(val[2 * ipl][0] * pscale, val[2 * ipl][1] * pscale, w0, false); w0 = __builtin_amdgcn_cvt_pk_fp8_f32(val[2 * ipl][2] * pscale, val[2 * ipl][3] * pscale, w0, true);
        w1 = __builtin_amdgcn_cvt_pk_fp8_f32(val[2 * ipl + 1][0] * pscale, val[2 * ipl + 1][1] * pscale, w1, false); w1 = __builtin_amdgcn_cvt_pk_fp8_f32(val[2 * ipl + 1][2] * pscale, val[2 * ipl + 1][3] * pscale, w1, true);
        pl[ipl][0] = w0; pl[ipl][1] = w1; }
    long Pf[8];
#pragma unroll
    for (int ipl = 0; ipl < 2; ++ipl) {
        Pf[ipl] = (long)(((unsigned long long)(unsigned)pl[ipl][1] << 32) | (unsigned long long)(unsigned)pl[ipl][0]);
#define PF_GATHER(c, ctrl) do { const int lo_ = __builtin_amdgcn_update_dpp(0, pl[ipl][0], ctrl, 0xF, 0x1, false), hi_ = __builtin_amdgcn_update_dpp(0, pl[ipl][1], ctrl, 0xF, 0x1, false); \
            Pf[2 * (c) + ipl] = (long)(((unsigned long long)(unsigned)hi_ << 32) | (unsigned long long)(unsigned)lo_); } while (0)
        PF_GATHER(1, 0x104); PF_GATHER(2, 0x108); PF_GATHER(3, 0x10C);
#undef PF_GATHER
    }
#undef DPP_F
    f32x4 O[8];
#pragma unroll
    for (int ct = 0; ct < 8; ++ct) O[ct] = (f32x4){0.f, 0.f, 0.f, 0.f};
    if (qi < NQW - 1) AT_LOADI(t + 1, kixn);
    const int q4 = fr >> 2, pp = fr & 3;
    typedef int v2i_t __attribute__((__vector_size__(2 * sizeof(int))));
#define AT_PVREAD(Vr, stl) do { _Pragma("unroll") for (int ipl = 0; ipl < 2; ++ipl) { const int qq = fr >> 1; const int r = 16 * kg + 4 * (qq & 3) + 2 * ipl + (qq >> 2); const int fk = ((r >> 2) & 3) | (((r >> 4) & 1) << 2); \
        _Pragma("unroll") for (int ct = 0; ct < 8; ++ct) { const unsigned a0 = (unsigned)(unsigned long)((stl) + r * 128 + ((ct ^ fk) << 4) + (fr & 1) * 8); \
            asm volatile("ds_read_b64_tr_b8 %0, %1" : "=v"(Vr[ipl][ct]) : "v"(a0)); } } } while (0)
#define AT_PVMMA(c, Vr) do { _Pragma("unroll") for (int ipl = 0; ipl < 2; ++ipl) _Pragma("unroll") for (int ct = 0; ct < 8; ++ct) \
        O[ct] = __builtin_amdgcn_mfma_f32_16x16x32_fp8_fp8(Pf[2 * (c) + ipl], Vr[ipl][ct], O[ct], 0, 0, 0); } while (0)
    long Vr[2][8];
    AT_SB; AT_WAITV(8); AT_SB; AT_PVREAD(Vr, s0l); AT_WAITL; AT_SB; AT_DMA(s0l, avb, 2, AT_FV); AT_SB; AT_PVMMA(0, Vr); AT_SB;
    AT_WAITV(8); AT_SB; AT_PVREAD(Vr, s1l); AT_WAITL; AT_SB; AT_DMA(s1l, avb, 3, AT_FV); AT_SB; AT_PVMMA(1, Vr); AT_SB;
    AT_WAITV(8); AT_SB; AT_PVREAD(Vr, s0l); AT_WAITL; AT_SB; AT_PVMMA(2, Vr); AT_SB;
    AT_WAITV(0); AT_SB; AT_PVREAD(Vr, s1l); AT_WAITL; AT_SB; AT_PVMMA(3, Vr); AT_SB;
#undef AT_PVREAD
#undef AT_PVMMA
#undef AT_DMA
#undef AT_FK
#undef AT_FV
#undef AT_WAITV
#undef AT_WAITL
#undef AT_SB
#undef AT_READK
#undef AT_MMAK
#undef AT_PV
    h16* ot = (h16*)vl;
    if (kg == 0) {
#pragma unroll
        for (int ct = 0; ct < 8; ++ct)
#pragma unroll
            for (int r = 0; r < 4; ++r) ot[r * 128 + 16 * ct + fr] = (h16)O[ct][r];
    }
    {
        const h16x8 ov = *(const h16x8*)(ot + 8 * lane);
        float rs[8];
#pragma unroll
        for (int j = 0; j < 8; ++j) rs[j] = (float)ov[j] * (float)gate_r[j] * (16.0f / 256.0f);
        int w0 = 0, w1 = 0;
        w0 = __builtin_amdgcn_cvt_pk_fp8_f32(rs[0], rs[1], w0, false); w0 = __builtin_amdgcn_cvt_pk_fp8_f32(rs[2], rs[3], w0, true);
        w1 = __builtin_amdgcn_cvt_pk_fp8_f32(rs[4], rs[5], w1, false); w1 = __builtin_amdgcn_cvt_pk_fp8_f32(rs[6], rs[7], w1, true);
        typedef int i32x2q __attribute__((ext_vector_type(2)));
        *(i32x2q*)(p.ws + OFF_OMIX + (size_t)bt * 3072 + 2048 + (4 * g) * 128 + 8 * lane) = (i32x2q){w0, w1};
    }
#pragma unroll
    for (int c = 0; c < 4; ++c) kix[c] = kixn[c];
    }
#undef AT_LOADI
}

__device__ __forceinline__ void phase5(const Params& p) {
    const int tid = opaque_tid(), wid = tid >> 6, lane = tid & 63;
    const int gw = blockIdx.x * 8 + wid, nw = gridDim.x * 8;
    const float* rowss = (const float*)(p.ws + OFF_ROWSS);
    for (int row = gw; row < BT; row += nw) {
        const float r = 1.0f / sqrtf(rowss[row] * (1.0f / DM) + EPS);
        f32x4* o = (f32x4*)(p.out + (size_t)row * DM);
        float eadd = 0.f;
        if ((TS_A >= 0 || TS_ACC >= 0) && row < 164) { const unsigned* ts = (const unsigned*)(p.ws + OFF_CTRL + 8192); const float tus = (TS_ACC >= 0) ? (float)ts[16 + (TS_ACC >= 0 ? TS_ACC : 0)] * (0.01f / 256.0f) : (float)(ts[TS_B >= 0 ? TS_B : 0] - ts[TS_A >= 0 ? TS_A : 0]) * 0.01f; eadd = sqrtf(tus * 1e-5f); }
#pragma unroll
        for (int i = 0; i < 8; ++i) { const f32x4 g = ((const f32x4*)p.final_g)[lane + 64 * i]; f32x4 v = o[lane + 64 * i]; v = v * r * g + eadd; o[lane + 64 * i] = v; }
    }
}

#define XB_TMO      128
#define XB_XCNT(j)  (256  + 64 * (j))
#define XB_XSUB(j)  (1280 + 64 * (j))
#define XB_XGEN(j)  (2304 + 64 * (j))
#define XB_TOP      3328
#define XB_TOPGEN   3392
#define XCD_BAR_WORDS 3456
#define XB_SPIN_CAP (1u << 18)

__device__ __forceinline__ unsigned xb_ld(unsigned* p)              { return __hip_atomic_load(p, __ATOMIC_RELAXED, __HIP_MEMORY_SCOPE_AGENT); }
__device__ __forceinline__ unsigned xb_add(unsigned* p, unsigned v) { return __hip_atomic_fetch_add(p, v, __ATOMIC_RELAXED, __HIP_MEMORY_SCOPE_AGENT); }
__device__ __forceinline__ unsigned xb_xcc_id() { return (unsigned)__builtin_amdgcn_s_getreg((3 << 11) | 20) & 0xFu; }
#define XB_SPIN(cond, bar) do { unsigned _sp = 0; while (cond) { __builtin_amdgcn_s_sleep(1); \
    if ((++_sp & 255u) == 0u) { if (xb_ld(&(bar)[XB_TMO])) break; if (_sp > XB_SPIN_CAP) { atomicAdd(&(bar)[XB_TMO], 1u); break; } } } } while (0)

struct XcdBarrier {
    unsigned* bar; unsigned x;
    volatile LAS unsigned* st;
};

__device__ __forceinline__ XcdBarrier xcd_barrier_post(unsigned* bar, volatile LAS unsigned* st) {
    XcdBarrier b; b.bar = bar; b.x = xb_xcc_id(); b.st = st;
    if (threadIdx.x == 0) (void)xb_add(&bar[XB_XCNT(b.x)], 1u);
    return b;
}
__device__ __forceinline__ void xcd_barrier_complete(unsigned* bar, unsigned x, unsigned& nloc, unsigned& nx) {
    const unsigned G = gridDim.x * gridDim.y * gridDim.z;
    unsigned sum, cnt, mine, sp = 0u;
    for (;;) {
        sum = 0u; cnt = 0u; mine = 0u;
#pragma unroll
        for (unsigned j = 0; j < 16; ++j) { const unsigned c = xb_ld(&bar[XB_XCNT(j)]); sum += c; cnt += (c > 0u) ? 1u : 0u; mine = (j == x) ? c : mine; }
        if (sum == G) break;
        __builtin_amdgcn_s_sleep(1);
        if ((++sp & 255u) == 0u) { if (xb_ld(&bar[XB_TMO])) break; if (sp > XB_SPIN_CAP) { atomicAdd(&bar[XB_TMO], 1u); break; } }
    }
    nloc = mine > 0u ? mine : 1u; nx = cnt > 0u ? cnt : 1u;
}

__device__ __forceinline__ void xcd_barrier(const XcdBarrier& b) {
    asm volatile("s_waitcnt vmcnt(0)" ::: "memory");
    __syncthreads();
    if (threadIdx.x == 0) {
        unsigned* bar = b.bar;
        __builtin_amdgcn_s_waitcnt(0);
        unsigned nloc = b.st[0], nx = b.st[1];
        if (nloc == 0u) { xcd_barrier_complete(bar, b.x, nloc, nx); b.st[0] = nloc; b.st[1] = nx; }
        const unsigned old = xb_add(&bar[XB_XSUB(b.x)], 1u);
        const unsigned gen = old / nloc;
        if (old + 1u == (gen + 1u) * nloc) {
            __builtin_amdgcn_fence(__ATOMIC_RELEASE, "agent");
            asm volatile("s_waitcnt vmcnt(0)" ::: "memory");
            const unsigned og = xb_add(&bar[XB_TOP], 1u);
            const unsigned tg = og / nx;
            if (og + 1u == (tg + 1u) * nx) xb_add(&bar[XB_TOPGEN], 1u);
            else XB_SPIN(xb_ld(&bar[XB_TOPGEN]) == tg, bar);
            __builtin_amdgcn_fence(__ATOMIC_ACQUIRE, "agent");
            xb_add(&bar[XB_XGEN(b.x)], 1u);
            asm volatile("s_waitcnt vmcnt(0)" ::: "memory");
        } else {
            XB_SPIN(xb_ld(&bar[XB_XGEN(b.x)]) == gen, bar);
            __builtin_amdgcn_fence(__ATOMIC_ACQUIRE, "agent");
            asm volatile("s_waitcnt vmcnt(0)" ::: "memory");
        }
    }
    __syncthreads();
}


template <int LO, int HI>
__global__ void __launch_bounds__(512, 2) k_phases(Params p) {
    extern __shared__ __attribute__((aligned(16))) unsigned char smem[];
#define IN(k) (LO <= (k) && (k) < HI)
#define SEAM(k) do { if constexpr (IN(k) && IN((k) + 1)) { xcd_barrier(xbar); if (TS_A >= 0 && blockIdx.x == 0 && threadIdx.x == 0) ((unsigned*)(p.ws + OFF_CTRL + 8192))[(k) + 1] = (unsigned)__builtin_amdgcn_s_memrealtime(); } } while (0)
    XcdBarrier xbar; xbar.bar = nullptr; xbar.x = 0; xbar.st = nullptr;
    if constexpr (HI - LO > 1) {
        volatile LAS unsigned* stw = (volatile LAS unsigned*)((LAS unsigned char*)smem + LDS_BYTES - 48);
        if (threadIdx.x < 4) stw[threadIdx.x] = 0u;
        __syncthreads();
        xbar = xcd_barrier_post((unsigned*)(p.ws + OFF_CTRL + 16384), stw);
    }
    if (TS_A >= 0 && blockIdx.x == 0 && threadIdx.x == 0) ((unsigned*)(p.ws + OFF_CTRL + 8192))[0] = (unsigned)__builtin_amdgcn_s_memrealtime();
    if constexpr (IN(0)) { for (int rep = 0; rep < NREP(0); ++rep) phase0(p, smem); }
    SEAM(0);
    if constexpr (IN(1)) for (int rep = 0; rep < NREP(1); ++rep) {
        EpiIn E{p.ws, p.a_log, p.dt_bias, p.pos};
        {
            pg8::Gemm g{(const h16*)(p.ws + OFF_H8), (const h16*)(p.ws + OFF_WT8 - (size_t)16 * 256 * 2048), BT, 2560, DM};
            OrderF8 S; S.G = gridDim.x; S.c = blockIdx.x;
            pg8::gemm_phase<EpiIn, OrderF8, true, true>((LAS unsigned char*)smem, g, S, E);
        }
        {
            pg8::Gemm g{(const h16*)(p.ws + OFF_H), (const h16*)(p.ws + OFF_WT), BT, NPAD, DM};
            OrderF16 S; S.init(BT, 21 * 256, gridDim.x, blockIdx.x);
            pg8::gemm_phase<EpiIn, OrderF16>((LAS unsigned char*)smem, g, S, E);
        }
    }
    SEAM(1);
    if constexpr (IN(2)) for (int rep = 0; rep < NREP(2); ++rep) {
        {
            unsigned* qctr = (unsigned*)(p.ws + OFF_CTRL);
            volatile unsigned* lds_t = (volatile unsigned*)(smem + LDS_BYTES - 16);
            __syncthreads();
            if (threadIdx.x == 0) lds_t[0] = atomicAdd(qctr + 0 + 16 * rep, 1u);
            __syncthreads();
            unsigned o = lds_t[0];
            unsigned* pdone = qctr + 300;
            bool published = false; int pendf = -1;
            while (o < 1024u + 32u + 2048u) {
                unsigned nxt = 0u;
                if (threadIdx.x == 0) nxt = atomicAdd(qctr + 0 + 16 * rep, 1u);
                if (o < 1024u) { ACC_T0(); gdn_prep_pair(p, smem, (int)o); LDS_SYNC(); ACC_ADD(0); }
                else {
                    if (!published) {
                        published = true;
                        asm volatile("s_waitcnt vmcnt(0)" ::: "memory"); __syncthreads();
                        if (threadIdx.x == 0) { __builtin_amdgcn_fence(__ATOMIC_RELEASE, "agent"); asm volatile("s_waitcnt vmcnt(0)" ::: "memory"); __hip_atomic_fetch_add(pdone, 1u, __ATOMIC_RELAXED, __HIP_MEMORY_SCOPE_AGENT); }
                    }
                    if (o < 1056u) {
                        if (threadIdx.x == 0) { unsigned spins = 0; while (__hip_atomic_load(pdone, __ATOMIC_RELAXED, __HIP_MEMORY_SCOPE_AGENT) < gridDim.x) { __builtin_amdgcn_s_sleep(8); if (++spins > (1u << 22)) break; } }
                        __syncthreads();
                        __builtin_amdgcn_fence(__ATOMIC_ACQUIRE, "agent"); asm volatile("s_waitcnt vmcnt(0)" ::: "memory");
                        gdn_scan_task(p, smem, (int)(o - 1024u)); __syncthreads();
                    } else { const unsigned o2 = o - 1056u; pendf = idx8_task(p, smem, (int)(o2 & 3u), 511 - (int)(o2 >> 2), pendf); }
                }
                if (threadIdx.x == 0) lds_t[0] = nxt;
                LDS_SYNC();
                o = lds_t[0];
            }
            if (pendf >= 0) {
                asm volatile("s_waitcnt vmcnt(0)" ::: "memory"); __syncthreads();
                if (threadIdx.x == 0) __hip_atomic_store((unsigned*)(p.ws + OFF_CTRL + 49152) + pendf, 1u, __ATOMIC_RELAXED, __HIP_MEMORY_SCOPE_AGENT);
            }
            if (!published) {
                asm volatile("s_waitcnt vmcnt(0)" ::: "memory"); __syncthreads();
                if (threadIdx.x == 0) { __builtin_amdgcn_fence(__ATOMIC_RELEASE, "agent"); asm volatile("s_waitcnt vmcnt(0)" ::: "memory"); __hip_atomic_fetch_add(pdone, 1u, __ATOMIC_RELAXED, __HIP_MEMORY_SCOPE_AGENT); }
            }
        }
    }
    if constexpr (IN(3)) for (int rep = 0; rep < NREP(3); ++rep) {
        {
            unsigned* qctr = (unsigned*)(p.ws + OFF_CTRL);
            volatile unsigned* lds_t = (volatile unsigned*)(smem + LDS_BYTES - 16);
            volatile unsigned* lds_c = (volatile unsigned*)(smem + LDS_BYTES - 192);
            const int myx = (int)(xb_xcc_id() & 7u);
            {
                for (int k = 0; k < 8; ++k) {
                    const int part = (myx + k) & 7;
                    if (k == 1) { __syncthreads(); if (threadIdx.x < 8) lds_c[threadIdx.x] = __hip_atomic_load(qctr + 128 + 16 * rep + threadIdx.x, __ATOMIC_RELAXED, __HIP_MEMORY_SCOPE_AGENT); __syncthreads(); }
                    if (k >= 1 && lds_c[part] >= 512u) continue;
#define ATT_POLL(tk) do { if ((tk) < 512u) { const unsigned* fl = (const unsigned*)(p.ws + OFF_CTRL + 49152) + (part >> 1) * 512 + (511 - (int)(tk)); unsigned spins = 0; \
                        while (__hip_atomic_load(fl, __ATOMIC_RELAXED, __HIP_MEMORY_SCOPE_AGENT) == 0u) { __builtin_amdgcn_s_sleep(4); if (++spins > (1u << 22)) break; } } } while (0)
                    __syncthreads();
                    if (threadIdx.x == 0) { const unsigned t0_ = atomicAdd(qctr + 128 + 16 * rep + part, 1u); ATT_POLL(t0_); lds_t[0] = t0_; }
                    __syncthreads();
                    unsigned a = lds_t[0]; int slot = 1;
                    while (a < 512u) {
                        unsigned nxt = 0u;
                        if (threadIdx.x == 0) nxt = atomicAdd(qctr + 128 + 16 * rep + part, 1u);
                        attn8_task(p, smem, part, 511 - (int)a);
                        if (threadIdx.x == 0) { ATT_POLL(nxt); lds_t[slot] = nxt; }
                        LDS_SYNC();
                        a = lds_t[slot]; slot ^= 3;
                    }
                    __syncthreads();
#undef ATT_POLL
                }
            }
        }
    }
    SEAM(3);
    const bool fuse_norm = (gridDim.x == 256) && (TS_A < 0) && (TS_ACC < 0);
    if constexpr (IN(4)) {
        pg8::Gemm g{(const h16*)(p.ws + OFF_OMIX), (const h16*)(p.ws + OFF_WOT), BT, DM, DM};
        if (fuse_norm) {
            PanelOrder S; S.c = blockIdx.x;
            EpiOutNorm E{p.x, p.out, (float*)(p.ws + OFF_ROWSS), (unsigned*)(p.ws + OFF_CTRL + 32768), p.final_g};
            pg8::gemm_phase<EpiOutNorm, PanelOrder, true, false, true, 0x79797979u, 0x7B7B7B7Bu>((LAS unsigned char*)smem, g, S, E);
        } else {
            pg8::StaticOrder S; S.init(BT, DM, gridDim.x, blockIdx.x);
            EpiOut E{p.x, p.out, (float*)(p.ws + OFF_ROWSS)};
            pg8::gemm_phase<EpiOut, pg8::StaticOrder, true, false, true, 0x79797979u, 0x7B7B7B7Bu>((LAS unsigned char*)smem, g, S, E);
        }
    }
    if (fuse_norm) return;
    SEAM(4);
    if constexpr (IN(5)) { phase5(p); }
#undef IN
#undef SEAM
}

template <int LO, int HI> static void launch_range(const Params& p, int grid, hipStream_t stream, bool coop) {
    static bool attr = false;
    if (!attr) { hipFuncSetAttribute((const void*)k_phases<LO, HI>, hipFuncAttributeMaxDynamicSharedMemorySize, LDS_BYTES); attr = true; }
    if (coop) {
        Params pp = p; void* args[] = {&pp};
        hipError_t e = hipLaunchCooperativeKernel((const void*)k_phases<LO, HI>, dim3(grid), dim3(512), args, LDS_BYTES, stream);
        if (e != hipSuccess) fprintf(stderr, "cooperative launch failed: %s (grid %d)\n", hipGetErrorString(e), grid);
    } else {
        hipLaunchKernelGGL((k_phases<LO, HI>), dim3(grid), dim3(512), LDS_BYTES, stream, p);
    }
}

extern "C" void kernel_launch(void* const* d_in, const int* in_sizes, int n_in, void* d_out, int out_size, void* d_ws, size_t ws_size, hipStream_t stream) {
    if (n_in != 10 || in_sizes[0] != BT * DM || out_size != BT * DM || ws_size < WS_END) {
        fprintf(stderr, "kernel_launch: unexpected shapes (n_in %d in0 %d out %d ws %zu need %zu)\n", n_in, n_in > 0 ? in_sizes[0] : -1, out_size, ws_size, (size_t)WS_END); return; }
    static int grid = 0;
    if (!grid) {
        int dev = 0, cus = 0, per_cu = 0; hipGetDevice(&dev); hipDeviceGetAttribute(&cus, hipDeviceAttributeMultiprocessorCount, dev);
#if FUSED
        hipFuncSetAttribute((const void*)k_phases<0, 6>, hipFuncAttributeMaxDynamicSharedMemorySize, LDS_BYTES);
        hipOccupancyMaxActiveBlocksPerMultiprocessor(&per_cu, (const void*)k_phases<0, 6>, 512, LDS_BYTES);
#else
        per_cu = 1;
#endif
        if (per_cu < 1) per_cu = 1; if (per_cu > 1) per_cu = 1;
        grid = cus * per_cu;
    }
    Params p{};
    p.x = (const float*)d_in[0]; p.pos = (const int*)d_in[1]; p.attn_g = (const float*)d_in[2]; p.w_in = (const float*)d_in[3]; p.conv_w = (const float*)d_in[4];
    p.a_log = (const float*)d_in[5]; p.dt_bias = (const float*)d_in[6]; p.gdn_norm_g = (const float*)d_in[7]; p.w_out = (const float*)d_in[8]; p.final_g = (const float*)d_in[9];
    p.out = (float*)d_out; p.ws = (unsigned char*)d_ws;
    hipMemsetAsync((char*)d_ws + OFF_CTRL, 0, CTL_ZERO_BYTES, stream);
#if FUSED
    launch_range<0, 6>(p, grid, stream, false);
#else
    launch_range<0, 1>(p, grid, stream, false);
    launch_range<1, 2>(p, grid, stream, false);
    launch_range<2, 3>(p, grid, stream, false);
    launch_range<3, 4>(p, grid, stream, false);
    launch_range<4, 5>(p, grid, stream, false);
    launch_range<5, 6>(p, grid, stream, false);
#endif
}
```
